# Optimizing an MI355X kernel written in HIP

```python
import math
import jax, jax.numpy as jnp
from jax import lax
import numpy as np

D_MODEL = 1024
BATCH = 2
SEQ = 8192
DEPTH = 4

N_MIXERS = 4
LN_EPS = 1e-5
NEG_BIG = -1e30
ML_HEADS = 8
ML_DQK = D_MODEL // 16
ML_DV = D_MODEL // 8
ML_CHUNK = 128
ML_F_BIAS_LO = 3.0
ML_F_BIAS_HI = 6.0
RET_HEADS = 8
RET_DQK = D_MODEL // RET_HEADS
RET_DV = 2 * D_MODEL // RET_HEADS
RET_CHUNK = 64
ROPE_BASE = 10000.0
GLA_HEADS = 4
GLA_DQK = D_MODEL // (2 * GLA_HEADS)
GLA_DV = D_MODEL // GLA_HEADS
GLA_RANK = 16
GLA_TAU = 16.0
GLA_CHUNK = 64
S5_GROUP = 16
S5_GROUPS = D_MODEL // S5_GROUP
S5_STATE = 64
N_EXPERTS = 32
TOP_K = 4
D_FF = D_MODEL
SWIGLU_LIMIT = 7.0
SWIGLU_ALPHA = 1.702
MOE_BLOCK = 256

kernel_name = 'hybrid_mlstm_retention_gla_s5_moe_deepnorm'


def _n_layers_of(kind):
    return (DEPTH - kind + N_MIXERS - 1) // N_MIXERS


def layer_norm(x, g, b):
    xf = x.astype(jnp.float32)
    mu = xf.mean(-1, keepdims=True)
    var = jnp.square(xf - mu).mean(-1, keepdims=True)
    return (xf - mu) * lax.rsqrt(var + LN_EPS) * g + b


def split_heads(t, n_heads):
    bn, t_len, _ = t.shape
    return t.reshape(bn, t_len, n_heads, -1).transpose(0, 2, 1, 3)


def head_norm(h, g):
    h = h.astype(jnp.float32)
    mu = h.mean(-1, keepdims=True)
    var = jnp.square(h - mu).mean(-1, keepdims=True)
    hn = (h - mu) * lax.rsqrt(var + LN_EPS)
    bn, nh, t_len, d = h.shape
    return hn.transpose(0, 2, 1, 3).reshape(bn, t_len, nh * d) * g


def rotary(t):
    t_len, d = t.shape[2], t.shape[3]
    inv = ROPE_BASE ** (-jnp.arange(0, d, 2, dtype=jnp.float32) / d)
    ang = jnp.arange(t_len, dtype=jnp.float32)[:, None] * inv[None, :]
    cos, sin = jnp.cos(ang), jnp.sin(ang)
    t1, t2 = t[..., : d // 2], t[..., d // 2:]
    return jnp.concatenate([t1 * cos - t2 * sin, t1 * sin + t2 * cos], axis=-1)


def mlstm_chunkwise(q, k, v, i_pre, f_pre):
    bn, nh, t_len, dk = q.shape
    dv = v.shape[-1]
    L = ML_CHUNK
    nc = t_len // L
    q = q.astype(jnp.float32).reshape(bn, nh, nc, L, dk) * (dk ** -0.5)
    k = k.astype(jnp.float32).reshape(bn, nh, nc, L, dk)
    v = v.astype(jnp.float32).reshape(bn, nh, nc, L, dv)
    ig = i_pre.reshape(bn, nh, nc, L)
    a = jnp.cumsum(jax.nn.log_sigmoid(f_pre).reshape(bn, nh, nc, L), axis=-1)
    a_tot = a[..., -1]
    w_log = a_tot[..., None] - a + ig
    m_loc = w_log.max(-1)
    w = jnp.exp(w_log - m_loc[..., None])
    c_loc = jnp.einsum('bhcl,bhcld,bhcle->bhcde', w, k, v)
    n_loc = jnp.einsum('bhcl,bhcld->bhcd', w, k)

    def step(carry, inp):
        c_st, n_st, m_st = carry
        cl, nl, ml, at = inp
        m_new = jnp.maximum(at + m_st, ml)
        s_old = jnp.exp(at + m_st - m_new)
        s_loc = jnp.exp(ml - m_new)
        c_new = s_old[..., None, None] * c_st + s_loc[..., None, None] * cl
        n_new = s_old[..., None] * n_st + s_loc[..., None] * nl
        return (c_new, n_new, m_new), (c_st, n_st, m_st)

    init = (jnp.zeros((bn, nh, dk, dv), jnp.float32), jnp.zeros((bn, nh, dk), jnp.float32),
            jnp.full((bn, nh), NEG_BIG, jnp.float32))
    xs = (jnp.moveaxis(c_loc, 2, 0), jnp.moveaxis(n_loc, 2, 0), jnp.moveaxis(m_loc, 2, 0), jnp.moveaxis(a_tot, 2, 0))
    _, (c_prev, n_prev, m_prev) = lax.scan(step, init, xs)
    c_prev = jnp.moveaxis(c_prev, 0, 2)
    n_prev = jnp.moveaxis(n_prev, 0, 2)
    m_prev = jnp.moveaxis(m_prev, 0, 2)
    causal = jnp.tril(jnp.ones((L, L), dtype=bool))
    d_log = jnp.where(causal, a[..., :, None] - a[..., None, :] + ig[..., None, :], -jnp.inf)
    inter_log = a + m_prev[..., None]
    m_t = jnp.maximum(inter_log, d_log.max(-1))
    s = jnp.einsum('bhcld,bhcsd->bhcls', q, k) * jnp.exp(d_log - m_t[..., None])
    inter_scale = jnp.exp(inter_log - m_t)
    num = jnp.einsum('bhcls,bhcse->bhcle', s, v) + inter_scale[..., None] * jnp.einsum('bhcld,bhcde->bhcle', q, c_prev)
    den = s.sum(-1) + inter_scale * jnp.einsum('bhcld,bhcd->bhcl', q, n_prev)
    h = num / jnp.maximum(jnp.abs(den), jnp.exp(-m_t))[..., None]
    return h.reshape(bn, nh, t_len, dv)


def chunked_decay_attention(q, k, v, log_a, L):
    bn, nh, t_len, dk = q.shape
    dv = v.shape[-1]
    nc = t_len // L
    q = q.astype(jnp.float32).reshape(bn, nh, nc, L, dk)
    k = k.astype(jnp.float32).reshape(bn, nh, nc, L, dk)
    v = v.astype(jnp.float32).reshape(bn, nh, nc, L, dv)
    b = jnp.cumsum(log_a.astype(jnp.float32).reshape(log_a.shape[:2] + (nc, L, log_a.shape[-1])), axis=3)
    b_end = b[:, :, :, -1:]
    q_in = q * jnp.exp(b)
    k_in = k * jnp.exp(-b)
    k_st = k * jnp.exp(b_end - b)
    causal = jnp.tril(jnp.ones((L, L), dtype=bool))
    scores = jnp.where(causal, jnp.einsum('bhcld,bhcsd->bhcls', q_in, k_in), 0.0)
    intra = jnp.einsum('bhcls,bhcse->bhcle', scores, v)
    u = jnp.einsum('bhcld,bhcle->bhcde', k_st, v)
    dec = jnp.exp(b_end[:, :, :, 0])

    def step(s_st, inp):
        u_c, dec_c = inp
        return dec_c[..., None] * s_st + u_c, s_st

    _, s_prev = lax.scan(step, jnp.zeros((bn, nh, dk, dv), jnp.float32), (jnp.moveaxis(u, 2, 0), jnp.moveaxis(dec, 2, 0)))
    s_prev = jnp.moveaxis(s_prev, 0, 2)
    inter = jnp.einsum('bhcld,bhcde->bhcle', q_in, s_prev)
    return (intra + inter).reshape(bn, nh, t_len, dv)


def mlstm_mixer(x, w_in, b_gates, norm_g, w_out):
    qk, vw = ML_HEADS * ML_DQK, ML_HEADS * ML_DV
    q, k, v, o, gates = jnp.split(x @ w_in, [qk, 2 * qk, 2 * qk + vw, 2 * qk + 2 * vw], axis=-1)
    gates = (gates + b_gates).astype(jnp.float32).transpose(0, 2, 1)
    h = mlstm_chunkwise(split_heads(q, ML_HEADS), split_heads(k, ML_HEADS), split_heads(v, ML_HEADS),
                        gates[:, :ML_HEADS], gates[:, ML_HEADS:])
    return (jax.nn.sigmoid(o) * head_norm(h, norm_g)) @ w_out


def retention_mixer(x, w_in, norm_g, w_out):
    qk, vw = RET_HEADS * RET_DQK, RET_HEADS * RET_DV
    q, k, v, g = jnp.split(x @ w_in, [qk, 2 * qk, 2 * qk + vw], axis=-1)
    q = rotary(split_heads(q, RET_HEADS).astype(jnp.float32))
    k = rotary(split_heads(k, RET_HEADS).astype(jnp.float32)) * (RET_DQK ** -0.5)
    log_gamma = jnp.log1p(-(2.0 ** (-5.0 - jnp.arange(RET_HEADS, dtype=jnp.float32))))
    log_a = jnp.broadcast_to(log_gamma[None, :, None, None], (1, RET_HEADS, x.shape[1], 1))
    o = chunked_decay_attention(q, k, split_heads(v, RET_HEADS), log_a, RET_CHUNK)
    return (jax.nn.silu(g) * head_norm(o, norm_g)) @ w_out


def gla_mixer(x, w_in, w_gate, b_gate, norm_g, w_out):
    qk, vw = GLA_HEADS * GLA_DQK, GLA_HEADS * GLA_DV
    q, k, v, r, z = jnp.split(x @ w_in, [qk, 2 * qk, 2 * qk + vw, 2 * qk + 2 * vw], axis=-1)
    log_a = jax.nn.log_sigmoid((z @ w_gate + b_gate).astype(jnp.float32)) / GLA_TAU
    k = split_heads(k, GLA_HEADS) * (GLA_DQK ** -0.5)
    o = chunked_decay_attention(split_heads(q, GLA_HEADS), k, split_heads(v, GLA_HEADS),
                                split_heads(log_a, GLA_HEADS), GLA_CHUNK)
    return (jax.nn.silu(r) * head_norm(o, norm_g)) @ w_out


def s5_mixer(x, w_in, lam_re, lam_im, b_re, b_im, c_re, c_im, d_skip, log_dt, w_glu, b_glu, w_out):
    f32 = jnp.float32
    bn, t_len, _ = x.shape
    u = (x @ w_in).astype(f32).reshape(bn, t_len, S5_GROUPS, S5_GROUP)
    lam = lax.complex(lam_re.astype(f32), lam_im.astype(f32))
    dt = jnp.exp(log_dt.astype(f32))[:, None]
    lam_bar = jnp.exp(lam * dt)
    b_bar = ((lam_bar - 1.0) / lam)[..., None] * lax.complex(b_re.astype(f32), b_im.astype(f32))
    bu = jnp.einsum('gph,btgh->btgp', b_bar, u.astype(jnp.complex64))
    a_elems = jnp.broadcast_to(lam_bar, bu.shape)

    def combine(e1, e2):
        a1, v1 = e1
        a2, v2 = e2
        return a2 * a1, a2 * v1 + v2

    _, states = lax.associative_scan(combine, (a_elems, bu), axis=1)
    c_mat = lax.complex(c_re.astype(f32), c_im.astype(f32))
    y = jnp.einsum('ghp,btgp->btgh', c_mat, states).real + d_skip.reshape(S5_GROUPS, S5_GROUP) * u
    y = jax.nn.gelu(y.reshape(bn, t_len, S5_GROUPS * S5_GROUP))
    y = y * jax.nn.sigmoid(y @ w_glu + b_glu)
    return y @ w_out


def moe_ffn(x, w_router, b_router, w_gate_up, b_gate_up, w_down, b_down):
    bn, t_len, dm = x.shape
    xf = x.reshape(-1, dm)
    n_tok = xf.shape[0]
    logits = (xf @ w_router + b_router).astype(jnp.float32)
    top_val, top_idx = lax.top_k(logits, TOP_K)
    gates = jax.nn.softmax(top_val, axis=-1)
    n_assign = n_tok * TOP_K
    e_flat = top_idx.reshape(-1)
    tok_flat = jnp.arange(n_assign, dtype=jnp.int32) // TOP_K
    order = jnp.argsort(e_flat)
    e_sorted = e_flat[order]
    tok_sorted = tok_flat[order]
    g_sorted = gates.reshape(-1)[order]
    counts = jnp.bincount(e_flat, length=N_EXPERTS)
    padded = (counts + MOE_BLOCK - 1) // MOE_BLOCK * MOE_BLOCK
    start = jnp.cumsum(counts) - counts
    pad_end = jnp.cumsum(padded)
    pad_start = pad_end - padded
    dest = pad_start[e_sorted] + (jnp.arange(n_assign, dtype=jnp.int32) - start[e_sorted])
    n_rows = -(-n_assign // MOE_BLOCK) * MOE_BLOCK + N_EXPERTS * MOE_BLOCK
    n_blocks = n_rows // MOE_BLOCK
    row_tok = jnp.zeros((n_rows,), jnp.int32).at[dest].set(tok_sorted)
    block_start = jnp.arange(n_blocks, dtype=jnp.int32) * MOE_BLOCK
    block_expert = jnp.minimum(jnp.searchsorted(pad_end, block_start, side='right'), N_EXPERTS - 1)
    x_rows = xf[row_tok].reshape(n_blocks, MOE_BLOCK, dm)

    def expert_block(args):
        xb, e = args
        hgu = xb @ w_gate_up[e] + b_gate_up[e]
        gate = jnp.minimum(hgu[:, :D_FF], SWIGLU_LIMIT)
        up = jnp.clip(hgu[:, D_FF:], -SWIGLU_LIMIT, SWIGLU_LIMIT)
        act = (up + 1.0) * gate * jax.nn.sigmoid(SWIGLU_ALPHA * gate)
        return act @ w_down[e] + b_down[e]

    y_rows = lax.map(expert_block, (x_rows, block_expert)).reshape(n_rows, dm)
    y = jnp.zeros((n_tok, dm), y_rows.dtype).at[tok_sorted].add(y_rows[dest] * g_sorted[:, None])
    return y.reshape(bn, t_len, dm)


def setup_inputs(seed: int = 0) -> dict:
    f32 = jnp.float32
    ks = list(jax.random.split(jax.random.key(seed), 48))
    beta = (8 * DEPTH) ** -0.25

    def nrm(shape, scale):
        return jax.random.normal(ks.pop(), shape, f32) * scale

    d = D_MODEL
    n_a, n_b, n_c, n_d = (_n_layers_of(m) for m in range(N_MIXERS))
    ml_cols = 2 * ML_HEADS * ML_DQK + 2 * ML_HEADS * ML_DV + 2 * ML_HEADS
    ret_cols = 2 * RET_HEADS * RET_DQK + 2 * RET_HEADS * RET_DV
    gla_cols = 2 * GLA_HEADS * GLA_DQK + 2 * GLA_HEADS * GLA_DV + GLA_RANK
    f_bias = jnp.linspace(ML_F_BIAS_LO, ML_F_BIAS_HI, ML_HEADS, dtype=f32)
    inp = {}
    inp['x'] = nrm((BATCH, SEQ, d), 1.0)
    inp['ln_g'] = 1.0 + nrm((DEPTH, 2, d), 0.02)
    inp['ln_b'] = nrm((DEPTH, 2, d), 0.02)
    inp['ml_w_in'] = nrm((n_a, d, ml_cols), d ** -0.5)
    inp['ml_b_gates'] = jnp.concatenate([jnp.zeros((n_a, ML_HEADS), f32), jnp.broadcast_to(f_bias, (n_a, ML_HEADS))], -1) + nrm((n_a, 2 * ML_HEADS), 0.1)
    inp['ml_norm_g'] = 1.0 + nrm((n_a, ML_HEADS * ML_DV), 0.02)
    inp['ml_w_out'] = nrm((n_a, ML_HEADS * ML_DV, d), beta * (ML_HEADS * ML_DV) ** -0.5)
    inp['ret_w_in'] = nrm((n_b, d, ret_cols), d ** -0.5)
    inp['ret_norm_g'] = 1.0 + nrm((n_b, RET_HEADS * RET_DV), 0.02)
    inp['ret_w_out'] = nrm((n_b, RET_HEADS * RET_DV, d), beta * (RET_HEADS * RET_DV) ** -0.5)
    inp['gla_w_in'] = nrm((n_c, d, gla_cols), d ** -0.5)
    inp['gla_w_gate'] = nrm((n_c, GLA_RANK, GLA_HEADS * GLA_DQK), GLA_RANK ** -0.5)
    inp['gla_b_gate'] = 2.0 + nrm((n_c, GLA_HEADS * GLA_DQK), 0.1)
    inp['gla_norm_g'] = 1.0 + nrm((n_c, GLA_HEADS * GLA_DV), 0.02)
    inp['gla_w_out'] = nrm((n_c, GLA_HEADS * GLA_DV, d), beta * (GLA_HEADS * GLA_DV) ** -0.5)
    inp['s5_w_in'] = nrm((n_d, d, d), d ** -0.5)
    inp['s5_lam_re'] = -0.5 + nrm((n_d, S5_GROUPS, S5_STATE), 0.01)
    inp['s5_lam_im'] = jnp.pi * jnp.arange(S5_STATE, dtype=f32) + nrm((n_d, S5_GROUPS, S5_STATE), 0.01)
    inp['s5_b_re'] = nrm((n_d, S5_GROUPS, S5_STATE, S5_GROUP), (2.0 * S5_GROUP) ** -0.5)
    inp['s5_b_im'] = nrm((n_d, S5_GROUPS, S5_STATE, S5_GROUP), (2.0 * S5_GROUP) ** -0.5)
    inp['s5_c_re'] = nrm((n_d, S5_GROUPS, S5_GROUP, S5_STATE), (2.0 * S5_STATE) ** -0.5)
    inp['s5_c_im'] = nrm((n_d, S5_GROUPS, S5_GROUP, S5_STATE), (2.0 * S5_STATE) ** -0.5)
    inp['s5_d'] = nrm((n_d, d), 1.0)
    inp['s5_log_dt'] = jax.random.uniform(ks.pop(), (n_d, S5_GROUPS), f32, math.log(1e-3), math.log(1e-1))
    inp['s5_w_glu'] = nrm((n_d, d, d), d ** -0.5)
    inp['s5_b_glu'] = nrm((n_d, d), 0.01)
    inp['s5_w_out'] = nrm((n_d, d, d), beta * d ** -0.5)
    inp['moe_w_router'] = nrm((DEPTH, d, N_EXPERTS), d ** -0.5)
    inp['moe_b_router'] = nrm((DEPTH, N_EXPERTS), 0.01)
    inp['moe_w_gate_up'] = nrm((DEPTH, N_EXPERTS, d, 2 * D_FF), d ** -0.5)
    inp['moe_b_gate_up'] = nrm((DEPTH, N_EXPERTS, 2 * D_FF), 0.01)
    inp['moe_w_down'] = nrm((DEPTH, N_EXPERTS, D_FF, d), beta * D_FF ** -0.5)
    inp['moe_b_down'] = nrm((DEPTH, N_EXPERTS, d), 0.01)
    return inp


def reference(x, ln_g, ln_b, ml_w_in, ml_b_gates, ml_norm_g, ml_w_out, ret_w_in, ret_norm_g, ret_w_out,
              gla_w_in, gla_w_gate, gla_b_gate, gla_norm_g, gla_w_out, s5_w_in, s5_lam_re, s5_lam_im,
              s5_b_re, s5_b_im, s5_c_re, s5_c_im, s5_d, s5_log_dt, s5_w_glu, s5_b_glu, s5_w_out,
              moe_w_router, moe_b_router, moe_w_gate_up, moe_b_gate_up, moe_w_down, moe_b_down):
    alpha = (2 * DEPTH) ** 0.25
    h = x.astype(jnp.float32)
    for layer in range(DEPTH):
        kind, j = layer % N_MIXERS, layer // N_MIXERS
        if kind == 0:
            mix = mlstm_mixer(h, ml_w_in[j], ml_b_gates[j], ml_norm_g[j], ml_w_out[j])
        elif kind == 1:
            mix = retention_mixer(h, ret_w_in[j], ret_norm_g[j], ret_w_out[j])
        elif kind == 2:
            mix = gla_mixer(h, gla_w_in[j], gla_w_gate[j], gla_b_gate[j], gla_norm_g[j], gla_w_out[j])
        else:
            mix = s5_mixer(h, s5_w_in[j], s5_lam_re[j], s5_lam_im[j], s5_b_re[j], s5_b_im[j], s5_c_re[j],
                           s5_c_im[j], s5_d[j], s5_log_dt[j], s5_w_glu[j], s5_b_glu[j], s5_w_out[j])
        h = layer_norm(alpha * h + mix, ln_g[layer, 0], ln_b[layer, 0])
        ffn = moe_ffn(h, moe_w_router[layer], moe_b_router[layer], moe_w_gate_up[layer],
                      moe_b_gate_up[layer], moe_w_down[layer], moe_b_down[layer])
        h = layer_norm(alpha * h + ffn, ln_g[layer, 1], ln_b[layer, 1])
    return h.astype(x.dtype)
```

```cpp
#include <hip/hip_runtime.h>
#include <cstdio>
#include <cstdint>

#ifndef NAIVE_MIX
#define NAIVE_MIX 1
#endif
#ifndef N_LAUNCH_MODE
#define N_LAUNCH_MODE 1
#endif


#ifdef SKIP_ML
constexpr bool defined_SKIP_ML = true;
#else
constexpr bool defined_SKIP_ML = false;
#endif
#ifdef SKIP_RET
constexpr bool defined_SKIP_RET = true;
#else
constexpr bool defined_SKIP_RET = false;
#endif
#ifdef SKIP_GLA
constexpr bool defined_SKIP_GLA = true;
#else
constexpr bool defined_SKIP_GLA = false;
#endif
#ifdef SKIP_S5
constexpr bool defined_SKIP_S5 = true;
#else
constexpr bool defined_SKIP_S5 = false;
#endif
#ifdef SKIP_LN1
constexpr bool defined_SKIP_LN1 = true;
#else
constexpr bool defined_SKIP_LN1 = false;
#endif
#ifdef SKIP_P0
constexpr bool defined_SKIP_P0 = true;
#else
constexpr bool defined_SKIP_P0 = false;
#endif
#ifndef PHMASK
#define PHMASK 0xffff
#endif
#define PHE(b) (((PHMASK) >> (b)) & 1)
#define GAS __attribute__((address_space(1)))
#define LAS __attribute__((address_space(3)))
typedef unsigned short bf16;
typedef short bf16x8 __attribute__((ext_vector_type(8)));
typedef float f32x4 __attribute__((ext_vector_type(4)));
typedef float f32x2 __attribute__((ext_vector_type(2)));
typedef unsigned u32x4 __attribute__((ext_vector_type(4)));
typedef unsigned u32x2 __attribute__((ext_vector_type(2)));

constexpr int BATCH = 2, T = 8192, D = 1024, M = BATCH * T;
constexpr int NEXP = 32, TOPK = 4, DFF = 1024, CAP = M;
constexpr int NWAVES = 8, NTHREADS = 512;
constexpr float LN_EPS = 1e-5f;
constexpr float ALPHA = 1.681792830507429f;
constexpr int MAXTILES = (M * TOPK) / 256 + NEXP;

constexpr size_t MiB = 1u << 20;
constexpr size_t WS_CTL = 0, CTL_ZERO_BYTES = 1 * MiB;
constexpr size_t WS_WT_ML_IN = 1 * MiB;
constexpr size_t WS_WT_ML_OUT = WS_WT_ML_IN + 6 * MiB;
constexpr size_t WS_WT_RET_IN = WS_WT_ML_OUT + 2 * MiB;
constexpr size_t WS_WT_RET_OUT = WS_WT_RET_IN + 12 * MiB;
constexpr size_t WS_WT_GLA_IN = WS_WT_RET_OUT + 4 * MiB;
constexpr size_t WS_WT_GLA_OUT = WS_WT_GLA_IN + 6 * MiB;
constexpr size_t WS_WT_S5_IN = WS_WT_GLA_OUT + 2 * MiB;
constexpr size_t WS_WT_S5_GLU = WS_WT_S5_IN + 2 * MiB;
constexpr size_t WS_WT_S5_OUT = WS_WT_S5_GLU + 2 * MiB;
constexpr size_t WS_S5TAB = WS_WT_S5_OUT + 2 * MiB;
constexpr size_t WS_GB = WS_S5TAB + 1 * MiB;
constexpr size_t WS_LIST = WS_GB + 1 * MiB;
constexpr size_t WS_GW = WS_LIST + 2 * MiB;
constexpr size_t WS_WT_GU = WS_GW + 1 * MiB;
constexpr size_t WS_WT_DN = WS_WT_GU + 512 * MiB;
constexpr size_t WS_HF = WS_WT_DN + 256 * MiB;
constexpr size_t WS_XB = WS_HF + 64 * MiB;
constexpr size_t WS_ZF = WS_XB + 32 * MiB;
constexpr size_t WS_PB = WS_ZF + 64 * MiB;
constexpr size_t WS_LA = WS_PB + 192 * MiB;
constexpr size_t WS_ORAW = WS_LA + 32 * MiB;
constexpr size_t WS_YB = WS_ORAW + 128 * MiB;
constexpr size_t WS_ACT = WS_YB + 64 * MiB;
constexpr size_t WS_YS = WS_ACT + 144 * MiB;
constexpr size_t WS_XG = WS_YS + 256 * MiB;
constexpr size_t WS_END = WS_XG + 1024 * MiB;
constexpr int CW_BAR = 4096;
constexpr int CW_CNT = 16384;

constexpr int PH_BYTES = 139264;
constexpr int TAB_OFF = PH_BYTES;
constexpr int MISC_OFF = TAB_OFF + 4096;
constexpr int LDS_BYTES = 147456;

__device__ __forceinline__ unsigned f2bf(float f) { unsigned u = __builtin_bit_cast(unsigned, f); return (u + 0x7fffu + ((u >> 16) & 1u)) >> 16; }
__device__ __forceinline__ unsigned pk2(float lo, float hi) { return f2bf(lo) | (f2bf(hi) << 16); }
__device__ __forceinline__ float bf2f(unsigned short b) { return __builtin_bit_cast(float, ((unsigned)b) << 16); }
__device__ __forceinline__ float bflo(unsigned w) { return __builtin_bit_cast(float, w << 16); }
__device__ __forceinline__ float bfhi(unsigned w) { return __builtin_bit_cast(float, w & 0xffff0000u); }
__device__ __forceinline__ int lane_id() { int l; asm volatile("v_mbcnt_lo_u32_b32 %0, -1, 0\n\tv_mbcnt_hi_u32_b32 %0, -1, %0" : "=v"(l)); return l; }
__device__ __forceinline__ float wave_sum(float v) {
#pragma unroll
    for (int o = 1; o < 64; o <<= 1) v += __shfl_xor(v, o);
    return v;
}
__device__ __forceinline__ float sigmoidf_(float x) { return 1.f / (1.f + __expf(-x)); }
__device__ __forceinline__ float log_sigmoidf_(float x) { return fminf(x, 0.f) - log1pf(__expf(-fabsf(x))); }
__device__ __forceinline__ float gelu_tanh(float x) { const float u = 0.7978845608028654f * (x + 0.044715f * x * x * x); return 0.5f * x * (1.f + tanhf(u)); }

namespace pg8 {
constexpr int BM = 256, BK = 64, HALF = 128, HTB = HALF * BK * 2, STAGE_BYTES = 8 * HTB, NXCD = 8, WGM = 8;
__host__ __device__ __forceinline__ int lds_byte(int r, int c) { const int st = (r >> 4) * 2 + (c >> 5), rr = r & 15, cc = c & 31, ob = rr * 64 + cc * 2; return st * 1024 + (ob ^ (((ob >> 9) & 1) << 5)); }
__host__ __device__ __forceinline__ void stage_rc(int b, int& R, int& C) { const int st = b / 1024, sb = b % 1024, swz = sb ^ (((sb >> 9) & 1) << 5); R = (st >> 1) * 16 + swz / 64; C = (st & 1) * 32 + (swz % 64) / 2; }
__host__ __device__ __forceinline__ int perm32(int rho) { const int n = rho >> 4, i = rho & 15; return 8 * (i >> 2) + 4 * n + (i & 3); }

struct Unit { const char* A; const char* B; int pm, pn, e, nvalid; };

__device__ __forceinline__ int xcd_remap(int L, int nwg) { const int q = nwg / NXCD, r = nwg % NXCD, xcd = L % NXCD, off = L / NXCD; return (xcd < r ? xcd * (q + 1) : r * (q + 1) + (xcd - r) * q) + off; }

struct DenseOrder {
    const char* A; const char* Bt; int K, nM, nN, nwg, G, c;
    __device__ __forceinline__ void init(const void* A_, const void* Bt_, int M_, int N_, int K_, int G_, int c_) { A = (const char*)A_; Bt = (const char*)Bt_; K = K_; nM = M_ / BM; nN = N_ / BM; nwg = nM * nN; G = G_; c = c_; }
    __device__ __forceinline__ bool next(int i, Unit& u) const {
        const long L = (long)i * G + c; if (L >= nwg) return false;
        const int wgid = xcd_remap((int)L, nwg);
        const int nig = WGM * nN, gid = wgid / nig, fm = gid * WGM, gsz = (nM - fm) < WGM ? (nM - fm) : WGM;
        u.pm = fm + ((wgid % nig) % gsz); u.pn = (wgid % nig) / gsz; u.e = 0; u.nvalid = 256;
        u.A = A + (size_t)u.pm * 256 * K * 2; u.B = Bt + (size_t)u.pn * 256 * K * 2; return true;
    }
};
struct MoeOrder {
    const char* A; const char* Bt; const LAS int* tab;
    int K, nN, ntiles, nwg, G, c; size_t b_estride; int a_compact;
    __device__ __forceinline__ bool next(int i, Unit& u) const {
        const long L = (long)i * G + c; if (L >= nwg) return false;
        const int wgid = xcd_remap((int)L, nwg);
        const int nig = WGM * nN, gid = wgid / nig, fm = gid * WGM, gsz = (ntiles - fm) < WGM ? (ntiles - fm) : WGM;
        const int tl = fm + ((wgid % nig) % gsz); u.pm = tl; u.pn = (wgid % nig) / gsz;
        const int e = __builtin_amdgcn_readfirstlane(tab[72 + tl]); u.e = e; const int r0 = (tl - __builtin_amdgcn_readfirstlane(tab[32 + e])) * 256; const int rem = __builtin_amdgcn_readfirstlane(tab[e]) - r0; u.nvalid = rem < 256 ? rem : 256;
        u.A = a_compact ? A + (size_t)tl * 256 * K * 2 : A + ((size_t)e * CAP + r0) * K * 2;
        u.B = Bt + (size_t)e * b_estride + (size_t)u.pn * 256 * K * 2; return true;
    }
};

__device__ __forceinline__ unsigned cvt_pk_bf16(float lo, float hi) { unsigned r; asm volatile("v_cvt_pk_bf16_f32 %0, %1, %2" : "=v"(r) : "v"(lo), "v"(hi)); return r; }

struct EpiBf16 {
    static constexpr bool PERM = true;
    bf16* O; int ldc;
    __device__ __forceinline__ void operator()(const f32x4 (&acc)[2][2][4][2], const Unit& u, int wr, int wc, int fr, int fq) const {
        const int row0 = u.pm * BM + wr * 64 + fr, col0 = u.pn * BM + wc * 32 + 8 * fq;
#pragma unroll
        for (int ai = 0; ai < 2; ++ai)
#pragma unroll
            for (int m = 0; m < 4; ++m) { bf16* rowp = O + (size_t)(row0 + ai * HALF + m * 16) * ldc + col0;
#pragma unroll
                for (int bj = 0; bj < 2; ++bj) { const f32x4 v0 = acc[ai][bj][m][0], v1 = acc[ai][bj][m][1];
                    u32x4 w; w.x = cvt_pk_bf16(v0[0], v0[1]); w.y = cvt_pk_bf16(v0[2], v0[3]); w.z = cvt_pk_bf16(v1[0], v1[1]); w.w = cvt_pk_bf16(v1[2], v1[3]);
                    *(u32x4*)(rowp + bj * HALF) = w; } }
    }
};
struct EpiResid {
    static constexpr bool PERM = false;
    const float* hin; float* Z;
    __device__ __forceinline__ void operator()(const f32x4 (&acc)[2][2][4][2], const Unit& u, int wr, int wc, int fr, int fq) const {
        const int row0 = u.pm * BM + wr * 64 + fr, col0 = u.pn * BM + wc * 32 + 4 * fq;
#pragma unroll
        for (int ai = 0; ai < 2; ++ai)
#pragma unroll
            for (int m = 0; m < 4; ++m) { const size_t off = (size_t)(row0 + ai * HALF + m * 16) * D + col0;
#pragma unroll
                for (int bj = 0; bj < 2; ++bj)
#pragma unroll
                    for (int n = 0; n < 2; ++n) { const f32x4 hv = *(const f32x4*)(hin + off + bj * HALF + n * 16); *(f32x4*)(Z + off + bj * HALF + n * 16) = hv * ALPHA + acc[ai][bj][m][n]; } }
    }
};
struct EpiGlu {
    static constexpr bool PERM = true;
    const bf16* Y; const float* bias; bf16* O;
    __device__ __forceinline__ void operator()(const f32x4 (&acc)[2][2][4][2], const Unit& u, int wr, int wc, int fr, int fq) const {
        const int row0 = u.pm * BM + wr * 64 + fr, col0 = u.pn * BM + wc * 32 + 8 * fq;
#pragma unroll
        for (int ai = 0; ai < 2; ++ai)
#pragma unroll
            for (int m = 0; m < 4; ++m) { const size_t off = (size_t)(row0 + ai * HALF + m * 16) * D + col0;
#pragma unroll
                for (int bj = 0; bj < 2; ++bj) {
                    const f32x4 b0 = *(const f32x4*)(bias + col0 + bj * HALF), b1 = *(const f32x4*)(bias + col0 + bj * HALF + 4);
                    const u32x4 yw = *(const u32x4*)(Y + off + bj * HALF);
                    const f32x4 v0 = acc[ai][bj][m][0] + b0, v1 = acc[ai][bj][m][1] + b1;
                    float o[8];
                    o[0] = bflo(yw.x) * sigmoidf_(v0[0]); o[1] = bfhi(yw.x) * sigmoidf_(v0[1]); o[2] = bflo(yw.y) * sigmoidf_(v0[2]); o[3] = bfhi(yw.y) * sigmoidf_(v0[3]);
                    o[4] = bflo(yw.z) * sigmoidf_(v1[0]); o[5] = bfhi(yw.z) * sigmoidf_(v1[1]); o[6] = bflo(yw.w) * sigmoidf_(v1[2]); o[7] = bfhi(yw.w) * sigmoidf_(v1[3]);
                    u32x4 w; w.x = cvt_pk_bf16(o[0], o[1]); w.y = cvt_pk_bf16(o[2], o[3]); w.z = cvt_pk_bf16(o[4], o[5]); w.w = cvt_pk_bf16(o[6], o[7]);
                    *(u32x4*)(O + off + bj * HALF) = w; } }
    }
};
struct EpiSwiglu {
    static constexpr bool PERM = true;
    bf16* ACT; const float* bgu;
    __device__ __forceinline__ void operator()(const f32x4 (&acc)[2][2][4][2], const Unit& u, int wr, int wc, int fr, int fq) const {
        const int row0 = u.pm * BM + wr * 64 + fr, j0 = u.pn * HALF + wc * 32 + 8 * fq;
        const float* bg = bgu + (size_t)u.e * 2 * DFF + j0;
        const f32x4 g0 = *(const f32x4*)(bg), g1 = *(const f32x4*)(bg + 4), u0 = *(const f32x4*)(bg + DFF), u1 = *(const f32x4*)(bg + DFF + 4);
#pragma unroll
        for (int ai = 0; ai < 2; ++ai)
#pragma unroll
            for (int m = 0; m < 4; ++m) {
                float o[8];
#pragma unroll
                for (int n = 0; n < 2; ++n)
#pragma unroll
                    for (int i = 0; i < 4; ++i) {
                        float g = acc[ai][0][m][n][i] + (n ? g1[i] : g0[i]), up = acc[ai][1][m][n][i] + (n ? u1[i] : u0[i]);
                        g = fminf(g, 7.0f); up = fminf(fmaxf(up, -7.0f), 7.0f);
                        o[n * 4 + i] = (up + 1.0f) * g * sigmoidf_(1.702f * g); }
                u32x4 w; w.x = cvt_pk_bf16(o[0], o[1]); w.y = cvt_pk_bf16(o[2], o[3]); w.z = cvt_pk_bf16(o[4], o[5]); w.w = cvt_pk_bf16(o[6], o[7]);
                *(u32x4*)(ACT + (size_t)(row0 + ai * HALF + m * 16) * DFF + j0) = w; }
    }
};
struct EpiMoeDown {
    static constexpr bool PERM = false;
    float* YS; const float* bd; const int* list; const float* gw; const LAS int* tab;
    __device__ __forceinline__ void operator()(const f32x4 (&acc)[2][2][4][2], const Unit& u, int wr, int wc, int fr, int fq) const {
        const int col0 = u.pn * BM + wc * 32 + 4 * fq; const int r0 = (u.pm - __builtin_amdgcn_readfirstlane(tab[32 + u.e])) * 256;
        const float* bp = bd + (size_t)u.e * D + col0;
        f32x4 bv[2][2];
#pragma unroll
        for (int bj = 0; bj < 2; ++bj)
#pragma unroll
            for (int n = 0; n < 2; ++n) bv[bj][n] = *(const f32x4*)(bp + bj * HALF + n * 16);
#pragma unroll
        for (int ai = 0; ai < 2; ++ai)
#pragma unroll
            for (int m = 0; m < 4; ++m) { const int r = ai * HALF + wr * 64 + m * 16 + fr;
                if (r < u.nvalid) { const int slot = list[(size_t)u.e * CAP + r0 + r]; const float g = gw[slot]; float* op = YS + (size_t)slot * D + col0;
#pragma unroll
                    for (int bj = 0; bj < 2; ++bj)
#pragma unroll
                        for (int n = 0; n < 2; ++n) *(f32x4*)(op + bj * HALF + n * 16) = (acc[ai][bj][m][n] + bv[bj][n]) * g; } }
    }
};

template <class Epi, class Sched, bool ALIGN_EPI, bool SP2>
__device__ __forceinline__ void gemm_phase(LAS unsigned char* lds, const int wid, const int K, const Sched& S, const Epi& E) {
    const int lane = lane_id(), tid = wid * 64 + lane, wr = wid >> 2, wc = wid & 3, fr = lane & 15, fq = lane >> 4;
    const int nt = K / BK;
    unsigned voffA[2], voffB[2];
#pragma unroll
    for (int i = 0; i < 2; ++i) { int R, C; stage_rc(tid * 16 + i * 8192, R, C); const int Rb = Epi::PERM ? ((R & ~31) + perm32(R & 31)) : R;
        voffA[i] = (unsigned)(R * K + C) * 2u; voffB[i] = (unsigned)(Rb * K + C) * 2u; }
    const size_t kstep = (size_t)(BK * 2);
    const size_t hstep = (size_t)HALF * K * 2;
    const unsigned ldsw = (unsigned)wid * 1024u;
    const int aoff = lds_byte(wr * 64 + fr, fq * 8), boff = lds_byte(wc * 32 + fr, fq * 8);
#define PG8_SA(b, h) (((b) * 2 + (h)) * HTB)
#define PG8_SB(b, h) ((4 + (b) * 2 + (h)) * HTB)
#define PG8_STAGE(bufoff, gbase, voff) do { _Pragma("unroll") for (int _i = 0; _i < 2; ++_i) \
        __builtin_amdgcn_global_load_lds((const unsigned*)((const char*)(gbase) + (voff)[_i]), (LAS unsigned*)(lds + (bufoff) + ldsw + _i * 8192), 16, 0, 0); } while (0)
#define PG8_LDA(dst, b, h) do { _Pragma("unroll") for (int m = 0; m < 4; ++m) _Pragma("unroll") for (int k = 0; k < 2; ++k) dst[m][k] = *(const LAS bf16x8*)(lds + PG8_SA(b, h) + aoff + m * 2048 + k * 1024); } while (0)
#define PG8_LDB(dst, b, h) do { _Pragma("unroll") for (int n = 0; n < 2; ++n) _Pragma("unroll") for (int k = 0; k < 2; ++k) dst[n][k] = *(const LAS bf16x8*)(lds + PG8_SB(b, h) + boff + n * 2048 + k * 1024); } while (0)
#define PG8_MMA(ai, bj, At, Bt) do { __builtin_amdgcn_s_setprio(1); _Pragma("unroll") for (int m = 0; m < 4; ++m) _Pragma("unroll") for (int n = 0; n < 2; ++n) _Pragma("unroll") for (int k = 0; k < 2; ++k) \
        acc[ai][bj][m][n] = __builtin_amdgcn_mfma_f32_16x16x32_bf16(Bt[n][k], At[m][k], acc[ai][bj][m][n], 0, 0, 0); __builtin_amdgcn_s_setprio(0); } while (0)
#define PG8_WAIT_V(n) asm volatile("s_waitcnt vmcnt(" #n ")" ::: "memory")
#define PG8_WAIT_L(n) asm volatile("s_waitcnt lgkmcnt(" #n ")" ::: "memory")
#define PG8_BAR __builtin_amdgcn_s_barrier()
#define PG8_SCHED __builtin_amdgcn_sched_barrier(0)
    Unit cur, nxt; int ui = 0;
    if (!S.next(0, cur)) return;
    f32x4 acc[2][2][4][2];
#pragma unroll
    for (int a = 0; a < 2; ++a)
#pragma unroll
        for (int b = 0; b < 2; ++b)
#pragma unroll
            for (int m = 0; m < 4; ++m)
#pragma unroll
                for (int n = 0; n < 2; ++n) acc[a][b][m][n] = (f32x4){0.f, 0.f, 0.f, 0.f};
    bf16x8 At[4][2], B0[2][2], B1[2][2];
    const char* cA = cur.A; const char* cB = cur.B;
    if constexpr (SP2) {
        PG8_STAGE(PG8_SB(0, 0), cB, voffB); PG8_STAGE(PG8_SB(0, 1), cB + hstep, voffB); PG8_STAGE(PG8_SA(0, 0), cA, voffA); PG8_STAGE(PG8_SA(0, 1), cA + hstep, voffA);
        if (wr == 1) PG8_BAR;
        PG8_WAIT_V(2); PG8_BAR;
        PG8_STAGE(PG8_SB(1, 0), cB + kstep, voffB); PG8_STAGE(PG8_SA(1, 0), cA + kstep, voffA); PG8_STAGE(PG8_SB(1, 1), cB + hstep + kstep, voffB);
        PG8_WAIT_V(6); PG8_BAR;
    } else {
        PG8_STAGE(PG8_SB(0, 0), cB, voffB); PG8_STAGE(PG8_SA(0, 0), cA, voffA); PG8_STAGE(PG8_SB(0, 1), cB + hstep, voffB); PG8_STAGE(PG8_SA(0, 1), cA + hstep, voffA);
        if (wr == 1) PG8_BAR;
        PG8_WAIT_V(4); PG8_BAR;
        PG8_STAGE(PG8_SB(1, 0), cB + kstep, voffB); PG8_STAGE(PG8_SA(1, 0), cA + kstep, voffA); PG8_STAGE(PG8_SB(1, 1), cB + hstep + kstep, voffB);
        PG8_WAIT_V(6); PG8_BAR;
    }
    for (;;) {
        const bool has_next = S.next(ui + 1, nxt);
        const char* nA = has_next ? nxt.A : cA; const char* nB = has_next ? nxt.B : cB;
        for (int t = 0; t < nt; t += 2) {
            const bool last = (t == nt - 2);
            const char* a1 = cA + (size_t)(t + 1) * kstep;
            const char* a2 = last ? nA : cA + (size_t)(t + 2) * kstep; const char* b2 = last ? nB : cB + (size_t)(t + 2) * kstep;
            const char* a3 = a2 + kstep; const char* b3 = b2 + kstep;
            if constexpr (SP2) {
            PG8_LDB(B0, 0, 0); PG8_LDB(B1, 0, 1); PG8_SCHED; PG8_LDA(At, 0, 0); PG8_STAGE(PG8_SA(1, 1), a1 + hstep, voffA);
            PG8_WAIT_V(8); PG8_WAIT_L(0); PG8_BAR; PG8_MMA(0, 0, At, B0); PG8_MMA(0, 1, At, B1); PG8_BAR; PG8_SCHED;
            PG8_LDA(At, 0, 1); PG8_STAGE(PG8_SB(0, 0), b2, voffB); PG8_STAGE(PG8_SB(0, 1), b2 + hstep, voffB); PG8_STAGE(PG8_SA(0, 0), a2, voffA);
            PG8_WAIT_V(8); PG8_WAIT_L(0); PG8_BAR; PG8_MMA(1, 0, At, B0); PG8_MMA(1, 1, At, B1); PG8_BAR; PG8_SCHED;
            PG8_LDB(B0, 1, 0); PG8_LDB(B1, 1, 1); PG8_SCHED; PG8_LDA(At, 1, 0); PG8_STAGE(PG8_SA(0, 1), a2 + hstep, voffA);
            PG8_WAIT_V(8); PG8_WAIT_L(0); PG8_BAR; PG8_MMA(0, 0, At, B0); PG8_MMA(0, 1, At, B1); PG8_BAR; PG8_SCHED;
            PG8_LDA(At, 1, 1); PG8_STAGE(PG8_SB(1, 0), b3, voffB); PG8_STAGE(PG8_SB(1, 1), b3 + hstep, voffB); PG8_STAGE(PG8_SA(1, 0), a3, voffA);
            PG8_WAIT_V(8); PG8_WAIT_L(0); PG8_BAR; PG8_MMA(1, 0, At, B0); PG8_MMA(1, 1, At, B1); PG8_BAR; PG8_SCHED;
            } else {
            PG8_LDB(B0, 0, 0); PG8_SCHED; PG8_LDA(At, 0, 0); PG8_STAGE(PG8_SA(1, 1), a1 + hstep, voffA);
            PG8_WAIT_L(8); PG8_BAR; PG8_WAIT_L(0); PG8_MMA(0, 0, At, B0); PG8_BAR; PG8_SCHED;
            PG8_LDB(B1, 0, 1); PG8_STAGE(PG8_SB(0, 0), b2, voffB);
            PG8_BAR; PG8_WAIT_L(0); PG8_MMA(0, 1, At, B1); PG8_BAR;
            PG8_LDA(At, 0, 1); PG8_STAGE(PG8_SA(0, 0), a2, voffA);
            PG8_BAR; PG8_WAIT_L(0); PG8_MMA(1, 0, At, B0); PG8_BAR; PG8_SCHED;
            PG8_STAGE(PG8_SB(0, 1), b2 + hstep, voffB);
            PG8_WAIT_V(6); PG8_BAR; PG8_MMA(1, 1, At, B1); PG8_BAR;
            PG8_LDB(B0, 1, 0); PG8_SCHED; PG8_LDA(At, 1, 0); PG8_STAGE(PG8_SA(0, 1), a2 + hstep, voffA);
            PG8_WAIT_L(8); PG8_BAR; PG8_WAIT_L(0); PG8_MMA(0, 0, At, B0); PG8_BAR; PG8_SCHED;
            PG8_LDB(B1, 1, 1); PG8_STAGE(PG8_SB(1, 0), b3, voffB);
            PG8_BAR; PG8_WAIT_L(0); PG8_MMA(0, 1, At, B1); PG8_BAR;
            PG8_LDA(At, 1, 1); PG8_STAGE(PG8_SA(1, 0), a3, voffA);
            PG8_BAR; PG8_WAIT_L(0); PG8_MMA(1, 0, At, B0); PG8_BAR; PG8_SCHED;
            PG8_STAGE(PG8_SB(1, 1), b3 + hstep, voffB);
            PG8_WAIT_V(6); PG8_BAR; PG8_MMA(1, 1, At, B1); PG8_BAR;
            }
        }
        if constexpr (ALIGN_EPI) { if (wr == 0) PG8_BAR; }
        E(acc, cur, wr, wc, fr, fq);
        if (!has_next) break;
#pragma unroll
        for (int a = 0; a < 2; ++a)
#pragma unroll
            for (int b = 0; b < 2; ++b)
#pragma unroll
                for (int m = 0; m < 4; ++m)
#pragma unroll
                    for (int n = 0; n < 2; ++n) acc[a][b][m][n] = (f32x4){0.f, 0.f, 0.f, 0.f};
        cur = nxt; cA = nA; cB = nB; ++ui;
        if constexpr (ALIGN_EPI) { if (wr == 1) PG8_BAR; }
    }
    PG8_WAIT_V(0);
    if constexpr (!ALIGN_EPI) { if (wr == 0) PG8_BAR; }
    PG8_BAR;
#undef PG8_SA
#undef PG8_SB
#undef PG8_STAGE
#undef PG8_LDA
#undef PG8_LDB
#undef PG8_MMA
#undef PG8_WAIT_V
#undef PG8_WAIT_L
#undef PG8_BAR
#undef PG8_SCHED
}
}

#define XB_TMO      128
#define XB_XCNT(j)  (256  + 64 * (j))
#define XB_XSUB(j)  (1280 + 64 * (j))
#define XB_XGEN(j)  (2304 + 64 * (j))
#define XB_TOP      3328
#define XB_TOPGEN   3392
#define XCD_BAR_WORDS 3456
#define XB_SPIN_CAP (1u << 18)
__device__ __forceinline__ unsigned xb_ld(unsigned* p)              { return __hip_atomic_load(p, __ATOMIC_RELAXED, __HIP_MEMORY_SCOPE_AGENT); }
__device__ __forceinline__ unsigned xb_add(unsigned* p, unsigned v) { return __hip_atomic_fetch_add(p, v, __ATOMIC_RELAXED, __HIP_MEMORY_SCOPE_AGENT); }
__device__ __forceinline__ unsigned xb_xcc_id() { return (unsigned)__builtin_amdgcn_s_getreg((3 << 11) | 20) & 0xFu; }
#define XB_SPIN(cond, bar) do { unsigned _sp = 0; while (cond) { __builtin_amdgcn_s_sleep(1); \
    if ((++_sp & 255u) == 0u) { if (xb_ld(&(bar)[XB_TMO])) break; if (_sp > XB_SPIN_CAP) { atomicAdd(&(bar)[XB_TMO], 1u); break; } } } } while (0)
struct XcdBarrier { unsigned* bar; unsigned x; volatile LAS unsigned* st; };
__device__ __forceinline__ XcdBarrier xcd_barrier_post(unsigned* bar, volatile LAS unsigned* st, bool leader) {
    XcdBarrier b; b.bar = bar; b.x = xb_xcc_id(); b.st = st;
    if (leader) (void)xb_add(&bar[XB_XCNT(b.x)], 1u);
    return b;
}
__device__ __forceinline__ void xcd_barrier_complete(unsigned* bar, unsigned x, unsigned& nloc, unsigned& nx) {
    const unsigned G = gridDim.x * gridDim.y * gridDim.z;
    unsigned sum, cnt, mine, sp = 0u;
    for (;;) {
        sum = 0u; cnt = 0u; mine = 0u;
#pragma unroll
        for (unsigned j = 0; j < 16; ++j) { const unsigned c = xb_ld(&bar[XB_XCNT(j)]); sum += c; cnt += (c > 0u) ? 1u : 0u; mine = (j == x) ? c : mine; }
        if (sum == G) break;
        __builtin_amdgcn_s_sleep(1);
        if ((++sp & 255u) == 0u) { if (xb_ld(&bar[XB_TMO])) break; if (sp > XB_SPIN_CAP) { atomicAdd(&bar[XB_TMO], 1u); break; } }
    }
    nloc = mine > 0u ? mine : 1u; nx = cnt > 0u ? cnt : 1u;
}
__device__ __forceinline__ void xcd_barrier(const XcdBarrier& b, int wave) {
    asm volatile("s_waitcnt vmcnt(0)" ::: "memory");
    __syncthreads();
    if (wave == 0 && lane_id() == 0) {
        unsigned* bar = b.bar;
        __builtin_amdgcn_s_waitcnt(0);
        unsigned nloc = b.st[0], nx = b.st[1];
        if (nloc == 0u) { xcd_barrier_complete(bar, b.x, nloc, nx); b.st[0] = nloc; b.st[1] = nx; }
        const unsigned old = xb_add(&bar[XB_XSUB(b.x)], 1u);
        const unsigned gen = old / nloc;
        if (old + 1u == (gen + 1u) * nloc) {
            __builtin_amdgcn_fence(__ATOMIC_RELEASE, "agent");
            asm volatile("s_waitcnt vmcnt(0)" ::: "memory");
            const unsigned og = xb_add(&bar[XB_TOP], 1u);
            const unsigned tg = og / nx;
            if (og + 1u == (tg + 1u) * nx) xb_add(&bar[XB_TOPGEN], 1u);
            else XB_SPIN(xb_ld(&bar[XB_TOPGEN]) == tg, bar);
            __builtin_amdgcn_fence(__ATOMIC_ACQUIRE, "agent");
            xb_add(&bar[XB_XGEN(b.x)], 1u);
            asm volatile("s_waitcnt vmcnt(0)" ::: "memory");
        } else {
            XB_SPIN(xb_ld(&bar[XB_XGEN(b.x)]) == gen, bar);
            __builtin_amdgcn_fence(__ATOMIC_ACQUIRE, "agent");
            asm volatile("s_waitcnt vmcnt(0)" ::: "memory");
        }
    }
    __syncthreads();
}

struct Args { const float* in[33]; float* out; unsigned char* ws; int ph_lo, ph_hi; };
struct Frame {
    LAS unsigned char* lds;
    int wave, vcu, G, gw, NGW;
};

__device__ __forceinline__ void transpose_item(const float* W, int ldw, int col_off, int K, bf16* WT, int mode, int kb, int nb, LAS unsigned char* scr, int lane) {
    const int k0 = 64 * kb, n0 = 64 * nb;
    const float* src = W + (size_t)k0 * ldw + col_off + n0;
    f32x4 v[16];
#pragma unroll
    for (int i = 0; i < 16; ++i) v[i] = *(const f32x4*)(src + (size_t)((lane >> 4) + 4 * i) * ldw + 4 * (lane & 15));
#pragma unroll
    for (int i = 0; i < 16; ++i) { LAS unsigned* p = (LAS unsigned*)(scr + ((lane >> 4) + 4 * i) * 132 + 8 * (lane & 15)); p[0] = pk2(v[i][0], v[i][1]); p[1] = pk2(v[i][2], v[i][3]); }
    asm volatile("s_waitcnt lgkmcnt(0)" ::: "memory");
    const int c = lane >> 3, nl = lane & 7;
#pragma unroll
    for (int r = 0; r < 8; ++r) { const int n = nl + 8 * r; const LAS unsigned short* s = (const LAS unsigned short*)(scr + (8 * c) * 132 + 2 * n);
        u32x4 o; o.x = (unsigned)s[0] | ((unsigned)s[66] << 16); o.y = (unsigned)s[132] | ((unsigned)s[198] << 16); o.z = (unsigned)s[264] | ((unsigned)s[330] << 16); o.w = (unsigned)s[396] | ((unsigned)s[462] << 16);
        const int ng = n0 + n; int drow = ng; if (mode == 1) { drow = ng < 1024 ? 256 * (ng >> 7) + (ng & 127) : 256 * ((ng - 1024) >> 7) + 128 + (ng & 127); }
        *(u32x4*)(WT + (size_t)drow * K + k0 + 8 * c) = o; }
    asm volatile("s_waitcnt lgkmcnt(0)" ::: "memory");
}

__device__ __forceinline__ void load_cols16(int tid, const float* W, int ldw, int col_off, LAS float* Wt) {
    for (int i = tid; i < 1024 * 16; i += NTHREADS) { const int e = i & 15, k = i >> 4; Wt[e * 1028 + k] = W[(size_t)k * ldw + col_off + e]; }
}
__device__ __forceinline__ void row_dot16(const f32x4 (&v)[4], const LAS float* Wt, int lane, float (&out)[16]) {
#pragma unroll
    for (int e = 0; e < 16; ++e) { float s = 0.f;
#pragma unroll
        for (int j = 0; j < 4; ++j) { const f32x4 w = *(const LAS f32x4*)(Wt + e * 1028 + 4 * (lane + 64 * j)); s += v[j][0] * w[0] + v[j][1] * w[1] + v[j][2] * w[2] + v[j][3] * w[3]; }
        out[e] = wave_sum(s); }
}
__device__ __forceinline__ void store_row_bf16(bf16* orow, const f32x4 (&v)[4], int lane) {
    unsigned long long* o8 = (unsigned long long*)orow + lane;
#pragma unroll
    for (int j = 0; j < 4; ++j) o8[64 * j] = (unsigned long long)pk2(v[j][0], v[j][1]) | ((unsigned long long)pk2(v[j][2], v[j][3]) << 32);
}
__device__ __forceinline__ void store_row_f32(float* orow, const f32x4 (&v)[4], int lane) {
    f32x4* o = (f32x4*)orow + lane;
#pragma unroll
    for (int j = 0; j < 4; ++j) o[64 * j] = v[j];
}
__device__ __forceinline__ void load_row_f32(const float* row, f32x4 (&v)[4], int lane) {
    const f32x4* p = (const f32x4*)row + lane;
#pragma unroll
    for (int j = 0; j < 4; ++j) v[j] = p[64 * j];
}
__device__ __forceinline__ void ln_row(f32x4 (&v)[4], const f32x4 (&gv)[4], const f32x4 (&bv)[4]) {
    float s = 0.f;
#pragma unroll
    for (int j = 0; j < 4; ++j) s += (v[j][0] + v[j][1]) + (v[j][2] + v[j][3]);
    const float mean = wave_sum(s) * (1.f / D); float s2 = 0.f;
#pragma unroll
    for (int j = 0; j < 4; ++j) { v[j] = v[j] - mean; s2 += (v[j][0] * v[j][0] + v[j][1] * v[j][1]) + (v[j][2] * v[j][2] + v[j][3] * v[j][3]); }
    const float rstd = 1.f / sqrtf(wave_sum(s2) * (1.f / D) + LN_EPS);
#pragma unroll
    for (int j = 0; j < 4; ++j) v[j] = v[j] * rstd * gv[j] + bv[j];
}

__device__ __forceinline__ const float* inp_ptr(LAS unsigned char* lds, int i) {
    const LAS unsigned* p = (const LAS unsigned*)(lds + MISC_OFF + 256) + 2 * i;
    const unsigned lo = __builtin_amdgcn_readfirstlane(p[0]), hi = __builtin_amdgcn_readfirstlane(p[1]);
    return (const float*)(const GAS float*)(((unsigned long long)hi << 32) | lo);
}

#define IN(k) (lo <= (k) && (k) < hi)
#define SEAM(k) do { if ((k) + 1 < hi) xcd_barrier(bar, F.wave); } while (0)
#define INP(i) inp_ptr(F.lds, (i))
#define x_in INP(0)
#define ln_g INP(1)
#define ln_b INP(2)
#define WS_PTRS \
    float* HF = (float*)(ws + WS_HF); bf16* XB = (bf16*)(ws + WS_XB); float* ZF = (float*)(ws + WS_ZF); bf16* PB = (bf16*)(ws + WS_PB); \
    float* GB = (float*)(ws + WS_GB); float* LA = (float*)(ws + WS_LA); float* ORAW = (float*)(ws + WS_ORAW); bf16* YB = (bf16*)(ws + WS_YB); \
    bf16* ACT = (bf16*)(ws + WS_ACT); float* YS = (float*)(ws + WS_YS); bf16* XG = (bf16*)(ws + WS_XG); \
    int* LIST = (int*)(ws + WS_LIST); float* GW = (float*)(ws + WS_GW); \
    float* S5LB = (float*)(ws + WS_S5TAB); float* S5BB = (float*)(ws + WS_S5TAB + 32768); \
    (void)HF; (void)XB; (void)ZF; (void)PB; (void)GB; (void)LA; (void)ORAW; (void)YB; (void)ACT; (void)YS; (void)XG; (void)LIST; (void)GW; (void)S5LB; (void)S5BB;

template <int layer>
__device__ __forceinline__ void layer_body(const Frame& F, unsigned char* ws, unsigned* ctl, LAS int* TAB, const XcdBarrier& bar, const int lo, const int hi, float* d_out) {
    WS_PTRS
        const int pb = 1 + layer * 12;
        const float* hin = (layer == 0) ? x_in : HF;
        if (PHE(1) && IN(pb + 0)) {
            const bf16* Wt = (const bf16*)(ws + (layer == 0 ? WS_WT_ML_IN : layer == 1 ? WS_WT_RET_IN : layer == 2 ? WS_WT_GLA_IN : WS_WT_S5_IN));
            const int N = (layer == 0 || layer == 2) ? 3072 : (layer == 1 ? 6144 : 1024);
            pg8::DenseOrder S; S.init(XB, Wt, M, N, D, F.G, (int)blockIdx.x);
            pg8::EpiBf16 E{PB, N};
            pg8::gemm_phase<pg8::EpiBf16, pg8::DenseOrder, true, true>(F.lds, F.wave, D, S, E);
            SEAM(pb + 0);
        }
        if (layer == 0) {
            if (IN(pb + 2) && !defined_SKIP_ML) { const int lane = lane_id(), tid = F.wave * 64 + lane; (void)tid;
                if (F.gw < 32) {
                    const int b = F.gw >> 4, h = (F.gw >> 1) & 7, eh = F.gw & 1, e = eh * 64 + lane;
                    float C[64];
#pragma unroll
                    for (int d = 0; d < 64; ++d) C[d] = 0.f;
                    float nl = 0.f, mst = -1e30f;
                    const bf16* prow = PB + (size_t)(b * T) * 3072;
                    const float* grow = GB + (size_t)(b * T) * 16;
                    for (int t = 0; t < T; ++t) {
                        const bf16* pr = prow + (size_t)t * 3072;
                        const float ql = bf2f(pr[h * 64 + lane]) * 0.125f, kl = bf2f(pr[512 + h * 64 + lane]), vv = bf2f(pr[1024 + h * 128 + e]);
                        const float ip = grow[t * 16 + h], fp = grow[t * 16 + 8 + h];
                        const float lf = log_sigmoidf_(fp);
                        const float mnew = fmaxf(lf + mst, ip);
                        const float fs = __expf(lf + mst - mnew), is = __expf(ip - mnew);
                        mst = mnew;
                        nl = fs * nl + is * kl;
                        const float den = wave_sum(nl * ql);
                        const float kv = is * vv; float num = 0.f;
#pragma unroll
                        for (int d = 0; d < 64; ++d) { const float kd = __builtin_bit_cast(float, __builtin_amdgcn_readlane(__builtin_bit_cast(int, kl), d)), qd = __builtin_bit_cast(float, __builtin_amdgcn_readlane(__builtin_bit_cast(int, ql), d));
                            C[d] = fs * C[d] + kv * kd; num += C[d] * qd; }
                        ORAW[(size_t)(b * T + t) * 1024 + h * 128 + e] = num / fmaxf(fabsf(den), __expf(-mnew));
                    }
                }
                SEAM(pb + 2);
            }
        } else if (layer == 1) {
            if (IN(pb + 1)) { const int lane = lane_id(), tid = F.wave * 64 + lane; (void)tid;
                for (int it = blockIdx.x * NTHREADS + tid; it < T * 64; it += F.G * NTHREADS) {
                    const int t = it >> 6, i = it & 63;
                    const float inv = exp2f(-(float)(2 * i) * (13.287712379549449f / 128.f));
                    float sn, cs; sincosf((float)t * inv, &sn, &cs);
                    for (int b = 0; b < 2; ++b) { bf16* pr = PB + (size_t)(b * T + t) * 6144;
                        for (int qk = 0; qk < 2; ++qk) { const float sc = qk ? 0.08838834764831845f : 1.f;
                            for (int h = 0; h < 8; ++h) { bf16* p = pr + qk * 1024 + h * 128 + i; const float t1 = bf2f(p[0]), t2 = bf2f(p[64]);
                                p[0] = (bf16)f2bf((t1 * cs - t2 * sn) * sc); p[64] = (bf16)f2bf((t1 * sn + t2 * cs) * sc); } } }
                }
                SEAM(pb + 1);
            }
            if (IN(pb + 2) && !defined_SKIP_RET) { const int lane = lane_id(), tid = F.wave * 64 + lane; (void)tid;
                if (F.gw < 64) {
                    const int b = F.gw >> 5, h = (F.gw >> 2) & 7, e = (F.gw & 3) * 64 + lane;
                    const float gamma = 1.f - exp2f(-5.f - (float)h);
                    float S[128];
#pragma unroll
                    for (int d = 0; d < 128; ++d) S[d] = 0.f;
                    const bf16* prow = PB + (size_t)(b * T) * 6144;
                    for (int t = 0; t < T; ++t) {
                        const bf16* pr = prow + (size_t)t * 6144;
                        const float q0 = bf2f(pr[h * 128 + lane]), q1 = bf2f(pr[h * 128 + 64 + lane]), k0 = bf2f(pr[1024 + h * 128 + lane]), k1 = bf2f(pr[1024 + h * 128 + 64 + lane]);
                        const float vv = bf2f(pr[2048 + h * 256 + e]);
                        float o = 0.f;
#pragma unroll
                        for (int d = 0; d < 64; ++d) {
                            const float kd = __builtin_bit_cast(float, __builtin_amdgcn_readlane(__builtin_bit_cast(int, k0), d)), qd = __builtin_bit_cast(float, __builtin_amdgcn_readlane(__builtin_bit_cast(int, q0), d));
                            S[d] = gamma * S[d] + kd * vv; o += qd * S[d];
                            const float kd1 = __builtin_bit_cast(float, __builtin_amdgcn_readlane(__builtin_bit_cast(int, k1), d)), qd1 = __builtin_bit_cast(float, __builtin_amdgcn_readlane(__builtin_bit_cast(int, q1), d));
                            S[64 + d] = gamma * S[64 + d] + kd1 * vv; o += qd1 * S[64 + d]; }
                        ORAW[(size_t)(b * T + t) * 2048 + h * 256 + e] = o;
                    }
                }
                SEAM(pb + 2);
            }
        } else if (layer == 2) {
            if (IN(pb + 2) && !defined_SKIP_GLA) { const int lane = lane_id(), tid = F.wave * 64 + lane; (void)tid;
                if (F.gw < 32) {
                    const int b = F.gw >> 4, h = (F.gw >> 2) & 3, e = (F.gw & 3) * 64 + lane;
                    float S[128];
#pragma unroll
                    for (int d = 0; d < 128; ++d) S[d] = 0.f;
                    const bf16* prow = PB + (size_t)(b * T) * 3072;
                    const float* larow = LA + (size_t)(b * T) * 512;
                    for (int t = 0; t < T; ++t) {
                        const bf16* pr = prow + (size_t)t * 3072;
                        const float q0 = bf2f(pr[h * 128 + lane]), q1 = bf2f(pr[h * 128 + 64 + lane]);
                        const float k0 = bf2f(pr[512 + h * 128 + lane]) * 0.08838834764831845f, k1 = bf2f(pr[512 + h * 128 + 64 + lane]) * 0.08838834764831845f;
                        const float a0 = __expf(larow[(size_t)t * 512 + h * 128 + lane]), a1 = __expf(larow[(size_t)t * 512 + h * 128 + 64 + lane]);
                        const float vv = bf2f(pr[1024 + h * 256 + e]);
                        float o = 0.f;
#pragma unroll
                        for (int d = 0; d < 64; ++d) {
                            const float kd = __builtin_bit_cast(float, __builtin_amdgcn_readlane(__builtin_bit_cast(int, k0), d)), qd = __builtin_bit_cast(float, __builtin_amdgcn_readlane(__builtin_bit_cast(int, q0), d)), ad = __builtin_bit_cast(float, __builtin_amdgcn_readlane(__builtin_bit_cast(int, a0), d));
                            S[d] = ad * S[d] + kd * vv; o += qd * S[d];
                            const float kd1 = __builtin_bit_cast(float, __builtin_amdgcn_readlane(__builtin_bit_cast(int, k1), d)), qd1 = __builtin_bit_cast(float, __builtin_amdgcn_readlane(__builtin_bit_cast(int, q1), d)), ad1 = __builtin_bit_cast(float, __builtin_amdgcn_readlane(__builtin_bit_cast(int, a1), d));
                            S[64 + d] = ad1 * S[64 + d] + kd1 * vv; o += qd1 * S[64 + d]; }
                        ORAW[(size_t)(b * T + t) * 1024 + h * 256 + e] = o;
                    }
                }
                SEAM(pb + 2);
            }
        } else {
            if (IN(pb + 2) && !defined_SKIP_S5) { const int lane = lane_id(), tid = F.wave * 64 + lane; (void)tid;
                if (F.gw < 128) {
                    const int b = F.gw >> 6, g = F.gw & 63, p = lane;
                    const float* c_re = INP(20); const float* c_im = INP(21); const float* dsk = INP(22);
                    const float lbr = S5LB[(g * 64 + p) * 2], lbi = S5LB[(g * 64 + p) * 2 + 1];
                    float bbr[16], bbi[16], cr[16], ci[16];
#pragma unroll
                    for (int h = 0; h < 16; ++h) { bbr[h] = S5BB[((g * 64 + p) * 16 + h) * 2]; bbi[h] = S5BB[((g * 64 + p) * 16 + h) * 2 + 1]; cr[h] = c_re[(g * 16 + h) * 64 + p]; ci[h] = c_im[(g * 16 + h) * 64 + p]; }
                    const float dl = (lane < 16) ? dsk[g * 16 + lane] : 0.f;
                    float sr = 0.f, si = 0.f;
                    for (int t = 0; t < T; ++t) {
                        const size_t row = (size_t)(b * T + t);
                        const float ul = (lane < 16) ? bf2f(PB[row * 1024 + g * 16 + lane]) : 0.f;
                        float bur = 0.f, bui = 0.f;
#pragma unroll
                        for (int h = 0; h < 16; ++h) { const float uh = __builtin_bit_cast(float, __builtin_amdgcn_readlane(__builtin_bit_cast(int, ul), h)); bur += bbr[h] * uh; bui += bbi[h] * uh; }
                        const float nr = lbr * sr - lbi * si + bur, ni = lbr * si + lbi * sr + bui; sr = nr; si = ni;
                        float yl = 0.f;
#pragma unroll
                        for (int h = 0; h < 16; ++h) { const float yv = wave_sum(cr[h] * sr - ci[h] * si); yl = (lane == h) ? yv : yl; }
                        if (lane < 16) { const float y = yl + dl * ul; YB[row * 1024 + g * 16 + lane] = (bf16)f2bf(gelu_tanh(y)); }
                    }
                }
                SEAM(pb + 2);
            }
        }
        if (PHE(3) && layer < 3 && IN(pb + 3)) { const int lane = lane_id(), tid = F.wave * 64 + lane; (void)tid;
            const int nh = (layer == 2) ? 4 : 8, dv = (layer == 0) ? 128 : 256, DV = nh * dv, ldp = (layer == 1) ? 6144 : 3072, goff = (layer == 1) ? 4096 : 2048;
            const float* ng = INP(layer == 0 ? 5 : layer == 1 ? 8 : 13);
            for (int it = F.gw; it < M * nh; it += F.NGW) {
                const int row = it / nh, h = it - row * nh;
                const float* src = ORAW + (size_t)row * DV + h * dv;
                float xv[4]; const int per = dv / 64;
                float s = 0.f;
#pragma unroll
                for (int j = 0; j < 4; ++j) { xv[j] = (j < per) ? src[lane + 64 * j] : 0.f; s += xv[j]; }
                const float mean = wave_sum(s) / (float)dv; float s2 = 0.f;
#pragma unroll
                for (int j = 0; j < 4; ++j) { const float dlt = (j < per) ? xv[j] - mean : 0.f; s2 += dlt * dlt; }
                const float rstd = 1.f / sqrtf(wave_sum(s2) / (float)dv + LN_EPS);
#pragma unroll
                for (int j = 0; j < 4; ++j) if (j < per) { const int c = h * dv + lane + 64 * j; const float gt = bf2f(PB[(size_t)row * ldp + goff + c]);
                    const float gate = (layer == 0) ? sigmoidf_(gt) : gt * sigmoidf_(gt);
                    YB[(size_t)row * DV + c] = (bf16)f2bf(gate * (xv[j] - mean) * rstd * ng[c]); }
            }
            SEAM(pb + 3);
        }
        if (PHE(4) && layer == 3 && IN(pb + 4)) {
            pg8::DenseOrder S; S.init(YB, ws + WS_WT_S5_GLU, M, D, D, F.G, (int)blockIdx.x);
            pg8::EpiGlu E{YB, INP(25), (bf16*)ORAW};
            pg8::gemm_phase<pg8::EpiGlu, pg8::DenseOrder, true, true>(F.lds, F.wave, D, S, E);
            SEAM(pb + 4);
        }
        if (PHE(5) && IN(pb + 5)) {
            const bf16* Wt = (const bf16*)(ws + (layer == 0 ? WS_WT_ML_OUT : layer == 1 ? WS_WT_RET_OUT : layer == 2 ? WS_WT_GLA_OUT : WS_WT_S5_OUT));
            const int Kd = (layer == 1) ? 2048 : 1024;
            const bf16* Ain = (layer == 3) ? (const bf16*)ORAW : YB;
            pg8::DenseOrder S; S.init(Ain, Wt, M, D, Kd, F.G, (int)blockIdx.x);
            pg8::EpiResid E{hin, ZF};
            pg8::gemm_phase<pg8::EpiResid, pg8::DenseOrder, true, true>(F.lds, F.wave, Kd, S, E);
            SEAM(pb + 5);
        }
        unsigned* cnt = ctl + CW_CNT + layer * 32 * 64;
        if (IN(pb + 6) && !defined_SKIP_LN1) { const int lane = lane_id(), tid = F.wave * 64 + lane; (void)tid;
            LAS float* Wt = (LAS float*)(F.lds);
            { const float* wr_ = INP(27) + (size_t)layer * D * NEXP;
              for (int i = tid; i < D * NEXP; i += NTHREADS) { const int e = i & 31, k = i >> 5; Wt[e * 1028 + k] = wr_[i]; } }
            __syncthreads();
            const float* br_ = INP(28) + layer * NEXP;
            const float* lng_ = ln_g + (size_t)(layer * 2 + 0) * D; const float* lnb_ = ln_b + (size_t)(layer * 2 + 0) * D;
            for (int row = F.gw; row < M; row += F.NGW) {
                asm volatile("" ::: "memory");
                f32x4 v[4]; load_row_f32(ZF + (size_t)row * D, v, lane);
                { f32x4 gv[4], bv[4]; load_row_f32(lng_, gv, lane); load_row_f32(lnb_, bv, lane); ln_row(v, gv, bv); }
                store_row_f32(HF + (size_t)row * D, v, lane);
                store_row_bf16(XB + (size_t)row * D, v, lane);
                float lg[32];
#pragma unroll
                for (int e = 0; e < 32; ++e) { float s = 0.f;
#pragma unroll
                    for (int j = 0; j < 4; ++j) { const f32x4 w = *(const LAS f32x4*)(Wt + e * 1028 + 4 * (lane + 64 * j)); s += v[j][0] * w[0] + v[j][1] * w[1] + v[j][2] * w[2] + v[j][3] * w[3]; }
                    lg[e] = wave_sum(s) + br_[e]; }
                int te[4]; float tv[4];
#pragma unroll
                for (int k = 0; k < 4; ++k) { float best = -3.0e38f; int bi = 0;
#pragma unroll
                    for (int e = 0; e < 32; ++e) { const bool taken = (k > 0 && te[0] == e) || (k > 1 && te[1] == e) || (k > 2 && te[2] == e); if (!taken && lg[e] > best) { best = lg[e]; bi = e; } }
                    te[k] = bi; tv[k] = best; }
                const float e0 = 1.f, e1 = __expf(tv[1] - tv[0]), e2 = __expf(tv[2] - tv[0]), e3 = __expf(tv[3] - tv[0]), rs = 1.f / (e0 + e1 + e2 + e3);
                int pos = 0;
                if (lane < 4) { const int ek = lane == 0 ? te[0] : lane == 1 ? te[1] : lane == 2 ? te[2] : te[3]; const float gk = (lane == 0 ? e0 : lane == 1 ? e1 : lane == 2 ? e2 : e3) * rs;
                    pos = (int)__hip_atomic_fetch_add(cnt + ek * 64, 1u, __ATOMIC_RELAXED, __HIP_MEMORY_SCOPE_AGENT);
                    LIST[(size_t)ek * CAP + pos] = row * 4 + lane; GW[row * 4 + lane] = gk; }
#pragma unroll
                for (int k = 0; k < 4; ++k) { const int pk = __shfl(pos, k); store_row_bf16(XG + ((size_t)te[k] * CAP + pk) * D, v, lane); }
            }
            __syncthreads();
            SEAM(pb + 6);
        }
        if ((PHE(7) || PHE(8)) && (IN(pb + 7) || IN(pb + 8))) { const int lane = lane_id(), tid = F.wave * 64 + lane; (void)tid;
            __syncthreads();
            if (tid < 32) TAB[tid] = (int)__hip_atomic_load(cnt + tid * 64, __ATOMIC_RELAXED, __HIP_MEMORY_SCOPE_AGENT);
            __syncthreads();
            if (tid == 0) { int acc = 0; for (int e = 0; e < 32; ++e) { TAB[32 + e] = acc; const int nt_ = (TAB[e] + 255) >> 8; for (int j = 0; j < nt_; ++j) TAB[72 + acc + j] = e; acc += nt_; } TAB[64] = acc; }
            __syncthreads();
        }
        if (PHE(7) && IN(pb + 7)) {
            pg8::MoeOrder S; S.A = (const char*)XG; S.Bt = (const char*)(ws + WS_WT_GU + (size_t)layer * 32 * 2048 * 1024 * 2); S.tab = TAB; S.K = D; S.nN = 8; S.ntiles = __builtin_amdgcn_readfirstlane(TAB[64]); S.nwg = S.ntiles * 8; S.G = F.G; S.c = (int)blockIdx.x;
            S.b_estride = (size_t)2048 * 1024 * 2; S.a_compact = 0;
            pg8::EpiSwiglu E{ACT, INP(30) + (size_t)layer * 32 * 2048};
            pg8::gemm_phase<pg8::EpiSwiglu, pg8::MoeOrder, true, true>(F.lds, F.wave, D, S, E);
            SEAM(pb + 7);
        }
        if (PHE(8) && IN(pb + 8)) {
            pg8::MoeOrder S; S.A = (const char*)ACT; S.Bt = (const char*)(ws + WS_WT_DN + (size_t)layer * 32 * 1024 * 1024 * 2); S.tab = TAB; S.K = DFF; S.nN = 4; S.ntiles = __builtin_amdgcn_readfirstlane(TAB[64]); S.nwg = S.ntiles * 4; S.G = F.G; S.c = (int)blockIdx.x;
            S.b_estride = (size_t)1024 * 1024 * 2; S.a_compact = 1;
            pg8::EpiMoeDown E{YS, INP(32) + (size_t)layer * 32 * 1024, LIST, GW, TAB};
            pg8::gemm_phase<pg8::EpiMoeDown, pg8::MoeOrder, true, true>(F.lds, F.wave, DFF, S, E);
            SEAM(pb + 8);
        }
        if (PHE(9) && IN(pb + 9)) { const int lane = lane_id(), tid = F.wave * 64 + lane; (void)tid;
            LAS float* Wt = (LAS float*)(F.lds);
            if (layer == 1) { load_cols16(tid, INP(10), 3088, 3072, Wt); __syncthreads(); }
            const float* lng_ = ln_g + (size_t)(layer * 2 + 1) * D; const float* lnb_ = ln_b + (size_t)(layer * 2 + 1) * D;
            float* outp = (layer == 3) ? d_out : HF;
            for (int row = F.gw; row < M; row += F.NGW) {
                asm volatile("" ::: "memory");
                f32x4 v[4], y[4]; load_row_f32(HF + (size_t)row * D, v, lane);
#pragma unroll
                for (int j = 0; j < 4; ++j) v[j] = v[j] * ALPHA;
#pragma unroll
                for (int k = 0; k < 4; ++k) { load_row_f32(YS + ((size_t)row * 4 + k) * D, y, lane);
#pragma unroll
                    for (int j = 0; j < 4; ++j) v[j] = v[j] + y[j]; }
                { f32x4 gv[4], bv[4]; load_row_f32(lng_, gv, lane); load_row_f32(lnb_, bv, lane); ln_row(v, gv, bv); }
                store_row_f32(outp + (size_t)row * D, v, lane);
                if (layer < 3) store_row_bf16(XB + (size_t)row * D, v, lane);
                if (layer == 1) {
                    float z[16]; row_dot16(v, Wt, lane, z);
                    if (lane < 16) { float o = 0.f;
#pragma unroll
                        for (int e = 0; e < 16; ++e) o = (lane == e) ? z[e] : o;
                        GB[(size_t)row * 16 + lane] = o; }
                }
            }
            if (layer == 1) {
                __syncthreads();
                const float* wgp = INP(11); const float bgc = INP(12)[tid];
                float wg[16];
#pragma unroll
                for (int r = 0; r < 16; ++r) wg[r] = wgp[r * 512 + tid];
                for (int row = F.vcu * NWAVES; row < M; row += F.NGW) {
#pragma unroll 1
                    for (int w = 0; w < NWAVES; ++w) { const float* zr = GB + (size_t)(row + w) * 16; float sacc = bgc;
#pragma unroll
                        for (int r = 0; r < 16; ++r) sacc += zr[r] * wg[r];
                        LA[(size_t)(row + w) * 512 + tid] = log_sigmoidf_(sacc) * (1.f / 16.f); }
                }
            }
            __syncthreads();
            SEAM(pb + 9);
        }
}
__global__ void __launch_bounds__(NTHREADS, 2) mega_fwd(Args args) {
    extern __shared__ __attribute__((aligned(16))) unsigned char lds_raw[];
    Frame F;
    F.lds = (LAS unsigned char*)lds_raw;
    F.wave = __builtin_amdgcn_readfirstlane((int)threadIdx.x >> 6);
    F.G = gridDim.x; { const int bx = blockIdx.x; F.vcu = (F.G % 8 == 0) ? (bx % 8) * (F.G / 8) + bx / 8 : bx; }
    F.gw = F.vcu * NWAVES + F.wave; F.NGW = F.G * NWAVES;
    unsigned char* ws = args.ws;
    unsigned* ctl = (unsigned*)(ws + WS_CTL);
    volatile LAS unsigned* MISC = (volatile LAS unsigned*)(F.lds + MISC_OFF);
    LAS int* TAB = (LAS int*)(F.lds + TAB_OFF);
    { const int tid0 = threadIdx.x;
      if (tid0 < 64) MISC[tid0] = 0u;
      if (tid0 < 33) ((LAS unsigned long long*)(F.lds + MISC_OFF + 256))[tid0] = (unsigned long long)args.in[tid0]; }
    __syncthreads();
    XcdBarrier bar = xcd_barrier_post(ctl + CW_BAR, MISC + 8, F.wave == 0 && lane_id() == 0);
    const int lo = args.ph_lo, hi = args.ph_hi;
    WS_PTRS
    if (IN(0) && !defined_SKIP_P0) { const int lane = lane_id(), tid = F.wave * 64 + lane; (void)tid;
        LAS unsigned char* scr = F.lds + F.wave * 8704;
#define TR_MAT(src_, ldw_, K_, N_, dst_, mode_, count_, sstride_, dstride_) do { \
            const int nkb = (K_) / 64, nnb = (N_) / 64, per = nkb * nnb, total = per * (count_); \
            _Pragma("unroll 1") for (int it = F.gw; it < total; it += F.NGW) { \
                const int q = it / per, r = it - q * per, kb = r / nnb, nb = r - kb * nnb; \
                transpose_item((src_) + (size_t)q * (sstride_), (ldw_), 0, (K_), (dst_) + (size_t)q * (dstride_), (mode_), kb, nb, scr, lane); } } while (0)
        TR_MAT(INP(29), 2048, 1024, 2048, (bf16*)(ws + WS_WT_GU), 1, 128, (size_t)1024 * 2048, (size_t)2048 * 1024);
        TR_MAT(INP(31), 1024, 1024, 1024, (bf16*)(ws + WS_WT_DN), 0, 128, (size_t)1024 * 1024, (size_t)1024 * 1024);
        TR_MAT(INP(3), 3088, 1024, 3072, (bf16*)(ws + WS_WT_ML_IN), 0, 1, (size_t)0, (size_t)0);
        TR_MAT(INP(6), 1024, 1024, 1024, (bf16*)(ws + WS_WT_ML_OUT), 0, 1, (size_t)0, (size_t)0);
        TR_MAT(INP(7), 6144, 1024, 6144, (bf16*)(ws + WS_WT_RET_IN), 0, 1, (size_t)0, (size_t)0);
        TR_MAT(INP(9), 1024, 2048, 1024, (bf16*)(ws + WS_WT_RET_OUT), 0, 1, (size_t)0, (size_t)0);
        TR_MAT(INP(10), 3088, 1024, 3072, (bf16*)(ws + WS_WT_GLA_IN), 0, 1, (size_t)0, (size_t)0);
        TR_MAT(INP(14), 1024, 1024, 1024, (bf16*)(ws + WS_WT_GLA_OUT), 0, 1, (size_t)0, (size_t)0);
        TR_MAT(INP(15), 1024, 1024, 1024, (bf16*)(ws + WS_WT_S5_IN), 0, 1, (size_t)0, (size_t)0);
        TR_MAT(INP(24), 1024, 1024, 1024, (bf16*)(ws + WS_WT_S5_GLU), 0, 1, (size_t)0, (size_t)0);
        TR_MAT(INP(26), 1024, 1024, 1024, (bf16*)(ws + WS_WT_S5_OUT), 0, 1, (size_t)0, (size_t)0);
#undef TR_MAT
        __syncthreads();
        {
            const float* lam_re = INP(16); const float* lam_im = INP(17); const float* b_re = INP(18); const float* b_im = INP(19); const float* log_dt = INP(23);
            for (int i = blockIdx.x * NTHREADS + tid; i < 64 * 64; i += F.G * NTHREADS) {
                const int g = i >> 6;
                const float lr = lam_re[i], li = lam_im[i], dt = expf(log_dt[g]);
                const float er = expf(lr * dt); float sn, cs; sincosf(li * dt, &sn, &cs);
                const float br = er * cs, bi = er * sn;
                S5LB[2 * i] = br; S5LB[2 * i + 1] = bi;
                const float nr = br - 1.f, ni = bi, den = lr * lr + li * li;
                const float fr_ = (nr * lr + ni * li) / den, fi_ = (ni * lr - nr * li) / den;
                for (int h = 0; h < 16; ++h) { const float xr = b_re[i * 16 + h], xi = b_im[i * 16 + h];
                    S5BB[(i * 16 + h) * 2] = fr_ * xr - fi_ * xi; S5BB[(i * 16 + h) * 2 + 1] = fr_ * xi + fi_ * xr; }
            }
        }
        LAS float* Wt = (LAS float*)(F.lds);
        load_cols16(tid, INP(3), 3088, 3072, Wt);
        __syncthreads();
        {
            const float* bg = INP(4);
            for (int row = F.gw; row < M; row += F.NGW) {
                asm volatile("" ::: "memory");
                f32x4 v[4]; load_row_f32(x_in + (size_t)row * D, v, lane);
                store_row_bf16(XB + (size_t)row * D, v, lane);
                float g[16]; row_dot16(v, Wt, lane, g);
                if (lane < 16) { float o = 0.f;
#pragma unroll
                    for (int e = 0; e < 16; ++e) o = (lane == e) ? g[e] : o;
                    GB[(size_t)row * 16 + lane] = o + bg[lane]; }
            }
        }
        __syncthreads();
        SEAM(0);
    }

    layer_body<0>(F, ws, ctl, TAB, bar, lo, hi, args.out);
    layer_body<1>(F, ws, ctl, TAB, bar, lo, hi, args.out);
    layer_body<2>(F, ws, ctl, TAB, bar, lo, hi, args.out);
    layer_body<3>(F, ws, ctl, TAB, bar, lo, hi, args.out);
#undef IN
#undef SEAM
#undef INP
#undef x_in
#undef ln_g
#undef ln_b
}

extern "C" void kernel_launch(void* const* d_in, const int* in_sizes, int n_in, void* d_out, int out_size, void* d_ws, size_t ws_size, hipStream_t stream) {
    static int grid = 0;
    if (grid == 0) {
        if (n_in != 33 || out_size != M * D || ws_size < WS_END) { fprintf(stderr, "kernel_launch: unexpected problem (n_in %d, out %d, ws %zu < %zu)\n", n_in, out_size, ws_size, (size_t)WS_END); grid = -1; return; }
        int dev = 0, cus = 0, per_cu = 0;
        if (hipGetDevice(&dev) != hipSuccess || hipDeviceGetAttribute(&cus, hipDeviceAttributeMultiprocessorCount, dev) != hipSuccess) { grid = -1; return; }
        if (hipFuncSetAttribute((const void*)mega_fwd, hipFuncAttributeMaxDynamicSharedMemorySize, LDS_BYTES) != hipSuccess) { fprintf(stderr, "kernel_launch: hipFuncSetAttribute failed\n"); grid = -1; return; }
        if (hipOccupancyMaxActiveBlocksPerMultiprocessor(&per_cu, (const void*)mega_fwd, NTHREADS, LDS_BYTES) != hipSuccess || per_cu < 1) { fprintf(stderr, "kernel_launch: occupancy query says %d\n", per_cu); }
        (void)hipGetLastError();
        grid = cus;
    }
    if (grid < 0) return;
    hipMemsetAsync((char*)d_ws + WS_CTL, 0, CTL_ZERO_BYTES, stream);
    Args a{};
    for (int i = 0; i < 33; ++i) a.in[i] = (const float*)d_in[i];
    a.out = (float*)d_out; a.ws = (unsigned char*)d_ws;
#if N_LAUNCH_MODE == 1
    a.ph_lo = 0; a.ph_hi = 1000;
    hipLaunchKernelGGL(mega_fwd, dim3(grid), dim3(NTHREADS), LDS_BYTES, stream, a);
#else
    for (int ph = 0; ph < 49; ++ph) { a.ph_lo = ph; a.ph_hi = ph + 1; hipLaunchKernelGGL(mega_fwd, dim3(grid), dim3(NTHREADS), LDS_BYTES, stream, a); }
#endif
}
```

```cpp
#include <hip/hip_runtime.h>
#include <cstdio>
#include <cstdint>

#ifndef NAIVE_MIX
#define NAIVE_MIX 1
#endif
#ifndef CH_ML
#define CH_ML 1
#endif
#ifndef CH_RET
#define CH_RET 1
#endif
#ifndef CH_GLA
#define CH_GLA 1
#endif
#ifndef N_LAUNCH_MODE
#define N_LAUNCH_MODE 1
#endif


#ifdef SKIP_ML
constexpr bool defined_SKIP_ML = true;
#else
constexpr bool defined_SKIP_ML = false;
#endif
#ifdef SKIP_RET
constexpr bool defined_SKIP_RET = true;
#else
constexpr bool defined_SKIP_RET = false;
#endif
#ifdef SKIP_GLA
constexpr bool defined_SKIP_GLA = true;
#else
constexpr bool defined_SKIP_GLA = false;
#endif
#ifdef SKIP_S5
constexpr bool defined_SKIP_S5 = true;
#else
constexpr bool defined_SKIP_S5 = false;
#endif
#ifdef SKIP_LN1
constexpr bool defined_SKIP_LN1 = true;
#else
constexpr bool defined_SKIP_LN1 = false;
#endif
#ifdef SKIP_P0
constexpr bool defined_SKIP_P0 = true;
#else
constexpr bool defined_SKIP_P0 = false;
#endif
#ifndef PHMASK
#define PHMASK 0xffff
#endif
#define PHE(b) (((PHMASK) >> (b)) & 1)
#define GAS __attribute__((address_space(1)))
#define LAS __attribute__((address_space(3)))
typedef unsigned short bf16;
typedef short bf16x8 __attribute__((ext_vector_type(8)));
typedef float f32x4 __attribute__((ext_vector_type(4)));
typedef float f32x2 __attribute__((ext_vector_type(2)));
typedef unsigned u32x4 __attribute__((ext_vector_type(4)));
typedef unsigned u32x2 __attribute__((ext_vector_type(2)));

constexpr int BATCH = 2, T = 8192, D = 1024, M = BATCH * T;
constexpr int NEXP = 32, TOPK = 4, DFF = 1024, CAP = M;
constexpr int NWAVES = 8, NTHREADS = 512;
constexpr float LN_EPS = 1e-5f;
constexpr float ALPHA = 1.681792830507429f;
constexpr int MAXTILES = (M * TOPK) / 256 + NEXP;

constexpr size_t MiB = 1u << 20;
constexpr size_t WS_CTL = 0, CTL_ZERO_BYTES = 1 * MiB;
constexpr size_t WS_WT_ML_IN = 1 * MiB;
constexpr size_t WS_WT_ML_OUT = WS_WT_ML_IN + 6 * MiB;
constexpr size_t WS_WT_RET_IN = WS_WT_ML_OUT + 2 * MiB;
constexpr size_t WS_WT_RET_OUT = WS_WT_RET_IN + 12 * MiB;
constexpr size_t WS_WT_GLA_IN = WS_WT_RET_OUT + 4 * MiB;
constexpr size_t WS_WT_GLA_OUT = WS_WT_GLA_IN + 6 * MiB;
constexpr size_t WS_WT_S5_IN = WS_WT_GLA_OUT + 2 * MiB;
constexpr size_t WS_WT_S5_GLU = WS_WT_S5_IN + 2 * MiB;
constexpr size_t WS_WT_S5_OUT = WS_WT_S5_GLU + 2 * MiB;
constexpr size_t WS_S5TAB = WS_WT_S5_OUT + 2 * MiB;
constexpr size_t WS_GB = WS_S5TAB + 1 * MiB;
constexpr size_t WS_LIST = WS_GB + 1 * MiB;
constexpr size_t WS_GW = WS_LIST + 2 * MiB;
constexpr size_t WS_WT_GU = WS_GW + 1 * MiB;
constexpr size_t WS_WT_DN = WS_WT_GU + 512 * MiB;
constexpr size_t WS_HF = WS_WT_DN + 256 * MiB;
constexpr size_t WS_XB = WS_HF + 64 * MiB;
constexpr size_t WS_ZF = WS_XB + 32 * MiB;
constexpr size_t WS_PB = WS_ZF + 64 * MiB;
constexpr size_t WS_LA = WS_PB + 192 * MiB;
constexpr size_t WS_ORAW = WS_LA + 32 * MiB;
constexpr size_t WS_YB = WS_ORAW + 128 * MiB;
constexpr size_t WS_ACT = WS_YB + 64 * MiB;
constexpr size_t WS_YS = WS_ACT + 144 * MiB;
constexpr size_t WS_XG = WS_YS + 256 * MiB;
constexpr size_t WS_UT = WS_XG + 1024 * MiB;
constexpr size_t WS_ST = WS_UT + 128 * MiB;
constexpr size_t WS_KPP = WS_ST + 64 * MiB;
constexpr size_t WS_SC = WS_KPP + 16 * MiB;
constexpr size_t WS_END = WS_SC + 4 * MiB;
constexpr int CW_BAR = 4096;
constexpr int CW_CNT = 16384;

constexpr int PH_BYTES = 139264;
constexpr int TAB_OFF = PH_BYTES;
constexpr int MISC_OFF = TAB_OFF + 4096;
constexpr int LDS_BYTES = 147456;

__device__ __forceinline__ unsigned f2bf(float f) { unsigned u = __builtin_bit_cast(unsigned, f); return (u + 0x7fffu + ((u >> 16) & 1u)) >> 16; }
__device__ __forceinline__ unsigned pk2(float lo, float hi) { return f2bf(lo) | (f2bf(hi) << 16); }
__device__ __forceinline__ float bf2f(unsigned short b) { return __builtin_bit_cast(float, ((unsigned)b) << 16); }
__device__ __forceinline__ float bflo(unsigned w) { return __builtin_bit_cast(float, w << 16); }
__device__ __forceinline__ float bfhi(unsigned w) { return __builtin_bit_cast(float, w & 0xffff0000u); }
__device__ __forceinline__ int lane_id() { int l; asm volatile("v_mbcnt_lo_u32_b32 %0, -1, 0\n\tv_mbcnt_hi_u32_b32 %0, -1, %0" : "=v"(l)); return l; }
__device__ __forceinline__ float wave_sum(float v) {
#pragma unroll
    for (int o = 1; o < 64; o <<= 1) v += __shfl_xor(v, o);
    return v;
}
__device__ __forceinline__ float sigmoidf_(float x) { return 1.f / (1.f + __expf(-x)); }
__device__ __forceinline__ float log_sigmoidf_(float x) { return fminf(x, 0.f) - log1pf(__expf(-fabsf(x))); }
__device__ __forceinline__ float gelu_tanh(float x) { const float u = 0.7978845608028654f * (x + 0.044715f * x * x * x); return 0.5f * x * (1.f + tanhf(u)); }

namespace pg8 {
constexpr int BM = 256, BK = 64, HALF = 128, HTB = HALF * BK * 2, STAGE_BYTES = 8 * HTB, NXCD = 8, WGM = 8;
__host__ __device__ __forceinline__ int lds_byte(int r, int c) { const int st = (r >> 4) * 2 + (c >> 5), rr = r & 15, cc = c & 31, ob = rr * 64 + cc * 2; return st * 1024 + (ob ^ (((ob >> 9) & 1) << 5)); }
__host__ __device__ __forceinline__ void stage_rc(int b, int& R, int& C) { const int st = b / 1024, sb = b % 1024, swz = sb ^ (((sb >> 9) & 1) << 5); R = (st >> 1) * 16 + swz / 64; C = (st & 1) * 32 + (swz % 64) / 2; }
__host__ __device__ __forceinline__ int perm32(int rho) { const int n = rho >> 4, i = rho & 15; return 8 * (i >> 2) + 4 * n + (i & 3); }

struct Unit { const char* A; const char* B; int pm, pn, e, nvalid; };

__device__ __forceinline__ int xcd_remap(int L, int nwg) { const int q = nwg / NXCD, r = nwg % NXCD, xcd = L % NXCD, off = L / NXCD; return (xcd < r ? xcd * (q + 1) : r * (q + 1) + (xcd - r) * q) + off; }

struct DenseOrder {
    const char* A; const char* Bt; int K, nM, nN, nwg, G, c;
    __device__ __forceinline__ void init(const void* A_, const void* Bt_, int M_, int N_, int K_, int G_, int c_) { A = (const char*)A_; Bt = (const char*)Bt_; K = K_; nM = M_ / BM; nN = N_ / BM; nwg = nM * nN; G = G_; c = c_; }
    __device__ __forceinline__ bool next(int i, Unit& u) const {
        const long L = (long)i * G + c; if (L >= nwg) return false;
        const int wgid = xcd_remap((int)L, nwg);
        const int nig = WGM * nN, gid = wgid / nig, fm = gid * WGM, gsz = (nM - fm) < WGM ? (nM - fm) : WGM;
        u.pm = fm + ((wgid % nig) % gsz); u.pn = (wgid % nig) / gsz; u.e = 0; u.nvalid = 256;
        u.A = A + (size_t)u.pm * 256 * K * 2; u.B = Bt + (size_t)u.pn * 256 * K * 2; return true;
    }
};
struct MoeOrder {
    const char* A; const char* Bt; const LAS int* tab;
    int K, nN, ntiles, nwg, G, c; size_t b_estride; int a_compact;
    __device__ __forceinline__ bool next(int i, Unit& u) const {
        const long L = (long)i * G + c; if (L >= nwg) return false;
        const int wgid = xcd_remap((int)L, nwg);
        const int nig = WGM * nN, gid = wgid / nig, fm = gid * WGM, gsz = (ntiles - fm) < WGM ? (ntiles - fm) : WGM;
        const int tl = fm + ((wgid % nig) % gsz); u.pm = tl; u.pn = (wgid % nig) / gsz;
        const int e = __builtin_amdgcn_readfirstlane(tab[72 + tl]); u.e = e; const int r0 = (tl - __builtin_amdgcn_readfirstlane(tab[32 + e])) * 256; const int rem = __builtin_amdgcn_readfirstlane(tab[e]) - r0; u.nvalid = rem < 256 ? rem : 256;
        u.A = a_compact ? A + (size_t)tl * 256 * K * 2 : A + ((size_t)e * CAP + r0) * K * 2;
        u.B = Bt + (size_t)e * b_estride + (size_t)u.pn * 256 * K * 2; return true;
    }
};

__device__ __forceinline__ unsigned cvt_pk_bf16(float lo, float hi) { unsigned r; asm volatile("v_cvt_pk_bf16_f32 %0, %1, %2" : "=v"(r) : "v"(lo), "v"(hi)); return r; }

struct EpiBf16 {
    static constexpr bool PERM = true;
    bf16* O; int ldc;
    __device__ __forceinline__ void operator()(const f32x4 (&acc)[2][2][4][2], const Unit& u, int wr, int wc, int fr, int fq) const {
        const int row0 = u.pm * BM + wr * 64 + fr, col0 = u.pn * BM + wc * 32 + 8 * fq;
#pragma unroll
        for (int ai = 0; ai < 2; ++ai)
#pragma unroll
            for (int m = 0; m < 4; ++m) { bf16* rowp = O + (size_t)(row0 + ai * HALF + m * 16) * ldc + col0;
#pragma unroll
                for (int bj = 0; bj < 2; ++bj) { const f32x4 v0 = acc[ai][bj][m][0], v1 = acc[ai][bj][m][1];
                    u32x4 w; w.x = cvt_pk_bf16(v0[0], v0[1]); w.y = cvt_pk_bf16(v0[2], v0[3]); w.z = cvt_pk_bf16(v1[0], v1[1]); w.w = cvt_pk_bf16(v1[2], v1[3]);
                    *(u32x4*)(rowp + bj * HALF) = w; } }
    }
};
struct EpiResid {
    static constexpr bool PERM = false;
    const float* hin; float* Z;
    __device__ __forceinline__ void operator()(const f32x4 (&acc)[2][2][4][2], const Unit& u, int wr, int wc, int fr, int fq) const {
        const int row0 = u.pm * BM + wr * 64 + fr, col0 = u.pn * BM + wc * 32 + 4 * fq;
#pragma unroll
        for (int ai = 0; ai < 2; ++ai)
#pragma unroll
            for (int m = 0; m < 4; ++m) { const size_t off = (size_t)(row0 + ai * HALF + m * 16) * D + col0;
#pragma unroll
                for (int bj = 0; bj < 2; ++bj)
#pragma unroll
                    for (int n = 0; n < 2; ++n) { const f32x4 hv = *(const f32x4*)(hin + off + bj * HALF + n * 16); *(f32x4*)(Z + off + bj * HALF + n * 16) = hv * ALPHA + acc[ai][bj][m][n]; } }
    }
};
struct EpiGlu {
    static constexpr bool PERM = true;
    const bf16* Y; const float* bias; bf16* O;
    __device__ __forceinline__ void operator()(const f32x4 (&acc)[2][2][4][2], const Unit& u, int wr, int wc, int fr, int fq) const {
        const int row0 = u.pm * BM + wr * 64 + fr, col0 = u.pn * BM + wc * 32 + 8 * fq;
#pragma unroll
        for (int ai = 0; ai < 2; ++ai)
#pragma unroll
            for (int m = 0; m < 4; ++m) { const size_t off = (size_t)(row0 + ai * HALF + m * 16) * D + col0;
#pragma unroll
                for (int bj = 0; bj < 2; ++bj) {
                    const f32x4 b0 = *(const f32x4*)(bias + col0 + bj * HALF), b1 = *(const f32x4*)(bias + col0 + bj * HALF + 4);
                    const u32x4 yw = *(const u32x4*)(Y + off + bj * HALF);
                    const f32x4 v0 = acc[ai][bj][m][0] + b0, v1 = acc[ai][bj][m][1] + b1;
                    float o[8];
                    o[0] = bflo(yw.x) * sigmoidf_(v0[0]); o[1] = bfhi(yw.x) * sigmoidf_(v0[1]); o[2] = bflo(yw.y) * sigmoidf_(v0[2]); o[3] = bfhi(yw.y) * sigmoidf_(v0[3]);
                    o[4] = bflo(yw.z) * sigmoidf_(v1[0]); o[5] = bfhi(yw.z) * sigmoidf_(v1[1]); o[6] = bflo(yw.w) * sigmoidf_(v1[2]); o[7] = bfhi(yw.w) * sigmoidf_(v1[3]);
                    u32x4 w; w.x = cvt_pk_bf16(o[0], o[1]); w.y = cvt_pk_bf16(o[2], o[3]); w.z = cvt_pk_bf16(o[4], o[5]); w.w = cvt_pk_bf16(o[6], o[7]);
                    *(u32x4*)(O + off + bj * HALF) = w; } }
    }
};
struct EpiSwiglu {
    static constexpr bool PERM = true;
    bf16* ACT; const float* bgu;
    __device__ __forceinline__ void operator()(const f32x4 (&acc)[2][2][4][2], const Unit& u, int wr, int wc, int fr, int fq) const {
        const int row0 = u.pm * BM + wr * 64 + fr, j0 = u.pn * HALF + wc * 32 + 8 * fq;
        const float* bg = bgu + (size_t)u.e * 2 * DFF + j0;
        const f32x4 g0 = *(const f32x4*)(bg), g1 = *(const f32x4*)(bg + 4), u0 = *(const f32x4*)(bg + DFF), u1 = *(const f32x4*)(bg + DFF + 4);
#pragma unroll
        for (int ai = 0; ai < 2; ++ai)
#pragma unroll
            for (int m = 0; m < 4; ++m) {
                float o[8];
#pragma unroll
                for (int n = 0; n < 2; ++n)
#pragma unroll
                    for (int i = 0; i < 4; ++i) {
                        float g = acc[ai][0][m][n][i] + (n ? g1[i] : g0[i]), up = acc[ai][1][m][n][i] + (n ? u1[i] : u0[i]);
                        g = fminf(g, 7.0f); up = fminf(fmaxf(up, -7.0f), 7.0f);
                        o[n * 4 + i] = (up + 1.0f) * g * sigmoidf_(1.702f * g); }
                u32x4 w; w.x = cvt_pk_bf16(o[0], o[1]); w.y = cvt_pk_bf16(o[2], o[3]); w.z = cvt_pk_bf16(o[4], o[5]); w.w = cvt_pk_bf16(o[6], o[7]);
                *(u32x4*)(ACT + (size_t)(row0 + ai * HALF + m * 16) * DFF + j0) = w; }
    }
};
struct EpiMoeDown {
    static constexpr bool PERM = false;
    float* YS; const float* bd; const int* list; const float* gw; const LAS int* tab;
    __device__ __forceinline__ void operator()(const f32x4 (&acc)[2][2][4][2], const Unit& u, int wr, int wc, int fr, int fq) const {
        const int col0 = u.pn * BM + wc * 32 + 4 * fq; const int r0 = (u.pm - __builtin_amdgcn_readfirstlane(tab[32 + u.e])) * 256;
        const float* bp = bd + (size_t)u.e * D + col0;
        f32x4 bv[2][2];
#pragma unroll
        for (int bj = 0; bj < 2; ++bj)
#pragma unroll
            for (int n = 0; n < 2; ++n) bv[bj][n] = *(const f32x4*)(bp + bj * HALF + n * 16);
#pragma unroll
        for (int ai = 0; ai < 2; ++ai)
#pragma unroll
            for (int m = 0; m < 4; ++m) { const int r = ai * HALF + wr * 64 + m * 16 + fr;
                if (r < u.nvalid) { const int slot = list[(size_t)u.e * CAP + r0 + r]; const float g = gw[slot]; float* op = YS + (size_t)slot * D + col0;
#pragma unroll
                    for (int bj = 0; bj < 2; ++bj)
#pragma unroll
                        for (int n = 0; n < 2; ++n) *(f32x4*)(op + bj * HALF + n * 16) = (acc[ai][bj][m][n] + bv[bj][n]) * g; } }
    }
};

template <class Epi, class Sched, bool ALIGN_EPI, bool SP2>
__device__ __forceinline__ void gemm_phase(LAS unsigned char* lds, const int wid, const int K, const Sched& S, const Epi& E) {
    const int lane = lane_id(), tid = wid * 64 + lane, wr = wid >> 2, wc = wid & 3, fr = lane & 15, fq = lane >> 4;
    const int nt = K / BK;
    unsigned voffA[2], voffB[2];
#pragma unroll
    for (int i = 0; i < 2; ++i) { int R, C; stage_rc(tid * 16 + i * 8192, R, C); const int Rb = Epi::PERM ? ((R & ~31) + perm32(R & 31)) : R;
        voffA[i] = (unsigned)(R * K + C) * 2u; voffB[i] = (unsigned)(Rb * K + C) * 2u; }
    const size_t kstep = (size_t)(BK * 2);
    const size_t hstep = (size_t)HALF * K * 2;
    const unsigned ldsw = (unsigned)wid * 1024u;
    const int aoff = lds_byte(wr * 64 + fr, fq * 8), boff = lds_byte(wc * 32 + fr, fq * 8);
#define PG8_SA(b, h) (((b) * 2 + (h)) * HTB)
#define PG8_SB(b, h) ((4 + (b) * 2 + (h)) * HTB)
#define PG8_STAGE(bufoff, gbase, voff) do { _Pragma("unroll") for (int _i = 0; _i < 2; ++_i) \
        __builtin_amdgcn_global_load_lds((const unsigned*)((const char*)(gbase) + (voff)[_i]), (LAS unsigned*)(lds + (bufoff) + ldsw + _i * 8192), 16, 0, 0); } while (0)
#define PG8_LDA(dst, b, h) do { _Pragma("unroll") for (int m = 0; m < 4; ++m) _Pragma("unroll") for (int k = 0; k < 2; ++k) dst[m][k] = *(const LAS bf16x8*)(lds + PG8_SA(b, h) + aoff + m * 2048 + k * 1024); } while (0)
#define PG8_LDB(dst, b, h) do { _Pragma("unroll") for (int n = 0; n < 2; ++n) _Pragma("unroll") for (int k = 0; k < 2; ++k) dst[n][k] = *(const LAS bf16x8*)(lds + PG8_SB(b, h) + boff + n * 2048 + k * 1024); } while (0)
#define PG8_MMA(ai, bj, At, Bt) do { __builtin_amdgcn_s_setprio(1); _Pragma("unroll") for (int m = 0; m < 4; ++m) _Pragma("unroll") for (int n = 0; n < 2; ++n) _Pragma("unroll") for (int k = 0; k < 2; ++k) \
        acc[ai][bj][m][n] = __builtin_amdgcn_mfma_f32_16x16x32_bf16(Bt[n][k], At[m][k], acc[ai][bj][m][n], 0, 0, 0); __builtin_amdgcn_s_setprio(0); } while (0)
#define PG8_WAIT_V(n) asm volatile("s_waitcnt vmcnt(" #n ")" ::: "memory")
#define PG8_WAIT_L(n) asm volatile("s_waitcnt lgkmcnt(" #n ")" ::: "memory")
#define PG8_BAR __builtin_amdgcn_s_barrier()
#define PG8_SCHED __builtin_amdgcn_sched_barrier(0)
    Unit cur, nxt; int ui = 0;
    if (!S.next(0, cur)) return;
    f32x4 acc[2][2][4][2];
#pragma unroll
    for (int a = 0; a < 2; ++a)
#pragma unroll
        for (int b = 0; b < 2; ++b)
#pragma unroll
            for (int m = 0; m < 4; ++m)
#pragma unroll
                for (int n = 0; n < 2; ++n) acc[a][b][m][n] = (f32x4){0.f, 0.f, 0.f, 0.f};
    bf16x8 At[4][2], B0[2][2], B1[2][2];
    const char* cA = cur.A; const char* cB = cur.B;
    if constexpr (SP2) {
        PG8_STAGE(PG8_SB(0, 0), cB, voffB); PG8_STAGE(PG8_SB(0, 1), cB + hstep, voffB); PG8_STAGE(PG8_SA(0, 0), cA, voffA); PG8_STAGE(PG8_SA(0, 1), cA + hstep, voffA);
        if (wr == 1) PG8_BAR;
        PG8_WAIT_V(2); PG8_BAR;
        PG8_STAGE(PG8_SB(1, 0), cB + kstep, voffB); PG8_STAGE(PG8_SA(1, 0), cA + kstep, voffA); PG8_STAGE(PG8_SB(1, 1), cB + hstep + kstep, voffB);
        PG8_WAIT_V(6); PG8_BAR;
    } else {
        PG8_STAGE(PG8_SB(0, 0), cB, voffB); PG8_STAGE(PG8_SA(0, 0), cA, voffA); PG8_STAGE(PG8_SB(0, 1), cB + hstep, voffB); PG8_STAGE(PG8_SA(0, 1), cA + hstep, voffA);
        if (wr == 1) PG8_BAR;
        PG8_WAIT_V(4); PG8_BAR;
        PG8_STAGE(PG8_SB(1, 0), cB + kstep, voffB); PG8_STAGE(PG8_SA(1, 0), cA + kstep, voffA); PG8_STAGE(PG8_SB(1, 1), cB + hstep + kstep, voffB);
        PG8_WAIT_V(6); PG8_BAR;
    }
    for (;;) {
        const bool has_next = S.next(ui + 1, nxt);
        const char* nA = has_next ? nxt.A : cA; const char* nB = has_next ? nxt.B : cB;
        for (int t = 0; t < nt; t += 2) {
            const bool last = (t == nt - 2);
            const char* a1 = cA + (size_t)(t + 1) * kstep;
            const char* a2 = last ? nA : cA + (size_t)(t + 2) * kstep; const char* b2 = last ? nB : cB + (size_t)(t + 2) * kstep;
            const char* a3 = a2 + kstep; const char* b3 = b2 + kstep;
            if constexpr (SP2) {
            PG8_LDB(B0, 0, 0); PG8_LDB(B1, 0, 1); PG8_SCHED; PG8_LDA(At, 0, 0); PG8_STAGE(PG8_SA(1, 1), a1 + hstep, voffA);
            PG8_WAIT_V(8); PG8_WAIT_L(0); PG8_BAR; PG8_MMA(0, 0, At, B0); PG8_MMA(0, 1, At, B1); PG8_BAR; PG8_SCHED;
            PG8_LDA(At, 0, 1); PG8_STAGE(PG8_SB(0, 0), b2, voffB); PG8_STAGE(PG8_SB(0, 1), b2 + hstep, voffB); PG8_STAGE(PG8_SA(0, 0), a2, voffA);
            PG8_WAIT_V(8); PG8_WAIT_L(0); PG8_BAR; PG8_MMA(1, 0, At, B0); PG8_MMA(1, 1, At, B1); PG8_BAR; PG8_SCHED;
            PG8_LDB(B0, 1, 0); PG8_LDB(B1, 1, 1); PG8_SCHED; PG8_LDA(At, 1, 0); PG8_STAGE(PG8_SA(0, 1), a2 + hstep, voffA);
            PG8_WAIT_V(8); PG8_WAIT_L(0); PG8_BAR; PG8_MMA(0, 0, At, B0); PG8_MMA(0, 1, At, B1); PG8_BAR; PG8_SCHED;
            PG8_LDA(At, 1, 1); PG8_STAGE(PG8_SB(1, 0), b3, voffB); PG8_STAGE(PG8_SB(1, 1), b3 + hstep, voffB); PG8_STAGE(PG8_SA(1, 0), a3, voffA);
            PG8_WAIT_V(8); PG8_WAIT_L(0); PG8_BAR; PG8_MMA(1, 0, At, B0); PG8_MMA(1, 1, At, B1); PG8_BAR; PG8_SCHED;
            } else {
            PG8_LDB(B0, 0, 0); PG8_SCHED; PG8_LDA(At, 0, 0); PG8_STAGE(PG8_SA(1, 1), a1 + hstep, voffA);
            PG8_WAIT_L(8); PG8_BAR; PG8_WAIT_L(0); PG8_MMA(0, 0, At, B0); PG8_BAR; PG8_SCHED;
            PG8_LDB(B1, 0, 1); PG8_STAGE(PG8_SB(0, 0), b2, voffB);
            PG8_BAR; PG8_WAIT_L(0); PG8_MMA(0, 1, At, B1); PG8_BAR;
            PG8_LDA(At, 0, 1); PG8_STAGE(PG8_SA(0, 0), a2, voffA);
            PG8_BAR; PG8_WAIT_L(0); PG8_MMA(1, 0, At, B0); PG8_BAR; PG8_SCHED;
            PG8_STAGE(PG8_SB(0, 1), b2 + hstep, voffB);
            PG8_WAIT_V(6); PG8_BAR; PG8_MMA(1, 1, At, B1); PG8_BAR;
            PG8_LDB(B0, 1, 0); PG8_SCHED; PG8_LDA(At, 1, 0); PG8_STAGE(PG8_SA(0, 1), a2 + hstep, voffA);
            PG8_WAIT_L(8); PG8_BAR; PG8_WAIT_L(0); PG8_MMA(0, 0, At, B0); PG8_BAR; PG8_SCHED;
            PG8_LDB(B1, 1, 1); PG8_STAGE(PG8_SB(1, 0), b3, voffB);
            PG8_BAR; PG8_WAIT_L(0); PG8_MMA(0, 1, At, B1); PG8_BAR;
            PG8_LDA(At, 1, 1); PG8_STAGE(PG8_SA(1, 0), a3, voffA);
            PG8_BAR; PG8_WAIT_L(0); PG8_MMA(1, 0, At, B0); PG8_BAR; PG8_SCHED;
            PG8_STAGE(PG8_SB(1, 1), b3 + hstep, voffB);
            PG8_WAIT_V(6); PG8_BAR; PG8_MMA(1, 1, At, B1); PG8_BAR;
            }
        }
        if constexpr (ALIGN_EPI) { if (wr == 0) PG8_BAR; }
        E(acc, cur, wr, wc, fr, fq);
        if (!has_next) break;
#pragma unroll
        for (int a = 0; a < 2; ++a)
#pragma unroll
            for (int b = 0; b < 2; ++b)
#pragma unroll
                for (int m = 0; m < 4; ++m)
#pragma unroll
                    for (int n = 0; n < 2; ++n) acc[a][b][m][n] = (f32x4){0.f, 0.f, 0.f, 0.f};
        cur = nxt; cA = nA; cB = nB; ++ui;
        if constexpr (ALIGN_EPI) { if (wr == 1) PG8_BAR; }
    }
    PG8_WAIT_V(0);
    if constexpr (!ALIGN_EPI) { if (wr == 0) PG8_BAR; }
    PG8_BAR;
#undef PG8_SA
#undef PG8_SB
#undef PG8_STAGE
#undef PG8_LDA
#undef PG8_LDB
#undef PG8_MMA
#undef PG8_WAIT_V
#undef PG8_WAIT_L
#undef PG8_BAR
#undef PG8_SCHED
}
}

#define XB_TMO      128
#define XB_XCNT(j)  (256  + 64 * (j))
#define XB_XSUB(j)  (1280 + 64 * (j))
#define XB_XGEN(j)  (2304 + 64 * (j))
#define XB_TOP      3328
#define XB_TOPGEN   3392
#define XCD_BAR_WORDS 3456
#define XB_SPIN_CAP (1u << 18)
__device__ __forceinline__ unsigned xb_ld(unsigned* p)              { return __hip_atomic_load(p, __ATOMIC_RELAXED, __HIP_MEMORY_SCOPE_AGENT); }
__device__ __forceinline__ unsigned xb_add(unsigned* p, unsigned v) { return __hip_atomic_fetch_add(p, v, __ATOMIC_RELAXED, __HIP_MEMORY_SCOPE_AGENT); }
__device__ __forceinline__ unsigned xb_xcc_id() { return (unsigned)__builtin_amdgcn_s_getreg((3 << 11) | 20) & 0xFu; }
#define XB_SPIN(cond, bar) do { unsigned _sp = 0; while (cond) { __builtin_amdgcn_s_sleep(1); \
    if ((++_sp & 255u) == 0u) { if (xb_ld(&(bar)[XB_TMO])) break; if (_sp > XB_SPIN_CAP) { atomicAdd(&(bar)[XB_TMO], 1u); break; } } } } while (0)
struct XcdBarrier { unsigned* bar; unsigned x; volatile LAS unsigned* st; };
__device__ __forceinline__ XcdBarrier xcd_barrier_post(unsigned* bar, volatile LAS unsigned* st, bool leader) {
    XcdBarrier b; b.bar = bar; b.x = xb_xcc_id(); b.st = st;
    if (leader) (void)xb_add(&bar[XB_XCNT(b.x)], 1u);
    return b;
}
__device__ __forceinline__ void xcd_barrier_complete(unsigned* bar, unsigned x, unsigned& nloc, unsigned& nx) {
    const unsigned G = gridDim.x * gridDim.y * gridDim.z;
    unsigned sum, cnt, mine, sp = 0u;
    for (;;) {
        sum = 0u; cnt = 0u; mine = 0u;
#pragma unroll
        for (unsigned j = 0; j < 16; ++j) { const unsigned c = xb_ld(&bar[XB_XCNT(j)]); sum += c; cnt += (c > 0u) ? 1u : 0u; mine = (j == x) ? c : mine; }
        if (sum == G) break;
        __builtin_amdgcn_s_sleep(1);
        if ((++sp & 255u) == 0u) { if (xb_ld(&bar[XB_TMO])) break; if (sp > XB_SPIN_CAP) { atomicAdd(&bar[XB_TMO], 1u); break; } }
    }
    nloc = mine > 0u ? mine : 1u; nx = cnt > 0u ? cnt : 1u;
}
__device__ __forceinline__ void xcd_barrier(const XcdBarrier& b, int wave) {
    asm volatile("s_waitcnt vmcnt(0)" ::: "memory");
    __syncthreads();
    if (wave == 0 && lane_id() == 0) {
        unsigned* bar = b.bar;
        __builtin_amdgcn_s_waitcnt(0);
        unsigned nloc = b.st[0], nx = b.st[1];
        if (nloc == 0u) { xcd_barrier_complete(bar, b.x, nloc, nx); b.st[0] = nloc; b.st[1] = nx; }
        const unsigned old = xb_add(&bar[XB_XSUB(b.x)], 1u);
        const unsigned gen = old / nloc;
        if (old + 1u == (gen + 1u) * nloc) {
            __builtin_amdgcn_fence(__ATOMIC_RELEASE, "agent");
            asm volatile("s_waitcnt vmcnt(0)" ::: "memory");
            const unsigned og = xb_add(&bar[XB_TOP], 1u);
            const unsigned tg = og / nx;
            if (og + 1u == (tg + 1u) * nx) xb_add(&bar[XB_TOPGEN], 1u);
            else XB_SPIN(xb_ld(&bar[XB_TOPGEN]) == tg, bar);
            __builtin_amdgcn_fence(__ATOMIC_ACQUIRE, "agent");
            xb_add(&bar[XB_XGEN(b.x)], 1u);
            asm volatile("s_waitcnt vmcnt(0)" ::: "memory");
        } else {
            XB_SPIN(xb_ld(&bar[XB_XGEN(b.x)]) == gen, bar);
            __builtin_amdgcn_fence(__ATOMIC_ACQUIRE, "agent");
            asm volatile("s_waitcnt vmcnt(0)" ::: "memory");
        }
    }
    __syncthreads();
}

struct Args { const float* in[33]; float* out; unsigned char* ws; int ph_lo, ph_hi; };
struct Frame {
    LAS unsigned char* lds;
    int wave, vcu, G, gw, NGW;
};

__device__ __forceinline__ void transpose_item(const float* W, int ldw, int col_off, int K, bf16* WT, int mode, int kb, int nb, LAS unsigned char* scr, int lane) {
    const int k0 = 64 * kb, n0 = 64 * nb;
    const float* src = W + (size_t)k0 * ldw + col_off + n0;
    f32x4 v[16];
#pragma unroll
    for (int i = 0; i < 16; ++i) v[i] = *(const f32x4*)(src + (size_t)((lane >> 4) + 4 * i) * ldw + 4 * (lane & 15));
#pragma unroll
    for (int i = 0; i < 16; ++i) { LAS unsigned* p = (LAS unsigned*)(scr + ((lane >> 4) + 4 * i) * 132 + 8 * (lane & 15)); p[0] = pk2(v[i][0], v[i][1]); p[1] = pk2(v[i][2], v[i][3]); }
    asm volatile("s_waitcnt lgkmcnt(0)" ::: "memory");
    const int c = lane >> 3, nl = lane & 7;
#pragma unroll
    for (int r = 0; r < 8; ++r) { const int n = nl + 8 * r; const LAS unsigned short* s = (const LAS unsigned short*)(scr + (8 * c) * 132 + 2 * n);
        u32x4 o; o.x = (unsigned)s[0] | ((unsigned)s[66] << 16); o.y = (unsigned)s[132] | ((unsigned)s[198] << 16); o.z = (unsigned)s[264] | ((unsigned)s[330] << 16); o.w = (unsigned)s[396] | ((unsigned)s[462] << 16);
        const int ng = n0 + n; int drow = ng; if (mode == 1) { drow = ng < 1024 ? 256 * (ng >> 7) + (ng & 127) : 256 * ((ng - 1024) >> 7) + 128 + (ng & 127); }
        *(u32x4*)(WT + (size_t)drow * K + k0 + 8 * c) = o; }
    asm volatile("s_waitcnt lgkmcnt(0)" ::: "memory");
}

__device__ __forceinline__ void load_cols16(int tid, const float* W, int ldw, int col_off, LAS float* Wt) {
    for (int i = tid; i < 1024 * 16; i += NTHREADS) { const int e = i & 15, k = i >> 4; Wt[e * 1028 + k] = W[(size_t)k * ldw + col_off + e]; }
}
__device__ __forceinline__ void row_dot16(const f32x4 (&v)[4], const LAS float* Wt, int lane, float (&out)[16]) {
#pragma unroll
    for (int e = 0; e < 16; ++e) { float s = 0.f;
#pragma unroll
        for (int j = 0; j < 4; ++j) { const f32x4 w = *(const LAS f32x4*)(Wt + e * 1028 + 4 * (lane + 64 * j)); s += v[j][0] * w[0] + v[j][1] * w[1] + v[j][2] * w[2] + v[j][3] * w[3]; }
        out[e] = wave_sum(s); }
}
__device__ __forceinline__ void store_row_bf16(bf16* orow, const f32x4 (&v)[4], int lane) {
    unsigned long long* o8 = (unsigned long long*)orow + lane;
#pragma unroll
    for (int j = 0; j < 4; ++j) o8[64 * j] = (unsigned long long)pk2(v[j][0], v[j][1]) | ((unsigned long long)pk2(v[j][2], v[j][3]) << 32);
}
__device__ __forceinline__ void store_row_f32(float* orow, const f32x4 (&v)[4], int lane) {
    f32x4* o = (f32x4*)orow + lane;
#pragma unroll
    for (int j = 0; j < 4; ++j) o[64 * j] = v[j];
}
__device__ __forceinline__ void load_row_f32(const float* row, f32x4 (&v)[4], int lane) {
    const f32x4* p = (const f32x4*)row + lane;
#pragma unroll
    for (int j = 0; j < 4; ++j) v[j] = p[64 * j];
}
__device__ __forceinline__ void ln_row(f32x4 (&v)[4], const f32x4 (&gv)[4], const f32x4 (&bv)[4]) {
    float s = 0.f;
#pragma unroll
    for (int j = 0; j < 4; ++j) s += (v[j][0] + v[j][1]) + (v[j][2] + v[j][3]);
    const float mean = wave_sum(s) * (1.f / D); float s2 = 0.f;
#pragma unroll
    for (int j = 0; j < 4; ++j) { v[j] = v[j] - mean; s2 += (v[j][0] * v[j][0] + v[j][1] * v[j][1]) + (v[j][2] * v[j][2] + v[j][3] * v[j][3]); }
    const float rstd = 1.f / sqrtf(wave_sum(s2) * (1.f / D) + LN_EPS);
#pragma unroll
    for (int j = 0; j < 4; ++j) v[j] = v[j] * rstd * gv[j] + bv[j];
}

__device__ __forceinline__ const float* inp_ptr(LAS unsigned char* lds, int i) {
    const LAS unsigned* p = (const LAS unsigned*)(lds + MISC_OFF + 256) + 2 * i;
    const unsigned lo = __builtin_amdgcn_readfirstlane(p[0]), hi = __builtin_amdgcn_readfirstlane(p[1]);
    return (const float*)(const GAS float*)(((unsigned long long)hi << 32) | lo);
}

typedef short s16x4 __attribute__((ext_vector_type(4)));
typedef short v4i16_t __attribute__((ext_vector_type(4)));
constexpr int CL = 128, NCH = T / CL;
template <int MODE> struct MX;
template <> struct MX<0> { static constexpr int NH = 8, DK = 64,  DV = 128, LDP = 3072, KOFF = 512,  VOFF = 1024; };
template <> struct MX<1> { static constexpr int NH = 8, DK = 128, DV = 256, LDP = 6144, KOFF = 1024, VOFF = 2048; };
template <> struct MX<2> { static constexpr int NH = 4, DK = 128, DV = 256, LDP = 3072, KOFF = 512,  VOFF = 1024; };
__device__ __forceinline__ s16x4 ds_tr(const LAS unsigned char* p) { return __builtin_bit_cast(s16x4, __builtin_amdgcn_ds_read_tr16_b64_v4i16((LAS v4i16_t*)p)); }
__device__ __forceinline__ bf16x8 tr_frag(const LAS unsigned char* base, int pitch, int k0, int n0, int lane) {
    const int g = lane >> 4, q = (lane & 15) >> 2, p = lane & 3;
    const LAS unsigned char* a = base + (k0 + 4 * g + q) * pitch + (n0 + 4 * p) * 2;
    const s16x4 r1 = ds_tr(a), r2 = ds_tr(a + 16 * pitch);
    bf16x8 f; f[0] = r1[0]; f[1] = r1[1]; f[2] = r1[2]; f[3] = r1[3]; f[4] = r2[0]; f[5] = r2[1]; f[6] = r2[2]; f[7] = r2[3]; return f;
}
__device__ __forceinline__ u32x4 scale_bf16x8(u32x4 v, float sc) {
    u32x4 o; o.x = pk2(bflo(v.x) * sc, bfhi(v.x) * sc); o.y = pk2(bflo(v.y) * sc, bfhi(v.y) * sc); o.z = pk2(bflo(v.z) * sc, bfhi(v.z) * sc); o.w = pk2(bflo(v.w) * sc, bfhi(v.w) * sc); return o;
}
__device__ __forceinline__ float ret_lg2gamma(int h) { return log2f(1.f - exp2f(-5.f - (float)h)); }

template <int MODE>
__device__ __forceinline__ void mix_phaseA(const Frame& F, unsigned char* ws, const int tid, const int lane) {
    typedef MX<MODE> C; constexpr int DK = C::DK, DV = C::DV, NH = C::NH, LDP = C::LDP, KP = DK * 2 + 32, VP = DV * 2 + 32, ETW = DV / 128, NDT = DK / 16;
    LAS unsigned char* ldsK = F.lds; LAS unsigned char* ldsV = F.lds + 128 * KP; LAS float* rsc = (LAS float*)(F.lds + 128 * KP + 128 * VP);
    const bf16* PB = (const bf16*)(ws + WS_PB); const bf16* KPP = (const bf16*)(ws + WS_KPP); float* UT = (float*)(ws + WS_UT);
    const float* GSC = (const float*)(ws + WS_SC); float* NLOC = (float*)(ws + WS_SC + 2 * MiB);
    const int w = F.wave, g = lane >> 4;
    for (int u = blockIdx.x; u < 2 * NH * NCH; u += F.G) {
        const int c = u % NCH, bh = u / NCH, h = bh % NH, b = bh / NH; const size_t row0 = (size_t)b * T + (size_t)c * CL;
        __syncthreads();
        if (tid < 128) { float sc = 1.f;
            if (MODE == 0) sc = __expf(GSC[(size_t)(1 * 16 + bh) * T + c * CL + tid] - GSC[(size_t)(2 * 16 + bh) * T + c * CL + 127]);
            if (MODE == 1) sc = exp2f((float)(127 - tid) * ret_lg2gamma(h));
            rsc[tid] = sc; }
        __syncthreads();
        for (int p = tid; p < 128 * DK / 8; p += NTHREADS) { const int r = p / (DK / 8), cp = p % (DK / 8);
            u32x4 v = (MODE == 2) ? *(const u32x4*)(KPP + (row0 + r) * 512 + h * 128 + cp * 8) : *(const u32x4*)(PB + (row0 + r) * LDP + C::KOFF + h * DK + cp * 8);
            if (MODE != 2) v = scale_bf16x8(v, rsc[r]);
            *(LAS u32x4*)(ldsK + r * KP + cp * 16) = v; }
        for (int p = tid; p < 128 * DV / 8; p += NTHREADS) { const int r = p / (DV / 8), cp = p % (DV / 8);
            *(LAS u32x4*)(ldsV + r * VP + cp * 16) = *(const u32x4*)(PB + (row0 + r) * LDP + C::VOFF + h * DV + cp * 8); }
        __syncthreads();
        f32x4 acc[ETW][NDT];
#pragma unroll
        for (int i = 0; i < ETW; ++i)
#pragma unroll
            for (int j = 0; j < NDT; ++j) acc[i][j] = (f32x4){0.f, 0.f, 0.f, 0.f};
#pragma unroll
        for (int ks = 0; ks < 4; ++ks) {
            bf16x8 af[ETW], bfv[NDT];
#pragma unroll
            for (int i = 0; i < ETW; ++i) af[i] = tr_frag(ldsV, VP, 32 * ks, (w * ETW + i) * 16, lane);
#pragma unroll
            for (int j = 0; j < NDT; ++j) bfv[j] = tr_frag(ldsK, KP, 32 * ks, j * 16, lane);
#pragma unroll
            for (int i = 0; i < ETW; ++i)
#pragma unroll
                for (int j = 0; j < NDT; ++j) acc[i][j] = __builtin_amdgcn_mfma_f32_16x16x32_bf16(af[i], bfv[j], acc[i][j], 0, 0, 0);
        }
        float* ut = UT + (size_t)u * DV * DK;
#pragma unroll
        for (int i = 0; i < ETW; ++i)
#pragma unroll
            for (int j = 0; j < NDT; ++j)
#pragma unroll
                for (int r = 0; r < 4; ++r) ut[(size_t)((w * ETW + i) * 16 + 4 * g + r) * DK + j * 16 + (lane & 15)] = acc[i][j][r];
        if (MODE == 0 && tid < 64) { float sacc = 0.f;
            for (int r = 0; r < 128; ++r) sacc += bf2f(*(const LAS unsigned short*)(ldsK + r * KP + tid * 2));
            NLOC[(size_t)u * 64 + tid] = sacc; }
    }
    __syncthreads();
}

template <int MODE>
__device__ __forceinline__ void mix_phaseB(const Frame& F, unsigned char* ws, const int tid) {
    typedef MX<MODE> C; constexpr int DK = C::DK, DV = C::DV, NH = C::NH, NEL = DV * DK, NBH = 2 * NH;
    const float* UT = (const float*)(ws + WS_UT); bf16* ST = (bf16*)(ws + WS_ST);
    const float* GSC = (const float*)(ws + WS_SC); const float* NLOC = (const float*)(ws + WS_SC + 2 * MiB); float* NPREV = (float*)(ws + WS_SC + 2 * MiB + 256 * 1024);
    float* MPREV = (float*)(ws + WS_SC + 2 * MiB + 512 * 1024); const float* DEC = (const float*)(ws + WS_SC + 3 * MiB);
    const int gtid = blockIdx.x * NTHREADS + tid, nthr = F.G * NTHREADS;
    for (int el = gtid; el < NBH * NEL; el += nthr) {
        const int bh = el / NEL, idx = el - bh * NEL, h = bh % NH, b = bh / NH;
        float S = 0.f, m = -1e30f;
        const float rdec = (MODE == 1) ? exp2f(128.f * ret_lg2gamma(h)) : 1.f;
#pragma unroll 1
        for (int c0 = 0; c0 < NCH; c0 += 8) {
            float uv[8];
#pragma unroll
            for (int i = 0; i < 8; ++i) uv[i] = UT[(size_t)(bh * NCH + c0 + i) * NEL + idx];
#pragma unroll
            for (int i = 0; i < 8; ++i) { const int c = c0 + i; const size_t u = (size_t)bh * NCH + c;
                ST[u * NEL + idx] = (bf16)f2bf(S);
                if (MODE == 0) { const float atot = GSC[(size_t)(0 * 16 + bh) * T + c * CL + 127], mloc = atot + GSC[(size_t)(2 * 16 + bh) * T + c * CL + 127];
                    const float mnew = fmaxf(atot + m, mloc), so = __expf(atot + m - mnew), sl = __expf(mloc - mnew);
                    if (idx == 0) MPREV[u] = m;
                    S = so * S + sl * uv[i]; m = mnew; }
                else if (MODE == 1) S = rdec * S + uv[i];
                else S = DEC[(size_t)(b * NCH + c) * 512 + h * 128 + (idx & 127)] * S + uv[i]; }
        }
    }
    if (MODE == 0) {
        for (int el = gtid; el < NBH * 64; el += nthr) { const int bh = el >> 6, d = el & 63; float S = 0.f, m = -1e30f;
            for (int c = 0; c < NCH; ++c) { const size_t u = (size_t)bh * NCH + c;
                const float atot = GSC[(size_t)(0 * 16 + bh) * T + c * CL + 127], mloc = atot + GSC[(size_t)(2 * 16 + bh) * T + c * CL + 127];
                const float mnew = fmaxf(atot + m, mloc), so = __expf(atot + m - mnew), sl = __expf(mloc - mnew);
                NPREV[u * 64 + d] = S; S = so * S + sl * NLOC[u * 64 + d]; m = mnew; } }
    }
}

template <int MODE>
__device__ __forceinline__ void mix_phaseC(const Frame& F, unsigned char* ws, const int tid, const int lane) {
    typedef MX<MODE> C; constexpr int DK = C::DK, DV = C::DV, NH = C::NH, LDP = C::LDP, VP = DV * 2 + 32, NET = DV / 16, NKS = DK / 32, DVT = NH * DV;
    LAS unsigned char* ldsV = F.lds; LAS float* tabs = (LAS float*)(F.lds + 128 * VP);
    const bf16* PB = (const bf16*)(ws + WS_PB); const bf16* ST = (const bf16*)(ws + WS_ST); float* ORAW = (float*)(ws + WS_ORAW);
    const float* GSC = (const float*)(ws + WS_SC); const float* NPREV = (const float*)(ws + WS_SC + 2 * MiB + 256 * 1024); const float* MPREV = (const float*)(ws + WS_SC + 2 * MiB + 512 * 1024);
    const int w = F.wave, g = lane >> 4, li = lane & 15;
    for (int u = blockIdx.x; u < 2 * NH * NCH; u += F.G) {
        const int c = u % NCH, bh = u / NCH, h = bh % NH, b = bh / NH; const size_t row0 = (size_t)b * T + (size_t)c * CL;
        const float lg = (MODE == 1) ? ret_lg2gamma(h) : 0.f;
        __syncthreads();
        for (int p = tid; p < 128 * DV / 8; p += NTHREADS) { const int r = p / (DV / 8), cp = p % (DV / 8);
            *(LAS u32x4*)(ldsV + r * VP + cp * 16) = *(const u32x4*)(PB + (row0 + r) * LDP + C::VOFF + h * DV + cp * 8); }
        if (MODE == 0 && tid < 128) { const float mp = MPREV[u]; const size_t gi = (size_t)bh * T + c * CL + tid;
            const float a = GSC[(size_t)(0 * 16) * T + gi], gg = GSC[(size_t)(1 * 16) * T + gi], cm = GSC[(size_t)(2 * 16) * T + gi];
            const float Mt = fmaxf(mp, cm);
            tabs[tid] = gg; tabs[128 + tid] = Mt; tabs[256 + tid] = __expf(mp - Mt) * 0.125f; tabs[384 + tid] = __expf(-(a + Mt)); }
        __syncthreads();
        const int tq = 16 * w + li;
        const bf16* qrow = PB + (row0 + tq) * LDP + h * DK;
        bf16x8 qf[NKS];
#pragma unroll
        for (int ks = 0; ks < NKS; ++ks) qf[ks] = *(const bf16x8*)(qrow + 32 * ks + 8 * g);
        f32x4 O[NET];
#pragma unroll
        for (int et = 0; et < NET; ++et) O[et] = (f32x4){0.f, 0.f, 0.f, 0.f};
        float den = 0.f;
        const float Mq = (MODE == 0) ? tabs[128 + tq] : 0.f;
        for (int jp = 0; jp <= (w >> 1); ++jp) {
            f32x4 p0 = (f32x4){0.f, 0.f, 0.f, 0.f}, p1 = (f32x4){0.f, 0.f, 0.f, 0.f};
            const bf16* k0p = PB + (row0 + 32 * jp + li) * LDP + C::KOFF + h * DK + 8 * g;
#pragma unroll
            for (int ks = 0; ks < NKS; ++ks) p0 = __builtin_amdgcn_mfma_f32_16x16x32_bf16(*(const bf16x8*)(k0p + 32 * ks), qf[ks], p0, 0, 0, 0);
            if (2 * jp + 1 <= w) {
#pragma unroll
                for (int ks = 0; ks < NKS; ++ks) p1 = __builtin_amdgcn_mfma_f32_16x16x32_bf16(*(const bf16x8*)(k0p + (size_t)16 * LDP + 32 * ks), qf[ks], p1, 0, 0, 0);
            }
#pragma unroll
            for (int r = 0; r < 4; ++r) {
                const int s0 = 32 * jp + 4 * g + r, s1 = s0 + 16;
                float f0, f1;
                if (MODE == 0) { f0 = __expf(tabs[s0] - Mq) * 0.125f; f1 = __expf(tabs[s1] - Mq) * 0.125f; }
                else if (MODE == 1) { f0 = exp2f((float)(tq - s0) * lg); f1 = exp2f((float)(tq - s1) * lg); }
                else { f0 = 1.f; f1 = 1.f; }
                p0[r] = (s0 <= tq) ? p0[r] * f0 : 0.f; p1[r] = (s1 <= tq) ? p1[r] * f1 : 0.f;
                den += p0[r] + p1[r];
            }
            bf16x8 af; { const unsigned a0 = pk2(p0[0], p0[1]), a1 = pk2(p0[2], p0[3]), a2 = pk2(p1[0], p1[1]), a3 = pk2(p1[2], p1[3]); u32x4 t4; t4.x = a0; t4.y = a1; t4.z = a2; t4.w = a3; af = __builtin_bit_cast(bf16x8, t4); }
#pragma unroll
            for (int et = 0; et < NET; ++et) O[et] = __builtin_amdgcn_mfma_f32_16x16x32_bf16(af, tr_frag(ldsV, VP, 32 * jp, 16 * et, lane), O[et], 0, 0, 0);
        }
        const float qs = (MODE == 0) ? tabs[256 + tq] : (MODE == 1) ? exp2f((float)(tq + 1) * lg) : 1.f;
        const bf16* st = ST + (size_t)u * DV * DK;
        float dint = 0.f;
#pragma unroll
        for (int ks = 0; ks < NKS; ++ks) {
            bf16x8 aq = qf[ks];
            if (MODE != 2) aq = __builtin_bit_cast(bf16x8, scale_bf16x8(__builtin_bit_cast(u32x4, qf[ks]), qs));
            if (MODE == 0) { const float* np = NPREV + (size_t)u * 64 + 32 * ks + 8 * g; const u32x4 qa = __builtin_bit_cast(u32x4, aq);
                dint += bflo(qa.x) * np[0] + bfhi(qa.x) * np[1] + bflo(qa.y) * np[2] + bfhi(qa.y) * np[3] + bflo(qa.z) * np[4] + bfhi(qa.z) * np[5] + bflo(qa.w) * np[6] + bfhi(qa.w) * np[7]; }
#pragma unroll
            for (int et = 0; et < NET; ++et) O[et] = __builtin_amdgcn_mfma_f32_16x16x32_bf16(aq, *(const bf16x8*)(st + (size_t)(16 * et + li) * DK + 32 * ks + 8 * g), O[et], 0, 0, 0);
        }
        float rd[4] = {1.f, 1.f, 1.f, 1.f};
        if (MODE == 0) {
            float dt = den + dint; dt += __shfl_xor(dt, 16); dt += __shfl_xor(dt, 32);
            LAS float* wsc = tabs + 512 + 16 * w;
            if (g == 0) wsc[li] = 1.f / fmaxf(fabsf(dt), tabs[384 + tq]);
            asm volatile("s_waitcnt lgkmcnt(0)" ::: "memory");
#pragma unroll
            for (int r = 0; r < 4; ++r) rd[r] = wsc[4 * g + r];
        }
        float* orow = ORAW + (row0 + 16 * w + 4 * g) * DVT + h * DV + li;
#pragma unroll
        for (int et = 0; et < NET; ++et)
#pragma unroll
            for (int r = 0; r < 4; ++r) orow[(size_t)r * DVT + 16 * et] = O[et][r] * rd[r];
    }
    __syncthreads();
}

#define IN(k) (lo <= (k) && (k) < hi)
#define SEAM(k) do { if ((k) + 1 < hi) xcd_barrier(bar, F.wave); } while (0)
#define INP(i) inp_ptr(F.lds, (i))
#define x_in INP(0)
#define ln_g INP(1)
#define ln_b INP(2)
#define WS_PTRS \
    float* HF = (float*)(ws + WS_HF); bf16* XB = (bf16*)(ws + WS_XB); float* ZF = (float*)(ws + WS_ZF); bf16* PB = (bf16*)(ws + WS_PB); \
    float* GB = (float*)(ws + WS_GB); float* LA = (float*)(ws + WS_LA); float* ORAW = (float*)(ws + WS_ORAW); bf16* YB = (bf16*)(ws + WS_YB); \
    bf16* ACT = (bf16*)(ws + WS_ACT); float* YS = (float*)(ws + WS_YS); bf16* XG = (bf16*)(ws + WS_XG); \
    int* LIST = (int*)(ws + WS_LIST); float* GW = (float*)(ws + WS_GW); \
    float* S5LB = (float*)(ws + WS_S5TAB); float* S5BB = (float*)(ws + WS_S5TAB + 32768); \
    (void)HF; (void)XB; (void)ZF; (void)PB; (void)GB; (void)LA; (void)ORAW; (void)YB; (void)ACT; (void)YS; (void)XG; (void)LIST; (void)GW; (void)S5LB; (void)S5BB;

template <int layer>
__device__ __forceinline__ void layer_body(const Frame& F, unsigned char* ws, unsigned* ctl, LAS int* TAB, const XcdBarrier& bar, const int lo, const int hi, float* d_out) {
    WS_PTRS
        const int pb = 1 + layer * 16;
        const float* hin = (layer == 0) ? x_in : HF;
        if (PHE(1) && IN(pb + 0)) {
            const bf16* Wt = (const bf16*)(ws + (layer == 0 ? WS_WT_ML_IN : layer == 1 ? WS_WT_RET_IN : layer == 2 ? WS_WT_GLA_IN : WS_WT_S5_IN));
            const int N = (layer == 0 || layer == 2) ? 3072 : (layer == 1 ? 6144 : 1024);
            pg8::DenseOrder S; S.init(XB, Wt, M, N, D, F.G, (int)blockIdx.x);
            pg8::EpiBf16 E{PB, N};
            pg8::gemm_phase<pg8::EpiBf16, pg8::DenseOrder, true, true>(F.lds, F.wave, D, S, E);
            if (layer == 0 && CH_ML) {
                const int lane = lane_id(), gt = blockIdx.x * NTHREADS + F.wave * 64 + lane;
                if (gt < 16 * NCH) { const int bh = gt / NCH, c = gt % NCH, b = bh >> 3, h = bh & 7; float a = 0.f, cm = -3.0e38f; float* GSC = (float*)(ws + WS_SC);
                    for (int l = 0; l < CL; ++l) { const int t = c * CL + l; const size_t row = (size_t)b * T + t;
                        a += log_sigmoidf_(GB[row * 16 + 8 + h]); const float gg = GB[row * 16 + h] - a; cm = fmaxf(cm, gg);
                        GSC[(size_t)(0 * 16 + bh) * T + t] = a; GSC[(size_t)(1 * 16 + bh) * T + t] = gg; GSC[(size_t)(2 * 16 + bh) * T + t] = cm; } }
            }
            SEAM(pb + 0);
        }
        if (layer == 0) {
            if (CH_ML) {
                if (IN(pb + 2)) { const int lane = lane_id(), tid = F.wave * 64 + lane; mix_phaseA<0>(F, ws, tid, lane); SEAM(pb + 2); }
                if (IN(pb + 3)) { const int lane = lane_id(), tid = F.wave * 64 + lane; mix_phaseB<0>(F, ws, tid); SEAM(pb + 3); }
                if (IN(pb + 4)) { const int lane = lane_id(), tid = F.wave * 64 + lane; mix_phaseC<0>(F, ws, tid, lane); SEAM(pb + 4); }
            } else
            if (IN(pb + 2) && !defined_SKIP_ML) { const int lane = lane_id(), tid = F.wave * 64 + lane; (void)tid;
                if (F.gw < 32) {
                    const int b = F.gw >> 4, h = (F.gw >> 1) & 7, eh = F.gw & 1, e = eh * 64 + lane;
                    float C[64];
#pragma unroll
                    for (int d = 0; d < 64; ++d) C[d] = 0.f;
                    float nl = 0.f, mst = -1e30f;
                    const bf16* prow = PB + (size_t)(b * T) * 3072;
                    const float* grow = GB + (size_t)(b * T) * 16;
                    for (int t = 0; t < T; ++t) {
                        const bf16* pr = prow + (size_t)t * 3072;
                        const float ql = bf2f(pr[h * 64 + lane]) * 0.125f, kl = bf2f(pr[512 + h * 64 + lane]), vv = bf2f(pr[1024 + h * 128 + e]);
                        const float ip = grow[t * 16 + h], fp = grow[t * 16 + 8 + h];
                        const float lf = log_sigmoidf_(fp);
                        const float mnew = fmaxf(lf + mst, ip);
                        const float fs = __expf(lf + mst - mnew), is = __expf(ip - mnew);
                        mst = mnew;
                        nl = fs * nl + is * kl;
                        const float den = wave_sum(nl * ql);
                        const float kv = is * vv; float num = 0.f;
#pragma unroll
                        for (int d = 0; d < 64; ++d) { const float kd = __builtin_bit_cast(float, __builtin_amdgcn_readlane(__builtin_bit_cast(int, kl), d)), qd = __builtin_bit_cast(float, __builtin_amdgcn_readlane(__builtin_bit_cast(int, ql), d));
                            C[d] = fs * C[d] + kv * kd; num += C[d] * qd; }
                        ORAW[(size_t)(b * T + t) * 1024 + h * 128 + e] = num / fmaxf(fabsf(den), __expf(-mnew));
                    }
                }
                SEAM(pb + 2);
            }
        } else if (layer == 1) {
            if (IN(pb + 1)) { const int lane = lane_id(), tid = F.wave * 64 + lane; (void)tid;
                for (int it = blockIdx.x * NTHREADS + tid; it < T * 64; it += F.G * NTHREADS) {
                    const int t = it >> 6, i = it & 63;
                    const float inv = exp2f(-(float)(2 * i) * (13.287712379549449f / 128.f));
                    float sn, cs; sincosf((float)t * inv, &sn, &cs);
                    for (int b = 0; b < 2; ++b) { bf16* pr = PB + (size_t)(b * T + t) * 6144;
                        for (int qk = 0; qk < 2; ++qk) { const float sc = qk ? 0.08838834764831845f : 1.f;
                            for (int h = 0; h < 8; ++h) { bf16* p = pr + qk * 1024 + h * 128 + i; const float t1 = bf2f(p[0]), t2 = bf2f(p[64]);
                                p[0] = (bf16)f2bf((t1 * cs - t2 * sn) * sc); p[64] = (bf16)f2bf((t1 * sn + t2 * cs) * sc); } } }
                }
                SEAM(pb + 1);
            }
            if (CH_RET) {
                if (IN(pb + 2)) { const int lane = lane_id(), tid = F.wave * 64 + lane; mix_phaseA<1>(F, ws, tid, lane); SEAM(pb + 2); }
                if (IN(pb + 3)) { const int lane = lane_id(), tid = F.wave * 64 + lane; mix_phaseB<1>(F, ws, tid); SEAM(pb + 3); }
                if (IN(pb + 4)) { const int lane = lane_id(), tid = F.wave * 64 + lane; mix_phaseC<1>(F, ws, tid, lane); SEAM(pb + 4); }
            } else
            if (IN(pb + 2) && !defined_SKIP_RET) { const int lane = lane_id(), tid = F.wave * 64 + lane; (void)tid;
                if (F.gw < 64) {
                    const int b = F.gw >> 5, h = (F.gw >> 2) & 7, e = (F.gw & 3) * 64 + lane;
                    const float gamma = 1.f - exp2f(-5.f - (float)h);
                    float S[128];
#pragma unroll
                    for (int d = 0; d < 128; ++d) S[d] = 0.f;
                    const bf16* prow = PB + (size_t)(b * T) * 6144;
                    for (int t = 0; t < T; ++t) {
                        const bf16* pr = prow + (size_t)t * 6144;
                        const float q0 = bf2f(pr[h * 128 + lane]), q1 = bf2f(pr[h * 128 + 64 + lane]), k0 = bf2f(pr[1024 + h * 128 + lane]), k1 = bf2f(pr[1024 + h * 128 + 64 + lane]);
                        const float vv = bf2f(pr[2048 + h * 256 + e]);
                        float o = 0.f;
#pragma unroll
                        for (int d = 0; d < 64; ++d) {
                            const float kd = __builtin_bit_cast(float, __builtin_amdgcn_readlane(__builtin_bit_cast(int, k0), d)), qd = __builtin_bit_cast(float, __builtin_amdgcn_readlane(__builtin_bit_cast(int, q0), d));
                            S[d] = gamma * S[d] + kd * vv; o += qd * S[d];
                            const float kd1 = __builtin_bit_cast(float, __builtin_amdgcn_readlane(__builtin_bit_cast(int, k1), d)), qd1 = __builtin_bit_cast(float, __builtin_amdgcn_readlane(__builtin_bit_cast(int, q1), d));
                            S[64 + d] = gamma * S[64 + d] + kd1 * vv; o += qd1 * S[64 + d]; }
                        ORAW[(size_t)(b * T + t) * 2048 + h * 256 + e] = o;
                    }
                }
                SEAM(pb + 2);
            }
        } else if (layer == 2) {
            if (CH_GLA) {
                if (IN(pb + 1)) {
                    const int lane = lane_id(), gt = blockIdx.x * NTHREADS + F.wave * 64 + lane;
                    if (gt < 2 * NCH * 512) { const int ch = gt & 511, bc = gt >> 9, b = bc / NCH, c = bc % NCH; const size_t row0 = (size_t)b * T + (size_t)c * CL;
                        bf16* KPP = (bf16*)(ws + WS_KPP); float* DEC = (float*)(ws + WS_SC + 3 * MiB);
                        float bend = 0.f;
#pragma unroll 8
                        for (int l = 0; l < CL; ++l) bend += LA[(row0 + l) * 512 + ch];
                        float bcum = 0.f;
#pragma unroll 8
                        for (int l = 0; l < CL; ++l) { bcum += LA[(row0 + l) * 512 + ch]; bf16* pr = PB + (row0 + l) * 3072;
                            const float qv = bf2f(pr[ch]), kv = bf2f(pr[512 + ch]) * 0.08838834764831845f;
                            pr[ch] = (bf16)f2bf(qv * __expf(bcum)); pr[512 + ch] = (bf16)f2bf(kv * __expf(-bcum)); KPP[(row0 + l) * 512 + ch] = (bf16)f2bf(kv * __expf(bend - bcum)); }
                        DEC[(size_t)bc * 512 + ch] = __expf(bend); }
                    SEAM(pb + 1);
                }
                if (IN(pb + 2)) { const int lane = lane_id(), tid = F.wave * 64 + lane; mix_phaseA<2>(F, ws, tid, lane); SEAM(pb + 2); }
                if (IN(pb + 3)) { const int lane = lane_id(), tid = F.wave * 64 + lane; mix_phaseB<2>(F, ws, tid); SEAM(pb + 3); }
                if (IN(pb + 4)) { const int lane = lane_id(), tid = F.wave * 64 + lane; mix_phaseC<2>(F, ws, tid, lane); SEAM(pb + 4); }
            } else
            if (IN(pb + 2) && !defined_SKIP_GLA) { const int lane = lane_id(), tid = F.wave * 64 + lane; (void)tid;
                if (F.gw < 32) {
                    const int b = F.gw >> 4, h = (F.gw >> 2) & 3, e = (F.gw & 3) * 64 + lane;
                    float S[128];
#pragma unroll
                    for (int d = 0; d < 128; ++d) S[d] = 0.f;
                    const bf16* prow = PB + (size_t)(b * T) * 3072;
                    const float* larow = LA + (size_t)(b * T) * 512;
                    for (int t = 0; t < T; ++t) {
                        const bf16* pr = prow + (size_t)t * 3072;
                        const float q0 = bf2f(pr[h * 128 + lane]), q1 = bf2f(pr[h * 128 + 64 + lane]);
                        const float k0 = bf2f(pr[512 + h * 128 + lane]) * 0.08838834764831845f, k1 = bf2f(pr[512 + h * 128 + 64 + lane]) * 0.08838834764831845f;
                        const float a0 = __expf(larow[(size_t)t * 512 + h * 128 + lane]), a1 = __expf(larow[(size_t)t * 512 + h * 128 + 64 + lane]);
                        const float vv = bf2f(pr[1024 + h * 256 + e]);
                        float o = 0.f;
#pragma unroll
                        for (int d = 0; d < 64; ++d) {
                            const float kd = __builtin_bit_cast(float, __builtin_amdgcn_readlane(__builtin_bit_cast(int, k0), d)), qd = __builtin_bit_cast(float, __builtin_amdgcn_readlane(__builtin_bit_cast(int, q0), d)), ad = __builtin_bit_cast(float, __builtin_amdgcn_readlane(__builtin_bit_cast(int, a0), d));
                            S[d] = ad * S[d] + kd * vv; o += qd * S[d];
                            const float kd1 = __builtin_bit_cast(float, __builtin_amdgcn_readlane(__builtin_bit_cast(int, k1), d)), qd1 = __builtin_bit_cast(float, __builtin_amdgcn_readlane(__builtin_bit_cast(int, q1), d)), ad1 = __builtin_bit_cast(float, __builtin_amdgcn_readlane(__builtin_bit_cast(int, a1), d));
                            S[64 + d] = ad1 * S[64 + d] + kd1 * vv; o += qd1 * S[64 + d]; }
                        ORAW[(size_t)(b * T + t) * 1024 + h * 256 + e] = o;
                    }
                }
                SEAM(pb + 2);
            }
        } else {
            if (IN(pb + 2) && !defined_SKIP_S5) { const int lane = lane_id(), tid = F.wave * 64 + lane; (void)tid;
                if (F.gw < 128) {
                    const int b = F.gw >> 6, g = F.gw & 63, p = lane;
                    const float* c_re = INP(20); const float* c_im = INP(21); const float* dsk = INP(22);
                    const float lbr = S5LB[(g * 64 + p) * 2], lbi = S5LB[(g * 64 + p) * 2 + 1];
                    float bbr[16], bbi[16], cr[16], ci[16];
#pragma unroll
                    for (int h = 0; h < 16; ++h) { bbr[h] = S5BB[((g * 64 + p) * 16 + h) * 2]; bbi[h] = S5BB[((g * 64 + p) * 16 + h) * 2 + 1]; cr[h] = c_re[(g * 16 + h) * 64 + p]; ci[h] = c_im[(g * 16 + h) * 64 + p]; }
                    const float dl = (lane < 16) ? dsk[g * 16 + lane] : 0.f;
                    float sr = 0.f, si = 0.f;
                    for (int t = 0; t < T; ++t) {
                        const size_t row = (size_t)(b * T + t);
                        const float ul = (lane < 16) ? bf2f(PB[row * 1024 + g * 16 + lane]) : 0.f;
                        float bur = 0.f, bui = 0.f;
#pragma unroll
                        for (int h = 0; h < 16; ++h) { const float uh = __builtin_bit_cast(float, __builtin_amdgcn_readlane(__builtin_bit_cast(int, ul), h)); bur += bbr[h] * uh; bui += bbi[h] * uh; }
                        const float nr = lbr * sr - lbi * si + bur, ni = lbr * si + lbi * sr + bui; sr = nr; si = ni;
                        float yl = 0.f;
#pragma unroll
                        for (int h = 0; h < 16; ++h) { const float yv = wave_sum(cr[h] * sr - ci[h] * si); yl = (lane == h) ? yv : yl; }
                        if (lane < 16) { const float y = yl + dl * ul; YB[row * 1024 + g * 16 + lane] = (bf16)f2bf(gelu_tanh(y)); }
                    }
                }
                SEAM(pb + 2);
            }
        }
        if (PHE(3) && layer < 3 && IN(pb + 5)) { const int lane = lane_id(), tid = F.wave * 64 + lane; (void)tid;
            const int nh = (layer == 2) ? 4 : 8, dv = (layer == 0) ? 128 : 256, DV = nh * dv, ldp = (layer == 1) ? 6144 : 3072, goff = (layer == 1) ? 4096 : 2048;
            const float* ng = INP(layer == 0 ? 5 : layer == 1 ? 8 : 13);
            for (int it = F.gw; it < M * nh; it += F.NGW) {
                const int row = it / nh, h = it - row * nh;
                const float* src = ORAW + (size_t)row * DV + h * dv;
                float xv[4]; const int per = dv / 64;
                float s = 0.f;
#pragma unroll
                for (int j = 0; j < 4; ++j) { xv[j] = (j < per) ? src[lane + 64 * j] : 0.f; s += xv[j]; }
                const float mean = wave_sum(s) / (float)dv; float s2 = 0.f;
#pragma unroll
                for (int j = 0; j < 4; ++j) { const float dlt = (j < per) ? xv[j] - mean : 0.f; s2 += dlt * dlt; }
                const float rstd = 1.f / sqrtf(wave_sum(s2) / (float)dv + LN_EPS);
#pragma unroll
                for (int j = 0; j < 4; ++j) if (j < per) { const int c = h * dv + lane + 64 * j; const float gt = bf2f(PB[(size_t)row * ldp + goff + c]);
                    const float gate = (layer == 0) ? sigmoidf_(gt) : gt * sigmoidf_(gt);
                    YB[(size_t)row * DV + c] = (bf16)f2bf(gate * (xv[j] - mean) * rstd * ng[c]); }
            }
            SEAM(pb + 5);
        }
        if (PHE(4) && layer == 3 && IN(pb + 6)) {
            pg8::DenseOrder S; S.init(YB, ws + WS_WT_S5_GLU, M, D, D, F.G, (int)blockIdx.x);
            pg8::EpiGlu E{YB, INP(25), (bf16*)ORAW};
            pg8::gemm_phase<pg8::EpiGlu, pg8::DenseOrder, true, true>(F.lds, F.wave, D, S, E);
            SEAM(pb + 6);
        }
        if (PHE(5) && IN(pb + 7)) {
            const bf16* Wt = (const bf16*)(ws + (layer == 0 ? WS_WT_ML_OUT : layer == 1 ? WS_WT_RET_OUT : layer == 2 ? WS_WT_GLA_OUT : WS_WT_S5_OUT));
            const int Kd = (layer == 1) ? 2048 : 1024;
            const bf16* Ain = (layer == 3) ? (const bf16*)ORAW : YB;
            pg8::DenseOrder S; S.init(Ain, Wt, M, D, Kd, F.G, (int)blockIdx.x);
            pg8::EpiResid E{hin, ZF};
            pg8::gemm_phase<pg8::EpiResid, pg8::DenseOrder, true, true>(F.lds, F.wave, Kd, S, E);
            SEAM(pb + 7);
        }
        unsigned* cnt = ctl + CW_CNT + layer * 32 * 64;
        if (IN(pb + 8) && !defined_SKIP_LN1) { const int lane = lane_id(), tid = F.wave * 64 + lane; (void)tid;
            LAS float* Wt = (LAS float*)(F.lds);
            { const float* wr_ = INP(27) + (size_t)layer * D * NEXP;
              for (int i = tid; i < D * NEXP; i += NTHREADS) { const int e = i & 31, k = i >> 5; Wt[e * 1028 + k] = wr_[i]; } }
            __syncthreads();
            const float* br_ = INP(28) + layer * NEXP;
            const float* lng_ = ln_g + (size_t)(layer * 2 + 0) * D; const float* lnb_ = ln_b + (size_t)(layer * 2 + 0) * D;
            for (int row = F.gw; row < M; row += F.NGW) {
                asm volatile("" ::: "memory");
                f32x4 v[4]; load_row_f32(ZF + (size_t)row * D, v, lane);
                { f32x4 gv[4], bv[4]; load_row_f32(lng_, gv, lane); load_row_f32(lnb_, bv, lane); ln_row(v, gv, bv); }
                store_row_f32(HF + (size_t)row * D, v, lane);
                store_row_bf16(XB + (size_t)row * D, v, lane);
                float lg[32];
#pragma unroll
                for (int e = 0; e < 32; ++e) { float s = 0.f;
#pragma unroll
                    for (int j = 0; j < 4; ++j) { const f32x4 w = *(const LAS f32x4*)(Wt + e * 1028 + 4 * (lane + 64 * j)); s += v[j][0] * w[0] + v[j][1] * w[1] + v[j][2] * w[2] + v[j][3] * w[3]; }
                    lg[e] = wave_sum(s) + br_[e]; }
                int te[4]; float tv[4];
#pragma unroll
                for (int k = 0; k < 4; ++k) { float best = -3.0e38f; int bi = 0;
#pragma unroll
                    for (int e = 0; e < 32; ++e) { const bool taken = (k > 0 && te[0] == e) || (k > 1 && te[1] == e) || (k > 2 && te[2] == e); if (!taken && lg[e] > best) { best = lg[e]; bi = e; } }
                    te[k] = bi; tv[k] = best; }
                const float e0 = 1.f, e1 = __expf(tv[1] - tv[0]), e2 = __expf(tv[2] - tv[0]), e3 = __expf(tv[3] - tv[0]), rs = 1.f / (e0 + e1 + e2 + e3);
                int pos = 0;
                if (lane < 4) { const int ek = lane == 0 ? te[0] : lane == 1 ? te[1] : lane == 2 ? te[2] : te[3]; const float gk = (lane == 0 ? e0 : lane == 1 ? e1 : lane == 2 ? e2 : e3) * rs;
                    pos = (int)__hip_atomic_fetch_add(cnt + ek * 64, 1u, __ATOMIC_RELAXED, __HIP_MEMORY_SCOPE_AGENT);
                    LIST[(size_t)ek * CAP + pos] = row * 4 + lane; GW[row * 4 + lane] = gk; }
#pragma unroll
                for (int k = 0; k < 4; ++k) { const int pk = __shfl(pos, k); store_row_bf16(XG + ((size_t)te[k] * CAP + pk) * D, v, lane); }
            }
            __syncthreads();
            SEAM(pb + 8);
        }
        if ((PHE(7) || PHE(8)) && (IN(pb + 9) || IN(pb + 10))) { const int lane = lane_id(), tid = F.wave * 64 + lane; (void)tid;
            __syncthreads();
            if (tid < 32) TAB[tid] = (int)__hip_atomic_load(cnt + tid * 64, __ATOMIC_RELAXED, __HIP_MEMORY_SCOPE_AGENT);
            __syncthreads();
            if (tid == 0) { int acc = 0; for (int e = 0; e < 32; ++e) { TAB[32 + e] = acc; const int nt_ = (TAB[e] + 255) >> 8; for (int j = 0; j < nt_; ++j) TAB[72 + acc + j] = e; acc += nt_; } TAB[64] = acc; }
            __syncthreads();
        }
        if (PHE(7) && IN(pb + 9)) {
            pg8::MoeOrder S; S.A = (const char*)XG; S.Bt = (const char*)(ws + WS_WT_GU + (size_t)layer * 32 * 2048 * 1024 * 2); S.tab = TAB; S.K = D; S.nN = 8; S.ntiles = __builtin_amdgcn_readfirstlane(TAB[64]); S.nwg = S.ntiles * 8; S.G = F.G; S.c = (int)blockIdx.x;
            S.b_estride = (size_t)2048 * 1024 * 2; S.a_compact = 0;
            pg8::EpiSwiglu E{ACT, INP(30) + (size_t)layer * 32 * 2048};
            pg8::gemm_phase<pg8::EpiSwiglu, pg8::MoeOrder, true, true>(F.lds, F.wave, D, S, E);
            SEAM(pb + 9);
        }
        if (PHE(8) && IN(pb + 10)) {
            pg8::MoeOrder S; S.A = (const char*)ACT; S.Bt = (const char*)(ws + WS_WT_DN + (size_t)layer * 32 * 1024 * 1024 * 2); S.tab = TAB; S.K = DFF; S.nN = 4; S.ntiles = __builtin_amdgcn_readfirstlane(TAB[64]); S.nwg = S.ntiles * 4; S.G = F.G; S.c = (int)blockIdx.x;
            S.b_estride = (size_t)1024 * 1024 * 2; S.a_compact = 1;
            pg8::EpiMoeDown E{YS, INP(32) + (size_t)layer * 32 * 1024, LIST, GW, TAB};
            pg8::gemm_phase<pg8::EpiMoeDown, pg8::MoeOrder, true, true>(F.lds, F.wave, DFF, S, E);
            SEAM(pb + 10);
        }
        if (PHE(9) && IN(pb + 11)) { const int lane = lane_id(), tid = F.wave * 64 + lane; (void)tid;
            LAS float* Wt = (LAS float*)(F.lds);
            if (layer == 1) { load_cols16(tid, INP(10), 3088, 3072, Wt); __syncthreads(); }
            const float* lng_ = ln_g + (size_t)(layer * 2 + 1) * D; const float* lnb_ = ln_b + (size_t)(layer * 2 + 1) * D;
            float* outp = (layer == 3) ? d_out : HF;
            for (int row = F.gw; row < M; row += F.NGW) {
                asm volatile("" ::: "memory");
                f32x4 v[4], y[4]; load_row_f32(HF + (size_t)row * D, v, lane);
#pragma unroll
                for (int j = 0; j < 4; ++j) v[j] = v[j] * ALPHA;
#pragma unroll
                for (int k = 0; k < 4; ++k) { load_row_f32(YS + ((size_t)row * 4 + k) * D, y, lane);
#pragma unroll
                    for (int j = 0; j < 4; ++j) v[j] = v[j] + y[j]; }
                { f32x4 gv[4], bv[4]; load_row_f32(lng_, gv, lane); load_row_f32(lnb_, bv, lane); ln_row(v, gv, bv); }
                store_row_f32(outp + (size_t)row * D, v, lane);
                if (layer < 3) store_row_bf16(XB + (size_t)row * D, v, lane);
                if (layer == 1) {
                    float z[16]; row_dot16(v, Wt, lane, z);
                    if (lane < 16) { float o = 0.f;
#pragma unroll
                        for (int e = 0; e < 16; ++e) o = (lane == e) ? z[e] : o;
                        GB[(size_t)row * 16 + lane] = o; }
                }
            }
            if (layer == 1) {
                __syncthreads();
                const float* wgp = INP(11); const float bgc = INP(12)[tid];
                float wg[16];
#pragma unroll
                for (int r = 0; r < 16; ++r) wg[r] = wgp[r * 512 + tid];
                for (int row = F.vcu * NWAVES; row < M; row += F.NGW) {
#pragma unroll 1
                    for (int w = 0; w < NWAVES; ++w) { const float* zr = GB + (size_t)(row + w) * 16; float sacc = bgc;
#pragma unroll
                        for (int r = 0; r < 16; ++r) sacc += zr[r] * wg[r];
                        LA[(size_t)(row + w) * 512 + tid] = log_sigmoidf_(sacc) * (1.f / 16.f); }
                }
            }
            __syncthreads();
            SEAM(pb + 11);
        }
}
__global__ void __launch_bounds__(NTHREADS, 2) mega_fwd(Args args) {
    extern __shared__ __attribute__((aligned(16))) unsigned char lds_raw[];
    Frame F;
    F.lds = (LAS unsigned char*)lds_raw;
    F.wave = __builtin_amdgcn_readfirstlane((int)threadIdx.x >> 6);
    F.G = gridDim.x; { const int bx = blockIdx.x; F.vcu = (F.G % 8 == 0) ? (bx % 8) * (F.G / 8) + bx / 8 : bx; }
    F.gw = F.vcu * NWAVES + F.wave; F.NGW = F.G * NWAVES;
    unsigned char* ws = args.ws;
    unsigned* ctl = (unsigned*)(ws + WS_CTL);
    volatile LAS unsigned* MISC = (volatile LAS unsigned*)(F.lds + MISC_OFF);
    LAS int* TAB = (LAS int*)(F.lds + TAB_OFF);
    { const int tid0 = threadIdx.x;
      if (tid0 < 64) MISC[tid0] = 0u;
      if (tid0 < 33) ((LAS unsigned long long*)(F.lds + MISC_OFF + 256))[tid0] = (unsigned long long)args.in[tid0]; }
    __syncthreads();
    XcdBarrier bar = xcd_barrier_post(ctl + CW_BAR, MISC + 8, F.wave == 0 && lane_id() == 0);
    const int lo = args.ph_lo, hi = args.ph_hi;
    WS_PTRS
    if (IN(0) && !defined_SKIP_P0) { const int lane = lane_id(), tid = F.wave * 64 + lane; (void)tid;
        LAS unsigned char* scr = F.lds + F.wave * 8704;
#define TR_MAT(src_, ldw_, K_, N_, dst_, mode_, count_, sstride_, dstride_) do { \
            const int nkb = (K_) / 64, nnb = (N_) / 64, per = nkb * nnb, total = per * (count_); \
            _Pragma("unroll 1") for (int it = F.gw; it < total; it += F.NGW) { \
                const int q = it / per, r = it - q * per, kb = r / nnb, nb = r - kb * nnb; \
                transpose_item((src_) + (size_t)q * (sstride_), (ldw_), 0, (K_), (dst_) + (size_t)q * (dstride_), (mode_), kb, nb, scr, lane); } } while (0)
        TR_MAT(INP(29), 2048, 1024, 2048, (bf16*)(ws + WS_WT_GU), 1, 128, (size_t)1024 * 2048, (size_t)2048 * 1024);
        TR_MAT(INP(31), 1024, 1024, 1024, (bf16*)(ws + WS_WT_DN), 0, 128, (size_t)1024 * 1024, (size_t)1024 * 1024);
        TR_MAT(INP(3), 3088, 1024, 3072, (bf16*)(ws + WS_WT_ML_IN), 0, 1, (size_t)0, (size_t)0);
        TR_MAT(INP(6), 1024, 1024, 1024, (bf16*)(ws + WS_WT_ML_OUT), 0, 1, (size_t)0, (size_t)0);
        TR_MAT(INP(7), 6144, 1024, 6144, (bf16*)(ws + WS_WT_RET_IN), 0, 1, (size_t)0, (size_t)0);
        TR_MAT(INP(9), 1024, 2048, 1024, (bf16*)(ws + WS_WT_RET_OUT), 0, 1, (size_t)0, (size_t)0);
        TR_MAT(INP(10), 3088, 1024, 3072, (bf16*)(ws + WS_WT_GLA_IN), 0, 1, (size_t)0, (size_t)0);
        TR_MAT(INP(14), 1024, 1024, 1024, (bf16*)(ws + WS_WT_GLA_OUT), 0, 1, (size_t)0, (size_t)0);
        TR_MAT(INP(15), 1024, 1024, 1024, (bf16*)(ws + WS_WT_S5_IN), 0, 1, (size_t)0, (size_t)0);
        TR_MAT(INP(24), 1024, 1024, 1024, (bf16*)(ws + WS_WT_S5_GLU), 0, 1, (size_t)0, (size_t)0);
        TR_MAT(INP(26), 1024, 1024, 1024, (bf16*)(ws + WS_WT_S5_OUT), 0, 1, (size_t)0, (size_t)0);
#undef TR_MAT
        __syncthreads();
        {
            const float* lam_re = INP(16); const float* lam_im = INP(17); const float* b_re = INP(18); const float* b_im = INP(19); const float* log_dt = INP(23);
            for (int i = blockIdx.x * NTHREADS + tid; i < 64 * 64; i += F.G * NTHREADS) {
                const int g = i >> 6;
                const float lr = lam_re[i], li = lam_im[i], dt = expf(log_dt[g]);
                const float er = expf(lr * dt); float sn, cs; sincosf(li * dt, &sn, &cs);
                const float br = er * cs, bi = er * sn;
                S5LB[2 * i] = br; S5LB[2 * i + 1] = bi;
                const float nr = br - 1.f, ni = bi, den = lr * lr + li * li;
                const float fr_ = (nr * lr + ni * li) / den, fi_ = (ni * lr - nr * li) / den;
                for (int h = 0; h < 16; ++h) { const float xr = b_re[i * 16 + h], xi = b_im[i * 16 + h];
                    S5BB[(i * 16 + h) * 2] = fr_ * xr - fi_ * xi; S5BB[(i * 16 + h) * 2 + 1] = fr_ * xi + fi_ * xr; }
            }
        }
        LAS float* Wt = (LAS float*)(F.lds);
        load_cols16(tid, INP(3), 3088, 3072, Wt);
        __syncthreads();
        {
            const float* bg = INP(4);
            for (int row = F.gw; row < M; row += F.NGW) {
                asm volatile("" ::: "memory");
                f32x4 v[4]; load_row_f32(x_in + (size_t)row * D, v, lane);
                store_row_bf16(XB + (size_t)row * D, v, lane);
                float g[16]; row_dot16(v, Wt, lane, g);
                if (lane < 16) { float o = 0.f;
#pragma unroll
                    for (int e = 0; e < 16; ++e) o = (lane == e) ? g[e] : o;
                    GB[(size_t)row * 16 + lane] = o + bg[lane]; }
            }
        }
        __syncthreads();
        SEAM(0);
    }

    layer_body<0>(F, ws, ctl, TAB, bar, lo, hi, args.out);
    layer_body<1>(F, ws, ctl, TAB, bar, lo, hi, args.out);
    layer_body<2>(F, ws, ctl, TAB, bar, lo, hi, args.out);
    layer_body<3>(F, ws, ctl, TAB, bar, lo, hi, args.out);
#undef IN
#undef SEAM
#undef INP
#undef x_in
#undef ln_g
#undef ln_b
}

extern "C" void kernel_launch(void* const* d_in, const int* in_sizes, int n_in, void* d_out, int out_size, void* d_ws, size_t ws_size, hipStream_t stream) {
    static int grid = 0;
    if (grid == 0) {
        if (n_in != 33 || out_size != M * D || ws_size < WS_END) { fprintf(stderr, "kernel_launch: unexpected problem (n_in %d, out %d, ws %zu < %zu)\n", n_in, out_size, ws_size, (size_t)WS_END); grid = -1; return; }
        int dev = 0, cus = 0, per_cu = 0;
        if (hipGetDevice(&dev) != hipSuccess || hipDeviceGetAttribute(&cus, hipDeviceAttributeMultiprocessorCount, dev) != hipSuccess) { grid = -1; return; }
        if (hipFuncSetAttribute((const void*)mega_fwd, hipFuncAttributeMaxDynamicSharedMemorySize, LDS_BYTES) != hipSuccess) { fprintf(stderr, "kernel_launch: hipFuncSetAttribute failed\n"); grid = -1; return; }
        if (hipOccupancyMaxActiveBlocksPerMultiprocessor(&per_cu, (const void*)mega_fwd, NTHREADS, LDS_BYTES) != hipSuccess || per_cu < 1) { fprintf(stderr, "kernel_launch: occupancy query says %d\n", per_cu); }
        (void)hipGetLastError();
        grid = cus;
    }
    if (grid < 0) return;
    hipMemsetAsync((char*)d_ws + WS_CTL, 0, CTL_ZERO_BYTES, stream);
    Args a{};
    for (int i = 0; i < 33; ++i) a.in[i] = (const float*)d_in[i];
    a.out = (float*)d_out; a.ws = (unsigned char*)d_ws;
#if N_LAUNCH_MODE == 1
    a.ph_lo = 0; a.ph_hi = 1000;
    hipLaunchKernelGGL(mega_fwd, dim3(grid), dim3(NTHREADS), LDS_BYTES, stream, a);
#else
    for (int ph = 0; ph < 65; ++ph) { a.ph_lo = ph; a.ph_hi = ph + 1; hipLaunchKernelGGL(mega_fwd, dim3(grid), dim3(NTHREADS), LDS_BYTES, stream, a); }
#endif
}
```

```cpp
#include <hip/hip_runtime.h>
#include <cstdio>
#include <cstdint>

#ifndef NAIVE_MIX
#define NAIVE_MIX 1
#endif
#ifndef CH_ML
#define CH_ML 1
#endif
#ifndef CH_RET
#define CH_RET 1
#endif
#ifndef CH_GLA
#define CH_GLA 1
#endif
#ifndef CH_S5
#define CH_S5 1
#endif
#ifndef N_LAUNCH_MODE
#define N_LAUNCH_MODE 1
#endif


#ifdef SKIP_ML
constexpr bool defined_SKIP_ML = true;
#else
constexpr bool defined_SKIP_ML = false;
#endif
#ifdef SKIP_RET
constexpr bool defined_SKIP_RET = true;
#else
constexpr bool defined_SKIP_RET = false;
#endif
#ifdef SKIP_GLA
constexpr bool defined_SKIP_GLA = true;
#else
constexpr bool defined_SKIP_GLA = false;
#endif
#ifdef SKIP_S5
constexpr bool defined_SKIP_S5 = true;
#else
constexpr bool defined_SKIP_S5 = false;
#endif
#ifdef SKIP_LN1
constexpr bool defined_SKIP_LN1 = true;
#else
constexpr bool defined_SKIP_LN1 = false;
#endif
#ifdef SKIP_P0
constexpr bool defined_SKIP_P0 = true;
#else
constexpr bool defined_SKIP_P0 = false;
#endif
#ifndef PHMASK
#define PHMASK 0xffff
#endif
#define PHE(b) (((PHMASK) >> (b)) & 1)
#define GAS __attribute__((address_space(1)))
#define LAS __attribute__((address_space(3)))
typedef unsigned short bf16;
typedef short bf16x8 __attribute__((ext_vector_type(8)));
typedef float f32x4 __attribute__((ext_vector_type(4)));
typedef float f32x2 __attribute__((ext_vector_type(2)));
typedef unsigned u32x4 __attribute__((ext_vector_type(4)));
typedef unsigned u32x2 __attribute__((ext_vector_type(2)));

constexpr int BATCH = 2, T = 8192, D = 1024, M = BATCH * T;
constexpr int NEXP = 32, TOPK = 4, DFF = 1024, CAP = M;
constexpr int NWAVES = 8, NTHREADS = 512;
constexpr float LN_EPS = 1e-5f;
constexpr float ALPHA = 1.681792830507429f;
constexpr int MAXTILES = (M * TOPK) / 256 + NEXP;

constexpr size_t MiB = 1u << 20;
constexpr size_t WS_CTL = 0, CTL_ZERO_BYTES = 1 * MiB;
constexpr size_t WS_WT_ML_IN = 1 * MiB;
constexpr size_t WS_WT_ML_OUT = WS_WT_ML_IN + 6 * MiB;
constexpr size_t WS_WT_RET_IN = WS_WT_ML_OUT + 2 * MiB;
constexpr size_t WS_WT_RET_OUT = WS_WT_RET_IN + 12 * MiB;
constexpr size_t WS_WT_GLA_IN = WS_WT_RET_OUT + 4 * MiB;
constexpr size_t WS_WT_GLA_OUT = WS_WT_GLA_IN + 6 * MiB;
constexpr size_t WS_WT_S5_IN = WS_WT_GLA_OUT + 2 * MiB;
constexpr size_t WS_WT_S5_GLU = WS_WT_S5_IN + 2 * MiB;
constexpr size_t WS_WT_S5_OUT = WS_WT_S5_GLU + 2 * MiB;
constexpr size_t WS_S5TAB = WS_WT_S5_OUT + 2 * MiB;
constexpr size_t WS_GB = WS_S5TAB + 1 * MiB;
constexpr size_t WS_LIST = WS_GB + 1 * MiB;
constexpr size_t WS_GW = WS_LIST + 2 * MiB;
constexpr size_t WS_WT_GU = WS_GW + 1 * MiB;
constexpr size_t WS_WT_DN = WS_WT_GU + 512 * MiB;
constexpr size_t WS_HF = WS_WT_DN + 256 * MiB;
constexpr size_t WS_XB = WS_HF + 64 * MiB;
constexpr size_t WS_ZF = WS_XB + 32 * MiB;
constexpr size_t WS_PB = WS_ZF + 64 * MiB;
constexpr size_t WS_LA = WS_PB + 192 * MiB;
constexpr size_t WS_ORAW = WS_LA + 32 * MiB;
constexpr size_t WS_YB = WS_ORAW + 128 * MiB;
constexpr size_t WS_ACT = WS_YB + 64 * MiB;
constexpr size_t WS_YS = WS_ACT + 144 * MiB;
constexpr size_t WS_XG = WS_YS + 256 * MiB;
constexpr size_t WS_UT = WS_XG + 1024 * MiB;
constexpr size_t WS_ST = WS_UT + 128 * MiB;
constexpr size_t WS_KPP = WS_ST + 64 * MiB;
constexpr size_t WS_SC = WS_KPP + 16 * MiB;
constexpr size_t WS_S5KT = WS_SC + 4 * MiB;
constexpr size_t WS_S5VT = WS_S5KT + 2 * MiB;
constexpr size_t WS_S5WT = WS_S5VT + 16 * MiB;
constexpr size_t WS_S5L64 = WS_S5WT + 16 * MiB;
constexpr size_t WS_S5SL = WS_S5L64 + 1 * MiB;
constexpr size_t WS_S5SP = WS_S5SL + 16 * MiB;
constexpr size_t WS_END = WS_S5SP + 8 * MiB;
constexpr int CW_BAR = 4096;
constexpr int CW_CNT = 16384;

constexpr int PH_BYTES = 139264;
constexpr int TAB_OFF = PH_BYTES;
constexpr int MISC_OFF = TAB_OFF + 4096;
constexpr int LDS_BYTES = 147456;

__device__ __forceinline__ unsigned f2bf(float f) { unsigned u = __builtin_bit_cast(unsigned, f); return (u + 0x7fffu + ((u >> 16) & 1u)) >> 16; }
__device__ __forceinline__ unsigned pk2(float lo, float hi) { return f2bf(lo) | (f2bf(hi) << 16); }
__device__ __forceinline__ float bf2f(unsigned short b) { return __builtin_bit_cast(float, ((unsigned)b) << 16); }
__device__ __forceinline__ float bflo(unsigned w) { return __builtin_bit_cast(float, w << 16); }
__device__ __forceinline__ float bfhi(unsigned w) { return __builtin_bit_cast(float, w & 0xffff0000u); }
__device__ __forceinline__ int lane_id() { int l; asm volatile("v_mbcnt_lo_u32_b32 %0, -1, 0\n\tv_mbcnt_hi_u32_b32 %0, -1, %0" : "=v"(l)); return l; }
__device__ __forceinline__ float wave_sum(float v) {
#pragma unroll
    for (int o = 1; o < 64; o <<= 1) v += __shfl_xor(v, o);
    return v;
}
__device__ __forceinline__ float sigmoidf_(float x) { return 1.f / (1.f + __expf(-x)); }
__device__ __forceinline__ float log_sigmoidf_(float x) { return fminf(x, 0.f) - log1pf(__expf(-fabsf(x))); }
__device__ __forceinline__ float gelu_tanh(float x) { const float u = 0.7978845608028654f * (x + 0.044715f * x * x * x); return 0.5f * x * (1.f + tanhf(u)); }

namespace pg8 {
constexpr int BM = 256, BK = 64, HALF = 128, HTB = HALF * BK * 2, STAGE_BYTES = 8 * HTB, NXCD = 8, WGM = 8;
__host__ __device__ __forceinline__ int lds_byte(int r, int c) { const int st = (r >> 4) * 2 + (c >> 5), rr = r & 15, cc = c & 31, ob = rr * 64 + cc * 2; return st * 1024 + (ob ^ (((ob >> 9) & 1) << 5)); }
__host__ __device__ __forceinline__ void stage_rc(int b, int& R, int& C) { const int st = b / 1024, sb = b % 1024, swz = sb ^ (((sb >> 9) & 1) << 5); R = (st >> 1) * 16 + swz / 64; C = (st & 1) * 32 + (swz % 64) / 2; }
__host__ __device__ __forceinline__ int perm32(int rho) { const int n = rho >> 4, i = rho & 15; return 8 * (i >> 2) + 4 * n + (i & 3); }

struct Unit { const char* A; const char* B; int pm, pn, e, nvalid; };

__device__ __forceinline__ int xcd_remap(int L, int nwg) { const int q = nwg / NXCD, r = nwg % NXCD, xcd = L % NXCD, off = L / NXCD; return (xcd < r ? xcd * (q + 1) : r * (q + 1) + (xcd - r) * q) + off; }

struct DenseOrder {
    const char* A; const char* Bt; int K, nM, nN, nwg, G, c;
    __device__ __forceinline__ void init(const void* A_, const void* Bt_, int M_, int N_, int K_, int G_, int c_) { A = (const char*)A_; Bt = (const char*)Bt_; K = K_; nM = M_ / BM; nN = N_ / BM; nwg = nM * nN; G = G_; c = c_; }
    __device__ __forceinline__ bool next(int i, Unit& u) const {
        const long L = (long)i * G + c; if (L >= nwg) return false;
        const int wgid = xcd_remap((int)L, nwg);
        const int nig = WGM * nN, gid = wgid / nig, fm = gid * WGM, gsz = (nM - fm) < WGM ? (nM - fm) : WGM;
        u.pm = fm + ((wgid % nig) % gsz); u.pn = (wgid % nig) / gsz; u.e = 0; u.nvalid = 256;
        u.A = A + (size_t)u.pm * 256 * K * 2; u.B = Bt + (size_t)u.pn * 256 * K * 2; return true;
    }
};
struct MoeOrder {
    const char* A; const char* Bt; const LAS int* tab;
    int K, nN, ntiles, nwg, G, c; size_t b_estride; int a_compact;
    __device__ __forceinline__ bool next(int i, Unit& u) const {
        const long L = (long)i * G + c; if (L >= nwg) return false;
        const int wgid = xcd_remap((int)L, nwg);
        const int nig = WGM * nN, gid = wgid / nig, fm = gid * WGM, gsz = (ntiles - fm) < WGM ? (ntiles - fm) : WGM;
        const int tl = fm + ((wgid % nig) % gsz); u.pm = tl; u.pn = (wgid % nig) / gsz;
        const int e = __builtin_amdgcn_readfirstlane(tab[72 + tl]); u.e = e; const int r0 = (tl - __builtin_amdgcn_readfirstlane(tab[32 + e])) * 256; const int rem = __builtin_amdgcn_readfirstlane(tab[e]) - r0; u.nvalid = rem < 256 ? rem : 256;
        u.A = a_compact ? A + (size_t)tl * 256 * K * 2 : A + ((size_t)e * CAP + r0) * K * 2;
        u.B = Bt + (size_t)e * b_estride + (size_t)u.pn * 256 * K * 2; return true;
    }
};

__device__ __forceinline__ unsigned cvt_pk_bf16(float lo, float hi) { unsigned r; asm volatile("v_cvt_pk_bf16_f32 %0, %1, %2" : "=v"(r) : "v"(lo), "v"(hi)); return r; }

struct EpiBf16 {
    static constexpr bool PERM = true;
    bf16* O; int ldc;
    __device__ __forceinline__ void operator()(const f32x4 (&acc)[2][2][4][2], const Unit& u, int wr, int wc, int fr, int fq) const {
        const int row0 = u.pm * BM + wr * 64 + fr, col0 = u.pn * BM + wc * 32 + 8 * fq;
#pragma unroll
        for (int ai = 0; ai < 2; ++ai)
#pragma unroll
            for (int m = 0; m < 4; ++m) { bf16* rowp = O + (size_t)(row0 + ai * HALF + m * 16) * ldc + col0;
#pragma unroll
                for (int bj = 0; bj < 2; ++bj) { const f32x4 v0 = acc[ai][bj][m][0], v1 = acc[ai][bj][m][1];
                    u32x4 w; w.x = cvt_pk_bf16(v0[0], v0[1]); w.y = cvt_pk_bf16(v0[2], v0[3]); w.z = cvt_pk_bf16(v1[0], v1[1]); w.w = cvt_pk_bf16(v1[2], v1[3]);
                    *(u32x4*)(rowp + bj * HALF) = w; } }
    }
};
struct EpiResid {
    static constexpr bool PERM = false;
    const float* hin; float* Z;
    __device__ __forceinline__ void operator()(const f32x4 (&acc)[2][2][4][2], const Unit& u, int wr, int wc, int fr, int fq) const {
        const int row0 = u.pm * BM + wr * 64 + fr, col0 = u.pn * BM + wc * 32 + 4 * fq;
#pragma unroll
        for (int ai = 0; ai < 2; ++ai)
#pragma unroll
            for (int m = 0; m < 4; ++m) { const size_t off = (size_t)(row0 + ai * HALF + m * 16) * D + col0;
#pragma unroll
                for (int bj = 0; bj < 2; ++bj)
#pragma unroll
                    for (int n = 0; n < 2; ++n) { const f32x4 hv = *(const f32x4*)(hin + off + bj * HALF + n * 16); *(f32x4*)(Z + off + bj * HALF + n * 16) = hv * ALPHA + acc[ai][bj][m][n]; } }
    }
};
struct EpiGlu {
    static constexpr bool PERM = true;
    const bf16* Y; const float* bias; bf16* O;
    __device__ __forceinline__ void operator()(const f32x4 (&acc)[2][2][4][2], const Unit& u, int wr, int wc, int fr, int fq) const {
        const int row0 = u.pm * BM + wr * 64 + fr, col0 = u.pn * BM + wc * 32 + 8 * fq;
#pragma unroll
        for (int ai = 0; ai < 2; ++ai)
#pragma unroll
            for (int m = 0; m < 4; ++m) { const size_t off = (size_t)(row0 + ai * HALF + m * 16) * D + col0;
#pragma unroll
                for (int bj = 0; bj < 2; ++bj) {
                    const f32x4 b0 = *(const f32x4*)(bias + col0 + bj * HALF), b1 = *(const f32x4*)(bias + col0 + bj * HALF + 4);
                    const u32x4 yw = *(const u32x4*)(Y + off + bj * HALF);
                    const f32x4 v0 = acc[ai][bj][m][0] + b0, v1 = acc[ai][bj][m][1] + b1;
                    float o[8];
                    o[0] = bflo(yw.x) * sigmoidf_(v0[0]); o[1] = bfhi(yw.x) * sigmoidf_(v0[1]); o[2] = bflo(yw.y) * sigmoidf_(v0[2]); o[3] = bfhi(yw.y) * sigmoidf_(v0[3]);
                    o[4] = bflo(yw.z) * sigmoidf_(v1[0]); o[5] = bfhi(yw.z) * sigmoidf_(v1[1]); o[6] = bflo(yw.w) * sigmoidf_(v1[2]); o[7] = bfhi(yw.w) * sigmoidf_(v1[3]);
                    u32x4 w; w.x = cvt_pk_bf16(o[0], o[1]); w.y = cvt_pk_bf16(o[2], o[3]); w.z = cvt_pk_bf16(o[4], o[5]); w.w = cvt_pk_bf16(o[6], o[7]);
                    *(u32x4*)(O + off + bj * HALF) = w; } }
    }
};
struct EpiSwiglu {
    static constexpr bool PERM = true;
    bf16* ACT; const float* bgu;
    __device__ __forceinline__ void operator()(const f32x4 (&acc)[2][2][4][2], const Unit& u, int wr, int wc, int fr, int fq) const {
        const int row0 = u.pm * BM + wr * 64 + fr, j0 = u.pn * HALF + wc * 32 + 8 * fq;
        const float* bg = bgu + (size_t)u.e * 2 * DFF + j0;
        const f32x4 g0 = *(const f32x4*)(bg), g1 = *(const f32x4*)(bg + 4), u0 = *(const f32x4*)(bg + DFF), u1 = *(const f32x4*)(bg + DFF + 4);
#pragma unroll
        for (int ai = 0; ai < 2; ++ai)
#pragma unroll
            for (int m = 0; m < 4; ++m) {
                float o[8];
#pragma unroll
                for (int n = 0; n < 2; ++n)
#pragma unroll
                    for (int i = 0; i < 4; ++i) {
                        float g = acc[ai][0][m][n][i] + (n ? g1[i] : g0[i]), up = acc[ai][1][m][n][i] + (n ? u1[i] : u0[i]);
                        g = fminf(g, 7.0f); up = fminf(fmaxf(up, -7.0f), 7.0f);
                        o[n * 4 + i] = (up + 1.0f) * g * sigmoidf_(1.702f * g); }
                u32x4 w; w.x = cvt_pk_bf16(o[0], o[1]); w.y = cvt_pk_bf16(o[2], o[3]); w.z = cvt_pk_bf16(o[4], o[5]); w.w = cvt_pk_bf16(o[6], o[7]);
                *(u32x4*)(ACT + (size_t)(row0 + ai * HALF + m * 16) * DFF + j0) = w; }
    }
};
struct EpiMoeDown {
    static constexpr bool PERM = false;
    float* YS; const float* bd; const int* list; const float* gw; const LAS int* tab;
    __device__ __forceinline__ void operator()(const f32x4 (&acc)[2][2][4][2], const Unit& u, int wr, int wc, int fr, int fq) const {
        const int col0 = u.pn * BM + wc * 32 + 4 * fq; const int r0 = (u.pm - __builtin_amdgcn_readfirstlane(tab[32 + u.e])) * 256;
        const float* bp = bd + (size_t)u.e * D + col0;
        f32x4 bv[2][2];
#pragma unroll
        for (int bj = 0; bj < 2; ++bj)
#pragma unroll
            for (int n = 0; n < 2; ++n) bv[bj][n] = *(const f32x4*)(bp + bj * HALF + n * 16);
#pragma unroll
        for (int ai = 0; ai < 2; ++ai)
#pragma unroll
            for (int m = 0; m < 4; ++m) { const int r = ai * HALF + wr * 64 + m * 16 + fr;
                if (r < u.nvalid) { const int slot = list[(size_t)u.e * CAP + r0 + r]; const float g = gw[slot]; float* op = YS + (size_t)slot * D + col0;
#pragma unroll
                    for (int bj = 0; bj < 2; ++bj)
#pragma unroll
                        for (int n = 0; n < 2; ++n) *(f32x4*)(op + bj * HALF + n * 16) = (acc[ai][bj][m][n] + bv[bj][n]) * g; } }
    }
};

template <class Epi, class Sched, bool ALIGN_EPI, bool SP2>
__device__ __forceinline__ void gemm_phase(LAS unsigned char* lds, const int wid, const int K, const Sched& S, const Epi& E) {
    const int lane = lane_id(), tid = wid * 64 + lane, wr = wid >> 2, wc = wid & 3, fr = lane & 15, fq = lane >> 4;
    const int nt = K / BK;
    unsigned voffA[2], voffB[2];
#pragma unroll
    for (int i = 0; i < 2; ++i) { int R, C; stage_rc(tid * 16 + i * 8192, R, C); const int Rb = Epi::PERM ? ((R & ~31) + perm32(R & 31)) : R;
        voffA[i] = (unsigned)(R * K + C) * 2u; voffB[i] = (unsigned)(Rb * K + C) * 2u; }
    const size_t kstep = (size_t)(BK * 2);
    const size_t hstep = (size_t)HALF * K * 2;
    const unsigned ldsw = (unsigned)wid * 1024u;
    const int aoff = lds_byte(wr * 64 + fr, fq * 8), boff = lds_byte(wc * 32 + fr, fq * 8);
#define PG8_SA(b, h) (((b) * 2 + (h)) * HTB)
#define PG8_SB(b, h) ((4 + (b) * 2 + (h)) * HTB)
#define PG8_STAGE(bufoff, gbase, voff) do { _Pragma("unroll") for (int _i = 0; _i < 2; ++_i) \
        __builtin_amdgcn_global_load_lds((const unsigned*)((const char*)(gbase) + (voff)[_i]), (LAS unsigned*)(lds + (bufoff) + ldsw + _i * 8192), 16, 0, 0); } while (0)
#define PG8_LDA(dst, b, h) do { _Pragma("unroll") for (int m = 0; m < 4; ++m) _Pragma("unroll") for (int k = 0; k < 2; ++k) dst[m][k] = *(const LAS bf16x8*)(lds + PG8_SA(b, h) + aoff + m * 2048 + k * 1024); } while (0)
#define PG8_LDB(dst, b, h) do { _Pragma("unroll") for (int n = 0; n < 2; ++n) _Pragma("unroll") for (int k = 0; k < 2; ++k) dst[n][k] = *(const LAS bf16x8*)(lds + PG8_SB(b, h) + boff + n * 2048 + k * 1024); } while (0)
#define PG8_MMA(ai, bj, At, Bt) do { __builtin_amdgcn_s_setprio(1); _Pragma("unroll") for (int m = 0; m < 4; ++m) _Pragma("unroll") for (int n = 0; n < 2; ++n) _Pragma("unroll") for (int k = 0; k < 2; ++k) \
        acc[ai][bj][m][n] = __builtin_amdgcn_mfma_f32_16x16x32_bf16(Bt[n][k], At[m][k], acc[ai][bj][m][n], 0, 0, 0); __builtin_amdgcn_s_setprio(0); } while (0)
#define PG8_WAIT_V(n) asm volatile("s_waitcnt vmcnt(" #n ")" ::: "memory")
#define PG8_WAIT_L(n) asm volatile("s_waitcnt lgkmcnt(" #n ")" ::: "memory")
#define PG8_BAR __builtin_amdgcn_s_barrier()
#define PG8_SCHED __builtin_amdgcn_sched_barrier(0)
    Unit cur, nxt; int ui = 0;
    if (!S.next(0, cur)) return;
    f32x4 acc[2][2][4][2];
#pragma unroll
    for (int a = 0; a < 2; ++a)
#pragma unroll
        for (int b = 0; b < 2; ++b)
#pragma unroll
            for (int m = 0; m < 4; ++m)
#pragma unroll
                for (int n = 0; n < 2; ++n) acc[a][b][m][n] = (f32x4){0.f, 0.f, 0.f, 0.f};
    bf16x8 At[4][2], B0[2][2], B1[2][2];
    const char* cA = cur.A; const char* cB = cur.B;
    if constexpr (SP2) {
        PG8_STAGE(PG8_SB(0, 0), cB, voffB); PG8_STAGE(PG8_SB(0, 1), cB + hstep, voffB); PG8_STAGE(PG8_SA(0, 0), cA, voffA); PG8_STAGE(PG8_SA(0, 1), cA + hstep, voffA);
        if (wr == 1) PG8_BAR;
        PG8_WAIT_V(2); PG8_BAR;
        PG8_STAGE(PG8_SB(1, 0), cB + kstep, voffB); PG8_STAGE(PG8_SA(1, 0), cA + kstep, voffA); PG8_STAGE(PG8_SB(1, 1), cB + hstep + kstep, voffB);
        PG8_WAIT_V(6); PG8_BAR;
    } else {
        PG8_STAGE(PG8_SB(0, 0), cB, voffB); PG8_STAGE(PG8_SA(0, 0), cA, voffA); PG8_STAGE(PG8_SB(0, 1), cB + hstep, voffB); PG8_STAGE(PG8_SA(0, 1), cA + hstep, voffA);
        if (wr == 1) PG8_BAR;
        PG8_WAIT_V(4); PG8_BAR;
        PG8_STAGE(PG8_SB(1, 0), cB + kstep, voffB); PG8_STAGE(PG8_SA(1, 0), cA + kstep, voffA); PG8_STAGE(PG8_SB(1, 1), cB + hstep + kstep, voffB);
        PG8_WAIT_V(6); PG8_BAR;
    }
    for (;;) {
        const bool has_next = S.next(ui + 1, nxt);
        const char* nA = has_next ? nxt.A : cA; const char* nB = has_next ? nxt.B : cB;
        for (int t = 0; t < nt; t += 2) {
            const bool last = (t == nt - 2);
            const char* a1 = cA + (size_t)(t + 1) * kstep;
            const char* a2 = last ? nA : cA + (size_t)(t + 2) * kstep; const char* b2 = last ? nB : cB + (size_t)(t + 2) * kstep;
            const char* a3 = a2 + kstep; const char* b3 = b2 + kstep;
            if constexpr (SP2) {
            PG8_LDB(B0, 0, 0); PG8_LDB(B1, 0, 1); PG8_SCHED; PG8_LDA(At, 0, 0); PG8_STAGE(PG8_SA(1, 1), a1 + hstep, voffA);
            PG8_WAIT_V(8); PG8_WAIT_L(0); PG8_BAR; PG8_MMA(0, 0, At, B0); PG8_MMA(0, 1, At, B1); PG8_BAR; PG8_SCHED;
            PG8_LDA(At, 0, 1); PG8_STAGE(PG8_SB(0, 0), b2, voffB); PG8_STAGE(PG8_SB(0, 1), b2 + hstep, voffB); PG8_STAGE(PG8_SA(0, 0), a2, voffA);
            PG8_WAIT_V(8); PG8_WAIT_L(0); PG8_BAR; PG8_MMA(1, 0, At, B0); PG8_MMA(1, 1, At, B1); PG8_BAR; PG8_SCHED;
            PG8_LDB(B0, 1, 0); PG8_LDB(B1, 1, 1); PG8_SCHED; PG8_LDA(At, 1, 0); PG8_STAGE(PG8_SA(0, 1), a2 + hstep, voffA);
            PG8_WAIT_V(8); PG8_WAIT_L(0); PG8_BAR; PG8_MMA(0, 0, At, B0); PG8_MMA(0, 1, At, B1); PG8_BAR; PG8_SCHED;
            PG8_LDA(At, 1, 1); PG8_STAGE(PG8_SB(1, 0), b3, voffB); PG8_STAGE(PG8_SB(1, 1), b3 + hstep, voffB); PG8_STAGE(PG8_SA(1, 0), a3, voffA);
            PG8_WAIT_V(8); PG8_WAIT_L(0); PG8_BAR; PG8_MMA(1, 0, At, B0); PG8_MMA(1, 1, At, B1); PG8_BAR; PG8_SCHED;
            } else {
            PG8_LDB(B0, 0, 0); PG8_SCHED; PG8_LDA(At, 0, 0); PG8_STAGE(PG8_SA(1, 1), a1 + hstep, voffA);
            PG8_WAIT_L(8); PG8_BAR; PG8_WAIT_L(0); PG8_MMA(0, 0, At, B0); PG8_BAR; PG8_SCHED;
            PG8_LDB(B1, 0, 1); PG8_STAGE(PG8_SB(0, 0), b2, voffB);
            PG8_BAR; PG8_WAIT_L(0); PG8_MMA(0, 1, At, B1); PG8_BAR;
            PG8_LDA(At, 0, 1); PG8_STAGE(PG8_SA(0, 0), a2, voffA);
            PG8_BAR; PG8_WAIT_L(0); PG8_MMA(1, 0, At, B0); PG8_BAR; PG8_SCHED;
            PG8_STAGE(PG8_SB(0, 1), b2 + hstep, voffB);
            PG8_WAIT_V(6); PG8_BAR; PG8_MMA(1, 1, At, B1); PG8_BAR;
            PG8_LDB(B0, 1, 0); PG8_SCHED; PG8_LDA(At, 1, 0); PG8_STAGE(PG8_SA(0, 1), a2 + hstep, voffA);
            PG8_WAIT_L(8); PG8_BAR; PG8_WAIT_L(0); PG8_MMA(0, 0, At, B0); PG8_BAR; PG8_SCHED;
            PG8_LDB(B1, 1, 1); PG8_STAGE(PG8_SB(1, 0), b3, voffB);
            PG8_BAR; PG8_WAIT_L(0); PG8_MMA(0, 1, At, B1); PG8_BAR;
            PG8_LDA(At, 1, 1); PG8_STAGE(PG8_SA(1, 0), a3, voffA);
            PG8_BAR; PG8_WAIT_L(0); PG8_MMA(1, 0, At, B0); PG8_BAR; PG8_SCHED;
            PG8_STAGE(PG8_SB(1, 1), b3 + hstep, voffB);
            PG8_WAIT_V(6); PG8_BAR; PG8_MMA(1, 1, At, B1); PG8_BAR;
            }
        }
        if constexpr (ALIGN_EPI) { if (wr == 0) PG8_BAR; }
        E(acc, cur, wr, wc, fr, fq);
        if (!has_next) break;
#pragma unroll
        for (int a = 0; a < 2; ++a)
#pragma unroll
            for (int b = 0; b < 2; ++b)
#pragma unroll
                for (int m = 0; m < 4; ++m)
#pragma unroll
                    for (int n = 0; n < 2; ++n) acc[a][b][m][n] = (f32x4){0.f, 0.f, 0.f, 0.f};
        cur = nxt; cA = nA; cB = nB; ++ui;
        if constexpr (ALIGN_EPI) { if (wr == 1) PG8_BAR; }
    }
    PG8_WAIT_V(0);
    if constexpr (!ALIGN_EPI) { if (wr == 0) PG8_BAR; }
    PG8_BAR;
#undef PG8_SA
#undef PG8_SB
#undef PG8_STAGE
#undef PG8_LDA
#undef PG8_LDB
#undef PG8_MMA
#undef PG8_WAIT_V
#undef PG8_WAIT_L
#undef PG8_BAR
#undef PG8_SCHED
}
}

#define XB_TMO      128
#define XB_XCNT(j)  (256  + 64 * (j))
#define XB_XSUB(j)  (1280 + 64 * (j))
#define XB_XGEN(j)  (2304 + 64 * (j))
#define XB_TOP      3328
#define XB_TOPGEN   3392
#define XCD_BAR_WORDS 3456
#define XB_SPIN_CAP (1u << 18)
__device__ __forceinline__ unsigned xb_ld(unsigned* p)              { return __hip_atomic_load(p, __ATOMIC_RELAXED, __HIP_MEMORY_SCOPE_AGENT); }
__device__ __forceinline__ unsigned xb_add(unsigned* p, unsigned v) { return __hip_atomic_fetch_add(p, v, __ATOMIC_RELAXED, __HIP_MEMORY_SCOPE_AGENT); }
__device__ __forceinline__ unsigned xb_xcc_id() { return (unsigned)__builtin_amdgcn_s_getreg((3 << 11) | 20) & 0xFu; }
#define XB_SPIN(cond, bar) do { unsigned _sp = 0; while (cond) { __builtin_amdgcn_s_sleep(1); \
    if ((++_sp & 255u) == 0u) { if (xb_ld(&(bar)[XB_TMO])) break; if (_sp > XB_SPIN_CAP) { atomicAdd(&(bar)[XB_TMO], 1u); break; } } } } while (0)
struct XcdBarrier { unsigned* bar; unsigned x; volatile LAS unsigned* st; };
__device__ __forceinline__ XcdBarrier xcd_barrier_post(unsigned* bar, volatile LAS unsigned* st, bool leader) {
    XcdBarrier b; b.bar = bar; b.x = xb_xcc_id(); b.st = st;
    if (leader) (void)xb_add(&bar[XB_XCNT(b.x)], 1u);
    return b;
}
__device__ __forceinline__ void xcd_barrier_complete(unsigned* bar, unsigned x, unsigned& nloc, unsigned& nx) {
    const unsigned G = gridDim.x * gridDim.y * gridDim.z;
    unsigned sum, cnt, mine, sp = 0u;
    for (;;) {
        sum = 0u; cnt = 0u; mine = 0u;
#pragma unroll
        for (unsigned j = 0; j < 16; ++j) { const unsigned c = xb_ld(&bar[XB_XCNT(j)]); sum += c; cnt += (c > 0u) ? 1u : 0u; mine = (j == x) ? c : mine; }
        if (sum == G) break;
        __builtin_amdgcn_s_sleep(1);
        if ((++sp & 255u) == 0u) { if (xb_ld(&bar[XB_TMO])) break; if (sp > XB_SPIN_CAP) { atomicAdd(&bar[XB_TMO], 1u); break; } }
    }
    nloc = mine > 0u ? mine : 1u; nx = cnt > 0u ? cnt : 1u;
}
__device__ __forceinline__ void xcd_barrier(const XcdBarrier& b, int wave) {
    asm volatile("s_waitcnt vmcnt(0)" ::: "memory");
    __syncthreads();
    if (wave == 0 && lane_id() == 0) {
        unsigned* bar = b.bar;
        __builtin_amdgcn_s_waitcnt(0);
        unsigned nloc = b.st[0], nx = b.st[1];
        if (nloc == 0u) { xcd_barrier_complete(bar, b.x, nloc, nx); b.st[0] = nloc; b.st[1] = nx; }
        const unsigned old = xb_add(&bar[XB_XSUB(b.x)], 1u);
        const unsigned gen = old / nloc;
        if (old + 1u == (gen + 1u) * nloc) {
            __builtin_amdgcn_fence(__ATOMIC_RELEASE, "agent");
            asm volatile("s_waitcnt vmcnt(0)" ::: "memory");
            const unsigned og = xb_add(&bar[XB_TOP], 1u);
            const unsigned tg = og / nx;
            if (og + 1u == (tg + 1u) * nx) xb_add(&bar[XB_TOPGEN], 1u);
            else XB_SPIN(xb_ld(&bar[XB_TOPGEN]) == tg, bar);
            __builtin_amdgcn_fence(__ATOMIC_ACQUIRE, "agent");
            xb_add(&bar[XB_XGEN(b.x)], 1u);
            asm volatile("s_waitcnt vmcnt(0)" ::: "memory");
        } else {
            XB_SPIN(xb_ld(&bar[XB_XGEN(b.x)]) == gen, bar);
            __builtin_amdgcn_fence(__ATOMIC_ACQUIRE, "agent");
            asm volatile("s_waitcnt vmcnt(0)" ::: "memory");
        }
    }
    __syncthreads();
}

struct Args { const float* in[33]; float* out; unsigned char* ws; int ph_lo, ph_hi; };
struct Frame {
    LAS unsigned char* lds;
    int wave, vcu, G, gw, NGW;
};

__device__ __forceinline__ void transpose_item(const float* W, int ldw, int col_off, int K, bf16* WT, int mode, int kb, int nb, LAS unsigned char* scr, int lane) {
    const int k0 = 64 * kb, n0 = 64 * nb;
    const float* src = W + (size_t)k0 * ldw + col_off + n0;
    f32x4 v[16];
#pragma unroll
    for (int i = 0; i < 16; ++i) v[i] = *(const f32x4*)(src + (size_t)((lane >> 4) + 4 * i) * ldw + 4 * (lane & 15));
#pragma unroll
    for (int i = 0; i < 16; ++i) { LAS unsigned* p = (LAS unsigned*)(scr + ((lane >> 4) + 4 * i) * 132 + 8 * (lane & 15)); p[0] = pk2(v[i][0], v[i][1]); p[1] = pk2(v[i][2], v[i][3]); }
    asm volatile("s_waitcnt lgkmcnt(0)" ::: "memory");
    const int c = lane >> 3, nl = lane & 7;
#pragma unroll
    for (int r = 0; r < 8; ++r) { const int n = nl + 8 * r; const LAS unsigned short* s = (const LAS unsigned short*)(scr + (8 * c) * 132 + 2 * n);
        u32x4 o; o.x = (unsigned)s[0] | ((unsigned)s[66] << 16); o.y = (unsigned)s[132] | ((unsigned)s[198] << 16); o.z = (unsigned)s[264] | ((unsigned)s[330] << 16); o.w = (unsigned)s[396] | ((unsigned)s[462] << 16);
        const int ng = n0 + n; int drow = ng; if (mode == 1) { drow = ng < 1024 ? 256 * (ng >> 7) + (ng & 127) : 256 * ((ng - 1024) >> 7) + 128 + (ng & 127); }
        *(u32x4*)(WT + (size_t)drow * K + k0 + 8 * c) = o; }
    asm volatile("s_waitcnt lgkmcnt(0)" ::: "memory");
}

__device__ __forceinline__ void load_cols16(int tid, const float* W, int ldw, int col_off, LAS float* Wt) {
    for (int i = tid; i < 1024 * 16; i += NTHREADS) { const int e = i & 15, k = i >> 4; Wt[e * 1028 + k] = W[(size_t)k * ldw + col_off + e]; }
}
__device__ __forceinline__ void row_dot16(const f32x4 (&v)[4], const LAS float* Wt, int lane, float (&out)[16]) {
#pragma unroll
    for (int e = 0; e < 16; ++e) { float s = 0.f;
#pragma unroll
        for (int j = 0; j < 4; ++j) { const f32x4 w = *(const LAS f32x4*)(Wt + e * 1028 + 4 * (lane + 64 * j)); s += v[j][0] * w[0] + v[j][1] * w[1] + v[j][2] * w[2] + v[j][3] * w[3]; }
        out[e] = wave_sum(s); }
}
__device__ __forceinline__ void store_row_bf16(bf16* orow, const f32x4 (&v)[4], int lane) {
    unsigned long long* o8 = (unsigned long long*)orow + lane;
#pragma unroll
    for (int j = 0; j < 4; ++j) o8[64 * j] = (unsigned long long)pk2(v[j][0], v[j][1]) | ((unsigned long long)pk2(v[j][2], v[j][3]) << 32);
}
__device__ __forceinline__ void store_row_f32(float* orow, const f32x4 (&v)[4], int lane) {
    f32x4* o = (f32x4*)orow + lane;
#pragma unroll
    for (int j = 0; j < 4; ++j) o[64 * j] = v[j];
}
__device__ __forceinline__ void load_row_f32(const float* row, f32x4 (&v)[4], int lane) {
    const f32x4* p = (const f32x4*)row + lane;
#pragma unroll
    for (int j = 0; j < 4; ++j) v[j] = p[64 * j];
}
__device__ __forceinline__ void ln_row(f32x4 (&v)[4], const f32x4 (&gv)[4], const f32x4 (&bv)[4]) {
    float s = 0.f;
#pragma unroll
    for (int j = 0; j < 4; ++j) s += (v[j][0] + v[j][1]) + (v[j][2] + v[j][3]);
    const float mean = wave_sum(s) * (1.f / D); float s2 = 0.f;
#pragma unroll
    for (int j = 0; j < 4; ++j) { v[j] = v[j] - mean; s2 += (v[j][0] * v[j][0] + v[j][1] * v[j][1]) + (v[j][2] * v[j][2] + v[j][3] * v[j][3]); }
    const float rstd = 1.f / sqrtf(wave_sum(s2) * (1.f / D) + LN_EPS);
#pragma unroll
    for (int j = 0; j < 4; ++j) v[j] = v[j] * rstd * gv[j] + bv[j];
}

__device__ __forceinline__ const float* inp_ptr(LAS unsigned char* lds, int i) {
    const LAS unsigned* p = (const LAS unsigned*)(lds + MISC_OFF + 256) + 2 * i;
    const unsigned lo = __builtin_amdgcn_readfirstlane(p[0]), hi = __builtin_amdgcn_readfirstlane(p[1]);
    return (const float*)(const GAS float*)(((unsigned long long)hi << 32) | lo);
}

typedef short s16x4 __attribute__((ext_vector_type(4)));
typedef short v4i16_t __attribute__((ext_vector_type(4)));
constexpr int CL = 128, NCH = T / CL;
template <int MODE> struct MX;
template <> struct MX<0> { static constexpr int NH = 8, DK = 64,  DV = 128, LDP = 3072, KOFF = 512,  VOFF = 1024; };
template <> struct MX<1> { static constexpr int NH = 8, DK = 128, DV = 256, LDP = 6144, KOFF = 1024, VOFF = 2048; };
template <> struct MX<2> { static constexpr int NH = 4, DK = 128, DV = 256, LDP = 3072, KOFF = 512,  VOFF = 1024; };
__device__ __forceinline__ s16x4 ds_tr(const LAS unsigned char* p) { return __builtin_bit_cast(s16x4, __builtin_amdgcn_ds_read_tr16_b64_v4i16((LAS v4i16_t*)p)); }
__device__ __forceinline__ bf16x8 tr_frag(const LAS unsigned char* base, int pitch, int k0, int n0, int lane) {
    const int g = lane >> 4, q = (lane & 15) >> 2, p = lane & 3;
    const LAS unsigned char* a = base + (k0 + 4 * g + q) * pitch + (n0 + 4 * p) * 2;
    const s16x4 r1 = ds_tr(a), r2 = ds_tr(a + 16 * pitch);
    bf16x8 f; f[0] = r1[0]; f[1] = r1[1]; f[2] = r1[2]; f[3] = r1[3]; f[4] = r2[0]; f[5] = r2[1]; f[6] = r2[2]; f[7] = r2[3]; return f;
}
__device__ __forceinline__ u32x4 scale_bf16x8(u32x4 v, float sc) {
    u32x4 o; o.x = pk2(bflo(v.x) * sc, bfhi(v.x) * sc); o.y = pk2(bflo(v.y) * sc, bfhi(v.y) * sc); o.z = pk2(bflo(v.z) * sc, bfhi(v.z) * sc); o.w = pk2(bflo(v.w) * sc, bfhi(v.w) * sc); return o;
}
__device__ __forceinline__ float ret_lg2gamma(int h) { return log2f(1.f - exp2f(-5.f - (float)h)); }

template <int MODE>
__device__ __forceinline__ void mix_phaseA(const Frame& F, unsigned char* ws, const int tid, const int lane) {
    typedef MX<MODE> C; constexpr int DK = C::DK, DV = C::DV, NH = C::NH, LDP = C::LDP, KP = DK * 2 + 32, VP = DV * 2 + 32, ETW = DV / 128, NDT = DK / 16;
    LAS unsigned char* ldsK = F.lds; LAS unsigned char* ldsV = F.lds + 128 * KP; LAS float* rsc = (LAS float*)(F.lds + 128 * KP + 128 * VP);
    const bf16* PB = (const bf16*)(ws + WS_PB); const bf16* KPP = (const bf16*)(ws + WS_KPP); float* UT = (float*)(ws + WS_UT);
    const float* GSC = (const float*)(ws + WS_SC); float* NLOC = (float*)(ws + WS_SC + 2 * MiB);
    const int w = F.wave, g = lane >> 4;
    for (int u = blockIdx.x; u < 2 * NH * NCH; u += F.G) {
        const int c = u % NCH, bh = u / NCH, h = bh % NH, b = bh / NH; const size_t row0 = (size_t)b * T + (size_t)c * CL;
        __syncthreads();
        if (tid < 128) { float sc = 1.f;
            if (MODE == 0) sc = __expf(GSC[(size_t)(1 * 16 + bh) * T + c * CL + tid] - GSC[(size_t)(2 * 16 + bh) * T + c * CL + 127]);
            if (MODE == 1) sc = exp2f((float)(127 - tid) * ret_lg2gamma(h));
            rsc[tid] = sc; }
        __syncthreads();
        for (int p = tid; p < 128 * DK / 8; p += NTHREADS) { const int r = p / (DK / 8), cp = p % (DK / 8);
            u32x4 v = (MODE == 2) ? *(const u32x4*)(KPP + (row0 + r) * 512 + h * 128 + cp * 8) : *(const u32x4*)(PB + (row0 + r) * LDP + C::KOFF + h * DK + cp * 8);
            if (MODE != 2) v = scale_bf16x8(v, rsc[r]);
            *(LAS u32x4*)(ldsK + r * KP + cp * 16) = v; }
        for (int p = tid; p < 128 * DV / 8; p += NTHREADS) { const int r = p / (DV / 8), cp = p % (DV / 8);
            *(LAS u32x4*)(ldsV + r * VP + cp * 16) = *(const u32x4*)(PB + (row0 + r) * LDP + C::VOFF + h * DV + cp * 8); }
        __syncthreads();
        f32x4 acc[ETW][NDT];
#pragma unroll
        for (int i = 0; i < ETW; ++i)
#pragma unroll
            for (int j = 0; j < NDT; ++j) acc[i][j] = (f32x4){0.f, 0.f, 0.f, 0.f};
#pragma unroll
        for (int ks = 0; ks < 4; ++ks) {
            bf16x8 af[ETW], bfv[NDT];
#pragma unroll
            for (int i = 0; i < ETW; ++i) af[i] = tr_frag(ldsV, VP, 32 * ks, (w * ETW + i) * 16, lane);
#pragma unroll
            for (int j = 0; j < NDT; ++j) bfv[j] = tr_frag(ldsK, KP, 32 * ks, j * 16, lane);
#pragma unroll
            for (int i = 0; i < ETW; ++i)
#pragma unroll
                for (int j = 0; j < NDT; ++j) acc[i][j] = __builtin_amdgcn_mfma_f32_16x16x32_bf16(af[i], bfv[j], acc[i][j], 0, 0, 0);
        }
        float* ut = UT + (size_t)u * DV * DK;
#pragma unroll
        for (int i = 0; i < ETW; ++i)
#pragma unroll
            for (int j = 0; j < NDT; ++j)
#pragma unroll
                for (int r = 0; r < 4; ++r) ut[(size_t)((w * ETW + i) * 16 + 4 * g + r) * DK + j * 16 + (lane & 15)] = acc[i][j][r];
        if (MODE == 0 && tid < 64) { float sacc = 0.f;
            for (int r = 0; r < 128; ++r) sacc += bf2f(*(const LAS unsigned short*)(ldsK + r * KP + tid * 2));
            NLOC[(size_t)u * 64 + tid] = sacc; }
    }
    __syncthreads();
}

template <int MODE>
__device__ __forceinline__ void mix_phaseB(const Frame& F, unsigned char* ws, const int tid) {
    typedef MX<MODE> C; constexpr int DK = C::DK, DV = C::DV, NH = C::NH, NEL = DV * DK, NBH = 2 * NH;
    const float* UT = (const float*)(ws + WS_UT); bf16* ST = (bf16*)(ws + WS_ST);
    const float* GSC = (const float*)(ws + WS_SC); const float* NLOC = (const float*)(ws + WS_SC + 2 * MiB); float* NPREV = (float*)(ws + WS_SC + 2 * MiB + 256 * 1024);
    float* MPREV = (float*)(ws + WS_SC + 2 * MiB + 512 * 1024); const float* DEC = (const float*)(ws + WS_SC + 3 * MiB);
    const int gtid = blockIdx.x * NTHREADS + tid, nthr = F.G * NTHREADS;
    for (int el = gtid; el < NBH * NEL; el += nthr) {
        const int bh = el / NEL, idx = el - bh * NEL, h = bh % NH, b = bh / NH;
        float S = 0.f, m = -1e30f;
        const float rdec = (MODE == 1) ? exp2f(128.f * ret_lg2gamma(h)) : 1.f;
#pragma unroll 1
        for (int c0 = 0; c0 < NCH; c0 += 8) {
            float uv[8];
#pragma unroll
            for (int i = 0; i < 8; ++i) uv[i] = UT[(size_t)(bh * NCH + c0 + i) * NEL + idx];
#pragma unroll
            for (int i = 0; i < 8; ++i) { const int c = c0 + i; const size_t u = (size_t)bh * NCH + c;
                ST[u * NEL + idx] = (bf16)f2bf(S);
                if (MODE == 0) { const float atot = GSC[(size_t)(0 * 16 + bh) * T + c * CL + 127], mloc = atot + GSC[(size_t)(2 * 16 + bh) * T + c * CL + 127];
                    const float mnew = fmaxf(atot + m, mloc), so = __expf(atot + m - mnew), sl = __expf(mloc - mnew);
                    if (idx == 0) MPREV[u] = m;
                    S = so * S + sl * uv[i]; m = mnew; }
                else if (MODE == 1) S = rdec * S + uv[i];
                else S = DEC[(size_t)(b * NCH + c) * 512 + h * 128 + (idx & 127)] * S + uv[i]; }
        }
    }
    if (MODE == 0) {
        for (int el = gtid; el < NBH * 64; el += nthr) { const int bh = el >> 6, d = el & 63; float S = 0.f, m = -1e30f;
            for (int c = 0; c < NCH; ++c) { const size_t u = (size_t)bh * NCH + c;
                const float atot = GSC[(size_t)(0 * 16 + bh) * T + c * CL + 127], mloc = atot + GSC[(size_t)(2 * 16 + bh) * T + c * CL + 127];
                const float mnew = fmaxf(atot + m, mloc), so = __expf(atot + m - mnew), sl = __expf(mloc - mnew);
                NPREV[u * 64 + d] = S; S = so * S + sl * NLOC[u * 64 + d]; m = mnew; } }
    }
}

template <int MODE>
__device__ __forceinline__ void mix_phaseC(const Frame& F, unsigned char* ws, const int tid, const int lane) {
    typedef MX<MODE> C; constexpr int DK = C::DK, DV = C::DV, NH = C::NH, LDP = C::LDP, VP = DV * 2 + 32, NET = DV / 16, NKS = DK / 32, DVT = NH * DV;
    LAS unsigned char* ldsV = F.lds; LAS float* tabs = (LAS float*)(F.lds + 128 * VP);
    const bf16* PB = (const bf16*)(ws + WS_PB); const bf16* ST = (const bf16*)(ws + WS_ST); float* ORAW = (float*)(ws + WS_ORAW);
    const float* GSC = (const float*)(ws + WS_SC); const float* NPREV = (const float*)(ws + WS_SC + 2 * MiB + 256 * 1024); const float* MPREV = (const float*)(ws + WS_SC + 2 * MiB + 512 * 1024);
    const int w = F.wave, g = lane >> 4, li = lane & 15;
    for (int u = blockIdx.x; u < 2 * NH * NCH; u += F.G) {
        const int c = u % NCH, bh = u / NCH, h = bh % NH, b = bh / NH; const size_t row0 = (size_t)b * T + (size_t)c * CL;
        const float lg = (MODE == 1) ? ret_lg2gamma(h) : 0.f;
        __syncthreads();
        for (int p = tid; p < 128 * DV / 8; p += NTHREADS) { const int r = p / (DV / 8), cp = p % (DV / 8);
            *(LAS u32x4*)(ldsV + r * VP + cp * 16) = *(const u32x4*)(PB + (row0 + r) * LDP + C::VOFF + h * DV + cp * 8); }
        if (MODE == 0 && tid < 128) { const float mp = MPREV[u]; const size_t gi = (size_t)bh * T + c * CL + tid;
            const float a = GSC[(size_t)(0 * 16) * T + gi], gg = GSC[(size_t)(1 * 16) * T + gi], cm = GSC[(size_t)(2 * 16) * T + gi];
            const float Mt = fmaxf(mp, cm);
            tabs[tid] = gg; tabs[128 + tid] = Mt; tabs[256 + tid] = __expf(mp - Mt) * 0.125f; tabs[384 + tid] = __expf(-(a + Mt)); }
        __syncthreads();
        const int tq = 16 * w + li;
        const bf16* qrow = PB + (row0 + tq) * LDP + h * DK;
        bf16x8 qf[NKS];
#pragma unroll
        for (int ks = 0; ks < NKS; ++ks) qf[ks] = *(const bf16x8*)(qrow + 32 * ks + 8 * g);
        f32x4 O[NET];
#pragma unroll
        for (int et = 0; et < NET; ++et) O[et] = (f32x4){0.f, 0.f, 0.f, 0.f};
        float den = 0.f;
        const float Mq = (MODE == 0) ? tabs[128 + tq] : 0.f;
        for (int jp = 0; jp <= (w >> 1); ++jp) {
            f32x4 p0 = (f32x4){0.f, 0.f, 0.f, 0.f}, p1 = (f32x4){0.f, 0.f, 0.f, 0.f};
            const bf16* k0p = PB + (row0 + 32 * jp + li) * LDP + C::KOFF + h * DK + 8 * g;
#pragma unroll
            for (int ks = 0; ks < NKS; ++ks) p0 = __builtin_amdgcn_mfma_f32_16x16x32_bf16(*(const bf16x8*)(k0p + 32 * ks), qf[ks], p0, 0, 0, 0);
            if (2 * jp + 1 <= w) {
#pragma unroll
                for (int ks = 0; ks < NKS; ++ks) p1 = __builtin_amdgcn_mfma_f32_16x16x32_bf16(*(const bf16x8*)(k0p + (size_t)16 * LDP + 32 * ks), qf[ks], p1, 0, 0, 0);
            }
#pragma unroll
            for (int r = 0; r < 4; ++r) {
                const int s0 = 32 * jp + 4 * g + r, s1 = s0 + 16;
                float f0, f1;
                if (MODE == 0) { f0 = __expf(tabs[s0] - Mq) * 0.125f; f1 = __expf(tabs[s1] - Mq) * 0.125f; }
                else if (MODE == 1) { f0 = exp2f((float)(tq - s0) * lg); f1 = exp2f((float)(tq - s1) * lg); }
                else { f0 = 1.f; f1 = 1.f; }
                p0[r] = (s0 <= tq) ? p0[r] * f0 : 0.f; p1[r] = (s1 <= tq) ? p1[r] * f1 : 0.f;
                den += p0[r] + p1[r];
            }
            bf16x8 af; { const unsigned a0 = pk2(p0[0], p0[1]), a1 = pk2(p0[2], p0[3]), a2 = pk2(p1[0], p1[1]), a3 = pk2(p1[2], p1[3]); u32x4 t4; t4.x = a0; t4.y = a1; t4.z = a2; t4.w = a3; af = __builtin_bit_cast(bf16x8, t4); }
#pragma unroll
            for (int et = 0; et < NET; ++et) O[et] = __builtin_amdgcn_mfma_f32_16x16x32_bf16(af, tr_frag(ldsV, VP, 32 * jp, 16 * et, lane), O[et], 0, 0, 0);
        }
        const float qs = (MODE == 0) ? tabs[256 + tq] : (MODE == 1) ? exp2f((float)(tq + 1) * lg) : 1.f;
        const bf16* st = ST + (size_t)u * DV * DK;
        float dint = 0.f;
#pragma unroll
        for (int ks = 0; ks < NKS; ++ks) {
            bf16x8 aq = qf[ks];
            if (MODE != 2) aq = __builtin_bit_cast(bf16x8, scale_bf16x8(__builtin_bit_cast(u32x4, qf[ks]), qs));
            if (MODE == 0) { const float* np = NPREV + (size_t)u * 64 + 32 * ks + 8 * g; const u32x4 qa = __builtin_bit_cast(u32x4, aq);
                dint += bflo(qa.x) * np[0] + bfhi(qa.x) * np[1] + bflo(qa.y) * np[2] + bfhi(qa.y) * np[3] + bflo(qa.z) * np[4] + bfhi(qa.z) * np[5] + bflo(qa.w) * np[6] + bfhi(qa.w) * np[7]; }
#pragma unroll
            for (int et = 0; et < NET; ++et) O[et] = __builtin_amdgcn_mfma_f32_16x16x32_bf16(aq, *(const bf16x8*)(st + (size_t)(16 * et + li) * DK + 32 * ks + 8 * g), O[et], 0, 0, 0);
        }
        float rd[4] = {1.f, 1.f, 1.f, 1.f};
        if (MODE == 0) {
            float dt = den + dint; dt += __shfl_xor(dt, 16); dt += __shfl_xor(dt, 32);
            LAS float* wsc = tabs + 512 + 16 * w;
            if (g == 0) wsc[li] = 1.f / fmaxf(fabsf(dt), tabs[384 + tq]);
            asm volatile("s_waitcnt lgkmcnt(0)" ::: "memory");
#pragma unroll
            for (int r = 0; r < 4; ++r) rd[r] = wsc[4 * g + r];
        }
        float* orow = ORAW + (row0 + 16 * w + 4 * g) * DVT + h * DV + li;
#pragma unroll
        for (int et = 0; et < NET; ++et)
#pragma unroll
            for (int r = 0; r < 4; ++r) orow[(size_t)r * DVT + 16 * et] = O[et][r] * rd[r];
    }
    __syncthreads();
}

constexpr int SLN = 32, NCI = T / SLN, NI = 2 * NCI, NRT = NI / 16, SKK = SLN * 16;
__device__ __forceinline__ void s5_coef(const float* lam_re, const float* lam_im, const float* log_dt, int g, int p, float& lr, float& li, float& dt, float& fr, float& fi) {
    const int i = g * 64 + p; lr = lam_re[i]; li = lam_im[i]; dt = expf(log_dt[g]);
    const float er = expf(lr * dt); float sn, cs; sincosf(li * dt, &sn, &cs);
    const float nr = er * cs - 1.f, ni = er * sn, den = lr * lr + li * li;
    fr = (nr * lr + ni * li) / den; fi = (ni * lr - nr * li) / den;
}
__device__ __forceinline__ void s5_pow(float lr, float li, float dt, float n, float& pr, float& pi) { const float e = expf(n * lr * dt); float sn, cs; sincosf(n * li * dt, &sn, &cs); pr = e * cs; pi = e * sn; }

__device__ __forceinline__ void s5_tables(const Frame& F, unsigned char* ws, const int tid, const float* lam_re, const float* lam_im, const float* b_re, const float* b_im, const float* c_re, const float* c_im, const float* log_dt) {
    bf16* KT = (bf16*)(ws + WS_S5KT); bf16* VT = (bf16*)(ws + WS_S5VT); bf16* WT = (bf16*)(ws + WS_S5WT); float* L64 = (float*)(ws + WS_S5L64);
    const int gt = blockIdx.x * NTHREADS + tid, nthr = F.G * NTHREADS;
    for (int idx = gt; idx < 64 * SLN * 16; idx += nthr) {
        const int h = idx & 15, tau = (idx >> 4) % SLN, g = idx / (16 * SLN);
        float acc[16];
#pragma unroll
        for (int q = 0; q < 16; ++q) acc[q] = 0.f;
        for (int p = 0; p < 64; ++p) { float lr, li, dt, fr, fi, pr, pi; s5_coef(lam_re, lam_im, log_dt, g, p, lr, li, dt, fr, fi); s5_pow(lr, li, dt, (float)tau, pr, pi);
            const float cr = c_re[(g * 16 + h) * 64 + p], ci = c_im[(g * 16 + h) * 64 + p];
            const float xr = cr * pr - ci * pi, xi = cr * pi + ci * pr;
            const float yr = xr * fr - xi * fi, yi = xr * fi + xi * fr;
            const float* br = b_re + (size_t)(g * 64 + p) * 16; const float* bi = b_im + (size_t)(g * 64 + p) * 16;
#pragma unroll
            for (int q = 0; q < 16; ++q) acc[q] += yr * br[q] - yi * bi[q]; }
        u32x4 o0, o1; o0.x = pk2(acc[0], acc[1]); o0.y = pk2(acc[2], acc[3]); o0.z = pk2(acc[4], acc[5]); o0.w = pk2(acc[6], acc[7]);
        o1.x = pk2(acc[8], acc[9]); o1.y = pk2(acc[10], acc[11]); o1.z = pk2(acc[12], acc[13]); o1.w = pk2(acc[14], acc[15]);
        *(u32x4*)(KT + (size_t)idx * 16) = o0; *(u32x4*)(KT + (size_t)idx * 16 + 8) = o1; }
    for (int idx = gt; idx < 64 * 64 * SLN; idx += nthr) {
        const int j = idx % SLN, p = (idx / SLN) & 63, g = idx / (SLN * 64);
        float lr, li, dt, fr, fi, pr, pi; s5_coef(lam_re, lam_im, log_dt, g, p, lr, li, dt, fr, fi);
        s5_pow(lr, li, dt, (float)(SLN - 1 - j), pr, pi);
        const float yr = pr * fr - pi * fi, yi = pr * fi + pi * fr;
        const float* br = b_re + (size_t)(g * 64 + p) * 16; const float* bi = b_im + (size_t)(g * 64 + p) * 16;
        float vr[16], vi[16];
#pragma unroll
        for (int q = 0; q < 16; ++q) { vr[q] = yr * br[q] - yi * bi[q]; vi[q] = yr * bi[q] + yi * br[q]; }
        bf16* v0 = VT + ((size_t)(g * 128 + 2 * p) * SKK + j * 16);
        u32x4 o; o.x = pk2(vr[0], vr[1]); o.y = pk2(vr[2], vr[3]); o.z = pk2(vr[4], vr[5]); o.w = pk2(vr[6], vr[7]); *(u32x4*)v0 = o;
        o.x = pk2(vr[8], vr[9]); o.y = pk2(vr[10], vr[11]); o.z = pk2(vr[12], vr[13]); o.w = pk2(vr[14], vr[15]); *(u32x4*)(v0 + 8) = o;
        o.x = pk2(vi[0], vi[1]); o.y = pk2(vi[2], vi[3]); o.z = pk2(vi[4], vi[5]); o.w = pk2(vi[6], vi[7]); *(u32x4*)(v0 + SKK) = o;
        o.x = pk2(vi[8], vi[9]); o.y = pk2(vi[10], vi[11]); o.z = pk2(vi[12], vi[13]); o.w = pk2(vi[14], vi[15]); *(u32x4*)(v0 + SKK + 8) = o;
        const int l = j; s5_pow(lr, li, dt, (float)(l + 1), pr, pi);
#pragma unroll
        for (int h = 0; h < 16; ++h) { const float cr = c_re[(g * 16 + h) * 64 + p], ci = c_im[(g * 16 + h) * 64 + p];
            *(unsigned*)(WT + ((size_t)((g * SLN + l) * 16 + h) * 128 + 2 * p)) = pk2(cr * pr - ci * pi, -(cr * pi + ci * pr)); }
        if (j == 0) { s5_pow(lr, li, dt, (float)SLN, pr, pi); L64[(g * 64 + p) * 2] = pr; L64[(g * 64 + p) * 2 + 1] = pi; }
    }
}
__device__ __forceinline__ void s5_phaseA(const Frame& F, unsigned char* ws, const int lane) {
    const bf16* PB = (const bf16*)(ws + WS_PB); const bf16* VT = (const bf16*)(ws + WS_S5VT); float* SL = (float*)(ws + WS_S5SL);
    const int gq = lane >> 4, li = lane & 15;
    for (int wu = F.gw; wu < 64 * NRT * 2; wu += F.NGW) {
        const int half = wu & 1, rt = (wu >> 1) % NRT, g = wu / (2 * NRT), b = rt / (NRT / 2), c0 = (rt % (NRT / 2)) * 16;
        f32x4 acc[4];
#pragma unroll
        for (int ct = 0; ct < 4; ++ct) acc[ct] = (f32x4){0.f, 0.f, 0.f, 0.f};
        const bf16* ap = PB + ((size_t)b * T + (size_t)(c0 + li) * SLN + (gq >> 1)) * 1024 + g * 16 + 8 * (gq & 1);
        const bf16* bp = VT + (size_t)(g * 128 + half * 64 + li) * SKK + 8 * gq;
#pragma unroll 4
        for (int ks = 0; ks < SLN / 2; ++ks) {
            const bf16x8 af = *(const bf16x8*)(ap + (size_t)(2 * ks) * 1024);
#pragma unroll
            for (int ct = 0; ct < 4; ++ct) acc[ct] = __builtin_amdgcn_mfma_f32_16x16x32_bf16(af, *(const bf16x8*)(bp + (size_t)(16 * ct) * SKK + 32 * ks), acc[ct], 0, 0, 0);
        }
#pragma unroll
        for (int ct = 0; ct < 4; ++ct)
#pragma unroll
            for (int r = 0; r < 4; ++r) SL[(size_t)(g * NI + rt * 16 + 4 * gq + r) * 128 + half * 64 + ct * 16 + li] = acc[ct][r];
    }
}
__device__ __forceinline__ void s5_phaseB(const Frame& F, unsigned char* ws, const int tid) {
    const float* SL = (const float*)(ws + WS_S5SL); bf16* SP = (bf16*)(ws + WS_S5SP); const float* L64 = (const float*)(ws + WS_S5L64);
    const int gt = blockIdx.x * NTHREADS + tid;
    if (gt < 2 * 64 * 64) { const int p = gt & 63, g = (gt >> 6) & 63, b = gt >> 12; const float ar = L64[(g * 64 + p) * 2], ai = L64[(g * 64 + p) * 2 + 1];
        float sr = 0.f, si = 0.f;
#pragma unroll 1
        for (int c0 = 0; c0 < NCI; c0 += 8) { f32x2 lv[8];
#pragma unroll
            for (int i = 0; i < 8; ++i) lv[i] = *(const f32x2*)(SL + (size_t)(g * NI + b * NCI + c0 + i) * 128 + 2 * p);
#pragma unroll
            for (int i = 0; i < 8; ++i) { *(unsigned*)(SP + (size_t)(g * NI + b * NCI + c0 + i) * 128 + 2 * p) = pk2(sr, si);
                const float nr = ar * sr - ai * si + lv[i][0], ni = ar * si + ai * sr + lv[i][1]; sr = nr; si = ni; } }
    }
}
__device__ __forceinline__ void s5_phaseC(const Frame& F, unsigned char* ws, const int lane, const float* dskip) {
    const bf16* PB = (const bf16*)(ws + WS_PB); const bf16* KT = (const bf16*)(ws + WS_S5KT); const bf16* WT = (const bf16*)(ws + WS_S5WT); const bf16* SP = (const bf16*)(ws + WS_S5SP);
    bf16* YB = (bf16*)(ws + WS_YB);
    const int gq = lane >> 4, li = lane & 15;
#pragma unroll 1
    for (int wu = F.gw; wu < 64 * NRT * 2; wu += F.NGW) {
        const int par = wu & 1, rt = (wu >> 1) % NRT, g = wu / (2 * NRT), b = rt / (NRT / 2), c0 = (rt % (NRT / 2)) * 16;
        bf16x8 af[SLN / 2], sf[4];
        const bf16* ap = PB + ((size_t)b * T + (size_t)(c0 + li) * SLN + (gq >> 1)) * 1024 + g * 16 + 8 * (gq & 1);
#pragma unroll
        for (int ks = 0; ks < SLN / 2; ++ks) af[ks] = *(const bf16x8*)(ap + (size_t)(2 * ks) * 1024);
#pragma unroll
        for (int ks = 0; ks < 4; ++ks) sf[ks] = *(const bf16x8*)(SP + (size_t)(g * NI + rt * 16 + li) * 128 + 32 * ks + 8 * gq);
        const float dl = dskip[g * 16 + li];
        const bf16* ktp = KT + (size_t)g * SLN * 256 + li * 16 + 8 * (gq & 1);
#pragma unroll
        for (int l2 = 0; l2 < SLN / 2; ++l2) {
            int l = 2 * l2 + par; asm volatile("" : "+v"(l));
            f32x4 acc = (f32x4){0.f, 0.f, 0.f, 0.f};
#pragma unroll
            for (int ks = 0; ks <= l2; ++ks) { const int tau = l - 2 * ks - (gq >> 1);
                bf16x8 bfv = *(const bf16x8*)(ktp + (size_t)(tau < 0 ? 0 : tau) * 256);
                if (ks == l2 && tau < 0) bfv = (bf16x8){0, 0, 0, 0, 0, 0, 0, 0};
                acc = __builtin_amdgcn_mfma_f32_16x16x32_bf16(af[ks], bfv, acc, 0, 0, 0); }
            const bf16* wp = WT + (size_t)((g * SLN + l) * 16 + li) * 128 + 8 * gq;
#pragma unroll
            for (int ks = 0; ks < 4; ++ks) acc = __builtin_amdgcn_mfma_f32_16x16x32_bf16(sf[ks], *(const bf16x8*)(wp + 32 * ks), acc, 0, 0, 0);
#pragma unroll
            for (int r = 0; r < 4; ++r) { const size_t row = (size_t)b * T + (size_t)(c0 + 4 * gq + r) * SLN + l; const size_t o = row * 1024 + g * 16 + li;
                const float y = acc[r] + dl * bf2f(PB[o]); YB[o] = (bf16)f2bf(gelu_tanh(y)); }
            asm volatile("" ::: "memory");
        }
    }
}

#define IN(k) (lo <= (k) && (k) < hi)
#define SEAM(k) do { if ((k) + 1 < hi) xcd_barrier(bar, F.wave); } while (0)
#define INP(i) inp_ptr(F.lds, (i))
#define x_in INP(0)
#define ln_g INP(1)
#define ln_b INP(2)
#define WS_PTRS \
    float* HF = (float*)(ws + WS_HF); bf16* XB = (bf16*)(ws + WS_XB); float* ZF = (float*)(ws + WS_ZF); bf16* PB = (bf16*)(ws + WS_PB); \
    float* GB = (float*)(ws + WS_GB); float* LA = (float*)(ws + WS_LA); float* ORAW = (float*)(ws + WS_ORAW); bf16* YB = (bf16*)(ws + WS_YB); \
    bf16* ACT = (bf16*)(ws + WS_ACT); float* YS = (float*)(ws + WS_YS); bf16* XG = (bf16*)(ws + WS_XG); \
    int* LIST = (int*)(ws + WS_LIST); float* GW = (float*)(ws + WS_GW); \
    float* S5LB = (float*)(ws + WS_S5TAB); float* S5BB = (float*)(ws + WS_S5TAB + 32768); \
    (void)HF; (void)XB; (void)ZF; (void)PB; (void)GB; (void)LA; (void)ORAW; (void)YB; (void)ACT; (void)YS; (void)XG; (void)LIST; (void)GW; (void)S5LB; (void)S5BB;

template <int layer>
__device__ __forceinline__ void layer_body(const Frame& F, unsigned char* ws, unsigned* ctl, LAS int* TAB, const XcdBarrier& bar, const int lo, const int hi, float* d_out) {
    WS_PTRS
        const int pb = 1 + layer * 16;
        const float* hin = (layer == 0) ? x_in : HF;
        if (PHE(1) && IN(pb + 0)) {
            const bf16* Wt = (const bf16*)(ws + (layer == 0 ? WS_WT_ML_IN : layer == 1 ? WS_WT_RET_IN : layer == 2 ? WS_WT_GLA_IN : WS_WT_S5_IN));
            const int N = (layer == 0 || layer == 2) ? 3072 : (layer == 1 ? 6144 : 1024);
            pg8::DenseOrder S; S.init(XB, Wt, M, N, D, F.G, (int)blockIdx.x);
            pg8::EpiBf16 E{PB, N};
            pg8::gemm_phase<pg8::EpiBf16, pg8::DenseOrder, true, true>(F.lds, F.wave, D, S, E);
            if (layer == 0 && CH_ML) {
                const int lane = lane_id(), gt = blockIdx.x * NTHREADS + F.wave * 64 + lane;
                if (gt < 16 * NCH) { const int bh = gt / NCH, c = gt % NCH, b = bh >> 3, h = bh & 7; float a = 0.f, cm = -3.0e38f; float* GSC = (float*)(ws + WS_SC);
                    for (int l = 0; l < CL; ++l) { const int t = c * CL + l; const size_t row = (size_t)b * T + t;
                        a += log_sigmoidf_(GB[row * 16 + 8 + h]); const float gg = GB[row * 16 + h] - a; cm = fmaxf(cm, gg);
                        GSC[(size_t)(0 * 16 + bh) * T + t] = a; GSC[(size_t)(1 * 16 + bh) * T + t] = gg; GSC[(size_t)(2 * 16 + bh) * T + t] = cm; } }
            }
            SEAM(pb + 0);
        }
        if (layer == 0) {
            if (CH_ML) {
                if (IN(pb + 2)) { const int lane = lane_id(), tid = F.wave * 64 + lane; mix_phaseA<0>(F, ws, tid, lane); SEAM(pb + 2); }
                if (IN(pb + 3)) { const int lane = lane_id(), tid = F.wave * 64 + lane; mix_phaseB<0>(F, ws, tid); SEAM(pb + 3); }
                if (IN(pb + 4)) { const int lane = lane_id(), tid = F.wave * 64 + lane; mix_phaseC<0>(F, ws, tid, lane); SEAM(pb + 4); }
            } else
            if (IN(pb + 2) && !defined_SKIP_ML) { const int lane = lane_id(), tid = F.wave * 64 + lane; (void)tid;
                if (F.gw < 32) {
                    const int b = F.gw >> 4, h = (F.gw >> 1) & 7, eh = F.gw & 1, e = eh * 64 + lane;
                    float C[64];
#pragma unroll
                    for (int d = 0; d < 64; ++d) C[d] = 0.f;
                    float nl = 0.f, mst = -1e30f;
                    const bf16* prow = PB + (size_t)(b * T) * 3072;
                    const float* grow = GB + (size_t)(b * T) * 16;
                    for (int t = 0; t < T; ++t) {
                        const bf16* pr = prow + (size_t)t * 3072;
                        const float ql = bf2f(pr[h * 64 + lane]) * 0.125f, kl = bf2f(pr[512 + h * 64 + lane]), vv = bf2f(pr[1024 + h * 128 + e]);
                        const float ip = grow[t * 16 + h], fp = grow[t * 16 + 8 + h];
                        const float lf = log_sigmoidf_(fp);
                        const float mnew = fmaxf(lf + mst, ip);
                        const float fs = __expf(lf + mst - mnew), is = __expf(ip - mnew);
                        mst = mnew;
                        nl = fs * nl + is * kl;
                        const float den = wave_sum(nl * ql);
                        const float kv = is * vv; float num = 0.f;
#pragma unroll
                        for (int d = 0; d < 64; ++d) { const float kd = __builtin_bit_cast(float, __builtin_amdgcn_readlane(__builtin_bit_cast(int, kl), d)), qd = __builtin_bit_cast(float, __builtin_amdgcn_readlane(__builtin_bit_cast(int, ql), d));
                            C[d] = fs * C[d] + kv * kd; num += C[d] * qd; }
                        ORAW[(size_t)(b * T + t) * 1024 + h * 128 + e] = num / fmaxf(fabsf(den), __expf(-mnew));
                    }
                }
                SEAM(pb + 2);
            }
        } else if (layer == 1) {
            if (IN(pb + 1)) { const int lane = lane_id(), tid = F.wave * 64 + lane; (void)tid;
                for (int it = blockIdx.x * NTHREADS + tid; it < T * 64; it += F.G * NTHREADS) {
                    const int t = it >> 6, i = it & 63;
                    const float inv = exp2f(-(float)(2 * i) * (13.287712379549449f / 128.f));
                    float sn, cs; sincosf((float)t * inv, &sn, &cs);
                    for (int b = 0; b < 2; ++b) { bf16* pr = PB + (size_t)(b * T + t) * 6144;
                        for (int qk = 0; qk < 2; ++qk) { const float sc = qk ? 0.08838834764831845f : 1.f;
                            for (int h = 0; h < 8; ++h) { bf16* p = pr + qk * 1024 + h * 128 + i; const float t1 = bf2f(p[0]), t2 = bf2f(p[64]);
                                p[0] = (bf16)f2bf((t1 * cs - t2 * sn) * sc); p[64] = (bf16)f2bf((t1 * sn + t2 * cs) * sc); } } }
                }
                SEAM(pb + 1);
            }
            if (CH_RET) {
                if (IN(pb + 2)) { const int lane = lane_id(), tid = F.wave * 64 + lane; mix_phaseA<1>(F, ws, tid, lane); SEAM(pb + 2); }
                if (IN(pb + 3)) { const int lane = lane_id(), tid = F.wave * 64 + lane; mix_phaseB<1>(F, ws, tid); SEAM(pb + 3); }
                if (IN(pb + 4)) { const int lane = lane_id(), tid = F.wave * 64 + lane; mix_phaseC<1>(F, ws, tid, lane); SEAM(pb + 4); }
            } else
            if (IN(pb + 2) && !defined_SKIP_RET) { const int lane = lane_id(), tid = F.wave * 64 + lane; (void)tid;
                if (F.gw < 64) {
                    const int b = F.gw >> 5, h = (F.gw >> 2) & 7, e = (F.gw & 3) * 64 + lane;
                    const float gamma = 1.f - exp2f(-5.f - (float)h);
                    float S[128];
#pragma unroll
                    for (int d = 0; d < 128; ++d) S[d] = 0.f;
                    const bf16* prow = PB + (size_t)(b * T) * 6144;
                    for (int t = 0; t < T; ++t) {
                        const bf16* pr = prow + (size_t)t * 6144;
                        const float q0 = bf2f(pr[h * 128 + lane]), q1 = bf2f(pr[h * 128 + 64 + lane]), k0 = bf2f(pr[1024 + h * 128 + lane]), k1 = bf2f(pr[1024 + h * 128 + 64 + lane]);
                        const float vv = bf2f(pr[2048 + h * 256 + e]);
                        float o = 0.f;
#pragma unroll
                        for (int d = 0; d < 64; ++d) {
                            const float kd = __builtin_bit_cast(float, __builtin_amdgcn_readlane(__builtin_bit_cast(int, k0), d)), qd = __builtin_bit_cast(float, __builtin_amdgcn_readlane(__builtin_bit_cast(int, q0), d));
                            S[d] = gamma * S[d] + kd * vv; o += qd * S[d];
                            const float kd1 = __builtin_bit_cast(float, __builtin_amdgcn_readlane(__builtin_bit_cast(int, k1), d)), qd1 = __builtin_bit_cast(float, __builtin_amdgcn_readlane(__builtin_bit_cast(int, q1), d));
                            S[64 + d] = gamma * S[64 + d] + kd1 * vv; o += qd1 * S[64 + d]; }
                        ORAW[(size_t)(b * T + t) * 2048 + h * 256 + e] = o;
                    }
                }
                SEAM(pb + 2);
            }
        } else if (layer == 2) {
            if (CH_GLA) {
                if (IN(pb + 1)) {
                    const int lane = lane_id(), gt = blockIdx.x * NTHREADS + F.wave * 64 + lane;
                    if (gt < 2 * NCH * 512) { const int ch = gt & 511, bc = gt >> 9, b = bc / NCH, c = bc % NCH; const size_t row0 = (size_t)b * T + (size_t)c * CL;
                        bf16* KPP = (bf16*)(ws + WS_KPP); float* DEC = (float*)(ws + WS_SC + 3 * MiB);
                        float bend = 0.f;
#pragma unroll 8
                        for (int l = 0; l < CL; ++l) bend += LA[(row0 + l) * 512 + ch];
                        float bcum = 0.f;
#pragma unroll 8
                        for (int l = 0; l < CL; ++l) { bcum += LA[(row0 + l) * 512 + ch]; bf16* pr = PB + (row0 + l) * 3072;
                            const float qv = bf2f(pr[ch]), kv = bf2f(pr[512 + ch]) * 0.08838834764831845f;
                            pr[ch] = (bf16)f2bf(qv * __expf(bcum)); pr[512 + ch] = (bf16)f2bf(kv * __expf(-bcum)); KPP[(row0 + l) * 512 + ch] = (bf16)f2bf(kv * __expf(bend - bcum)); }
                        DEC[(size_t)bc * 512 + ch] = __expf(bend); }
                    SEAM(pb + 1);
                }
                if (IN(pb + 2)) { const int lane = lane_id(), tid = F.wave * 64 + lane; mix_phaseA<2>(F, ws, tid, lane); SEAM(pb + 2); }
                if (IN(pb + 3)) { const int lane = lane_id(), tid = F.wave * 64 + lane; mix_phaseB<2>(F, ws, tid); SEAM(pb + 3); }
                if (IN(pb + 4)) { const int lane = lane_id(), tid = F.wave * 64 + lane; mix_phaseC<2>(F, ws, tid, lane); SEAM(pb + 4); }
            } else
            if (IN(pb + 2) && !defined_SKIP_GLA) { const int lane = lane_id(), tid = F.wave * 64 + lane; (void)tid;
                if (F.gw < 32) {
                    const int b = F.gw >> 4, h = (F.gw >> 2) & 3, e = (F.gw & 3) * 64 + lane;
                    float S[128];
#pragma unroll
                    for (int d = 0; d < 128; ++d) S[d] = 0.f;
                    const bf16* prow = PB + (size_t)(b * T) * 3072;
                    const float* larow = LA + (size_t)(b * T) * 512;
                    for (int t = 0; t < T; ++t) {
                        const bf16* pr = prow + (size_t)t * 3072;
                        const float q0 = bf2f(pr[h * 128 + lane]), q1 = bf2f(pr[h * 128 + 64 + lane]);
                        const float k0 = bf2f(pr[512 + h * 128 + lane]) * 0.08838834764831845f, k1 = bf2f(pr[512 + h * 128 + 64 + lane]) * 0.08838834764831845f;
                        const float a0 = __expf(larow[(size_t)t * 512 + h * 128 + lane]), a1 = __expf(larow[(size_t)t * 512 + h * 128 + 64 + lane]);
                        const float vv = bf2f(pr[1024 + h * 256 + e]);
                        float o = 0.f;
#pragma unroll
                        for (int d = 0; d < 64; ++d) {
                            const float kd = __builtin_bit_cast(float, __builtin_amdgcn_readlane(__builtin_bit_cast(int, k0), d)), qd = __builtin_bit_cast(float, __builtin_amdgcn_readlane(__builtin_bit_cast(int, q0), d)), ad = __builtin_bit_cast(float, __builtin_amdgcn_readlane(__builtin_bit_cast(int, a0), d));
                            S[d] = ad * S[d] + kd * vv; o += qd * S[d];
                            const float kd1 = __builtin_bit_cast(float, __builtin_amdgcn_readlane(__builtin_bit_cast(int, k1), d)), qd1 = __builtin_bit_cast(float, __builtin_amdgcn_readlane(__builtin_bit_cast(int, q1), d)), ad1 = __builtin_bit_cast(float, __builtin_amdgcn_readlane(__builtin_bit_cast(int, a1), d));
                            S[64 + d] = ad1 * S[64 + d] + kd1 * vv; o += qd1 * S[64 + d]; }
                        ORAW[(size_t)(b * T + t) * 1024 + h * 256 + e] = o;
                    }
                }
                SEAM(pb + 2);
            }
        } else {
            if (CH_S5) {
                if (IN(pb + 2)) { const int lane = lane_id(); s5_phaseA(F, ws, lane); SEAM(pb + 2); }
                if (IN(pb + 3)) { const int lane = lane_id(), tid = F.wave * 64 + lane; s5_phaseB(F, ws, tid); SEAM(pb + 3); }
                if (IN(pb + 4)) { const int lane = lane_id(); s5_phaseC(F, ws, lane, INP(22)); SEAM(pb + 4); }
            } else
            if (IN(pb + 2) && !defined_SKIP_S5) { const int lane = lane_id(), tid = F.wave * 64 + lane; (void)tid;
                if (F.gw < 128) {
                    const int b = F.gw >> 6, g = F.gw & 63, p = lane;
                    const float* c_re = INP(20); const float* c_im = INP(21); const float* dsk = INP(22);
                    const float lbr = S5LB[(g * 64 + p) * 2], lbi = S5LB[(g * 64 + p) * 2 + 1];
                    float bbr[16], bbi[16], cr[16], ci[16];
#pragma unroll
                    for (int h = 0; h < 16; ++h) { bbr[h] = S5BB[((g * 64 + p) * 16 + h) * 2]; bbi[h] = S5BB[((g * 64 + p) * 16 + h) * 2 + 1]; cr[h] = c_re[(g * 16 + h) * 64 + p]; ci[h] = c_im[(g * 16 + h) * 64 + p]; }
                    const float dl = (lane < 16) ? dsk[g * 16 + lane] : 0.f;
                    float sr = 0.f, si = 0.f;
                    for (int t = 0; t < T; ++t) {
                        const size_t row = (size_t)(b * T + t);
                        const float ul = (lane < 16) ? bf2f(PB[row * 1024 + g * 16 + lane]) : 0.f;
                        float bur = 0.f, bui = 0.f;
#pragma unroll
                        for (int h = 0; h < 16; ++h) { const float uh = __builtin_bit_cast(float, __builtin_amdgcn_readlane(__builtin_bit_cast(int, ul), h)); bur += bbr[h] * uh; bui += bbi[h] * uh; }
                        const float nr = lbr * sr - lbi * si + bur, ni = lbr * si + lbi * sr + bui; sr = nr; si = ni;
                        float yl = 0.f;
#pragma unroll
                        for (int h = 0; h < 16; ++h) { const float yv = wave_sum(cr[h] * sr - ci[h] * si); yl = (lane == h) ? yv : yl; }
                        if (lane < 16) { const float y = yl + dl * ul; YB[row * 1024 + g * 16 + lane] = (bf16)f2bf(gelu_tanh(y)); }
                    }
                }
                SEAM(pb + 2);
            }
        }
        if (PHE(3) && layer < 3 && IN(pb + 5)) { const int lane = lane_id(), tid = F.wave * 64 + lane; (void)tid;
            const int nh = (layer == 2) ? 4 : 8, dv = (layer == 0) ? 128 : 256, DV = nh * dv, ldp = (layer == 1) ? 6144 : 3072, goff = (layer == 1) ? 4096 : 2048;
            const float* ng = INP(layer == 0 ? 5 : layer == 1 ? 8 : 13);
            for (int it = F.gw; it < M * nh; it += F.NGW) {
                const int row = it / nh, h = it - row * nh;
                const float* src = ORAW + (size_t)row * DV + h * dv;
                float xv[4]; const int per = dv / 64;
                float s = 0.f;
#pragma unroll
                for (int j = 0; j < 4; ++j) { xv[j] = (j < per) ? src[lane + 64 * j] : 0.f; s += xv[j]; }
                const float mean = wave_sum(s) / (float)dv; float s2 = 0.f;
#pragma unroll
                for (int j = 0; j < 4; ++j) { const float dlt = (j < per) ? xv[j] - mean : 0.f; s2 += dlt * dlt; }
                const float rstd = 1.f / sqrtf(wave_sum(s2) / (float)dv + LN_EPS);
#pragma unroll
                for (int j = 0; j < 4; ++j) if (j < per) { const int c = h * dv + lane + 64 * j; const float gt = bf2f(PB[(size_t)row * ldp + goff + c]);
                    const float gate = (layer == 0) ? sigmoidf_(gt) : gt * sigmoidf_(gt);
                    YB[(size_t)row * DV + c] = (bf16)f2bf(gate * (xv[j] - mean) * rstd * ng[c]); }
            }
            SEAM(pb + 5);
        }
        if (PHE(4) && layer == 3 && IN(pb + 6)) {
            pg8::DenseOrder S; S.init(YB, ws + WS_WT_S5_GLU, M, D, D, F.G, (int)blockIdx.x);
            pg8::EpiGlu E{YB, INP(25), (bf16*)ORAW};
            pg8::gemm_phase<pg8::EpiGlu, pg8::DenseOrder, true, true>(F.lds, F.wave, D, S, E);
            SEAM(pb + 6);
        }
        if (PHE(5) && IN(pb + 7)) {
            const bf16* Wt = (const bf16*)(ws + (layer == 0 ? WS_WT_ML_OUT : layer == 1 ? WS_WT_RET_OUT : layer == 2 ? WS_WT_GLA_OUT : WS_WT_S5_OUT));
            const int Kd = (layer == 1) ? 2048 : 1024;
            const bf16* Ain = (layer == 3) ? (const bf16*)ORAW : YB;
            pg8::DenseOrder S; S.init(Ain, Wt, M, D, Kd, F.G, (int)blockIdx.x);
            pg8::EpiResid E{hin, ZF};
            pg8::gemm_phase<pg8::EpiResid, pg8::DenseOrder, true, true>(F.lds, F.wave, Kd, S, E);
            SEAM(pb + 7);
        }
        unsigned* cnt = ctl + CW_CNT + layer * 32 * 64;
        if (IN(pb + 8) && !defined_SKIP_LN1) { const int lane = lane_id(), tid = F.wave * 64 + lane; (void)tid;
            LAS float* Wt = (LAS float*)(F.lds);
            { const float* wr_ = INP(27) + (size_t)layer * D * NEXP;
              for (int i = tid; i < D * NEXP; i += NTHREADS) { const int e = i & 31, k = i >> 5; Wt[e * 1028 + k] = wr_[i]; } }
            __syncthreads();
            const float* br_ = INP(28) + layer * NEXP;
            const float* lng_ = ln_g + (size_t)(layer * 2 + 0) * D; const float* lnb_ = ln_b + (size_t)(layer * 2 + 0) * D;
            for (int row = F.gw; row < M; row += F.NGW) {
                asm volatile("" ::: "memory");
                f32x4 v[4]; load_row_f32(ZF + (size_t)row * D, v, lane);
                { f32x4 gv[4], bv[4]; load_row_f32(lng_, gv, lane); load_row_f32(lnb_, bv, lane); ln_row(v, gv, bv); }
                store_row_f32(HF + (size_t)row * D, v, lane);
                store_row_bf16(XB + (size_t)row * D, v, lane);
                float lg[32];
#pragma unroll
                for (int e = 0; e < 32; ++e) { float s = 0.f;
#pragma unroll
                    for (int j = 0; j < 4; ++j) { const f32x4 w = *(const LAS f32x4*)(Wt + e * 1028 + 4 * (lane + 64 * j)); s += v[j][0] * w[0] + v[j][1] * w[1] + v[j][2] * w[2] + v[j][3] * w[3]; }
                    lg[e] = wave_sum(s) + br_[e]; }
                int te[4]; float tv[4];
#pragma unroll
                for (int k = 0; k < 4; ++k) { float best = -3.0e38f; int bi = 0;
#pragma unroll
                    for (int e = 0; e < 32; ++e) { const bool taken = (k > 0 && te[0] == e) || (k > 1 && te[1] == e) || (k > 2 && te[2] == e); if (!taken && lg[e] > best) { best = lg[e]; bi = e; } }
                    te[k] = bi; tv[k] = best; }
                const float e0 = 1.f, e1 = __expf(tv[1] - tv[0]), e2 = __expf(tv[2] - tv[0]), e3 = __expf(tv[3] - tv[0]), rs = 1.f / (e0 + e1 + e2 + e3);
                int pos = 0;
                if (lane < 4) { const int ek = lane == 0 ? te[0] : lane == 1 ? te[1] : lane == 2 ? te[2] : te[3]; const float gk = (lane == 0 ? e0 : lane == 1 ? e1 : lane == 2 ? e2 : e3) * rs;
                    pos = (int)__hip_atomic_fetch_add(cnt + ek * 64, 1u, __ATOMIC_RELAXED, __HIP_MEMORY_SCOPE_AGENT);
                    LIST[(size_t)ek * CAP + pos] = row * 4 + lane; GW[row * 4 + lane] = gk; }
#pragma unroll
                for (int k = 0; k < 4; ++k) { const int pk = __shfl(pos, k); store_row_bf16(XG + ((size_t)te[k] * CAP + pk) * D, v, lane); }
            }
            __syncthreads();
            SEAM(pb + 8);
        }
        if ((PHE(7) || PHE(8)) && (IN(pb + 9) || IN(pb + 10))) { const int lane = lane_id(), tid = F.wave * 64 + lane; (void)tid;
            __syncthreads();
            if (tid < 32) TAB[tid] = (int)__hip_atomic_load(cnt + tid * 64, __ATOMIC_RELAXED, __HIP_MEMORY_SCOPE_AGENT);
            __syncthreads();
            if (tid == 0) { int acc = 0; for (int e = 0; e < 32; ++e) { TAB[32 + e] = acc; const int nt_ = (TAB[e] + 255) >> 8; for (int j = 0; j < nt_; ++j) TAB[72 + acc + j] = e; acc += nt_; } TAB[64] = acc; }
            __syncthreads();
        }
        if (PHE(7) && IN(pb + 9)) {
            pg8::MoeOrder S; S.A = (const char*)XG; S.Bt = (const char*)(ws + WS_WT_GU + (size_t)layer * 32 * 2048 * 1024 * 2); S.tab = TAB; S.K = D; S.nN = 8; S.ntiles = __builtin_amdgcn_readfirstlane(TAB[64]); S.nwg = S.ntiles * 8; S.G = F.G; S.c = (int)blockIdx.x;
            S.b_estride = (size_t)2048 * 1024 * 2; S.a_compact = 0;
            pg8::EpiSwiglu E{ACT, INP(30) + (size_t)layer * 32 * 2048};
            pg8::gemm_phase<pg8::EpiSwiglu, pg8::MoeOrder, true, true>(F.lds, F.wave, D, S, E);
            SEAM(pb + 9);
        }
        if (PHE(8) && IN(pb + 10)) {
            pg8::MoeOrder S; S.A = (const char*)ACT; S.Bt = (const char*)(ws + WS_WT_DN + (size_t)layer * 32 * 1024 * 1024 * 2); S.tab = TAB; S.K = DFF; S.nN = 4; S.ntiles = __builtin_amdgcn_readfirstlane(TAB[64]); S.nwg = S.ntiles * 4; S.G = F.G; S.c = (int)blockIdx.x;
            S.b_estride = (size_t)1024 * 1024 * 2; S.a_compact = 1;
            pg8::EpiMoeDown E{YS, INP(32) + (size_t)layer * 32 * 1024, LIST, GW, TAB};
            pg8::gemm_phase<pg8::EpiMoeDown, pg8::MoeOrder, true, true>(F.lds, F.wave, DFF, S, E);
            SEAM(pb + 10);
        }
        if (PHE(9) && IN(pb + 11)) { const int lane = lane_id(), tid = F.wave * 64 + lane; (void)tid;
            LAS float* Wt = (LAS float*)(F.lds);
            if (layer == 1) { load_cols16(tid, INP(10), 3088, 3072, Wt); __syncthreads(); }
            const float* lng_ = ln_g + (size_t)(layer * 2 + 1) * D; const float* lnb_ = ln_b + (size_t)(layer * 2 + 1) * D;
            float* outp = (layer == 3) ? d_out : HF;
            for (int row = F.gw; row < M; row += F.NGW) {
                asm volatile("" ::: "memory");
                f32x4 v[4], y[4]; load_row_f32(HF + (size_t)row * D, v, lane);
#pragma unroll
                for (int j = 0; j < 4; ++j) v[j] = v[j] * ALPHA;
#pragma unroll
                for (int k = 0; k < 4; ++k) { load_row_f32(YS + ((size_t)row * 4 + k) * D, y, lane);
#pragma unroll
                    for (int j = 0; j < 4; ++j) v[j] = v[j] + y[j]; }
                { f32x4 gv[4], bv[4]; load_row_f32(lng_, gv, lane); load_row_f32(lnb_, bv, lane); ln_row(v, gv, bv); }
                store_row_f32(outp + (size_t)row * D, v, lane);
                if (layer < 3) store_row_bf16(XB + (size_t)row * D, v, lane);
                if (layer == 1) {
                    float z[16]; row_dot16(v, Wt, lane, z);
                    if (lane < 16) { float o = 0.f;
#pragma unroll
                        for (int e = 0; e < 16; ++e) o = (lane == e) ? z[e] : o;
                        GB[(size_t)row * 16 + lane] = o; }
                }
            }
            if (layer == 1) {
                __syncthreads();
                const float* wgp = INP(11); const float bgc = INP(12)[tid];
                float wg[16];
#pragma unroll
                for (int r = 0; r < 16; ++r) wg[r] = wgp[r * 512 + tid];
                for (int row = F.vcu * NWAVES; row < M; row += F.NGW) {
#pragma unroll 1
                    for (int w = 0; w < NWAVES; ++w) { const float* zr = GB + (size_t)(row + w) * 16; float sacc = bgc;
#pragma unroll
                        for (int r = 0; r < 16; ++r) sacc += zr[r] * wg[r];
                        LA[(size_t)(row + w) * 512 + tid] = log_sigmoidf_(sacc) * (1.f / 16.f); }
                }
            }
            __syncthreads();
            SEAM(pb + 11);
        }
}
__global__ void __launch_bounds__(NTHREADS, 2) mega_fwd(Args args) {
    extern __shared__ __attribute__((aligned(16))) unsigned char lds_raw[];
    Frame F;
    F.lds = (LAS unsigned char*)lds_raw;
    F.wave = __builtin_amdgcn_readfirstlane((int)threadIdx.x >> 6);
    F.G = gridDim.x; { const int bx = blockIdx.x; F.vcu = (F.G % 8 == 0) ? (bx % 8) * (F.G / 8) + bx / 8 : bx; }
    F.gw = F.vcu * NWAVES + F.wave; F.NGW = F.G * NWAVES;
    unsigned char* ws = args.ws;
    unsigned* ctl = (unsigned*)(ws + WS_CTL);
    volatile LAS unsigned* MISC = (volatile LAS unsigned*)(F.lds + MISC_OFF);
    LAS int* TAB = (LAS int*)(F.lds + TAB_OFF);
    { const int tid0 = threadIdx.x;
      if (tid0 < 64) MISC[tid0] = 0u;
      if (tid0 < 33) ((LAS unsigned long long*)(F.lds + MISC_OFF + 256))[tid0] = (unsigned long long)args.in[tid0]; }
    __syncthreads();
    XcdBarrier bar = xcd_barrier_post(ctl + CW_BAR, MISC + 8, F.wave == 0 && lane_id() == 0);
    const int lo = args.ph_lo, hi = args.ph_hi;
    WS_PTRS
    if (IN(0) && !defined_SKIP_P0) { const int lane = lane_id(), tid = F.wave * 64 + lane; (void)tid;
        LAS unsigned char* scr = F.lds + F.wave * 8704;
#define TR_MAT(src_, ldw_, K_, N_, dst_, mode_, count_, sstride_, dstride_) do { \
            const int nkb = (K_) / 64, nnb = (N_) / 64, per = nkb * nnb, total = per * (count_); \
            _Pragma("unroll 1") for (int it = F.gw; it < total; it += F.NGW) { \
                const int q = it / per, r = it - q * per, kb = r / nnb, nb = r - kb * nnb; \
                transpose_item((src_) + (size_t)q * (sstride_), (ldw_), 0, (K_), (dst_) + (size_t)q * (dstride_), (mode_), kb, nb, scr, lane); } } while (0)
        TR_MAT(INP(29), 2048, 1024, 2048, (bf16*)(ws + WS_WT_GU), 1, 128, (size_t)1024 * 2048, (size_t)2048 * 1024);
        TR_MAT(INP(31), 1024, 1024, 1024, (bf16*)(ws + WS_WT_DN), 0, 128, (size_t)1024 * 1024, (size_t)1024 * 1024);
        TR_MAT(INP(3), 3088, 1024, 3072, (bf16*)(ws + WS_WT_ML_IN), 0, 1, (size_t)0, (size_t)0);
        TR_MAT(INP(6), 1024, 1024, 1024, (bf16*)(ws + WS_WT_ML_OUT), 0, 1, (size_t)0, (size_t)0);
        TR_MAT(INP(7), 6144, 1024, 6144, (bf16*)(ws + WS_WT_RET_IN), 0, 1, (size_t)0, (size_t)0);
        TR_MAT(INP(9), 1024, 2048, 1024, (bf16*)(ws + WS_WT_RET_OUT), 0, 1, (size_t)0, (size_t)0);
        TR_MAT(INP(10), 3088, 1024, 3072, (bf16*)(ws + WS_WT_GLA_IN), 0, 1, (size_t)0, (size_t)0);
        TR_MAT(INP(14), 1024, 1024, 1024, (bf16*)(ws + WS_WT_GLA_OUT), 0, 1, (size_t)0, (size_t)0);
        TR_MAT(INP(15), 1024, 1024, 1024, (bf16*)(ws + WS_WT_S5_IN), 0, 1, (size_t)0, (size_t)0);
        TR_MAT(INP(24), 1024, 1024, 1024, (bf16*)(ws + WS_WT_S5_GLU), 0, 1, (size_t)0, (size_t)0);
        TR_MAT(INP(26), 1024, 1024, 1024, (bf16*)(ws + WS_WT_S5_OUT), 0, 1, (size_t)0, (size_t)0);
#undef TR_MAT
        __syncthreads();
        {
            const float* lam_re = INP(16); const float* lam_im = INP(17); const float* b_re = INP(18); const float* b_im = INP(19); const float* log_dt = INP(23);
            for (int i = blockIdx.x * NTHREADS + tid; i < 64 * 64; i += F.G * NTHREADS) {
                const int g = i >> 6;
                const float lr = lam_re[i], li = lam_im[i], dt = expf(log_dt[g]);
                const float er = expf(lr * dt); float sn, cs; sincosf(li * dt, &sn, &cs);
                const float br = er * cs, bi = er * sn;
                S5LB[2 * i] = br; S5LB[2 * i + 1] = bi;
                const float nr = br - 1.f, ni = bi, den = lr * lr + li * li;
                const float fr_ = (nr * lr + ni * li) / den, fi_ = (ni * lr - nr * li) / den;
                for (int h = 0; h < 16; ++h) { const float xr = b_re[i * 16 + h], xi = b_im[i * 16 + h];
                    S5BB[(i * 16 + h) * 2] = fr_ * xr - fi_ * xi; S5BB[(i * 16 + h) * 2 + 1] = fr_ * xi + fi_ * xr; }
            }
        }
        if (CH_S5) s5_tables(F, ws, tid, INP(16), INP(17), INP(18), INP(19), INP(20), INP(21), INP(23));
        LAS float* Wt = (LAS float*)(F.lds);
        load_cols16(tid, INP(3), 3088, 3072, Wt);
        __syncthreads();
        {
            const float* bg = INP(4);
            for (int row = F.gw; row < M; row += F.NGW) {
                asm volatile("" ::: "memory");
                f32x4 v[4]; load_row_f32(x_in + (size_t)row * D, v, lane);
                store_row_bf16(XB + (size_t)row * D, v, lane);
                float g[16]; row_dot16(v, Wt, lane, g);
                if (lane < 16) { float o = 0.f;
#pragma unroll
                    for (int e = 0; e < 16; ++e) o = (lane == e) ? g[e] : o;
                    GB[(size_t)row * 16 + lane] = o + bg[lane]; }
            }
        }
        __syncthreads();
        SEAM(0);
    }

    layer_body<0>(F, ws, ctl, TAB, bar, lo, hi, args.out);
    layer_body<1>(F, ws, ctl, TAB, bar, lo, hi, args.out);
    layer_body<2>(F, ws, ctl, TAB, bar, lo, hi, args.out);
    layer_body<3>(F, ws, ctl, TAB, bar, lo, hi, args.out);
#undef IN
#undef SEAM
#undef INP
#undef x_in
#undef ln_g
#undef ln_b
}

extern "C" void kernel_launch(void* const* d_in, const int* in_sizes, int n_in, void* d_out, int out_size, void* d_ws, size_t ws_size, hipStream_t stream) {
    static int grid = 0;
    if (grid == 0) {
        if (n_in != 33 || out_size != M * D || ws_size < WS_END) { fprintf(stderr, "kernel_launch: unexpected problem (n_in %d, out %d, ws %zu < %zu)\n", n_in, out_size, ws_size, (size_t)WS_END); grid = -1; return; }
        int dev = 0, cus = 0, per_cu = 0;
        if (hipGetDevice(&dev) != hipSuccess || hipDeviceGetAttribute(&cus, hipDeviceAttributeMultiprocessorCount, dev) != hipSuccess) { grid = -1; return; }
        if (hipFuncSetAttribute((const void*)mega_fwd, hipFuncAttributeMaxDynamicSharedMemorySize, LDS_BYTES) != hipSuccess) { fprintf(stderr, "kernel_launch: hipFuncSetAttribute failed\n"); grid = -1; return; }
        if (hipOccupancyMaxActiveBlocksPerMultiprocessor(&per_cu, (const void*)mega_fwd, NTHREADS, LDS_BYTES) != hipSuccess || per_cu < 1) { fprintf(stderr, "kernel_launch: occupancy query says %d\n", per_cu); }
        (void)hipGetLastError();
        grid = cus;
    }
    if (grid < 0) return;
    hipMemsetAsync((char*)d_ws + WS_CTL, 0, CTL_ZERO_BYTES, stream);
    Args a{};
    for (int i = 0; i < 33; ++i) a.in[i] = (const float*)d_in[i];
    a.out = (float*)d_out; a.ws = (unsigned char*)d_ws;
#if N_LAUNCH_MODE == 1
    a.ph_lo = 0; a.ph_hi = 1000;
    hipLaunchKernelGGL(mega_fwd, dim3(grid), dim3(NTHREADS), LDS_BYTES, stream, a);
#else
    for (int ph = 0; ph < 65; ++ph) { a.ph_lo = ph; a.ph_hi = ph + 1; hipLaunchKernelGGL(mega_fwd, dim3(grid), dim3(NTHREADS), LDS_BYTES, stream, a); }
#endif
}
```

```cpp
#include <hip/hip_runtime.h>
#include <cstdio>
#include <cstdint>

#ifndef NAIVE_MIX
#define NAIVE_MIX 1
#endif
#ifndef CH_ML
#define CH_ML 1
#endif
#ifndef CH_RET
#define CH_RET 1
#endif
#ifndef CH_GLA
#define CH_GLA 1
#endif
#ifndef CH_S5
#define CH_S5 1
#endif
#ifndef PROBE_CLS
#define PROBE_CLS 0
#endif
#define REPS(c) ((PROBE_CLS == (c)) ? 2 : 1)
#ifndef N_LAUNCH_MODE
#define N_LAUNCH_MODE 1
#endif


#ifdef SKIP_ML
constexpr bool defined_SKIP_ML = true;
#else
constexpr bool defined_SKIP_ML = false;
#endif
#ifdef SKIP_RET
constexpr bool defined_SKIP_RET = true;
#else
constexpr bool defined_SKIP_RET = false;
#endif
#ifdef SKIP_GLA
constexpr bool defined_SKIP_GLA = true;
#else
constexpr bool defined_SKIP_GLA = false;
#endif
#ifdef SKIP_S5
constexpr bool defined_SKIP_S5 = true;
#else
constexpr bool defined_SKIP_S5 = false;
#endif
#ifdef SKIP_LN1
constexpr bool defined_SKIP_LN1 = true;
#else
constexpr bool defined_SKIP_LN1 = false;
#endif
#ifdef SKIP_P0
constexpr bool defined_SKIP_P0 = true;
#else
constexpr bool defined_SKIP_P0 = false;
#endif
#ifndef PHMASK
#define PHMASK 0xffff
#endif
#define PHE(b) (((PHMASK) >> (b)) & 1)
#define GAS __attribute__((address_space(1)))
#define LAS __attribute__((address_space(3)))
typedef unsigned short bf16;
typedef short bf16x8 __attribute__((ext_vector_type(8)));
typedef float f32x4 __attribute__((ext_vector_type(4)));
typedef float f32x2 __attribute__((ext_vector_type(2)));
typedef unsigned u32x4 __attribute__((ext_vector_type(4)));
typedef unsigned u32x2 __attribute__((ext_vector_type(2)));

constexpr int BATCH = 2, T = 8192, D = 1024, M = BATCH * T;
constexpr int NEXP = 32, TOPK = 4, DFF = 1024, CAP = M;
constexpr int NWAVES = 8, NTHREADS = 512;
constexpr float LN_EPS = 1e-5f;
constexpr float ALPHA = 1.681792830507429f;
constexpr int MAXTILES = (M * TOPK) / 256 + NEXP;

constexpr size_t MiB = 1u << 20;
constexpr size_t WS_CTL = 0, CTL_ZERO_BYTES = 1 * MiB;
constexpr size_t WS_WT_ML_IN = 1 * MiB;
constexpr size_t WS_WT_ML_OUT = WS_WT_ML_IN + 6 * MiB;
constexpr size_t WS_WT_RET_IN = WS_WT_ML_OUT + 2 * MiB;
constexpr size_t WS_WT_RET_OUT = WS_WT_RET_IN + 12 * MiB;
constexpr size_t WS_WT_GLA_IN = WS_WT_RET_OUT + 4 * MiB;
constexpr size_t WS_WT_GLA_OUT = WS_WT_GLA_IN + 6 * MiB;
constexpr size_t WS_WT_S5_IN = WS_WT_GLA_OUT + 2 * MiB;
constexpr size_t WS_WT_S5_GLU = WS_WT_S5_IN + 2 * MiB;
constexpr size_t WS_WT_S5_OUT = WS_WT_S5_GLU + 2 * MiB;
constexpr size_t WS_S5TAB = WS_WT_S5_OUT + 2 * MiB;
constexpr size_t WS_GB = WS_S5TAB + 1 * MiB;
constexpr size_t WS_LIST = WS_GB + 1 * MiB;
constexpr size_t WS_GW = WS_LIST + 2 * MiB;
constexpr size_t WS_WT_GU = WS_GW + 1 * MiB;
constexpr size_t WS_WT_DN = WS_WT_GU + 512 * MiB;
constexpr size_t WS_HF = WS_WT_DN + 256 * MiB;
constexpr size_t WS_XB = WS_HF + 64 * MiB;
constexpr size_t WS_ZF = WS_XB + 32 * MiB;
constexpr size_t WS_PB = WS_ZF + 64 * MiB;
constexpr size_t WS_LA = WS_PB + 192 * MiB;
constexpr size_t WS_ORAW = WS_LA + 32 * MiB;
constexpr size_t WS_YB = WS_ORAW + 128 * MiB;
constexpr size_t WS_ACT = WS_YB + 64 * MiB;
constexpr size_t WS_YS = WS_ACT + 144 * MiB;
constexpr size_t WS_XG = WS_YS + 256 * MiB;
constexpr size_t WS_UT = WS_XG + 1024 * MiB;
constexpr size_t WS_ST = WS_UT + 128 * MiB;
constexpr size_t WS_KPP = WS_ST + 64 * MiB;
constexpr size_t WS_SC = WS_KPP + 16 * MiB;
constexpr size_t WS_S5KT = WS_SC + 4 * MiB;
constexpr size_t WS_S5VT = WS_S5KT + 2 * MiB;
constexpr size_t WS_S5WT = WS_S5VT + 16 * MiB;
constexpr size_t WS_S5L64 = WS_S5WT + 16 * MiB;
constexpr size_t WS_S5SL = WS_S5L64 + 1 * MiB;
constexpr size_t WS_S5SP = WS_S5SL + 16 * MiB;
constexpr size_t WS_END = WS_S5SP + 8 * MiB;
constexpr int CW_BAR = 4096;
constexpr int CW_CNT = 16384;

constexpr int PH_BYTES = 139264;
constexpr int TAB_OFF = PH_BYTES;
constexpr int MISC_OFF = TAB_OFF + 4096;
constexpr int LDS_BYTES = 147456;

__device__ __forceinline__ unsigned f2bf(float f) { unsigned u = __builtin_bit_cast(unsigned, f); return (u + 0x7fffu + ((u >> 16) & 1u)) >> 16; }
__device__ __forceinline__ unsigned pk2(float lo, float hi) { return f2bf(lo) | (f2bf(hi) << 16); }
__device__ __forceinline__ float bf2f(unsigned short b) { return __builtin_bit_cast(float, ((unsigned)b) << 16); }
__device__ __forceinline__ float bflo(unsigned w) { return __builtin_bit_cast(float, w << 16); }
__device__ __forceinline__ float bfhi(unsigned w) { return __builtin_bit_cast(float, w & 0xffff0000u); }
__device__ __forceinline__ int lane_id() { int l; asm volatile("v_mbcnt_lo_u32_b32 %0, -1, 0\n\tv_mbcnt_hi_u32_b32 %0, -1, %0" : "=v"(l)); return l; }
__device__ __forceinline__ float wave_sum(float v) {
#pragma unroll
    for (int o = 1; o < 64; o <<= 1) v += __shfl_xor(v, o);
    return v;
}
__device__ __forceinline__ float sigmoidf_(float x) { return 1.f / (1.f + __expf(-x)); }
__device__ __forceinline__ float log_sigmoidf_(float x) { return fminf(x, 0.f) - log1pf(__expf(-fabsf(x))); }
__device__ __forceinline__ float gelu_tanh(float x) { const float u = 0.7978845608028654f * (x + 0.044715f * x * x * x); return 0.5f * x * (1.f + tanhf(u)); }

namespace pg8 {
constexpr int BM = 256, BK = 64, HALF = 128, HTB = HALF * BK * 2, STAGE_BYTES = 8 * HTB, NXCD = 8, WGM = 8;
__host__ __device__ __forceinline__ int lds_byte(int r, int c) { const int st = (r >> 4) * 2 + (c >> 5), rr = r & 15, cc = c & 31, ob = rr * 64 + cc * 2; return st * 1024 + (ob ^ (((ob >> 9) & 1) << 5)); }
__host__ __device__ __forceinline__ void stage_rc(int b, int& R, int& C) { const int st = b / 1024, sb = b % 1024, swz = sb ^ (((sb >> 9) & 1) << 5); R = (st >> 1) * 16 + swz / 64; C = (st & 1) * 32 + (swz % 64) / 2; }
__host__ __device__ __forceinline__ int perm32(int rho) { const int n = rho >> 4, i = rho & 15; return 8 * (i >> 2) + 4 * n + (i & 3); }

struct Unit { const char* A; const char* B; int pm, pn, e, nvalid; };

__device__ __forceinline__ int xcd_remap(int L, int nwg) { const int q = nwg / NXCD, r = nwg % NXCD, xcd = L % NXCD, off = L / NXCD; return (xcd < r ? xcd * (q + 1) : r * (q + 1) + (xcd - r) * q) + off; }

struct DenseOrder {
    const char* A; const char* Bt; int K, nM, nN, nwg, G, c;
    __device__ __forceinline__ void init(const void* A_, const void* Bt_, int M_, int N_, int K_, int G_, int c_) { A = (const char*)A_; Bt = (const char*)Bt_; K = K_; nM = M_ / BM; nN = N_ / BM; nwg = nM * nN; G = G_; c = c_; }
    __device__ __forceinline__ bool next(int i, Unit& u) const {
        const long L = (long)i * G + c; if (L >= nwg) return false;
        const int wgid = xcd_remap((int)L, nwg);
        const int nig = WGM * nN, gid = wgid / nig, fm = gid * WGM, gsz = (nM - fm) < WGM ? (nM - fm) : WGM;
        u.pm = fm + ((wgid % nig) % gsz); u.pn = (wgid % nig) / gsz; u.e = 0; u.nvalid = 256;
        u.A = A + (size_t)u.pm * 256 * K * 2; u.B = Bt + (size_t)u.pn * 256 * K * 2; return true;
    }
};
struct MoeOrder {
    const char* A; const char* Bt; const LAS int* tab;
    int K, nN, ntiles, nwg, G, c; size_t b_estride; int a_compact;
    __device__ __forceinline__ bool next(int i, Unit& u) const {
        const long L = (long)i * G + c; if (L >= nwg) return false;
        const int wgid = xcd_remap((int)L, nwg);
        const int nig = WGM * nN, gid = wgid / nig, fm = gid * WGM, gsz = (ntiles - fm) < WGM ? (ntiles - fm) : WGM;
        const int tl = fm + ((wgid % nig) % gsz); u.pm = tl; u.pn = (wgid % nig) / gsz;
        const int e = __builtin_amdgcn_readfirstlane(tab[72 + tl]); u.e = e; const int r0 = (tl - __builtin_amdgcn_readfirstlane(tab[32 + e])) * 256; const int rem = __builtin_amdgcn_readfirstlane(tab[e]) - r0; u.nvalid = rem < 256 ? rem : 256;
        u.A = a_compact ? A + (size_t)tl * 256 * K * 2 : A + ((size_t)e * CAP + r0) * K * 2;
        u.B = Bt + (size_t)e * b_estride + (size_t)u.pn * 256 * K * 2; return true;
    }
};

__device__ __forceinline__ unsigned cvt_pk_bf16(float lo, float hi) { unsigned r; asm volatile("v_cvt_pk_bf16_f32 %0, %1, %2" : "=v"(r) : "v"(lo), "v"(hi)); return r; }

struct EpiBf16 {
    static constexpr bool PERM = true;
    bf16* O; int ldc;
    __device__ __forceinline__ void operator()(const f32x4 (&acc)[2][2][4][2], const Unit& u, int wr, int wc, int fr, int fq) const {
        const int row0 = u.pm * BM + wr * 64 + fr, col0 = u.pn * BM + wc * 32 + 8 * fq;
#pragma unroll
        for (int ai = 0; ai < 2; ++ai)
#pragma unroll
            for (int m = 0; m < 4; ++m) { bf16* rowp = O + (size_t)(row0 + ai * HALF + m * 16) * ldc + col0;
#pragma unroll
                for (int bj = 0; bj < 2; ++bj) { const f32x4 v0 = acc[ai][bj][m][0], v1 = acc[ai][bj][m][1];
                    u32x4 w; w.x = cvt_pk_bf16(v0[0], v0[1]); w.y = cvt_pk_bf16(v0[2], v0[3]); w.z = cvt_pk_bf16(v1[0], v1[1]); w.w = cvt_pk_bf16(v1[2], v1[3]);
                    *(u32x4*)(rowp + bj * HALF) = w; } }
    }
};
struct EpiResid {
    static constexpr bool PERM = false;
    const float* __restrict__ hin; float* __restrict__ Z;
    __device__ __forceinline__ void operator()(const f32x4 (&acc)[2][2][4][2], const Unit& u, int wr, int wc, int fr, int fq) const {
        const int row0 = u.pm * BM + wr * 64 + fr, col0 = u.pn * BM + wc * 32 + 4 * fq;
#pragma unroll
        for (int ai = 0; ai < 2; ++ai)
#pragma unroll
            for (int m = 0; m < 4; ++m) { const size_t off = (size_t)(row0 + ai * HALF + m * 16) * D + col0;
                f32x4 hv[2][2];
#pragma unroll
                for (int bj = 0; bj < 2; ++bj)
#pragma unroll
                    for (int n = 0; n < 2; ++n) hv[bj][n] = *(const f32x4*)(hin + off + bj * HALF + n * 16);
#pragma unroll
                for (int bj = 0; bj < 2; ++bj)
#pragma unroll
                    for (int n = 0; n < 2; ++n) *(f32x4*)(Z + off + bj * HALF + n * 16) = hv[bj][n] * ALPHA + acc[ai][bj][m][n]; }
    }
};
struct EpiGlu {
    static constexpr bool PERM = true;
    const bf16* Y; const float* bias; bf16* O;
    __device__ __forceinline__ void operator()(const f32x4 (&acc)[2][2][4][2], const Unit& u, int wr, int wc, int fr, int fq) const {
        const int row0 = u.pm * BM + wr * 64 + fr, col0 = u.pn * BM + wc * 32 + 8 * fq;
#pragma unroll
        for (int ai = 0; ai < 2; ++ai)
#pragma unroll
            for (int m = 0; m < 4; ++m) { const size_t off = (size_t)(row0 + ai * HALF + m * 16) * D + col0;
#pragma unroll
                for (int bj = 0; bj < 2; ++bj) {
                    const f32x4 b0 = *(const f32x4*)(bias + col0 + bj * HALF), b1 = *(const f32x4*)(bias + col0 + bj * HALF + 4);
                    const u32x4 yw = *(const u32x4*)(Y + off + bj * HALF);
                    const f32x4 v0 = acc[ai][bj][m][0] + b0, v1 = acc[ai][bj][m][1] + b1;
                    float o[8];
                    o[0] = bflo(yw.x) * sigmoidf_(v0[0]); o[1] = bfhi(yw.x) * sigmoidf_(v0[1]); o[2] = bflo(yw.y) * sigmoidf_(v0[2]); o[3] = bfhi(yw.y) * sigmoidf_(v0[3]);
                    o[4] = bflo(yw.z) * sigmoidf_(v1[0]); o[5] = bfhi(yw.z) * sigmoidf_(v1[1]); o[6] = bflo(yw.w) * sigmoidf_(v1[2]); o[7] = bfhi(yw.w) * sigmoidf_(v1[3]);
                    u32x4 w; w.x = cvt_pk_bf16(o[0], o[1]); w.y = cvt_pk_bf16(o[2], o[3]); w.z = cvt_pk_bf16(o[4], o[5]); w.w = cvt_pk_bf16(o[6], o[7]);
                    *(u32x4*)(O + off + bj * HALF) = w; } }
    }
};
struct EpiSwiglu {
    static constexpr bool PERM = true;
    bf16* ACT; const float* bgu;
    __device__ __forceinline__ void operator()(const f32x4 (&acc)[2][2][4][2], const Unit& u, int wr, int wc, int fr, int fq) const {
        const int row0 = u.pm * BM + wr * 64 + fr, j0 = u.pn * HALF + wc * 32 + 8 * fq;
        const float* bg = bgu + (size_t)u.e * 2 * DFF + j0;
        const f32x4 g0 = *(const f32x4*)(bg), g1 = *(const f32x4*)(bg + 4), u0 = *(const f32x4*)(bg + DFF), u1 = *(const f32x4*)(bg + DFF + 4);
#pragma unroll
        for (int ai = 0; ai < 2; ++ai)
#pragma unroll
            for (int m = 0; m < 4; ++m) {
                float o[8];
#pragma unroll
                for (int n = 0; n < 2; ++n)
#pragma unroll
                    for (int i = 0; i < 4; ++i) {
                        float g = acc[ai][0][m][n][i] + (n ? g1[i] : g0[i]), up = acc[ai][1][m][n][i] + (n ? u1[i] : u0[i]);
                        g = fminf(g, 7.0f); up = fminf(fmaxf(up, -7.0f), 7.0f);
                        o[n * 4 + i] = (up + 1.0f) * g * sigmoidf_(1.702f * g); }
                u32x4 w; w.x = cvt_pk_bf16(o[0], o[1]); w.y = cvt_pk_bf16(o[2], o[3]); w.z = cvt_pk_bf16(o[4], o[5]); w.w = cvt_pk_bf16(o[6], o[7]);
                *(u32x4*)(ACT + (size_t)(row0 + ai * HALF + m * 16) * DFF + j0) = w; }
    }
};
struct EpiMoeDown {
    static constexpr bool PERM = true;
    bf16* YS; const float* bd; const int* list; const float* gw; const LAS int* tab;
    __device__ __forceinline__ void operator()(const f32x4 (&acc)[2][2][4][2], const Unit& u, int wr, int wc, int fr, int fq) const {
        const int col0 = u.pn * BM + wc * 32 + 8 * fq; const int r0 = (u.pm - __builtin_amdgcn_readfirstlane(tab[32 + u.e])) * 256;
        const float* bp = bd + (size_t)u.e * D + col0;
        f32x4 bv[2][2];
#pragma unroll
        for (int bj = 0; bj < 2; ++bj)
#pragma unroll
            for (int n = 0; n < 2; ++n) bv[bj][n] = *(const f32x4*)(bp + bj * HALF + 4 * n);
        int slot[8]; float g[8];
#pragma unroll
        for (int i = 0; i < 8; ++i) { const int r = (i >> 2) * HALF + wr * 64 + (i & 3) * 16 + fr; slot[i] = (r < u.nvalid) ? list[(size_t)u.e * CAP + r0 + r] : -1; }
#pragma unroll
        for (int i = 0; i < 8; ++i) g[i] = (slot[i] >= 0) ? gw[slot[i]] : 0.f;
#pragma unroll
        for (int ai = 0; ai < 2; ++ai)
#pragma unroll
            for (int m = 0; m < 4; ++m) { const int i = ai * 4 + m;
                if (slot[i] >= 0) { const float gg = g[i]; bf16* op = YS + (size_t)slot[i] * D + col0;
#pragma unroll
                    for (int bj = 0; bj < 2; ++bj) { const f32x4 v0 = (acc[ai][bj][m][0] + bv[bj][0]) * gg, v1 = (acc[ai][bj][m][1] + bv[bj][1]) * gg;
                        u32x4 w; w.x = cvt_pk_bf16(v0[0], v0[1]); w.y = cvt_pk_bf16(v0[2], v0[3]); w.z = cvt_pk_bf16(v1[0], v1[1]); w.w = cvt_pk_bf16(v1[2], v1[3]);
                        *(u32x4*)(op + bj * HALF) = w; } } }
    }
};

template <class Epi, class Sched, bool ALIGN_EPI, bool SP2>
__device__ __forceinline__ void gemm_phase(LAS unsigned char* lds, const int wid, const int K, const Sched& S, const Epi& E) {
    const int lane = lane_id(), tid = wid * 64 + lane, wr = wid >> 2, wc = wid & 3, fr = lane & 15, fq = lane >> 4;
    const int nt = K / BK;
    unsigned voffA[2], voffB[2];
#pragma unroll
    for (int i = 0; i < 2; ++i) { int R, C; stage_rc(tid * 16 + i * 8192, R, C); const int Rb = Epi::PERM ? ((R & ~31) + perm32(R & 31)) : R;
        voffA[i] = (unsigned)(R * K + C) * 2u; voffB[i] = (unsigned)(Rb * K + C) * 2u; }
    const size_t kstep = (size_t)(BK * 2);
    const size_t hstep = (size_t)HALF * K * 2;
    const unsigned ldsw = (unsigned)wid * 1024u;
    const int aoff = lds_byte(wr * 64 + fr, fq * 8), boff = lds_byte(wc * 32 + fr, fq * 8);
#define PG8_SA(b, h) (((b) * 2 + (h)) * HTB)
#define PG8_SB(b, h) ((4 + (b) * 2 + (h)) * HTB)
#define PG8_STAGE(bufoff, gbase, voff) do { _Pragma("unroll") for (int _i = 0; _i < 2; ++_i) \
        __builtin_amdgcn_global_load_lds((const unsigned*)((const char*)(gbase) + (voff)[_i]), (LAS unsigned*)(lds + (bufoff) + ldsw + _i * 8192), 16, 0, 0); } while (0)
#define PG8_LDA(dst, b, h) do { _Pragma("unroll") for (int m = 0; m < 4; ++m) _Pragma("unroll") for (int k = 0; k < 2; ++k) dst[m][k] = *(const LAS bf16x8*)(lds + PG8_SA(b, h) + aoff + m * 2048 + k * 1024); } while (0)
#define PG8_LDB(dst, b, h) do { _Pragma("unroll") for (int n = 0; n < 2; ++n) _Pragma("unroll") for (int k = 0; k < 2; ++k) dst[n][k] = *(const LAS bf16x8*)(lds + PG8_SB(b, h) + boff + n * 2048 + k * 1024); } while (0)
#define PG8_MMA(ai, bj, At, Bt) do { __builtin_amdgcn_s_setprio(1); _Pragma("unroll") for (int m = 0; m < 4; ++m) _Pragma("unroll") for (int n = 0; n < 2; ++n) _Pragma("unroll") for (int k = 0; k < 2; ++k) \
        acc[ai][bj][m][n] = __builtin_amdgcn_mfma_f32_16x16x32_bf16(Bt[n][k], At[m][k], acc[ai][bj][m][n], 0, 0, 0); __builtin_amdgcn_s_setprio(0); } while (0)
#define PG8_WAIT_V(n) asm volatile("s_waitcnt vmcnt(" #n ")" ::: "memory")
#define PG8_WAIT_L(n) asm volatile("s_waitcnt lgkmcnt(" #n ")" ::: "memory")
#define PG8_BAR __builtin_amdgcn_s_barrier()
#define PG8_SCHED __builtin_amdgcn_sched_barrier(0)
    Unit cur, nxt; int ui = 0;
    if (!S.next(0, cur)) return;
    f32x4 acc[2][2][4][2];
#pragma unroll
    for (int a = 0; a < 2; ++a)
#pragma unroll
        for (int b = 0; b < 2; ++b)
#pragma unroll
            for (int m = 0; m < 4; ++m)
#pragma unroll
                for (int n = 0; n < 2; ++n) acc[a][b][m][n] = (f32x4){0.f, 0.f, 0.f, 0.f};
    bf16x8 At[4][2], B0[2][2], B1[2][2];
    const char* cA = cur.A; const char* cB = cur.B;
    if constexpr (SP2) {
        PG8_STAGE(PG8_SB(0, 0), cB, voffB); PG8_STAGE(PG8_SB(0, 1), cB + hstep, voffB); PG8_STAGE(PG8_SA(0, 0), cA, voffA); PG8_STAGE(PG8_SA(0, 1), cA + hstep, voffA);
        if (wr == 1) PG8_BAR;
        PG8_WAIT_V(2); PG8_BAR;
        PG8_STAGE(PG8_SB(1, 0), cB + kstep, voffB); PG8_STAGE(PG8_SA(1, 0), cA + kstep, voffA); PG8_STAGE(PG8_SB(1, 1), cB + hstep + kstep, voffB);
        PG8_WAIT_V(6); PG8_BAR;
    } else {
        PG8_STAGE(PG8_SB(0, 0), cB, voffB); PG8_STAGE(PG8_SA(0, 0), cA, voffA); PG8_STAGE(PG8_SB(0, 1), cB + hstep, voffB); PG8_STAGE(PG8_SA(0, 1), cA + hstep, voffA);
        if (wr == 1) PG8_BAR;
        PG8_WAIT_V(4); PG8_BAR;
        PG8_STAGE(PG8_SB(1, 0), cB + kstep, voffB); PG8_STAGE(PG8_SA(1, 0), cA + kstep, voffA); PG8_STAGE(PG8_SB(1, 1), cB + hstep + kstep, voffB);
        PG8_WAIT_V(6); PG8_BAR;
    }
    for (;;) {
        const bool has_next = S.next(ui + 1, nxt);
        const char* nA = has_next ? nxt.A : cA; const char* nB = has_next ? nxt.B : cB;
        for (int t = 0; t < nt; t += 2) {
            const bool last = (t == nt - 2);
            const char* a1 = cA + (size_t)(t + 1) * kstep;
            const char* a2 = last ? nA : cA + (size_t)(t + 2) * kstep; const char* b2 = last ? nB : cB + (size_t)(t + 2) * kstep;
            const char* a3 = a2 + kstep; const char* b3 = b2 + kstep;
            if constexpr (SP2) {
            PG8_LDB(B0, 0, 0); PG8_LDB(B1, 0, 1); PG8_SCHED; PG8_LDA(At, 0, 0); PG8_STAGE(PG8_SA(1, 1), a1 + hstep, voffA);
            PG8_WAIT_V(8); PG8_WAIT_L(0); PG8_BAR; PG8_MMA(0, 0, At, B0); PG8_MMA(0, 1, At, B1); PG8_BAR; PG8_SCHED;
            PG8_LDA(At, 0, 1); PG8_STAGE(PG8_SB(0, 0), b2, voffB); PG8_STAGE(PG8_SB(0, 1), b2 + hstep, voffB); PG8_STAGE(PG8_SA(0, 0), a2, voffA);
            PG8_WAIT_V(8); PG8_WAIT_L(0); PG8_BAR; PG8_MMA(1, 0, At, B0); PG8_MMA(1, 1, At, B1); PG8_BAR; PG8_SCHED;
            PG8_LDB(B0, 1, 0); PG8_LDB(B1, 1, 1); PG8_SCHED; PG8_LDA(At, 1, 0); PG8_STAGE(PG8_SA(0, 1), a2 + hstep, voffA);
            PG8_WAIT_V(8); PG8_WAIT_L(0); PG8_BAR; PG8_MMA(0, 0, At, B0); PG8_MMA(0, 1, At, B1); PG8_BAR; PG8_SCHED;
            PG8_LDA(At, 1, 1); PG8_STAGE(PG8_SB(1, 0), b3, voffB); PG8_STAGE(PG8_SB(1, 1), b3 + hstep, voffB); PG8_STAGE(PG8_SA(1, 0), a3, voffA);
            PG8_WAIT_V(8); PG8_WAIT_L(0); PG8_BAR; PG8_MMA(1, 0, At, B0); PG8_MMA(1, 1, At, B1); PG8_BAR; PG8_SCHED;
            } else {
            PG8_LDB(B0, 0, 0); PG8_SCHED; PG8_LDA(At, 0, 0); PG8_STAGE(PG8_SA(1, 1), a1 + hstep, voffA);
            PG8_WAIT_L(8); PG8_BAR; PG8_WAIT_L(0); PG8_MMA(0, 0, At, B0); PG8_BAR; PG8_SCHED;
            PG8_LDB(B1, 0, 1); PG8_STAGE(PG8_SB(0, 0), b2, voffB);
            PG8_BAR; PG8_WAIT_L(0); PG8_MMA(0, 1, At, B1); PG8_BAR;
            PG8_LDA(At, 0, 1); PG8_STAGE(PG8_SA(0, 0), a2, voffA);
            PG8_BAR; PG8_WAIT_L(0); PG8_MMA(1, 0, At, B0); PG8_BAR; PG8_SCHED;
            PG8_STAGE(PG8_SB(0, 1), b2 + hstep, voffB);
            PG8_WAIT_V(6); PG8_BAR; PG8_MMA(1, 1, At, B1); PG8_BAR;
            PG8_LDB(B0, 1, 0); PG8_SCHED; PG8_LDA(At, 1, 0); PG8_STAGE(PG8_SA(0, 1), a2 + hstep, voffA);
            PG8_WAIT_L(8); PG8_BAR; PG8_WAIT_L(0); PG8_MMA(0, 0, At, B0); PG8_BAR; PG8_SCHED;
            PG8_LDB(B1, 1, 1); PG8_STAGE(PG8_SB(1, 0), b3, voffB);
            PG8_BAR; PG8_WAIT_L(0); PG8_MMA(0, 1, At, B1); PG8_BAR;
            PG8_LDA(At, 1, 1); PG8_STAGE(PG8_SA(1, 0), a3, voffA);
            PG8_BAR; PG8_WAIT_L(0); PG8_MMA(1, 0, At, B0); PG8_BAR; PG8_SCHED;
            PG8_STAGE(PG8_SB(1, 1), b3 + hstep, voffB);
            PG8_WAIT_V(6); PG8_BAR; PG8_MMA(1, 1, At, B1); PG8_BAR;
            }
        }
        if constexpr (ALIGN_EPI) { if (wr == 0) PG8_BAR; }
        E(acc, cur, wr, wc, fr, fq);
        if (!has_next) break;
#pragma unroll
        for (int a = 0; a < 2; ++a)
#pragma unroll
            for (int b = 0; b < 2; ++b)
#pragma unroll
                for (int m = 0; m < 4; ++m)
#pragma unroll
                    for (int n = 0; n < 2; ++n) acc[a][b][m][n] = (f32x4){0.f, 0.f, 0.f, 0.f};
        cur = nxt; cA = nA; cB = nB; ++ui;
        if constexpr (ALIGN_EPI) { if (wr == 1) PG8_BAR; }
    }
    PG8_WAIT_V(0);
    if constexpr (!ALIGN_EPI) { if (wr == 0) PG8_BAR; }
    PG8_BAR;
#undef PG8_SA
#undef PG8_SB
#undef PG8_STAGE
#undef PG8_LDA
#undef PG8_LDB
#undef PG8_MMA
#undef PG8_WAIT_V
#undef PG8_WAIT_L
#undef PG8_BAR
#undef PG8_SCHED
}
}

#define XB_TMO      128
#define XB_XCNT(j)  (256  + 64 * (j))
#define XB_XSUB(j)  (1280 + 64 * (j))
#define XB_XGEN(j)  (2304 + 64 * (j))
#define XB_TOP      3328
#define XB_TOPGEN   3392
#define XCD_BAR_WORDS 3456
#define XB_SPIN_CAP (1u << 18)
__device__ __forceinline__ unsigned xb_ld(unsigned* p)              { return __hip_atomic_load(p, __ATOMIC_RELAXED, __HIP_MEMORY_SCOPE_AGENT); }
__device__ __forceinline__ unsigned xb_add(unsigned* p, unsigned v) { return __hip_atomic_fetch_add(p, v, __ATOMIC_RELAXED, __HIP_MEMORY_SCOPE_AGENT); }
__device__ __forceinline__ unsigned xb_xcc_id() { return (unsigned)__builtin_amdgcn_s_getreg((3 << 11) | 20) & 0xFu; }
#define XB_SPIN(cond, bar) do { unsigned _sp = 0; while (cond) { __builtin_amdgcn_s_sleep(1); \
    if ((++_sp & 255u) == 0u) { if (xb_ld(&(bar)[XB_TMO])) break; if (_sp > XB_SPIN_CAP) { atomicAdd(&(bar)[XB_TMO], 1u); break; } } } } while (0)
struct XcdBarrier { unsigned* bar; unsigned x; volatile LAS unsigned* st; };
__device__ __forceinline__ XcdBarrier xcd_barrier_post(unsigned* bar, volatile LAS unsigned* st, bool leader) {
    XcdBarrier b; b.bar = bar; b.x = xb_xcc_id(); b.st = st;
    if (leader) (void)xb_add(&bar[XB_XCNT(b.x)], 1u);
    return b;
}
__device__ __forceinline__ void xcd_barrier_complete(unsigned* bar, unsigned x, unsigned& nloc, unsigned& nx) {
    const unsigned G = gridDim.x * gridDim.y * gridDim.z;
    unsigned sum, cnt, mine, sp = 0u;
    for (;;) {
        sum = 0u; cnt = 0u; mine = 0u;
#pragma unroll
        for (unsigned j = 0; j < 16; ++j) { const unsigned c = xb_ld(&bar[XB_XCNT(j)]); sum += c; cnt += (c > 0u) ? 1u : 0u; mine = (j == x) ? c : mine; }
        if (sum == G) break;
        __builtin_amdgcn_s_sleep(1);
        if ((++sp & 255u) == 0u) { if (xb_ld(&bar[XB_TMO])) break; if (sp > XB_SPIN_CAP) { atomicAdd(&bar[XB_TMO], 1u); break; } }
    }
    nloc = mine > 0u ? mine : 1u; nx = cnt > 0u ? cnt : 1u;
}
__device__ __forceinline__ void xcd_barrier(const XcdBarrier& b, int wave) {
    asm volatile("s_waitcnt vmcnt(0)" ::: "memory");
    __syncthreads();
    if (wave == 0 && lane_id() == 0) {
        unsigned* bar = b.bar;
        __builtin_amdgcn_s_waitcnt(0);
        unsigned nloc = b.st[0], nx = b.st[1];
        if (nloc == 0u) { xcd_barrier_complete(bar, b.x, nloc, nx); b.st[0] = nloc; b.st[1] = nx; }
        const unsigned old = xb_add(&bar[XB_XSUB(b.x)], 1u);
        const unsigned gen = old / nloc;
        if (old + 1u == (gen + 1u) * nloc) {
            __builtin_amdgcn_fence(__ATOMIC_RELEASE, "agent");
            asm volatile("s_waitcnt vmcnt(0)" ::: "memory");
            const unsigned og = xb_add(&bar[XB_TOP], 1u);
            const unsigned tg = og / nx;
            if (og + 1u == (tg + 1u) * nx) xb_add(&bar[XB_TOPGEN], 1u);
            else XB_SPIN(xb_ld(&bar[XB_TOPGEN]) == tg, bar);
            __builtin_amdgcn_fence(__ATOMIC_ACQUIRE, "agent");
            xb_add(&bar[XB_XGEN(b.x)], 1u);
            asm volatile("s_waitcnt vmcnt(0)" ::: "memory");
        } else {
            XB_SPIN(xb_ld(&bar[XB_XGEN(b.x)]) == gen, bar);
            __builtin_amdgcn_fence(__ATOMIC_ACQUIRE, "agent");
            asm volatile("s_waitcnt vmcnt(0)" ::: "memory");
        }
    }
    __syncthreads();
}

struct Args { const float* in[33]; float* out; unsigned char* ws; int ph_lo, ph_hi; };
struct Frame {
    LAS unsigned char* lds;
    int wave, vcu, G, gw, NGW;
};

__device__ __forceinline__ void transpose_item(const float* W, int ldw, int col_off, int K, bf16* WT, int mode, int kb, int nb, LAS unsigned char* scr, int lane) {
    const int k0 = 64 * kb, n0 = 64 * nb;
    const float* src = W + (size_t)k0 * ldw + col_off + n0;
    f32x4 v[16];
#pragma unroll
    for (int i = 0; i < 16; ++i) v[i] = *(const f32x4*)(src + (size_t)((lane >> 4) + 4 * i) * ldw + 4 * (lane & 15));
#pragma unroll
    for (int i = 0; i < 16; ++i) { LAS unsigned* p = (LAS unsigned*)(scr + ((lane >> 4) + 4 * i) * 132 + 8 * (lane & 15)); p[0] = pk2(v[i][0], v[i][1]); p[1] = pk2(v[i][2], v[i][3]); }
    asm volatile("s_waitcnt lgkmcnt(0)" ::: "memory");
    const int c = lane >> 3, nl = lane & 7;
#pragma unroll
    for (int r = 0; r < 8; ++r) { const int n = nl + 8 * r; const LAS unsigned short* s = (const LAS unsigned short*)(scr + (8 * c) * 132 + 2 * n);
        u32x4 o; o.x = (unsigned)s[0] | ((unsigned)s[66] << 16); o.y = (unsigned)s[132] | ((unsigned)s[198] << 16); o.z = (unsigned)s[264] | ((unsigned)s[330] << 16); o.w = (unsigned)s[396] | ((unsigned)s[462] << 16);
        const int ng = n0 + n; int drow = ng; if (mode == 1) { drow = ng < 1024 ? 256 * (ng >> 7) + (ng & 127) : 256 * ((ng - 1024) >> 7) + 128 + (ng & 127); }
        *(u32x4*)(WT + (size_t)drow * K + k0 + 8 * c) = o; }
    asm volatile("s_waitcnt lgkmcnt(0)" ::: "memory");
}

__device__ __forceinline__ void load_cols16(int tid, const float* W, int ldw, int col_off, LAS float* Wt) {
    for (int i = tid; i < 1024 * 16; i += NTHREADS) { const int e = i & 15, k = i >> 4; Wt[e * 1028 + k] = W[(size_t)k * ldw + col_off + e]; }
}
__device__ __forceinline__ void row_dot16(const f32x4 (&v)[4], const LAS float* Wt, int lane, float (&out)[16]) {
#pragma unroll
    for (int e = 0; e < 16; ++e) { float s = 0.f;
#pragma unroll
        for (int j = 0; j < 4; ++j) { const f32x4 w = *(const LAS f32x4*)(Wt + e * 1028 + 4 * (lane + 64 * j)); s += v[j][0] * w[0] + v[j][1] * w[1] + v[j][2] * w[2] + v[j][3] * w[3]; }
        out[e] = wave_sum(s); }
}
__device__ __forceinline__ void store_row_bf16(bf16* orow, const f32x4 (&v)[4], int lane) {
    unsigned long long* o8 = (unsigned long long*)orow + lane;
#pragma unroll
    for (int j = 0; j < 4; ++j) o8[64 * j] = (unsigned long long)pk2(v[j][0], v[j][1]) | ((unsigned long long)pk2(v[j][2], v[j][3]) << 32);
}
__device__ __forceinline__ void store_row_f32(float* orow, const f32x4 (&v)[4], int lane) {
    f32x4* o = (f32x4*)orow + lane;
#pragma unroll
    for (int j = 0; j < 4; ++j) o[64 * j] = v[j];
}
__device__ __forceinline__ void load_row_f32(const float* row, f32x4 (&v)[4], int lane) {
    const f32x4* p = (const f32x4*)row + lane;
#pragma unroll
    for (int j = 0; j < 4; ++j) v[j] = p[64 * j];
}
__device__ __forceinline__ void ln_row(f32x4 (&v)[4], const f32x4 (&gv)[4], const f32x4 (&bv)[4]) {
    float s = 0.f;
#pragma unroll
    for (int j = 0; j < 4; ++j) s += (v[j][0] + v[j][1]) + (v[j][2] + v[j][3]);
    const float mean = wave_sum(s) * (1.f / D); float s2 = 0.f;
#pragma unroll
    for (int j = 0; j < 4; ++j) { v[j] = v[j] - mean; s2 += (v[j][0] * v[j][0] + v[j][1] * v[j][1]) + (v[j][2] * v[j][2] + v[j][3] * v[j][3]); }
    const float rstd = 1.f / sqrtf(wave_sum(s2) * (1.f / D) + LN_EPS);
#pragma unroll
    for (int j = 0; j < 4; ++j) v[j] = v[j] * rstd * gv[j] + bv[j];
}

__device__ __forceinline__ const float* inp_ptr(LAS unsigned char* lds, int i) {
    const LAS unsigned* p = (const LAS unsigned*)(lds + MISC_OFF + 256) + 2 * i;
    const unsigned lo = __builtin_amdgcn_readfirstlane(p[0]), hi = __builtin_amdgcn_readfirstlane(p[1]);
    return (const float*)(const GAS float*)(((unsigned long long)hi << 32) | lo);
}

typedef short s16x4 __attribute__((ext_vector_type(4)));
typedef short v4i16_t __attribute__((ext_vector_type(4)));
constexpr int CL = 128, NCH = T / CL;
template <int MODE> struct MX;
template <> struct MX<0> { static constexpr int NH = 8, DK = 64,  DV = 128, LDP = 3072, KOFF = 512,  VOFF = 1024; };
template <> struct MX<1> { static constexpr int NH = 8, DK = 128, DV = 256, LDP = 6144, KOFF = 1024, VOFF = 2048; };
template <> struct MX<2> { static constexpr int NH = 4, DK = 128, DV = 256, LDP = 3072, KOFF = 512,  VOFF = 1024; };
__device__ __forceinline__ s16x4 ds_tr(const LAS unsigned char* p) { return __builtin_bit_cast(s16x4, __builtin_amdgcn_ds_read_tr16_b64_v4i16((LAS v4i16_t*)p)); }
__device__ __forceinline__ bf16x8 tr_frag(const LAS unsigned char* base, int pitch, int k0, int n0, int lane) {
    const int g = lane >> 4, q = (lane & 15) >> 2, p = lane & 3;
    const LAS unsigned char* a = base + (k0 + 4 * g + q) * pitch + (n0 + 4 * p) * 2;
    const s16x4 r1 = ds_tr(a), r2 = ds_tr(a + 16 * pitch);
    bf16x8 f; f[0] = r1[0]; f[1] = r1[1]; f[2] = r1[2]; f[3] = r1[3]; f[4] = r2[0]; f[5] = r2[1]; f[6] = r2[2]; f[7] = r2[3]; return f;
}
__device__ __forceinline__ u32x4 scale_bf16x8(u32x4 v, float sc) {
    u32x4 o; o.x = pk2(bflo(v.x) * sc, bfhi(v.x) * sc); o.y = pk2(bflo(v.y) * sc, bfhi(v.y) * sc); o.z = pk2(bflo(v.z) * sc, bfhi(v.z) * sc); o.w = pk2(bflo(v.w) * sc, bfhi(v.w) * sc); return o;
}
__device__ __forceinline__ float ret_lg2gamma(int h) { return log2f(1.f - exp2f(-5.f - (float)h)); }

template <int MODE>
__device__ __forceinline__ void mix_phaseA(const Frame& F, unsigned char* ws, const int tid, const int lane) {
    typedef MX<MODE> C; constexpr int DK = C::DK, DV = C::DV, NH = C::NH, LDP = C::LDP, KP = DK * 2 + 32, VP = DV * 2 + 32, ETW = DV / 128, NDT = DK / 16;
    LAS unsigned char* ldsK = F.lds; LAS unsigned char* ldsV = F.lds + 128 * KP; LAS float* rsc = (LAS float*)(F.lds + 128 * KP + 128 * VP);
    const bf16* PB = (const bf16*)(ws + WS_PB); const bf16* KPP = (const bf16*)(ws + WS_KPP); float* UT = (float*)(ws + WS_UT);
    const float* GSC = (const float*)(ws + WS_SC); float* NLOC = (float*)(ws + WS_SC + 2 * MiB);
    const int w = F.wave, g = lane >> 4;
    for (int u = blockIdx.x; u < 2 * NH * NCH; u += F.G) {
        const int c = u % NCH, bh = u / NCH, h = bh % NH, b = bh / NH; const size_t row0 = (size_t)b * T + (size_t)c * CL;
        __syncthreads();
        if (tid < 128) { float sc = 1.f;
            if (MODE == 0) sc = __expf(GSC[(size_t)(1 * 16 + bh) * T + c * CL + tid] - GSC[(size_t)(2 * 16 + bh) * T + c * CL + 127]);
            if (MODE == 1) sc = exp2f((float)(127 - tid) * ret_lg2gamma(h));
            rsc[tid] = sc; }
        __syncthreads();
        for (int p = tid; p < 128 * DK / 8; p += NTHREADS) { const int r = p / (DK / 8), cp = p % (DK / 8);
            u32x4 v = (MODE == 2) ? *(const u32x4*)(KPP + (row0 + r) * 512 + h * 128 + cp * 8) : *(const u32x4*)(PB + (row0 + r) * LDP + C::KOFF + h * DK + cp * 8);
            if (MODE != 2) v = scale_bf16x8(v, rsc[r]);
            *(LAS u32x4*)(ldsK + r * KP + cp * 16) = v; }
        for (int p = tid; p < 128 * DV / 8; p += NTHREADS) { const int r = p / (DV / 8), cp = p % (DV / 8);
            *(LAS u32x4*)(ldsV + r * VP + cp * 16) = *(const u32x4*)(PB + (row0 + r) * LDP + C::VOFF + h * DV + cp * 8); }
        __syncthreads();
        f32x4 acc[ETW][NDT];
#pragma unroll
        for (int i = 0; i < ETW; ++i)
#pragma unroll
            for (int j = 0; j < NDT; ++j) acc[i][j] = (f32x4){0.f, 0.f, 0.f, 0.f};
#pragma unroll
        for (int ks = 0; ks < 4; ++ks) {
            bf16x8 af[ETW], bfv[NDT];
#pragma unroll
            for (int i = 0; i < ETW; ++i) af[i] = tr_frag(ldsV, VP, 32 * ks, (w * ETW + i) * 16, lane);
#pragma unroll
            for (int j = 0; j < NDT; ++j) bfv[j] = tr_frag(ldsK, KP, 32 * ks, j * 16, lane);
#pragma unroll
            for (int i = 0; i < ETW; ++i)
#pragma unroll
                for (int j = 0; j < NDT; ++j) acc[i][j] = __builtin_amdgcn_mfma_f32_16x16x32_bf16(af[i], bfv[j], acc[i][j], 0, 0, 0);
        }
        float* ut = UT + (size_t)u * DV * DK;
#pragma unroll
        for (int i = 0; i < ETW; ++i)
#pragma unroll
            for (int j = 0; j < NDT; ++j)
#pragma unroll
                for (int r = 0; r < 4; ++r) ut[(size_t)((w * ETW + i) * 16 + 4 * g + r) * DK + j * 16 + (lane & 15)] = acc[i][j][r];
        if (MODE == 0 && tid < 64) { float sacc = 0.f;
            for (int r = 0; r < 128; ++r) sacc += bf2f(*(const LAS unsigned short*)(ldsK + r * KP + tid * 2));
            NLOC[(size_t)u * 64 + tid] = sacc; }
    }
    __syncthreads();
}

template <int MODE>
__device__ __forceinline__ void mix_phaseB(const Frame& F, unsigned char* ws, const int tid) {
    typedef MX<MODE> C; constexpr int DK = C::DK, DV = C::DV, NH = C::NH, NEL = DV * DK, NBH = 2 * NH;
    const float* UT = (const float*)(ws + WS_UT); bf16* ST = (bf16*)(ws + WS_ST);
    const float* GSC = (const float*)(ws + WS_SC); const float* NLOC = (const float*)(ws + WS_SC + 2 * MiB); float* NPREV = (float*)(ws + WS_SC + 2 * MiB + 256 * 1024);
    float* MPREV = (float*)(ws + WS_SC + 2 * MiB + 512 * 1024); const float* DEC = (const float*)(ws + WS_SC + 3 * MiB);
    const int gtid = blockIdx.x * NTHREADS + tid, nthr = F.G * NTHREADS;
    for (int el = gtid; el < NBH * NEL; el += nthr) {
        const int bh = el / NEL, idx = el - bh * NEL, h = bh % NH, b = bh / NH;
        float S = 0.f, m = -1e30f;
        const float rdec = (MODE == 1) ? exp2f(128.f * ret_lg2gamma(h)) : 1.f;
#pragma unroll 1
        for (int c0 = 0; c0 < NCH; c0 += 8) {
            float uv[8];
#pragma unroll
            for (int i = 0; i < 8; ++i) uv[i] = UT[(size_t)(bh * NCH + c0 + i) * NEL + idx];
#pragma unroll
            for (int i = 0; i < 8; ++i) { const int c = c0 + i; const size_t u = (size_t)bh * NCH + c;
                ST[u * NEL + idx] = (bf16)f2bf(S);
                if (MODE == 0) { const float atot = GSC[(size_t)(0 * 16 + bh) * T + c * CL + 127], mloc = atot + GSC[(size_t)(2 * 16 + bh) * T + c * CL + 127];
                    const float mnew = fmaxf(atot + m, mloc), so = __expf(atot + m - mnew), sl = __expf(mloc - mnew);
                    if (idx == 0) MPREV[u] = m;
                    S = so * S + sl * uv[i]; m = mnew; }
                else if (MODE == 1) S = rdec * S + uv[i];
                else S = DEC[(size_t)(b * NCH + c) * 512 + h * 128 + (idx & 127)] * S + uv[i]; }
        }
    }
    if (MODE == 0) {
        for (int el = gtid; el < NBH * 64; el += nthr) { const int bh = el >> 6, d = el & 63; float S = 0.f, m = -1e30f;
            for (int c = 0; c < NCH; ++c) { const size_t u = (size_t)bh * NCH + c;
                const float atot = GSC[(size_t)(0 * 16 + bh) * T + c * CL + 127], mloc = atot + GSC[(size_t)(2 * 16 + bh) * T + c * CL + 127];
                const float mnew = fmaxf(atot + m, mloc), so = __expf(atot + m - mnew), sl = __expf(mloc - mnew);
                NPREV[u * 64 + d] = S; S = so * S + sl * NLOC[u * 64 + d]; m = mnew; } }
    }
}

template <int MODE>
__device__ __forceinline__ void mix_phaseC(const Frame& F, unsigned char* ws, const int tid, const int lane) {
    typedef MX<MODE> C; constexpr int DK = C::DK, DV = C::DV, NH = C::NH, LDP = C::LDP, VP = DV * 2 + 32, NET = DV / 16, NKS = DK / 32, DVT = NH * DV;
    LAS unsigned char* ldsV = F.lds; LAS float* tabs = (LAS float*)(F.lds + 128 * VP);
    const bf16* PB = (const bf16*)(ws + WS_PB); const bf16* ST = (const bf16*)(ws + WS_ST); float* ORAW = (float*)(ws + WS_ORAW);
    const float* GSC = (const float*)(ws + WS_SC); const float* NPREV = (const float*)(ws + WS_SC + 2 * MiB + 256 * 1024); const float* MPREV = (const float*)(ws + WS_SC + 2 * MiB + 512 * 1024);
    const int w = F.wave, g = lane >> 4, li = lane & 15;
    for (int u = blockIdx.x; u < 2 * NH * NCH; u += F.G) {
        const int c = u % NCH, bh = u / NCH, h = bh % NH, b = bh / NH; const size_t row0 = (size_t)b * T + (size_t)c * CL;
        const float lg = (MODE == 1) ? ret_lg2gamma(h) : 0.f;
        __syncthreads();
        for (int p = tid; p < 128 * DV / 8; p += NTHREADS) { const int r = p / (DV / 8), cp = p % (DV / 8);
            *(LAS u32x4*)(ldsV + r * VP + cp * 16) = *(const u32x4*)(PB + (row0 + r) * LDP + C::VOFF + h * DV + cp * 8); }
        if (MODE == 0 && tid < 128) { const float mp = MPREV[u]; const size_t gi = (size_t)bh * T + c * CL + tid;
            const float a = GSC[(size_t)(0 * 16) * T + gi], gg = GSC[(size_t)(1 * 16) * T + gi], cm = GSC[(size_t)(2 * 16) * T + gi];
            const float Mt = fmaxf(mp, cm);
            tabs[tid] = gg; tabs[128 + tid] = Mt; tabs[256 + tid] = __expf(mp - Mt) * 0.125f; tabs[384 + tid] = __expf(-(a + Mt)); }
        __syncthreads();
        const int tq = 16 * w + li;
        const bf16* qrow = PB + (row0 + tq) * LDP + h * DK;
        bf16x8 qf[NKS];
#pragma unroll
        for (int ks = 0; ks < NKS; ++ks) qf[ks] = *(const bf16x8*)(qrow + 32 * ks + 8 * g);
        f32x4 O[NET];
#pragma unroll
        for (int et = 0; et < NET; ++et) O[et] = (f32x4){0.f, 0.f, 0.f, 0.f};
        float den = 0.f;
        const float Mq = (MODE == 0) ? tabs[128 + tq] : 0.f;
        for (int jp = 0; jp <= (w >> 1); ++jp) {
            f32x4 p0 = (f32x4){0.f, 0.f, 0.f, 0.f}, p1 = (f32x4){0.f, 0.f, 0.f, 0.f};
            const bf16* k0p = PB + (row0 + 32 * jp + li) * LDP + C::KOFF + h * DK + 8 * g;
#pragma unroll
            for (int ks = 0; ks < NKS; ++ks) p0 = __builtin_amdgcn_mfma_f32_16x16x32_bf16(*(const bf16x8*)(k0p + 32 * ks), qf[ks], p0, 0, 0, 0);
            if (2 * jp + 1 <= w) {
#pragma unroll
                for (int ks = 0; ks < NKS; ++ks) p1 = __builtin_amdgcn_mfma_f32_16x16x32_bf16(*(const bf16x8*)(k0p + (size_t)16 * LDP + 32 * ks), qf[ks], p1, 0, 0, 0);
            }
#pragma unroll
            for (int r = 0; r < 4; ++r) {
                const int s0 = 32 * jp + 4 * g + r, s1 = s0 + 16;
                float f0, f1;
                if (MODE == 0) { f0 = __expf(tabs[s0] - Mq) * 0.125f; f1 = __expf(tabs[s1] - Mq) * 0.125f; }
                else if (MODE == 1) { f0 = exp2f((float)(tq - s0) * lg); f1 = exp2f((float)(tq - s1) * lg); }
                else { f0 = 1.f; f1 = 1.f; }
                p0[r] = (s0 <= tq) ? p0[r] * f0 : 0.f; p1[r] = (s1 <= tq) ? p1[r] * f1 : 0.f;
                den += p0[r] + p1[r];
            }
            bf16x8 af; { const unsigned a0 = pk2(p0[0], p0[1]), a1 = pk2(p0[2], p0[3]), a2 = pk2(p1[0], p1[1]), a3 = pk2(p1[2], p1[3]); u32x4 t4; t4.x = a0; t4.y = a1; t4.z = a2; t4.w = a3; af = __builtin_bit_cast(bf16x8, t4); }
#pragma unroll
            for (int et = 0; et < NET; ++et) O[et] = __builtin_amdgcn_mfma_f32_16x16x32_bf16(af, tr_frag(ldsV, VP, 32 * jp, 16 * et, lane), O[et], 0, 0, 0);
        }
        const float qs = (MODE == 0) ? tabs[256 + tq] : (MODE == 1) ? exp2f((float)(tq + 1) * lg) : 1.f;
        const bf16* st = ST + (size_t)u * DV * DK;
        float dint = 0.f;
#pragma unroll
        for (int ks = 0; ks < NKS; ++ks) {
            bf16x8 aq = qf[ks];
            if (MODE != 2) aq = __builtin_bit_cast(bf16x8, scale_bf16x8(__builtin_bit_cast(u32x4, qf[ks]), qs));
            if (MODE == 0) { const float* np = NPREV + (size_t)u * 64 + 32 * ks + 8 * g; const u32x4 qa = __builtin_bit_cast(u32x4, aq);
                dint += bflo(qa.x) * np[0] + bfhi(qa.x) * np[1] + bflo(qa.y) * np[2] + bfhi(qa.y) * np[3] + bflo(qa.z) * np[4] + bfhi(qa.z) * np[5] + bflo(qa.w) * np[6] + bfhi(qa.w) * np[7]; }
#pragma unroll
            for (int et = 0; et < NET; ++et) O[et] = __builtin_amdgcn_mfma_f32_16x16x32_bf16(aq, *(const bf16x8*)(st + (size_t)(16 * et + li) * DK + 32 * ks + 8 * g), O[et], 0, 0, 0);
        }
        float rd[4] = {1.f, 1.f, 1.f, 1.f};
        if (MODE == 0) {
            float dt = den + dint; dt += __shfl_xor(dt, 16); dt += __shfl_xor(dt, 32);
            LAS float* wsc = tabs + 512 + 16 * w;
            if (g == 0) wsc[li] = 1.f / fmaxf(fabsf(dt), tabs[384 + tq]);
            asm volatile("s_waitcnt lgkmcnt(0)" ::: "memory");
#pragma unroll
            for (int r = 0; r < 4; ++r) rd[r] = wsc[4 * g + r];
        }
        float* orow = ORAW + (row0 + 16 * w + 4 * g) * DVT + h * DV + li;
#pragma unroll
        for (int et = 0; et < NET; ++et)
#pragma unroll
            for (int r = 0; r < 4; ++r) orow[(size_t)r * DVT + 16 * et] = O[et][r] * rd[r];
    }
    __syncthreads();
}

constexpr int SLN = 32, NCI = T / SLN, NI = 2 * NCI, NRT = NI / 16, SKK = SLN * 16;
__device__ __forceinline__ void s5_coef(const float* lam_re, const float* lam_im, const float* log_dt, int g, int p, float& lr, float& li, float& dt, float& fr, float& fi) {
    const int i = g * 64 + p; lr = lam_re[i]; li = lam_im[i]; dt = expf(log_dt[g]);
    const float er = expf(lr * dt); float sn, cs; sincosf(li * dt, &sn, &cs);
    const float nr = er * cs - 1.f, ni = er * sn, den = lr * lr + li * li;
    fr = (nr * lr + ni * li) / den; fi = (ni * lr - nr * li) / den;
}
__device__ __forceinline__ void s5_pow(float lr, float li, float dt, float n, float& pr, float& pi) { const float e = expf(n * lr * dt); float sn, cs; sincosf(n * li * dt, &sn, &cs); pr = e * cs; pi = e * sn; }

__device__ __forceinline__ void s5_tables(const Frame& F, unsigned char* ws, const int tid, const float* lam_re, const float* lam_im, const float* b_re, const float* b_im, const float* c_re, const float* c_im, const float* log_dt) {
    bf16* KT = (bf16*)(ws + WS_S5KT); bf16* VT = (bf16*)(ws + WS_S5VT); bf16* WT = (bf16*)(ws + WS_S5WT); float* L64 = (float*)(ws + WS_S5L64);
    const int gt = blockIdx.x * NTHREADS + tid, nthr = F.G * NTHREADS;
    for (int idx = gt; idx < 64 * SLN * 16; idx += nthr) {
        const int h = idx & 15, tau = (idx >> 4) % SLN, g = idx / (16 * SLN);
        float acc[16];
#pragma unroll
        for (int q = 0; q < 16; ++q) acc[q] = 0.f;
        for (int p = 0; p < 64; ++p) { float lr, li, dt, fr, fi, pr, pi; s5_coef(lam_re, lam_im, log_dt, g, p, lr, li, dt, fr, fi); s5_pow(lr, li, dt, (float)tau, pr, pi);
            const float cr = c_re[(g * 16 + h) * 64 + p], ci = c_im[(g * 16 + h) * 64 + p];
            const float xr = cr * pr - ci * pi, xi = cr * pi + ci * pr;
            const float yr = xr * fr - xi * fi, yi = xr * fi + xi * fr;
            const float* br = b_re + (size_t)(g * 64 + p) * 16; const float* bi = b_im + (size_t)(g * 64 + p) * 16;
#pragma unroll
            for (int q = 0; q < 16; ++q) acc[q] += yr * br[q] - yi * bi[q]; }
        u32x4 o0, o1; o0.x = pk2(acc[0], acc[1]); o0.y = pk2(acc[2], acc[3]); o0.z = pk2(acc[4], acc[5]); o0.w = pk2(acc[6], acc[7]);
        o1.x = pk2(acc[8], acc[9]); o1.y = pk2(acc[10], acc[11]); o1.z = pk2(acc[12], acc[13]); o1.w = pk2(acc[14], acc[15]);
        *(u32x4*)(KT + (size_t)idx * 16) = o0; *(u32x4*)(KT + (size_t)idx * 16 + 8) = o1; }
    for (int idx = gt; idx < 64 * 64 * SLN; idx += nthr) {
        const int j = idx % SLN, p = (idx / SLN) & 63, g = idx / (SLN * 64);
        float lr, li, dt, fr, fi, pr, pi; s5_coef(lam_re, lam_im, log_dt, g, p, lr, li, dt, fr, fi);
        s5_pow(lr, li, dt, (float)(SLN - 1 - j), pr, pi);
        const float yr = pr * fr - pi * fi, yi = pr * fi + pi * fr;
        const float* br = b_re + (size_t)(g * 64 + p) * 16; const float* bi = b_im + (size_t)(g * 64 + p) * 16;
        float vr[16], vi[16];
#pragma unroll
        for (int q = 0; q < 16; ++q) { vr[q] = yr * br[q] - yi * bi[q]; vi[q] = yr * bi[q] + yi * br[q]; }
        bf16* v0 = VT + ((size_t)(g * 128 + 2 * p) * SKK + j * 16);
        u32x4 o; o.x = pk2(vr[0], vr[1]); o.y = pk2(vr[2], vr[3]); o.z = pk2(vr[4], vr[5]); o.w = pk2(vr[6], vr[7]); *(u32x4*)v0 = o;
        o.x = pk2(vr[8], vr[9]); o.y = pk2(vr[10], vr[11]); o.z = pk2(vr[12], vr[13]); o.w = pk2(vr[14], vr[15]); *(u32x4*)(v0 + 8) = o;
        o.x = pk2(vi[0], vi[1]); o.y = pk2(vi[2], vi[3]); o.z = pk2(vi[4], vi[5]); o.w = pk2(vi[6], vi[7]); *(u32x4*)(v0 + SKK) = o;
        o.x = pk2(vi[8], vi[9]); o.y = pk2(vi[10], vi[11]); o.z = pk2(vi[12], vi[13]); o.w = pk2(vi[14], vi[15]); *(u32x4*)(v0 + SKK + 8) = o;
        const int l = j; s5_pow(lr, li, dt, (float)(l + 1), pr, pi);
#pragma unroll
        for (int h = 0; h < 16; ++h) { const float cr = c_re[(g * 16 + h) * 64 + p], ci = c_im[(g * 16 + h) * 64 + p];
            *(unsigned*)(WT + ((size_t)((g * SLN + l) * 16 + h) * 128 + 2 * p)) = pk2(cr * pr - ci * pi, -(cr * pi + ci * pr)); }
        if (j == 0) { s5_pow(lr, li, dt, (float)SLN, pr, pi); L64[(g * 64 + p) * 2] = pr; L64[(g * 64 + p) * 2 + 1] = pi; }
    }
}
__device__ __forceinline__ void s5_phaseA(const Frame& F, unsigned char* ws, const int lane) {
    const bf16* PB = (const bf16*)(ws + WS_PB); const bf16* VT = (const bf16*)(ws + WS_S5VT); float* SL = (float*)(ws + WS_S5SL);
    const int gq = lane >> 4, li = lane & 15;
    for (int wu = F.gw; wu < 64 * NRT * 2; wu += F.NGW) {
        const int half = wu & 1, rt = (wu >> 1) % NRT, g = wu / (2 * NRT), b = rt / (NRT / 2), c0 = (rt % (NRT / 2)) * 16;
        f32x4 acc[4];
#pragma unroll
        for (int ct = 0; ct < 4; ++ct) acc[ct] = (f32x4){0.f, 0.f, 0.f, 0.f};
        const bf16* ap = PB + ((size_t)b * T + (size_t)(c0 + li) * SLN + (gq >> 1)) * 1024 + g * 16 + 8 * (gq & 1);
        const bf16* bp = VT + (size_t)(g * 128 + half * 64 + li) * SKK + 8 * gq;
#pragma unroll 4
        for (int ks = 0; ks < SLN / 2; ++ks) {
            const bf16x8 af = *(const bf16x8*)(ap + (size_t)(2 * ks) * 1024);
#pragma unroll
            for (int ct = 0; ct < 4; ++ct) acc[ct] = __builtin_amdgcn_mfma_f32_16x16x32_bf16(af, *(const bf16x8*)(bp + (size_t)(16 * ct) * SKK + 32 * ks), acc[ct], 0, 0, 0);
        }
#pragma unroll
        for (int ct = 0; ct < 4; ++ct)
#pragma unroll
            for (int r = 0; r < 4; ++r) SL[(size_t)(g * NI + rt * 16 + 4 * gq + r) * 128 + half * 64 + ct * 16 + li] = acc[ct][r];
    }
}
__device__ __forceinline__ void s5_phaseB(const Frame& F, unsigned char* ws, const int tid) {
    const float* SL = (const float*)(ws + WS_S5SL); bf16* SP = (bf16*)(ws + WS_S5SP); const float* L64 = (const float*)(ws + WS_S5L64);
    const int gt = blockIdx.x * NTHREADS + tid;
    if (gt < 2 * 64 * 64) { const int p = gt & 63, g = (gt >> 6) & 63, b = gt >> 12; const float ar = L64[(g * 64 + p) * 2], ai = L64[(g * 64 + p) * 2 + 1];
        float sr = 0.f, si = 0.f;
#pragma unroll 1
        for (int c0 = 0; c0 < NCI; c0 += 8) { f32x2 lv[8];
#pragma unroll
            for (int i = 0; i < 8; ++i) lv[i] = *(const f32x2*)(SL + (size_t)(g * NI + b * NCI + c0 + i) * 128 + 2 * p);
#pragma unroll
            for (int i = 0; i < 8; ++i) { *(unsigned*)(SP + (size_t)(g * NI + b * NCI + c0 + i) * 128 + 2 * p) = pk2(sr, si);
                const float nr = ar * sr - ai * si + lv[i][0], ni = ar * si + ai * sr + lv[i][1]; sr = nr; si = ni; } }
    }
}
__device__ __forceinline__ void s5_phaseC(const Frame& F, unsigned char* ws, const int lane, const float* dskip) {
    const bf16* PB = (const bf16*)(ws + WS_PB); const bf16* KT = (const bf16*)(ws + WS_S5KT); const bf16* WT = (const bf16*)(ws + WS_S5WT); const bf16* SP = (const bf16*)(ws + WS_S5SP);
    bf16* YB = (bf16*)(ws + WS_YB);
    const int gq = lane >> 4, li = lane & 15;
#pragma unroll 1
    for (int wu = F.gw; wu < 64 * NRT * 2; wu += F.NGW) {
        const int par = wu & 1, rt = (wu >> 1) % NRT, g = wu / (2 * NRT), b = rt / (NRT / 2), c0 = (rt % (NRT / 2)) * 16;
        bf16x8 af[SLN / 2], sf[4];
        const bf16* ap = PB + ((size_t)b * T + (size_t)(c0 + li) * SLN + (gq >> 1)) * 1024 + g * 16 + 8 * (gq & 1);
#pragma unroll
        for (int ks = 0; ks < SLN / 2; ++ks) af[ks] = *(const bf16x8*)(ap + (size_t)(2 * ks) * 1024);
#pragma unroll
        for (int ks = 0; ks < 4; ++ks) sf[ks] = *(const bf16x8*)(SP + (size_t)(g * NI + rt * 16 + li) * 128 + 32 * ks + 8 * gq);
        const float dl = dskip[g * 16 + li];
        const bf16* ktp = KT + (size_t)g * SLN * 256 + li * 16 + 8 * (gq & 1);
#pragma unroll
        for (int l2 = 0; l2 < SLN / 2; ++l2) {
            int l = 2 * l2 + par; asm volatile("" : "+v"(l));
            f32x4 acc = (f32x4){0.f, 0.f, 0.f, 0.f};
#pragma unroll
            for (int ks = 0; ks <= l2; ++ks) { const int tau = l - 2 * ks - (gq >> 1);
                bf16x8 bfv = *(const bf16x8*)(ktp + (size_t)(tau < 0 ? 0 : tau) * 256);
                if (ks == l2 && tau < 0) bfv = (bf16x8){0, 0, 0, 0, 0, 0, 0, 0};
                acc = __builtin_amdgcn_mfma_f32_16x16x32_bf16(af[ks], bfv, acc, 0, 0, 0); }
            const bf16* wp = WT + (size_t)((g * SLN + l) * 16 + li) * 128 + 8 * gq;
#pragma unroll
            for (int ks = 0; ks < 4; ++ks) acc = __builtin_amdgcn_mfma_f32_16x16x32_bf16(sf[ks], *(const bf16x8*)(wp + 32 * ks), acc, 0, 0, 0);
#pragma unroll
            for (int r = 0; r < 4; ++r) { const size_t row = (size_t)b * T + (size_t)(c0 + 4 * gq + r) * SLN + l; const size_t o = row * 1024 + g * 16 + li;
                const float y = acc[r] + dl * bf2f(PB[o]); YB[o] = (bf16)f2bf(gelu_tanh(y)); }
            asm volatile("" ::: "memory");
        }
    }
}

#define IN(k) (lo <= (k) && (k) < hi)
#define SEAM(k) do { if ((k) + 1 < hi) xcd_barrier(bar, F.wave); } while (0)
#define INP(i) inp_ptr(F.lds, (i))
#define x_in INP(0)
#define ln_g INP(1)
#define ln_b INP(2)
#define WS_PTRS \
    float* HF = (float*)(ws + WS_HF); bf16* XB = (bf16*)(ws + WS_XB); float* ZF = (float*)(ws + WS_ZF); bf16* PB = (bf16*)(ws + WS_PB); \
    float* GB = (float*)(ws + WS_GB); float* LA = (float*)(ws + WS_LA); float* ORAW = (float*)(ws + WS_ORAW); bf16* YB = (bf16*)(ws + WS_YB); \
    bf16* ACT = (bf16*)(ws + WS_ACT); bf16* YS = (bf16*)(ws + WS_YS); bf16* XG = (bf16*)(ws + WS_XG); \
    int* LIST = (int*)(ws + WS_LIST); float* GW = (float*)(ws + WS_GW); \
    float* S5LB = (float*)(ws + WS_S5TAB); float* S5BB = (float*)(ws + WS_S5TAB + 32768); \
    (void)HF; (void)XB; (void)ZF; (void)PB; (void)GB; (void)LA; (void)ORAW; (void)YB; (void)ACT; (void)YS; (void)XG; (void)LIST; (void)GW; (void)S5LB; (void)S5BB;

template <int layer>
__device__ __forceinline__ void layer_body(const Frame& F, unsigned char* ws, unsigned* ctl, LAS int* TAB, const XcdBarrier& bar, const int lo, const int hi, float* d_out) {
    WS_PTRS
        const int pb = 1 + layer * 16;
        const float* hin = (layer == 0) ? x_in : HF;
        if (PHE(1) && IN(pb + 0)) {
            const bf16* Wt = (const bf16*)(ws + (layer == 0 ? WS_WT_ML_IN : layer == 1 ? WS_WT_RET_IN : layer == 2 ? WS_WT_GLA_IN : WS_WT_S5_IN));
            const int N = (layer == 0 || layer == 2) ? 3072 : (layer == 1 ? 6144 : 1024);
            pg8::DenseOrder S; S.init(XB, Wt, M, N, D, F.G, (int)blockIdx.x);
            pg8::EpiBf16 E{PB, N};
            for (int rep_ = 0; rep_ < REPS(2); ++rep_)
            pg8::gemm_phase<pg8::EpiBf16, pg8::DenseOrder, true, true>(F.lds, F.wave, D, S, E);
            if (layer == 0 && CH_ML) {
                const int lane = lane_id(), gt = blockIdx.x * NTHREADS + F.wave * 64 + lane;
                if (gt < 16 * NCH) { const int bh = gt / NCH, c = gt % NCH, b = bh >> 3, h = bh & 7; float a = 0.f, cm = -3.0e38f; float* GSC = (float*)(ws + WS_SC);
                    for (int l = 0; l < CL; ++l) { const int t = c * CL + l; const size_t row = (size_t)b * T + t;
                        a += log_sigmoidf_(GB[row * 16 + 8 + h]); const float gg = GB[row * 16 + h] - a; cm = fmaxf(cm, gg);
                        GSC[(size_t)(0 * 16 + bh) * T + t] = a; GSC[(size_t)(1 * 16 + bh) * T + t] = gg; GSC[(size_t)(2 * 16 + bh) * T + t] = cm; } }
            }
            SEAM(pb + 0);
        }
        if (layer == 0) {
            if (CH_ML) {
                if (IN(pb + 2)) { const int lane = lane_id(), tid = F.wave * 64 + lane; for (int rep_ = 0; rep_ < REPS(6); ++rep_) mix_phaseA<0>(F, ws, tid, lane); SEAM(pb + 2); }
                if (IN(pb + 3)) { const int lane = lane_id(), tid = F.wave * 64 + lane; for (int rep_ = 0; rep_ < REPS(7); ++rep_) mix_phaseB<0>(F, ws, tid); SEAM(pb + 3); }
                if (IN(pb + 4)) { const int lane = lane_id(), tid = F.wave * 64 + lane; for (int rep_ = 0; rep_ < REPS(8); ++rep_) mix_phaseC<0>(F, ws, tid, lane); SEAM(pb + 4); }
            }
        } else if (layer == 1) {
            if (IN(pb + 1)) { const int lane = lane_id(), tid = F.wave * 64 + lane; (void)tid;
                for (int it = blockIdx.x * NTHREADS + tid; it < T * 64; it += F.G * NTHREADS) {
                    const int t = it >> 6, i = it & 63;
                    const float inv = exp2f(-(float)(2 * i) * (13.287712379549449f / 128.f));
                    float sn, cs; sincosf((float)t * inv, &sn, &cs);
                    for (int b = 0; b < 2; ++b) { bf16* pr = PB + (size_t)(b * T + t) * 6144;
                        for (int qk = 0; qk < 2; ++qk) { const float sc = qk ? 0.08838834764831845f : 1.f;
                            for (int h = 0; h < 8; ++h) { bf16* p = pr + qk * 1024 + h * 128 + i; const float t1 = bf2f(p[0]), t2 = bf2f(p[64]);
                                p[0] = (bf16)f2bf((t1 * cs - t2 * sn) * sc); p[64] = (bf16)f2bf((t1 * sn + t2 * cs) * sc); } } }
                }
                SEAM(pb + 1);
            }
            if (CH_RET) {
                if (IN(pb + 2)) { const int lane = lane_id(), tid = F.wave * 64 + lane; for (int rep_ = 0; rep_ < REPS(6); ++rep_) mix_phaseA<1>(F, ws, tid, lane); SEAM(pb + 2); }
                if (IN(pb + 3)) { const int lane = lane_id(), tid = F.wave * 64 + lane; for (int rep_ = 0; rep_ < REPS(7); ++rep_) mix_phaseB<1>(F, ws, tid); SEAM(pb + 3); }
                if (IN(pb + 4)) { const int lane = lane_id(), tid = F.wave * 64 + lane; for (int rep_ = 0; rep_ < REPS(8); ++rep_) mix_phaseC<1>(F, ws, tid, lane); SEAM(pb + 4); }
            }
        } else if (layer == 2) {
            if (CH_GLA) {
                if (IN(pb + 1)) {
                    const int lane = lane_id(), gt = blockIdx.x * NTHREADS + F.wave * 64 + lane;
                    if (gt < 2 * NCH * 512) { const int ch = gt & 511, bc = gt >> 9, b = bc / NCH, c = bc % NCH; const size_t row0 = (size_t)b * T + (size_t)c * CL;
                        bf16* KPP = (bf16*)(ws + WS_KPP); float* DEC = (float*)(ws + WS_SC + 3 * MiB);
                        float bend = 0.f;
#pragma unroll 8
                        for (int l = 0; l < CL; ++l) bend += LA[(row0 + l) * 512 + ch];
                        float bcum = 0.f;
#pragma unroll 8
                        for (int l = 0; l < CL; ++l) { bcum += LA[(row0 + l) * 512 + ch]; bf16* pr = PB + (row0 + l) * 3072;
                            const float qv = bf2f(pr[ch]), kv = bf2f(pr[512 + ch]) * 0.08838834764831845f;
                            pr[ch] = (bf16)f2bf(qv * __expf(bcum)); pr[512 + ch] = (bf16)f2bf(kv * __expf(-bcum)); KPP[(row0 + l) * 512 + ch] = (bf16)f2bf(kv * __expf(bend - bcum)); }
                        DEC[(size_t)bc * 512 + ch] = __expf(bend); }
                    SEAM(pb + 1);
                }
                if (IN(pb + 2)) { const int lane = lane_id(), tid = F.wave * 64 + lane; for (int rep_ = 0; rep_ < REPS(6); ++rep_) mix_phaseA<2>(F, ws, tid, lane); SEAM(pb + 2); }
                if (IN(pb + 3)) { const int lane = lane_id(), tid = F.wave * 64 + lane; for (int rep_ = 0; rep_ < REPS(7); ++rep_) mix_phaseB<2>(F, ws, tid); SEAM(pb + 3); }
                if (IN(pb + 4)) { const int lane = lane_id(), tid = F.wave * 64 + lane; for (int rep_ = 0; rep_ < REPS(8); ++rep_) mix_phaseC<2>(F, ws, tid, lane); SEAM(pb + 4); }
            }
        } else {
            if (CH_S5) {
                if (IN(pb + 2)) { const int lane = lane_id(); for (int rep_ = 0; rep_ < REPS(6); ++rep_) s5_phaseA(F, ws, lane); SEAM(pb + 2); }
                if (IN(pb + 3)) { const int lane = lane_id(), tid = F.wave * 64 + lane; for (int rep_ = 0; rep_ < REPS(7); ++rep_) s5_phaseB(F, ws, tid); SEAM(pb + 3); }
                if (IN(pb + 4)) { const int lane = lane_id(); for (int rep_ = 0; rep_ < REPS(8); ++rep_) s5_phaseC(F, ws, lane, INP(22)); SEAM(pb + 4); }
            }
        }
        if (PHE(3) && layer < 3 && IN(pb + 5)) { const int lane = lane_id(), tid = F.wave * 64 + lane; (void)tid;
          for (int rep_ = 0; rep_ < REPS(9); ++rep_) {
            const int nh = (layer == 2) ? 4 : 8, dv = (layer == 0) ? 128 : 256, DV = nh * dv, ldp = (layer == 1) ? 6144 : 3072, goff = (layer == 1) ? 4096 : 2048;
            const float* ng = INP(layer == 0 ? 5 : layer == 1 ? 8 : 13);
            for (int it = F.gw; it < M * nh; it += F.NGW) {
                const int row = it / nh, h = it - row * nh;
                const float* src = ORAW + (size_t)row * DV + h * dv;
                float xv[4]; const int per = dv / 64;
                float s = 0.f;
#pragma unroll
                for (int j = 0; j < 4; ++j) { xv[j] = (j < per) ? src[lane + 64 * j] : 0.f; s += xv[j]; }
                const float mean = wave_sum(s) / (float)dv; float s2 = 0.f;
#pragma unroll
                for (int j = 0; j < 4; ++j) { const float dlt = (j < per) ? xv[j] - mean : 0.f; s2 += dlt * dlt; }
                const float rstd = 1.f / sqrtf(wave_sum(s2) / (float)dv + LN_EPS);
#pragma unroll
                for (int j = 0; j < 4; ++j) if (j < per) { const int c = h * dv + lane + 64 * j; const float gt = bf2f(PB[(size_t)row * ldp + goff + c]);
                    const float gate = (layer == 0) ? sigmoidf_(gt) : gt * sigmoidf_(gt);
                    YB[(size_t)row * DV + c] = (bf16)f2bf(gate * (xv[j] - mean) * rstd * ng[c]); }
            }
          }
            SEAM(pb + 5);
        }
        if (PHE(4) && layer == 3 && IN(pb + 6)) {
            pg8::DenseOrder S; S.init(YB, ws + WS_WT_S5_GLU, M, D, D, F.G, (int)blockIdx.x);
            pg8::EpiGlu E{YB, INP(25), (bf16*)ORAW};
            for (int rep_ = 0; rep_ < REPS(3); ++rep_)
            pg8::gemm_phase<pg8::EpiGlu, pg8::DenseOrder, true, true>(F.lds, F.wave, D, S, E);
            SEAM(pb + 6);
        }
        if (PHE(5) && IN(pb + 7)) {
            const bf16* Wt = (const bf16*)(ws + (layer == 0 ? WS_WT_ML_OUT : layer == 1 ? WS_WT_RET_OUT : layer == 2 ? WS_WT_GLA_OUT : WS_WT_S5_OUT));
            const int Kd = (layer == 1) ? 2048 : 1024;
            const bf16* Ain = (layer == 3) ? (const bf16*)ORAW : YB;
            pg8::DenseOrder S; S.init(Ain, Wt, M, D, Kd, F.G, (int)blockIdx.x);
            pg8::EpiResid E{hin, ZF};
            for (int rep_ = 0; rep_ < REPS(3); ++rep_)
            pg8::gemm_phase<pg8::EpiResid, pg8::DenseOrder, true, true>(F.lds, F.wave, Kd, S, E);
            SEAM(pb + 7);
        }
        unsigned* cnt = ctl + CW_CNT + layer * 32 * 64;
        if (IN(pb + 8) && !defined_SKIP_LN1) { const int lane = lane_id(), tid = F.wave * 64 + lane; (void)tid;
            LAS float* Wt = (LAS float*)(F.lds);
            { const float* wr_ = INP(27) + (size_t)layer * D * NEXP;
              for (int i = tid; i < D * NEXP; i += NTHREADS) { const int e = i & 31, k = i >> 5; Wt[e * 1028 + k] = wr_[i]; } }
            __syncthreads();
            const float* br_ = INP(28) + layer * NEXP;
            const float* lng_ = ln_g + (size_t)(layer * 2 + 0) * D; const float* lnb_ = ln_b + (size_t)(layer * 2 + 0) * D;
            for (int row = F.gw; row < M; row += F.NGW) {
                asm volatile("" ::: "memory");
                f32x4 v[4]; load_row_f32(ZF + (size_t)row * D, v, lane);
                { f32x4 gv[4], bv[4]; load_row_f32(lng_, gv, lane); load_row_f32(lnb_, bv, lane); ln_row(v, gv, bv); }
                store_row_f32(HF + (size_t)row * D, v, lane);
                float pz[32];
#pragma unroll
                for (int e = 0; e < 32; ++e) { float sacc = 0.f;
#pragma unroll
                    for (int j = 0; j < 4; ++j) { const f32x4 w = *(const LAS f32x4*)(Wt + e * 1028 + 4 * (lane + 64 * j)); sacc += v[j][0] * w[0] + v[j][1] * w[1] + v[j][2] * w[2] + v[j][3] * w[3]; }
                    pz[e] = sacc; }
                float a16[16], a8[8], a4[4], a2[2], lgv;
                { const bool hi = (lane & 32) != 0;
#pragma unroll
                  for (int e = 0; e < 16; ++e) { const float mine = hi ? pz[e + 16] : pz[e], theirs = hi ? pz[e] : pz[e + 16]; a16[e] = mine + __shfl_xor(theirs, 32); } }
                { const bool hi = (lane & 16) != 0;
#pragma unroll
                  for (int e = 0; e < 8; ++e) { const float mine = hi ? a16[e + 8] : a16[e], theirs = hi ? a16[e] : a16[e + 8]; a8[e] = mine + __shfl_xor(theirs, 16); } }
                { const bool hi = (lane & 8) != 0;
#pragma unroll
                  for (int e = 0; e < 4; ++e) { const float mine = hi ? a8[e + 4] : a8[e], theirs = hi ? a8[e] : a8[e + 4]; a4[e] = mine + __shfl_xor(theirs, 8); } }
                { const bool hi = (lane & 4) != 0;
#pragma unroll
                  for (int e = 0; e < 2; ++e) { const float mine = hi ? a4[e + 2] : a4[e], theirs = hi ? a4[e] : a4[e + 2]; a2[e] = mine + __shfl_xor(theirs, 4); } }
                { const bool hi = (lane & 2) != 0; const float mine = hi ? a2[1] : a2[0], theirs = hi ? a2[0] : a2[1]; lgv = mine + __shfl_xor(theirs, 2); }
                lgv += __shfl_xor(lgv, 1);
                lgv += br_[lane >> 1];
                int te[4]; float tv[4];
#pragma unroll
                for (int k = 0; k < 4; ++k) { float best = lgv;
#pragma unroll
                    for (int o = 1; o < 64; o <<= 1) best = fmaxf(best, __shfl_xor(best, o));
                    const unsigned long long mk = __ballot(lgv == best); const int src = __builtin_amdgcn_readfirstlane((int)__ffsll((long long)mk) - 1);
                    te[k] = src >> 1; tv[k] = best; if ((lane >> 1) == te[k]) lgv = -3.0e38f; }
                const float e0 = 1.f, e1 = __expf(tv[1] - tv[0]), e2 = __expf(tv[2] - tv[0]), e3 = __expf(tv[3] - tv[0]), rs = 1.f / (e0 + e1 + e2 + e3);
                int pos = 0;
                if (lane < 4) { const int ek = lane == 0 ? te[0] : lane == 1 ? te[1] : lane == 2 ? te[2] : te[3]; const float gk = (lane == 0 ? e0 : lane == 1 ? e1 : lane == 2 ? e2 : e3) * rs;
                    pos = (int)__hip_atomic_fetch_add(cnt + ek * 64, 1u, __ATOMIC_RELAXED, __HIP_MEMORY_SCOPE_AGENT);
                    LIST[(size_t)ek * CAP + pos] = row * 4 + lane; GW[row * 4 + lane] = gk; }
#pragma unroll
                for (int k = 0; k < 4; ++k) { const int pk = __shfl(pos, k); store_row_bf16(XG + ((size_t)te[k] * CAP + pk) * D, v, lane); }
            }
            __syncthreads();
            SEAM(pb + 8);
        }
        if ((PHE(7) || PHE(8)) && (IN(pb + 9) || IN(pb + 10))) { const int lane = lane_id(), tid = F.wave * 64 + lane; (void)tid;
            __syncthreads();
            if (tid < 32) TAB[tid] = (int)__hip_atomic_load(cnt + tid * 64, __ATOMIC_RELAXED, __HIP_MEMORY_SCOPE_AGENT);
            __syncthreads();
            if (tid == 0) { int acc = 0; for (int e = 0; e < 32; ++e) { TAB[32 + e] = acc; const int nt_ = (TAB[e] + 255) >> 8; for (int j = 0; j < nt_; ++j) TAB[72 + acc + j] = e; acc += nt_; } TAB[64] = acc; }
            __syncthreads();
        }
        if (PHE(7) && IN(pb + 9)) {
            pg8::MoeOrder S; S.A = (const char*)XG; S.Bt = (const char*)(ws + WS_WT_GU + (size_t)layer * 32 * 2048 * 1024 * 2); S.tab = TAB; S.K = D; S.nN = 8; S.ntiles = __builtin_amdgcn_readfirstlane(TAB[64]); S.nwg = S.ntiles * 8; S.G = F.G; S.c = (int)blockIdx.x;
            S.b_estride = (size_t)2048 * 1024 * 2; S.a_compact = 0;
            pg8::EpiSwiglu E{ACT, INP(30) + (size_t)layer * 32 * 2048};
            for (int rep_ = 0; rep_ < REPS(4); ++rep_)
            pg8::gemm_phase<pg8::EpiSwiglu, pg8::MoeOrder, true, true>(F.lds, F.wave, D, S, E);
            SEAM(pb + 9);
        }
        if (PHE(8) && IN(pb + 10)) {
            pg8::MoeOrder S; S.A = (const char*)ACT; S.Bt = (const char*)(ws + WS_WT_DN + (size_t)layer * 32 * 1024 * 1024 * 2); S.tab = TAB; S.K = DFF; S.nN = 4; S.ntiles = __builtin_amdgcn_readfirstlane(TAB[64]); S.nwg = S.ntiles * 4; S.G = F.G; S.c = (int)blockIdx.x;
            S.b_estride = (size_t)1024 * 1024 * 2; S.a_compact = 1;
            pg8::EpiMoeDown E{YS, INP(32) + (size_t)layer * 32 * 1024, LIST, GW, TAB};
            for (int rep_ = 0; rep_ < REPS(5); ++rep_)
            pg8::gemm_phase<pg8::EpiMoeDown, pg8::MoeOrder, true, true>(F.lds, F.wave, DFF, S, E);
            SEAM(pb + 10);
        }
        if (PHE(9) && IN(pb + 11)) { const int lane = lane_id(), tid = F.wave * 64 + lane; (void)tid;
            LAS float* Wt = (LAS float*)(F.lds);
            if (layer == 1) { load_cols16(tid, INP(10), 3088, 3072, Wt); __syncthreads(); }
            const float* lng_ = ln_g + (size_t)(layer * 2 + 1) * D; const float* lnb_ = ln_b + (size_t)(layer * 2 + 1) * D;
            float* outp = (layer == 3) ? d_out : HF;
            for (int row = F.gw; row < M; row += F.NGW) {
                asm volatile("" ::: "memory");
                f32x4 v[4]; load_row_f32(HF + (size_t)row * D, v, lane);
#pragma unroll
                for (int j = 0; j < 4; ++j) v[j] = v[j] * ALPHA;
#pragma unroll
                for (int k = 0; k < 4; ++k) { const u32x2* yp = (const u32x2*)(YS + ((size_t)row * 4 + k) * D) + lane;
#pragma unroll
                    for (int j = 0; j < 4; ++j) { const u32x2 yw = yp[64 * j]; v[j][0] += bflo(yw.x); v[j][1] += bfhi(yw.x); v[j][2] += bflo(yw.y); v[j][3] += bfhi(yw.y); } }
                { f32x4 gv[4], bv[4]; load_row_f32(lng_, gv, lane); load_row_f32(lnb_, bv, lane); ln_row(v, gv, bv); }
                store_row_f32(outp + (size_t)row * D, v, lane);
                if (layer < 3) store_row_bf16(XB + (size_t)row * D, v, lane);
                if (layer == 1) {
                    float z[16]; row_dot16(v, Wt, lane, z);
                    if (lane < 16) { float o = 0.f;
#pragma unroll
                        for (int e = 0; e < 16; ++e) o = (lane == e) ? z[e] : o;
                        GB[(size_t)row * 16 + lane] = o; }
                }
            }
            if (layer == 1) {
                __syncthreads();
                const float* wgp = INP(11); const float bgc = INP(12)[tid];
                float wg[16];
#pragma unroll
                for (int r = 0; r < 16; ++r) wg[r] = wgp[r * 512 + tid];
                for (int row = F.vcu * NWAVES; row < M; row += F.NGW) {
#pragma unroll 1
                    for (int w = 0; w < NWAVES; ++w) { const float* zr = GB + (size_t)(row + w) * 16; float sacc = bgc;
#pragma unroll
                        for (int r = 0; r < 16; ++r) sacc += zr[r] * wg[r];
                        LA[(size_t)(row + w) * 512 + tid] = log_sigmoidf_(sacc) * (1.f / 16.f); }
                }
            }
            __syncthreads();
            SEAM(pb + 11);
        }
}
__global__ void __launch_bounds__(NTHREADS, 2) mega_fwd(Args args) {
    extern __shared__ __attribute__((aligned(16))) unsigned char lds_raw[];
    Frame F;
    F.lds = (LAS unsigned char*)lds_raw;
    F.wave = __builtin_amdgcn_readfirstlane((int)threadIdx.x >> 6);
    F.G = gridDim.x; { const int bx = blockIdx.x; F.vcu = (F.G % 8 == 0) ? (bx % 8) * (F.G / 8) + bx / 8 : bx; }
    F.gw = F.vcu * NWAVES + F.wave; F.NGW = F.G * NWAVES;
    unsigned char* ws = args.ws;
    unsigned* ctl = (unsigned*)(ws + WS_CTL);
    volatile LAS unsigned* MISC = (volatile LAS unsigned*)(F.lds + MISC_OFF);
    LAS int* TAB = (LAS int*)(F.lds + TAB_OFF);
    { const int tid0 = threadIdx.x;
      if (tid0 < 64) MISC[tid0] = 0u;
      if (tid0 < 33) ((LAS unsigned long long*)(F.lds + MISC_OFF + 256))[tid0] = (unsigned long long)args.in[tid0]; }
    __syncthreads();
    XcdBarrier bar = xcd_barrier_post(ctl + CW_BAR, MISC + 8, F.wave == 0 && lane_id() == 0);
    const int lo = args.ph_lo, hi = args.ph_hi;
    WS_PTRS
    if (IN(0) && !defined_SKIP_P0) { const int lane = lane_id(), tid = F.wave * 64 + lane; (void)tid;
      {
        LAS unsigned char* scr = F.lds + F.wave * 8704;
#define TR_MAT(src_, ldw_, K_, N_, dst_, mode_, count_, sstride_, dstride_) do { \
            const int nkb = (K_) / 64, nnb = (N_) / 64, per = nkb * nnb, total = per * (count_); \
            _Pragma("unroll 1") for (int it = F.gw; it < total; it += F.NGW) { \
                const int q = it / per, r = it - q * per, kb = r / nnb, nb = r - kb * nnb; \
                transpose_item((src_) + (size_t)q * (sstride_), (ldw_), 0, (K_), (dst_) + (size_t)q * (dstride_), (mode_), kb, nb, scr, lane); } } while (0)
        TR_MAT(INP(29), 2048, 1024, 2048, (bf16*)(ws + WS_WT_GU), 1, 128, (size_t)1024 * 2048, (size_t)2048 * 1024);
        TR_MAT(INP(31), 1024, 1024, 1024, (bf16*)(ws + WS_WT_DN), 0, 128, (size_t)1024 * 1024, (size_t)1024 * 1024);
        if (PROBE_CLS == 1) { TR_MAT(INP(29), 2048, 1024, 2048, (bf16*)(ws + WS_WT_GU), 1, 128, (size_t)1024 * 2048, (size_t)2048 * 1024);
            TR_MAT(INP(31), 1024, 1024, 1024, (bf16*)(ws + WS_WT_DN), 0, 128, (size_t)1024 * 1024, (size_t)1024 * 1024); }
        TR_MAT(INP(3), 3088, 1024, 3072, (bf16*)(ws + WS_WT_ML_IN), 0, 1, (size_t)0, (size_t)0);
        TR_MAT(INP(6), 1024, 1024, 1024, (bf16*)(ws + WS_WT_ML_OUT), 0, 1, (size_t)0, (size_t)0);
        TR_MAT(INP(7), 6144, 1024, 6144, (bf16*)(ws + WS_WT_RET_IN), 0, 1, (size_t)0, (size_t)0);
        TR_MAT(INP(9), 1024, 2048, 1024, (bf16*)(ws + WS_WT_RET_OUT), 0, 1, (size_t)0, (size_t)0);
        TR_MAT(INP(10), 3088, 1024, 3072, (bf16*)(ws + WS_WT_GLA_IN), 0, 1, (size_t)0, (size_t)0);
        TR_MAT(INP(14), 1024, 1024, 1024, (bf16*)(ws + WS_WT_GLA_OUT), 0, 1, (size_t)0, (size_t)0);
        TR_MAT(INP(15), 1024, 1024, 1024, (bf16*)(ws + WS_WT_S5_IN), 0, 1, (size_t)0, (size_t)0);
        TR_MAT(INP(24), 1024, 1024, 1024, (bf16*)(ws + WS_WT_S5_GLU), 0, 1, (size_t)0, (size_t)0);
        TR_MAT(INP(26), 1024, 1024, 1024, (bf16*)(ws + WS_WT_S5_OUT), 0, 1, (size_t)0, (size_t)0);
#undef TR_MAT
        __syncthreads();
        {
            const float* lam_re = INP(16); const float* lam_im = INP(17); const float* b_re = INP(18); const float* b_im = INP(19); const float* log_dt = INP(23);
            for (int i = blockIdx.x * NTHREADS + tid; i < 64 * 64; i += F.G * NTHREADS) {
                const int g = i >> 6;
                const float lr = lam_re[i], li = lam_im[i], dt = expf(log_dt[g]);
                const float er = expf(lr * dt); float sn, cs; sincosf(li * dt, &sn, &cs);
                const float br = er * cs, bi = er * sn;
                S5LB[2 * i] = br; S5LB[2 * i + 1] = bi;
                const float nr = br - 1.f, ni = bi, den = lr * lr + li * li;
                const float fr_ = (nr * lr + ni * li) / den, fi_ = (ni * lr - nr * li) / den;
                for (int h = 0; h < 16; ++h) { const float xr = b_re[i * 16 + h], xi = b_im[i * 16 + h];
                    S5BB[(i * 16 + h) * 2] = fr_ * xr - fi_ * xi; S5BB[(i * 16 + h) * 2 + 1] = fr_ * xi + fi_ * xr; }
            }
        }
        if (CH_S5) s5_tables(F, ws, tid, INP(16), INP(17), INP(18), INP(19), INP(20), INP(21), INP(23));
        LAS float* Wt = (LAS float*)(F.lds);
        load_cols16(tid, INP(3), 3088, 3072, Wt);
        __syncthreads();
        {
            const float* bg = INP(4);
            for (int row = F.gw; row < M; row += F.NGW) {
                asm volatile("" ::: "memory");
                f32x4 v[4]; load_row_f32(x_in + (size_t)row * D, v, lane);
                store_row_bf16(XB + (size_t)row * D, v, lane);
                float g[16]; row_dot16(v, Wt, lane, g);
                if (lane < 16) { float o = 0.f;
#pragma unroll
                    for (int e = 0; e < 16; ++e) o = (lane == e) ? g[e] : o;
                    GB[(size_t)row * 16 + lane] = o + bg[lane]; }
            }
        }
        __syncthreads();
      }
        SEAM(0);
    }

    layer_body<0>(F, ws, ctl, TAB, bar, lo, hi, args.out);
    layer_body<1>(F, ws, ctl, TAB, bar, lo, hi, args.out);
    layer_body<2>(F, ws, ctl, TAB, bar, lo, hi, args.out);
    layer_body<3>(F, ws, ctl, TAB, bar, lo, hi, args.out);
#undef IN
#undef SEAM
#undef INP
#undef x_in
#undef ln_g
#undef ln_b
}

extern "C" void kernel_launch(void* const* d_in, const int* in_sizes, int n_in, void* d_out, int out_size, void* d_ws, size_t ws_size, hipStream_t stream) {
    static int grid = 0;
    if (grid == 0) {
        if (n_in != 33 || out_size != M * D || ws_size < WS_END) { fprintf(stderr, "kernel_launch: unexpected problem (n_in %d, out %d, ws %zu < %zu)\n", n_in, out_size, ws_size, (size_t)WS_END); grid = -1; return; }
        int dev = 0, cus = 0, per_cu = 0;
        if (hipGetDevice(&dev) != hipSuccess || hipDeviceGetAttribute(&cus, hipDeviceAttributeMultiprocessorCount, dev) != hipSuccess) { grid = -1; return; }
        if (hipFuncSetAttribute((const void*)mega_fwd, hipFuncAttributeMaxDynamicSharedMemorySize, LDS_BYTES) != hipSuccess) { fprintf(stderr, "kernel_launch: hipFuncSetAttribute failed\n"); grid = -1; return; }
        if (hipOccupancyMaxActiveBlocksPerMultiprocessor(&per_cu, (const void*)mega_fwd, NTHREADS, LDS_BYTES) != hipSuccess || per_cu < 1) { fprintf(stderr, "kernel_launch: occupancy query says %d\n", per_cu); }
        (void)hipGetLastError();
        grid = cus;
    }
    if (grid < 0) return;
    hipMemsetAsync((char*)d_ws + WS_CTL, 0, CTL_ZERO_BYTES, stream);
    Args a{};
    for (int i = 0; i < 33; ++i) a.in[i] = (const float*)d_in[i];
    a.out = (float*)d_out; a.ws = (unsigned char*)d_ws;
#if N_LAUNCH_MODE == 1
    a.ph_lo = 0; a.ph_hi = 1000;
    hipLaunchKernelGGL(mega_fwd, dim3(grid), dim3(NTHREADS), LDS_BYTES, stream, a);
#else
    for (int ph = 0; ph < 65; ++ph) { a.ph_lo = ph; a.ph_hi = ph + 1; hipLaunchKernelGGL(mega_fwd, dim3(grid), dim3(NTHREADS), LDS_BYTES, stream, a); }
#endif
}
```

```cpp
#include <hip/hip_runtime.h>
#include <cstdio>
#include <cstdint>

#ifndef NAIVE_MIX
#define NAIVE_MIX 1
#endif
#ifndef CH_ML
#define CH_ML 1
#endif
#ifndef CH_RET
#define CH_RET 1
#endif
#ifndef CH_GLA
#define CH_GLA 1
#endif
#ifndef CH_S5
#define CH_S5 1
#endif
#ifndef PROBE_CLS
#define PROBE_CLS 0
#endif
#define REPS(c) ((PROBE_CLS == (c)) ? 2 : 1)
#ifndef N_LAUNCH_MODE
#define N_LAUNCH_MODE 1
#endif


#ifdef SKIP_ML
constexpr bool defined_SKIP_ML = true;
#else
constexpr bool defined_SKIP_ML = false;
#endif
#ifdef SKIP_RET
constexpr bool defined_SKIP_RET = true;
#else
constexpr bool defined_SKIP_RET = false;
#endif
#ifdef SKIP_GLA
constexpr bool defined_SKIP_GLA = true;
#else
constexpr bool defined_SKIP_GLA = false;
#endif
#ifdef SKIP_S5
constexpr bool defined_SKIP_S5 = true;
#else
constexpr bool defined_SKIP_S5 = false;
#endif
#ifdef SKIP_LN1
constexpr bool defined_SKIP_LN1 = true;
#else
constexpr bool defined_SKIP_LN1 = false;
#endif
#ifdef SKIP_P0
constexpr bool defined_SKIP_P0 = true;
#else
constexpr bool defined_SKIP_P0 = false;
#endif
#ifndef PHMASK
#define PHMASK 0xffff
#endif
#define PHE(b) (((PHMASK) >> (b)) & 1)
#define GAS __attribute__((address_space(1)))
#define LAS __attribute__((address_space(3)))
typedef unsigned short bf16;
typedef short bf16x8 __attribute__((ext_vector_type(8)));
typedef float f32x4 __attribute__((ext_vector_type(4)));
typedef float f32x2 __attribute__((ext_vector_type(2)));
typedef unsigned u32x4 __attribute__((ext_vector_type(4)));
typedef unsigned u32x2 __attribute__((ext_vector_type(2)));

constexpr int BATCH = 2, T = 8192, D = 1024, M = BATCH * T;
constexpr int NEXP = 32, TOPK = 4, DFF = 1024, CAP = M;
constexpr int NWAVES = 8, NTHREADS = 512;
constexpr float LN_EPS = 1e-5f;
constexpr float ALPHA = 1.681792830507429f;
constexpr int MAXTILES = (M * TOPK) / 256 + NEXP;

constexpr size_t MiB = 1u << 20;
constexpr size_t WS_CTL = 0, CTL_ZERO_BYTES = 1 * MiB;
constexpr size_t WS_WT_ML_IN = 1 * MiB;
constexpr size_t WS_WT_ML_OUT = WS_WT_ML_IN + 6 * MiB;
constexpr size_t WS_WT_RET_IN = WS_WT_ML_OUT + 2 * MiB;
constexpr size_t WS_WT_RET_OUT = WS_WT_RET_IN + 12 * MiB;
constexpr size_t WS_WT_GLA_IN = WS_WT_RET_OUT + 4 * MiB;
constexpr size_t WS_WT_GLA_OUT = WS_WT_GLA_IN + 6 * MiB;
constexpr size_t WS_WT_S5_IN = WS_WT_GLA_OUT + 2 * MiB;
constexpr size_t WS_WT_S5_GLU = WS_WT_S5_IN + 2 * MiB;
constexpr size_t WS_WT_S5_OUT = WS_WT_S5_GLU + 2 * MiB;
constexpr size_t WS_S5TAB = WS_WT_S5_OUT + 2 * MiB;
constexpr size_t WS_GB = WS_S5TAB + 1 * MiB;
constexpr size_t WS_LIST = WS_GB + 1 * MiB;
constexpr size_t WS_GW = WS_LIST + 2 * MiB;
constexpr size_t WS_WT_GU = WS_GW + 1 * MiB;
constexpr size_t WS_WT_DN = WS_WT_GU + 512 * MiB;
constexpr size_t WS_HF = WS_WT_DN + 256 * MiB;
constexpr size_t WS_XB = WS_HF + 64 * MiB;
constexpr size_t WS_ZF = WS_XB + 32 * MiB;
constexpr size_t WS_PB = WS_ZF + 64 * MiB;
constexpr size_t WS_LA = WS_PB + 192 * MiB;
constexpr size_t WS_ORAW = WS_LA + 32 * MiB;
constexpr size_t WS_YB = WS_ORAW + 128 * MiB;
constexpr size_t WS_ACT = WS_YB + 64 * MiB;
constexpr size_t WS_YS = WS_ACT + 144 * MiB;
constexpr size_t WS_XG = WS_YS + 256 * MiB;
constexpr size_t WS_UT = WS_XG + 1024 * MiB;
constexpr size_t WS_ST = WS_UT + 128 * MiB;
constexpr size_t WS_KPP = WS_ST + 64 * MiB;
constexpr size_t WS_SC = WS_KPP + 16 * MiB;
constexpr size_t WS_S5KT = WS_SC + 4 * MiB;
constexpr size_t WS_S5VT = WS_S5KT + 2 * MiB;
constexpr size_t WS_S5WT = WS_S5VT + 16 * MiB;
constexpr size_t WS_S5L64 = WS_S5WT + 16 * MiB;
constexpr size_t WS_S5SL = WS_S5L64 + 1 * MiB;
constexpr size_t WS_S5SP = WS_S5SL + 16 * MiB;
constexpr size_t WS_END = WS_S5SP + 8 * MiB;
constexpr int CW_BAR = 4096;
constexpr int CW_CNT = 16384;

constexpr int PH_BYTES = 139264;
constexpr int TAB_OFF = PH_BYTES;
constexpr int MISC_OFF = TAB_OFF + 4096;
constexpr int LDS_BYTES = 147456;

__device__ __forceinline__ unsigned f2bf(float f) { unsigned u = __builtin_bit_cast(unsigned, f); return (u + 0x7fffu + ((u >> 16) & 1u)) >> 16; }
__device__ __forceinline__ unsigned pk2(float lo, float hi) { return f2bf(lo) | (f2bf(hi) << 16); }
__device__ __forceinline__ float bf2f(unsigned short b) { return __builtin_bit_cast(float, ((unsigned)b) << 16); }
__device__ __forceinline__ float bflo(unsigned w) { return __builtin_bit_cast(float, w << 16); }
__device__ __forceinline__ float bfhi(unsigned w) { return __builtin_bit_cast(float, w & 0xffff0000u); }
__device__ __forceinline__ int lane_id() { int l; asm volatile("v_mbcnt_lo_u32_b32 %0, -1, 0\n\tv_mbcnt_hi_u32_b32 %0, -1, %0" : "=v"(l)); return l; }
__device__ __forceinline__ float wave_sum(float v) {
#pragma unroll
    for (int o = 1; o < 64; o <<= 1) v += __shfl_xor(v, o);
    return v;
}
__device__ __forceinline__ float sigmoidf_(float x) { return 1.f / (1.f + __expf(-x)); }
__device__ __forceinline__ float log_sigmoidf_(float x) { return fminf(x, 0.f) - log1pf(__expf(-fabsf(x))); }
__device__ __forceinline__ float gelu_tanh(float x) { const float u = 0.7978845608028654f * (x + 0.044715f * x * x * x); return 0.5f * x * (1.f + tanhf(u)); }

namespace pg8 {
constexpr int BM = 256, BK = 64, HALF = 128, HTB = HALF * BK * 2, STAGE_BYTES = 8 * HTB, NXCD = 8, WGM = 8;
__host__ __device__ __forceinline__ int lds_byte(int r, int c) { const int st = (r >> 4) * 2 + (c >> 5), rr = r & 15, cc = c & 31, ob = rr * 64 + cc * 2; return st * 1024 + (ob ^ (((ob >> 9) & 1) << 5)); }
__host__ __device__ __forceinline__ void stage_rc(int b, int& R, int& C) { const int st = b / 1024, sb = b % 1024, swz = sb ^ (((sb >> 9) & 1) << 5); R = (st >> 1) * 16 + swz / 64; C = (st & 1) * 32 + (swz % 64) / 2; }
__host__ __device__ __forceinline__ int perm32(int rho) { const int n = rho >> 4, i = rho & 15; return 8 * (i >> 2) + 4 * n + (i & 3); }

struct Unit { const char* A; const char* B; int pm, pn, e, nvalid; };

__device__ __forceinline__ int xcd_remap(int L, int nwg) { const int q = nwg / NXCD, r = nwg % NXCD, xcd = L % NXCD, off = L / NXCD; return (xcd < r ? xcd * (q + 1) : r * (q + 1) + (xcd - r) * q) + off; }

struct DenseOrder {
    const char* A; const char* Bt; int K, nM, nN, nwg, G, c;
    __device__ __forceinline__ void init(const void* A_, const void* Bt_, int M_, int N_, int K_, int G_, int c_) { A = (const char*)A_; Bt = (const char*)Bt_; K = K_; nM = M_ / BM; nN = N_ / BM; nwg = nM * nN; G = G_; c = c_; }
    __device__ __forceinline__ bool next(int i, Unit& u) const {
        const long L = (long)i * G + c; if (L >= nwg) return false;
        const int wgid = xcd_remap((int)L, nwg);
        const int nig = WGM * nN, gid = wgid / nig, fm = gid * WGM, gsz = (nM - fm) < WGM ? (nM - fm) : WGM;
        u.pm = fm + ((wgid % nig) % gsz); u.pn = (wgid % nig) / gsz; u.e = 0; u.nvalid = 256;
        u.A = A + (size_t)u.pm * 256 * K * 2; u.B = Bt + (size_t)u.pn * 256 * K * 2; return true;
    }
};
struct MoeOrder {
    const char* A; const char* Bt; const LAS int* tab;
    int K, nN, ntiles, nwg, G, c; size_t b_estride; int a_compact;
    __device__ __forceinline__ bool next(int i, Unit& u) const {
        const long L = (long)i * G + c; if (L >= nwg) return false;
        const int wgid = xcd_remap((int)L, nwg);
        const int nig = WGM * nN, gid = wgid / nig, fm = gid * WGM, gsz = (ntiles - fm) < WGM ? (ntiles - fm) : WGM;
        const int tl = fm + ((wgid % nig) % gsz); u.pm = tl; u.pn = (wgid % nig) / gsz;
        const int e = __builtin_amdgcn_readfirstlane(tab[72 + tl]); u.e = e; const int r0 = (tl - __builtin_amdgcn_readfirstlane(tab[32 + e])) * 256; const int rem = __builtin_amdgcn_readfirstlane(tab[e]) - r0; u.nvalid = rem < 256 ? rem : 256;
        u.A = a_compact ? A + (size_t)tl * 256 * K * 2 : A + ((size_t)e * CAP + r0) * K * 2;
        u.B = Bt + (size_t)e * b_estride + (size_t)u.pn * 256 * K * 2; return true;
    }
};

__device__ __forceinline__ unsigned cvt_pk_bf16(float lo, float hi) { unsigned r; asm volatile("v_cvt_pk_bf16_f32 %0, %1, %2" : "=v"(r) : "v"(lo), "v"(hi)); return r; }

struct EpiBf16 {
    static constexpr bool PERM = true;
    bf16* O; int ldc;
    __device__ __forceinline__ void operator()(const f32x4 (&acc)[2][2][4][2], const Unit& u, int wr, int wc, int fr, int fq) const {
        const int row0 = u.pm * BM + wr * 64 + fr, col0 = u.pn * BM + wc * 32 + 8 * fq;
#pragma unroll
        for (int ai = 0; ai < 2; ++ai)
#pragma unroll
            for (int m = 0; m < 4; ++m) { bf16* rowp = O + (size_t)(row0 + ai * HALF + m * 16) * ldc + col0;
#pragma unroll
                for (int bj = 0; bj < 2; ++bj) { const f32x4 v0 = acc[ai][bj][m][0], v1 = acc[ai][bj][m][1];
                    u32x4 w; w.x = cvt_pk_bf16(v0[0], v0[1]); w.y = cvt_pk_bf16(v0[2], v0[3]); w.z = cvt_pk_bf16(v1[0], v1[1]); w.w = cvt_pk_bf16(v1[2], v1[3]);
                    *(u32x4*)(rowp + bj * HALF) = w; } }
    }
};
struct EpiResid {
    static constexpr bool PERM = false;
    const float* __restrict__ hin; float* __restrict__ Z;
    __device__ __forceinline__ void operator()(const f32x4 (&acc)[2][2][4][2], const Unit& u, int wr, int wc, int fr, int fq) const {
        const int row0 = u.pm * BM + wr * 64 + fr, col0 = u.pn * BM + wc * 32 + 4 * fq;
#pragma unroll
        for (int ai = 0; ai < 2; ++ai)
#pragma unroll
            for (int m = 0; m < 4; ++m) { const size_t off = (size_t)(row0 + ai * HALF + m * 16) * D + col0;
                f32x4 hv[2][2];
#pragma unroll
                for (int bj = 0; bj < 2; ++bj)
#pragma unroll
                    for (int n = 0; n < 2; ++n) hv[bj][n] = *(const f32x4*)(hin + off + bj * HALF + n * 16);
#pragma unroll
                for (int bj = 0; bj < 2; ++bj)
#pragma unroll
                    for (int n = 0; n < 2; ++n) *(f32x4*)(Z + off + bj * HALF + n * 16) = hv[bj][n] * ALPHA + acc[ai][bj][m][n]; }
    }
};
struct EpiGlu {
    static constexpr bool PERM = true;
    const bf16* Y; const float* bias; bf16* O;
    __device__ __forceinline__ void operator()(const f32x4 (&acc)[2][2][4][2], const Unit& u, int wr, int wc, int fr, int fq) const {
        const int row0 = u.pm * BM + wr * 64 + fr, col0 = u.pn * BM + wc * 32 + 8 * fq;
#pragma unroll
        for (int ai = 0; ai < 2; ++ai)
#pragma unroll
            for (int m = 0; m < 4; ++m) { const size_t off = (size_t)(row0 + ai * HALF + m * 16) * D + col0;
#pragma unroll
                for (int bj = 0; bj < 2; ++bj) {
                    const f32x4 b0 = *(const f32x4*)(bias + col0 + bj * HALF), b1 = *(const f32x4*)(bias + col0 + bj * HALF + 4);
                    const u32x4 yw = *(const u32x4*)(Y + off + bj * HALF);
                    const f32x4 v0 = acc[ai][bj][m][0] + b0, v1 = acc[ai][bj][m][1] + b1;
                    float o[8];
                    o[0] = bflo(yw.x) * sigmoidf_(v0[0]); o[1] = bfhi(yw.x) * sigmoidf_(v0[1]); o[2] = bflo(yw.y) * sigmoidf_(v0[2]); o[3] = bfhi(yw.y) * sigmoidf_(v0[3]);
                    o[4] = bflo(yw.z) * sigmoidf_(v1[0]); o[5] = bfhi(yw.z) * sigmoidf_(v1[1]); o[6] = bflo(yw.w) * sigmoidf_(v1[2]); o[7] = bfhi(yw.w) * sigmoidf_(v1[3]);
                    u32x4 w; w.x = cvt_pk_bf16(o[0], o[1]); w.y = cvt_pk_bf16(o[2], o[3]); w.z = cvt_pk_bf16(o[4], o[5]); w.w = cvt_pk_bf16(o[6], o[7]);
                    *(u32x4*)(O + off + bj * HALF) = w; } }
    }
};
struct EpiSwiglu {
    static constexpr bool PERM = true;
    bf16* ACT; const float* bgu;
    __device__ __forceinline__ void operator()(const f32x4 (&acc)[2][2][4][2], const Unit& u, int wr, int wc, int fr, int fq) const {
        const int row0 = u.pm * BM + wr * 64 + fr, j0 = u.pn * HALF + wc * 32 + 8 * fq;
        const float* bg = bgu + (size_t)u.e * 2 * DFF + j0;
        const f32x4 g0 = *(const f32x4*)(bg), g1 = *(const f32x4*)(bg + 4), u0 = *(const f32x4*)(bg + DFF), u1 = *(const f32x4*)(bg + DFF + 4);
#pragma unroll
        for (int ai = 0; ai < 2; ++ai)
#pragma unroll
            for (int m = 0; m < 4; ++m) {
                float o[8];
#pragma unroll
                for (int n = 0; n < 2; ++n)
#pragma unroll
                    for (int i = 0; i < 4; ++i) {
                        float g = acc[ai][0][m][n][i] + (n ? g1[i] : g0[i]), up = acc[ai][1][m][n][i] + (n ? u1[i] : u0[i]);
                        g = fminf(g, 7.0f); up = fminf(fmaxf(up, -7.0f), 7.0f);
                        o[n * 4 + i] = (up + 1.0f) * g * sigmoidf_(1.702f * g); }
                u32x4 w; w.x = cvt_pk_bf16(o[0], o[1]); w.y = cvt_pk_bf16(o[2], o[3]); w.z = cvt_pk_bf16(o[4], o[5]); w.w = cvt_pk_bf16(o[6], o[7]);
                *(u32x4*)(ACT + (size_t)(row0 + ai * HALF + m * 16) * DFF + j0) = w; }
    }
};
struct EpiMoeDown {
    static constexpr bool PERM = true;
    bf16* YS; const float* bd; const int* list; const float* gw; const LAS int* tab;
    __device__ __forceinline__ void operator()(const f32x4 (&acc)[2][2][4][2], const Unit& u, int wr, int wc, int fr, int fq) const {
        const int col0 = u.pn * BM + wc * 32 + 8 * fq; const int r0 = (u.pm - __builtin_amdgcn_readfirstlane(tab[32 + u.e])) * 256;
        const float* bp = bd + (size_t)u.e * D + col0;
        f32x4 bv[2][2];
#pragma unroll
        for (int bj = 0; bj < 2; ++bj)
#pragma unroll
            for (int n = 0; n < 2; ++n) bv[bj][n] = *(const f32x4*)(bp + bj * HALF + 4 * n);
        int slot[8]; float g[8];
#pragma unroll
        for (int i = 0; i < 8; ++i) { const int r = (i >> 2) * HALF + wr * 64 + (i & 3) * 16 + fr; slot[i] = (r < u.nvalid) ? list[(size_t)u.e * CAP + r0 + r] : -1; }
#pragma unroll
        for (int i = 0; i < 8; ++i) g[i] = (slot[i] >= 0) ? gw[slot[i]] : 0.f;
#pragma unroll
        for (int ai = 0; ai < 2; ++ai)
#pragma unroll
            for (int m = 0; m < 4; ++m) { const int i = ai * 4 + m;
                if (slot[i] >= 0) { const float gg = g[i]; bf16* op = YS + (size_t)slot[i] * D + col0;
#pragma unroll
                    for (int bj = 0; bj < 2; ++bj) { const f32x4 v0 = (acc[ai][bj][m][0] + bv[bj][0]) * gg, v1 = (acc[ai][bj][m][1] + bv[bj][1]) * gg;
                        u32x4 w; w.x = cvt_pk_bf16(v0[0], v0[1]); w.y = cvt_pk_bf16(v0[2], v0[3]); w.z = cvt_pk_bf16(v1[0], v1[1]); w.w = cvt_pk_bf16(v1[2], v1[3]);
                        *(u32x4*)(op + bj * HALF) = w; } } }
    }
};

template <class Epi, class Sched, bool ALIGN_EPI, bool SP2>
__device__ __forceinline__ void gemm_phase(LAS unsigned char* lds, const int wid, const int K, const Sched& S, const Epi& E) {
    const int lane = lane_id(), tid = wid * 64 + lane, wr = wid >> 2, wc = wid & 3, fr = lane & 15, fq = lane >> 4;
    const int nt = K / BK;
    unsigned voffA[2], voffB[2];
#pragma unroll
    for (int i = 0; i < 2; ++i) { int R, C; stage_rc(tid * 16 + i * 8192, R, C); const int Rb = Epi::PERM ? ((R & ~31) + perm32(R & 31)) : R;
        voffA[i] = (unsigned)(R * K + C) * 2u; voffB[i] = (unsigned)(Rb * K + C) * 2u; }
    const size_t kstep = (size_t)(BK * 2);
    const size_t hstep = (size_t)HALF * K * 2;
    const unsigned ldsw = (unsigned)wid * 1024u;
    const int aoff = lds_byte(wr * 64 + fr, fq * 8), boff = lds_byte(wc * 32 + fr, fq * 8);
#define PG8_SA(b, h) (((b) * 2 + (h)) * HTB)
#define PG8_SB(b, h) ((4 + (b) * 2 + (h)) * HTB)
#define PG8_STAGE(bufoff, gbase, voff) do { _Pragma("unroll") for (int _i = 0; _i < 2; ++_i) \
        __builtin_amdgcn_global_load_lds((const unsigned*)((const char*)(gbase) + (voff)[_i]), (LAS unsigned*)(lds + (bufoff) + ldsw + _i * 8192), 16, 0, 0); } while (0)
#define PG8_LDA(dst, b, h) do { _Pragma("unroll") for (int m = 0; m < 4; ++m) _Pragma("unroll") for (int k = 0; k < 2; ++k) dst[m][k] = *(const LAS bf16x8*)(lds + PG8_SA(b, h) + aoff + m * 2048 + k * 1024); } while (0)
#define PG8_LDB(dst, b, h) do { _Pragma("unroll") for (int n = 0; n < 2; ++n) _Pragma("unroll") for (int k = 0; k < 2; ++k) dst[n][k] = *(const LAS bf16x8*)(lds + PG8_SB(b, h) + boff + n * 2048 + k * 1024); } while (0)
#define PG8_MMA(ai, bj, At, Bt) do { __builtin_amdgcn_s_setprio(1); _Pragma("unroll") for (int m = 0; m < 4; ++m) _Pragma("unroll") for (int n = 0; n < 2; ++n) _Pragma("unroll") for (int k = 0; k < 2; ++k) \
        acc[ai][bj][m][n] = __builtin_amdgcn_mfma_f32_16x16x32_bf16(Bt[n][k], At[m][k], acc[ai][bj][m][n], 0, 0, 0); __builtin_amdgcn_s_setprio(0); } while (0)
#define PG8_WAIT_V(n) asm volatile("s_waitcnt vmcnt(" #n ")" ::: "memory")
#define PG8_WAIT_L(n) asm volatile("s_waitcnt lgkmcnt(" #n ")" ::: "memory")
#define PG8_BAR __builtin_amdgcn_s_barrier()
#define PG8_SCHED __builtin_amdgcn_sched_barrier(0)
    Unit cur, nxt; int ui = 0;
    if (!S.next(0, cur)) return;
    f32x4 acc[2][2][4][2];
#pragma unroll
    for (int a = 0; a < 2; ++a)
#pragma unroll
        for (int b = 0; b < 2; ++b)
#pragma unroll
            for (int m = 0; m < 4; ++m)
#pragma unroll
                for (int n = 0; n < 2; ++n) acc[a][b][m][n] = (f32x4){0.f, 0.f, 0.f, 0.f};
    bf16x8 At[4][2], B0[2][2], B1[2][2];
    const char* cA = cur.A; const char* cB = cur.B;
    if constexpr (SP2) {
        PG8_STAGE(PG8_SB(0, 0), cB, voffB); PG8_STAGE(PG8_SB(0, 1), cB + hstep, voffB); PG8_STAGE(PG8_SA(0, 0), cA, voffA); PG8_STAGE(PG8_SA(0, 1), cA + hstep, voffA);
        if (wr == 1) PG8_BAR;
        PG8_WAIT_V(2); PG8_BAR;
        PG8_STAGE(PG8_SB(1, 0), cB + kstep, voffB); PG8_STAGE(PG8_SA(1, 0), cA + kstep, voffA); PG8_STAGE(PG8_SB(1, 1), cB + hstep + kstep, voffB);
        PG8_WAIT_V(6); PG8_BAR;
    } else {
        PG8_STAGE(PG8_SB(0, 0), cB, voffB); PG8_STAGE(PG8_SA(0, 0), cA, voffA); PG8_STAGE(PG8_SB(0, 1), cB + hstep, voffB); PG8_STAGE(PG8_SA(0, 1), cA + hstep, voffA);
        if (wr == 1) PG8_BAR;
        PG8_WAIT_V(4); PG8_BAR;
        PG8_STAGE(PG8_SB(1, 0), cB + kstep, voffB); PG8_STAGE(PG8_SA(1, 0), cA + kstep, voffA); PG8_STAGE(PG8_SB(1, 1), cB + hstep + kstep, voffB);
        PG8_WAIT_V(6); PG8_BAR;
    }
    for (;;) {
        const bool has_next = S.next(ui + 1, nxt);
        const char* nA = has_next ? nxt.A : cA; const char* nB = has_next ? nxt.B : cB;
        for (int t = 0; t < nt; t += 2) {
            const bool last = (t == nt - 2);
            const char* a1 = cA + (size_t)(t + 1) * kstep;
            const char* a2 = last ? nA : cA + (size_t)(t + 2) * kstep; const char* b2 = last ? nB : cB + (size_t)(t + 2) * kstep;
            const char* a3 = a2 + kstep; const char* b3 = b2 + kstep;
            if constexpr (SP2) {
            PG8_LDB(B0, 0, 0); PG8_LDB(B1, 0, 1); PG8_SCHED; PG8_LDA(At, 0, 0); PG8_STAGE(PG8_SA(1, 1), a1 + hstep, voffA);
            PG8_WAIT_V(8); PG8_WAIT_L(0); PG8_BAR; PG8_MMA(0, 0, At, B0); PG8_MMA(0, 1, At, B1); PG8_BAR; PG8_SCHED;
            PG8_LDA(At, 0, 1); PG8_STAGE(PG8_SB(0, 0), b2, voffB); PG8_STAGE(PG8_SB(0, 1), b2 + hstep, voffB); PG8_STAGE(PG8_SA(0, 0), a2, voffA);
            PG8_WAIT_V(8); PG8_WAIT_L(0); PG8_BAR; PG8_MMA(1, 0, At, B0); PG8_MMA(1, 1, At, B1); PG8_BAR; PG8_SCHED;
            PG8_LDB(B0, 1, 0); PG8_LDB(B1, 1, 1); PG8_SCHED; PG8_LDA(At, 1, 0); PG8_STAGE(PG8_SA(0, 1), a2 + hstep, voffA);
            PG8_WAIT_V(8); PG8_WAIT_L(0); PG8_BAR; PG8_MMA(0, 0, At, B0); PG8_MMA(0, 1, At, B1); PG8_BAR; PG8_SCHED;
            PG8_LDA(At, 1, 1); PG8_STAGE(PG8_SB(1, 0), b3, voffB); PG8_STAGE(PG8_SB(1, 1), b3 + hstep, voffB); PG8_STAGE(PG8_SA(1, 0), a3, voffA);
            PG8_WAIT_V(8); PG8_WAIT_L(0); PG8_BAR; PG8_MMA(1, 0, At, B0); PG8_MMA(1, 1, At, B1); PG8_BAR; PG8_SCHED;
            } else {
            PG8_LDB(B0, 0, 0); PG8_SCHED; PG8_LDA(At, 0, 0); PG8_STAGE(PG8_SA(1, 1), a1 + hstep, voffA);
            PG8_WAIT_L(8); PG8_BAR; PG8_WAIT_L(0); PG8_MMA(0, 0, At, B0); PG8_BAR; PG8_SCHED;
            PG8_LDB(B1, 0, 1); PG8_STAGE(PG8_SB(0, 0), b2, voffB);
            PG8_BAR; PG8_WAIT_L(0); PG8_MMA(0, 1, At, B1); PG8_BAR;
            PG8_LDA(At, 0, 1); PG8_STAGE(PG8_SA(0, 0), a2, voffA);
            PG8_BAR; PG8_WAIT_L(0); PG8_MMA(1, 0, At, B0); PG8_BAR; PG8_SCHED;
            PG8_STAGE(PG8_SB(0, 1), b2 + hstep, voffB);
            PG8_WAIT_V(6); PG8_BAR; PG8_MMA(1, 1, At, B1); PG8_BAR;
            PG8_LDB(B0, 1, 0); PG8_SCHED; PG8_LDA(At, 1, 0); PG8_STAGE(PG8_SA(0, 1), a2 + hstep, voffA);
            PG8_WAIT_L(8); PG8_BAR; PG8_WAIT_L(0); PG8_MMA(0, 0, At, B0); PG8_BAR; PG8_SCHED;
            PG8_LDB(B1, 1, 1); PG8_STAGE(PG8_SB(1, 0), b3, voffB);
            PG8_BAR; PG8_WAIT_L(0); PG8_MMA(0, 1, At, B1); PG8_BAR;
            PG8_LDA(At, 1, 1); PG8_STAGE(PG8_SA(1, 0), a3, voffA);
            PG8_BAR; PG8_WAIT_L(0); PG8_MMA(1, 0, At, B0); PG8_BAR; PG8_SCHED;
            PG8_STAGE(PG8_SB(1, 1), b3 + hstep, voffB);
            PG8_WAIT_V(6); PG8_BAR; PG8_MMA(1, 1, At, B1); PG8_BAR;
            }
        }
        if constexpr (ALIGN_EPI) { if (wr == 0) PG8_BAR; }
        E(acc, cur, wr, wc, fr, fq);
        if (!has_next) break;
#pragma unroll
        for (int a = 0; a < 2; ++a)
#pragma unroll
            for (int b = 0; b < 2; ++b)
#pragma unroll
                for (int m = 0; m < 4; ++m)
#pragma unroll
                    for (int n = 0; n < 2; ++n) acc[a][b][m][n] = (f32x4){0.f, 0.f, 0.f, 0.f};
        cur = nxt; cA = nA; cB = nB; ++ui;
        if constexpr (ALIGN_EPI) { if (wr == 1) PG8_BAR; }
    }
    PG8_WAIT_V(0);
    if constexpr (!ALIGN_EPI) { if (wr == 0) PG8_BAR; }
    PG8_BAR;
#undef PG8_SA
#undef PG8_SB
#undef PG8_STAGE
#undef PG8_LDA
#undef PG8_LDB
#undef PG8_MMA
#undef PG8_WAIT_V
#undef PG8_WAIT_L
#undef PG8_BAR
#undef PG8_SCHED
}
}

#define XB_TMO      128
#define XB_XCNT(j)  (256  + 64 * (j))
#define XB_XSUB(j)  (1280 + 64 * (j))
#define XB_XGEN(j)  (2304 + 64 * (j))
#define XB_TOP      3328
#define XB_TOPGEN   3392
#define XCD_BAR_WORDS 3456
#define XB_SPIN_CAP (1u << 18)
__device__ __forceinline__ unsigned xb_ld(unsigned* p)              { return __hip_atomic_load(p, __ATOMIC_RELAXED, __HIP_MEMORY_SCOPE_AGENT); }
__device__ __forceinline__ unsigned xb_add(unsigned* p, unsigned v) { return __hip_atomic_fetch_add(p, v, __ATOMIC_RELAXED, __HIP_MEMORY_SCOPE_AGENT); }
__device__ __forceinline__ unsigned xb_xcc_id() { return (unsigned)__builtin_amdgcn_s_getreg((3 << 11) | 20) & 0xFu; }
#define XB_SPIN(cond, bar) do { unsigned _sp = 0; while (cond) { __builtin_amdgcn_s_sleep(1); \
    if ((++_sp & 255u) == 0u) { if (xb_ld(&(bar)[XB_TMO])) break; if (_sp > XB_SPIN_CAP) { atomicAdd(&(bar)[XB_TMO], 1u); break; } } } } while (0)
struct XcdBarrier { unsigned* bar; unsigned x; volatile LAS unsigned* st; };
__device__ __forceinline__ XcdBarrier xcd_barrier_post(unsigned* bar, volatile LAS unsigned* st, bool leader) {
    XcdBarrier b; b.bar = bar; b.x = xb_xcc_id(); b.st = st;
    if (leader) (void)xb_add(&bar[XB_XCNT(b.x)], 1u);
    return b;
}
__device__ __forceinline__ void xcd_barrier_complete(unsigned* bar, unsigned x, unsigned& nloc, unsigned& nx) {
    const unsigned G = gridDim.x * gridDim.y * gridDim.z;
    unsigned sum, cnt, mine, sp = 0u;
    for (;;) {
        sum = 0u; cnt = 0u; mine = 0u;
#pragma unroll
        for (unsigned j = 0; j < 16; ++j) { const unsigned c = xb_ld(&bar[XB_XCNT(j)]); sum += c; cnt += (c > 0u) ? 1u : 0u; mine = (j == x) ? c : mine; }
        if (sum == G) break;
        __builtin_amdgcn_s_sleep(1);
        if ((++sp & 255u) == 0u) { if (xb_ld(&bar[XB_TMO])) break; if (sp > XB_SPIN_CAP) { atomicAdd(&bar[XB_TMO], 1u); break; } }
    }
    nloc = mine > 0u ? mine : 1u; nx = cnt > 0u ? cnt : 1u;
}
__device__ __forceinline__ void xcd_barrier(const XcdBarrier& b, int wave) {
    asm volatile("s_waitcnt vmcnt(0)" ::: "memory");
    __syncthreads();
    if (wave == 0 && lane_id() == 0) {
        unsigned* bar = b.bar;
        __builtin_amdgcn_s_waitcnt(0);
        unsigned nloc = b.st[0], nx = b.st[1];
        if (nloc == 0u) { xcd_barrier_complete(bar, b.x, nloc, nx); b.st[0] = nloc; b.st[1] = nx; }
        const unsigned old = xb_add(&bar[XB_XSUB(b.x)], 1u);
        const unsigned gen = old / nloc;
        if (old + 1u == (gen + 1u) * nloc) {
            __builtin_amdgcn_fence(__ATOMIC_RELEASE, "agent");
            asm volatile("s_waitcnt vmcnt(0)" ::: "memory");
            const unsigned og = xb_add(&bar[XB_TOP], 1u);
            const unsigned tg = og / nx;
            if (og + 1u == (tg + 1u) * nx) xb_add(&bar[XB_TOPGEN], 1u);
            else XB_SPIN(xb_ld(&bar[XB_TOPGEN]) == tg, bar);
            __builtin_amdgcn_fence(__ATOMIC_ACQUIRE, "agent");
            xb_add(&bar[XB_XGEN(b.x)], 1u);
            asm volatile("s_waitcnt vmcnt(0)" ::: "memory");
        } else {
            XB_SPIN(xb_ld(&bar[XB_XGEN(b.x)]) == gen, bar);
            __builtin_amdgcn_fence(__ATOMIC_ACQUIRE, "agent");
            asm volatile("s_waitcnt vmcnt(0)" ::: "memory");
        }
    }
    __syncthreads();
}

struct Args { const float* in[33]; float* out; unsigned char* ws; int ph_lo, ph_hi; };
struct Frame {
    LAS unsigned char* lds;
    int wave, vcu, G, gw, NGW;
};

__device__ __forceinline__ void transpose_item(const float* W, int ldw, int col_off, int K, bf16* WT, int mode, int kb, int nb, LAS unsigned char* scr, int lane) {
    const int k0 = 64 * kb, n0 = 64 * nb;
    const float* src = W + (size_t)k0 * ldw + col_off + n0;
    f32x4 v[16];
#pragma unroll
    for (int i = 0; i < 16; ++i) v[i] = *(const f32x4*)(src + (size_t)((lane >> 4) + 4 * i) * ldw + 4 * (lane & 15));
#pragma unroll
    for (int i = 0; i < 16; ++i) { LAS unsigned* p = (LAS unsigned*)(scr + ((lane >> 4) + 4 * i) * 132 + 8 * (lane & 15)); p[0] = pk2(v[i][0], v[i][1]); p[1] = pk2(v[i][2], v[i][3]); }
    asm volatile("s_waitcnt lgkmcnt(0)" ::: "memory");
    const int c = lane >> 3, nl = lane & 7;
#pragma unroll
    for (int r = 0; r < 8; ++r) { const int n = nl + 8 * r; const LAS unsigned short* s = (const LAS unsigned short*)(scr + (8 * c) * 132 + 2 * n);
        u32x4 o; o.x = (unsigned)s[0] | ((unsigned)s[66] << 16); o.y = (unsigned)s[132] | ((unsigned)s[198] << 16); o.z = (unsigned)s[264] | ((unsigned)s[330] << 16); o.w = (unsigned)s[396] | ((unsigned)s[462] << 16);
        const int ng = n0 + n; int drow = ng; if (mode == 1) { drow = ng < 1024 ? 256 * (ng >> 7) + (ng & 127) : 256 * ((ng - 1024) >> 7) + 128 + (ng & 127); }
        *(u32x4*)(WT + (size_t)drow * K + k0 + 8 * c) = o; }
    asm volatile("s_waitcnt lgkmcnt(0)" ::: "memory");
}

__device__ __forceinline__ void load_cols16(int tid, const float* W, int ldw, int col_off, LAS float* Wt) {
    for (int i = tid; i < 1024 * 16; i += NTHREADS) { const int e = i & 15, k = i >> 4; Wt[e * 1028 + k] = W[(size_t)k * ldw + col_off + e]; }
}
__device__ __forceinline__ void row_dot16(const f32x4 (&v)[4], const LAS float* Wt, int lane, float (&out)[16]) {
#pragma unroll
    for (int e = 0; e < 16; ++e) { float s = 0.f;
#pragma unroll
        for (int j = 0; j < 4; ++j) { const f32x4 w = *(const LAS f32x4*)(Wt + e * 1028 + 4 * (lane + 64 * j)); s += v[j][0] * w[0] + v[j][1] * w[1] + v[j][2] * w[2] + v[j][3] * w[3]; }
        out[e] = wave_sum(s); }
}
__device__ __forceinline__ void store_row_bf16(bf16* orow, const f32x4 (&v)[4], int lane) {
    unsigned long long* o8 = (unsigned long long*)orow + lane;
#pragma unroll
    for (int j = 0; j < 4; ++j) o8[64 * j] = (unsigned long long)pk2(v[j][0], v[j][1]) | ((unsigned long long)pk2(v[j][2], v[j][3]) << 32);
}
__device__ __forceinline__ void store_row_f32(float* orow, const f32x4 (&v)[4], int lane) {
    f32x4* o = (f32x4*)orow + lane;
#pragma unroll
    for (int j = 0; j < 4; ++j) o[64 * j] = v[j];
}
__device__ __forceinline__ void load_row_f32(const float* row, f32x4 (&v)[4], int lane) {
    const f32x4* p = (const f32x4*)row + lane;
#pragma unroll
    for (int j = 0; j < 4; ++j) v[j] = p[64 * j];
}
__device__ __forceinline__ void ln_row(f32x4 (&v)[4], const f32x4 (&gv)[4], const f32x4 (&bv)[4]) {
    float s = 0.f;
#pragma unroll
    for (int j = 0; j < 4; ++j) s += (v[j][0] + v[j][1]) + (v[j][2] + v[j][3]);
    const float mean = wave_sum(s) * (1.f / D); float s2 = 0.f;
#pragma unroll
    for (int j = 0; j < 4; ++j) { v[j] = v[j] - mean; s2 += (v[j][0] * v[j][0] + v[j][1] * v[j][1]) + (v[j][2] * v[j][2] + v[j][3] * v[j][3]); }
    const float rstd = 1.f / sqrtf(wave_sum(s2) * (1.f / D) + LN_EPS);
#pragma unroll
    for (int j = 0; j < 4; ++j) v[j] = v[j] * rstd * gv[j] + bv[j];
}

__device__ __forceinline__ const float* inp_ptr(LAS unsigned char* lds, int i) {
    const LAS unsigned* p = (const LAS unsigned*)(lds + MISC_OFF + 256) + 2 * i;
    const unsigned lo = __builtin_amdgcn_readfirstlane(p[0]), hi = __builtin_amdgcn_readfirstlane(p[1]);
    return (const float*)(const GAS float*)(((unsigned long long)hi << 32) | lo);
}

typedef short s16x4 __attribute__((ext_vector_type(4)));
typedef short v4i16_t __attribute__((ext_vector_type(4)));
constexpr int CL = 128, NCH = T / CL;
template <int MODE> struct MX;
template <> struct MX<0> { static constexpr int NH = 8, DK = 64,  DV = 128, LDP = 3072, KOFF = 512,  VOFF = 1024, GOFF = 2048; };
template <> struct MX<1> { static constexpr int NH = 8, DK = 128, DV = 256, LDP = 6144, KOFF = 1024, VOFF = 2048, GOFF = 4096; };
template <> struct MX<2> { static constexpr int NH = 4, DK = 128, DV = 256, LDP = 3072, KOFF = 512,  VOFF = 1024, GOFF = 2048; };
__device__ __forceinline__ s16x4 ds_tr(const LAS unsigned char* p) { return __builtin_bit_cast(s16x4, __builtin_amdgcn_ds_read_tr16_b64_v4i16((LAS v4i16_t*)p)); }
__device__ __forceinline__ bf16x8 tr_frag(const LAS unsigned char* base, int pitch, int k0, int n0, int lane) {
    const int g = lane >> 4, q = (lane & 15) >> 2, p = lane & 3;
    const LAS unsigned char* a = base + (k0 + 4 * g + q) * pitch + (n0 + 4 * p) * 2;
    const s16x4 r1 = ds_tr(a), r2 = ds_tr(a + 16 * pitch);
    bf16x8 f; f[0] = r1[0]; f[1] = r1[1]; f[2] = r1[2]; f[3] = r1[3]; f[4] = r2[0]; f[5] = r2[1]; f[6] = r2[2]; f[7] = r2[3]; return f;
}
__device__ __forceinline__ u32x4 scale_bf16x8(u32x4 v, float sc) {
    u32x4 o; o.x = pk2(bflo(v.x) * sc, bfhi(v.x) * sc); o.y = pk2(bflo(v.y) * sc, bfhi(v.y) * sc); o.z = pk2(bflo(v.z) * sc, bfhi(v.z) * sc); o.w = pk2(bflo(v.w) * sc, bfhi(v.w) * sc); return o;
}
__device__ __forceinline__ float ret_lg2gamma(int h) { return log2f(1.f - exp2f(-5.f - (float)h)); }

template <int MODE>
__device__ __forceinline__ void mix_phaseA(const Frame& F, unsigned char* ws, const int tid, const int lane) {
    typedef MX<MODE> C; constexpr int DK = C::DK, DV = C::DV, NH = C::NH, LDP = C::LDP, KP = DK * 2 + 32, VP = DV * 2 + 32, ETW = DV / 128, NDT = DK / 16;
    LAS unsigned char* ldsK = F.lds; LAS unsigned char* ldsV = F.lds + 128 * KP; LAS float* rsc = (LAS float*)(F.lds + 128 * KP + 128 * VP);
    const bf16* PB = (const bf16*)(ws + WS_PB); const bf16* KPP = (const bf16*)(ws + WS_KPP); float* UT = (float*)(ws + WS_UT);
    const float* GSC = (const float*)(ws + WS_SC); float* NLOC = (float*)(ws + WS_SC + 2 * MiB);
    const int w = F.wave, g = lane >> 4;
    for (int u = blockIdx.x; u < 2 * NH * NCH; u += F.G) {
        const int c = u % NCH, bh = u / NCH, h = bh % NH, b = bh / NH; const size_t row0 = (size_t)b * T + (size_t)c * CL;
        __syncthreads();
        if (tid < 128) { float sc = 1.f;
            if (MODE == 0) sc = __expf(GSC[(size_t)(1 * 16 + bh) * T + c * CL + tid] - GSC[(size_t)(2 * 16 + bh) * T + c * CL + 127]);
            if (MODE == 1) sc = exp2f((float)(127 - tid) * ret_lg2gamma(h));
            rsc[tid] = sc; }
        __syncthreads();
        for (int p = tid; p < 128 * DK / 8; p += NTHREADS) { const int r = p / (DK / 8), cp = p % (DK / 8);
            u32x4 v = (MODE == 2) ? *(const u32x4*)(KPP + (row0 + r) * 512 + h * 128 + cp * 8) : *(const u32x4*)(PB + (row0 + r) * LDP + C::KOFF + h * DK + cp * 8);
            if (MODE != 2) v = scale_bf16x8(v, rsc[r]);
            *(LAS u32x4*)(ldsK + r * KP + cp * 16) = v; }
        for (int p = tid; p < 128 * DV / 8; p += NTHREADS) { const int r = p / (DV / 8), cp = p % (DV / 8);
            *(LAS u32x4*)(ldsV + r * VP + cp * 16) = *(const u32x4*)(PB + (row0 + r) * LDP + C::VOFF + h * DV + cp * 8); }
        __syncthreads();
        f32x4 acc[ETW][NDT];
#pragma unroll
        for (int i = 0; i < ETW; ++i)
#pragma unroll
            for (int j = 0; j < NDT; ++j) acc[i][j] = (f32x4){0.f, 0.f, 0.f, 0.f};
#pragma unroll
        for (int ks = 0; ks < 4; ++ks) {
            bf16x8 af[ETW], bfv[NDT];
#pragma unroll
            for (int i = 0; i < ETW; ++i) af[i] = tr_frag(ldsV, VP, 32 * ks, (w * ETW + i) * 16, lane);
#pragma unroll
            for (int j = 0; j < NDT; ++j) bfv[j] = tr_frag(ldsK, KP, 32 * ks, j * 16, lane);
#pragma unroll
            for (int i = 0; i < ETW; ++i)
#pragma unroll
                for (int j = 0; j < NDT; ++j) acc[i][j] = __builtin_amdgcn_mfma_f32_16x16x32_bf16(af[i], bfv[j], acc[i][j], 0, 0, 0);
        }
        float* ut = UT + (size_t)u * DV * DK;
#pragma unroll
        for (int i = 0; i < ETW; ++i)
#pragma unroll
            for (int j = 0; j < NDT; ++j)
#pragma unroll
                for (int r = 0; r < 4; ++r) ut[(size_t)((w * ETW + i) * 16 + 4 * g + r) * DK + j * 16 + (lane & 15)] = acc[i][j][r];
        if (MODE == 0 && tid < 64) { float sacc = 0.f;
            for (int r = 0; r < 128; ++r) sacc += bf2f(*(const LAS unsigned short*)(ldsK + r * KP + tid * 2));
            NLOC[(size_t)u * 64 + tid] = sacc; }
    }
    __syncthreads();
}

template <int MODE>
__device__ __forceinline__ void mix_phaseB(const Frame& F, unsigned char* ws, const int tid) {
    typedef MX<MODE> C; constexpr int DK = C::DK, DV = C::DV, NH = C::NH, NEL = DV * DK, NBH = 2 * NH;
    const float* UT = (const float*)(ws + WS_UT); bf16* ST = (bf16*)(ws + WS_ST);
    const float* GSC = (const float*)(ws + WS_SC); const float* NLOC = (const float*)(ws + WS_SC + 2 * MiB); float* NPREV = (float*)(ws + WS_SC + 2 * MiB + 256 * 1024);
    float* MPREV = (float*)(ws + WS_SC + 2 * MiB + 512 * 1024); const float* DEC = (const float*)(ws + WS_SC + 3 * MiB);
    const int gtid = blockIdx.x * NTHREADS + tid, nthr = F.G * NTHREADS;
    for (int el = gtid; el < NBH * NEL; el += nthr) {
        const int bh = el / NEL, idx = el - bh * NEL, h = bh % NH, b = bh / NH;
        float S = 0.f, m = -1e30f;
        const float rdec = (MODE == 1) ? exp2f(128.f * ret_lg2gamma(h)) : 1.f;
#pragma unroll 1
        for (int c0 = 0; c0 < NCH; c0 += 8) {
            float uv[8];
#pragma unroll
            for (int i = 0; i < 8; ++i) uv[i] = UT[(size_t)(bh * NCH + c0 + i) * NEL + idx];
#pragma unroll
            for (int i = 0; i < 8; ++i) { const int c = c0 + i; const size_t u = (size_t)bh * NCH + c;
                ST[u * NEL + idx] = (bf16)f2bf(S);
                if (MODE == 0) { const float atot = GSC[(size_t)(0 * 16 + bh) * T + c * CL + 127], mloc = atot + GSC[(size_t)(2 * 16 + bh) * T + c * CL + 127];
                    const float mnew = fmaxf(atot + m, mloc), so = __expf(atot + m - mnew), sl = __expf(mloc - mnew);
                    if (idx == 0) MPREV[u] = m;
                    S = so * S + sl * uv[i]; m = mnew; }
                else if (MODE == 1) S = rdec * S + uv[i];
                else S = DEC[(size_t)(b * NCH + c) * 512 + h * 128 + (idx & 127)] * S + uv[i]; }
        }
    }
    if (MODE == 0) {
        for (int el = gtid; el < NBH * 64; el += nthr) { const int bh = el >> 6, d = el & 63; float S = 0.f, m = -1e30f;
            for (int c = 0; c < NCH; ++c) { const size_t u = (size_t)bh * NCH + c;
                const float atot = GSC[(size_t)(0 * 16 + bh) * T + c * CL + 127], mloc = atot + GSC[(size_t)(2 * 16 + bh) * T + c * CL + 127];
                const float mnew = fmaxf(atot + m, mloc), so = __expf(atot + m - mnew), sl = __expf(mloc - mnew);
                NPREV[u * 64 + d] = S; S = so * S + sl * NLOC[u * 64 + d]; m = mnew; } }
    }
}

template <int MODE>
__device__ __forceinline__ void mix_phaseC(const Frame& F, unsigned char* ws, const int tid, const int lane, const float* ng) {
    typedef MX<MODE> C; constexpr int DK = C::DK, DV = C::DV, NH = C::NH, LDP = C::LDP, VP = DV * 2 + 32, NET = DV / 16, NKS = DK / 32, DVT = NH * DV;
    LAS unsigned char* ldsV = F.lds; LAS float* tabs = (LAS float*)(F.lds + 128 * VP);
    const bf16* PB = (const bf16*)(ws + WS_PB); const bf16* ST = (const bf16*)(ws + WS_ST);
    const float* GSC = (const float*)(ws + WS_SC); const float* NPREV = (const float*)(ws + WS_SC + 2 * MiB + 256 * 1024); const float* MPREV = (const float*)(ws + WS_SC + 2 * MiB + 512 * 1024);
    const int w = F.wave, g = lane >> 4, li = lane & 15;
    for (int u = blockIdx.x; u < 2 * NH * NCH; u += F.G) {
        const int c = u % NCH, bh = u / NCH, h = bh % NH, b = bh / NH; const size_t row0 = (size_t)b * T + (size_t)c * CL;
        const float lg = (MODE == 1) ? ret_lg2gamma(h) : 0.f;
        __syncthreads();
        for (int p = tid; p < 128 * DV / 8; p += NTHREADS) { const int r = p / (DV / 8), cp = p % (DV / 8);
            *(LAS u32x4*)(ldsV + r * VP + cp * 16) = *(const u32x4*)(PB + (row0 + r) * LDP + C::VOFF + h * DV + cp * 8); }
        if (MODE == 0 && tid < 128) { const float mp = MPREV[u]; const size_t gi = (size_t)bh * T + c * CL + tid;
            const float a = GSC[(size_t)(0 * 16) * T + gi], gg = GSC[(size_t)(1 * 16) * T + gi], cm = GSC[(size_t)(2 * 16) * T + gi];
            const float Mt = fmaxf(mp, cm);
            tabs[tid] = gg; tabs[128 + tid] = Mt; tabs[256 + tid] = __expf(mp - Mt) * 0.125f; tabs[384 + tid] = __expf(-(a + Mt)); }
        __syncthreads();
        const int tq = 16 * w + li;
        const bf16* qrow = PB + (row0 + tq) * LDP + h * DK;
        bf16x8 qf[NKS];
#pragma unroll
        for (int ks = 0; ks < NKS; ++ks) qf[ks] = *(const bf16x8*)(qrow + 32 * ks + 8 * g);
        f32x4 O[NET];
#pragma unroll
        for (int et = 0; et < NET; ++et) O[et] = (f32x4){0.f, 0.f, 0.f, 0.f};
        float den = 0.f;
        const float Mq = (MODE == 0) ? tabs[128 + tq] : 0.f;
        for (int jp = 0; jp <= (w >> 1); ++jp) {
            f32x4 p0 = (f32x4){0.f, 0.f, 0.f, 0.f}, p1 = (f32x4){0.f, 0.f, 0.f, 0.f};
            const bf16* k0p = PB + (row0 + 32 * jp + li) * LDP + C::KOFF + h * DK + 8 * g;
#pragma unroll
            for (int ks = 0; ks < NKS; ++ks) p0 = __builtin_amdgcn_mfma_f32_16x16x32_bf16(*(const bf16x8*)(k0p + 32 * ks), qf[ks], p0, 0, 0, 0);
            if (2 * jp + 1 <= w) {
#pragma unroll
                for (int ks = 0; ks < NKS; ++ks) p1 = __builtin_amdgcn_mfma_f32_16x16x32_bf16(*(const bf16x8*)(k0p + (size_t)16 * LDP + 32 * ks), qf[ks], p1, 0, 0, 0);
            }
#pragma unroll
            for (int r = 0; r < 4; ++r) {
                const int s0 = 32 * jp + 4 * g + r, s1 = s0 + 16;
                float f0, f1;
                if (MODE == 0) { f0 = __expf(tabs[s0] - Mq) * 0.125f; f1 = __expf(tabs[s1] - Mq) * 0.125f; }
                else if (MODE == 1) { f0 = exp2f((float)(tq - s0) * lg); f1 = exp2f((float)(tq - s1) * lg); }
                else { f0 = 1.f; f1 = 1.f; }
                p0[r] = (s0 <= tq) ? p0[r] * f0 : 0.f; p1[r] = (s1 <= tq) ? p1[r] * f1 : 0.f;
                den += p0[r] + p1[r];
            }
            bf16x8 af; { const unsigned a0 = pk2(p0[0], p0[1]), a1 = pk2(p0[2], p0[3]), a2 = pk2(p1[0], p1[1]), a3 = pk2(p1[2], p1[3]); u32x4 t4; t4.x = a0; t4.y = a1; t4.z = a2; t4.w = a3; af = __builtin_bit_cast(bf16x8, t4); }
#pragma unroll
            for (int et = 0; et < NET; ++et) O[et] = __builtin_amdgcn_mfma_f32_16x16x32_bf16(af, tr_frag(ldsV, VP, 32 * jp, 16 * et, lane), O[et], 0, 0, 0);
        }
        const float qs = (MODE == 0) ? tabs[256 + tq] : (MODE == 1) ? exp2f((float)(tq + 1) * lg) : 1.f;
        const bf16* st = ST + (size_t)u * DV * DK;
        float dint = 0.f;
#pragma unroll
        for (int ks = 0; ks < NKS; ++ks) {
            bf16x8 aq = qf[ks];
            if (MODE != 2) aq = __builtin_bit_cast(bf16x8, scale_bf16x8(__builtin_bit_cast(u32x4, qf[ks]), qs));
            if (MODE == 0) { const float* np = NPREV + (size_t)u * 64 + 32 * ks + 8 * g; const u32x4 qa = __builtin_bit_cast(u32x4, aq);
                dint += bflo(qa.x) * np[0] + bfhi(qa.x) * np[1] + bflo(qa.y) * np[2] + bfhi(qa.y) * np[3] + bflo(qa.z) * np[4] + bfhi(qa.z) * np[5] + bflo(qa.w) * np[6] + bfhi(qa.w) * np[7]; }
#pragma unroll
            for (int et = 0; et < NET; ++et) O[et] = __builtin_amdgcn_mfma_f32_16x16x32_bf16(aq, *(const bf16x8*)(st + (size_t)(16 * et + li) * DK + 32 * ks + 8 * g), O[et], 0, 0, 0);
        }
        float rd[4] = {1.f, 1.f, 1.f, 1.f};
        if (MODE == 0) {
            float dt = den + dint; dt += __shfl_xor(dt, 16); dt += __shfl_xor(dt, 32);
            LAS float* wsc = tabs + 512 + 16 * w;
            if (g == 0) wsc[li] = 1.f / fmaxf(fabsf(dt), tabs[384 + tq]);
            asm volatile("s_waitcnt lgkmcnt(0)" ::: "memory");
#pragma unroll
            for (int r = 0; r < 4; ++r) rd[r] = wsc[4 * g + r];
        }
        float mean[4], rstd[4];
#pragma unroll
        for (int r = 0; r < 4; ++r) { float sacc = 0.f;
#pragma unroll
            for (int et = 0; et < NET; ++et) { O[et][r] *= rd[r]; sacc += O[et][r]; }
            sacc += __shfl_xor(sacc, 1); sacc += __shfl_xor(sacc, 2); sacc += __shfl_xor(sacc, 4); sacc += __shfl_xor(sacc, 8);
            mean[r] = sacc * (1.f / DV); float q = 0.f;
#pragma unroll
            for (int et = 0; et < NET; ++et) { const float dlt = O[et][r] - mean[r]; q += dlt * dlt; }
            q += __shfl_xor(q, 1); q += __shfl_xor(q, 2); q += __shfl_xor(q, 4); q += __shfl_xor(q, 8);
            rstd[r] = 1.f / sqrtf(q * (1.f / DV) + LN_EPS); }
        bf16* YBp = (bf16*)(ws + WS_YB);
#pragma unroll
        for (int et = 0; et < NET; ++et) { const float gn = ng[h * DV + 16 * et + li];
#pragma unroll
            for (int r = 0; r < 4; ++r) { const size_t row = row0 + 16 * w + 4 * g + r;
                const float gt = bf2f(PB[row * LDP + C::GOFF + h * DV + 16 * et + li]);
                const float gate = (MODE == 0) ? sigmoidf_(gt) : gt * sigmoidf_(gt);
                YBp[row * DVT + h * DV + 16 * et + li] = (bf16)f2bf(gate * (O[et][r] - mean[r]) * rstd[r] * gn); } }
    }
    __syncthreads();
}

constexpr int SLN = 32, NCI = T / SLN, NI = 2 * NCI, NRT = NI / 16, SKK = SLN * 16;
__device__ __forceinline__ void s5_coef(const float* lam_re, const float* lam_im, const float* log_dt, int g, int p, float& lr, float& li, float& dt, float& fr, float& fi) {
    const int i = g * 64 + p; lr = lam_re[i]; li = lam_im[i]; dt = expf(log_dt[g]);
    const float er = expf(lr * dt); float sn, cs; sincosf(li * dt, &sn, &cs);
    const float nr = er * cs - 1.f, ni = er * sn, den = lr * lr + li * li;
    fr = (nr * lr + ni * li) / den; fi = (ni * lr - nr * li) / den;
}
__device__ __forceinline__ void s5_pow(float lr, float li, float dt, float n, float& pr, float& pi) { const float e = expf(n * lr * dt); float sn, cs; sincosf(n * li * dt, &sn, &cs); pr = e * cs; pi = e * sn; }

__device__ __forceinline__ void s5_tables(const Frame& F, unsigned char* ws, const int tid, const float* lam_re, const float* lam_im, const float* b_re, const float* b_im, const float* c_re, const float* c_im, const float* log_dt) {
    bf16* KT = (bf16*)(ws + WS_S5KT); bf16* VT = (bf16*)(ws + WS_S5VT); bf16* WT = (bf16*)(ws + WS_S5WT); float* L64 = (float*)(ws + WS_S5L64);
    const int gt = blockIdx.x * NTHREADS + tid, nthr = F.G * NTHREADS;
    for (int idx = gt; idx < 64 * SLN * 16; idx += nthr) {
        const int h = idx & 15, tau = (idx >> 4) % SLN, g = idx / (16 * SLN);
        float acc[16];
#pragma unroll
        for (int q = 0; q < 16; ++q) acc[q] = 0.f;
        for (int p = 0; p < 64; ++p) { float lr, li, dt, fr, fi, pr, pi; s5_coef(lam_re, lam_im, log_dt, g, p, lr, li, dt, fr, fi); s5_pow(lr, li, dt, (float)tau, pr, pi);
            const float cr = c_re[(g * 16 + h) * 64 + p], ci = c_im[(g * 16 + h) * 64 + p];
            const float xr = cr * pr - ci * pi, xi = cr * pi + ci * pr;
            const float yr = xr * fr - xi * fi, yi = xr * fi + xi * fr;
            const float* br = b_re + (size_t)(g * 64 + p) * 16; const float* bi = b_im + (size_t)(g * 64 + p) * 16;
#pragma unroll
            for (int q = 0; q < 16; ++q) acc[q] += yr * br[q] - yi * bi[q]; }
        u32x4 o0, o1; o0.x = pk2(acc[0], acc[1]); o0.y = pk2(acc[2], acc[3]); o0.z = pk2(acc[4], acc[5]); o0.w = pk2(acc[6], acc[7]);
        o1.x = pk2(acc[8], acc[9]); o1.y = pk2(acc[10], acc[11]); o1.z = pk2(acc[12], acc[13]); o1.w = pk2(acc[14], acc[15]);
        *(u32x4*)(KT + (size_t)idx * 16) = o0; *(u32x4*)(KT + (size_t)idx * 16 + 8) = o1; }
    for (int idx = gt; idx < 64 * 64 * SLN; idx += nthr) {
        const int j = idx % SLN, p = (idx / SLN) & 63, g = idx / (SLN * 64);
        float lr, li, dt, fr, fi, pr, pi; s5_coef(lam_re, lam_im, log_dt, g, p, lr, li, dt, fr, fi);
        s5_pow(lr, li, dt, (float)(SLN - 1 - j), pr, pi);
        const float yr = pr * fr - pi * fi, yi = pr * fi + pi * fr;
        const float* br = b_re + (size_t)(g * 64 + p) * 16; const float* bi = b_im + (size_t)(g * 64 + p) * 16;
        float vr[16], vi[16];
#pragma unroll
        for (int q = 0; q < 16; ++q) { vr[q] = yr * br[q] - yi * bi[q]; vi[q] = yr * bi[q] + yi * br[q]; }
        bf16* v0 = VT + ((size_t)(g * 128 + 2 * p) * SKK + j * 16);
        u32x4 o; o.x = pk2(vr[0], vr[1]); o.y = pk2(vr[2], vr[3]); o.z = pk2(vr[4], vr[5]); o.w = pk2(vr[6], vr[7]); *(u32x4*)v0 = o;
        o.x = pk2(vr[8], vr[9]); o.y = pk2(vr[10], vr[11]); o.z = pk2(vr[12], vr[13]); o.w = pk2(vr[14], vr[15]); *(u32x4*)(v0 + 8) = o;
        o.x = pk2(vi[0], vi[1]); o.y = pk2(vi[2], vi[3]); o.z = pk2(vi[4], vi[5]); o.w = pk2(vi[6], vi[7]); *(u32x4*)(v0 + SKK) = o;
        o.x = pk2(vi[8], vi[9]); o.y = pk2(vi[10], vi[11]); o.z = pk2(vi[12], vi[13]); o.w = pk2(vi[14], vi[15]); *(u32x4*)(v0 + SKK + 8) = o;
        const int l = j; s5_pow(lr, li, dt, (float)(l + 1), pr, pi);
#pragma unroll
        for (int h = 0; h < 16; ++h) { const float cr = c_re[(g * 16 + h) * 64 + p], ci = c_im[(g * 16 + h) * 64 + p];
            *(unsigned*)(WT + ((size_t)((g * SLN + l) * 16 + h) * 128 + 2 * p)) = pk2(cr * pr - ci * pi, -(cr * pi + ci * pr)); }
        if (j == 0) { s5_pow(lr, li, dt, (float)SLN, pr, pi); L64[(g * 64 + p) * 2] = pr; L64[(g * 64 + p) * 2 + 1] = pi; }
    }
}
__device__ __forceinline__ void s5_phaseA(const Frame& F, unsigned char* ws, const int lane) {
    const bf16* PB = (const bf16*)(ws + WS_PB); const bf16* VT = (const bf16*)(ws + WS_S5VT); float* SL = (float*)(ws + WS_S5SL);
    const int gq = lane >> 4, li = lane & 15;
    for (int wu = F.gw; wu < 64 * NRT * 2; wu += F.NGW) {
        const int half = wu & 1, rt = (wu >> 1) % NRT, g = wu / (2 * NRT), b = rt / (NRT / 2), c0 = (rt % (NRT / 2)) * 16;
        f32x4 acc[4];
#pragma unroll
        for (int ct = 0; ct < 4; ++ct) acc[ct] = (f32x4){0.f, 0.f, 0.f, 0.f};
        const bf16* ap = PB + ((size_t)b * T + (size_t)(c0 + li) * SLN + (gq >> 1)) * 1024 + g * 16 + 8 * (gq & 1);
        const bf16* bp = VT + (size_t)(g * 128 + half * 64 + li) * SKK + 8 * gq;
#pragma unroll 4
        for (int ks = 0; ks < SLN / 2; ++ks) {
            const bf16x8 af = *(const bf16x8*)(ap + (size_t)(2 * ks) * 1024);
#pragma unroll
            for (int ct = 0; ct < 4; ++ct) acc[ct] = __builtin_amdgcn_mfma_f32_16x16x32_bf16(af, *(const bf16x8*)(bp + (size_t)(16 * ct) * SKK + 32 * ks), acc[ct], 0, 0, 0);
        }
#pragma unroll
        for (int ct = 0; ct < 4; ++ct)
#pragma unroll
            for (int r = 0; r < 4; ++r) SL[(size_t)(g * NI + rt * 16 + 4 * gq + r) * 128 + half * 64 + ct * 16 + li] = acc[ct][r];
    }
}
__device__ __forceinline__ void s5_phaseB(const Frame& F, unsigned char* ws, const int tid) {
    const float* SL = (const float*)(ws + WS_S5SL); bf16* SP = (bf16*)(ws + WS_S5SP); const float* L64 = (const float*)(ws + WS_S5L64);
    const int gt = blockIdx.x * NTHREADS + tid;
    if (gt < 2 * 64 * 64) { const int p = gt & 63, g = (gt >> 6) & 63, b = gt >> 12; const float ar = L64[(g * 64 + p) * 2], ai = L64[(g * 64 + p) * 2 + 1];
        float sr = 0.f, si = 0.f;
#pragma unroll 1
        for (int c0 = 0; c0 < NCI; c0 += 8) { f32x2 lv[8];
#pragma unroll
            for (int i = 0; i < 8; ++i) lv[i] = *(const f32x2*)(SL + (size_t)(g * NI + b * NCI + c0 + i) * 128 + 2 * p);
#pragma unroll
            for (int i = 0; i < 8; ++i) { *(unsigned*)(SP + (size_t)(g * NI + b * NCI + c0 + i) * 128 + 2 * p) = pk2(sr, si);
                const float nr = ar * sr - ai * si + lv[i][0], ni = ar * si + ai * sr + lv[i][1]; sr = nr; si = ni; } }
    }
}
__device__ __forceinline__ void s5_phaseC(const Frame& F, unsigned char* ws, const int lane, const float* dskip) {
    const bf16* PB = (const bf16*)(ws + WS_PB); const bf16* KT = (const bf16*)(ws + WS_S5KT); const bf16* WT = (const bf16*)(ws + WS_S5WT); const bf16* SP = (const bf16*)(ws + WS_S5SP);
    bf16* YB = (bf16*)(ws + WS_YB);
    const int gq = lane >> 4, li = lane & 15;
#pragma unroll 1
    for (int wu = F.gw; wu < 64 * NRT * 2; wu += F.NGW) {
        const int par = wu & 1, rt = (wu >> 1) % NRT, g = wu / (2 * NRT), b = rt / (NRT / 2), c0 = (rt % (NRT / 2)) * 16;
        bf16x8 af[SLN / 2], sf[4];
        const bf16* ap = PB + ((size_t)b * T + (size_t)(c0 + li) * SLN + (gq >> 1)) * 1024 + g * 16 + 8 * (gq & 1);
#pragma unroll
        for (int ks = 0; ks < SLN / 2; ++ks) af[ks] = *(const bf16x8*)(ap + (size_t)(2 * ks) * 1024);
#pragma unroll
        for (int ks = 0; ks < 4; ++ks) sf[ks] = *(const bf16x8*)(SP + (size_t)(g * NI + rt * 16 + li) * 128 + 32 * ks + 8 * gq);
        const float dl = dskip[g * 16 + li];
        const bf16* ktp = KT + (size_t)g * SLN * 256 + li * 16 + 8 * (gq & 1);
#pragma unroll
        for (int l2 = 0; l2 < SLN / 2; ++l2) {
            int l = 2 * l2 + par; asm volatile("" : "+v"(l));
            f32x4 acc = (f32x4){0.f, 0.f, 0.f, 0.f};
#pragma unroll
            for (int ks = 0; ks <= l2; ++ks) { const int tau = l - 2 * ks - (gq >> 1);
                bf16x8 bfv = *(const bf16x8*)(ktp + (size_t)(tau < 0 ? 0 : tau) * 256);
                if (ks == l2 && tau < 0) bfv = (bf16x8){0, 0, 0, 0, 0, 0, 0, 0};
                acc = __builtin_amdgcn_mfma_f32_16x16x32_bf16(af[ks], bfv, acc, 0, 0, 0); }
            const bf16* wp = WT + (size_t)((g * SLN + l) * 16 + li) * 128 + 8 * gq;
#pragma unroll
            for (int ks = 0; ks < 4; ++ks) acc = __builtin_amdgcn_mfma_f32_16x16x32_bf16(sf[ks], *(const bf16x8*)(wp + 32 * ks), acc, 0, 0, 0);
#pragma unroll
            for (int r = 0; r < 4; ++r) { const size_t row = (size_t)b * T + (size_t)(c0 + 4 * gq + r) * SLN + l; const size_t o = row * 1024 + g * 16 + li;
                const float y = acc[r] + dl * bf2f(PB[o]); YB[o] = (bf16)f2bf(gelu_tanh(y)); }
            asm volatile("" ::: "memory");
        }
    }
}

#define IN(k) (lo <= (k) && (k) < hi)
#define SEAM(k) do { if ((k) + 1 < hi) xcd_barrier(bar, F.wave); } while (0)
#define INP(i) inp_ptr(F.lds, (i))
#define x_in INP(0)
#define ln_g INP(1)
#define ln_b INP(2)
#define WS_PTRS \
    float* HF = (float*)(ws + WS_HF); bf16* XB = (bf16*)(ws + WS_XB); float* ZF = (float*)(ws + WS_ZF); bf16* PB = (bf16*)(ws + WS_PB); \
    float* GB = (float*)(ws + WS_GB); float* LA = (float*)(ws + WS_LA); float* ORAW = (float*)(ws + WS_ORAW); bf16* YB = (bf16*)(ws + WS_YB); \
    bf16* ACT = (bf16*)(ws + WS_ACT); bf16* YS = (bf16*)(ws + WS_YS); bf16* XG = (bf16*)(ws + WS_XG); \
    int* LIST = (int*)(ws + WS_LIST); float* GW = (float*)(ws + WS_GW); \
    float* S5LB = (float*)(ws + WS_S5TAB); float* S5BB = (float*)(ws + WS_S5TAB + 32768); \
    (void)HF; (void)XB; (void)ZF; (void)PB; (void)GB; (void)LA; (void)ORAW; (void)YB; (void)ACT; (void)YS; (void)XG; (void)LIST; (void)GW; (void)S5LB; (void)S5BB;

template <int layer>
__device__ __forceinline__ void layer_body(const Frame& F, unsigned char* ws, unsigned* ctl, LAS int* TAB, const XcdBarrier& bar, const int lo, const int hi, float* d_out) {
    WS_PTRS
        const int pb = 1 + layer * 16;
        const float* hin = (layer == 0) ? x_in : HF;
        if (PHE(1) && IN(pb + 0)) {
            const bf16* Wt = (const bf16*)(ws + (layer == 0 ? WS_WT_ML_IN : layer == 1 ? WS_WT_RET_IN : layer == 2 ? WS_WT_GLA_IN : WS_WT_S5_IN));
            const int N = (layer == 0 || layer == 2) ? 3072 : (layer == 1 ? 6144 : 1024);
            pg8::DenseOrder S; S.init(XB, Wt, M, N, D, F.G, (int)blockIdx.x);
            pg8::EpiBf16 E{PB, N};
            for (int rep_ = 0; rep_ < REPS(2); ++rep_)
            pg8::gemm_phase<pg8::EpiBf16, pg8::DenseOrder, true, true>(F.lds, F.wave, D, S, E);
            if (layer == 0 && CH_ML) {
                const int lane = lane_id(), gt = blockIdx.x * NTHREADS + F.wave * 64 + lane;
                if (gt < 16 * NCH) { const int bh = gt / NCH, c = gt % NCH, b = bh >> 3, h = bh & 7; float a = 0.f, cm = -3.0e38f; float* GSC = (float*)(ws + WS_SC);
                    for (int l = 0; l < CL; ++l) { const int t = c * CL + l; const size_t row = (size_t)b * T + t;
                        a += log_sigmoidf_(GB[row * 16 + 8 + h]); const float gg = GB[row * 16 + h] - a; cm = fmaxf(cm, gg);
                        GSC[(size_t)(0 * 16 + bh) * T + t] = a; GSC[(size_t)(1 * 16 + bh) * T + t] = gg; GSC[(size_t)(2 * 16 + bh) * T + t] = cm; } }
            }
            SEAM(pb + 0);
        }
        if (layer == 0) {
            if (CH_ML) {
                if (IN(pb + 2)) { const int lane = lane_id(), tid = F.wave * 64 + lane; for (int rep_ = 0; rep_ < REPS(6); ++rep_) mix_phaseA<0>(F, ws, tid, lane); SEAM(pb + 2); }
                if (IN(pb + 3)) { const int lane = lane_id(), tid = F.wave * 64 + lane; for (int rep_ = 0; rep_ < REPS(7); ++rep_) mix_phaseB<0>(F, ws, tid); SEAM(pb + 3); }
                if (IN(pb + 4)) { const int lane = lane_id(), tid = F.wave * 64 + lane; for (int rep_ = 0; rep_ < REPS(8); ++rep_) mix_phaseC<0>(F, ws, tid, lane, INP(5)); SEAM(pb + 4); }
            }
        } else if (layer == 1) {
            if (IN(pb + 1)) { const int lane = lane_id(), tid = F.wave * 64 + lane; (void)tid;
                for (int it = blockIdx.x * NTHREADS + tid; it < T * 64; it += F.G * NTHREADS) {
                    const int t = it >> 6, i = it & 63;
                    const float inv = exp2f(-(float)(2 * i) * (13.287712379549449f / 128.f));
                    float sn, cs; sincosf((float)t * inv, &sn, &cs);
                    for (int b = 0; b < 2; ++b) { bf16* pr = PB + (size_t)(b * T + t) * 6144;
                        for (int qk = 0; qk < 2; ++qk) { const float sc = qk ? 0.08838834764831845f : 1.f;
                            for (int h = 0; h < 8; ++h) { bf16* p = pr + qk * 1024 + h * 128 + i; const float t1 = bf2f(p[0]), t2 = bf2f(p[64]);
                                p[0] = (bf16)f2bf((t1 * cs - t2 * sn) * sc); p[64] = (bf16)f2bf((t1 * sn + t2 * cs) * sc); } } }
                }
                SEAM(pb + 1);
            }
            if (CH_RET) {
                if (IN(pb + 2)) { const int lane = lane_id(), tid = F.wave * 64 + lane; for (int rep_ = 0; rep_ < REPS(6); ++rep_) mix_phaseA<1>(F, ws, tid, lane); SEAM(pb + 2); }
                if (IN(pb + 3)) { const int lane = lane_id(), tid = F.wave * 64 + lane; for (int rep_ = 0; rep_ < REPS(7); ++rep_) mix_phaseB<1>(F, ws, tid); SEAM(pb + 3); }
                if (IN(pb + 4)) { const int lane = lane_id(), tid = F.wave * 64 + lane; for (int rep_ = 0; rep_ < REPS(8); ++rep_) mix_phaseC<1>(F, ws, tid, lane, INP(8)); SEAM(pb + 4); }
            }
        } else if (layer == 2) {
            if (CH_GLA) {
                if (IN(pb + 1)) {
                    const int lane = lane_id(), gt = blockIdx.x * NTHREADS + F.wave * 64 + lane;
                    if (gt < 2 * NCH * 512) { const int ch = gt & 511, bc = gt >> 9, b = bc / NCH, c = bc % NCH; const size_t row0 = (size_t)b * T + (size_t)c * CL;
                        bf16* KPP = (bf16*)(ws + WS_KPP); float* DEC = (float*)(ws + WS_SC + 3 * MiB);
                        float bend = 0.f;
#pragma unroll 8
                        for (int l = 0; l < CL; ++l) bend += LA[(row0 + l) * 512 + ch];
                        float bcum = 0.f;
#pragma unroll 8
                        for (int l = 0; l < CL; ++l) { bcum += LA[(row0 + l) * 512 + ch]; bf16* pr = PB + (row0 + l) * 3072;
                            const float qv = bf2f(pr[ch]), kv = bf2f(pr[512 + ch]) * 0.08838834764831845f;
                            pr[ch] = (bf16)f2bf(qv * __expf(bcum)); pr[512 + ch] = (bf16)f2bf(kv * __expf(-bcum)); KPP[(row0 + l) * 512 + ch] = (bf16)f2bf(kv * __expf(bend - bcum)); }
                        DEC[(size_t)bc * 512 + ch] = __expf(bend); }
                    SEAM(pb + 1);
                }
                if (IN(pb + 2)) { const int lane = lane_id(), tid = F.wave * 64 + lane; for (int rep_ = 0; rep_ < REPS(6); ++rep_) mix_phaseA<2>(F, ws, tid, lane); SEAM(pb + 2); }
                if (IN(pb + 3)) { const int lane = lane_id(), tid = F.wave * 64 + lane; for (int rep_ = 0; rep_ < REPS(7); ++rep_) mix_phaseB<2>(F, ws, tid); SEAM(pb + 3); }
                if (IN(pb + 4)) { const int lane = lane_id(), tid = F.wave * 64 + lane; for (int rep_ = 0; rep_ < REPS(8); ++rep_) mix_phaseC<2>(F, ws, tid, lane, INP(13)); SEAM(pb + 4); }
            }
        } else {
            if (CH_S5) {
                if (IN(pb + 2)) { const int lane = lane_id(); for (int rep_ = 0; rep_ < REPS(6); ++rep_) s5_phaseA(F, ws, lane); SEAM(pb + 2); }
                if (IN(pb + 3)) { const int lane = lane_id(), tid = F.wave * 64 + lane; for (int rep_ = 0; rep_ < REPS(7); ++rep_) s5_phaseB(F, ws, tid); SEAM(pb + 3); }
                if (IN(pb + 4)) { const int lane = lane_id(); for (int rep_ = 0; rep_ < REPS(8); ++rep_) s5_phaseC(F, ws, lane, INP(22)); SEAM(pb + 4); }
            }
        }
        if (PHE(4) && layer == 3 && IN(pb + 6)) {
            pg8::DenseOrder S; S.init(YB, ws + WS_WT_S5_GLU, M, D, D, F.G, (int)blockIdx.x);
            pg8::EpiGlu E{YB, INP(25), (bf16*)ORAW};
            for (int rep_ = 0; rep_ < REPS(3); ++rep_)
            pg8::gemm_phase<pg8::EpiGlu, pg8::DenseOrder, true, true>(F.lds, F.wave, D, S, E);
            SEAM(pb + 6);
        }
        if (PHE(5) && IN(pb + 7)) {
            const bf16* Wt = (const bf16*)(ws + (layer == 0 ? WS_WT_ML_OUT : layer == 1 ? WS_WT_RET_OUT : layer == 2 ? WS_WT_GLA_OUT : WS_WT_S5_OUT));
            const int Kd = (layer == 1) ? 2048 : 1024;
            const bf16* Ain = (layer == 3) ? (const bf16*)ORAW : YB;
            pg8::DenseOrder S; S.init(Ain, Wt, M, D, Kd, F.G, (int)blockIdx.x);
            pg8::EpiResid E{hin, ZF};
            for (int rep_ = 0; rep_ < REPS(3); ++rep_)
            pg8::gemm_phase<pg8::EpiResid, pg8::DenseOrder, true, true>(F.lds, F.wave, Kd, S, E);
            SEAM(pb + 7);
        }
        unsigned* cnt = ctl + CW_CNT + layer * 32 * 64;
        if (IN(pb + 8) && !defined_SKIP_LN1) { const int lane = lane_id(), tid = F.wave * 64 + lane; (void)tid;
            LAS float* Wt = (LAS float*)(F.lds);
            { const float* wr_ = INP(27) + (size_t)layer * D * NEXP;
              for (int i = tid; i < D * NEXP; i += NTHREADS) { const int e = i & 31, k = i >> 5; Wt[e * 1028 + k] = wr_[i]; } }
            __syncthreads();
            const float* br_ = INP(28) + layer * NEXP;
            const float* lng_ = ln_g + (size_t)(layer * 2 + 0) * D; const float* lnb_ = ln_b + (size_t)(layer * 2 + 0) * D;
            for (int row = F.gw; row < M; row += F.NGW) {
                asm volatile("" ::: "memory");
                f32x4 v[4]; load_row_f32(ZF + (size_t)row * D, v, lane);
                { f32x4 gv[4], bv[4]; load_row_f32(lng_, gv, lane); load_row_f32(lnb_, bv, lane); ln_row(v, gv, bv); }
                store_row_f32(HF + (size_t)row * D, v, lane);
                float pz[32];
#pragma unroll
                for (int e = 0; e < 32; ++e) { float sacc = 0.f;
#pragma unroll
                    for (int j = 0; j < 4; ++j) { const f32x4 w = *(const LAS f32x4*)(Wt + e * 1028 + 4 * (lane + 64 * j)); sacc += v[j][0] * w[0] + v[j][1] * w[1] + v[j][2] * w[2] + v[j][3] * w[3]; }
                    pz[e] = sacc; }
                float a16[16], a8[8], a4[4], a2[2], lgv;
                { const bool hi = (lane & 32) != 0;
#pragma unroll
                  for (int e = 0; e < 16; ++e) { const float mine = hi ? pz[e + 16] : pz[e], theirs = hi ? pz[e] : pz[e + 16]; a16[e] = mine + __shfl_xor(theirs, 32); } }
                { const bool hi = (lane & 16) != 0;
#pragma unroll
                  for (int e = 0; e < 8; ++e) { const float mine = hi ? a16[e + 8] : a16[e], theirs = hi ? a16[e] : a16[e + 8]; a8[e] = mine + __shfl_xor(theirs, 16); } }
                { const bool hi = (lane & 8) != 0;
#pragma unroll
                  for (int e = 0; e < 4; ++e) { const float mine = hi ? a8[e + 4] : a8[e], theirs = hi ? a8[e] : a8[e + 4]; a4[e] = mine + __shfl_xor(theirs, 8); } }
                { const bool hi = (lane & 4) != 0;
#pragma unroll
                  for (int e = 0; e < 2; ++e) { const float mine = hi ? a4[e + 2] : a4[e], theirs = hi ? a4[e] : a4[e + 2]; a2[e] = mine + __shfl_xor(theirs, 4); } }
                { const bool hi = (lane & 2) != 0; const float mine = hi ? a2[1] : a2[0], theirs = hi ? a2[0] : a2[1]; lgv = mine + __shfl_xor(theirs, 2); }
                lgv += __shfl_xor(lgv, 1);
                lgv += br_[lane >> 1];
                int te[4]; float tv[4];
#pragma unroll
                for (int k = 0; k < 4; ++k) { float best = lgv;
#pragma unroll
                    for (int o = 1; o < 64; o <<= 1) best = fmaxf(best, __shfl_xor(best, o));
                    const unsigned long long mk = __ballot(lgv == best); const int src = __builtin_amdgcn_readfirstlane((int)__ffsll((long long)mk) - 1);
                    te[k] = src >> 1; tv[k] = best; if ((lane >> 1) == te[k]) lgv = -3.0e38f; }
                const float e0 = 1.f, e1 = __expf(tv[1] - tv[0]), e2 = __expf(tv[2] - tv[0]), e3 = __expf(tv[3] - tv[0]), rs = 1.f / (e0 + e1 + e2 + e3);
                int pos = 0;
                if (lane < 4) { const int ek = lane == 0 ? te[0] : lane == 1 ? te[1] : lane == 2 ? te[2] : te[3]; const float gk = (lane == 0 ? e0 : lane == 1 ? e1 : lane == 2 ? e2 : e3) * rs;
                    pos = (int)__hip_atomic_fetch_add(cnt + ek * 64, 1u, __ATOMIC_RELAXED, __HIP_MEMORY_SCOPE_AGENT);
                    LIST[(size_t)ek * CAP + pos] = row * 4 + lane; GW[row * 4 + lane] = gk; }
#pragma unroll
                for (int k = 0; k < 4; ++k) { const int pk = __shfl(pos, k); store_row_bf16(XG + ((size_t)te[k] * CAP + pk) * D, v, lane); }
            }
            __syncthreads();
            SEAM(pb + 8);
        }
        if ((PHE(7) || PHE(8)) && (IN(pb + 9) || IN(pb + 10))) { const int lane = lane_id(), tid = F.wave * 64 + lane; (void)tid;
            __syncthreads();
            if (tid < 32) TAB[tid] = (int)__hip_atomic_load(cnt + tid * 64, __ATOMIC_RELAXED, __HIP_MEMORY_SCOPE_AGENT);
            __syncthreads();
            if (tid == 0) { int acc = 0; for (int e = 0; e < 32; ++e) { TAB[32 + e] = acc; const int nt_ = (TAB[e] + 255) >> 8; for (int j = 0; j < nt_; ++j) TAB[72 + acc + j] = e; acc += nt_; } TAB[64] = acc; }
            __syncthreads();
        }
        if (PHE(7) && IN(pb + 9)) {
            pg8::MoeOrder S; S.A = (const char*)XG; S.Bt = (const char*)(ws + WS_WT_GU + (size_t)layer * 32 * 2048 * 1024 * 2); S.tab = TAB; S.K = D; S.nN = 8; S.ntiles = __builtin_amdgcn_readfirstlane(TAB[64]); S.nwg = S.ntiles * 8; S.G = F.G; S.c = (int)blockIdx.x;
            S.b_estride = (size_t)2048 * 1024 * 2; S.a_compact = 0;
            pg8::EpiSwiglu E{ACT, INP(30) + (size_t)layer * 32 * 2048};
            for (int rep_ = 0; rep_ < REPS(4); ++rep_)
            pg8::gemm_phase<pg8::EpiSwiglu, pg8::MoeOrder, true, true>(F.lds, F.wave, D, S, E);
            SEAM(pb + 9);
        }
        if (PHE(8) && IN(pb + 10)) {
            pg8::MoeOrder S; S.A = (const char*)ACT; S.Bt = (const char*)(ws + WS_WT_DN + (size_t)layer * 32 * 1024 * 1024 * 2); S.tab = TAB; S.K = DFF; S.nN = 4; S.ntiles = __builtin_amdgcn_readfirstlane(TAB[64]); S.nwg = S.ntiles * 4; S.G = F.G; S.c = (int)blockIdx.x;
            S.b_estride = (size_t)1024 * 1024 * 2; S.a_compact = 1;
            pg8::EpiMoeDown E{YS, INP(32) + (size_t)layer * 32 * 1024, LIST, GW, TAB};
            for (int rep_ = 0; rep_ < REPS(5); ++rep_)
            pg8::gemm_phase<pg8::EpiMoeDown, pg8::MoeOrder, true, true>(F.lds, F.wave, DFF, S, E);
            SEAM(pb + 10);
        }
        if (PHE(9) && IN(pb + 11)) { const int lane = lane_id(), tid = F.wave * 64 + lane; (void)tid;
            LAS float* Wt = (LAS float*)(F.lds);
            if (layer == 1) { load_cols16(tid, INP(10), 3088, 3072, Wt); __syncthreads(); }
            const float* lng_ = ln_g + (size_t)(layer * 2 + 1) * D; const float* lnb_ = ln_b + (size_t)(layer * 2 + 1) * D;
            float* outp = (layer == 3) ? d_out : HF;
            for (int row = F.gw; row < M; row += F.NGW) {
                asm volatile("" ::: "memory");
                f32x4 v[4]; load_row_f32(HF + (size_t)row * D, v, lane);
#pragma unroll
                for (int j = 0; j < 4; ++j) v[j] = v[j] * ALPHA;
#pragma unroll
                for (int k = 0; k < 4; ++k) { const u32x2* yp = (const u32x2*)(YS + ((size_t)row * 4 + k) * D) + lane;
#pragma unroll
                    for (int j = 0; j < 4; ++j) { const u32x2 yw = yp[64 * j]; v[j][0] += bflo(yw.x); v[j][1] += bfhi(yw.x); v[j][2] += bflo(yw.y); v[j][3] += bfhi(yw.y); } }
                { f32x4 gv[4], bv[4]; load_row_f32(lng_, gv, lane); load_row_f32(lnb_, bv, lane); ln_row(v, gv, bv); }
                store_row_f32(outp + (size_t)row * D, v, lane);
                if (layer < 3) store_row_bf16(XB + (size_t)row * D, v, lane);
                if (layer == 1) {
                    float z[16]; row_dot16(v, Wt, lane, z);
                    if (lane < 16) { float o = 0.f;
#pragma unroll
                        for (int e = 0; e < 16; ++e) o = (lane == e) ? z[e] : o;
                        GB[(size_t)row * 16 + lane] = o; }
                }
            }
            if (layer == 1) {
                __syncthreads();
                const float* wgp = INP(11); const float bgc = INP(12)[tid];
                float wg[16];
#pragma unroll
                for (int r = 0; r < 16; ++r) wg[r] = wgp[r * 512 + tid];
                for (int row = F.vcu * NWAVES; row < M; row += F.NGW) {
#pragma unroll 1
                    for (int w = 0; w < NWAVES; ++w) { const float* zr = GB + (size_t)(row + w) * 16; float sacc = bgc;
#pragma unroll
                        for (int r = 0; r < 16; ++r) sacc += zr[r] * wg[r];
                        LA[(size_t)(row + w) * 512 + tid] = log_sigmoidf_(sacc) * (1.f / 16.f); }
                }
            }
            __syncthreads();
            SEAM(pb + 11);
        }
}
__global__ void __launch_bounds__(NTHREADS, 2) mega_fwd(Args args) {
    extern __shared__ __attribute__((aligned(16))) unsigned char lds_raw[];
    Frame F;
    F.lds = (LAS unsigned char*)lds_raw;
    F.wave = __builtin_amdgcn_readfirstlane((int)threadIdx.x >> 6);
    F.G = gridDim.x; { const int bx = blockIdx.x; F.vcu = (F.G % 8 == 0) ? (bx % 8) * (F.G / 8) + bx / 8 : bx; }
    F.gw = F.vcu * NWAVES + F.wave; F.NGW = F.G * NWAVES;
    unsigned char* ws = args.ws;
    unsigned* ctl = (unsigned*)(ws + WS_CTL);
    volatile LAS unsigned* MISC = (volatile LAS unsigned*)(F.lds + MISC_OFF);
    LAS int* TAB = (LAS int*)(F.lds + TAB_OFF);
    { const int tid0 = threadIdx.x;
      if (tid0 < 64) MISC[tid0] = 0u;
      if (tid0 < 33) ((LAS unsigned long long*)(F.lds + MISC_OFF + 256))[tid0] = (unsigned long long)args.in[tid0]; }
    __syncthreads();
    XcdBarrier bar = xcd_barrier_post(ctl + CW_BAR, MISC + 8, F.wave == 0 && lane_id() == 0);
    const int lo = args.ph_lo, hi = args.ph_hi;
    WS_PTRS
    if (IN(0) && !defined_SKIP_P0) { const int lane = lane_id(), tid = F.wave * 64 + lane; (void)tid;
      {
        LAS unsigned char* scr = F.lds + F.wave * 8704;
#define TR_MAT(src_, ldw_, K_, N_, dst_, mode_, count_, sstride_, dstride_) do { \
            const int nkb = (K_) / 64, nnb = (N_) / 64, per = nkb * nnb, total = per * (count_); \
            _Pragma("unroll 1") for (int it = F.gw; it < total; it += F.NGW) { \
                const int q = it / per, r = it - q * per, kb = r / nnb, nb = r - kb * nnb; \
                transpose_item((src_) + (size_t)q * (sstride_), (ldw_), 0, (K_), (dst_) + (size_t)q * (dstride_), (mode_), kb, nb, scr, lane); } } while (0)
        TR_MAT(INP(29), 2048, 1024, 2048, (bf16*)(ws + WS_WT_GU), 1, 128, (size_t)1024 * 2048, (size_t)2048 * 1024);
        TR_MAT(INP(31), 1024, 1024, 1024, (bf16*)(ws + WS_WT_DN), 0, 128, (size_t)1024 * 1024, (size_t)1024 * 1024);
        if (PROBE_CLS == 1) { TR_MAT(INP(29), 2048, 1024, 2048, (bf16*)(ws + WS_WT_GU), 1, 128, (size_t)1024 * 2048, (size_t)2048 * 1024);
            TR_MAT(INP(31), 1024, 1024, 1024, (bf16*)(ws + WS_WT_DN), 0, 128, (size_t)1024 * 1024, (size_t)1024 * 1024); }
        TR_MAT(INP(3), 3088, 1024, 3072, (bf16*)(ws + WS_WT_ML_IN), 0, 1, (size_t)0, (size_t)0);
        TR_MAT(INP(6), 1024, 1024, 1024, (bf16*)(ws + WS_WT_ML_OUT), 0, 1, (size_t)0, (size_t)0);
        TR_MAT(INP(7), 6144, 1024, 6144, (bf16*)(ws + WS_WT_RET_IN), 0, 1, (size_t)0, (size_t)0);
        TR_MAT(INP(9), 1024, 2048, 1024, (bf16*)(ws + WS_WT_RET_OUT), 0, 1, (size_t)0, (size_t)0);
        TR_MAT(INP(10), 3088, 1024, 3072, (bf16*)(ws + WS_WT_GLA_IN), 0, 1, (size_t)0, (size_t)0);
        TR_MAT(INP(14), 1024, 1024, 1024, (bf16*)(ws + WS_WT_GLA_OUT), 0, 1, (size_t)0, (size_t)0);
        TR_MAT(INP(15), 1024, 1024, 1024, (bf16*)(ws + WS_WT_S5_IN), 0, 1, (size_t)0, (size_t)0);
        TR_MAT(INP(24), 1024, 1024, 1024, (bf16*)(ws + WS_WT_S5_GLU), 0, 1, (size_t)0, (size_t)0);
        TR_MAT(INP(26), 1024, 1024, 1024, (bf16*)(ws + WS_WT_S5_OUT), 0, 1, (size_t)0, (size_t)0);
#undef TR_MAT
        __syncthreads();
        {
            const float* lam_re = INP(16); const float* lam_im = INP(17); const float* b_re = INP(18); const float* b_im = INP(19); const float* log_dt = INP(23);
            for (int i = blockIdx.x * NTHREADS + tid; i < 64 * 64; i += F.G * NTHREADS) {
                const int g = i >> 6;
                const float lr = lam_re[i], li = lam_im[i], dt = expf(log_dt[g]);
                const float er = expf(lr * dt); float sn, cs; sincosf(li * dt, &sn, &cs);
                const float br = er * cs, bi = er * sn;
                S5LB[2 * i] = br; S5LB[2 * i + 1] = bi;
                const float nr = br - 1.f, ni = bi, den = lr * lr + li * li;
                const float fr_ = (nr * lr + ni * li) / den, fi_ = (ni * lr - nr * li) / den;
                for (int h = 0; h < 16; ++h) { const float xr = b_re[i * 16 + h], xi = b_im[i * 16 + h];
                    S5BB[(i * 16 + h) * 2] = fr_ * xr - fi_ * xi; S5BB[(i * 16 + h) * 2 + 1] = fr_ * xi + fi_ * xr; }
            }
        }
        if (CH_S5) s5_tables(F, ws, tid, INP(16), INP(17), INP(18), INP(19), INP(20), INP(21), INP(23));
        LAS float* Wt = (LAS float*)(F.lds);
        load_cols16(tid, INP(3), 3088, 3072, Wt);
        __syncthreads();
        {
            const float* bg = INP(4);
            for (int row = F.gw; row < M; row += F.NGW) {
                asm volatile("" ::: "memory");
                f32x4 v[4]; load_row_f32(x_in + (size_t)row * D, v, lane);
                store_row_bf16(XB + (size_t)row * D, v, lane);
                float g[16]; row_dot16(v, Wt, lane, g);
                if (lane < 16) { float o = 0.f;
#pragma unroll
                    for (int e = 0; e < 16; ++e) o = (lane == e) ? g[e] : o;
                    GB[(size_t)row * 16 + lane] = o + bg[lane]; }
            }
        }
        __syncthreads();
      }
        SEAM(0);
    }

    layer_body<0>(F, ws, ctl, TAB, bar, lo, hi, args.out);
    layer_body<1>(F, ws, ctl, TAB, bar, lo, hi, args.out);
    layer_body<2>(F, ws, ctl, TAB, bar, lo, hi, args.out);
    layer_body<3>(F, ws, ctl, TAB, bar, lo, hi, args.out);
#undef IN
#undef SEAM
#undef INP
#undef x_in
#undef ln_g
#undef ln_b
}

extern "C" void kernel_launch(void* const* d_in, const int* in_sizes, int n_in, void* d_out, int out_size, void* d_ws, size_t ws_size, hipStream_t stream) {
    static int grid = 0;
    if (grid == 0) {
        if (n_in != 33 || out_size != M * D || ws_size < WS_END) { fprintf(stderr, "kernel_launch: unexpected problem (n_in %d, out %d, ws %zu < %zu)\n", n_in, out_size, ws_size, (size_t)WS_END); grid = -1; return; }
        int dev = 0, cus = 0, per_cu = 0;
        if (hipGetDevice(&dev) != hipSuccess || hipDeviceGetAttribute(&cus, hipDeviceAttributeMultiprocessorCount, dev) != hipSuccess) { grid = -1; return; }
        if (hipFuncSetAttribute((const void*)mega_fwd, hipFuncAttributeMaxDynamicSharedMemorySize, LDS_BYTES) != hipSuccess) { fprintf(stderr, "kernel_launch: hipFuncSetAttribute failed\n"); grid = -1; return; }
        if (hipOccupancyMaxActiveBlocksPerMultiprocessor(&per_cu, (const void*)mega_fwd, NTHREADS, LDS_BYTES) != hipSuccess || per_cu < 1) { fprintf(stderr, "kernel_launch: occupancy query says %d\n", per_cu); }
        (void)hipGetLastError();
        grid = cus;
    }
    if (grid < 0) return;
    hipMemsetAsync((char*)d_ws + WS_CTL, 0, CTL_ZERO_BYTES, stream);
    Args a{};
    for (int i = 0; i < 33; ++i) a.in[i] = (const float*)d_in[i];
    a.out = (float*)d_out; a.ws = (unsigned char*)d_ws;
#if N_LAUNCH_MODE == 1
    a.ph_lo = 0; a.ph_hi = 1000;
    hipLaunchKernelGGL(mega_fwd, dim3(grid), dim3(NTHREADS), LDS_BYTES, stream, a);
#else
    for (int ph = 0; ph < 65; ++ph) { a.ph_lo = ph; a.ph_hi = ph + 1; hipLaunchKernelGGL(mega_fwd, dim3(grid), dim3(NTHREADS), LDS_BYTES, stream, a); }
#endif
}
```

```cpp
#include <hip/hip_runtime.h>
#include <cstdio>
#include <cstdint>

#ifndef NAIVE_MIX
#define NAIVE_MIX 1
#endif
#ifndef CH_ML
#define CH_ML 1
#endif
#ifndef CH_RET
#define CH_RET 1
#endif
#ifndef CH_GLA
#define CH_GLA 1
#endif
#ifndef CH_S5
#define CH_S5 1
#endif
#ifndef PROBE_CLS
#define PROBE_CLS 0
#endif
#define REPS(c) ((PROBE_CLS == (c) || PROBE_CLS == 100 + layer * 10 + (c)) ? 2 : 1)
#ifndef PROBE_T
#define PROBE_T -1
#endif
#ifndef PROBE_T2
#define PROBE_T2 PROBE_T
#endif
#ifndef MOE_ALIGN
#define MOE_ALIGN true
#endif
#ifndef MOE_COUNTED
#define MOE_COUNTED 1
#endif
#ifndef N_LAUNCH_MODE
#define N_LAUNCH_MODE 1
#endif


#ifdef SKIP_ML
constexpr bool defined_SKIP_ML = true;
#else
constexpr bool defined_SKIP_ML = false;
#endif
#ifdef SKIP_RET
constexpr bool defined_SKIP_RET = true;
#else
constexpr bool defined_SKIP_RET = false;
#endif
#ifdef SKIP_GLA
constexpr bool defined_SKIP_GLA = true;
#else
constexpr bool defined_SKIP_GLA = false;
#endif
#ifdef SKIP_S5
constexpr bool defined_SKIP_S5 = true;
#else
constexpr bool defined_SKIP_S5 = false;
#endif
#ifdef SKIP_LN1
constexpr bool defined_SKIP_LN1 = true;
#else
constexpr bool defined_SKIP_LN1 = false;
#endif
#ifdef SKIP_P0
constexpr bool defined_SKIP_P0 = true;
#else
constexpr bool defined_SKIP_P0 = false;
#endif
#ifndef PHMASK
#define PHMASK 0xffff
#endif
#define PHE(b) (((PHMASK) >> (b)) & 1)
#define GAS __attribute__((address_space(1)))
#define LAS __attribute__((address_space(3)))
typedef unsigned short bf16;
typedef short bf16x8 __attribute__((ext_vector_type(8)));
typedef float f32x4 __attribute__((ext_vector_type(4)));
typedef float f32x2 __attribute__((ext_vector_type(2)));
typedef unsigned u32x4 __attribute__((ext_vector_type(4)));
typedef unsigned u32x2 __attribute__((ext_vector_type(2)));

constexpr int BATCH = 2, T = 8192, D = 1024, M = BATCH * T;
constexpr int NEXP = 32, TOPK = 4, DFF = 1024, CAP = M;
constexpr int NWAVES = 8, NTHREADS = 512;
constexpr float LN_EPS = 1e-5f;
constexpr float ALPHA = 1.681792830507429f;
constexpr int MAXTILES = (M * TOPK) / 256 + NEXP;

constexpr size_t MiB = 1u << 20;
constexpr size_t WS_CTL = 0, CTL_ZERO_BYTES = 1 * MiB;
constexpr size_t WS_WT_ML_IN = 1 * MiB;
constexpr size_t WS_WT_ML_OUT = WS_WT_ML_IN + 6 * MiB;
constexpr size_t WS_WT_RET_IN = WS_WT_ML_OUT + 2 * MiB;
constexpr size_t WS_WT_RET_OUT = WS_WT_RET_IN + 12 * MiB;
constexpr size_t WS_WT_GLA_IN = WS_WT_RET_OUT + 4 * MiB;
constexpr size_t WS_WT_GLA_OUT = WS_WT_GLA_IN + 6 * MiB;
constexpr size_t WS_WT_S5_IN = WS_WT_GLA_OUT + 2 * MiB;
constexpr size_t WS_WT_S5_GLU = WS_WT_S5_IN + 2 * MiB;
constexpr size_t WS_WT_S5_OUT = WS_WT_S5_GLU + 2 * MiB;
constexpr size_t WS_S5TAB = WS_WT_S5_OUT + 2 * MiB;
constexpr size_t WS_GB = WS_S5TAB + 1 * MiB;
constexpr size_t WS_LIST = WS_GB + 1 * MiB;
constexpr size_t WS_GW = WS_LIST + 2 * MiB;
constexpr size_t WS_WT_GU = WS_GW + 1 * MiB;
constexpr size_t WS_WT_DN = WS_WT_GU + 512 * MiB;
constexpr size_t WS_HF = WS_WT_DN + 256 * MiB;
constexpr size_t WS_XB = WS_HF + 64 * MiB;
constexpr size_t WS_ZF = WS_XB + 32 * MiB;
constexpr size_t WS_PB = WS_ZF + 64 * MiB;
constexpr size_t WS_LA = WS_PB + 192 * MiB;
constexpr size_t WS_ORAW = WS_LA + 32 * MiB;
constexpr size_t WS_YB = WS_ORAW + 128 * MiB;
constexpr size_t WS_ACT = WS_YB + 64 * MiB;
constexpr size_t WS_YS = WS_ACT + 144 * MiB;
constexpr size_t WS_XG = WS_YS + 256 * MiB;
constexpr size_t WS_UT = WS_XG + 1024 * MiB;
constexpr size_t WS_ST = WS_UT + 128 * MiB;
constexpr size_t WS_KPP = WS_ST + 64 * MiB;
constexpr size_t WS_SC = WS_KPP + 16 * MiB;
constexpr size_t WS_S5KT = WS_SC + 4 * MiB;
constexpr size_t WS_S5VT = WS_S5KT + 2 * MiB;
constexpr size_t WS_S5WT = WS_S5VT + 16 * MiB;
constexpr size_t WS_S5L64 = WS_S5WT + 16 * MiB;
constexpr size_t WS_S5SL = WS_S5L64 + 1 * MiB;
constexpr size_t WS_S5SP = WS_S5SL + 16 * MiB;
constexpr size_t WS_CS = WS_S5SP + 8 * MiB;
constexpr size_t WS_END = WS_CS + 4 * MiB;
constexpr int CW_BAR = 4096;
constexpr int CW_CNT = 16384;

constexpr int PH_BYTES = 139264;
constexpr int TAB_OFF = PH_BYTES;
constexpr int MISC_OFF = TAB_OFF + 16384;
constexpr int LDS_BYTES = 159744;

typedef __bf16 bf16x2_t __attribute__((ext_vector_type(2)));
__device__ __forceinline__ unsigned pk2(float lo, float hi) { const f32x2 v = {lo, hi}; const bf16x2_t b = __builtin_convertvector(v, bf16x2_t); return __builtin_bit_cast(unsigned, b); }
__device__ __forceinline__ unsigned f2bf(float f) { return pk2(f, 0.f) & 0xffffu; }
__device__ __forceinline__ float bf2f(unsigned short b) { return __builtin_bit_cast(float, ((unsigned)b) << 16); }
__device__ __forceinline__ float bflo(unsigned w) { return __builtin_bit_cast(float, w << 16); }
__device__ __forceinline__ float bfhi(unsigned w) { return __builtin_bit_cast(float, w & 0xffff0000u); }
__device__ __forceinline__ int lane_id() { int l; asm volatile("v_mbcnt_lo_u32_b32 %0, -1, 0\n\tv_mbcnt_hi_u32_b32 %0, -1, %0" : "=v"(l)); return l; }
template <int CTRL> __device__ __forceinline__ float dpp_f(float v) { return __builtin_bit_cast(float, __builtin_amdgcn_update_dpp(0, __builtin_bit_cast(int, v), CTRL, 0xf, 0xf, false)); }
__device__ __forceinline__ float rl_f(float v, int l) { return __builtin_bit_cast(float, __builtin_amdgcn_readlane(__builtin_bit_cast(int, v), l)); }
__device__ __forceinline__ float wave_sum(float v) {
    v += dpp_f<0xB1>(v);
    v += dpp_f<0x4E>(v);
    v += dpp_f<0x141>(v);
    v += dpp_f<0x140>(v);
    return (rl_f(v, 0) + rl_f(v, 16)) + (rl_f(v, 32) + rl_f(v, 48));
}
__device__ __forceinline__ float row16_sum(float v) { v += dpp_f<0xB1>(v); v += dpp_f<0x4E>(v); v += dpp_f<0x141>(v); v += dpp_f<0x140>(v); return v; }
__device__ __forceinline__ float wave_max(float v) {
    v = fmaxf(v, dpp_f<0xB1>(v)); v = fmaxf(v, dpp_f<0x4E>(v)); v = fmaxf(v, dpp_f<0x141>(v)); v = fmaxf(v, dpp_f<0x140>(v));
    return fmaxf(fmaxf(rl_f(v, 0), rl_f(v, 16)), fmaxf(rl_f(v, 32), rl_f(v, 48)));
}
__device__ __forceinline__ float sigmoidf_(float x) { return __builtin_amdgcn_rcpf(1.f + __expf(-x)); }
__device__ __forceinline__ float log_sigmoidf_(float x) { return fminf(x, 0.f) - __logf(1.f + __expf(-fabsf(x))); }
__device__ __forceinline__ float gelu_tanh(float x) { const float u = 0.7978845608028654f * (x + 0.044715f * x * x * x); return x * sigmoidf_(2.f * u); }

namespace pg8 {
constexpr int BM = 256, BK = 64, HALF = 128, HTB = HALF * BK * 2, STAGE_BYTES = 8 * HTB, NXCD = 8, WGM = 8;
__host__ __device__ __forceinline__ int lds_byte(int r, int c) { const int st = (r >> 4) * 2 + (c >> 5), rr = r & 15, cc = c & 31, ob = rr * 64 + cc * 2; return st * 1024 + (ob ^ (((ob >> 9) & 1) << 5)); }
__host__ __device__ __forceinline__ void stage_rc(int b, int& R, int& C) { const int st = b / 1024, sb = b % 1024, swz = sb ^ (((sb >> 9) & 1) << 5); R = (st >> 1) * 16 + swz / 64; C = (st & 1) * 32 + (swz % 64) / 2; }
__host__ __device__ __forceinline__ int perm32(int rho) { const int n = rho >> 4, i = rho & 15; return 8 * (i >> 2) + 4 * n + (i & 3); }

struct Unit { const char* A; const char* B; int pm, pn, e, nvalid, r0, buf; };

__device__ __forceinline__ int xcd_remap(int L, int nwg) { const int q = nwg / NXCD, r = nwg % NXCD, xcd = L % NXCD, off = L / NXCD; return (xcd < r ? xcd * (q + 1) : r * (q + 1) + (xcd - r) * q) + off; }

struct DenseOrder {
    const char* A; const char* Bt; int K, nM, nN, nwg, G, c; const int* list; const float* gwl; static constexpr int a_compact = 0;
    __device__ __forceinline__ void init(const void* A_, const void* Bt_, int M_, int N_, int K_, int G_, int c_) { A = (const char*)A_; Bt = (const char*)Bt_; K = K_; nM = M_ / BM; nN = N_ / BM; nwg = nM * nN; G = G_; c = c_; list = nullptr; gwl = nullptr; }
    __device__ __forceinline__ bool next(int i, Unit& u) const {
        const long L = (long)i * G + c; if (L >= nwg) return false;
        const int wgid = xcd_remap((int)L, nwg);
        const int nig = WGM * nN, gid = wgid / nig, fm = gid * WGM, gsz = (nM - fm) < WGM ? (nM - fm) : WGM;
        u.pm = fm + ((wgid % nig) % gsz); u.pn = (wgid % nig) / gsz; u.e = 0; u.nvalid = 256; u.r0 = 0;
        u.A = A + (size_t)u.pm * 256 * K * 2; u.B = Bt + (size_t)u.pn * 256 * K * 2; return true;
    }
    __device__ __forceinline__ void a_ready(const Unit&, int) const {}
};
struct MoeOrder {
    const char* A; const char* Bt; const LAS int* tab;
    int K, nN, ntiles, nwg, G, c; size_t b_estride; int a_compact; const int* list; const float* gwl;
    __device__ __forceinline__ bool next(int i, Unit& u) const {
        const long L = (long)i * G + c; if (L >= nwg) return false;
        const int wgid = xcd_remap((int)L, nwg);
        const int nig = WGM * nN, gid = wgid / nig, fm = gid * WGM, gsz = (ntiles - fm) < WGM ? (ntiles - fm) : WGM;
        const int tl = fm + ((wgid % nig) % gsz); u.pm = tl; u.pn = (wgid % nig) / gsz;
        const int e = __builtin_amdgcn_readfirstlane(tab[72 + tl]); u.e = e; const int r0 = (tl - __builtin_amdgcn_readfirstlane(tab[32 + e])) * 256; const int rem = __builtin_amdgcn_readfirstlane(tab[e]) - r0; u.nvalid = rem < 256 ? rem : 256; u.r0 = r0;
        u.A = (a_compact == 2) ? A : a_compact ? A + (size_t)tl * 256 * K * 2 : A + ((size_t)e * CAP + r0) * K * 2;
        u.B = Bt + (size_t)e * b_estride + (size_t)u.pn * 256 * K * 2; return true;
    }
    const unsigned* ready; unsigned need; unsigned* tmo;
    __device__ __forceinline__ void a_ready(const Unit& u, int wid) const {
        if (ready == nullptr) return;
        if (wid == 0) { unsigned polls = 0;
            while ((unsigned)__builtin_amdgcn_readfirstlane((int)__hip_atomic_load(ready + 64 * u.pm, __ATOMIC_RELAXED, __HIP_MEMORY_SCOPE_AGENT)) < need) {
                if (++polls > (1u << 20)) { __hip_atomic_store(tmo, 1u, __ATOMIC_RELAXED, __HIP_MEMORY_SCOPE_AGENT); break; }
                __builtin_amdgcn_s_sleep(2); }
            __builtin_amdgcn_fence(__ATOMIC_ACQUIRE, "agent");
            asm volatile("s_waitcnt vmcnt(0)" ::: "memory"); }
        asm volatile("" ::: "memory"); __builtin_amdgcn_s_barrier(); asm volatile("" ::: "memory");
    }
};

__device__ __forceinline__ unsigned cvt_pk_bf16(float lo, float hi) { unsigned r; asm volatile("v_cvt_pk_bf16_f32 %0, %1, %2" : "=v"(r) : "v"(lo), "v"(hi)); return r; }

struct EpiBf16 {
    static constexpr bool BIASTAB = false; static constexpr bool ROWINFO = false; static constexpr bool PERM = true;
    bf16* O; int ldc; const float* cs; int rot_tiles;
    __device__ __forceinline__ void operator()(const f32x4 (&acc)[2][2][4][2], const Unit& u, int wr, int wc, int fr, int fq) const {
        const int row0 = u.pm * BM + wr * 64 + fr, col0 = u.pn * BM + wc * 32 + 8 * fq;
        const bool rot = u.pn < rot_tiles; const float sc = (col0 >= 1024) ? 0.08838834764831845f : 1.f;
#pragma unroll
        for (int ai = 0; ai < 2; ++ai)
#pragma unroll
            for (int m = 0; m < 4; ++m) { const int row = row0 + ai * HALF + m * 16; bf16* rowp = O + (size_t)row * ldc + col0;
#pragma unroll
                for (int bj = 0; bj < 2; ++bj) { f32x4 v0 = acc[ai][bj][m][0], v1 = acc[ai][bj][m][1];
                    if (rot) { const float* cp = cs + ((size_t)(row & (T - 1)) * 64 + (((col0 + bj * HALF) & 127) >> 1)) * 2; const f32x4 c0 = *(const f32x4*)cp, c1 = *(const f32x4*)(cp + 4);
                        const f32x4 a0 = v0, a1 = v1;
                        v0[0] = (a0[0] * c0[0] - a0[1] * c0[1]) * sc; v0[1] = (a0[0] * c0[1] + a0[1] * c0[0]) * sc; v0[2] = (a0[2] * c0[2] - a0[3] * c0[3]) * sc; v0[3] = (a0[2] * c0[3] + a0[3] * c0[2]) * sc;
                        v1[0] = (a1[0] * c1[0] - a1[1] * c1[1]) * sc; v1[1] = (a1[0] * c1[1] + a1[1] * c1[0]) * sc; v1[2] = (a1[2] * c1[2] - a1[3] * c1[3]) * sc; v1[3] = (a1[2] * c1[3] + a1[3] * c1[2]) * sc; }
                    u32x4 w; w.x = cvt_pk_bf16(v0[0], v0[1]); w.y = cvt_pk_bf16(v0[2], v0[3]); w.z = cvt_pk_bf16(v1[0], v1[1]); w.w = cvt_pk_bf16(v1[2], v1[3]);
                    *(u32x4*)(rowp + bj * HALF) = w; } }
    }
};
struct EpiResid {
    static constexpr bool BIASTAB = false; static constexpr bool ROWINFO = false; static constexpr bool PERM = true;
    const float* __restrict__ hin; const bf16* __restrict__ hinb; bf16* __restrict__ Z;
    __device__ __forceinline__ void operator()(const f32x4 (&acc)[2][2][4][2], const Unit& u, int wr, int wc, int fr, int fq) const {
        const int row0 = u.pm * BM + wr * 64 + fr, col0 = u.pn * BM + wc * 32 + 8 * fq;
#pragma unroll
        for (int ai = 0; ai < 2; ++ai)
#pragma unroll
            for (int m = 0; m < 4; ++m) { const size_t off = (size_t)(row0 + ai * HALF + m * 16) * D + col0;
                f32x4 hv[2][2];
                if (hinb) {
#pragma unroll
                    for (int bj = 0; bj < 2; ++bj) { const u32x4 hw = *(const u32x4*)(hinb + off + bj * HALF);
                        hv[bj][0] = (f32x4){bflo(hw.x), bfhi(hw.x), bflo(hw.y), bfhi(hw.y)}; hv[bj][1] = (f32x4){bflo(hw.z), bfhi(hw.z), bflo(hw.w), bfhi(hw.w)}; }
                } else {
#pragma unroll
                    for (int bj = 0; bj < 2; ++bj)
#pragma unroll
                        for (int n = 0; n < 2; ++n) hv[bj][n] = *(const f32x4*)(hin + off + bj * HALF + n * 4);
                }
#pragma unroll
                for (int bj = 0; bj < 2; ++bj) { const f32x4 v0 = hv[bj][0] * ALPHA + acc[ai][bj][m][0], v1 = hv[bj][1] * ALPHA + acc[ai][bj][m][1];
                    u32x4 w; w.x = cvt_pk_bf16(v0[0], v0[1]); w.y = cvt_pk_bf16(v0[2], v0[3]); w.z = cvt_pk_bf16(v1[0], v1[1]); w.w = cvt_pk_bf16(v1[2], v1[3]);
                    *(u32x4*)(Z + off + bj * HALF) = w; } }
    }
};
struct EpiGlu {
    static constexpr bool BIASTAB = false; static constexpr bool ROWINFO = false; static constexpr bool PERM = true;
    const bf16* Y; const float* bias; bf16* O;
    __device__ __forceinline__ void operator()(const f32x4 (&acc)[2][2][4][2], const Unit& u, int wr, int wc, int fr, int fq) const {
        const int row0 = u.pm * BM + wr * 64 + fr, col0 = u.pn * BM + wc * 32 + 8 * fq;
#pragma unroll
        for (int ai = 0; ai < 2; ++ai)
#pragma unroll
            for (int m = 0; m < 4; ++m) { const size_t off = (size_t)(row0 + ai * HALF + m * 16) * D + col0;
#pragma unroll
                for (int bj = 0; bj < 2; ++bj) {
                    const f32x4 b0 = *(const f32x4*)(bias + col0 + bj * HALF), b1 = *(const f32x4*)(bias + col0 + bj * HALF + 4);
                    const u32x4 yw = *(const u32x4*)(Y + off + bj * HALF);
                    const f32x4 v0 = acc[ai][bj][m][0] + b0, v1 = acc[ai][bj][m][1] + b1;
                    float o[8];
                    o[0] = bflo(yw.x) * sigmoidf_(v0[0]); o[1] = bfhi(yw.x) * sigmoidf_(v0[1]); o[2] = bflo(yw.y) * sigmoidf_(v0[2]); o[3] = bfhi(yw.y) * sigmoidf_(v0[3]);
                    o[4] = bflo(yw.z) * sigmoidf_(v1[0]); o[5] = bfhi(yw.z) * sigmoidf_(v1[1]); o[6] = bflo(yw.w) * sigmoidf_(v1[2]); o[7] = bfhi(yw.w) * sigmoidf_(v1[3]);
                    u32x4 w; w.x = cvt_pk_bf16(o[0], o[1]); w.y = cvt_pk_bf16(o[2], o[3]); w.z = cvt_pk_bf16(o[4], o[5]); w.w = cvt_pk_bf16(o[6], o[7]);
                    *(u32x4*)(O + off + bj * HALF) = w; } }
    }
};
struct EpiSwiglu {
    static constexpr bool BIASTAB = true; static constexpr bool ROWINFO = false; static constexpr bool PERM = true;
    bf16* ACT; const float* bgu; const LAS float* btab; unsigned* done;
    __device__ __forceinline__ float bias_at(const Unit& u, int j) const { return bgu[(size_t)u.e * 2 * DFF + (j < HALF ? 0 : DFF) + u.pn * HALF + (j & (HALF - 1))]; }
    __device__ __forceinline__ void operator()(const f32x4 (&acc)[2][2][4][2], const Unit& u, int wr, int wc, int fr, int fq) const {
        const int row0 = u.pm * BM + wr * 64 + fr, j0 = u.pn * HALF + wc * 32 + 8 * fq;
        const LAS float* bt = btab + u.buf * 256 + wc * 32 + 8 * fq;
        const f32x4 g0 = *(const LAS f32x4*)(bt), g1 = *(const LAS f32x4*)(bt + 4), u0 = *(const LAS f32x4*)(bt + HALF), u1 = *(const LAS f32x4*)(bt + HALF + 4);
#pragma unroll
        for (int ai = 0; ai < 2; ++ai)
#pragma unroll
            for (int m = 0; m < 4; ++m) {
                float o[8];
#pragma unroll
                for (int n = 0; n < 2; ++n)
#pragma unroll
                    for (int i = 0; i < 4; ++i) {
                        float g = acc[ai][0][m][n][i] + (n ? g1[i] : g0[i]), up = acc[ai][1][m][n][i] + (n ? u1[i] : u0[i]);
                        g = fminf(g, 7.0f); up = fminf(fmaxf(up, -7.0f), 7.0f);
                        o[n * 4 + i] = (up + 1.0f) * g * sigmoidf_(1.702f * g); }
                u32x4 w; w.x = cvt_pk_bf16(o[0], o[1]); w.y = cvt_pk_bf16(o[2], o[3]); w.z = cvt_pk_bf16(o[4], o[5]); w.w = cvt_pk_bf16(o[6], o[7]);
                { bf16* p_ = ACT + (size_t)(row0 + ai * HALF + m * 16) * DFF + j0; asm volatile("global_store_dwordx4 %0, %1, off sc1\n\ts_nop 1" :: "v"(p_), "v"(w) : "memory"); } }
        asm volatile("s_waitcnt vmcnt(0)" ::: "memory");
        if (fr == 0 && fq == 0) __hip_atomic_fetch_add(done + 64 * u.pm, 1u, __ATOMIC_RELAXED, __HIP_MEMORY_SCOPE_AGENT);
    }
};
struct EpiMoeDown {
    static constexpr bool BIASTAB = true; static constexpr bool ROWINFO = true; static constexpr bool PERM = true;
    bf16* YS; const float* bd; const LAS int* rinfo; const LAS float* btab;
    __device__ __forceinline__ float bias_at(const Unit& u, int j) const { return bd[(size_t)u.e * D + u.pn * BM + j]; }
    __device__ __forceinline__ void operator()(const f32x4 (&acc)[2][2][4][2], const Unit& u, int wr, int wc, int fr, int fq) const {
        const int col0 = u.pn * BM + wc * 32 + 8 * fq;
        const LAS float* bt = btab + u.buf * 256 + wc * 32 + 8 * fq;
        f32x4 bv[2][2];
#pragma unroll
        for (int bj = 0; bj < 2; ++bj)
#pragma unroll
            for (int n = 0; n < 2; ++n) bv[bj][n] = *(const LAS f32x4*)(bt + bj * HALF + 4 * n);
        const LAS int* ri = rinfo + u.buf * 512;
#pragma unroll
        for (int ai = 0; ai < 2; ++ai)
#pragma unroll
            for (int m = 0; m < 4; ++m) { const int r = ai * HALF + wr * 64 + m * 16 + fr; const int slot = ri[r];
                if (slot >= 0) { const float gg = __builtin_bit_cast(float, ri[256 + r]); bf16* op = YS + (size_t)slot * D + col0;
#pragma unroll
                    for (int bj = 0; bj < 2; ++bj) { const f32x4 v0 = (acc[ai][bj][m][0] + bv[bj][0]) * gg, v1 = (acc[ai][bj][m][1] + bv[bj][1]) * gg;
                        u32x4 w; w.x = cvt_pk_bf16(v0[0], v0[1]); w.y = cvt_pk_bf16(v0[2], v0[3]); w.z = cvt_pk_bf16(v1[0], v1[1]); w.w = cvt_pk_bf16(v1[2], v1[3]);
                        *(u32x4*)(op + bj * HALF) = w; } } }
    }
};

template <class Epi, class Sched, bool ALIGN_EPI, bool SP2, bool GATHER = false>
__device__ __forceinline__ void gemm_phase(LAS unsigned char* lds, const int wid, const int K, const Sched& S, const Epi& E, LAS int* rowtab = nullptr) {
    const int lane = lane_id(), tid = wid * 64 + lane, wr = wid >> 2, wc = wid & 3, fr = lane & 15, fq = lane >> 4;
    const int nt = K / BK;
    unsigned voffA[2], voffB[2]; int Rr[2]; unsigned Cc2[2];
#pragma unroll
    for (int i = 0; i < 2; ++i) { int R, C; stage_rc(tid * 16 + i * 8192, R, C); const int Rb = Epi::PERM ? ((R & ~31) + perm32(R & 31)) : R;
        voffA[i] = (unsigned)(R * K + C) * 2u; voffB[i] = (unsigned)(Rb * K + C) * 2u; Rr[i] = R; Cc2[i] = (unsigned)C * 2u; }
    unsigned vA[2][2] = {{0u, 0u}, {0u, 0u}}, vN[2][2] = {{0u, 0u}, {0u, 0u}};
    const size_t kstep = (size_t)(BK * 2);
    const size_t hstep = (size_t)HALF * K * 2;
    const unsigned ldsw = (unsigned)wid * 1024u;
    const int aoff = lds_byte(wr * 64 + fr, fq * 8), boff = lds_byte(wc * 32 + fr, fq * 8);
#define PG8_SA(b, h) (((b) * 2 + (h)) * HTB)
#define PG8_SB(b, h) ((4 + (b) * 2 + (h)) * HTB)
#define PG8_STAGE(bufoff, gbase, voff) do { _Pragma("unroll") for (int _i = 0; _i < 2; ++_i) \
        __builtin_amdgcn_global_load_lds((const unsigned*)((const char*)(gbase) + (voff)[_i]), (LAS unsigned*)(lds + (bufoff) + ldsw + _i * 8192), 16, 0, 0); } while (0)
#define PG8_STAGE_A(bufoff, kbase, h, VO) do { if constexpr (GATHER) { PG8_STAGE(bufoff, kbase, (VO)[h]); } else { PG8_STAGE(bufoff, (kbase) + (h) * hstep, voffA); } } while (0)
#define PG8_FILL(buf, U) do { if (tid < 256) { const bool ok_ = tid < (U).nvalid; const int ent_ = (ok_ && (S.a_compact == 2 || Epi::ROWINFO)) ? S.list[(size_t)(U).e * CAP + (U).r0 + tid] : 0; \
        rowtab[(buf) * 256 + tid] = (S.a_compact == 2) ? (ent_ >> 2) * (K * 2) : tid * (K * 2); \
        if constexpr (Epi::ROWINFO) { rowtab[768 + (buf) * 512 + tid] = ok_ ? ent_ : -1; rowtab[768 + (buf) * 512 + 256 + tid] = ok_ ? __builtin_bit_cast(int, S.gwl[(size_t)(U).e * CAP + (U).r0 + tid]) : 0; } } \
        if constexpr (Epi::BIASTAB) { if (tid >= 256) rowtab[2304 + (buf) * 256 + (tid - 256)] = __builtin_bit_cast(int, E.bias_at((U), tid - 256)); } } while (0)
#define PG8_LOADVO(VO, buf) do { _Pragma("unroll") for (int h_ = 0; h_ < 2; ++h_) _Pragma("unroll") for (int i_ = 0; i_ < 2; ++i_) (VO)[h_][i_] = (unsigned)rowtab[(buf) * 256 + h_ * 128 + Rr[i_]] + Cc2[i_]; } while (0)
#define PG8_LDA(dst, b, h) do { _Pragma("unroll") for (int m = 0; m < 4; ++m) _Pragma("unroll") for (int k = 0; k < 2; ++k) dst[m][k] = *(const LAS bf16x8*)(lds + PG8_SA(b, h) + aoff + m * 2048 + k * 1024); } while (0)
#define PG8_LDB(dst, b, h) do { _Pragma("unroll") for (int n = 0; n < 2; ++n) _Pragma("unroll") for (int k = 0; k < 2; ++k) dst[n][k] = *(const LAS bf16x8*)(lds + PG8_SB(b, h) + boff + n * 2048 + k * 1024); } while (0)
#define PG8_MMA(ai, bj, At, Bt) do { __builtin_amdgcn_s_setprio(1); _Pragma("unroll") for (int m = 0; m < 4; ++m) _Pragma("unroll") for (int n = 0; n < 2; ++n) _Pragma("unroll") for (int k = 0; k < 2; ++k) \
        acc[ai][bj][m][n] = __builtin_amdgcn_mfma_f32_16x16x32_bf16(Bt[n][k], At[m][k], acc[ai][bj][m][n], 0, 0, 0); __builtin_amdgcn_s_setprio(0); } while (0)
#define PG8_WAIT_V(n) asm volatile("s_waitcnt vmcnt(" #n ")" ::: "memory")
#define PG8_WAIT_L(n) asm volatile("s_waitcnt lgkmcnt(" #n ")" ::: "memory")
#define PG8_BAR __builtin_amdgcn_s_barrier()
#define PG8_SCHED __builtin_amdgcn_sched_barrier(0)
#define VO_a1 vA
#define VO_cA vA
#define VO_a2 vS
#define VO_a3 vS
    Unit cur, nxt; int ui = 0;
    if (!S.next(0, cur)) return;
    f32x4 acc[2][2][4][2];
#pragma unroll
    for (int a = 0; a < 2; ++a)
#pragma unroll
        for (int b = 0; b < 2; ++b)
#pragma unroll
            for (int m = 0; m < 4; ++m)
#pragma unroll
                for (int n = 0; n < 2; ++n) acc[a][b][m][n] = (f32x4){0.f, 0.f, 0.f, 0.f};
    bf16x8 At[4][2], B0[2][2], B1[2][2];
    const char* cA = cur.A; const char* cB = cur.B;
    S.a_ready(cur, wid);
    cur.buf = 0;
    if constexpr (GATHER) { PG8_FILL(0, cur); asm volatile("s_waitcnt lgkmcnt(0)" ::: "memory"); PG8_BAR; asm volatile("" ::: "memory"); PG8_LOADVO(vA, 0); }
    if constexpr (SP2) {
        PG8_STAGE(PG8_SB(0, 0), cB, voffB); PG8_STAGE(PG8_SB(0, 1), cB + hstep, voffB); PG8_STAGE_A(PG8_SA(0, 0), cA, 0, VO_cA); PG8_STAGE_A(PG8_SA(0, 1), cA, 1, VO_cA);
        if (wr == 1) PG8_BAR;
        PG8_WAIT_V(2); PG8_BAR;
        PG8_STAGE(PG8_SB(1, 0), cB + kstep, voffB); PG8_STAGE_A(PG8_SA(1, 0), cA + kstep, 0, VO_cA); PG8_STAGE(PG8_SB(1, 1), cB + hstep + kstep, voffB);
        PG8_WAIT_V(6); PG8_BAR;
    } else {
        PG8_STAGE(PG8_SB(0, 0), cB, voffB); PG8_STAGE_A(PG8_SA(0, 0), cA, 0, VO_cA); PG8_STAGE(PG8_SB(0, 1), cB + hstep, voffB); PG8_STAGE_A(PG8_SA(0, 1), cA, 1, VO_cA);
        if (wr == 1) PG8_BAR;
        PG8_WAIT_V(4); PG8_BAR;
        PG8_STAGE(PG8_SB(1, 0), cB + kstep, voffB); PG8_STAGE_A(PG8_SA(1, 0), cA + kstep, 0, VO_cA); PG8_STAGE(PG8_SB(1, 1), cB + hstep + kstep, voffB);
        PG8_WAIT_V(6); PG8_BAR;
    }
    for (;;) {
        const bool has_next = S.next(ui + 1, nxt);
        const char* nA = has_next ? nxt.A : cA; const char* nB = has_next ? nxt.B : cB;
        nxt.buf = (ui + 1) % 3;
        if constexpr (GATHER) { if (has_next) PG8_FILL((ui + 1) % 3, nxt); }
        for (int t = 0; t < nt; t += 2) {
            const bool last = (t == nt - 2);
            const char* a1 = cA + (size_t)(t + 1) * kstep;
            const char* a2 = last ? nA : cA + (size_t)(t + 2) * kstep; const char* b2 = last ? nB : cB + (size_t)(t + 2) * kstep;
            const char* a3 = a2 + kstep; const char* b3 = b2 + kstep;
            unsigned vS[2][2];
            if (last && has_next) S.a_ready(nxt, wid);
            if constexpr (GATHER) { if (last && has_next) PG8_LOADVO(vN, (ui + 1) % 3);
#pragma unroll
                for (int h_ = 0; h_ < 2; ++h_)
#pragma unroll
                    for (int i_ = 0; i_ < 2; ++i_) vS[h_][i_] = (last && has_next) ? vN[h_][i_] : vA[h_][i_]; }
            else { vS[0][0] = 0u; vS[0][1] = 0u; vS[1][0] = 0u; vS[1][1] = 0u; }
            if constexpr (SP2) {
            PG8_LDB(B0, 0, 0); PG8_LDB(B1, 0, 1); PG8_SCHED; PG8_LDA(At, 0, 0); PG8_STAGE_A(PG8_SA(1, 1), a1, 1, VO_a1);
            PG8_WAIT_V(8); PG8_WAIT_L(0); PG8_BAR; PG8_MMA(0, 0, At, B0); PG8_MMA(0, 1, At, B1); PG8_BAR; PG8_SCHED;
            PG8_LDA(At, 0, 1); PG8_STAGE(PG8_SB(0, 0), b2, voffB); PG8_STAGE(PG8_SB(0, 1), b2 + hstep, voffB); PG8_STAGE_A(PG8_SA(0, 0), a2, 0, VO_a2);
            PG8_WAIT_V(8); PG8_WAIT_L(0); PG8_BAR; PG8_MMA(1, 0, At, B0); PG8_MMA(1, 1, At, B1); PG8_BAR; PG8_SCHED;
            PG8_LDB(B0, 1, 0); PG8_LDB(B1, 1, 1); PG8_SCHED; PG8_LDA(At, 1, 0); PG8_STAGE_A(PG8_SA(0, 1), a2, 1, VO_a2);
            PG8_WAIT_V(8); PG8_WAIT_L(0); PG8_BAR; PG8_MMA(0, 0, At, B0); PG8_MMA(0, 1, At, B1); PG8_BAR; PG8_SCHED;
            PG8_LDA(At, 1, 1); PG8_STAGE(PG8_SB(1, 0), b3, voffB); PG8_STAGE(PG8_SB(1, 1), b3 + hstep, voffB); PG8_STAGE_A(PG8_SA(1, 0), a3, 0, VO_a3);
            PG8_WAIT_V(8); PG8_WAIT_L(0); PG8_BAR; PG8_MMA(1, 0, At, B0); PG8_MMA(1, 1, At, B1); PG8_BAR; PG8_SCHED;
            } else {
            PG8_LDB(B0, 0, 0); PG8_SCHED; PG8_LDA(At, 0, 0); PG8_STAGE_A(PG8_SA(1, 1), a1, 1, VO_a1);
            PG8_WAIT_L(8); PG8_BAR; PG8_WAIT_L(0); PG8_MMA(0, 0, At, B0); PG8_BAR; PG8_SCHED;
            PG8_LDB(B1, 0, 1); PG8_STAGE(PG8_SB(0, 0), b2, voffB);
            PG8_BAR; PG8_WAIT_L(0); PG8_MMA(0, 1, At, B1); PG8_BAR;
            PG8_LDA(At, 0, 1); PG8_STAGE_A(PG8_SA(0, 0), a2, 0, VO_a2);
            PG8_BAR; PG8_WAIT_L(0); PG8_MMA(1, 0, At, B0); PG8_BAR; PG8_SCHED;
            PG8_STAGE(PG8_SB(0, 1), b2 + hstep, voffB);
            PG8_WAIT_V(6); PG8_BAR; PG8_MMA(1, 1, At, B1); PG8_BAR;
            PG8_LDB(B0, 1, 0); PG8_SCHED; PG8_LDA(At, 1, 0); PG8_STAGE_A(PG8_SA(0, 1), a2, 1, VO_a2);
            PG8_WAIT_L(8); PG8_BAR; PG8_WAIT_L(0); PG8_MMA(0, 0, At, B0); PG8_BAR; PG8_SCHED;
            PG8_LDB(B1, 1, 1); PG8_STAGE(PG8_SB(1, 0), b3, voffB);
            PG8_BAR; PG8_WAIT_L(0); PG8_MMA(0, 1, At, B1); PG8_BAR;
            PG8_LDA(At, 1, 1); PG8_STAGE_A(PG8_SA(1, 0), a3, 0, VO_a3);
            PG8_BAR; PG8_WAIT_L(0); PG8_MMA(1, 0, At, B0); PG8_BAR; PG8_SCHED;
            PG8_STAGE(PG8_SB(1, 1), b3 + hstep, voffB);
            PG8_WAIT_V(6); PG8_BAR; PG8_MMA(1, 1, At, B1); PG8_BAR;
            }
        }
        if constexpr (ALIGN_EPI) { if (wr == 0) PG8_BAR; }
        E(acc, cur, wr, wc, fr, fq);
        if (!has_next) break;
#pragma unroll
        for (int a = 0; a < 2; ++a)
#pragma unroll
            for (int b = 0; b < 2; ++b)
#pragma unroll
                for (int m = 0; m < 4; ++m)
#pragma unroll
                    for (int n = 0; n < 2; ++n) acc[a][b][m][n] = (f32x4){0.f, 0.f, 0.f, 0.f};
        cur = nxt; cA = nA; cB = nB; ++ui;
        if constexpr (GATHER) { vA[0][0] = vN[0][0]; vA[0][1] = vN[0][1]; vA[1][0] = vN[1][0]; vA[1][1] = vN[1][1]; }
        if constexpr (ALIGN_EPI) { if (wr == 1) PG8_BAR; }
    }
    PG8_WAIT_V(0);
    if constexpr (!ALIGN_EPI) { if (wr == 0) PG8_BAR; }
    PG8_BAR;
#undef PG8_SA
#undef PG8_SB
#undef PG8_STAGE
#undef PG8_STAGE_A
#undef PG8_FILL
#undef PG8_LOADVO
#undef VO_a1
#undef VO_cA
#undef VO_a2
#undef VO_a3
#undef PG8_LDA
#undef PG8_LDB
#undef PG8_MMA
#undef PG8_WAIT_V
#undef PG8_WAIT_L
#undef PG8_BAR
#undef PG8_SCHED
}
}

#define XB_TMO      128
#define XB_XCNT(j)  (256  + 64 * (j))
#define XB_XSUB(j)  (1280 + 64 * (j))
#define XB_XGEN(j)  (2304 + 64 * (j))
#define XB_TOP      3328
#define XB_TOPGEN   3392
#define XCD_BAR_WORDS 3456
#define XB_SPIN_CAP (1u << 18)
__device__ __forceinline__ unsigned xb_ld(unsigned* p)              { return __hip_atomic_load(p, __ATOMIC_RELAXED, __HIP_MEMORY_SCOPE_AGENT); }
__device__ __forceinline__ unsigned xb_add(unsigned* p, unsigned v) { return __hip_atomic_fetch_add(p, v, __ATOMIC_RELAXED, __HIP_MEMORY_SCOPE_AGENT); }
__device__ __forceinline__ unsigned xb_xcc_id() { return (unsigned)__builtin_amdgcn_s_getreg((3 << 11) | 20) & 0xFu; }
#define XB_SPIN(cond, bar) do { unsigned _sp = 0; while (cond) { __builtin_amdgcn_s_sleep(1); \
    if ((++_sp & 255u) == 0u) { if (xb_ld(&(bar)[XB_TMO])) break; if (_sp > XB_SPIN_CAP) { atomicAdd(&(bar)[XB_TMO], 1u); break; } } } } while (0)
struct XcdBarrier { unsigned* bar; unsigned x; volatile LAS unsigned* st; };
__device__ __forceinline__ XcdBarrier xcd_barrier_post(unsigned* bar, volatile LAS unsigned* st, bool leader) {
    XcdBarrier b; b.bar = bar; b.x = xb_xcc_id(); b.st = st;
    if (leader) (void)xb_add(&bar[XB_XCNT(b.x)], 1u);
    return b;
}
__device__ __forceinline__ void xcd_barrier_complete(unsigned* bar, unsigned x, unsigned& nloc, unsigned& nx) {
    const unsigned G = gridDim.x * gridDim.y * gridDim.z;
    unsigned sum, cnt, mine, sp = 0u;
    for (;;) {
        sum = 0u; cnt = 0u; mine = 0u;
#pragma unroll
        for (unsigned j = 0; j < 16; ++j) { const unsigned c = xb_ld(&bar[XB_XCNT(j)]); sum += c; cnt += (c > 0u) ? 1u : 0u; mine = (j == x) ? c : mine; }
        if (sum == G) break;
        __builtin_amdgcn_s_sleep(1);
        if ((++sp & 255u) == 0u) { if (xb_ld(&bar[XB_TMO])) break; if (sp > XB_SPIN_CAP) { atomicAdd(&bar[XB_TMO], 1u); break; } }
    }
    nloc = mine > 0u ? mine : 1u; nx = cnt > 0u ? cnt : 1u;
}
__device__ __forceinline__ void xcd_barrier(const XcdBarrier& b, int wave) {
    asm volatile("s_waitcnt vmcnt(0)" ::: "memory");
    __syncthreads();
    if (wave == 0 && lane_id() == 0) {
        unsigned* bar = b.bar;
        __builtin_amdgcn_s_waitcnt(0);
        unsigned nloc = b.st[0], nx = b.st[1];
        if (nloc == 0u) { xcd_barrier_complete(bar, b.x, nloc, nx); b.st[0] = nloc; b.st[1] = nx; }
        const unsigned old = xb_add(&bar[XB_XSUB(b.x)], 1u);
        const unsigned gen = old / nloc;
        if (old + 1u == (gen + 1u) * nloc) {
            __builtin_amdgcn_fence(__ATOMIC_RELEASE, "agent");
            asm volatile("s_waitcnt vmcnt(0)" ::: "memory");
            const unsigned og = xb_add(&bar[XB_TOP], 1u);
            const unsigned tg = og / nx;
            if (og + 1u == (tg + 1u) * nx) xb_add(&bar[XB_TOPGEN], 1u);
            else XB_SPIN(xb_ld(&bar[XB_TOPGEN]) == tg, bar);
            __builtin_amdgcn_fence(__ATOMIC_ACQUIRE, "agent");
            xb_add(&bar[XB_XGEN(b.x)], 1u);
            asm volatile("s_waitcnt vmcnt(0)" ::: "memory");
        } else {
            XB_SPIN(xb_ld(&bar[XB_XGEN(b.x)]) == gen, bar);
            __builtin_amdgcn_fence(__ATOMIC_ACQUIRE, "agent");
            asm volatile("s_waitcnt vmcnt(0)" ::: "memory");
        }
    }
    __syncthreads();
}

struct Args { const float* in[33]; float* out; unsigned char* ws; int ph_lo, ph_hi; };
struct Frame {
    LAS unsigned char* lds;
    int wave, vcu, G, gw, NGW;
};

__device__ __forceinline__ void transpose_item(const float* W, int ldw, int col_off, int K, bf16* WT, int mode, int kb, int nb, LAS unsigned char* scr, int lane) {
    const int k0 = 64 * kb, n0 = 64 * nb;
    const float* src = W + (size_t)k0 * ldw + col_off + n0;
    f32x4 v[16];
#pragma unroll
    for (int i = 0; i < 16; ++i) v[i] = __builtin_nontemporal_load((const f32x4*)(src + (size_t)((lane >> 4) + 4 * i) * ldw + 4 * (lane & 15)));
#pragma unroll
    for (int i = 0; i < 16; ++i) { LAS unsigned* p = (LAS unsigned*)(scr + ((lane >> 4) + 4 * i) * 132 + 8 * (lane & 15)); p[0] = pk2(v[i][0], v[i][1]); p[1] = pk2(v[i][2], v[i][3]); }
    asm volatile("s_waitcnt lgkmcnt(0)" ::: "memory");
    const int c = lane >> 3, nl = lane & 7;
#pragma unroll
    for (int r = 0; r < 8; ++r) { const int n = nl + 8 * r; const LAS unsigned short* s = (const LAS unsigned short*)(scr + (8 * c) * 132 + 2 * n);
        u32x4 o; o.x = (unsigned)s[0] | ((unsigned)s[66] << 16); o.y = (unsigned)s[132] | ((unsigned)s[198] << 16); o.z = (unsigned)s[264] | ((unsigned)s[330] << 16); o.w = (unsigned)s[396] | ((unsigned)s[462] << 16);
        const int ng = n0 + n; int drow = ng; if (mode == 1) { drow = ng < 1024 ? 256 * (ng >> 7) + (ng & 127) : 256 * ((ng - 1024) >> 7) + 128 + (ng & 127); }
        if (mode == 2 && ng < 2048) { const int i_ = ng & 127; drow = (ng & ~127) + (i_ < 64 ? 2 * i_ : 2 * (i_ - 64) + 1); }
        __builtin_nontemporal_store(o, (u32x4*)(WT + (size_t)drow * K + k0 + 8 * c)); }
    asm volatile("s_waitcnt lgkmcnt(0)" ::: "memory");
}

__device__ __forceinline__ void load_cols16(int tid, const float* W, int ldw, int col_off, LAS float* Wt) {
    f32x4 wv[8];
#pragma unroll
    for (int i = 0; i < 8; ++i) { const int q = tid + i * NTHREADS, k = q >> 2, e0 = (q & 3) * 4; wv[i] = *(const f32x4*)(W + (size_t)k * ldw + col_off + e0); }
#pragma unroll
    for (int i = 0; i < 8; ++i) { const int q = tid + i * NTHREADS, k = q >> 2, e0 = (q & 3) * 4;
        Wt[(e0 + 0) * 1028 + k] = wv[i][0]; Wt[(e0 + 1) * 1028 + k] = wv[i][1]; Wt[(e0 + 2) * 1028 + k] = wv[i][2]; Wt[(e0 + 3) * 1028 + k] = wv[i][3]; }
}
__device__ __forceinline__ float row_dot16(const f32x4 (&v)[4], const LAS float* Wt, int lane) {
    float p[16];
#pragma unroll
    for (int e = 0; e < 16; ++e) { float s = 0.f;
#pragma unroll
        for (int j = 0; j < 4; ++j) { const f32x4 w = *(const LAS f32x4*)(Wt + e * 1028 + 4 * (lane + 64 * j)); s += v[j][0] * w[0] + v[j][1] * w[1] + v[j][2] * w[2] + v[j][3] * w[3]; }
        p[e] = s; }
    float a8[8], a4[4], a2[2], r1;
#pragma unroll
    for (int e = 0; e < 8; ++e) { const auto r = __builtin_amdgcn_permlane32_swap(__builtin_bit_cast(unsigned, p[e]), __builtin_bit_cast(unsigned, p[e + 8]), false, false); a8[e] = __builtin_bit_cast(float, (unsigned)r[0]) + __builtin_bit_cast(float, (unsigned)r[1]); }
#pragma unroll
    for (int e = 0; e < 4; ++e) { const auto r = __builtin_amdgcn_permlane16_swap(__builtin_bit_cast(unsigned, a8[e]), __builtin_bit_cast(unsigned, a8[e + 4]), false, false); a4[e] = __builtin_bit_cast(float, (unsigned)r[0]) + __builtin_bit_cast(float, (unsigned)r[1]); }
    { const bool hi = (lane & 8) != 0;
#pragma unroll
      for (int e = 0; e < 2; ++e) { const float mine = hi ? a4[e + 2] : a4[e], theirs = hi ? a4[e] : a4[e + 2]; a2[e] = mine + dpp_f<0x128>(theirs); } }
    { const bool hi = (lane & 4) != 0; const float mine = hi ? a2[1] : a2[0], theirs = hi ? a2[0] : a2[1]; r1 = mine + dpp_f<0x141>(theirs); }
    r1 += dpp_f<0x4E>(r1); r1 += dpp_f<0xB1>(r1);
    return r1;
}
__device__ __forceinline__ void store_row_bf16(bf16* orow, const f32x4 (&v)[4], int lane) {
    unsigned long long* o8 = (unsigned long long*)orow + lane;
#pragma unroll
    for (int j = 0; j < 4; ++j) o8[64 * j] = (unsigned long long)pk2(v[j][0], v[j][1]) | ((unsigned long long)pk2(v[j][2], v[j][3]) << 32);
}
__device__ __forceinline__ void store_row_f32(float* orow, const f32x4 (&v)[4], int lane) {
    f32x4* o = (f32x4*)orow + lane;
#pragma unroll
    for (int j = 0; j < 4; ++j) o[64 * j] = v[j];
}
__device__ __forceinline__ void load_row_f32(const float* row, f32x4 (&v)[4], int lane) {
    const f32x4* p = (const f32x4*)row + lane;
#pragma unroll
    for (int j = 0; j < 4; ++j) v[j] = p[64 * j];
}
__device__ __forceinline__ void ln_row(f32x4 (&v)[4], const f32x4 (&gv)[4], const f32x4 (&bv)[4]) {
    float s = 0.f;
#pragma unroll
    for (int j = 0; j < 4; ++j) s += (v[j][0] + v[j][1]) + (v[j][2] + v[j][3]);
    const float mean = wave_sum(s) * (1.f / D); float s2 = 0.f;
#pragma unroll
    for (int j = 0; j < 4; ++j) { v[j] = v[j] - mean; s2 += (v[j][0] * v[j][0] + v[j][1] * v[j][1]) + (v[j][2] * v[j][2] + v[j][3] * v[j][3]); }
    const float rstd = __builtin_amdgcn_rsqf(wave_sum(s2) * (1.f / D) + LN_EPS);
#pragma unroll
    for (int j = 0; j < 4; ++j) v[j] = v[j] * rstd * gv[j] + bv[j];
}

__device__ __forceinline__ const float* inp_ptr(LAS unsigned char* lds, int i) {
    const LAS unsigned* p = (const LAS unsigned*)(lds + MISC_OFF + 256) + 2 * i;
    const unsigned lo = __builtin_amdgcn_readfirstlane(p[0]), hi = __builtin_amdgcn_readfirstlane(p[1]);
    return (const float*)(const GAS float*)(((unsigned long long)hi << 32) | lo);
}

__device__ __forceinline__ void stamp_fn(LAS unsigned char* lds, int wave, int k) {
    if (blockIdx.x == 0 && wave == 0 && lane_id() == 0) { volatile LAS unsigned long long* st = (volatile LAS unsigned long long*)(lds + MISC_OFF + 1024);
        const unsigned long long now = __builtin_amdgcn_s_memrealtime(); if (k >= PROBE_T && k <= PROBE_T2) st[1] = st[1] + (now - st[0]); st[0] = now; }
}
typedef short s16x4 __attribute__((ext_vector_type(4)));
typedef short v4i16_t __attribute__((ext_vector_type(4)));
constexpr int CL = 128, NCH = T / CL;
template <int MODE> struct MX;
template <> struct MX<0> { static constexpr int NH = 8, DK = 64,  DV = 128, LDP = 3072, KOFF = 512,  VOFF = 1024, GOFF = 2048; };
template <> struct MX<1> { static constexpr int NH = 8, DK = 128, DV = 256, LDP = 6144, KOFF = 1024, VOFF = 2048, GOFF = 4096; };
template <> struct MX<2> { static constexpr int NH = 4, DK = 128, DV = 256, LDP = 3072, KOFF = 512,  VOFF = 1024, GOFF = 2048; };
__device__ __forceinline__ s16x4 ds_tr(const LAS unsigned char* p) { return __builtin_bit_cast(s16x4, __builtin_amdgcn_ds_read_tr16_b64_v4i16((LAS v4i16_t*)p)); }
__device__ __forceinline__ bf16x8 tr_frag(const LAS unsigned char* base, int pitch, int k0, int n0, int lane) {
    const int g = lane >> 4, q = (lane & 15) >> 2, p = lane & 3;
    const LAS unsigned char* a = base + (k0 + 4 * g + q) * pitch + (n0 + 4 * p) * 2;
    const s16x4 r1 = ds_tr(a), r2 = ds_tr(a + 16 * pitch);
    bf16x8 f; f[0] = r1[0]; f[1] = r1[1]; f[2] = r1[2]; f[3] = r1[3]; f[4] = r2[0]; f[5] = r2[1]; f[6] = r2[2]; f[7] = r2[3]; return f;
}
__device__ __forceinline__ u32x4 scale_bf16x8(u32x4 v, float sc) {
    u32x4 o; o.x = pk2(bflo(v.x) * sc, bfhi(v.x) * sc); o.y = pk2(bflo(v.y) * sc, bfhi(v.y) * sc); o.z = pk2(bflo(v.z) * sc, bfhi(v.z) * sc); o.w = pk2(bflo(v.w) * sc, bfhi(v.w) * sc); return o;
}
__device__ __forceinline__ float ret_lg2gamma(int h) { return log2f(1.f - exp2f(-5.f - (float)h)); }

template <int MODE>
__device__ __forceinline__ void mix_phaseA(const Frame& F, unsigned char* ws, const int tid, const int lane) {
    typedef MX<MODE> C; constexpr int DK = C::DK, DV = C::DV, NH = C::NH, LDP = C::LDP, KP = DK * 2 + 32, VP = DV * 2 + 32, ETW = DV / 128, NDT = DK / 16;
    LAS unsigned char* ldsK = F.lds; LAS unsigned char* ldsV = F.lds + 128 * KP; LAS float* rsc = (LAS float*)(F.lds + 128 * KP + 128 * VP);
    const bf16* PB = (const bf16*)(ws + WS_PB); const bf16* KPP = (const bf16*)(ws + WS_KPP); bf16* UT = (bf16*)(ws + WS_UT);
    const float* GSC = (const float*)(ws + WS_SC); float* NLOC = (float*)(ws + WS_SC + 2 * MiB);
    const int w = F.wave, g = lane >> 4;
    for (int u = blockIdx.x; u < 2 * NH * NCH; u += F.G) {
        const int c = u % NCH, bh = u / NCH, h = bh % NH, b = bh / NH; const size_t row0 = (size_t)b * T + (size_t)c * CL;
        u32x4 kr[DK / 32], vr[DV / 32];
#pragma unroll
        for (int i = 0; i < DK / 32; ++i) { const int p = tid + i * NTHREADS, r = p / (DK / 8), cp = p % (DK / 8);
            kr[i] = (MODE == 2) ? *(const u32x4*)(KPP + (row0 + r) * 512 + h * 128 + cp * 8) : *(const u32x4*)(PB + (row0 + r) * LDP + C::KOFF + h * DK + cp * 8); }
#pragma unroll
        for (int i = 0; i < DV / 32; ++i) { const int p = tid + i * NTHREADS, r = p / (DV / 8), cp = p % (DV / 8);
            vr[i] = *(const u32x4*)(PB + (row0 + r) * LDP + C::VOFF + h * DV + cp * 8); }
        float gmax = 0.f; if (MODE == 0) gmax = GSC[(size_t)(2 * 16 + bh) * T + c * CL + 127];
        const float lgh = (MODE == 1) ? ret_lg2gamma(h) : 0.f;
        __syncthreads();
#pragma unroll
        for (int i = 0; i < DK / 32; ++i) { const int p = tid + i * NTHREADS, r = p / (DK / 8), cp = p % (DK / 8);
            u32x4 v = kr[i];
            if (MODE == 0) v = scale_bf16x8(v, __expf(GSC[(size_t)(1 * 16 + bh) * T + c * CL + r] - gmax));
            if (MODE == 1) v = scale_bf16x8(v, exp2f((float)(127 - r) * lgh));
            *(LAS u32x4*)(ldsK + r * KP + cp * 16) = v; }
#pragma unroll
        for (int i = 0; i < DV / 32; ++i) { const int p = tid + i * NTHREADS, r = p / (DV / 8), cp = p % (DV / 8); *(LAS u32x4*)(ldsV + r * VP + cp * 16) = vr[i]; }
        __syncthreads();
        f32x4 acc[ETW][NDT];
#pragma unroll
        for (int i = 0; i < ETW; ++i)
#pragma unroll
            for (int j = 0; j < NDT; ++j) acc[i][j] = (f32x4){0.f, 0.f, 0.f, 0.f};
#pragma unroll
        for (int ks = 0; ks < 4; ++ks) {
            bf16x8 af[ETW], bfv[NDT];
#pragma unroll
            for (int i = 0; i < ETW; ++i) af[i] = tr_frag(ldsV, VP, 32 * ks, (w * ETW + i) * 16, lane);
#pragma unroll
            for (int j = 0; j < NDT; ++j) bfv[j] = tr_frag(ldsK, KP, 32 * ks, j * 16, lane);
#pragma unroll
            for (int i = 0; i < ETW; ++i)
#pragma unroll
                for (int j = 0; j < NDT; ++j) acc[i][j] = __builtin_amdgcn_mfma_f32_16x16x32_bf16(af[i], bfv[j], acc[i][j], 0, 0, 0);
        }
        bf16* ut = UT + (size_t)u * DV * DK;
#pragma unroll
        for (int i = 0; i < ETW; ++i)
#pragma unroll
            for (int j = 0; j < NDT; ++j)
#pragma unroll
                for (int r = 0; r < 4; ++r) ut[(size_t)((w * ETW + i) * 16 + 4 * g + r) * DK + j * 16 + (lane & 15)] = (bf16)f2bf(acc[i][j][r]);
        if (MODE == 0) {
            float sacc = 0.f;
#pragma unroll
            for (int r = 0; r < 16; ++r) sacc += bf2f(*(const LAS unsigned short*)(ldsK + (16 * w + r) * KP + lane * 2));
            rsc[w * 64 + lane] = sacc;
            __syncthreads();
            if (tid < 64) { float t = 0.f;
#pragma unroll
                for (int q = 0; q < NWAVES; ++q) t += rsc[q * 64 + tid];
                NLOC[(size_t)u * 64 + tid] = t; } }
    }
    __syncthreads();
}

template <int MODE>
__device__ __forceinline__ void mix_phaseB(const Frame& F, unsigned char* ws, const int tid) {
    typedef MX<MODE> C; constexpr int DK = C::DK, DV = C::DV, NH = C::NH, NEL = DV * DK, NBH = 2 * NH;
    const bf16* UT = (const bf16*)(ws + WS_UT); bf16* ST = (bf16*)(ws + WS_ST);
    const float* GSC = (const float*)(ws + WS_SC); const float* NLOC = (const float*)(ws + WS_SC + 2 * MiB); float* NPREV = (float*)(ws + WS_SC + 2 * MiB + 256 * 1024);
    float* MPREV = (float*)(ws + WS_SC + 2 * MiB + 512 * 1024); const float* DEC = (const float*)(ws + WS_SC + 3 * MiB);
    const int gtid = blockIdx.x * NTHREADS + tid, nthr = F.G * NTHREADS;
    for (int el8 = gtid; el8 < NBH * NEL / 8; el8 += nthr) {
        const int el = el8 * 8, bh = el / NEL, idx = el - bh * NEL, h = bh % NH, b = bh / NH;
        float S[8]; float m = -1e30f;
#pragma unroll
        for (int q = 0; q < 8; ++q) S[q] = 0.f;
        const float rdec = (MODE == 1) ? exp2f(128.f * ret_lg2gamma(h)) : 1.f;
#pragma unroll 1
        for (int c0 = 0; c0 < NCH; c0 += 8) {
            u32x4 uv[8];
#pragma unroll
            for (int i = 0; i < 8; ++i) uv[i] = *(const u32x4*)(UT + (size_t)(bh * NCH + c0 + i) * NEL + idx);
#pragma unroll
            for (int i = 0; i < 8; ++i) { const int c = c0 + i; const size_t u = (size_t)bh * NCH + c;
                u32x4 o; o.x = pk2(S[0], S[1]); o.y = pk2(S[2], S[3]); o.z = pk2(S[4], S[5]); o.w = pk2(S[6], S[7]);
                *(u32x4*)(ST + u * NEL + idx) = o;
                const float u0 = bflo(uv[i].x), u1 = bfhi(uv[i].x), u2 = bflo(uv[i].y), u3 = bfhi(uv[i].y), u4 = bflo(uv[i].z), u5 = bfhi(uv[i].z), u6 = bflo(uv[i].w), u7 = bfhi(uv[i].w);
                if (MODE == 0) { const float atot = GSC[(size_t)(0 * 16 + bh) * T + c * CL + 127], mloc = atot + GSC[(size_t)(2 * 16 + bh) * T + c * CL + 127];
                    const float mnew = fmaxf(atot + m, mloc), so = __expf(atot + m - mnew), sl = __expf(mloc - mnew);
                    if (idx == 0) MPREV[u] = m;
                    S[0] = so * S[0] + sl * u0; S[1] = so * S[1] + sl * u1; S[2] = so * S[2] + sl * u2; S[3] = so * S[3] + sl * u3;
                    S[4] = so * S[4] + sl * u4; S[5] = so * S[5] + sl * u5; S[6] = so * S[6] + sl * u6; S[7] = so * S[7] + sl * u7; m = mnew; }
                else if (MODE == 1) { S[0] = rdec * S[0] + u0; S[1] = rdec * S[1] + u1; S[2] = rdec * S[2] + u2; S[3] = rdec * S[3] + u3; S[4] = rdec * S[4] + u4; S[5] = rdec * S[5] + u5; S[6] = rdec * S[6] + u6; S[7] = rdec * S[7] + u7; }
                else { const float* dp = DEC + (size_t)(b * NCH + c) * 512 + h * 128 + (idx & 127); const f32x4 d0 = *(const f32x4*)dp, d1 = *(const f32x4*)(dp + 4);
                    S[0] = d0[0] * S[0] + u0; S[1] = d0[1] * S[1] + u1; S[2] = d0[2] * S[2] + u2; S[3] = d0[3] * S[3] + u3; S[4] = d1[0] * S[4] + u4; S[5] = d1[1] * S[5] + u5; S[6] = d1[2] * S[6] + u6; S[7] = d1[3] * S[7] + u7; } }
        }
    }
    if (MODE == 0) {
        for (int el = gtid; el < NBH * 64; el += nthr) { const int bh = el >> 6, d = el & 63; float S = 0.f, m = -1e30f;
#pragma unroll 1
            for (int c0 = 0; c0 < NCH; c0 += 8) { float at[8], gm[8], nl[8];
#pragma unroll
                for (int i = 0; i < 8; ++i) { const int c = c0 + i; at[i] = GSC[(size_t)(0 * 16 + bh) * T + c * CL + 127]; gm[i] = GSC[(size_t)(2 * 16 + bh) * T + c * CL + 127]; nl[i] = NLOC[((size_t)bh * NCH + c) * 64 + d]; }
#pragma unroll
                for (int i = 0; i < 8; ++i) { const size_t u = (size_t)bh * NCH + c0 + i; const float atot = at[i], mloc = atot + gm[i];
                    const float mnew = fmaxf(atot + m, mloc), so = __expf(atot + m - mnew), sl = __expf(mloc - mnew);
                    NPREV[u * 64 + d] = S; S = so * S + sl * nl[i]; m = mnew; } } }
    }
}

template <int MODE>
__device__ __forceinline__ void mix_phaseC(const Frame& F, unsigned char* ws, const int tid, const int lane, const float* ng) {
    typedef MX<MODE> C; constexpr int DK = C::DK, DV = C::DV, NH = C::NH, LDP = C::LDP, VP = DV * 2 + 32, KP = DK * 2 + 16, SP = DK * 2 + 16, NET = DV / 16, NKS = DK / 32, DVT = NH * DV;
    constexpr int NSP = DV * DK / 8 / NTHREADS;
    LAS unsigned char* ldsV = F.lds; LAS unsigned char* ldsK = F.lds + 128 * VP; LAS unsigned char* ldsS = F.lds;
    LAS float* tabs = (LAS float*)(F.lds + 128 * VP + 128 * KP);
    static_assert(DV * SP <= 128 * VP + 128 * KP, "S^T image fits the stage-1 region");
    const bf16* PB = (const bf16*)(ws + WS_PB); const bf16* ST = (const bf16*)(ws + WS_ST);
    const float* GSC = (const float*)(ws + WS_SC); const float* NPREV = (const float*)(ws + WS_SC + 2 * MiB + 256 * 1024); const float* MPREV = (const float*)(ws + WS_SC + 2 * MiB + 512 * 1024);
    const int w = F.wave, g = lane >> 4, li = lane & 15;
    constexpr int NU = 2 * NH * NCH;
    u32x4 kr[DK / 32], vr[DV / 32], sreg[NSP];
#define PC_LOAD_KV(U_) do { const int c_ = (U_) % NCH, bh_ = (U_) / NCH, h_ = bh_ % NH, b_ = bh_ / NH; const char* pb_ = (const char*)(PB + ((size_t)b_ * T + (size_t)c_ * CL) * LDP); \
        const char* vb_ = pb_ + (C::VOFF + h_ * DV) * 2; const char* kb_ = pb_ + (C::KOFF + h_ * DK) * 2; int t_ = tid; asm volatile("" : "+v"(t_));     \
        _Pragma("unroll") for (int i = 0; i < DV / 32; ++i) { const int p = t_ + i * NTHREADS, r = p / (DV / 8), cp = p % (DV / 8); vr[i] = *(const u32x4*)(vb_ + (unsigned)(r * LDP + cp * 8) * 2u); } \
        _Pragma("unroll") for (int i = 0; i < DK / 32; ++i) { const int p = t_ + i * NTHREADS, r = p / (DK / 8), cp = p % (DK / 8); kr[i] = *(const u32x4*)(kb_ + (unsigned)(r * LDP + cp * 8) * 2u); } } while (0)
#define PC_LOAD_S(U_) do { const bf16* st_ = ST + (size_t)(U_) * DV * DK; _Pragma("unroll") for (int i = 0; i < NSP; ++i) sreg[i] = *(const u32x4*)(st_ + (size_t)(tid + i * NTHREADS) * 8); } while (0)
    if ((int)blockIdx.x < NU) { PC_LOAD_KV((int)blockIdx.x); }
    for (int u = blockIdx.x; u < NU; u += F.G) {
        const int c = u % NCH, bh = u / NCH, h = bh % NH, b = bh / NH; const size_t row0 = (size_t)b * T + (size_t)c * CL;
        const float lg = (MODE == 1) ? ret_lg2gamma(h) : 0.f;
        PC_LOAD_S(u);
        __syncthreads();
#pragma unroll
        for (int i = 0; i < DV / 32; ++i) { const int p = tid + i * NTHREADS, r = p / (DV / 8), cp = p % (DV / 8); *(LAS u32x4*)(ldsV + r * VP + cp * 16) = vr[i]; }
#pragma unroll
        for (int i = 0; i < DK / 32; ++i) { const int p = tid + i * NTHREADS, r = p / (DK / 8), cp = p % (DK / 8); *(LAS u32x4*)(ldsK + r * KP + cp * 16) = kr[i]; }
        if (u + F.G < NU) PC_LOAD_KV(u + F.G);
        if (MODE == 0 && tid < 128) { const float mp = MPREV[u]; const size_t gi = (size_t)bh * T + c * CL + tid;
            const float a = GSC[(size_t)(0 * 16) * T + gi], gg = GSC[(size_t)(1 * 16) * T + gi], cm = GSC[(size_t)(2 * 16) * T + gi];
            const float Mt = fmaxf(mp, cm);
            tabs[tid] = gg; tabs[128 + tid] = Mt; tabs[256 + tid] = __expf(mp - Mt) * 0.125f; tabs[384 + tid] = __expf(-(a + Mt)); }
        __syncthreads();
        const int tq = 16 * w + li;
        const bf16* qrow = PB + (row0 + tq) * LDP + h * DK;
        bf16x8 qf[NKS];
#pragma unroll
        for (int ks = 0; ks < NKS; ++ks) qf[ks] = *(const bf16x8*)(qrow + 32 * ks + 8 * g);
        f32x4 O[NET];
#pragma unroll
        for (int et = 0; et < NET; ++et) O[et] = (f32x4){0.f, 0.f, 0.f, 0.f};
        float den = 0.f;
        const float Mq = (MODE == 0) ? tabs[128 + tq] : 0.f;
        const float qs = (MODE == 0) ? tabs[256 + tq] : (MODE == 1) ? exp2f((float)(tq + 1) * lg) : 1.f;
        const float fin = (MODE == 0) ? tabs[384 + tq] : 1.f;
        for (int jp = 0; jp <= (w >> 1); ++jp) {
            f32x4 p0 = (f32x4){0.f, 0.f, 0.f, 0.f}, p1 = (f32x4){0.f, 0.f, 0.f, 0.f};
            const LAS unsigned char* k0p = ldsK + (32 * jp + li) * KP + 16 * g;
#pragma unroll
            for (int ks = 0; ks < NKS; ++ks) p0 = __builtin_amdgcn_mfma_f32_16x16x32_bf16(*(const LAS bf16x8*)(k0p + 64 * ks), qf[ks], p0, 0, 0, 0);
            if (2 * jp + 1 <= w) {
#pragma unroll
                for (int ks = 0; ks < NKS; ++ks) p1 = __builtin_amdgcn_mfma_f32_16x16x32_bf16(*(const LAS bf16x8*)(k0p + 16 * KP + 64 * ks), qf[ks], p1, 0, 0, 0);
            }
#pragma unroll
            for (int r = 0; r < 4; ++r) {
                const int s0 = 32 * jp + 4 * g + r, s1 = s0 + 16;
                float f0, f1;
                if (MODE == 0) { f0 = __expf(tabs[s0] - Mq) * 0.125f; f1 = __expf(tabs[s1] - Mq) * 0.125f; }
                else if (MODE == 1) { f0 = exp2f((float)(tq - s0) * lg); f1 = exp2f((float)(tq - s1) * lg); }
                else { f0 = 1.f; f1 = 1.f; }
                p0[r] = (s0 <= tq) ? p0[r] * f0 : 0.f; p1[r] = (s1 <= tq) ? p1[r] * f1 : 0.f;
                den += p0[r] + p1[r];
            }
            bf16x8 af; { const unsigned a0 = pk2(p0[0], p0[1]), a1 = pk2(p0[2], p0[3]), a2 = pk2(p1[0], p1[1]), a3 = pk2(p1[2], p1[3]); u32x4 t4; t4.x = a0; t4.y = a1; t4.z = a2; t4.w = a3; af = __builtin_bit_cast(bf16x8, t4); }
#pragma unroll
            for (int et = 0; et < NET; ++et) O[et] = __builtin_amdgcn_mfma_f32_16x16x32_bf16(af, tr_frag(ldsV, VP, 32 * jp, 16 * et, lane), O[et], 0, 0, 0);
        }
        __syncthreads();
#pragma unroll
        for (int i = 0; i < NSP; ++i) { const int p = tid + i * NTHREADS, e = p / (DK / 8), cp = p % (DK / 8); *(LAS u32x4*)(ldsS + e * SP + cp * 16) = sreg[i]; }
        __syncthreads();
        float dint = 0.f;
#pragma unroll
        for (int ks = 0; ks < NKS; ++ks) {
            bf16x8 aq = qf[ks];
            if (MODE != 2) aq = __builtin_bit_cast(bf16x8, scale_bf16x8(__builtin_bit_cast(u32x4, qf[ks]), qs));
            if (MODE == 0) { const float* np = NPREV + (size_t)u * 64 + 32 * ks + 8 * g; const u32x4 qa = __builtin_bit_cast(u32x4, aq);
                dint += bflo(qa.x) * np[0] + bfhi(qa.x) * np[1] + bflo(qa.y) * np[2] + bfhi(qa.y) * np[3] + bflo(qa.z) * np[4] + bfhi(qa.z) * np[5] + bflo(qa.w) * np[6] + bfhi(qa.w) * np[7]; }
#pragma unroll
            for (int et = 0; et < NET; ++et) O[et] = __builtin_amdgcn_mfma_f32_16x16x32_bf16(aq, *(const LAS bf16x8*)(ldsS + (16 * et + li) * SP + 64 * ks + 16 * g), O[et], 0, 0, 0);
        }
        float rd[4] = {1.f, 1.f, 1.f, 1.f};
        if (MODE == 0) {
            float dt = den + dint; dt += __shfl_xor(dt, 16); dt += __shfl_xor(dt, 32);
            LAS float* wsc = tabs + 512 + 16 * w;
            if (g == 0) wsc[li] = __builtin_amdgcn_rcpf(fmaxf(fabsf(dt), fin));
            asm volatile("s_waitcnt lgkmcnt(0)" ::: "memory");
#pragma unroll
            for (int r = 0; r < 4; ++r) rd[r] = wsc[4 * g + r];
        }
        float mean[4], rstd[4];
#pragma unroll
        for (int r = 0; r < 4; ++r) { float sacc = 0.f;
#pragma unroll
            for (int et = 0; et < NET; ++et) { O[et][r] *= rd[r]; sacc += O[et][r]; }
            sacc = row16_sum(sacc);
            mean[r] = sacc * (1.f / DV); float q = 0.f;
#pragma unroll
            for (int et = 0; et < NET; ++et) { const float dlt = O[et][r] - mean[r]; q += dlt * dlt; }
            q = row16_sum(q);
            rstd[r] = __builtin_amdgcn_rsqf(q * (1.f / DV) + LN_EPS); }
        bf16* YBp = (bf16*)(ws + WS_YB);
        const bf16* gp[4]; bf16* yp[4];
#pragma unroll
        for (int r = 0; r < 4; ++r) { const size_t row = row0 + 16 * w + 4 * g + r; gp[r] = PB + row * LDP + C::GOFF + h * DV + li; yp[r] = YBp + row * DVT + h * DV + li;
            asm volatile("" : "+v"(gp[r]), "+v"(yp[r])); }
        const float* ngp = ng + h * DV + li;
#pragma unroll
        for (int et = 0; et < NET; ++et) { const float gn = ngp[16 * et];
#pragma unroll
            for (int r = 0; r < 4; ++r) {
                const float gt = bf2f(gp[r][16 * et]);
                const float gate = (MODE == 0) ? sigmoidf_(gt) : gt * sigmoidf_(gt);
                yp[r][16 * et] = (bf16)f2bf(gate * (O[et][r] - mean[r]) * rstd[r] * gn); }
            if ((et & 3) == 3) asm volatile("" ::: "memory"); }
    }
    __syncthreads();
#undef PC_LOAD_KV
#undef PC_LOAD_S
}

constexpr int SLN = 32, NCI = T / SLN, NI = 2 * NCI, NRT = NI / 16, SKK = SLN * 16;
__device__ __forceinline__ void s5_pow(const f32x4 cf, float n, float& pr, float& pi) { const float e = __expf(n * cf[0]); const float a = n * cf[1]; pr = e * __cosf(a); pi = e * __sinf(a); }

__device__ __forceinline__ void s5_tables(const Frame& F, unsigned char* ws, const int tid, const float* lam_re, const float* lam_im, const float* b_re, const float* b_im, const float* c_re, const float* c_im, const float* log_dt) {
    bf16* KT = (bf16*)(ws + WS_S5KT); bf16* VT = (bf16*)(ws + WS_S5VT); bf16* WT = (bf16*)(ws + WS_S5WT); float* L64 = (float*)(ws + WS_S5L64);
    LAS f32x4* CF = (LAS f32x4*)F.lds;
    for (int i = tid; i < 64 * 64; i += NTHREADS) { const int g = i >> 6; const float lr = lam_re[i], li = lam_im[i], dt = expf(log_dt[g]);
        const float er = expf(lr * dt); float sn, cs; sincosf(li * dt, &sn, &cs);
        const float nr = er * cs - 1.f, ni = er * sn, den = lr * lr + li * li;
        CF[i] = (f32x4){lr * dt, li * dt, (nr * lr + ni * li) / den, (ni * lr - nr * li) / den}; }
    __syncthreads();
    const int gt = blockIdx.x * NTHREADS + tid, nthr = F.G * NTHREADS;
    LAS float* BR = (LAS float*)(F.lds + 65536); LAS float* BI = BR + 1024; LAS float* CR = BI + 1024; LAS float* CI = CR + 1024;
    for (int i0 = blockIdx.x * NTHREADS; i0 < 64 * SLN * 16 * 4; i0 += nthr) {
        const int g = i0 / (64 * SLN);
        __syncthreads();
        for (int q = tid; q < 1024; q += NTHREADS) { BR[q] = b_re[(size_t)g * 1024 + q]; BI[q] = b_im[(size_t)g * 1024 + q]; CR[q] = c_re[(size_t)g * 1024 + q]; CI[q] = c_im[(size_t)g * 1024 + q]; }
        __syncthreads();
        const int i4 = i0 + tid, pq = i4 & 3, idx = i4 >> 2, h = idx & 15, tau = (idx >> 4) % SLN;
        float acc[16];
#pragma unroll
        for (int q = 0; q < 16; ++q) acc[q] = 0.f;
#pragma unroll 4
        for (int p = pq * 16; p < pq * 16 + 16; ++p) { const f32x4 cf = CF[g * 64 + p]; float pr, pi; s5_pow(cf, (float)tau, pr, pi);
            const float cr = CR[h * 64 + p], ci = CI[h * 64 + p];
            const float xr = cr * pr - ci * pi, xi = cr * pi + ci * pr;
            const float yr = xr * cf[2] - xi * cf[3], yi = xr * cf[3] + xi * cf[2];
            const LAS f32x4* br4 = (const LAS f32x4*)(BR + p * 16); const LAS f32x4* bi4 = (const LAS f32x4*)(BI + p * 16);
#pragma unroll
            for (int q = 0; q < 4; ++q) { const f32x4 b_r = br4[q], b_i = bi4[q];
#pragma unroll
                for (int z = 0; z < 4; ++z) acc[4 * q + z] += yr * b_r[z] - yi * b_i[z]; } }
#pragma unroll
        for (int q = 0; q < 16; ++q) { acc[q] += dpp_f<0xB1>(acc[q]); acc[q] += dpp_f<0x4E>(acc[q]); }
        if (pq == 0) { u32x4 o0, o1; o0.x = pk2(acc[0], acc[1]); o0.y = pk2(acc[2], acc[3]); o0.z = pk2(acc[4], acc[5]); o0.w = pk2(acc[6], acc[7]);
            o1.x = pk2(acc[8], acc[9]); o1.y = pk2(acc[10], acc[11]); o1.z = pk2(acc[12], acc[13]); o1.w = pk2(acc[14], acc[15]);
            *(u32x4*)(KT + (size_t)idx * 16) = o0; *(u32x4*)(KT + (size_t)idx * 16 + 8) = o1; } }
    for (int idx = gt; idx < 64 * 64 * SLN; idx += nthr) {
        const int j = idx % SLN, p = (idx / SLN) & 63, g = idx / (SLN * 64);
        const f32x4 cf = CF[g * 64 + p]; float pr, pi;
        s5_pow(cf, (float)(SLN - 1 - j), pr, pi);
        const float yr = pr * cf[2] - pi * cf[3], yi = pr * cf[3] + pi * cf[2];
        const float* br = b_re + (size_t)(g * 64 + p) * 16; const float* bi = b_im + (size_t)(g * 64 + p) * 16;
        float vr[16], vi[16];
#pragma unroll
        for (int q = 0; q < 16; ++q) { vr[q] = yr * br[q] - yi * bi[q]; vi[q] = yr * bi[q] + yi * br[q]; }
        bf16* v0 = VT + ((size_t)(g * 128 + 2 * p) * SKK + j * 16);
        u32x4 o; o.x = pk2(vr[0], vr[1]); o.y = pk2(vr[2], vr[3]); o.z = pk2(vr[4], vr[5]); o.w = pk2(vr[6], vr[7]); *(u32x4*)v0 = o;
        o.x = pk2(vr[8], vr[9]); o.y = pk2(vr[10], vr[11]); o.z = pk2(vr[12], vr[13]); o.w = pk2(vr[14], vr[15]); *(u32x4*)(v0 + 8) = o;
        o.x = pk2(vi[0], vi[1]); o.y = pk2(vi[2], vi[3]); o.z = pk2(vi[4], vi[5]); o.w = pk2(vi[6], vi[7]); *(u32x4*)(v0 + SKK) = o;
        o.x = pk2(vi[8], vi[9]); o.y = pk2(vi[10], vi[11]); o.z = pk2(vi[12], vi[13]); o.w = pk2(vi[14], vi[15]); *(u32x4*)(v0 + SKK + 8) = o;
        if (j == 0) { s5_pow(cf, (float)SLN, pr, pi); L64[(g * 64 + p) * 2] = pr; L64[(g * 64 + p) * 2 + 1] = pi; }
    }
    for (int idx = gt; idx < 64 * 64 * SLN; idx += nthr) {
        const int p = idx & 63, l = (idx >> 6) % SLN, g = idx / (SLN * 64);
        const f32x4 cf = CF[g * 64 + p]; float pr, pi; s5_pow(cf, (float)(l + 1), pr, pi);
#pragma unroll
        for (int h = 0; h < 16; ++h) { const float cr = c_re[(g * 16 + h) * 64 + p], ci = c_im[(g * 16 + h) * 64 + p];
            *(unsigned*)(WT + ((size_t)((g * SLN + l) * 16 + h) * 128 + 2 * p)) = pk2(cr * pr - ci * pi, -(cr * pi + ci * pr)); }
    }
    __syncthreads();
}
__device__ __forceinline__ void s5_phaseA(const Frame& F, unsigned char* ws, const int lane) {
    const bf16* PB = (const bf16*)(ws + WS_PB); const bf16* VT = (const bf16*)(ws + WS_S5VT); float* SL = (float*)(ws + WS_S5SL);
    const int gq = lane >> 4, li = lane & 15;
    for (int wu = F.gw; wu < 64 * NRT * 2; wu += F.NGW) {
        const int half = wu & 1, rt = (wu >> 1) % NRT, g = wu / (2 * NRT), b = rt / (NRT / 2), c0 = (rt % (NRT / 2)) * 16;
        f32x4 acc[4];
#pragma unroll
        for (int ct = 0; ct < 4; ++ct) acc[ct] = (f32x4){0.f, 0.f, 0.f, 0.f};
        const bf16* ap = PB + ((size_t)b * T + (size_t)(c0 + li) * SLN + (gq >> 1)) * 1024 + g * 16 + 8 * (gq & 1);
        const bf16* bp = VT + (size_t)(g * 128 + half * 64 + li) * SKK + 8 * gq;
#pragma unroll 4
        for (int ks = 0; ks < SLN / 2; ++ks) {
            const bf16x8 af = *(const bf16x8*)(ap + (size_t)(2 * ks) * 1024);
#pragma unroll
            for (int ct = 0; ct < 4; ++ct) acc[ct] = __builtin_amdgcn_mfma_f32_16x16x32_bf16(af, *(const bf16x8*)(bp + (size_t)(16 * ct) * SKK + 32 * ks), acc[ct], 0, 0, 0);
        }
#pragma unroll
        for (int ct = 0; ct < 4; ++ct)
#pragma unroll
            for (int r = 0; r < 4; ++r) SL[(size_t)(g * NI + rt * 16 + 4 * gq + r) * 128 + half * 64 + ct * 16 + li] = acc[ct][r];
    }
}
__device__ __forceinline__ void s5_phaseB(const Frame& F, unsigned char* ws, const int tid) {
    static_assert(NCI == 256, "16 groups of 16 chunks");
    const float* SL = (const float*)(ws + WS_S5SL); bf16* SP = (bf16*)(ws + WS_S5SP); const float* L64 = (const float*)(ws + WS_S5L64);
    for (int gt = blockIdx.x * NTHREADS + tid; gt < 2 * 64 * 64 * 16; gt += F.G * NTHREADS) {
        const int grp = gt & 15, p = (gt >> 4) & 63, g = (gt >> 10) & 63, b = gt >> 16;
        const float ar = L64[(g * 64 + p) * 2], ai = L64[(g * 64 + p) * 2 + 1];
        const size_t base = (size_t)(g * NI + b * NCI + grp * 16) * 128 + 2 * p;
        f32x2 x[16];
#pragma unroll
        for (int i = 0; i < 16; ++i) x[i] = *(const f32x2*)(SL + base + (size_t)i * 128);
        float lr[16], li[16], sr = 0.f, si = 0.f;
#pragma unroll
        for (int i = 0; i < 16; ++i) { lr[i] = sr; li[i] = si; const float nr = ar * sr - ai * si + x[i][0], ni = ar * si + ai * sr + x[i][1]; sr = nr; si = ni; }
        float mr = ar, mi = ai;
#pragma unroll
        for (int k = 0; k < 4; ++k) { const float t = mr * mr - mi * mi; mi = 2.f * mr * mi; mr = t; }
#define S5_STEP(CTRL) do { const float tr = __builtin_bit_cast(float, __builtin_amdgcn_update_dpp(0, __builtin_bit_cast(int, sr), CTRL, 0xf, 0xf, true)), ti = __builtin_bit_cast(float, __builtin_amdgcn_update_dpp(0, __builtin_bit_cast(int, si), CTRL, 0xf, 0xf, true)); \
            sr += mr * tr - mi * ti; si += mr * ti + mi * tr; const float t2 = mr * mr - mi * mi; mi = 2.f * mr * mi; mr = t2; } while (0)
        S5_STEP(0x111); S5_STEP(0x112); S5_STEP(0x114); S5_STEP(0x118);
#undef S5_STEP
        const float pr = __builtin_bit_cast(float, __builtin_amdgcn_update_dpp(0, __builtin_bit_cast(int, sr), 0x111, 0xf, 0xf, true)), pi = __builtin_bit_cast(float, __builtin_amdgcn_update_dpp(0, __builtin_bit_cast(int, si), 0x111, 0xf, 0xf, true));
        float qr = 1.f, qi = 0.f;
#pragma unroll
        for (int i = 0; i < 16; ++i) { const float orr = qr * pr - qi * pi + lr[i], oi = qr * pi + qi * pr + li[i];
            *(unsigned*)(SP + base + (size_t)i * 128) = pk2(orr, oi);
            const float t = qr * ar - qi * ai; qi = qr * ai + qi * ar; qr = t; }
    }
}
__device__ __forceinline__ void s5_phaseC(const Frame& F, unsigned char* ws, const int lane, const float* dskip) {
    const bf16* PB = (const bf16*)(ws + WS_PB); const bf16* KT = (const bf16*)(ws + WS_S5KT); const bf16* WT = (const bf16*)(ws + WS_S5WT); const bf16* SP = (const bf16*)(ws + WS_S5SP);
    bf16* YB = (bf16*)(ws + WS_YB);
    const int gq = lane >> 4, li = lane & 15;
#pragma unroll 1
    for (int wu = F.gw; wu < 64 * NRT * 2; wu += F.NGW) {
        const int par = wu & 1, rt = (wu >> 1) % NRT, g = wu / (2 * NRT), b = rt / (NRT / 2), c0 = (rt % (NRT / 2)) * 16;
        bf16x8 af[SLN / 2], sf[4];
        const bf16* ap = PB + ((size_t)b * T + (size_t)(c0 + li) * SLN + (gq >> 1)) * 1024 + g * 16 + 8 * (gq & 1);
#pragma unroll
        for (int ks = 0; ks < SLN / 2; ++ks) af[ks] = *(const bf16x8*)(ap + (size_t)(2 * ks) * 1024);
#pragma unroll
        for (int ks = 0; ks < 4; ++ks) sf[ks] = *(const bf16x8*)(SP + (size_t)(g * NI + rt * 16 + li) * 128 + 32 * ks + 8 * gq);
        const float dl = dskip[g * 16 + li];
        const bf16* ktp = KT + (size_t)g * SLN * 256 + li * 16 + 8 * (gq & 1);
#pragma unroll
        for (int l2 = 0; l2 < SLN / 2; ++l2) {
            int l = 2 * l2 + par; asm volatile("" : "+v"(l));
            f32x4 acc = (f32x4){0.f, 0.f, 0.f, 0.f};
#pragma unroll
            for (int ks = 0; ks <= l2; ++ks) { const int tau = l - 2 * ks - (gq >> 1);
                bf16x8 bfv = *(const bf16x8*)(ktp + (size_t)(tau < 0 ? 0 : tau) * 256);
                if (ks == l2 && tau < 0) bfv = (bf16x8){0, 0, 0, 0, 0, 0, 0, 0};
                acc = __builtin_amdgcn_mfma_f32_16x16x32_bf16(af[ks], bfv, acc, 0, 0, 0); }
            const bf16* wp = WT + (size_t)((g * SLN + l) * 16 + li) * 128 + 8 * gq;
#pragma unroll
            for (int ks = 0; ks < 4; ++ks) acc = __builtin_amdgcn_mfma_f32_16x16x32_bf16(sf[ks], *(const bf16x8*)(wp + 32 * ks), acc, 0, 0, 0);
#pragma unroll
            for (int r = 0; r < 4; ++r) { const size_t row = (size_t)b * T + (size_t)(c0 + 4 * gq + r) * SLN + l; const size_t o = row * 1024 + g * 16 + li;
                const float y = acc[r] + dl * bf2f(PB[o]); YB[o] = (bf16)f2bf(gelu_tanh(y)); }
            asm volatile("" ::: "memory");
        }
    }
}

#define IN(k) (lo <= (k) && (k) < hi)
#define SEAM(k) do { if ((k) + 1 < hi) { xcd_barrier(bar, F.wave); if (PROBE_CLS == 10) xcd_barrier(bar, F.wave); if (PROBE_T >= 0) stamp_fn(F.lds, F.wave, (k)); } } while (0)
#define INP(i) inp_ptr(F.lds, (i))
#define x_in INP(0)
#define ln_g INP(1)
#define ln_b INP(2)
#define WS_PTRS \
    float* HF = (float*)(ws + WS_HF); bf16* XB = (bf16*)(ws + WS_XB); bf16* ZF = (bf16*)(ws + WS_ZF); bf16* PB = (bf16*)(ws + WS_PB); \
    float* GB = (float*)(ws + WS_GB); float* LA = (float*)(ws + WS_LA); float* ORAW = (float*)(ws + WS_ORAW); bf16* YB = (bf16*)(ws + WS_YB); \
    bf16* ACT = (bf16*)(ws + WS_ACT); bf16* YS = (bf16*)(ws + WS_YS); bf16* XG = (bf16*)(ws + WS_XG); \
    int* LIST = (int*)(ws + WS_LIST); float* GW = (float*)(ws + WS_ORAW); \
    float* S5LB = (float*)(ws + WS_S5TAB); float* S5BB = (float*)(ws + WS_S5TAB + 32768); \
    (void)HF; (void)XB; (void)ZF; (void)PB; (void)GB; (void)LA; (void)ORAW; (void)YB; (void)ACT; (void)YS; (void)XG; (void)LIST; (void)GW; (void)S5LB; (void)S5BB;

template <int layer>
__device__ __forceinline__ void layer_body(const Frame& F, unsigned char* ws, unsigned* ctl, LAS int* TAB, const XcdBarrier& bar, const int lo, const int hi, float* d_out) {
    WS_PTRS
        const int pb = 1 + layer * 16;
        const float* hin = (layer == 0) ? x_in : HF;
        if (PHE(1) && IN(pb + 0)) {
            const bf16* Wt = (const bf16*)(ws + (layer == 0 ? WS_WT_ML_IN : layer == 1 ? WS_WT_RET_IN : layer == 2 ? WS_WT_GLA_IN : WS_WT_S5_IN));
            const int N = (layer == 0 || layer == 2) ? 3072 : (layer == 1 ? 6144 : 1024);
            pg8::DenseOrder S; S.init(XB, Wt, M, N, D, F.G, (int)blockIdx.x);
            pg8::EpiBf16 E{PB, N, (const float*)(ws + WS_CS), (layer == 1) ? 8 : 0};
            for (int rep_ = 0; rep_ < REPS(2); ++rep_)
            pg8::gemm_phase<pg8::EpiBf16, pg8::DenseOrder, true, true>(F.lds, F.wave, D, S, E);
            if (layer == 0 && CH_ML) {
                const int lane = lane_id(); float* GSC = (float*)(ws + WS_SC);
                for (int wu = F.gw; wu < 16 * NCH; wu += F.NGW) { const int bh = wu / NCH, c = wu % NCH, b = bh >> 3, h = bh & 7;
                    const int t0 = c * CL + 2 * lane; const size_t row = (size_t)b * T + t0;
                    const float lf0 = log_sigmoidf_(GB[row * 16 + 8 + h]), lf1 = log_sigmoidf_(GB[(row + 1) * 16 + 8 + h]);
                    const float sp = lf0 + lf1; float inc = sp;
#pragma unroll
                    for (int d = 1; d < 64; d <<= 1) { const float tv_ = __shfl_up(inc, d); if (lane >= d) inc += tv_; }
                    const float a0 = inc - sp + lf0, a1 = inc;
                    const float g0 = GB[row * 16 + h] - a0, g1 = GB[(row + 1) * 16 + h] - a1;
                    float mx = fmaxf(g0, g1);
#pragma unroll
                    for (int d = 1; d < 64; d <<= 1) { const float tv_ = __shfl_up(mx, d); if (lane >= d) mx = fmaxf(mx, tv_); }
                    float ex = __shfl_up(mx, 1); if (lane == 0) ex = -3.0e38f;
                    const size_t o0 = (size_t)bh * T + t0;
                    *(f32x2*)(GSC + (size_t)(0 * 16) * T + o0) = (f32x2){a0, a1};
                    *(f32x2*)(GSC + (size_t)(1 * 16) * T + o0) = (f32x2){g0, g1};
                    *(f32x2*)(GSC + (size_t)(2 * 16) * T + o0) = (f32x2){fmaxf(ex, g0), mx}; }
            }
            SEAM(pb + 0);
        }
        if (layer == 0) {
            if (CH_ML) {
                if (IN(pb + 2)) { const int lane = lane_id(), tid = F.wave * 64 + lane; for (int rep_ = 0; rep_ < REPS(6); ++rep_) mix_phaseA<0>(F, ws, tid, lane); SEAM(pb + 2); }
                if (IN(pb + 3)) { const int lane = lane_id(), tid = F.wave * 64 + lane; for (int rep_ = 0; rep_ < REPS(7); ++rep_) mix_phaseB<0>(F, ws, tid); SEAM(pb + 3); }
                if (IN(pb + 4)) { const int lane = lane_id(), tid = F.wave * 64 + lane; for (int rep_ = 0; rep_ < REPS(8); ++rep_) mix_phaseC<0>(F, ws, tid, lane, INP(5)); SEAM(pb + 4); }
            }
        } else if (layer == 1) {
            if (CH_RET) {
                if (IN(pb + 2)) { const int lane = lane_id(), tid = F.wave * 64 + lane; for (int rep_ = 0; rep_ < REPS(6); ++rep_) mix_phaseA<1>(F, ws, tid, lane); SEAM(pb + 2); }
                if (IN(pb + 3)) { const int lane = lane_id(), tid = F.wave * 64 + lane; for (int rep_ = 0; rep_ < REPS(7); ++rep_) mix_phaseB<1>(F, ws, tid); SEAM(pb + 3); }
                if (IN(pb + 4)) { const int lane = lane_id(), tid = F.wave * 64 + lane; for (int rep_ = 0; rep_ < REPS(8); ++rep_) mix_phaseC<1>(F, ws, tid, lane, INP(8)); SEAM(pb + 4); }
            }
        } else if (layer == 2) {
            if (CH_GLA) {
                if (IN(pb + 1)) {
                    const int lane = lane_id();
                    bf16* KPP = (bf16*)(ws + WS_KPP); float* DEC = (float*)(ws + WS_SC + 3 * MiB); LAS float* tot = (LAS float*)F.lds;
                    for (int u = blockIdx.x; u < 2 * NCH * 8; u += F.G) { const int cg = u & 7, bc = u >> 3, b = bc / NCH, c = bc % NCH, ch = cg * 64 + lane;
                        const size_t r0 = (size_t)b * T + (size_t)c * CL + 16 * F.wave;
                        float cs[16]; unsigned short qv[16], kv[16];
#pragma unroll
                        for (int i = 0; i < 16; ++i) { cs[i] = LA[(r0 + i) * 512 + ch]; qv[i] = PB[(r0 + i) * 3072 + ch]; kv[i] = PB[(r0 + i) * 3072 + 512 + ch]; }
#pragma unroll
                        for (int i = 1; i < 16; ++i) cs[i] += cs[i - 1];
                        __syncthreads();
                        tot[F.wave * 64 + lane] = cs[15];
                        __syncthreads();
                        float pre = 0.f, bend = 0.f;
#pragma unroll
                        for (int w2 = 0; w2 < NWAVES; ++w2) { const float tw = tot[w2 * 64 + lane]; bend += tw; if (w2 < F.wave) pre += tw; }
#pragma unroll
                        for (int i = 0; i < 16; ++i) { const float bcum = pre + cs[i]; const float q_ = bf2f(qv[i]), k_ = bf2f(kv[i]) * 0.08838834764831845f;
                            PB[(r0 + i) * 3072 + ch] = (bf16)f2bf(q_ * __expf(bcum)); PB[(r0 + i) * 3072 + 512 + ch] = (bf16)f2bf(k_ * __expf(-bcum)); KPP[(r0 + i) * 512 + ch] = (bf16)f2bf(k_ * __expf(bend - bcum)); }
                        if (F.wave == 0) DEC[(size_t)bc * 512 + ch] = __expf(bend); }
                    __syncthreads();
                    SEAM(pb + 1);
                }
                if (IN(pb + 2)) { const int lane = lane_id(), tid = F.wave * 64 + lane; for (int rep_ = 0; rep_ < REPS(6); ++rep_) mix_phaseA<2>(F, ws, tid, lane); SEAM(pb + 2); }
                if (IN(pb + 3)) { const int lane = lane_id(), tid = F.wave * 64 + lane; for (int rep_ = 0; rep_ < REPS(7); ++rep_) mix_phaseB<2>(F, ws, tid); SEAM(pb + 3); }
                if (IN(pb + 4)) { const int lane = lane_id(), tid = F.wave * 64 + lane; for (int rep_ = 0; rep_ < REPS(8); ++rep_) mix_phaseC<2>(F, ws, tid, lane, INP(13)); SEAM(pb + 4); }
            }
        } else {
            if (CH_S5) {
                if (IN(pb + 2)) { const int lane = lane_id(); for (int rep_ = 0; rep_ < REPS(6); ++rep_) s5_phaseA(F, ws, lane); SEAM(pb + 2); }
                if (IN(pb + 3)) { const int lane = lane_id(), tid = F.wave * 64 + lane; for (int rep_ = 0; rep_ < REPS(7); ++rep_) s5_phaseB(F, ws, tid); SEAM(pb + 3); }
                if (IN(pb + 4)) { const int lane = lane_id(); for (int rep_ = 0; rep_ < REPS(8); ++rep_) s5_phaseC(F, ws, lane, INP(22)); SEAM(pb + 4); }
            }
        }
        if (PHE(4) && layer == 3 && IN(pb + 6)) {
            pg8::DenseOrder S; S.init(YB, ws + WS_WT_S5_GLU, M, D, D, F.G, (int)blockIdx.x);
            pg8::EpiGlu E{YB, INP(25), (bf16*)ORAW};
            for (int rep_ = 0; rep_ < REPS(3); ++rep_)
            pg8::gemm_phase<pg8::EpiGlu, pg8::DenseOrder, true, true>(F.lds, F.wave, D, S, E);
            SEAM(pb + 6);
        }
        if (PHE(5) && IN(pb + 7)) {
            const bf16* Wt = (const bf16*)(ws + (layer == 0 ? WS_WT_ML_OUT : layer == 1 ? WS_WT_RET_OUT : layer == 2 ? WS_WT_GLA_OUT : WS_WT_S5_OUT));
            const int Kd = (layer == 1) ? 2048 : 1024;
            const bf16* Ain = (layer == 3) ? (const bf16*)ORAW : YB;
            pg8::DenseOrder S; S.init(Ain, Wt, M, D, Kd, F.G, (int)blockIdx.x);
            pg8::EpiResid E{hin, (layer == 0) ? (const bf16*)nullptr : (const bf16*)XB, ZF};
            for (int rep_ = 0; rep_ < REPS(3); ++rep_)
            pg8::gemm_phase<pg8::EpiResid, pg8::DenseOrder, true, true>(F.lds, F.wave, Kd, S, E);
            SEAM(pb + 7);
        }
        unsigned* cnt = ctl + CW_CNT + layer * 32 * 64;
        if (IN(pb + 8) && !defined_SKIP_LN1) { const int lane = lane_id(), tid = F.wave * 64 + lane; (void)tid;
            LAS float* Wt = (LAS float*)(F.lds);
            { const f32x4* wr4 = (const f32x4*)(INP(27) + (size_t)layer * D * NEXP);
              f32x4 wv[16];
#pragma unroll
              for (int i = 0; i < 16; ++i) wv[i] = wr4[tid + i * NTHREADS];
#pragma unroll
              for (int i = 0; i < 16; ++i) { const int q = tid + i * NTHREADS, k = q >> 3, e0 = (q & 7) * 4;
                  Wt[(e0 + 0) * 1028 + k] = wv[i][0]; Wt[(e0 + 1) * 1028 + k] = wv[i][1]; Wt[(e0 + 2) * 1028 + k] = wv[i][2]; Wt[(e0 + 3) * 1028 + k] = wv[i][3]; } }
            __syncthreads();
            const float* br_ = INP(28) + layer * NEXP;
            const float* lng_ = ln_g + (size_t)(layer * 2 + 0) * D; const float* lnb_ = ln_b + (size_t)(layer * 2 + 0) * D;
          {
            unsigned* cntp = cnt;
            int aE = 0, aRow = -1; float aG = 0.f;
            LAS unsigned* lcnt = (LAS unsigned*)(F.lds + 131584); LAS int* lbase = (LAS int*)(lcnt + 32);
            if (tid < 32) lcnt[tid] = 0u;
            const int ntrip = (M + F.NGW - 1) / F.NGW;
            u32x2 vnext[2][4];
#pragma unroll
            for (int q = 0; q < 2; ++q) { const int r_ = F.gw + q * F.NGW; if (r_ < M) { const u32x2* zp = (const u32x2*)(ZF + (size_t)r_ * D) + lane;
#pragma unroll
                for (int j = 0; j < 4; ++j) vnext[q][j] = zp[64 * j]; } }
            for (int it_ = 0; it_ < ntrip; it_ += 2) { const int row0_ = F.gw + it_ * F.NGW;
                asm volatile("" ::: "memory");
                const bool ok[2] = {row0_ < M, it_ + 1 < ntrip && row0_ + F.NGW < M};
                f32x4 v[2][4];
#pragma unroll
                for (int q = 0; q < 2; ++q)
#pragma unroll
                    for (int j = 0; j < 4; ++j) v[q][j] = (f32x4){bflo(vnext[q][j].x), bfhi(vnext[q][j].x), bflo(vnext[q][j].y), bfhi(vnext[q][j].y)};
#pragma unroll
                for (int q = 0; q < 2; ++q) { const int r_ = row0_ + (2 + q) * F.NGW; if (it_ + 2 + q < ntrip && r_ < M) { const u32x2* zp = (const u32x2*)(ZF + (size_t)r_ * D) + lane;
#pragma unroll
                    for (int j = 0; j < 4; ++j) vnext[q][j] = zp[64 * j]; } }
                { f32x4 gv[4], bv[4]; load_row_f32(lng_, gv, lane); load_row_f32(lnb_, bv, lane); ln_row(v[0], gv, bv); ln_row(v[1], gv, bv); }
                float pz[2][32];
#pragma unroll
                for (int e = 0; e < 32; ++e) { float s0 = 0.f, s1 = 0.f;
#pragma unroll
                    for (int j = 0; j < 4; ++j) { const f32x4 w = *(const LAS f32x4*)(Wt + e * 1028 + 4 * (lane + 64 * j));
                        s0 += v[0][j][0] * w[0] + v[0][j][1] * w[1] + v[0][j][2] * w[2] + v[0][j][3] * w[3]; s1 += v[1][j][0] * w[0] + v[1][j][1] * w[1] + v[1][j][2] * w[2] + v[1][j][3] * w[3]; }
                    pz[0][e] = s0; pz[1][e] = s1; }
                float lgv[2];
#pragma unroll
                for (int q = 0; q < 2; ++q) {
                    float a16[16], a8[8], a4[4], a2[2];
#pragma unroll
                    for (int e = 0; e < 16; ++e) { const auto r = __builtin_amdgcn_permlane32_swap(__builtin_bit_cast(unsigned, pz[q][e]), __builtin_bit_cast(unsigned, pz[q][e + 16]), false, false);
                        a16[e] = __builtin_bit_cast(float, (unsigned)r[0]) + __builtin_bit_cast(float, (unsigned)r[1]); }
#pragma unroll
                    for (int e = 0; e < 8; ++e) { const auto r = __builtin_amdgcn_permlane16_swap(__builtin_bit_cast(unsigned, a16[e]), __builtin_bit_cast(unsigned, a16[e + 8]), false, false);
                        a8[e] = __builtin_bit_cast(float, (unsigned)r[0]) + __builtin_bit_cast(float, (unsigned)r[1]); }
                    { const bool hi = (lane & 8) != 0;
#pragma unroll
                      for (int e = 0; e < 4; ++e) { const float mine = hi ? a8[e + 4] : a8[e], theirs = hi ? a8[e] : a8[e + 4]; a4[e] = mine + dpp_f<0x128>(theirs); } }
                    { const bool hi = (lane & 4) != 0;
#pragma unroll
                      for (int e = 0; e < 2; ++e) { const float mine = hi ? a4[e + 2] : a4[e], theirs = hi ? a4[e] : a4[e + 2]; a2[e] = mine + dpp_f<0x141>(theirs); } }
                    { const bool hi = (lane & 2) != 0; const float mine = hi ? a2[1] : a2[0], theirs = hi ? a2[0] : a2[1]; lgv[q] = mine + dpp_f<0x4E>(theirs); }
                    lgv[q] += dpp_f<0xB1>(lgv[q]);
                    lgv[q] += br_[lane >> 1];
                }
                int te[2][4]; float tv[2][4];
#pragma unroll
                for (int k = 0; k < 4; ++k)
#pragma unroll
                    for (int q = 0; q < 2; ++q) { const float best = wave_max(lgv[q]);
                        const unsigned long long mk = __ballot(lgv[q] == best); const int src = __builtin_amdgcn_readfirstlane((int)__ffsll((long long)mk) - 1);
                        te[q][k] = src >> 1; tv[q][k] = best; if ((lane >> 1) == te[q][k]) lgv[q] = -3.0e38f; }
#pragma unroll
                for (int q = 0; q < 2; ++q) if (ok[q]) { const int row = row0_ + q * F.NGW;
                    const float e0 = 1.f, e1 = __expf(tv[q][1] - tv[q][0]), e2 = __expf(tv[q][2] - tv[q][0]), e3 = __expf(tv[q][3] - tv[q][0]), rs = __builtin_amdgcn_rcpf(e0 + e1 + e2 + e3);
                    const int ri = (it_ + q) & 15;
                    if ((lane >> 2) == ri) { const int k = lane & 3; aE = k == 0 ? te[q][0] : k == 1 ? te[q][1] : k == 2 ? te[q][2] : te[q][3]; aG = (k == 0 ? e0 : k == 1 ? e1 : k == 2 ? e2 : e3) * rs; aRow = row; }
                    store_row_bf16(XB + (size_t)row * D, v[q], lane); }
                if (((it_ + 1) & 15) == 15 || it_ + 2 >= ntrip) {
                    __syncthreads();
                    int lp = 0; if (aRow >= 0) lp = (int)__hip_atomic_fetch_add(lcnt + aE, 1u, __ATOMIC_RELAXED, __HIP_MEMORY_SCOPE_WORKGROUP);
                    __syncthreads();
                    if (tid < 32) { const unsigned n = lcnt[tid]; lbase[tid] = n ? (int)__hip_atomic_fetch_add(cntp + tid * 64, n, __ATOMIC_RELAXED, __HIP_MEMORY_SCOPE_AGENT) : 0; }
                    __syncthreads();
                    if (aRow >= 0) { const int pos = lbase[aE] + lp; LIST[(size_t)aE * CAP + pos] = aRow * 4 + (lane & 3); GW[(size_t)aE * CAP + pos] = aG; }
                    aRow = -1;
                    __syncthreads();
                    if (tid < 32) lcnt[tid] = 0u;
                }
            }
          }
            __syncthreads();
            SEAM(pb + 8);
        }
        if ((PHE(7) || PHE(8)) && (IN(pb + 9) || IN(pb + 10))) { const int lane = lane_id(), tid = F.wave * 64 + lane; (void)tid;
            __syncthreads();
            if (tid < 32) TAB[tid] = (int)__hip_atomic_load(cnt + tid * 64, __ATOMIC_RELAXED, __HIP_MEMORY_SCOPE_AGENT);
            __syncthreads();
            if (tid < 64) {
                const int nt_ = (lane < 32) ? ((TAB[lane] + 255) >> 8) : 0; int inc = nt_;
#pragma unroll
                for (int d = 1; d < 32; d <<= 1) { const int t_ = __shfl_up(inc, d); if (lane >= d) inc += t_; }
                if (lane < 32) TAB[32 + lane] = inc - nt_;
                if (lane == 31) TAB[64] = inc; }
            __syncthreads();
            if (tid < MAXTILES) { int e = 0;
#pragma unroll
                for (int k = 1; k < 32; ++k) e += (TAB[32 + k] <= tid) ? 1 : 0;
                if (tid < TAB[64]) TAB[72 + tid] = e; }
            __syncthreads();
        }
        if (PHE(7) && IN(pb + 9)) {
            pg8::MoeOrder S; S.A = (const char*)XB; S.list = LIST; S.gwl = GW; S.Bt = (const char*)(ws + WS_WT_GU + (size_t)layer * 32 * 2048 * 1024 * 2); S.tab = TAB; S.K = D; S.nN = 8; S.ntiles = __builtin_amdgcn_readfirstlane(TAB[64]); S.nwg = S.ntiles * 8; S.G = F.G; S.c = (int)blockIdx.x;
            S.b_estride = (size_t)2048 * 1024 * 2; S.a_compact = 2;
            pg8::EpiSwiglu E{ACT, INP(30) + (size_t)layer * 32 * 2048, (const LAS float*)(TAB + 2816), ctl + 32768 + layer * 320 * 64};
            S.ready = nullptr; S.need = 0u; S.tmo = ctl + 2;
            for (int rep_ = 0; rep_ < REPS(4); ++rep_)
            pg8::gemm_phase<pg8::EpiSwiglu, pg8::MoeOrder, MOE_ALIGN, true, true>(F.lds, F.wave, D, S, E, TAB + 512);
            if (!MOE_COUNTED) SEAM(pb + 9);
        }
        if (PHE(8) && IN(pb + 10)) {
            pg8::MoeOrder S; S.A = (const char*)ACT; S.list = LIST; S.gwl = GW; S.Bt = (const char*)(ws + WS_WT_DN + (size_t)layer * 32 * 1024 * 1024 * 2); S.tab = TAB; S.K = DFF; S.nN = 4; S.ntiles = __builtin_amdgcn_readfirstlane(TAB[64]); S.nwg = S.ntiles * 4; S.G = F.G; S.c = (int)blockIdx.x;
            S.b_estride = (size_t)1024 * 1024 * 2; S.a_compact = 1;
            S.ready = ctl + 32768 + layer * 320 * 64; S.need = 64u; S.tmo = ctl + 2;
            pg8::EpiMoeDown E{YS, INP(32) + (size_t)layer * 32 * 1024, TAB + 1280, (const LAS float*)(TAB + 2816)};
            for (int rep_ = 0; rep_ < REPS(5); ++rep_)
            pg8::gemm_phase<pg8::EpiMoeDown, pg8::MoeOrder, MOE_ALIGN, true, true>(F.lds, F.wave, DFF, S, E, TAB + 512);
            SEAM(pb + 10);
        }
        if (PHE(9) && IN(pb + 11)) { const int lane = lane_id(), tid = F.wave * 64 + lane; (void)tid;
            LAS float* Wt = (LAS float*)(F.lds);
            if (layer == 1) { load_cols16(tid, INP(10), 3088, 3072, Wt); __syncthreads(); }
            const float* lng_ = ln_g + (size_t)(layer * 2 + 1) * D; const float* lnb_ = ln_b + (size_t)(layer * 2 + 1) * D;
          for (int rep_ = 0; rep_ < REPS(12); ++rep_) {
            float* outp = (PROBE_CLS == 12 && rep_ == 0) ? ORAW : (layer == 3) ? d_out : HF; bf16* XBo = (PROBE_CLS == 12 && rep_ == 0) ? YB : XB;
            f32x4 hn[4]; u32x2 yn[4][4];
#define CMB_LOAD(r_) do { { const u32x2* hp_ = (const u32x2*)(XB + (size_t)(r_) * D) + lane; _Pragma("unroll") for (int j = 0; j < 4; ++j) { const u32x2 hw_ = hp_[64 * j]; hn[j] = (f32x4){bflo(hw_.x), bfhi(hw_.x), bflo(hw_.y), bfhi(hw_.y)}; } } _Pragma("unroll") for (int k = 0; k < 4; ++k) { const u32x2* yp = (const u32x2*)(YS + ((size_t)(r_) * 4 + k) * D) + lane; _Pragma("unroll") for (int j = 0; j < 4; ++j) yn[k][j] = yp[64 * j]; } } while (0)
            if (F.gw < M) CMB_LOAD(F.gw);
            for (int row = F.gw; row < M; row += F.NGW) {
                asm volatile("" ::: "memory");
                f32x4 v[4];
#pragma unroll
                for (int j = 0; j < 4; ++j) v[j] = hn[j] * ALPHA;
#pragma unroll
                for (int k = 0; k < 4; ++k)
#pragma unroll
                    for (int j = 0; j < 4; ++j) { const u32x2 yw = yn[k][j]; v[j][0] += bflo(yw.x); v[j][1] += bfhi(yw.x); v[j][2] += bflo(yw.y); v[j][3] += bfhi(yw.y); }
                if (row + F.NGW < M) CMB_LOAD(row + F.NGW);
                { f32x4 gv[4], bv[4]; load_row_f32(lng_, gv, lane); load_row_f32(lnb_, bv, lane); ln_row(v, gv, bv); }
                if (layer == 3) store_row_f32(outp + (size_t)row * D, v, lane);
                if (layer < 3) store_row_bf16(XBo + (size_t)row * D, v, lane);
                if (layer == 1) {
                    const float zsum = row_dot16(v, Wt, lane);
                    if ((lane & 3) == 0) GB[(size_t)row * 16 + (lane >> 2)] = zsum;
                }
            }
            if (layer == 1) {
                __syncthreads();
                const float* wgp = INP(11); const float bgc = INP(12)[tid];
                float wg[16];
#pragma unroll
                for (int r = 0; r < 16; ++r) wg[r] = wgp[r * 512 + tid];
                for (int row = F.vcu * NWAVES; row < M; row += F.NGW) {
                    f32x4 zv[NWAVES][4];
#pragma unroll
                    for (int w = 0; w < NWAVES; ++w)
#pragma unroll
                        for (int q = 0; q < 4; ++q) zv[w][q] = *(const f32x4*)(GB + (size_t)(row + w) * 16 + 4 * q);
#pragma unroll
                    for (int w = 0; w < NWAVES; ++w) { float sacc = bgc;
#pragma unroll
                        for (int q = 0; q < 4; ++q) sacc += zv[w][q][0] * wg[4 * q] + zv[w][q][1] * wg[4 * q + 1] + zv[w][q][2] * wg[4 * q + 2] + zv[w][q][3] * wg[4 * q + 3];
                        LA[(size_t)(row + w) * 512 + tid] = log_sigmoidf_(sacc) * (1.f / 16.f); }
                }
            }
          }
            __syncthreads();
#undef CMB_LOAD
            if (layer < 3) SEAM(pb + 11);
        }
}
__global__ void __launch_bounds__(NTHREADS, 2) mega_fwd(Args args) {
    extern __shared__ __attribute__((aligned(16))) unsigned char lds_raw[];
    Frame F;
    F.lds = (LAS unsigned char*)lds_raw;
    F.wave = __builtin_amdgcn_readfirstlane((int)threadIdx.x >> 6);
    F.G = gridDim.x; { const int bx = blockIdx.x; F.vcu = (F.G % 8 == 0) ? (bx % 8) * (F.G / 8) + bx / 8 : bx; }
    F.gw = F.vcu * NWAVES + F.wave; F.NGW = F.G * NWAVES;
    unsigned char* ws = args.ws;
    unsigned* ctl = (unsigned*)(ws + WS_CTL);
    volatile LAS unsigned* MISC = (volatile LAS unsigned*)(F.lds + MISC_OFF);
    LAS int* TAB = (LAS int*)(F.lds + TAB_OFF);
    { const int tid0 = threadIdx.x;
      if (tid0 < 64) MISC[tid0] = 0u;
      if (tid0 < 33) ((LAS unsigned long long*)(F.lds + MISC_OFF + 256))[tid0] = (unsigned long long)args.in[tid0]; }
    __syncthreads();
    XcdBarrier bar = xcd_barrier_post(ctl + CW_BAR, MISC + 8, F.wave == 0 && lane_id() == 0);
    if (PROBE_T >= 0 && blockIdx.x == 0 && F.wave == 0 && lane_id() == 0) { volatile LAS unsigned long long* st = (volatile LAS unsigned long long*)(F.lds + MISC_OFF + 1024); st[0] = __builtin_amdgcn_s_memrealtime(); st[1] = 0ull; }
    const int lo = args.ph_lo, hi = args.ph_hi;
    WS_PTRS
    if (IN(0) && !defined_SKIP_P0) { const int lane = lane_id(), tid = F.wave * 64 + lane; (void)tid;
      {
        LAS unsigned char* scr = F.lds + F.wave * 8704;
        {
            constexpr int I_GU = 128 * 16 * 32, I_DN = 128 * 16 * 16, I_ML = 16 * 48, I_SQ = 16 * 16, I_RI = 16 * 96, I_RO = 32 * 16;
            constexpr int B0 = I_GU, B1 = B0 + I_DN, B2 = B1 + I_ML, B3 = B2 + I_SQ, B4 = B3 + I_RI, B5 = B4 + I_RO, B6 = B5 + I_ML, B7 = B6 + I_SQ, B8 = B7 + I_SQ, B9 = B8 + I_SQ, B10 = B9 + I_SQ;
#define P0_ITEM(IT_) do { const int it = (IT_); \
                    const float* src; bf16* dst; int ldw, Kd, nnb, mode = 0, r; \
                    if (it < B0)      { r = it;      const int q = r / (16 * 32); r -= q * (16 * 32); src = INP(29) + (size_t)q * 1024 * 2048; dst = (bf16*)(ws + WS_WT_GU) + (size_t)q * 2048 * 1024; ldw = 2048; Kd = 1024; nnb = 32; mode = 1; } \
                    else if (it < B1) { r = it - B0; const int q = r / (16 * 16); r -= q * (16 * 16); src = INP(31) + (size_t)q * 1024 * 1024; dst = (bf16*)(ws + WS_WT_DN) + (size_t)q * 1024 * 1024; ldw = 1024; Kd = 1024; nnb = 16; } \
                    else if (it < B2) { r = it - B1; src = INP(3);  dst = (bf16*)(ws + WS_WT_ML_IN);  ldw = 3088; Kd = 1024; nnb = 48; } \
                    else if (it < B3) { r = it - B2; src = INP(6);  dst = (bf16*)(ws + WS_WT_ML_OUT); ldw = 1024; Kd = 1024; nnb = 16; } \
                    else if (it < B4) { r = it - B3; src = INP(7);  dst = (bf16*)(ws + WS_WT_RET_IN); ldw = 6144; Kd = 1024; nnb = 96; mode = 2; } \
                    else if (it < B5) { r = it - B4; src = INP(9);  dst = (bf16*)(ws + WS_WT_RET_OUT); ldw = 1024; Kd = 2048; nnb = 16; } \
                    else if (it < B6) { r = it - B5; src = INP(10); dst = (bf16*)(ws + WS_WT_GLA_IN); ldw = 3088; Kd = 1024; nnb = 48; } \
                    else if (it < B7) { r = it - B6; src = INP(14); dst = (bf16*)(ws + WS_WT_GLA_OUT); ldw = 1024; Kd = 1024; nnb = 16; } \
                    else if (it < B8) { r = it - B7; src = INP(15); dst = (bf16*)(ws + WS_WT_S5_IN);  ldw = 1024; Kd = 1024; nnb = 16; } \
                    else if (it < B9) { r = it - B8; src = INP(24); dst = (bf16*)(ws + WS_WT_S5_GLU); ldw = 1024; Kd = 1024; nnb = 16; } \
                    else              { r = it - B9; src = INP(26); dst = (bf16*)(ws + WS_WT_S5_OUT); ldw = 1024; Kd = 1024; nnb = 16; } \
                const int kb = r / nnb, nb = r - kb * nnb; \
                transpose_item(src, ldw, 0, Kd, dst, mode, kb, nb, scr, lane); } while (0)
            const int NSTAT = (B10 / F.NGW) * 4 / 5, DYN0 = NSTAT * F.NGW, DLEN = B10 - DYN0, GLEN = (DLEN + 7) / 8;
#pragma unroll 1
            for (int n_ = 0; n_ < NSTAT; ++n_) P0_ITEM(F.gw + n_ * F.NGW);
#pragma unroll 1
            for (int tr = 0; tr < 8; ++tr) { const int grp = ((int)blockIdx.x + tr) & 7; unsigned* q = ctl + 2304 + 64 * grp; const int glo = DYN0 + grp * GLEN, glen = (DLEN - grp * GLEN) < GLEN ? (DLEN - grp * GLEN) : GLEN;
                int cur = 0; if (lane == 0) cur = (int)__hip_atomic_fetch_add(q, 4u, __ATOMIC_RELAXED, __HIP_MEMORY_SCOPE_AGENT); cur = __builtin_amdgcn_readfirstlane(cur);
#pragma unroll 1
                while (cur < glen) { int nx = 0; if (lane == 0) nx = (int)__hip_atomic_fetch_add(q, 4u, __ATOMIC_RELAXED, __HIP_MEMORY_SCOPE_AGENT);
#pragma unroll 1
                    for (int k = 0; k < 4; ++k) if (cur + k < glen) P0_ITEM(glo + cur + k);
                    cur = __builtin_amdgcn_readfirstlane(nx); } }
#undef P0_ITEM
        }
        __syncthreads();
        if (CH_S5) s5_tables(F, ws, tid, INP(16), INP(17), INP(18), INP(19), INP(20), INP(21), INP(23));
        { float* CS = (float*)(ws + WS_CS);
          for (int it = blockIdx.x * NTHREADS + tid; it < T * 64; it += F.G * NTHREADS) { const int t = it >> 6, i = it & 63;
              const float inv = exp2f(-(float)(2 * i) * (13.287712379549449f / 128.f)); float sn, cs; sincosf((float)t * inv, &sn, &cs); CS[2 * it] = cs; CS[2 * it + 1] = sn; } }
        LAS float* Wt = (LAS float*)(F.lds);
        load_cols16(tid, INP(3), 3088, 3072, Wt);
        __syncthreads();
        {
            const float* bg = INP(4);
            f32x4 vn[4]; if (F.gw < M) load_row_f32(x_in + (size_t)F.gw * D, vn, lane);
            for (int row = F.gw; row < M; row += F.NGW) {
                asm volatile("" ::: "memory");
                f32x4 v[4];
#pragma unroll
                for (int j = 0; j < 4; ++j) v[j] = vn[j];
                if (row + F.NGW < M) load_row_f32(x_in + (size_t)(row + F.NGW) * D, vn, lane);
                store_row_bf16(XB + (size_t)row * D, v, lane);
                const float gsum = row_dot16(v, Wt, lane);
                if ((lane & 3) == 0) GB[(size_t)row * 16 + (lane >> 2)] = gsum + bg[lane >> 2];
            }
        }
        __syncthreads();
      }
        SEAM(0);
    }

    layer_body<0>(F, ws, ctl, TAB, bar, lo, hi, args.out);
    layer_body<1>(F, ws, ctl, TAB, bar, lo, hi, args.out);
    layer_body<2>(F, ws, ctl, TAB, bar, lo, hi, args.out);
    layer_body<3>(F, ws, ctl, TAB, bar, lo, hi, args.out);
    if (PROBE_T >= 0 && blockIdx.x == 0 && F.wave == 0 && lane_id() == 0) { volatile LAS unsigned long long* st = (volatile LAS unsigned long long*)(F.lds + MISC_OFF + 1024); args.out[0] = (float)st[1] * (0.01f / 16.f); }
#undef IN
#undef SEAM
#undef INP
#undef x_in
#undef ln_g
#undef ln_b
}

extern "C" void kernel_launch(void* const* d_in, const int* in_sizes, int n_in, void* d_out, int out_size, void* d_ws, size_t ws_size, hipStream_t stream) {
    static int grid = 0;
    if (grid == 0) {
        if (n_in != 33 || out_size != M * D || ws_size < WS_END) { fprintf(stderr, "kernel_launch: unexpected problem (n_in %d, out %d, ws %zu < %zu)\n", n_in, out_size, ws_size, (size_t)WS_END); grid = -1; return; }
        int dev = 0, cus = 0, per_cu = 0;
        if (hipGetDevice(&dev) != hipSuccess || hipDeviceGetAttribute(&cus, hipDeviceAttributeMultiprocessorCount, dev) != hipSuccess) { grid = -1; return; }
        if (hipFuncSetAttribute((const void*)mega_fwd, hipFuncAttributeMaxDynamicSharedMemorySize, LDS_BYTES) != hipSuccess) { fprintf(stderr, "kernel_launch: hipFuncSetAttribute failed\n"); grid = -1; return; }
        if (hipOccupancyMaxActiveBlocksPerMultiprocessor(&per_cu, (const void*)mega_fwd, NTHREADS, LDS_BYTES) != hipSuccess || per_cu < 1) { fprintf(stderr, "kernel_launch: occupancy query says %d\n", per_cu); }
        (void)hipGetLastError();
        grid = cus;
    }
    if (grid < 0) return;
    hipMemsetAsync((char*)d_ws + WS_CTL, 0, CTL_ZERO_BYTES, stream);
    Args a{};
    for (int i = 0; i < 33; ++i) a.in[i] = (const float*)d_in[i];
    a.out = (float*)d_out; a.ws = (unsigned char*)d_ws;
#if N_LAUNCH_MODE == 1
    a.ph_lo = 0; a.ph_hi = 1000;
    hipLaunchKernelGGL(mega_fwd, dim3(grid), dim3(NTHREADS), LDS_BYTES, stream, a);
#else
    for (int ph = 0; ph < 65; ++ph) { a.ph_lo = ph; a.ph_hi = ph + 1; hipLaunchKernelGGL(mega_fwd, dim3(grid), dim3(NTHREADS), LDS_BYTES, stream, a); }
#endif
}
```

```cpp
#include <hip/hip_runtime.h>
#include <cstdio>
#include <cstdint>

#ifndef NAIVE_MIX
#define NAIVE_MIX 1
#endif
#ifndef CH_ML
#define CH_ML 1
#endif
#ifndef CH_RET
#define CH_RET 1
#endif
#ifndef CH_GLA
#define CH_GLA 1
#endif
#ifndef CH_S5
#define CH_S5 1
#endif
#ifndef PROBE_CLS
#define PROBE_CLS 0
#endif
#define REPS(c) ((PROBE_CLS == (c) || PROBE_CLS == 100 + layer * 10 + (c)) ? 2 : 1)
#ifndef PROBE_T
#define PROBE_T -1
#endif
#ifndef PROBE_T2
#define PROBE_T2 PROBE_T
#endif
#ifndef MOE_ALIGN
#define MOE_ALIGN true
#endif
#ifndef N_LAUNCH_MODE
#define N_LAUNCH_MODE 1
#endif


#ifdef SKIP_ML
constexpr bool defined_SKIP_ML = true;
#else
constexpr bool defined_SKIP_ML = false;
#endif
#ifdef SKIP_RET
constexpr bool defined_SKIP_RET = true;
#else
constexpr bool defined_SKIP_RET = false;
#endif
#ifdef SKIP_GLA
constexpr bool defined_SKIP_GLA = true;
#else
constexpr bool defined_SKIP_GLA = false;
#endif
#ifdef SKIP_S5
constexpr bool defined_SKIP_S5 = true;
#else
constexpr bool defined_SKIP_S5 = false;
#endif
#ifdef SKIP_LN1
constexpr bool defined_SKIP_LN1 = true;
#else
constexpr bool defined_SKIP_LN1 = false;
#endif
#ifdef SKIP_P0
constexpr bool defined_SKIP_P0 = true;
#else
constexpr bool defined_SKIP_P0 = false;
#endif
#ifndef PHMASK
#define PHMASK 0xffff
#endif
#define PHE(b) (((PHMASK) >> (b)) & 1)
#define GAS __attribute__((address_space(1)))
#define LAS __attribute__((address_space(3)))
typedef unsigned short bf16;
typedef short bf16x8 __attribute__((ext_vector_type(8)));
typedef float f32x4 __attribute__((ext_vector_type(4)));
typedef float f32x2 __attribute__((ext_vector_type(2)));
typedef unsigned u32x4 __attribute__((ext_vector_type(4)));
typedef unsigned u32x2 __attribute__((ext_vector_type(2)));

constexpr int BATCH = 2, T = 8192, D = 1024, M = BATCH * T;
constexpr int NEXP = 32, TOPK = 4, DFF = 1024, CAP = M;
constexpr int NWAVES = 8, NTHREADS = 512;
constexpr float LN_EPS = 1e-5f;
constexpr float ALPHA = 1.681792830507429f;
constexpr int MAXTILES = (M * TOPK) / 256 + NEXP;

constexpr size_t MiB = 1u << 20;
constexpr size_t WS_CTL = 0, CTL_ZERO_BYTES = 1 * MiB;
constexpr size_t WS_WT_ML_IN = 1 * MiB;
constexpr size_t WS_WT_ML_OUT = WS_WT_ML_IN + 6 * MiB;
constexpr size_t WS_WT_RET_IN = WS_WT_ML_OUT + 2 * MiB;
constexpr size_t WS_WT_RET_OUT = WS_WT_RET_IN + 12 * MiB;
constexpr size_t WS_WT_GLA_IN = WS_WT_RET_OUT + 4 * MiB;
constexpr size_t WS_WT_GLA_OUT = WS_WT_GLA_IN + 6 * MiB;
constexpr size_t WS_WT_S5_IN = WS_WT_GLA_OUT + 2 * MiB;
constexpr size_t WS_WT_S5_GLU = WS_WT_S5_IN + 2 * MiB;
constexpr size_t WS_WT_S5_OUT = WS_WT_S5_GLU + 2 * MiB;
constexpr size_t WS_S5TAB = WS_WT_S5_OUT + 2 * MiB;
constexpr size_t WS_GB = WS_S5TAB + 1 * MiB;
constexpr size_t WS_LIST = WS_GB + 1 * MiB;
constexpr size_t WS_GW = WS_LIST + 2 * MiB;
constexpr size_t WS_WT_GU = WS_GW + 1 * MiB;
constexpr size_t WS_WT_DN = WS_WT_GU + 512 * MiB;
constexpr size_t WS_HF = WS_WT_DN + 256 * MiB;
constexpr size_t WS_XB = WS_HF + 64 * MiB;
constexpr size_t WS_ZF = WS_XB + 32 * MiB;
constexpr size_t WS_PB = WS_ZF + 64 * MiB;
constexpr size_t WS_LA = WS_PB + 192 * MiB;
constexpr size_t WS_ORAW = WS_LA + 32 * MiB;
constexpr size_t WS_YB = WS_ORAW + 128 * MiB;
constexpr size_t WS_ACT = WS_YB + 64 * MiB;
constexpr size_t WS_YS = WS_ACT + 144 * MiB;
constexpr size_t WS_XG = WS_YS + 256 * MiB;
constexpr size_t WS_UT = WS_XG + 1024 * MiB;
constexpr size_t WS_ST = WS_UT + 128 * MiB;
constexpr size_t WS_KPP = WS_ST + 64 * MiB;
constexpr size_t WS_SC = WS_KPP + 16 * MiB;
constexpr size_t WS_S5KT = WS_SC + 4 * MiB;
constexpr size_t WS_S5VT = WS_S5KT + 2 * MiB;
constexpr size_t WS_S5WT = WS_S5VT + 16 * MiB;
constexpr size_t WS_S5L64 = WS_S5WT + 16 * MiB;
constexpr size_t WS_S5SL = WS_S5L64 + 1 * MiB;
constexpr size_t WS_S5SP = WS_S5SL + 16 * MiB;
constexpr size_t WS_CS = WS_S5SP + 8 * MiB;
constexpr size_t WS_END = WS_CS + 4 * MiB;
constexpr int CW_BAR = 4096;
constexpr int CW_CNT = 16384;

constexpr int PH_BYTES = 139264;
constexpr int TAB_OFF = PH_BYTES;
constexpr int MISC_OFF = TAB_OFF + 16384;
constexpr int LDS_BYTES = 159744;

typedef __bf16 bf16x2_t __attribute__((ext_vector_type(2)));
__device__ __forceinline__ unsigned pk2(float lo, float hi) { const f32x2 v = {lo, hi}; const bf16x2_t b = __builtin_convertvector(v, bf16x2_t); return __builtin_bit_cast(unsigned, b); }
__device__ __forceinline__ unsigned f2bf(float f) { return pk2(f, 0.f) & 0xffffu; }
__device__ __forceinline__ float bf2f(unsigned short b) { return __builtin_bit_cast(float, ((unsigned)b) << 16); }
__device__ __forceinline__ float bflo(unsigned w) { return __builtin_bit_cast(float, w << 16); }
__device__ __forceinline__ float bfhi(unsigned w) { return __builtin_bit_cast(float, w & 0xffff0000u); }
__device__ __forceinline__ int lane_id() { int l; asm volatile("v_mbcnt_lo_u32_b32 %0, -1, 0\n\tv_mbcnt_hi_u32_b32 %0, -1, %0" : "=v"(l)); return l; }
template <int CTRL> __device__ __forceinline__ float dpp_f(float v) { return __builtin_bit_cast(float, __builtin_amdgcn_update_dpp(0, __builtin_bit_cast(int, v), CTRL, 0xf, 0xf, false)); }
__device__ __forceinline__ float rl_f(float v, int l) { return __builtin_bit_cast(float, __builtin_amdgcn_readlane(__builtin_bit_cast(int, v), l)); }
__device__ __forceinline__ float wave_sum(float v) {
    v += dpp_f<0xB1>(v);
    v += dpp_f<0x4E>(v);
    v += dpp_f<0x141>(v);
    v += dpp_f<0x140>(v);
    return (rl_f(v, 0) + rl_f(v, 16)) + (rl_f(v, 32) + rl_f(v, 48));
}
__device__ __forceinline__ float row16_sum(float v) { v += dpp_f<0xB1>(v); v += dpp_f<0x4E>(v); v += dpp_f<0x141>(v); v += dpp_f<0x140>(v); return v; }
__device__ __forceinline__ float wave_max(float v) {
    v = fmaxf(v, dpp_f<0xB1>(v)); v = fmaxf(v, dpp_f<0x4E>(v)); v = fmaxf(v, dpp_f<0x141>(v)); v = fmaxf(v, dpp_f<0x140>(v));
    return fmaxf(fmaxf(rl_f(v, 0), rl_f(v, 16)), fmaxf(rl_f(v, 32), rl_f(v, 48)));
}
__device__ __forceinline__ float sigmoidf_(float x) { return __builtin_amdgcn_rcpf(1.f + __expf(-x)); }
__device__ __forceinline__ float log_sigmoidf_(float x) { return fminf(x, 0.f) - __logf(1.f + __expf(-fabsf(x))); }
__device__ __forceinline__ float gelu_tanh(float x) { const float u = 0.7978845608028654f * (x + 0.044715f * x * x * x); return x * sigmoidf_(2.f * u); }

namespace pg8 {
constexpr int BM = 256, BK = 64, HALF = 128, HTB = HALF * BK * 2, STAGE_BYTES = 8 * HTB, NXCD = 8, WGM = 8;
__host__ __device__ __forceinline__ int lds_byte(int r, int c) { const int st = (r >> 4) * 2 + (c >> 5), rr = r & 15, cc = c & 31, ob = rr * 64 + cc * 2; return st * 1024 + (ob ^ (((ob >> 9) & 1) << 5)); }
__host__ __device__ __forceinline__ void stage_rc(int b, int& R, int& C) { const int st = b / 1024, sb = b % 1024, swz = sb ^ (((sb >> 9) & 1) << 5); R = (st >> 1) * 16 + swz / 64; C = (st & 1) * 32 + (swz % 64) / 2; }
__host__ __device__ __forceinline__ int perm32(int rho) { const int n = rho >> 4, i = rho & 15; return 8 * (i >> 2) + 4 * n + (i & 3); }

struct Unit { const char* A; const char* B; int pm, pn, e, nvalid, r0, buf; };

__device__ __forceinline__ int xcd_remap(int L, int nwg) { const int q = nwg / NXCD, r = nwg % NXCD, xcd = L % NXCD, off = L / NXCD; return (xcd < r ? xcd * (q + 1) : r * (q + 1) + (xcd - r) * q) + off; }

struct DenseOrder {
    const char* A; const char* Bt; int K, nM, nN, nwg, G, c; const int* list; const float* gwl; static constexpr int a_compact = 0;
    __device__ __forceinline__ void init(const void* A_, const void* Bt_, int M_, int N_, int K_, int G_, int c_) { A = (const char*)A_; Bt = (const char*)Bt_; K = K_; nM = M_ / BM; nN = N_ / BM; nwg = nM * nN; G = G_; c = c_; list = nullptr; gwl = nullptr; }
    __device__ __forceinline__ bool next(int i, Unit& u) const {
        const long L = (long)i * G + c; if (L >= nwg) return false;
        const int wgid = xcd_remap((int)L, nwg);
        const int nig = WGM * nN, gid = wgid / nig, fm = gid * WGM, gsz = (nM - fm) < WGM ? (nM - fm) : WGM;
        u.pm = fm + ((wgid % nig) % gsz); u.pn = (wgid % nig) / gsz; u.e = 0; u.nvalid = 256; u.r0 = 0;
        u.A = A + (size_t)u.pm * 256 * K * 2; u.B = Bt + (size_t)u.pn * 256 * K * 2; return true;
    }
};
struct MoeOrder {
    const char* A; const char* Bt; const LAS int* tab;
    int K, nN, ntiles, nwg, G, c; size_t b_estride; int a_compact; const int* list; const float* gwl;
    __device__ __forceinline__ bool next(int i, Unit& u) const {
        const long L = (long)i * G + c; if (L >= nwg) return false;
        const int wgid = xcd_remap((int)L, nwg);
        const int nig = WGM * nN, gid = wgid / nig, fm = gid * WGM, gsz = (ntiles - fm) < WGM ? (ntiles - fm) : WGM;
        const int tl = fm + ((wgid % nig) % gsz); u.pm = tl; u.pn = (wgid % nig) / gsz;
        const int e = __builtin_amdgcn_readfirstlane(tab[72 + tl]); u.e = e; const int r0 = (tl - __builtin_amdgcn_readfirstlane(tab[32 + e])) * 256; const int rem = __builtin_amdgcn_readfirstlane(tab[e]) - r0; u.nvalid = rem < 256 ? rem : 256; u.r0 = r0;
        u.A = (a_compact == 2) ? A : a_compact ? A + (size_t)tl * 256 * K * 2 : A + ((size_t)e * CAP + r0) * K * 2;
        u.B = Bt + (size_t)e * b_estride + (size_t)u.pn * 256 * K * 2; return true;
    }
};

__device__ __forceinline__ unsigned cvt_pk_bf16(float lo, float hi) { unsigned r; asm volatile("v_cvt_pk_bf16_f32 %0, %1, %2" : "=v"(r) : "v"(lo), "v"(hi)); return r; }

struct EpiBf16 {
    static constexpr bool BIASTAB = false; static constexpr bool ROWINFO = false; static constexpr bool PERM = true;
    bf16* O; int ldc; const float* cs; int rot_tiles;
    __device__ __forceinline__ void operator()(const f32x4 (&acc)[2][2][4][2], const Unit& u, int wr, int wc, int fr, int fq) const {
        const int row0 = u.pm * BM + wr * 64 + fr, col0 = u.pn * BM + wc * 32 + 8 * fq;
        const bool rot = u.pn < rot_tiles; const float sc = (col0 >= 1024) ? 0.08838834764831845f : 1.f;
#pragma unroll
        for (int ai = 0; ai < 2; ++ai)
#pragma unroll
            for (int m = 0; m < 4; ++m) { const int row = row0 + ai * HALF + m * 16; bf16* rowp = O + (size_t)row * ldc + col0;
#pragma unroll
                for (int bj = 0; bj < 2; ++bj) { f32x4 v0 = acc[ai][bj][m][0], v1 = acc[ai][bj][m][1];
                    if (rot) { const float* cp = cs + ((size_t)(row & (T - 1)) * 64 + (((col0 + bj * HALF) & 127) >> 1)) * 2; const f32x4 c0 = *(const f32x4*)cp, c1 = *(const f32x4*)(cp + 4);
                        const f32x4 a0 = v0, a1 = v1;
                        v0[0] = (a0[0] * c0[0] - a0[1] * c0[1]) * sc; v0[1] = (a0[0] * c0[1] + a0[1] * c0[0]) * sc; v0[2] = (a0[2] * c0[2] - a0[3] * c0[3]) * sc; v0[3] = (a0[2] * c0[3] + a0[3] * c0[2]) * sc;
                        v1[0] = (a1[0] * c1[0] - a1[1] * c1[1]) * sc; v1[1] = (a1[0] * c1[1] + a1[1] * c1[0]) * sc; v1[2] = (a1[2] * c1[2] - a1[3] * c1[3]) * sc; v1[3] = (a1[2] * c1[3] + a1[3] * c1[2]) * sc; }
                    u32x4 w; w.x = cvt_pk_bf16(v0[0], v0[1]); w.y = cvt_pk_bf16(v0[2], v0[3]); w.z = cvt_pk_bf16(v1[0], v1[1]); w.w = cvt_pk_bf16(v1[2], v1[3]);
                    *(u32x4*)(rowp + bj * HALF) = w; } }
    }
};
struct EpiResid {
    static constexpr bool BIASTAB = false; static constexpr bool ROWINFO = false; static constexpr bool PERM = true;
    const float* __restrict__ hin; const bf16* __restrict__ hinb; bf16* __restrict__ Z;
    __device__ __forceinline__ void operator()(const f32x4 (&acc)[2][2][4][2], const Unit& u, int wr, int wc, int fr, int fq) const {
        const int row0 = u.pm * BM + wr * 64 + fr, col0 = u.pn * BM + wc * 32 + 8 * fq;
#pragma unroll
        for (int ai = 0; ai < 2; ++ai)
#pragma unroll
            for (int m = 0; m < 4; ++m) { const size_t off = (size_t)(row0 + ai * HALF + m * 16) * D + col0;
                f32x4 hv[2][2];
                if (hinb) {
#pragma unroll
                    for (int bj = 0; bj < 2; ++bj) { const u32x4 hw = *(const u32x4*)(hinb + off + bj * HALF);
                        hv[bj][0] = (f32x4){bflo(hw.x), bfhi(hw.x), bflo(hw.y), bfhi(hw.y)}; hv[bj][1] = (f32x4){bflo(hw.z), bfhi(hw.z), bflo(hw.w), bfhi(hw.w)}; }
                } else {
#pragma unroll
                    for (int bj = 0; bj < 2; ++bj)
#pragma unroll
                        for (int n = 0; n < 2; ++n) hv[bj][n] = *(const f32x4*)(hin + off + bj * HALF + n * 4);
                }
#pragma unroll
                for (int bj = 0; bj < 2; ++bj) { const f32x4 v0 = hv[bj][0] * ALPHA + acc[ai][bj][m][0], v1 = hv[bj][1] * ALPHA + acc[ai][bj][m][1];
                    u32x4 w; w.x = cvt_pk_bf16(v0[0], v0[1]); w.y = cvt_pk_bf16(v0[2], v0[3]); w.z = cvt_pk_bf16(v1[0], v1[1]); w.w = cvt_pk_bf16(v1[2], v1[3]);
                    *(u32x4*)(Z + off + bj * HALF) = w; } }
    }
};
struct EpiGlu {
    static constexpr bool BIASTAB = false; static constexpr bool ROWINFO = false; static constexpr bool PERM = true;
    const bf16* Y; const float* bias; bf16* O;
    __device__ __forceinline__ void operator()(const f32x4 (&acc)[2][2][4][2], const Unit& u, int wr, int wc, int fr, int fq) const {
        const int row0 = u.pm * BM + wr * 64 + fr, col0 = u.pn * BM + wc * 32 + 8 * fq;
#pragma unroll
        for (int ai = 0; ai < 2; ++ai)
#pragma unroll
            for (int m = 0; m < 4; ++m) { const size_t off = (size_t)(row0 + ai * HALF + m * 16) * D + col0;
#pragma unroll
                for (int bj = 0; bj < 2; ++bj) {
                    const f32x4 b0 = *(const f32x4*)(bias + col0 + bj * HALF), b1 = *(const f32x4*)(bias + col0 + bj * HALF + 4);
                    const u32x4 yw = *(const u32x4*)(Y + off + bj * HALF);
                    const f32x4 v0 = acc[ai][bj][m][0] + b0, v1 = acc[ai][bj][m][1] + b1;
                    float o[8];
                    o[0] = bflo(yw.x) * sigmoidf_(v0[0]); o[1] = bfhi(yw.x) * sigmoidf_(v0[1]); o[2] = bflo(yw.y) * sigmoidf_(v0[2]); o[3] = bfhi(yw.y) * sigmoidf_(v0[3]);
                    o[4] = bflo(yw.z) * sigmoidf_(v1[0]); o[5] = bfhi(yw.z) * sigmoidf_(v1[1]); o[6] = bflo(yw.w) * sigmoidf_(v1[2]); o[7] = bfhi(yw.w) * sigmoidf_(v1[3]);
                    u32x4 w; w.x = cvt_pk_bf16(o[0], o[1]); w.y = cvt_pk_bf16(o[2], o[3]); w.z = cvt_pk_bf16(o[4], o[5]); w.w = cvt_pk_bf16(o[6], o[7]);
                    *(u32x4*)(O + off + bj * HALF) = w; } }
    }
};
struct EpiSwiglu {
    static constexpr bool BIASTAB = true; static constexpr bool ROWINFO = false; static constexpr bool PERM = true;
    bf16* ACT; const float* bgu; const LAS float* btab;
    __device__ __forceinline__ float bias_at(const Unit& u, int j) const { return bgu[(size_t)u.e * 2 * DFF + (j < HALF ? 0 : DFF) + u.pn * HALF + (j & (HALF - 1))]; }
    __device__ __forceinline__ void operator()(const f32x4 (&acc)[2][2][4][2], const Unit& u, int wr, int wc, int fr, int fq) const {
        const int row0 = u.pm * BM + wr * 64 + fr, j0 = u.pn * HALF + wc * 32 + 8 * fq;
        const LAS float* bt = btab + u.buf * 256 + wc * 32 + 8 * fq;
        const f32x4 g0 = *(const LAS f32x4*)(bt), g1 = *(const LAS f32x4*)(bt + 4), u0 = *(const LAS f32x4*)(bt + HALF), u1 = *(const LAS f32x4*)(bt + HALF + 4);
#pragma unroll
        for (int ai = 0; ai < 2; ++ai)
#pragma unroll
            for (int m = 0; m < 4; ++m) {
                float o[8];
#pragma unroll
                for (int n = 0; n < 2; ++n)
#pragma unroll
                    for (int i = 0; i < 4; ++i) {
                        float g = acc[ai][0][m][n][i] + (n ? g1[i] : g0[i]), up = acc[ai][1][m][n][i] + (n ? u1[i] : u0[i]);
                        g = fminf(g, 7.0f); up = fminf(fmaxf(up, -7.0f), 7.0f);
                        o[n * 4 + i] = (up + 1.0f) * g * sigmoidf_(1.702f * g); }
                u32x4 w; w.x = cvt_pk_bf16(o[0], o[1]); w.y = cvt_pk_bf16(o[2], o[3]); w.z = cvt_pk_bf16(o[4], o[5]); w.w = cvt_pk_bf16(o[6], o[7]);
                *(u32x4*)(ACT + (size_t)(row0 + ai * HALF + m * 16) * DFF + j0) = w; }
    }
};
struct EpiMoeDown {
    static constexpr bool BIASTAB = true; static constexpr bool ROWINFO = true; static constexpr bool PERM = true;
    bf16* YS; const float* bd; const LAS int* rinfo; const LAS float* btab;
    __device__ __forceinline__ float bias_at(const Unit& u, int j) const { return bd[(size_t)u.e * D + u.pn * BM + j]; }
    __device__ __forceinline__ void operator()(const f32x4 (&acc)[2][2][4][2], const Unit& u, int wr, int wc, int fr, int fq) const {
        const int col0 = u.pn * BM + wc * 32 + 8 * fq;
        const LAS float* bt = btab + u.buf * 256 + wc * 32 + 8 * fq;
        f32x4 bv[2][2];
#pragma unroll
        for (int bj = 0; bj < 2; ++bj)
#pragma unroll
            for (int n = 0; n < 2; ++n) bv[bj][n] = *(const LAS f32x4*)(bt + bj * HALF + 4 * n);
        const LAS int* ri = rinfo + u.buf * 512;
#pragma unroll
        for (int ai = 0; ai < 2; ++ai)
#pragma unroll
            for (int m = 0; m < 4; ++m) { const int r = ai * HALF + wr * 64 + m * 16 + fr; const int slot = ri[r];
                if (slot >= 0) { const float gg = __builtin_bit_cast(float, ri[256 + r]); bf16* op = YS + (size_t)slot * D + col0;
#pragma unroll
                    for (int bj = 0; bj < 2; ++bj) { const f32x4 v0 = (acc[ai][bj][m][0] + bv[bj][0]) * gg, v1 = (acc[ai][bj][m][1] + bv[bj][1]) * gg;
                        u32x4 w; w.x = cvt_pk_bf16(v0[0], v0[1]); w.y = cvt_pk_bf16(v0[2], v0[3]); w.z = cvt_pk_bf16(v1[0], v1[1]); w.w = cvt_pk_bf16(v1[2], v1[3]);
                        *(u32x4*)(op + bj * HALF) = w; } } }
    }
};

template <class Epi, class Sched, bool ALIGN_EPI, bool SP2, bool GATHER = false>
__device__ __forceinline__ void gemm_phase(LAS unsigned char* lds, const int wid, const int K, const Sched& S, const Epi& E, LAS int* rowtab = nullptr) {
    const int lane = lane_id(), tid = wid * 64 + lane, wr = wid >> 2, wc = wid & 3, fr = lane & 15, fq = lane >> 4;
    const int nt = K / BK;
    unsigned voffA[2], voffB[2]; int Rr[2]; unsigned Cc2[2];
#pragma unroll
    for (int i = 0; i < 2; ++i) { int R, C; stage_rc(tid * 16 + i * 8192, R, C); const int Rb = Epi::PERM ? ((R & ~31) + perm32(R & 31)) : R;
        voffA[i] = (unsigned)(R * K + C) * 2u; voffB[i] = (unsigned)(Rb * K + C) * 2u; Rr[i] = R; Cc2[i] = (unsigned)C * 2u; }
    unsigned vA[2][2] = {{0u, 0u}, {0u, 0u}}, vN[2][2] = {{0u, 0u}, {0u, 0u}};
    const size_t kstep = (size_t)(BK * 2);
    const size_t hstep = (size_t)HALF * K * 2;
    const unsigned ldsw = (unsigned)wid * 1024u;
    const int aoff = lds_byte(wr * 64 + fr, fq * 8), boff = lds_byte(wc * 32 + fr, fq * 8);
#define PG8_SA(b, h) (((b) * 2 + (h)) * HTB)
#define PG8_SB(b, h) ((4 + (b) * 2 + (h)) * HTB)
#define PG8_STAGE(bufoff, gbase, voff) do { _Pragma("unroll") for (int _i = 0; _i < 2; ++_i) \
        __builtin_amdgcn_global_load_lds((const unsigned*)((const char*)(gbase) + (voff)[_i]), (LAS unsigned*)(lds + (bufoff) + ldsw + _i * 8192), 16, 0, 0); } while (0)
#define PG8_STAGE_A(bufoff, kbase, h, VO) do { if constexpr (GATHER) { PG8_STAGE(bufoff, kbase, (VO)[h]); } else { PG8_STAGE(bufoff, (kbase) + (h) * hstep, voffA); } } while (0)
#define PG8_FILL(buf, U) do { if (tid < 256) { const bool ok_ = tid < (U).nvalid; const int ent_ = (ok_ && (S.a_compact == 2 || Epi::ROWINFO)) ? S.list[(size_t)(U).e * CAP + (U).r0 + tid] : 0; \
        rowtab[(buf) * 256 + tid] = (S.a_compact == 2) ? (ent_ >> 2) * (K * 2) : tid * (K * 2); \
        if constexpr (Epi::ROWINFO) { rowtab[768 + (buf) * 512 + tid] = ok_ ? ent_ : -1; rowtab[768 + (buf) * 512 + 256 + tid] = ok_ ? __builtin_bit_cast(int, S.gwl[(size_t)(U).e * CAP + (U).r0 + tid]) : 0; } } \
        if constexpr (Epi::BIASTAB) { if (tid >= 256) rowtab[2304 + (buf) * 256 + (tid - 256)] = __builtin_bit_cast(int, E.bias_at((U), tid - 256)); } } while (0)
#define PG8_LOADVO(VO, buf) do { _Pragma("unroll") for (int h_ = 0; h_ < 2; ++h_) _Pragma("unroll") for (int i_ = 0; i_ < 2; ++i_) (VO)[h_][i_] = (unsigned)rowtab[(buf) * 256 + h_ * 128 + Rr[i_]] + Cc2[i_]; } while (0)
#define PG8_LDA(dst, b, h) do { _Pragma("unroll") for (int m = 0; m < 4; ++m) _Pragma("unroll") for (int k = 0; k < 2; ++k) dst[m][k] = *(const LAS bf16x8*)(lds + PG8_SA(b, h) + aoff + m * 2048 + k * 1024); } while (0)
#define PG8_LDB(dst, b, h) do { _Pragma("unroll") for (int n = 0; n < 2; ++n) _Pragma("unroll") for (int k = 0; k < 2; ++k) dst[n][k] = *(const LAS bf16x8*)(lds + PG8_SB(b, h) + boff + n * 2048 + k * 1024); } while (0)
#define PG8_MMA(ai, bj, At, Bt) do { __builtin_amdgcn_s_setprio(1); _Pragma("unroll") for (int m = 0; m < 4; ++m) _Pragma("unroll") for (int n = 0; n < 2; ++n) _Pragma("unroll") for (int k = 0; k < 2; ++k) \
        acc[ai][bj][m][n] = __builtin_amdgcn_mfma_f32_16x16x32_bf16(Bt[n][k], At[m][k], acc[ai][bj][m][n], 0, 0, 0); __builtin_amdgcn_s_setprio(0); } while (0)
#define PG8_WAIT_V(n) asm volatile("s_waitcnt vmcnt(" #n ")" ::: "memory")
#define PG8_WAIT_L(n) asm volatile("s_waitcnt lgkmcnt(" #n ")" ::: "memory")
#define PG8_BAR __builtin_amdgcn_s_barrier()
#define PG8_SCHED __builtin_amdgcn_sched_barrier(0)
#define VO_a1 vA
#define VO_cA vA
#define VO_a2 vS
#define VO_a3 vS
    Unit cur, nxt; int ui = 0;
    if (!S.next(0, cur)) return;
    f32x4 acc[2][2][4][2];
#pragma unroll
    for (int a = 0; a < 2; ++a)
#pragma unroll
        for (int b = 0; b < 2; ++b)
#pragma unroll
            for (int m = 0; m < 4; ++m)
#pragma unroll
                for (int n = 0; n < 2; ++n) acc[a][b][m][n] = (f32x4){0.f, 0.f, 0.f, 0.f};
    bf16x8 At[4][2], B0[2][2], B1[2][2];
    const char* cA = cur.A; const char* cB = cur.B;
    cur.buf = 0;
    if constexpr (GATHER) { PG8_FILL(0, cur); asm volatile("s_waitcnt lgkmcnt(0)" ::: "memory"); PG8_BAR; asm volatile("" ::: "memory"); PG8_LOADVO(vA, 0); }
    if constexpr (SP2) {
        PG8_STAGE(PG8_SB(0, 0), cB, voffB); PG8_STAGE(PG8_SB(0, 1), cB + hstep, voffB); PG8_STAGE_A(PG8_SA(0, 0), cA, 0, VO_cA); PG8_STAGE_A(PG8_SA(0, 1), cA, 1, VO_cA);
        if (wr == 1) PG8_BAR;
        PG8_WAIT_V(2); PG8_BAR;
        PG8_STAGE(PG8_SB(1, 0), cB + kstep, voffB); PG8_STAGE_A(PG8_SA(1, 0), cA + kstep, 0, VO_cA); PG8_STAGE(PG8_SB(1, 1), cB + hstep + kstep, voffB);
        PG8_WAIT_V(6); PG8_BAR;
    } else {
        PG8_STAGE(PG8_SB(0, 0), cB, voffB); PG8_STAGE_A(PG8_SA(0, 0), cA, 0, VO_cA); PG8_STAGE(PG8_SB(0, 1), cB + hstep, voffB); PG8_STAGE_A(PG8_SA(0, 1), cA, 1, VO_cA);
        if (wr == 1) PG8_BAR;
        PG8_WAIT_V(4); PG8_BAR;
        PG8_STAGE(PG8_SB(1, 0), cB + kstep, voffB); PG8_STAGE_A(PG8_SA(1, 0), cA + kstep, 0, VO_cA); PG8_STAGE(PG8_SB(1, 1), cB + hstep + kstep, voffB);
        PG8_WAIT_V(6); PG8_BAR;
    }
    for (;;) {
        const bool has_next = S.next(ui + 1, nxt);
        const char* nA = has_next ? nxt.A : cA; const char* nB = has_next ? nxt.B : cB;
        nxt.buf = (ui + 1) % 3;
        if constexpr (GATHER) { if (has_next) PG8_FILL((ui + 1) % 3, nxt); }
        for (int t = 0; t < nt; t += 2) {
            const bool last = (t == nt - 2);
            const char* a1 = cA + (size_t)(t + 1) * kstep;
            const char* a2 = last ? nA : cA + (size_t)(t + 2) * kstep; const char* b2 = last ? nB : cB + (size_t)(t + 2) * kstep;
            const char* a3 = a2 + kstep; const char* b3 = b2 + kstep;
            unsigned vS[2][2];
            if constexpr (GATHER) { if (last && has_next) PG8_LOADVO(vN, (ui + 1) % 3);
#pragma unroll
                for (int h_ = 0; h_ < 2; ++h_)
#pragma unroll
                    for (int i_ = 0; i_ < 2; ++i_) vS[h_][i_] = (last && has_next) ? vN[h_][i_] : vA[h_][i_]; }
            else { vS[0][0] = 0u; vS[0][1] = 0u; vS[1][0] = 0u; vS[1][1] = 0u; }
            if constexpr (SP2) {
            PG8_LDB(B0, 0, 0); PG8_LDB(B1, 0, 1); PG8_SCHED; PG8_LDA(At, 0, 0); PG8_STAGE_A(PG8_SA(1, 1), a1, 1, VO_a1);
            PG8_WAIT_V(8); PG8_WAIT_L(0); PG8_BAR; PG8_MMA(0, 0, At, B0); PG8_MMA(0, 1, At, B1); PG8_BAR; PG8_SCHED;
            PG8_LDA(At, 0, 1); PG8_STAGE(PG8_SB(0, 0), b2, voffB); PG8_STAGE(PG8_SB(0, 1), b2 + hstep, voffB); PG8_STAGE_A(PG8_SA(0, 0), a2, 0, VO_a2);
            PG8_WAIT_V(8); PG8_WAIT_L(0); PG8_BAR; PG8_MMA(1, 0, At, B0); PG8_MMA(1, 1, At, B1); PG8_BAR; PG8_SCHED;
            PG8_LDB(B0, 1, 0); PG8_LDB(B1, 1, 1); PG8_SCHED; PG8_LDA(At, 1, 0); PG8_STAGE_A(PG8_SA(0, 1), a2, 1, VO_a2);
            PG8_WAIT_V(8); PG8_WAIT_L(0); PG8_BAR; PG8_MMA(0, 0, At, B0); PG8_MMA(0, 1, At, B1); PG8_BAR; PG8_SCHED;
            PG8_LDA(At, 1, 1); PG8_STAGE(PG8_SB(1, 0), b3, voffB); PG8_STAGE(PG8_SB(1, 1), b3 + hstep, voffB); PG8_STAGE_A(PG8_SA(1, 0), a3, 0, VO_a3);
            PG8_WAIT_V(8); PG8_WAIT_L(0); PG8_BAR; PG8_MMA(1, 0, At, B0); PG8_MMA(1, 1, At, B1); PG8_BAR; PG8_SCHED;
            } else {
            PG8_LDB(B0, 0, 0); PG8_SCHED; PG8_LDA(At, 0, 0); PG8_STAGE_A(PG8_SA(1, 1), a1, 1, VO_a1);
            PG8_WAIT_L(8); PG8_BAR; PG8_WAIT_L(0); PG8_MMA(0, 0, At, B0); PG8_BAR; PG8_SCHED;
            PG8_LDB(B1, 0, 1); PG8_STAGE(PG8_SB(0, 0), b2, voffB);
            PG8_BAR; PG8_WAIT_L(0); PG8_MMA(0, 1, At, B1); PG8_BAR;
            PG8_LDA(At, 0, 1); PG8_STAGE_A(PG8_SA(0, 0), a2, 0, VO_a2);
            PG8_BAR; PG8_WAIT_L(0); PG8_MMA(1, 0, At, B0); PG8_BAR; PG8_SCHED;
            PG8_STAGE(PG8_SB(0, 1), b2 + hstep, voffB);
            PG8_WAIT_V(6); PG8_BAR; PG8_MMA(1, 1, At, B1); PG8_BAR;
            PG8_LDB(B0, 1, 0); PG8_SCHED; PG8_LDA(At, 1, 0); PG8_STAGE_A(PG8_SA(0, 1), a2, 1, VO_a2);
            PG8_WAIT_L(8); PG8_BAR; PG8_WAIT_L(0); PG8_MMA(0, 0, At, B0); PG8_BAR; PG8_SCHED;
            PG8_LDB(B1, 1, 1); PG8_STAGE(PG8_SB(1, 0), b3, voffB);
            PG8_BAR; PG8_WAIT_L(0); PG8_MMA(0, 1, At, B1); PG8_BAR;
            PG8_LDA(At, 1, 1); PG8_STAGE_A(PG8_SA(1, 0), a3, 0, VO_a3);
            PG8_BAR; PG8_WAIT_L(0); PG8_MMA(1, 0, At, B0); PG8_BAR; PG8_SCHED;
            PG8_STAGE(PG8_SB(1, 1), b3 + hstep, voffB);
            PG8_WAIT_V(6); PG8_BAR; PG8_MMA(1, 1, At, B1); PG8_BAR;
            }
        }
        if constexpr (ALIGN_EPI) { if (wr == 0) PG8_BAR; }
        E(acc, cur, wr, wc, fr, fq);
        if (!has_next) break;
#pragma unroll
        for (int a = 0; a < 2; ++a)
#pragma unroll
            for (int b = 0; b < 2; ++b)
#pragma unroll
                for (int m = 0; m < 4; ++m)
#pragma unroll
                    for (int n = 0; n < 2; ++n) acc[a][b][m][n] = (f32x4){0.f, 0.f, 0.f, 0.f};
        cur = nxt; cA = nA; cB = nB; ++ui;
        if constexpr (GATHER) { vA[0][0] = vN[0][0]; vA[0][1] = vN[0][1]; vA[1][0] = vN[1][0]; vA[1][1] = vN[1][1]; }
        if constexpr (ALIGN_EPI) { if (wr == 1) PG8_BAR; }
    }
    PG8_WAIT_V(0);
    if constexpr (!ALIGN_EPI) { if (wr == 0) PG8_BAR; }
    PG8_BAR;
#undef PG8_SA
#undef PG8_SB
#undef PG8_STAGE
#undef PG8_STAGE_A
#undef PG8_FILL
#undef PG8_LOADVO
#undef VO_a1
#undef VO_cA
#undef VO_a2
#undef VO_a3
#undef PG8_LDA
#undef PG8_LDB
#undef PG8_MMA
#undef PG8_WAIT_V
#undef PG8_WAIT_L
#undef PG8_BAR
#undef PG8_SCHED
}
}

#define XB_TMO      128
#define XB_XCNT(j)  (256  + 64 * (j))
#define XB_XSUB(j)  (1280 + 64 * (j))
#define XB_XGEN(j)  (2304 + 64 * (j))
#define XB_TOP      3328
#define XB_TOPGEN   3392
#define XCD_BAR_WORDS 3456
#define XB_SPIN_CAP (1u << 18)
__device__ __forceinline__ unsigned xb_ld(unsigned* p)              { return __hip_atomic_load(p, __ATOMIC_RELAXED, __HIP_MEMORY_SCOPE_AGENT); }
__device__ __forceinline__ unsigned xb_add(unsigned* p, unsigned v) { return __hip_atomic_fetch_add(p, v, __ATOMIC_RELAXED, __HIP_MEMORY_SCOPE_AGENT); }
__device__ __forceinline__ unsigned xb_xcc_id() { return (unsigned)__builtin_amdgcn_s_getreg((3 << 11) | 20) & 0xFu; }
#define XB_SPIN(cond, bar) do { unsigned _sp = 0; while (cond) { __builtin_amdgcn_s_sleep(1); \
    if ((++_sp & 255u) == 0u) { if (xb_ld(&(bar)[XB_TMO])) break; if (_sp > XB_SPIN_CAP) { atomicAdd(&(bar)[XB_TMO], 1u); break; } } } } while (0)
struct XcdBarrier { unsigned* bar; unsigned x; volatile LAS unsigned* st; };
__device__ __forceinline__ XcdBarrier xcd_barrier_post(unsigned* bar, volatile LAS unsigned* st, bool leader) {
    XcdBarrier b; b.bar = bar; b.x = xb_xcc_id(); b.st = st;
    if (leader) (void)xb_add(&bar[XB_XCNT(b.x)], 1u);
    return b;
}
__device__ __forceinline__ void xcd_barrier_complete(unsigned* bar, unsigned x, unsigned& nloc, unsigned& nx) {
    const unsigned G = gridDim.x * gridDim.y * gridDim.z;
    unsigned sum, cnt, mine, sp = 0u;
    for (;;) {
        sum = 0u; cnt = 0u; mine = 0u;
#pragma unroll
        for (unsigned j = 0; j < 16; ++j) { const unsigned c = xb_ld(&bar[XB_XCNT(j)]); sum += c; cnt += (c > 0u) ? 1u : 0u; mine = (j == x) ? c : mine; }
        if (sum == G) break;
        __builtin_amdgcn_s_sleep(1);
        if ((++sp & 255u) == 0u) { if (xb_ld(&bar[XB_TMO])) break; if (sp > XB_SPIN_CAP) { atomicAdd(&bar[XB_TMO], 1u); break; } }
    }
    nloc = mine > 0u ? mine : 1u; nx = cnt > 0u ? cnt : 1u;
}
__device__ __forceinline__ void xcd_barrier(const XcdBarrier& b, int wave) {
    asm volatile("s_waitcnt vmcnt(0)" ::: "memory");
    __syncthreads();
    if (wave == 0 && lane_id() == 0) {
        unsigned* bar = b.bar;
        __builtin_amdgcn_s_waitcnt(0);
        unsigned nloc = b.st[0], nx = b.st[1];
        if (nloc == 0u) { xcd_barrier_complete(bar, b.x, nloc, nx); b.st[0] = nloc; b.st[1] = nx; }
        const unsigned old = xb_add(&bar[XB_XSUB(b.x)], 1u);
        const unsigned gen = old / nloc;
        if (old + 1u == (gen + 1u) * nloc) {
            __builtin_amdgcn_fence(__ATOMIC_RELEASE, "agent");
            asm volatile("s_waitcnt vmcnt(0)" ::: "memory");
            const unsigned og = xb_add(&bar[XB_TOP], 1u);
            const unsigned tg = og / nx;
            if (og + 1u == (tg + 1u) * nx) xb_add(&bar[XB_TOPGEN], 1u);
            else XB_SPIN(xb_ld(&bar[XB_TOPGEN]) == tg, bar);
            __builtin_amdgcn_fence(__ATOMIC_ACQUIRE, "agent");
            xb_add(&bar[XB_XGEN(b.x)], 1u);
            asm volatile("s_waitcnt vmcnt(0)" ::: "memory");
        } else {
            XB_SPIN(xb_ld(&bar[XB_XGEN(b.x)]) == gen, bar);
            __builtin_amdgcn_fence(__ATOMIC_ACQUIRE, "agent");
            asm volatile("s_waitcnt vmcnt(0)" ::: "memory");
        }
    }
    __syncthreads();
}

struct Args { const float* in[33]; float* out; unsigned char* ws; int ph_lo, ph_hi; };
struct Frame {
    LAS unsigned char* lds;
    int wave, vcu, G, gw, NGW;
};

__device__ __forceinline__ void transpose_item(const float* W, int ldw, int col_off, int K, bf16* WT, int mode, int kb, int nb, LAS unsigned char* scr, int lane) {
    const int k0 = 64 * kb, n0 = 64 * nb;
    const float* src = W + (size_t)k0 * ldw + col_off + n0;
    f32x4 v[16];
#pragma unroll
    for (int i = 0; i < 16; ++i) v[i] = __builtin_nontemporal_load((const f32x4*)(src + (size_t)((lane >> 4) + 4 * i) * ldw + 4 * (lane & 15)));
#pragma unroll
    for (int i = 0; i < 16; ++i) { LAS unsigned* p = (LAS unsigned*)(scr + ((lane >> 4) + 4 * i) * 132 + 8 * (lane & 15)); p[0] = pk2(v[i][0], v[i][1]); p[1] = pk2(v[i][2], v[i][3]); }
    asm volatile("s_waitcnt lgkmcnt(0)" ::: "memory");
    const int c = lane >> 3, nl = lane & 7;
#pragma unroll
    for (int r = 0; r < 8; ++r) { const int n = nl + 8 * r; const LAS unsigned short* s = (const LAS unsigned short*)(scr + (8 * c) * 132 + 2 * n);
        u32x4 o; o.x = (unsigned)s[0] | ((unsigned)s[66] << 16); o.y = (unsigned)s[132] | ((unsigned)s[198] << 16); o.z = (unsigned)s[264] | ((unsigned)s[330] << 16); o.w = (unsigned)s[396] | ((unsigned)s[462] << 16);
        const int ng = n0 + n; int drow = ng; if (mode == 1) { drow = ng < 1024 ? 256 * (ng >> 7) + (ng & 127) : 256 * ((ng - 1024) >> 7) + 128 + (ng & 127); }
        if (mode == 2 && ng < 2048) { const int i_ = ng & 127; drow = (ng & ~127) + (i_ < 64 ? 2 * i_ : 2 * (i_ - 64) + 1); }
        __builtin_nontemporal_store(o, (u32x4*)(WT + (size_t)drow * K + k0 + 8 * c)); }
    asm volatile("s_waitcnt lgkmcnt(0)" ::: "memory");
}

__device__ __forceinline__ void load_cols16(int tid, const float* W, int ldw, int col_off, LAS float* Wt) {
    f32x4 wv[8];
#pragma unroll
    for (int i = 0; i < 8; ++i) { const int q = tid + i * NTHREADS, k = q >> 2, e0 = (q & 3) * 4; wv[i] = *(const f32x4*)(W + (size_t)k * ldw + col_off + e0); }
#pragma unroll
    for (int i = 0; i < 8; ++i) { const int q = tid + i * NTHREADS, k = q >> 2, e0 = (q & 3) * 4;
        Wt[(e0 + 0) * 1028 + k] = wv[i][0]; Wt[(e0 + 1) * 1028 + k] = wv[i][1]; Wt[(e0 + 2) * 1028 + k] = wv[i][2]; Wt[(e0 + 3) * 1028 + k] = wv[i][3]; }
}
__device__ __forceinline__ float row_dot16(const f32x4 (&v)[4], const LAS float* Wt, int lane) {
    float p[16];
#pragma unroll
    for (int e = 0; e < 16; ++e) { float s = 0.f;
#pragma unroll
        for (int j = 0; j < 4; ++j) { const f32x4 w = *(const LAS f32x4*)(Wt + e * 1028 + 4 * (lane + 64 * j)); s += v[j][0] * w[0] + v[j][1] * w[1] + v[j][2] * w[2] + v[j][3] * w[3]; }
        p[e] = s; }
    float a8[8], a4[4], a2[2], r1;
#pragma unroll
    for (int e = 0; e < 8; ++e) { const auto r = __builtin_amdgcn_permlane32_swap(__builtin_bit_cast(unsigned, p[e]), __builtin_bit_cast(unsigned, p[e + 8]), false, false); a8[e] = __builtin_bit_cast(float, (unsigned)r[0]) + __builtin_bit_cast(float, (unsigned)r[1]); }
#pragma unroll
    for (int e = 0; e < 4; ++e) { const auto r = __builtin_amdgcn_permlane16_swap(__builtin_bit_cast(unsigned, a8[e]), __builtin_bit_cast(unsigned, a8[e + 4]), false, false); a4[e] = __builtin_bit_cast(float, (unsigned)r[0]) + __builtin_bit_cast(float, (unsigned)r[1]); }
    { const bool hi = (lane & 8) != 0;
#pragma unroll
      for (int e = 0; e < 2; ++e) { const float mine = hi ? a4[e + 2] : a4[e], theirs = hi ? a4[e] : a4[e + 2]; a2[e] = mine + dpp_f<0x128>(theirs); } }
    { const bool hi = (lane & 4) != 0; const float mine = hi ? a2[1] : a2[0], theirs = hi ? a2[0] : a2[1]; r1 = mine + dpp_f<0x141>(theirs); }
    r1 += dpp_f<0x4E>(r1); r1 += dpp_f<0xB1>(r1);
    return r1;
}
__device__ __forceinline__ void store_row_bf16(bf16* orow, const f32x4 (&v)[4], int lane) {
    unsigned long long* o8 = (unsigned long long*)orow + lane;
#pragma unroll
    for (int j = 0; j < 4; ++j) o8[64 * j] = (unsigned long long)pk2(v[j][0], v[j][1]) | ((unsigned long long)pk2(v[j][2], v[j][3]) << 32);
}
__device__ __forceinline__ void store_row_f32(float* orow, const f32x4 (&v)[4], int lane) {
    f32x4* o = (f32x4*)orow + lane;
#pragma unroll
    for (int j = 0; j < 4; ++j) o[64 * j] = v[j];
}
__device__ __forceinline__ void load_row_f32(const float* row, f32x4 (&v)[4], int lane) {
    const f32x4* p = (const f32x4*)row + lane;
#pragma unroll
    for (int j = 0; j < 4; ++j) v[j] = p[64 * j];
}
__device__ __forceinline__ void ln_row(f32x4 (&v)[4], const f32x4 (&gv)[4], const f32x4 (&bv)[4]) {
    float s = 0.f;
#pragma unroll
    for (int j = 0; j < 4; ++j) s += (v[j][0] + v[j][1]) + (v[j][2] + v[j][3]);
    const float mean = wave_sum(s) * (1.f / D); float s2 = 0.f;
#pragma unroll
    for (int j = 0; j < 4; ++j) { v[j] = v[j] - mean; s2 += (v[j][0] * v[j][0] + v[j][1] * v[j][1]) + (v[j][2] * v[j][2] + v[j][3] * v[j][3]); }
    const float rstd = __builtin_amdgcn_rsqf(wave_sum(s2) * (1.f / D) + LN_EPS);
#pragma unroll
    for (int j = 0; j < 4; ++j) v[j] = v[j] * rstd * gv[j] + bv[j];
}

__device__ __forceinline__ const float* inp_ptr(LAS unsigned char* lds, int i) {
    const LAS unsigned* p = (const LAS unsigned*)(lds + MISC_OFF + 256) + 2 * i;
    const unsigned lo = __builtin_amdgcn_readfirstlane(p[0]), hi = __builtin_amdgcn_readfirstlane(p[1]);
    return (const float*)(const GAS float*)(((unsigned long long)hi << 32) | lo);
}

__device__ __forceinline__ void stamp_fn(LAS unsigned char* lds, int wave, int k) {
    if (blockIdx.x == 0 && wave == 0 && lane_id() == 0) { volatile LAS unsigned long long* st = (volatile LAS unsigned long long*)(lds + MISC_OFF + 1024);
        const unsigned long long now = __builtin_amdgcn_s_memrealtime(); if (k >= PROBE_T && k <= PROBE_T2) st[1] = st[1] + (now - st[0]); st[0] = now; }
}
typedef short s16x4 __attribute__((ext_vector_type(4)));
typedef short v4i16_t __attribute__((ext_vector_type(4)));
constexpr int CL = 128, NCH = T / CL;
template <int MODE> struct MX;
template <> struct MX<0> { static constexpr int NH = 8, DK = 64,  DV = 128, LDP = 3072, KOFF = 512,  VOFF = 1024, GOFF = 2048; };
template <> struct MX<1> { static constexpr int NH = 8, DK = 128, DV = 256, LDP = 6144, KOFF = 1024, VOFF = 2048, GOFF = 4096; };
template <> struct MX<2> { static constexpr int NH = 4, DK = 128, DV = 256, LDP = 3072, KOFF = 512,  VOFF = 1024, GOFF = 2048; };
__device__ __forceinline__ s16x4 ds_tr(const LAS unsigned char* p) { return __builtin_bit_cast(s16x4, __builtin_amdgcn_ds_read_tr16_b64_v4i16((LAS v4i16_t*)p)); }
__device__ __forceinline__ bf16x8 tr_frag(const LAS unsigned char* base, int pitch, int k0, int n0, int lane) {
    const int g = lane >> 4, q = (lane & 15) >> 2, p = lane & 3;
    const LAS unsigned char* a = base + (k0 + 4 * g + q) * pitch + (n0 + 4 * p) * 2;
    const s16x4 r1 = ds_tr(a), r2 = ds_tr(a + 16 * pitch);
    bf16x8 f; f[0] = r1[0]; f[1] = r1[1]; f[2] = r1[2]; f[3] = r1[3]; f[4] = r2[0]; f[5] = r2[1]; f[6] = r2[2]; f[7] = r2[3]; return f;
}
__device__ __forceinline__ u32x4 scale_bf16x8(u32x4 v, float sc) {
    u32x4 o; o.x = pk2(bflo(v.x) * sc, bfhi(v.x) * sc); o.y = pk2(bflo(v.y) * sc, bfhi(v.y) * sc); o.z = pk2(bflo(v.z) * sc, bfhi(v.z) * sc); o.w = pk2(bflo(v.w) * sc, bfhi(v.w) * sc); return o;
}
__device__ __forceinline__ float ret_lg2gamma(int h) { return log2f(1.f - exp2f(-5.f - (float)h)); }

template <int MODE>
__device__ __forceinline__ void mix_phaseA(const Frame& F, unsigned char* ws, const int tid, const int lane) {
    typedef MX<MODE> C; constexpr int DK = C::DK, DV = C::DV, NH = C::NH, LDP = C::LDP, KP = DK * 2 + 32, VP = DV * 2 + 32, ETW = DV / 128, NDT = DK / 16;
    LAS unsigned char* ldsK = F.lds; LAS unsigned char* ldsV = F.lds + 128 * KP; LAS float* rsc = (LAS float*)(F.lds + 128 * KP + 128 * VP);
    const bf16* PB = (const bf16*)(ws + WS_PB); const bf16* KPP = (const bf16*)(ws + WS_KPP); bf16* UT = (bf16*)(ws + WS_UT);
    const float* GSC = (const float*)(ws + WS_SC); float* NLOC = (float*)(ws + WS_SC + 2 * MiB);
    const int w = F.wave, g = lane >> 4;
    for (int u = blockIdx.x; u < 2 * NH * NCH; u += F.G) {
        const int c = u % NCH, bh = u / NCH, h = bh % NH, b = bh / NH; const size_t row0 = (size_t)b * T + (size_t)c * CL;
        u32x4 kr[DK / 32], vr[DV / 32];
#pragma unroll
        for (int i = 0; i < DK / 32; ++i) { const int p = tid + i * NTHREADS, r = p / (DK / 8), cp = p % (DK / 8);
            kr[i] = (MODE == 2) ? *(const u32x4*)(KPP + (row0 + r) * 512 + h * 128 + cp * 8) : *(const u32x4*)(PB + (row0 + r) * LDP + C::KOFF + h * DK + cp * 8); }
#pragma unroll
        for (int i = 0; i < DV / 32; ++i) { const int p = tid + i * NTHREADS, r = p / (DV / 8), cp = p % (DV / 8);
            vr[i] = *(const u32x4*)(PB + (row0 + r) * LDP + C::VOFF + h * DV + cp * 8); }
        float gmax = 0.f; if (MODE == 0) gmax = GSC[(size_t)(2 * 16 + bh) * T + c * CL + 127];
        const float lgh = (MODE == 1) ? ret_lg2gamma(h) : 0.f;
        __syncthreads();
#pragma unroll
        for (int i = 0; i < DK / 32; ++i) { const int p = tid + i * NTHREADS, r = p / (DK / 8), cp = p % (DK / 8);
            u32x4 v = kr[i];
            if (MODE == 0) v = scale_bf16x8(v, __expf(GSC[(size_t)(1 * 16 + bh) * T + c * CL + r] - gmax));
            if (MODE == 1) v = scale_bf16x8(v, exp2f((float)(127 - r) * lgh));
            *(LAS u32x4*)(ldsK + r * KP + cp * 16) = v; }
#pragma unroll
        for (int i = 0; i < DV / 32; ++i) { const int p = tid + i * NTHREADS, r = p / (DV / 8), cp = p % (DV / 8); *(LAS u32x4*)(ldsV + r * VP + cp * 16) = vr[i]; }
        __syncthreads();
        f32x4 acc[ETW][NDT];
#pragma unroll
        for (int i = 0; i < ETW; ++i)
#pragma unroll
            for (int j = 0; j < NDT; ++j) acc[i][j] = (f32x4){0.f, 0.f, 0.f, 0.f};
#pragma unroll
        for (int ks = 0; ks < 4; ++ks) {
            bf16x8 af[ETW], bfv[NDT];
#pragma unroll
            for (int i = 0; i < ETW; ++i) af[i] = tr_frag(ldsV, VP, 32 * ks, (w * ETW + i) * 16, lane);
#pragma unroll
            for (int j = 0; j < NDT; ++j) bfv[j] = tr_frag(ldsK, KP, 32 * ks, j * 16, lane);
#pragma unroll
            for (int i = 0; i < ETW; ++i)
#pragma unroll
                for (int j = 0; j < NDT; ++j) acc[i][j] = __builtin_amdgcn_mfma_f32_16x16x32_bf16(af[i], bfv[j], acc[i][j], 0, 0, 0);
        }
        bf16* ut = UT + (size_t)u * DV * DK;
#pragma unroll
        for (int i = 0; i < ETW; ++i)
#pragma unroll
            for (int j = 0; j < NDT; ++j)
#pragma unroll
                for (int r = 0; r < 4; ++r) ut[(size_t)((w * ETW + i) * 16 + 4 * g + r) * DK + j * 16 + (lane & 15)] = (bf16)f2bf(acc[i][j][r]);
        if (MODE == 0) {
            float sacc = 0.f;
#pragma unroll
            for (int r = 0; r < 16; ++r) sacc += bf2f(*(const LAS unsigned short*)(ldsK + (16 * w + r) * KP + lane * 2));
            rsc[w * 64 + lane] = sacc;
            __syncthreads();
            if (tid < 64) { float t = 0.f;
#pragma unroll
                for (int q = 0; q < NWAVES; ++q) t += rsc[q * 64 + tid];
                NLOC[(size_t)u * 64 + tid] = t; } }
    }
    __syncthreads();
}

template <int MODE>
__device__ __forceinline__ void mix_phaseB(const Frame& F, unsigned char* ws, const int tid) {
    typedef MX<MODE> C; constexpr int DK = C::DK, DV = C::DV, NH = C::NH, NEL = DV * DK, NBH = 2 * NH;
    const bf16* UT = (const bf16*)(ws + WS_UT); bf16* ST = (bf16*)(ws + WS_ST);
    const float* GSC = (const float*)(ws + WS_SC); const float* NLOC = (const float*)(ws + WS_SC + 2 * MiB); float* NPREV = (float*)(ws + WS_SC + 2 * MiB + 256 * 1024);
    float* MPREV = (float*)(ws + WS_SC + 2 * MiB + 512 * 1024); const float* DEC = (const float*)(ws + WS_SC + 3 * MiB);
    const int gtid = blockIdx.x * NTHREADS + tid, nthr = F.G * NTHREADS;
    for (int el8 = gtid; el8 < NBH * NEL / 8; el8 += nthr) {
        const int el = el8 * 8, bh = el / NEL, idx = el - bh * NEL, h = bh % NH, b = bh / NH;
        float S[8]; float m = -1e30f;
#pragma unroll
        for (int q = 0; q < 8; ++q) S[q] = 0.f;
        const float rdec = (MODE == 1) ? exp2f(128.f * ret_lg2gamma(h)) : 1.f;
#pragma unroll 1
        for (int c0 = 0; c0 < NCH; c0 += 8) {
            u32x4 uv[8];
#pragma unroll
            for (int i = 0; i < 8; ++i) uv[i] = *(const u32x4*)(UT + (size_t)(bh * NCH + c0 + i) * NEL + idx);
#pragma unroll
            for (int i = 0; i < 8; ++i) { const int c = c0 + i; const size_t u = (size_t)bh * NCH + c;
                u32x4 o; o.x = pk2(S[0], S[1]); o.y = pk2(S[2], S[3]); o.z = pk2(S[4], S[5]); o.w = pk2(S[6], S[7]);
                *(u32x4*)(ST + u * NEL + idx) = o;
                const float u0 = bflo(uv[i].x), u1 = bfhi(uv[i].x), u2 = bflo(uv[i].y), u3 = bfhi(uv[i].y), u4 = bflo(uv[i].z), u5 = bfhi(uv[i].z), u6 = bflo(uv[i].w), u7 = bfhi(uv[i].w);
                if (MODE == 0) { const float atot = GSC[(size_t)(0 * 16 + bh) * T + c * CL + 127], mloc = atot + GSC[(size_t)(2 * 16 + bh) * T + c * CL + 127];
                    const float mnew = fmaxf(atot + m, mloc), so = __expf(atot + m - mnew), sl = __expf(mloc - mnew);
                    if (idx == 0) MPREV[u] = m;
                    S[0] = so * S[0] + sl * u0; S[1] = so * S[1] + sl * u1; S[2] = so * S[2] + sl * u2; S[3] = so * S[3] + sl * u3;
                    S[4] = so * S[4] + sl * u4; S[5] = so * S[5] + sl * u5; S[6] = so * S[6] + sl * u6; S[7] = so * S[7] + sl * u7; m = mnew; }
                else if (MODE == 1) { S[0] = rdec * S[0] + u0; S[1] = rdec * S[1] + u1; S[2] = rdec * S[2] + u2; S[3] = rdec * S[3] + u3; S[4] = rdec * S[4] + u4; S[5] = rdec * S[5] + u5; S[6] = rdec * S[6] + u6; S[7] = rdec * S[7] + u7; }
                else { const float* dp = DEC + (size_t)(b * NCH + c) * 512 + h * 128 + (idx & 127); const f32x4 d0 = *(const f32x4*)dp, d1 = *(const f32x4*)(dp + 4);
                    S[0] = d0[0] * S[0] + u0; S[1] = d0[1] * S[1] + u1; S[2] = d0[2] * S[2] + u2; S[3] = d0[3] * S[3] + u3; S[4] = d1[0] * S[4] + u4; S[5] = d1[1] * S[5] + u5; S[6] = d1[2] * S[6] + u6; S[7] = d1[3] * S[7] + u7; } }
        }
    }
    if (MODE == 0) {
        for (int el = gtid; el < NBH * 64; el += nthr) { const int bh = el >> 6, d = el & 63; float S = 0.f, m = -1e30f;
#pragma unroll 1
            for (int c0 = 0; c0 < NCH; c0 += 8) { float at[8], gm[8], nl[8];
#pragma unroll
                for (int i = 0; i < 8; ++i) { const int c = c0 + i; at[i] = GSC[(size_t)(0 * 16 + bh) * T + c * CL + 127]; gm[i] = GSC[(size_t)(2 * 16 + bh) * T + c * CL + 127]; nl[i] = NLOC[((size_t)bh * NCH + c) * 64 + d]; }
#pragma unroll
                for (int i = 0; i < 8; ++i) { const size_t u = (size_t)bh * NCH + c0 + i; const float atot = at[i], mloc = atot + gm[i];
                    const float mnew = fmaxf(atot + m, mloc), so = __expf(atot + m - mnew), sl = __expf(mloc - mnew);
                    NPREV[u * 64 + d] = S; S = so * S + sl * nl[i]; m = mnew; } } }
    }
}

template <int MODE>
__device__ __forceinline__ void mix_phaseC(const Frame& F, unsigned char* ws, const int tid, const int lane, const float* ng) {
    typedef MX<MODE> C; constexpr int DK = C::DK, DV = C::DV, NH = C::NH, LDP = C::LDP, VP = DV * 2 + 32, KP = DK * 2 + 16, SP = DK * 2 + 16, NET = DV / 16, NKS = DK / 32, DVT = NH * DV;
    constexpr int NSP = DV * DK / 8 / NTHREADS;
    LAS unsigned char* ldsV = F.lds; LAS unsigned char* ldsK = F.lds + 128 * VP; LAS unsigned char* ldsS = F.lds;
    LAS float* tabs = (LAS float*)(F.lds + 128 * VP + 128 * KP);
    static_assert(DV * SP <= 128 * VP + 128 * KP, "S^T image fits the stage-1 region");
    const bf16* PB = (const bf16*)(ws + WS_PB); const bf16* ST = (const bf16*)(ws + WS_ST);
    const float* GSC = (const float*)(ws + WS_SC); const float* NPREV = (const float*)(ws + WS_SC + 2 * MiB + 256 * 1024); const float* MPREV = (const float*)(ws + WS_SC + 2 * MiB + 512 * 1024);
    const int w = F.wave, g = lane >> 4, li = lane & 15;
    constexpr int NU = 2 * NH * NCH;
    u32x4 kr[DK / 32], vr[DV / 32], sreg[NSP];
#define PC_LOAD_KV(U_) do { const int c_ = (U_) % NCH, bh_ = (U_) / NCH, h_ = bh_ % NH, b_ = bh_ / NH; const char* pb_ = (const char*)(PB + ((size_t)b_ * T + (size_t)c_ * CL) * LDP); \
        const char* vb_ = pb_ + (C::VOFF + h_ * DV) * 2; const char* kb_ = pb_ + (C::KOFF + h_ * DK) * 2; int t_ = tid; asm volatile("" : "+v"(t_));     \
        _Pragma("unroll") for (int i = 0; i < DV / 32; ++i) { const int p = t_ + i * NTHREADS, r = p / (DV / 8), cp = p % (DV / 8); vr[i] = *(const u32x4*)(vb_ + (unsigned)(r * LDP + cp * 8) * 2u); } \
        _Pragma("unroll") for (int i = 0; i < DK / 32; ++i) { const int p = t_ + i * NTHREADS, r = p / (DK / 8), cp = p % (DK / 8); kr[i] = *(const u32x4*)(kb_ + (unsigned)(r * LDP + cp * 8) * 2u); } } while (0)
#define PC_LOAD_S(U_) do { const bf16* st_ = ST + (size_t)(U_) * DV * DK; _Pragma("unroll") for (int i = 0; i < NSP; ++i) sreg[i] = *(const u32x4*)(st_ + (size_t)(tid + i * NTHREADS) * 8); } while (0)
    if ((int)blockIdx.x < NU) { PC_LOAD_KV((int)blockIdx.x); }
    for (int u = blockIdx.x; u < NU; u += F.G) {
        const int c = u % NCH, bh = u / NCH, h = bh % NH, b = bh / NH; const size_t row0 = (size_t)b * T + (size_t)c * CL;
        const float lg = (MODE == 1) ? ret_lg2gamma(h) : 0.f;
        PC_LOAD_S(u);
        __syncthreads();
#pragma unroll
        for (int i = 0; i < DV / 32; ++i) { const int p = tid + i * NTHREADS, r = p / (DV / 8), cp = p % (DV / 8); *(LAS u32x4*)(ldsV + r * VP + cp * 16) = vr[i]; }
#pragma unroll
        for (int i = 0; i < DK / 32; ++i) { const int p = tid + i * NTHREADS, r = p / (DK / 8), cp = p % (DK / 8); *(LAS u32x4*)(ldsK + r * KP + cp * 16) = kr[i]; }
        if (u + F.G < NU) PC_LOAD_KV(u + F.G);
        if (MODE == 0 && tid < 128) { const float mp = MPREV[u]; const size_t gi = (size_t)bh * T + c * CL + tid;
            const float a = GSC[(size_t)(0 * 16) * T + gi], gg = GSC[(size_t)(1 * 16) * T + gi], cm = GSC[(size_t)(2 * 16) * T + gi];
            const float Mt = fmaxf(mp, cm);
            tabs[tid] = gg; tabs[128 + tid] = Mt; tabs[256 + tid] = __expf(mp - Mt) * 0.125f; tabs[384 + tid] = __expf(-(a + Mt)); }
        __syncthreads();
        const int tq = 16 * w + li;
        const bf16* qrow = PB + (row0 + tq) * LDP + h * DK;
        bf16x8 qf[NKS];
#pragma unroll
        for (int ks = 0; ks < NKS; ++ks) qf[ks] = *(const bf16x8*)(qrow + 32 * ks + 8 * g);
        f32x4 O[NET];
#pragma unroll
        for (int et = 0; et < NET; ++et) O[et] = (f32x4){0.f, 0.f, 0.f, 0.f};
        float den = 0.f;
        const float Mq = (MODE == 0) ? tabs[128 + tq] : 0.f;
        const float qs = (MODE == 0) ? tabs[256 + tq] : (MODE == 1) ? exp2f((float)(tq + 1) * lg) : 1.f;
        const float fin = (MODE == 0) ? tabs[384 + tq] : 1.f;
        for (int jp = 0; jp <= (w >> 1); ++jp) {
            f32x4 p0 = (f32x4){0.f, 0.f, 0.f, 0.f}, p1 = (f32x4){0.f, 0.f, 0.f, 0.f};
            const LAS unsigned char* k0p = ldsK + (32 * jp + li) * KP + 16 * g;
#pragma unroll
            for (int ks = 0; ks < NKS; ++ks) p0 = __builtin_amdgcn_mfma_f32_16x16x32_bf16(*(const LAS bf16x8*)(k0p + 64 * ks), qf[ks], p0, 0, 0, 0);
            if (2 * jp + 1 <= w) {
#pragma unroll
                for (int ks = 0; ks < NKS; ++ks) p1 = __builtin_amdgcn_mfma_f32_16x16x32_bf16(*(const LAS bf16x8*)(k0p + 16 * KP + 64 * ks), qf[ks], p1, 0, 0, 0);
            }
#pragma unroll
            for (int r = 0; r < 4; ++r) {
                const int s0 = 32 * jp + 4 * g + r, s1 = s0 + 16;
                float f0, f1;
                if (MODE == 0) { f0 = __expf(tabs[s0] - Mq) * 0.125f; f1 = __expf(tabs[s1] - Mq) * 0.125f; }
                else if (MODE == 1) { f0 = exp2f((float)(tq - s0) * lg); f1 = exp2f((float)(tq - s1) * lg); }
                else { f0 = 1.f; f1 = 1.f; }
                p0[r] = (s0 <= tq) ? p0[r] * f0 : 0.f; p1[r] = (s1 <= tq) ? p1[r] * f1 : 0.f;
                den += p0[r] + p1[r];
            }
            bf16x8 af; { const unsigned a0 = pk2(p0[0], p0[1]), a1 = pk2(p0[2], p0[3]), a2 = pk2(p1[0], p1[1]), a3 = pk2(p1[2], p1[3]); u32x4 t4; t4.x = a0; t4.y = a1; t4.z = a2; t4.w = a3; af = __builtin_bit_cast(bf16x8, t4); }
#pragma unroll
            for (int et = 0; et < NET; ++et) O[et] = __builtin_amdgcn_mfma_f32_16x16x32_bf16(af, tr_frag(ldsV, VP, 32 * jp, 16 * et, lane), O[et], 0, 0, 0);
        }
        __syncthreads();
#pragma unroll
        for (int i = 0; i < NSP; ++i) { const int p = tid + i * NTHREADS, e = p / (DK / 8), cp = p % (DK / 8); *(LAS u32x4*)(ldsS + e * SP + cp * 16) = sreg[i]; }
        __syncthreads();
        float dint = 0.f;
#pragma unroll
        for (int ks = 0; ks < NKS; ++ks) {
            bf16x8 aq = qf[ks];
            if (MODE != 2) aq = __builtin_bit_cast(bf16x8, scale_bf16x8(__builtin_bit_cast(u32x4, qf[ks]), qs));
            if (MODE == 0) { const float* np = NPREV + (size_t)u * 64 + 32 * ks + 8 * g; const u32x4 qa = __builtin_bit_cast(u32x4, aq);
                dint += bflo(qa.x) * np[0] + bfhi(qa.x) * np[1] + bflo(qa.y) * np[2] + bfhi(qa.y) * np[3] + bflo(qa.z) * np[4] + bfhi(qa.z) * np[5] + bflo(qa.w) * np[6] + bfhi(qa.w) * np[7]; }
#pragma unroll
            for (int et = 0; et < NET; ++et) O[et] = __builtin_amdgcn_mfma_f32_16x16x32_bf16(aq, *(const LAS bf16x8*)(ldsS + (16 * et + li) * SP + 64 * ks + 16 * g), O[et], 0, 0, 0);
        }
        float rd[4] = {1.f, 1.f, 1.f, 1.f};
        if (MODE == 0) {
            float dt = den + dint; dt += __shfl_xor(dt, 16); dt += __shfl_xor(dt, 32);
            LAS float* wsc = tabs + 512 + 16 * w;
            if (g == 0) wsc[li] = __builtin_amdgcn_rcpf(fmaxf(fabsf(dt), fin));
            asm volatile("s_waitcnt lgkmcnt(0)" ::: "memory");
#pragma unroll
            for (int r = 0; r < 4; ++r) rd[r] = wsc[4 * g + r];
        }
        float mean[4], rstd[4];
#pragma unroll
        for (int r = 0; r < 4; ++r) { float sacc = 0.f;
#pragma unroll
            for (int et = 0; et < NET; ++et) { O[et][r] *= rd[r]; sacc += O[et][r]; }
            sacc = row16_sum(sacc);
            mean[r] = sacc * (1.f / DV); float q = 0.f;
#pragma unroll
            for (int et = 0; et < NET; ++et) { const float dlt = O[et][r] - mean[r]; q += dlt * dlt; }
            q = row16_sum(q);
            rstd[r] = __builtin_amdgcn_rsqf(q * (1.f / DV) + LN_EPS); }
        bf16* YBp = (bf16*)(ws + WS_YB);
        constexpr int RPF = DV * 2 + 16, TB = (MODE == 0) ? (128 * VP + 128 * KP + 2560) : DV * SP;
        static_assert(TB + NWAVES * 16 * RPF <= PH_BYTES && TB % 16 == 0, "epilogue tiles fit");
        LAS unsigned char* tw = F.lds + TB + w * (16 * RPF);
        const float* ngp = ng + h * DV + li;
        const int rr = lane >> 3, pq = lane & 7;
        const bf16* gpr = PB + (row0 + 16 * w + rr) * LDP + C::GOFF + h * DV + pq * 8; bf16* ypr = YBp + (row0 + 16 * w + rr) * DVT + h * DV + pq * 8;
        asm volatile("" : "+v"(gpr), "+v"(ypr));
#define GATEF(x_) ((MODE == 0) ? sigmoidf_(x_) : (x_) * sigmoidf_(x_))
#pragma unroll
        for (int hf = 0; hf < 2; ++hf) {
#pragma unroll
            for (int e2 = 0; e2 < NET / 2; ++e2) { const int et = hf * (NET / 2) + e2; const float gn = ngp[16 * et];
#pragma unroll
                for (int r = 0; r < 4; ++r) *(LAS float*)(tw + (4 * g + r) * RPF + (16 * e2 + li) * 4) = (O[et][r] - mean[r]) * rstd[r] * gn; }
            asm volatile("s_waitcnt lgkmcnt(0)" ::: "memory");
#pragma unroll
            for (int it = 0; it < DV / 64; ++it) { const int rb = 8 * (it & 1), cb = 64 * (it >> 1);
                const u32x4 gv = *(const u32x4*)(gpr + (size_t)rb * LDP + hf * (DV / 2) + cb);
                const LAS float* tp = (const LAS float*)(tw + (rb + rr) * RPF + (cb + pq * 8) * 4);
                const f32x4 n0 = *(const LAS f32x4*)tp, n1 = *(const LAS f32x4*)(tp + 4);
                const float g0 = bflo(gv.x), g1 = bfhi(gv.x), g2 = bflo(gv.y), g3 = bfhi(gv.y), g4 = bflo(gv.z), g5 = bfhi(gv.z), g6 = bflo(gv.w), g7 = bfhi(gv.w);
                u32x4 o; o.x = pk2(GATEF(g0) * n0[0], GATEF(g1) * n0[1]); o.y = pk2(GATEF(g2) * n0[2], GATEF(g3) * n0[3]);
                o.z = pk2(GATEF(g4) * n1[0], GATEF(g5) * n1[1]); o.w = pk2(GATEF(g6) * n1[2], GATEF(g7) * n1[3]);
                *(u32x4*)(ypr + (size_t)rb * DVT + hf * (DV / 2) + cb) = o; }
            asm volatile("s_waitcnt lgkmcnt(0)" ::: "memory");
        }
#undef GATEF
    }
    __syncthreads();
#undef PC_LOAD_KV
#undef PC_LOAD_S
}

constexpr int SLN = 32, NCI = T / SLN, NI = 2 * NCI, NRT = NI / 16, SKK = SLN * 16;
__device__ __forceinline__ void s5_pow(const f32x4 cf, float n, float& pr, float& pi) { const float e = __expf(n * cf[0]); const float a = n * cf[1]; pr = e * __cosf(a); pi = e * __sinf(a); }

__device__ __forceinline__ void s5_tables(const Frame& F, unsigned char* ws, const int tid, const float* lam_re, const float* lam_im, const float* b_re, const float* b_im, const float* c_re, const float* c_im, const float* log_dt) {
    bf16* KT = (bf16*)(ws + WS_S5KT); bf16* VT = (bf16*)(ws + WS_S5VT); bf16* WT = (bf16*)(ws + WS_S5WT); float* L64 = (float*)(ws + WS_S5L64);
    LAS f32x4* CF = (LAS f32x4*)F.lds;
    for (int i = tid; i < 64 * 64; i += NTHREADS) { const int g = i >> 6; const float lr = lam_re[i], li = lam_im[i], dt = expf(log_dt[g]);
        const float er = expf(lr * dt); float sn, cs; sincosf(li * dt, &sn, &cs);
        const float nr = er * cs - 1.f, ni = er * sn, den = lr * lr + li * li;
        CF[i] = (f32x4){lr * dt, li * dt, (nr * lr + ni * li) / den, (ni * lr - nr * li) / den}; }
    __syncthreads();
    const int gt = blockIdx.x * NTHREADS + tid, nthr = F.G * NTHREADS;
    LAS float* BR = (LAS float*)(F.lds + 65536); LAS float* BI = BR + 1024; LAS float* CR = BI + 1024; LAS float* CI = CR + 1024;
    for (int i0 = blockIdx.x * NTHREADS; i0 < 64 * SLN * 16 * 4; i0 += nthr) {
        const int g = i0 / (64 * SLN);
        __syncthreads();
        for (int q = tid; q < 1024; q += NTHREADS) { BR[q] = b_re[(size_t)g * 1024 + q]; BI[q] = b_im[(size_t)g * 1024 + q]; CR[q] = c_re[(size_t)g * 1024 + q]; CI[q] = c_im[(size_t)g * 1024 + q]; }
        __syncthreads();
        const int i4 = i0 + tid, pq = i4 & 3, idx = i4 >> 2, h = idx & 15, tau = (idx >> 4) % SLN;
        float acc[16];
#pragma unroll
        for (int q = 0; q < 16; ++q) acc[q] = 0.f;
#pragma unroll 4
        for (int p = pq * 16; p < pq * 16 + 16; ++p) { const f32x4 cf = CF[g * 64 + p]; float pr, pi; s5_pow(cf, (float)tau, pr, pi);
            const float cr = CR[h * 64 + p], ci = CI[h * 64 + p];
            const float xr = cr * pr - ci * pi, xi = cr * pi + ci * pr;
            const float yr = xr * cf[2] - xi * cf[3], yi = xr * cf[3] + xi * cf[2];
            const LAS f32x4* br4 = (const LAS f32x4*)(BR + p * 16); const LAS f32x4* bi4 = (const LAS f32x4*)(BI + p * 16);
#pragma unroll
            for (int q = 0; q < 4; ++q) { const f32x4 b_r = br4[q], b_i = bi4[q];
#pragma unroll
                for (int z = 0; z < 4; ++z) acc[4 * q + z] += yr * b_r[z] - yi * b_i[z]; } }
#pragma unroll
        for (int q = 0; q < 16; ++q) { acc[q] += dpp_f<0xB1>(acc[q]); acc[q] += dpp_f<0x4E>(acc[q]); }
        if (pq == 0) { u32x4 o0, o1; o0.x = pk2(acc[0], acc[1]); o0.y = pk2(acc[2], acc[3]); o0.z = pk2(acc[4], acc[5]); o0.w = pk2(acc[6], acc[7]);
            o1.x = pk2(acc[8], acc[9]); o1.y = pk2(acc[10], acc[11]); o1.z = pk2(acc[12], acc[13]); o1.w = pk2(acc[14], acc[15]);
            *(u32x4*)(KT + (size_t)idx * 16) = o0; *(u32x4*)(KT + (size_t)idx * 16 + 8) = o1; } }
    for (int idx = gt; idx < 64 * 64 * SLN; idx += nthr) {
        const int j = idx % SLN, p = (idx / SLN) & 63, g = idx / (SLN * 64);
        const f32x4 cf = CF[g * 64 + p]; float pr, pi;
        s5_pow(cf, (float)(SLN - 1 - j), pr, pi);
        const float yr = pr * cf[2] - pi * cf[3], yi = pr * cf[3] + pi * cf[2];
        const float* br = b_re + (size_t)(g * 64 + p) * 16; const float* bi = b_im + (size_t)(g * 64 + p) * 16;
        float vr[16], vi[16];
#pragma unroll
        for (int q = 0; q < 16; ++q) { vr[q] = yr * br[q] - yi * bi[q]; vi[q] = yr * bi[q] + yi * br[q]; }
        bf16* v0 = VT + ((size_t)(g * 128 + 2 * p) * SKK + j * 16);
        u32x4 o; o.x = pk2(vr[0], vr[1]); o.y = pk2(vr[2], vr[3]); o.z = pk2(vr[4], vr[5]); o.w = pk2(vr[6], vr[7]); *(u32x4*)v0 = o;
        o.x = pk2(vr[8], vr[9]); o.y = pk2(vr[10], vr[11]); o.z = pk2(vr[12], vr[13]); o.w = pk2(vr[14], vr[15]); *(u32x4*)(v0 + 8) = o;
        o.x = pk2(vi[0], vi[1]); o.y = pk2(vi[2], vi[3]); o.z = pk2(vi[4], vi[5]); o.w = pk2(vi[6], vi[7]); *(u32x4*)(v0 + SKK) = o;
        o.x = pk2(vi[8], vi[9]); o.y = pk2(vi[10], vi[11]); o.z = pk2(vi[12], vi[13]); o.w = pk2(vi[14], vi[15]); *(u32x4*)(v0 + SKK + 8) = o;
        if (j == 0) { s5_pow(cf, (float)SLN, pr, pi); L64[(g * 64 + p) * 2] = pr; L64[(g * 64 + p) * 2 + 1] = pi; }
    }
    for (int idx = gt; idx < 64 * 64 * SLN; idx += nthr) {
        const int p = idx & 63, l = (idx >> 6) % SLN, g = idx / (SLN * 64);
        const f32x4 cf = CF[g * 64 + p]; float pr, pi; s5_pow(cf, (float)(l + 1), pr, pi);
#pragma unroll
        for (int h = 0; h < 16; ++h) { const float cr = c_re[(g * 16 + h) * 64 + p], ci = c_im[(g * 16 + h) * 64 + p];
            *(unsigned*)(WT + ((size_t)((g * SLN + l) * 16 + h) * 128 + 2 * p)) = pk2(cr * pr - ci * pi, -(cr * pi + ci * pr)); }
    }
    __syncthreads();
}
__device__ __forceinline__ void s5_phaseA(const Frame& F, unsigned char* ws, const int lane) {
    const bf16* PB = (const bf16*)(ws + WS_PB); const bf16* VT = (const bf16*)(ws + WS_S5VT); float* SL = (float*)(ws + WS_S5SL);
    const int gq = lane >> 4, li = lane & 15;
    for (int wu = F.gw; wu < 64 * NRT * 2; wu += F.NGW) {
        const int half = wu & 1, rt = (wu >> 1) % NRT, g = wu / (2 * NRT), b = rt / (NRT / 2), c0 = (rt % (NRT / 2)) * 16;
        f32x4 acc[4];
#pragma unroll
        for (int ct = 0; ct < 4; ++ct) acc[ct] = (f32x4){0.f, 0.f, 0.f, 0.f};
        const bf16* ap = PB + ((size_t)b * T + (size_t)(c0 + li) * SLN + (gq >> 1)) * 1024 + g * 16 + 8 * (gq & 1);
        const bf16* bp = VT + (size_t)(g * 128 + half * 64 + li) * SKK + 8 * gq;
#pragma unroll 4
        for (int ks = 0; ks < SLN / 2; ++ks) {
            const bf16x8 af = *(const bf16x8*)(ap + (size_t)(2 * ks) * 1024);
#pragma unroll
            for (int ct = 0; ct < 4; ++ct) acc[ct] = __builtin_amdgcn_mfma_f32_16x16x32_bf16(af, *(const bf16x8*)(bp + (size_t)(16 * ct) * SKK + 32 * ks), acc[ct], 0, 0, 0);
        }
#pragma unroll
        for (int ct = 0; ct < 4; ++ct)
#pragma unroll
            for (int r = 0; r < 4; ++r) SL[(size_t)(g * NI + rt * 16 + 4 * gq + r) * 128 + half * 64 + ct * 16 + li] = acc[ct][r];
    }
}
__device__ __forceinline__ void s5_phaseB(const Frame& F, unsigned char* ws, const int tid) {
    static_assert(NCI == 256, "16 groups of 16 chunks");
    const float* SL = (const float*)(ws + WS_S5SL); bf16* SP = (bf16*)(ws + WS_S5SP); const float* L64 = (const float*)(ws + WS_S5L64);
    for (int gt = blockIdx.x * NTHREADS + tid; gt < 2 * 64 * 64 * 16; gt += F.G * NTHREADS) {
        const int grp = gt & 15, p = (gt >> 4) & 63, g = (gt >> 10) & 63, b = gt >> 16;
        const float ar = L64[(g * 64 + p) * 2], ai = L64[(g * 64 + p) * 2 + 1];
        const size_t base = (size_t)(g * NI + b * NCI + grp * 16) * 128 + 2 * p;
        f32x2 x[16];
#pragma unroll
        for (int i = 0; i < 16; ++i) x[i] = *(const f32x2*)(SL + base + (size_t)i * 128);
        float lr[16], li[16], sr = 0.f, si = 0.f;
#pragma unroll
        for (int i = 0; i < 16; ++i) { lr[i] = sr; li[i] = si; const float nr = ar * sr - ai * si + x[i][0], ni = ar * si + ai * sr + x[i][1]; sr = nr; si = ni; }
        float mr = ar, mi = ai;
#pragma unroll
        for (int k = 0; k < 4; ++k) { const float t = mr * mr - mi * mi; mi = 2.f * mr * mi; mr = t; }
#define S5_STEP(CTRL) do { const float tr = __builtin_bit_cast(float, __builtin_amdgcn_update_dpp(0, __builtin_bit_cast(int, sr), CTRL, 0xf, 0xf, true)), ti = __builtin_bit_cast(float, __builtin_amdgcn_update_dpp(0, __builtin_bit_cast(int, si), CTRL, 0xf, 0xf, true)); \
            sr += mr * tr - mi * ti; si += mr * ti + mi * tr; const float t2 = mr * mr - mi * mi; mi = 2.f * mr * mi; mr = t2; } while (0)
        S5_STEP(0x111); S5_STEP(0x112); S5_STEP(0x114); S5_STEP(0x118);
#undef S5_STEP
        const float pr = __builtin_bit_cast(float, __builtin_amdgcn_update_dpp(0, __builtin_bit_cast(int, sr), 0x111, 0xf, 0xf, true)), pi = __builtin_bit_cast(float, __builtin_amdgcn_update_dpp(0, __builtin_bit_cast(int, si), 0x111, 0xf, 0xf, true));
        float qr = 1.f, qi = 0.f;
#pragma unroll
        for (int i = 0; i < 16; ++i) { const float orr = qr * pr - qi * pi + lr[i], oi = qr * pi + qi * pr + li[i];
            *(unsigned*)(SP + base + (size_t)i * 128) = pk2(orr, oi);
            const float t = qr * ar - qi * ai; qi = qr * ai + qi * ar; qr = t; }
    }
}
__device__ __forceinline__ void s5_phaseC(const Frame& F, unsigned char* ws, const int lane, const float* dskip) {
    const bf16* PB = (const bf16*)(ws + WS_PB); const bf16* KT = (const bf16*)(ws + WS_S5KT); const bf16* WT = (const bf16*)(ws + WS_S5WT); const bf16* SP = (const bf16*)(ws + WS_S5SP);
    bf16* YB = (bf16*)(ws + WS_YB);
    const int gq = lane >> 4, li = lane & 15;
#pragma unroll 1
    for (int wu = F.gw; wu < 64 * NRT * 2; wu += F.NGW) {
        const int par = wu & 1, rt = (wu >> 1) % NRT, g = wu / (2 * NRT), b = rt / (NRT / 2), c0 = (rt % (NRT / 2)) * 16;
        bf16x8 af[SLN / 2], sf[4];
        const bf16* ap = PB + ((size_t)b * T + (size_t)(c0 + li) * SLN + (gq >> 1)) * 1024 + g * 16 + 8 * (gq & 1);
#pragma unroll
        for (int ks = 0; ks < SLN / 2; ++ks) af[ks] = *(const bf16x8*)(ap + (size_t)(2 * ks) * 1024);
#pragma unroll
        for (int ks = 0; ks < 4; ++ks) sf[ks] = *(const bf16x8*)(SP + (size_t)(g * NI + rt * 16 + li) * 128 + 32 * ks + 8 * gq);
        const float dl = dskip[g * 16 + li];
        const bf16* ktp = KT + (size_t)g * SLN * 256 + li * 16 + 8 * (gq & 1);
#pragma unroll
        for (int l2 = 0; l2 < SLN / 2; ++l2) {
            int l = 2 * l2 + par; asm volatile("" : "+v"(l));
            f32x4 acc = (f32x4){0.f, 0.f, 0.f, 0.f};
#pragma unroll
            for (int ks = 0; ks <= l2; ++ks) { const int tau = l - 2 * ks - (gq >> 1);
                bf16x8 bfv = *(const bf16x8*)(ktp + (size_t)(tau < 0 ? 0 : tau) * 256);
                if (ks == l2 && tau < 0) bfv = (bf16x8){0, 0, 0, 0, 0, 0, 0, 0};
                acc = __builtin_amdgcn_mfma_f32_16x16x32_bf16(af[ks], bfv, acc, 0, 0, 0); }
            const bf16* wp = WT + (size_t)((g * SLN + l) * 16 + li) * 128 + 8 * gq;
#pragma unroll
            for (int ks = 0; ks < 4; ++ks) acc = __builtin_amdgcn_mfma_f32_16x16x32_bf16(sf[ks], *(const bf16x8*)(wp + 32 * ks), acc, 0, 0, 0);
#pragma unroll
            for (int r = 0; r < 4; ++r) { const size_t row = (size_t)b * T + (size_t)(c0 + 4 * gq + r) * SLN + l; const size_t o = row * 1024 + g * 16 + li;
                const float y = acc[r] + dl * bf2f(PB[o]); YB[o] = (bf16)f2bf(gelu_tanh(y)); }
            asm volatile("" ::: "memory");
        }
    }
}

#define IN(k) (lo <= (k) && (k) < hi)
#define SEAM(k) do { if ((k) + 1 < hi) { xcd_barrier(bar, F.wave); if (PROBE_CLS == 10) xcd_barrier(bar, F.wave); if (PROBE_T >= 0) stamp_fn(F.lds, F.wave, (k)); } } while (0)
#define INP(i) inp_ptr(F.lds, (i))
#define x_in INP(0)
#define ln_g INP(1)
#define ln_b INP(2)
#define WS_PTRS \
    float* HF = (float*)(ws + WS_HF); bf16* XB = (bf16*)(ws + WS_XB); bf16* ZF = (bf16*)(ws + WS_ZF); bf16* PB = (bf16*)(ws + WS_PB); \
    float* GB = (float*)(ws + WS_GB); float* LA = (float*)(ws + WS_LA); float* ORAW = (float*)(ws + WS_ORAW); bf16* YB = (bf16*)(ws + WS_YB); \
    bf16* ACT = (bf16*)(ws + WS_ACT); bf16* YS = (bf16*)(ws + WS_YS); bf16* XG = (bf16*)(ws + WS_XG); \
    int* LIST = (int*)(ws + WS_LIST); float* GW = (float*)(ws + WS_ORAW); \
    float* S5LB = (float*)(ws + WS_S5TAB); float* S5BB = (float*)(ws + WS_S5TAB + 32768); \
    (void)HF; (void)XB; (void)ZF; (void)PB; (void)GB; (void)LA; (void)ORAW; (void)YB; (void)ACT; (void)YS; (void)XG; (void)LIST; (void)GW; (void)S5LB; (void)S5BB;

template <int layer>
__device__ __forceinline__ void layer_body(const Frame& F, unsigned char* ws, unsigned* ctl, LAS int* TAB, const XcdBarrier& bar, const int lo, const int hi, float* d_out) {
    WS_PTRS
        const int pb = 1 + layer * 16;
        const float* hin = (layer == 0) ? x_in : HF;
        if (PHE(1) && IN(pb + 0)) {
            const bf16* Wt = (const bf16*)(ws + (layer == 0 ? WS_WT_ML_IN : layer == 1 ? WS_WT_RET_IN : layer == 2 ? WS_WT_GLA_IN : WS_WT_S5_IN));
            const int N = (layer == 0 || layer == 2) ? 3072 : (layer == 1 ? 6144 : 1024);
            pg8::DenseOrder S; S.init(XB, Wt, M, N, D, F.G, (int)blockIdx.x);
            pg8::EpiBf16 E{PB, N, (const float*)(ws + WS_CS), (layer == 1) ? 8 : 0};
            for (int rep_ = 0; rep_ < REPS(2); ++rep_)
            pg8::gemm_phase<pg8::EpiBf16, pg8::DenseOrder, true, true>(F.lds, F.wave, D, S, E);
            if (layer == 0 && CH_ML) {
                const int lane = lane_id(); float* GSC = (float*)(ws + WS_SC);
                for (int wu = F.gw; wu < 16 * NCH; wu += F.NGW) { const int bh = wu / NCH, c = wu % NCH, b = bh >> 3, h = bh & 7;
                    const int t0 = c * CL + 2 * lane; const size_t row = (size_t)b * T + t0;
                    const float lf0 = log_sigmoidf_(GB[row * 16 + 8 + h]), lf1 = log_sigmoidf_(GB[(row + 1) * 16 + 8 + h]);
                    const float sp = lf0 + lf1; float inc = sp;
#pragma unroll
                    for (int d = 1; d < 64; d <<= 1) { const float tv_ = __shfl_up(inc, d); if (lane >= d) inc += tv_; }
                    const float a0 = inc - sp + lf0, a1 = inc;
                    const float g0 = GB[row * 16 + h] - a0, g1 = GB[(row + 1) * 16 + h] - a1;
                    float mx = fmaxf(g0, g1);
#pragma unroll
                    for (int d = 1; d < 64; d <<= 1) { const float tv_ = __shfl_up(mx, d); if (lane >= d) mx = fmaxf(mx, tv_); }
                    float ex = __shfl_up(mx, 1); if (lane == 0) ex = -3.0e38f;
                    const size_t o0 = (size_t)bh * T + t0;
                    *(f32x2*)(GSC + (size_t)(0 * 16) * T + o0) = (f32x2){a0, a1};
                    *(f32x2*)(GSC + (size_t)(1 * 16) * T + o0) = (f32x2){g0, g1};
                    *(f32x2*)(GSC + (size_t)(2 * 16) * T + o0) = (f32x2){fmaxf(ex, g0), mx}; }
            }
            SEAM(pb + 0);
        }
        if (layer == 0) {
            if (CH_ML) {
                if (IN(pb + 2)) { const int lane = lane_id(), tid = F.wave * 64 + lane; for (int rep_ = 0; rep_ < REPS(6); ++rep_) mix_phaseA<0>(F, ws, tid, lane); SEAM(pb + 2); }
                if (IN(pb + 3)) { const int lane = lane_id(), tid = F.wave * 64 + lane; for (int rep_ = 0; rep_ < REPS(7); ++rep_) mix_phaseB<0>(F, ws, tid); SEAM(pb + 3); }
                if (IN(pb + 4)) { const int lane = lane_id(), tid = F.wave * 64 + lane; for (int rep_ = 0; rep_ < REPS(8); ++rep_) mix_phaseC<0>(F, ws, tid, lane, INP(5)); SEAM(pb + 4); }
            }
        } else if (layer == 1) {
            if (CH_RET) {
                if (IN(pb + 2)) { const int lane = lane_id(), tid = F.wave * 64 + lane; for (int rep_ = 0; rep_ < REPS(6); ++rep_) mix_phaseA<1>(F, ws, tid, lane); SEAM(pb + 2); }
                if (IN(pb + 3)) { const int lane = lane_id(), tid = F.wave * 64 + lane; for (int rep_ = 0; rep_ < REPS(7); ++rep_) mix_phaseB<1>(F, ws, tid); SEAM(pb + 3); }
                if (IN(pb + 4)) { const int lane = lane_id(), tid = F.wave * 64 + lane; for (int rep_ = 0; rep_ < REPS(8); ++rep_) mix_phaseC<1>(F, ws, tid, lane, INP(8)); SEAM(pb + 4); }
            }
        } else if (layer == 2) {
            if (CH_GLA) {
                if (IN(pb + 1)) {
                    const int lane = lane_id();
                    bf16* KPP = (bf16*)(ws + WS_KPP); float* DEC = (float*)(ws + WS_SC + 3 * MiB); LAS float* tot = (LAS float*)F.lds;
                    for (int u = blockIdx.x; u < 2 * NCH * 8; u += F.G) { const int cg = u & 7, bc = u >> 3, b = bc / NCH, c = bc % NCH, ch = cg * 64 + lane;
                        const size_t r0 = (size_t)b * T + (size_t)c * CL + 16 * F.wave;
                        float cs[16]; unsigned short qv[16], kv[16];
#pragma unroll
                        for (int i = 0; i < 16; ++i) { cs[i] = LA[(r0 + i) * 512 + ch]; qv[i] = PB[(r0 + i) * 3072 + ch]; kv[i] = PB[(r0 + i) * 3072 + 512 + ch]; }
#pragma unroll
                        for (int i = 1; i < 16; ++i) cs[i] += cs[i - 1];
                        __syncthreads();
                        tot[F.wave * 64 + lane] = cs[15];
                        __syncthreads();
                        float pre = 0.f, bend = 0.f;
#pragma unroll
                        for (int w2 = 0; w2 < NWAVES; ++w2) { const float tw = tot[w2 * 64 + lane]; bend += tw; if (w2 < F.wave) pre += tw; }
#pragma unroll
                        for (int i = 0; i < 16; ++i) { const float bcum = pre + cs[i]; const float q_ = bf2f(qv[i]), k_ = bf2f(kv[i]) * 0.08838834764831845f;
                            PB[(r0 + i) * 3072 + ch] = (bf16)f2bf(q_ * __expf(bcum)); PB[(r0 + i) * 3072 + 512 + ch] = (bf16)f2bf(k_ * __expf(-bcum)); KPP[(r0 + i) * 512 + ch] = (bf16)f2bf(k_ * __expf(bend - bcum)); }
                        if (F.wave == 0) DEC[(size_t)bc * 512 + ch] = __expf(bend); }
                    __syncthreads();
                    SEAM(pb + 1);
                }
                if (IN(pb + 2)) { const int lane = lane_id(), tid = F.wave * 64 + lane; for (int rep_ = 0; rep_ < REPS(6); ++rep_) mix_phaseA<2>(F, ws, tid, lane); SEAM(pb + 2); }
                if (IN(pb + 3)) { const int lane = lane_id(), tid = F.wave * 64 + lane; for (int rep_ = 0; rep_ < REPS(7); ++rep_) mix_phaseB<2>(F, ws, tid); SEAM(pb + 3); }
                if (IN(pb + 4)) { const int lane = lane_id(), tid = F.wave * 64 + lane; for (int rep_ = 0; rep_ < REPS(8); ++rep_) mix_phaseC<2>(F, ws, tid, lane, INP(13)); SEAM(pb + 4); }
            }
        } else {
            if (CH_S5) {
                if (IN(pb + 2)) { const int lane = lane_id(); for (int rep_ = 0; rep_ < REPS(6); ++rep_) s5_phaseA(F, ws, lane); SEAM(pb + 2); }
                if (IN(pb + 3)) { const int lane = lane_id(), tid = F.wave * 64 + lane; for (int rep_ = 0; rep_ < REPS(7); ++rep_) s5_phaseB(F, ws, tid); SEAM(pb + 3); }
                if (IN(pb + 4)) { const int lane = lane_id(); for (int rep_ = 0; rep_ < REPS(8); ++rep_) s5_phaseC(F, ws, lane, INP(22)); SEAM(pb + 4); }
            }
        }
        if (PHE(4) && layer == 3 && IN(pb + 6)) {
            pg8::DenseOrder S; S.init(YB, ws + WS_WT_S5_GLU, M, D, D, F.G, (int)blockIdx.x);
            pg8::EpiGlu E{YB, INP(25), (bf16*)ORAW};
            for (int rep_ = 0; rep_ < REPS(3); ++rep_)
            pg8::gemm_phase<pg8::EpiGlu, pg8::DenseOrder, true, true>(F.lds, F.wave, D, S, E);
            SEAM(pb + 6);
        }
        if (PHE(5) && IN(pb + 7)) {
            const bf16* Wt = (const bf16*)(ws + (layer == 0 ? WS_WT_ML_OUT : layer == 1 ? WS_WT_RET_OUT : layer == 2 ? WS_WT_GLA_OUT : WS_WT_S5_OUT));
            const int Kd = (layer == 1) ? 2048 : 1024;
            const bf16* Ain = (layer == 3) ? (const bf16*)ORAW : YB;
            pg8::DenseOrder S; S.init(Ain, Wt, M, D, Kd, F.G, (int)blockIdx.x);
            pg8::EpiResid E{hin, (layer == 0) ? (const bf16*)nullptr : (const bf16*)XB, ZF};
            for (int rep_ = 0; rep_ < REPS(3); ++rep_)
            pg8::gemm_phase<pg8::EpiResid, pg8::DenseOrder, true, true>(F.lds, F.wave, Kd, S, E);
            SEAM(pb + 7);
        }
        unsigned* cnt = ctl + CW_CNT + layer * 32 * 64;
        if (IN(pb + 8) && !defined_SKIP_LN1) { const int lane = lane_id(), tid = F.wave * 64 + lane; (void)tid;
            LAS float* Wt = (LAS float*)(F.lds);
            { const f32x4* wr4 = (const f32x4*)(INP(27) + (size_t)layer * D * NEXP);
              f32x4 wv[16];
#pragma unroll
              for (int i = 0; i < 16; ++i) wv[i] = wr4[tid + i * NTHREADS];
#pragma unroll
              for (int i = 0; i < 16; ++i) { const int q = tid + i * NTHREADS, k = q >> 3, e0 = (q & 7) * 4;
                  Wt[(e0 + 0) * 1028 + k] = wv[i][0]; Wt[(e0 + 1) * 1028 + k] = wv[i][1]; Wt[(e0 + 2) * 1028 + k] = wv[i][2]; Wt[(e0 + 3) * 1028 + k] = wv[i][3]; } }
            __syncthreads();
            const float* br_ = INP(28) + layer * NEXP;
            const float* lng_ = ln_g + (size_t)(layer * 2 + 0) * D; const float* lnb_ = ln_b + (size_t)(layer * 2 + 0) * D;
          {
            unsigned* cntp = cnt;
            int aE = 0, aRow = -1; float aG = 0.f;
            LAS unsigned* lcnt = (LAS unsigned*)(F.lds + 131584); LAS int* lbase = (LAS int*)(lcnt + 32);
            if (tid < 32) lcnt[tid] = 0u;
            const int ntrip = (M + F.NGW - 1) / F.NGW;
            u32x2 vnext[2][4];
#pragma unroll
            for (int q = 0; q < 2; ++q) { const int r_ = F.gw + q * F.NGW; if (r_ < M) { const u32x2* zp = (const u32x2*)(ZF + (size_t)r_ * D) + lane;
#pragma unroll
                for (int j = 0; j < 4; ++j) vnext[q][j] = zp[64 * j]; } }
            for (int it_ = 0; it_ < ntrip; it_ += 2) { const int row0_ = F.gw + it_ * F.NGW;
                asm volatile("" ::: "memory");
                const bool ok[2] = {row0_ < M, it_ + 1 < ntrip && row0_ + F.NGW < M};
                f32x4 v[2][4];
#pragma unroll
                for (int q = 0; q < 2; ++q)
#pragma unroll
                    for (int j = 0; j < 4; ++j) v[q][j] = (f32x4){bflo(vnext[q][j].x), bfhi(vnext[q][j].x), bflo(vnext[q][j].y), bfhi(vnext[q][j].y)};
#pragma unroll
                for (int q = 0; q < 2; ++q) { const int r_ = row0_ + (2 + q) * F.NGW; if (it_ + 2 + q < ntrip && r_ < M) { const u32x2* zp = (const u32x2*)(ZF + (size_t)r_ * D) + lane;
#pragma unroll
                    for (int j = 0; j < 4; ++j) vnext[q][j] = zp[64 * j]; } }
                { f32x4 gv[4], bv[4]; load_row_f32(lng_, gv, lane); load_row_f32(lnb_, bv, lane); ln_row(v[0], gv, bv); ln_row(v[1], gv, bv); }
                float pz[2][32];
#pragma unroll
                for (int e = 0; e < 32; ++e) { float s0 = 0.f, s1 = 0.f;
#pragma unroll
                    for (int j = 0; j < 4; ++j) { const f32x4 w = *(const LAS f32x4*)(Wt + e * 1028 + 4 * (lane + 64 * j));
                        s0 += v[0][j][0] * w[0] + v[0][j][1] * w[1] + v[0][j][2] * w[2] + v[0][j][3] * w[3]; s1 += v[1][j][0] * w[0] + v[1][j][1] * w[1] + v[1][j][2] * w[2] + v[1][j][3] * w[3]; }
                    pz[0][e] = s0; pz[1][e] = s1; }
                float lgv[2];
#pragma unroll
                for (int q = 0; q < 2; ++q) {
                    float a16[16], a8[8], a4[4], a2[2];
#pragma unroll
                    for (int e = 0; e < 16; ++e) { const auto r = __builtin_amdgcn_permlane32_swap(__builtin_bit_cast(unsigned, pz[q][e]), __builtin_bit_cast(unsigned, pz[q][e + 16]), false, false);
                        a16[e] = __builtin_bit_cast(float, (unsigned)r[0]) + __builtin_bit_cast(float, (unsigned)r[1]); }
#pragma unroll
                    for (int e = 0; e < 8; ++e) { const auto r = __builtin_amdgcn_permlane16_swap(__builtin_bit_cast(unsigned, a16[e]), __builtin_bit_cast(unsigned, a16[e + 8]), false, false);
                        a8[e] = __builtin_bit_cast(float, (unsigned)r[0]) + __builtin_bit_cast(float, (unsigned)r[1]); }
                    { const bool hi = (lane & 8) != 0;
#pragma unroll
                      for (int e = 0; e < 4; ++e) { const float mine = hi ? a8[e + 4] : a8[e], theirs = hi ? a8[e] : a8[e + 4]; a4[e] = mine + dpp_f<0x128>(theirs); } }
                    { const bool hi = (lane & 4) != 0;
#pragma unroll
                      for (int e = 0; e < 2; ++e) { const float mine = hi ? a4[e + 2] : a4[e], theirs = hi ? a4[e] : a4[e + 2]; a2[e] = mine + dpp_f<0x141>(theirs); } }
                    { const bool hi = (lane & 2) != 0; const float mine = hi ? a2[1] : a2[0], theirs = hi ? a2[0] : a2[1]; lgv[q] = mine + dpp_f<0x4E>(theirs); }
                    lgv[q] += dpp_f<0xB1>(lgv[q]);
                    lgv[q] += br_[lane >> 1];
                }
                int te[2][4]; float tv[2][4];
#pragma unroll
                for (int k = 0; k < 4; ++k)
#pragma unroll
                    for (int q = 0; q < 2; ++q) { const float best = wave_max(lgv[q]);
                        const unsigned long long mk = __ballot(lgv[q] == best); const int src = __builtin_amdgcn_readfirstlane((int)__ffsll((long long)mk) - 1);
                        te[q][k] = src >> 1; tv[q][k] = best; if ((lane >> 1) == te[q][k]) lgv[q] = -3.0e38f; }
#pragma unroll
                for (int q = 0; q < 2; ++q) if (ok[q]) { const int row = row0_ + q * F.NGW;
                    const float e0 = 1.f, e1 = __expf(tv[q][1] - tv[q][0]), e2 = __expf(tv[q][2] - tv[q][0]), e3 = __expf(tv[q][3] - tv[q][0]), rs = __builtin_amdgcn_rcpf(e0 + e1 + e2 + e3);
                    const int ri = (it_ + q) & 15;
                    if ((lane >> 2) == ri) { const int k = lane & 3; aE = k == 0 ? te[q][0] : k == 1 ? te[q][1] : k == 2 ? te[q][2] : te[q][3]; aG = (k == 0 ? e0 : k == 1 ? e1 : k == 2 ? e2 : e3) * rs; aRow = row; }
                    store_row_bf16(XB + (size_t)row * D, v[q], lane); }
                if (((it_ + 1) & 15) == 15 || it_ + 2 >= ntrip) {
                    __syncthreads();
                    int lp = 0; if (aRow >= 0) lp = (int)__hip_atomic_fetch_add(lcnt + aE, 1u, __ATOMIC_RELAXED, __HIP_MEMORY_SCOPE_WORKGROUP);
                    __syncthreads();
                    if (tid < 32) { const unsigned n = lcnt[tid]; lbase[tid] = n ? (int)__hip_atomic_fetch_add(cntp + tid * 64, n, __ATOMIC_RELAXED, __HIP_MEMORY_SCOPE_AGENT) : 0; }
                    __syncthreads();
                    if (aRow >= 0) { const int pos = lbase[aE] + lp; LIST[(size_t)aE * CAP + pos] = aRow * 4 + (lane & 3); GW[(size_t)aE * CAP + pos] = aG; }
                    aRow = -1;
                    __syncthreads();
                    if (tid < 32) lcnt[tid] = 0u;
                }
            }
          }
            __syncthreads();
            SEAM(pb + 8);
        }
        if ((PHE(7) || PHE(8)) && (IN(pb + 9) || IN(pb + 10))) { const int lane = lane_id(), tid = F.wave * 64 + lane; (void)tid;
            __syncthreads();
            if (tid < 32) TAB[tid] = (int)__hip_atomic_load(cnt + tid * 64, __ATOMIC_RELAXED, __HIP_MEMORY_SCOPE_AGENT);
            __syncthreads();
            if (tid < 64) {
                const int nt_ = (lane < 32) ? ((TAB[lane] + 255) >> 8) : 0; int inc = nt_;
#pragma unroll
                for (int d = 1; d < 32; d <<= 1) { const int t_ = __shfl_up(inc, d); if (lane >= d) inc += t_; }
                if (lane < 32) TAB[32 + lane] = inc - nt_;
                if (lane == 31) TAB[64] = inc; }
            __syncthreads();
            if (tid < MAXTILES) { int e = 0;
#pragma unroll
                for (int k = 1; k < 32; ++k) e += (TAB[32 + k] <= tid) ? 1 : 0;
                if (tid < TAB[64]) TAB[72 + tid] = e; }
            __syncthreads();
        }
        if (PHE(7) && IN(pb + 9)) {
            pg8::MoeOrder S; S.A = (const char*)XB; S.list = LIST; S.gwl = GW; S.Bt = (const char*)(ws + WS_WT_GU + (size_t)layer * 32 * 2048 * 1024 * 2); S.tab = TAB; S.K = D; S.nN = 8; S.ntiles = __builtin_amdgcn_readfirstlane(TAB[64]); S.nwg = S.ntiles * 8; S.G = F.G; S.c = (int)blockIdx.x;
            S.b_estride = (size_t)2048 * 1024 * 2; S.a_compact = 2;
            pg8::EpiSwiglu E{ACT, INP(30) + (size_t)layer * 32 * 2048, (const LAS float*)(TAB + 2816)};
            for (int rep_ = 0; rep_ < REPS(4); ++rep_)
            pg8::gemm_phase<pg8::EpiSwiglu, pg8::MoeOrder, MOE_ALIGN, true, true>(F.lds, F.wave, D, S, E, TAB + 512);
            SEAM(pb + 9);
        }
        if (PHE(8) && IN(pb + 10)) {
            pg8::MoeOrder S; S.A = (const char*)ACT; S.list = LIST; S.gwl = GW; S.Bt = (const char*)(ws + WS_WT_DN + (size_t)layer * 32 * 1024 * 1024 * 2); S.tab = TAB; S.K = DFF; S.nN = 4; S.ntiles = __builtin_amdgcn_readfirstlane(TAB[64]); S.nwg = S.ntiles * 4; S.G = F.G; S.c = (int)blockIdx.x;
            S.b_estride = (size_t)1024 * 1024 * 2; S.a_compact = 1;
            pg8::EpiMoeDown E{YS, INP(32) + (size_t)layer * 32 * 1024, TAB + 1280, (const LAS float*)(TAB + 2816)};
            for (int rep_ = 0; rep_ < REPS(5); ++rep_)
            pg8::gemm_phase<pg8::EpiMoeDown, pg8::MoeOrder, MOE_ALIGN, true, true>(F.lds, F.wave, DFF, S, E, TAB + 512);
            SEAM(pb + 10);
        }
        if (PHE(9) && IN(pb + 11)) { const int lane = lane_id(), tid = F.wave * 64 + lane; (void)tid;
            LAS float* Wt = (LAS float*)(F.lds);
            if (layer == 1) { load_cols16(tid, INP(10), 3088, 3072, Wt); __syncthreads(); }
            const float* lng_ = ln_g + (size_t)(layer * 2 + 1) * D; const float* lnb_ = ln_b + (size_t)(layer * 2 + 1) * D;
          for (int rep_ = 0; rep_ < REPS(12); ++rep_) {
            float* outp = (PROBE_CLS == 12 && rep_ == 0) ? ORAW : (layer == 3) ? d_out : HF; bf16* XBo = (PROBE_CLS == 12 && rep_ == 0) ? YB : XB;
            f32x4 hn[4]; u32x2 yn[4][4];
#define CMB_LOAD(r_) do { { const u32x2* hp_ = (const u32x2*)(XB + (size_t)(r_) * D) + lane; _Pragma("unroll") for (int j = 0; j < 4; ++j) { const u32x2 hw_ = hp_[64 * j]; hn[j] = (f32x4){bflo(hw_.x), bfhi(hw_.x), bflo(hw_.y), bfhi(hw_.y)}; } } _Pragma("unroll") for (int k = 0; k < 4; ++k) { const u32x2* yp = (const u32x2*)(YS + ((size_t)(r_) * 4 + k) * D) + lane; _Pragma("unroll") for (int j = 0; j < 4; ++j) yn[k][j] = yp[64 * j]; } } while (0)
            if (F.gw < M) CMB_LOAD(F.gw);
            for (int row = F.gw; row < M; row += F.NGW) {
                asm volatile("" ::: "memory");
                f32x4 v[4];
#pragma unroll
                for (int j = 0; j < 4; ++j) v[j] = hn[j] * ALPHA;
#pragma unroll
                for (int k = 0; k < 4; ++k)
#pragma unroll
                    for (int j = 0; j < 4; ++j) { const u32x2 yw = yn[k][j]; v[j][0] += bflo(yw.x); v[j][1] += bfhi(yw.x); v[j][2] += bflo(yw.y); v[j][3] += bfhi(yw.y); }
                if (row + F.NGW < M) CMB_LOAD(row + F.NGW);
                { f32x4 gv[4], bv[4]; load_row_f32(lng_, gv, lane); load_row_f32(lnb_, bv, lane); ln_row(v, gv, bv); }
                if (layer == 3) store_row_f32(outp + (size_t)row * D, v, lane);
                if (layer < 3) store_row_bf16(XBo + (size_t)row * D, v, lane);
                if (layer == 1) {
                    const float zsum = row_dot16(v, Wt, lane);
                    if ((lane & 3) == 0) GB[(size_t)row * 16 + (lane >> 2)] = zsum;
                }
            }
            if (layer == 1) {
                __syncthreads();
                const float* wgp = INP(11); const float bgc = INP(12)[tid];
                float wg[16];
#pragma unroll
                for (int r = 0; r < 16; ++r) wg[r] = wgp[r * 512 + tid];
                for (int row = F.vcu * NWAVES; row < M; row += F.NGW) {
                    f32x4 zv[NWAVES][4];
#pragma unroll
                    for (int w = 0; w < NWAVES; ++w)
#pragma unroll
                        for (int q = 0; q < 4; ++q) zv[w][q] = *(const f32x4*)(GB + (size_t)(row + w) * 16 + 4 * q);
#pragma unroll
                    for (int w = 0; w < NWAVES; ++w) { float sacc = bgc;
#pragma unroll
                        for (int q = 0; q < 4; ++q) sacc += zv[w][q][0] * wg[4 * q] + zv[w][q][1] * wg[4 * q + 1] + zv[w][q][2] * wg[4 * q + 2] + zv[w][q][3] * wg[4 * q + 3];
                        LA[(size_t)(row + w) * 512 + tid] = log_sigmoidf_(sacc) * (1.f / 16.f); }
                }
            }
          }
            __syncthreads();
#undef CMB_LOAD
            if (layer < 3) SEAM(pb + 11);
        }
}
__global__ void __launch_bounds__(NTHREADS, 2) mega_fwd(Args args) {
    extern __shared__ __attribute__((aligned(16))) unsigned char lds_raw[];
    Frame F;
    F.lds = (LAS unsigned char*)lds_raw;
    F.wave = __builtin_amdgcn_readfirstlane((int)threadIdx.x >> 6);
    F.G = gridDim.x; { const int bx = blockIdx.x; F.vcu = (F.G % 8 == 0) ? (bx % 8) * (F.G / 8) + bx / 8 : bx; }
    F.gw = F.vcu * NWAVES + F.wave; F.NGW = F.G * NWAVES;
    unsigned char* ws = args.ws;
    unsigned* ctl = (unsigned*)(ws + WS_CTL);
    volatile LAS unsigned* MISC = (volatile LAS unsigned*)(F.lds + MISC_OFF);
    LAS int* TAB = (LAS int*)(F.lds + TAB_OFF);
    { const int tid0 = threadIdx.x;
      if (tid0 < 64) MISC[tid0] = 0u;
      if (tid0 < 33) ((LAS unsigned long long*)(F.lds + MISC_OFF + 256))[tid0] = (unsigned long long)args.in[tid0]; }
    __syncthreads();
    XcdBarrier bar = xcd_barrier_post(ctl + CW_BAR, MISC + 8, F.wave == 0 && lane_id() == 0);
    if (PROBE_T >= 0 && blockIdx.x == 0 && F.wave == 0 && lane_id() == 0) { volatile LAS unsigned long long* st = (volatile LAS unsigned long long*)(F.lds + MISC_OFF + 1024); st[0] = __builtin_amdgcn_s_memrealtime(); st[1] = 0ull; }
    const int lo = args.ph_lo, hi = args.ph_hi;
    WS_PTRS
    if (IN(0) && !defined_SKIP_P0) { const int lane = lane_id(), tid = F.wave * 64 + lane; (void)tid;
      {
        LAS unsigned char* scr = F.lds + F.wave * 8704;
        {
            constexpr int I_GU = 128 * 16 * 32, I_DN = 128 * 16 * 16, I_ML = 16 * 48, I_SQ = 16 * 16, I_RI = 16 * 96, I_RO = 32 * 16;
            constexpr int B0 = I_GU, B1 = B0 + I_DN, B2 = B1 + I_ML, B3 = B2 + I_SQ, B4 = B3 + I_RI, B5 = B4 + I_RO, B6 = B5 + I_ML, B7 = B6 + I_SQ, B8 = B7 + I_SQ, B9 = B8 + I_SQ, B10 = B9 + I_SQ;
#define P0_ITEM(IT_) do { const int it = (IT_); \
                    const float* src; bf16* dst; int ldw, Kd, nnb, mode = 0, r; \
                    if (it < B0)      { r = it;      const int q = r / (16 * 32); r -= q * (16 * 32); src = INP(29) + (size_t)q * 1024 * 2048; dst = (bf16*)(ws + WS_WT_GU) + (size_t)q * 2048 * 1024; ldw = 2048; Kd = 1024; nnb = 32; mode = 1; } \
                    else if (it < B1) { r = it - B0; const int q = r / (16 * 16); r -= q * (16 * 16); src = INP(31) + (size_t)q * 1024 * 1024; dst = (bf16*)(ws + WS_WT_DN) + (size_t)q * 1024 * 1024; ldw = 1024; Kd = 1024; nnb = 16; } \
                    else if (it < B2) { r = it - B1; src = INP(3);  dst = (bf16*)(ws + WS_WT_ML_IN);  ldw = 3088; Kd = 1024; nnb = 48; } \
                    else if (it < B3) { r = it - B2; src = INP(6);  dst = (bf16*)(ws + WS_WT_ML_OUT); ldw = 1024; Kd = 1024; nnb = 16; } \
                    else if (it < B4) { r = it - B3; src = INP(7);  dst = (bf16*)(ws + WS_WT_RET_IN); ldw = 6144; Kd = 1024; nnb = 96; mode = 2; } \
                    else if (it < B5) { r = it - B4; src = INP(9);  dst = (bf16*)(ws + WS_WT_RET_OUT); ldw = 1024; Kd = 2048; nnb = 16; } \
                    else if (it < B6) { r = it - B5; src = INP(10); dst = (bf16*)(ws + WS_WT_GLA_IN); ldw = 3088; Kd = 1024; nnb = 48; } \
                    else if (it < B7) { r = it - B6; src = INP(14); dst = (bf16*)(ws + WS_WT_GLA_OUT); ldw = 1024; Kd = 1024; nnb = 16; } \
                    else if (it < B8) { r = it - B7; src = INP(15); dst = (bf16*)(ws + WS_WT_S5_IN);  ldw = 1024; Kd = 1024; nnb = 16; } \
                    else if (it < B9) { r = it - B8; src = INP(24); dst = (bf16*)(ws + WS_WT_S5_GLU); ldw = 1024; Kd = 1024; nnb = 16; } \
                    else              { r = it - B9; src = INP(26); dst = (bf16*)(ws + WS_WT_S5_OUT); ldw = 1024; Kd = 1024; nnb = 16; } \
                const int kb = r / nnb, nb = r - kb * nnb; \
                transpose_item(src, ldw, 0, Kd, dst, mode, kb, nb, scr, lane); } while (0)
            const int NSTAT = (B10 / F.NGW) * 4 / 5, DYN0 = NSTAT * F.NGW, DLEN = B10 - DYN0, GLEN = (DLEN + 7) / 8;
#pragma unroll 1
            for (int n_ = 0; n_ < NSTAT; ++n_) P0_ITEM(F.gw + n_ * F.NGW);
#pragma unroll 1
            for (int tr = 0; tr < 8; ++tr) { const int grp = ((int)blockIdx.x + tr) & 7; unsigned* q = ctl + 2304 + 64 * grp; const int glo = DYN0 + grp * GLEN, glen = (DLEN - grp * GLEN) < GLEN ? (DLEN - grp * GLEN) : GLEN;
                int cur = 0; if (lane == 0) cur = (int)__hip_atomic_fetch_add(q, 4u, __ATOMIC_RELAXED, __HIP_MEMORY_SCOPE_AGENT); cur = __builtin_amdgcn_readfirstlane(cur);
#pragma unroll 1
                while (cur < glen) { int nx = 0; if (lane == 0) nx = (int)__hip_atomic_fetch_add(q, 4u, __ATOMIC_RELAXED, __HIP_MEMORY_SCOPE_AGENT);
#pragma unroll 1
                    for (int k = 0; k < 4; ++k) if (cur + k < glen) P0_ITEM(glo + cur + k);
                    cur = __builtin_amdgcn_readfirstlane(nx); } }
#undef P0_ITEM
        }
        __syncthreads();
        if (CH_S5) s5_tables(F, ws, tid, INP(16), INP(17), INP(18), INP(19), INP(20), INP(21), INP(23));
        { float* CS = (float*)(ws + WS_CS);
          for (int it = blockIdx.x * NTHREADS + tid; it < T * 64; it += F.G * NTHREADS) { const int t = it >> 6, i = it & 63;
              const float inv = exp2f(-(float)(2 * i) * (13.287712379549449f / 128.f)); float sn, cs; sincosf((float)t * inv, &sn, &cs); CS[2 * it] = cs; CS[2 * it + 1] = sn; } }
        LAS float* Wt = (LAS float*)(F.lds);
        load_cols16(tid, INP(3), 3088, 3072, Wt);
        __syncthreads();
        {
            const float* bg = INP(4);
            f32x4 vn[4]; if (F.gw < M) load_row_f32(x_in + (size_t)F.gw * D, vn, lane);
            for (int row = F.gw; row < M; row += F.NGW) {
                asm volatile("" ::: "memory");
                f32x4 v[4];
#pragma unroll
                for (int j = 0; j < 4; ++j) v[j] = vn[j];
                if (row + F.NGW < M) load_row_f32(x_in + (size_t)(row + F.NGW) * D, vn, lane);
                store_row_bf16(XB + (size_t)row * D, v, lane);
                const float gsum = row_dot16(v, Wt, lane);
                if ((lane & 3) == 0) GB[(size_t)row * 16 + (lane >> 2)] = gsum + bg[lane >> 2];
            }
        }
        __syncthreads();
      }
        SEAM(0);
    }

    layer_body<0>(F, ws, ctl, TAB, bar, lo, hi, args.out);
    layer_body<1>(F, ws, ctl, TAB, bar, lo, hi, args.out);
    layer_body<2>(F, ws, ctl, TAB, bar, lo, hi, args.out);
    layer_body<3>(F, ws, ctl, TAB, bar, lo, hi, args.out);
    if (PROBE_T >= 0 && blockIdx.x == 0 && F.wave == 0 && lane_id() == 0) { volatile LAS unsigned long long* st = (volatile LAS unsigned long long*)(F.lds + MISC_OFF + 1024); args.out[0] = (float)st[1] * (0.01f / 16.f); }
#undef IN
#undef SEAM
#undef INP
#undef x_in
#undef ln_g
#undef ln_b
}

extern "C" void kernel_launch(void* const* d_in, const int* in_sizes, int n_in, void* d_out, int out_size, void* d_ws, size_t ws_size, hipStream_t stream) {
    static int grid = 0;
    if (grid == 0) {
        if (n_in != 33 || out_size != M * D || ws_size < WS_END) { fprintf(stderr, "kernel_launch: unexpected problem (n_in %d, out %d, ws %zu < %zu)\n", n_in, out_size, ws_size, (size_t)WS_END); grid = -1; return; }
        int dev = 0, cus = 0, per_cu = 0;
        if (hipGetDevice(&dev) != hipSuccess || hipDeviceGetAttribute(&cus, hipDeviceAttributeMultiprocessorCount, dev) != hipSuccess) { grid = -1; return; }
        if (hipFuncSetAttribute((const void*)mega_fwd, hipFuncAttributeMaxDynamicSharedMemorySize, LDS_BYTES) != hipSuccess) { fprintf(stderr, "kernel_launch: hipFuncSetAttribute failed\n"); grid = -1; return; }
        if (hipOccupancyMaxActiveBlocksPerMultiprocessor(&per_cu, (const void*)mega_fwd, NTHREADS, LDS_BYTES) != hipSuccess || per_cu < 1) { fprintf(stderr, "kernel_launch: occupancy query says %d\n", per_cu); }
        (void)hipGetLastError();
        grid = cus;
    }
    if (grid < 0) return;
    hipMemsetAsync((char*)d_ws + WS_CTL, 0, CTL_ZERO_BYTES, stream);
    Args a{};
    for (int i = 0; i < 33; ++i) a.in[i] = (const float*)d_in[i];
    a.out = (float*)d_out; a.ws = (unsigned char*)d_ws;
#if N_LAUNCH_MODE == 1
    a.ph_lo = 0; a.ph_hi = 1000;
    hipLaunchKernelGGL(mega_fwd, dim3(grid), dim3(NTHREADS), LDS_BYTES, stream, a);
#else
    for (int ph = 0; ph < 65; ++ph) { a.ph_lo = ph; a.ph_hi = ph + 1; hipLaunchKernelGGL(mega_fwd, dim3(grid), dim3(NTHREADS), LDS_BYTES, stream, a); }
#endif
}
```

```cpp
#include <hip/hip_runtime.h>
#include <cstdio>
#include <cstdint>

#ifndef NAIVE_MIX
#define NAIVE_MIX 1
#endif
#ifndef CH_ML
#define CH_ML 1
#endif
#ifndef CH_RET
#define CH_RET 1
#endif
#ifndef CH_GLA
#define CH_GLA 1
#endif
#ifndef CH_S5
#define CH_S5 1
#endif
#ifndef PROBE_CLS
#define PROBE_CLS 0
#endif
#define REPS(c) ((PROBE_CLS == (c) || PROBE_CLS == 100 + layer * 10 + (c)) ? 2 : 1)
#ifndef PROBE_T
#define PROBE_T -1
#endif
#ifndef PROBE_T2
#define PROBE_T2 PROBE_T
#endif
#ifndef MOE_ALIGN
#define MOE_ALIGN true
#endif
#ifndef N_LAUNCH_MODE
#define N_LAUNCH_MODE 1
#endif


#ifdef SKIP_ML
constexpr bool defined_SKIP_ML = true;
#else
constexpr bool defined_SKIP_ML = false;
#endif
#ifdef SKIP_RET
constexpr bool defined_SKIP_RET = true;
#else
constexpr bool defined_SKIP_RET = false;
#endif
#ifdef SKIP_GLA
constexpr bool defined_SKIP_GLA = true;
#else
constexpr bool defined_SKIP_GLA = false;
#endif
#ifdef SKIP_S5
constexpr bool defined_SKIP_S5 = true;
#else
constexpr bool defined_SKIP_S5 = false;
#endif
#ifdef SKIP_LN1
constexpr bool defined_SKIP_LN1 = true;
#else
constexpr bool defined_SKIP_LN1 = false;
#endif
#ifdef SKIP_P0
constexpr bool defined_SKIP_P0 = true;
#else
constexpr bool defined_SKIP_P0 = false;
#endif
#ifndef PHMASK
#define PHMASK 0xffff
#endif
#define PHE(b) (((PHMASK) >> (b)) & 1)
#define GAS __attribute__((address_space(1)))
#define LAS __attribute__((address_space(3)))
typedef unsigned short bf16;
typedef short bf16x8 __attribute__((ext_vector_type(8)));
typedef float f32x4 __attribute__((ext_vector_type(4)));
typedef float f32x2 __attribute__((ext_vector_type(2)));
typedef unsigned u32x4 __attribute__((ext_vector_type(4)));
typedef unsigned u32x2 __attribute__((ext_vector_type(2)));

constexpr int BATCH = 2, T = 8192, D = 1024, M = BATCH * T;
constexpr int NEXP = 32, TOPK = 4, DFF = 1024, CAP = M;
constexpr int NWAVES = 8, NTHREADS = 512;
constexpr float LN_EPS = 1e-5f;
constexpr float ALPHA = 1.681792830507429f;
constexpr int MAXTILES = (M * TOPK) / 256 + NEXP;

constexpr size_t MiB = 1u << 20;
constexpr size_t WS_CTL = 0, CTL_ZERO_BYTES = 1 * MiB;
constexpr size_t WS_WT_ML_IN = 1 * MiB;
constexpr size_t WS_WT_ML_OUT = WS_WT_ML_IN + 6 * MiB;
constexpr size_t WS_WT_RET_IN = WS_WT_ML_OUT + 2 * MiB;
constexpr size_t WS_WT_RET_OUT = WS_WT_RET_IN + 12 * MiB;
constexpr size_t WS_WT_GLA_IN = WS_WT_RET_OUT + 4 * MiB;
constexpr size_t WS_WT_GLA_OUT = WS_WT_GLA_IN + 6 * MiB;
constexpr size_t WS_WT_S5_IN = WS_WT_GLA_OUT + 2 * MiB;
constexpr size_t WS_WT_S5_GLU = WS_WT_S5_IN + 2 * MiB;
constexpr size_t WS_WT_S5_OUT = WS_WT_S5_GLU + 2 * MiB;
constexpr size_t WS_S5TAB = WS_WT_S5_OUT + 2 * MiB;
constexpr size_t WS_GB = WS_S5TAB + 1 * MiB;
constexpr size_t WS_LIST = WS_GB + 1 * MiB;
constexpr size_t WS_GW = WS_LIST + 2 * MiB;
constexpr size_t WS_WT_GU = WS_GW + 1 * MiB;
constexpr size_t WS_WT_DN = WS_WT_GU + 512 * MiB;
constexpr size_t WS_HF = WS_WT_DN + 256 * MiB;
constexpr size_t WS_XB = WS_HF + 64 * MiB;
constexpr size_t WS_ZF = WS_XB + 32 * MiB;
constexpr size_t WS_PB = WS_ZF + 64 * MiB;
constexpr size_t WS_LA = WS_PB + 192 * MiB;
constexpr size_t WS_ORAW = WS_LA + 32 * MiB;
constexpr size_t WS_YB = WS_ORAW + 128 * MiB;
constexpr size_t WS_ACT = WS_YB + 64 * MiB;
constexpr size_t WS_YS = WS_ACT + 144 * MiB;
constexpr size_t WS_XG = WS_YS + 256 * MiB;
constexpr size_t WS_UT = WS_XG + 1024 * MiB;
constexpr size_t WS_ST = WS_UT + 128 * MiB;
constexpr size_t WS_KPP = WS_ST + 64 * MiB;
constexpr size_t WS_SC = WS_KPP + 16 * MiB;
constexpr size_t WS_S5KT = WS_SC + 4 * MiB;
constexpr size_t WS_S5VT = WS_S5KT + 2 * MiB;
constexpr size_t WS_S5WT = WS_S5VT + 16 * MiB;
constexpr size_t WS_S5L64 = WS_S5WT + 16 * MiB;
constexpr size_t WS_S5SL = WS_S5L64 + 1 * MiB;
constexpr size_t WS_S5SP = WS_S5SL + 16 * MiB;
constexpr size_t WS_CS = WS_S5SP + 8 * MiB;
constexpr size_t WS_END = WS_CS + 4 * MiB;
constexpr int CW_BAR = 4096;
constexpr int CW_CNT = 16384;

constexpr int PH_BYTES = 139264;
constexpr int TAB_OFF = PH_BYTES;
constexpr int MISC_OFF = TAB_OFF + 16384;
constexpr int LDS_BYTES = 159744;

typedef __bf16 bf16x2_t __attribute__((ext_vector_type(2)));
__device__ __forceinline__ unsigned pk2(float lo, float hi) { const f32x2 v = {lo, hi}; const bf16x2_t b = __builtin_convertvector(v, bf16x2_t); return __builtin_bit_cast(unsigned, b); }
__device__ __forceinline__ unsigned f2bf(float f) { return pk2(f, 0.f) & 0xffffu; }
__device__ __forceinline__ float bf2f(unsigned short b) { return __builtin_bit_cast(float, ((unsigned)b) << 16); }
__device__ __forceinline__ float bflo(unsigned w) { return __builtin_bit_cast(float, w << 16); }
__device__ __forceinline__ float bfhi(unsigned w) { return __builtin_bit_cast(float, w & 0xffff0000u); }
__device__ __forceinline__ int lane_id() { int l; asm volatile("v_mbcnt_lo_u32_b32 %0, -1, 0\n\tv_mbcnt_hi_u32_b32 %0, -1, %0" : "=v"(l)); return l; }
template <int CTRL> __device__ __forceinline__ float dpp_f(float v) { return __builtin_bit_cast(float, __builtin_amdgcn_update_dpp(0, __builtin_bit_cast(int, v), CTRL, 0xf, 0xf, false)); }
__device__ __forceinline__ float rl_f(float v, int l) { return __builtin_bit_cast(float, __builtin_amdgcn_readlane(__builtin_bit_cast(int, v), l)); }
__device__ __forceinline__ float wave_sum(float v) {
    v += dpp_f<0xB1>(v);
    v += dpp_f<0x4E>(v);
    v += dpp_f<0x141>(v);
    v += dpp_f<0x140>(v);
    return (rl_f(v, 0) + rl_f(v, 16)) + (rl_f(v, 32) + rl_f(v, 48));
}
__device__ __forceinline__ float row16_sum(float v) { v += dpp_f<0xB1>(v); v += dpp_f<0x4E>(v); v += dpp_f<0x141>(v); v += dpp_f<0x140>(v); return v; }
__device__ __forceinline__ float wave_max(float v) {
    v = fmaxf(v, dpp_f<0xB1>(v)); v = fmaxf(v, dpp_f<0x4E>(v)); v = fmaxf(v, dpp_f<0x141>(v)); v = fmaxf(v, dpp_f<0x140>(v));
    return fmaxf(fmaxf(rl_f(v, 0), rl_f(v, 16)), fmaxf(rl_f(v, 32), rl_f(v, 48)));
}
__device__ __forceinline__ float sigmoidf_(float x) { return __builtin_amdgcn_rcpf(1.f + __expf(-x)); }
__device__ __forceinline__ float log_sigmoidf_(float x) { return fminf(x, 0.f) - __logf(1.f + __expf(-fabsf(x))); }
__device__ __forceinline__ float gelu_tanh(float x) { const float u = 0.7978845608028654f * (x + 0.044715f * x * x * x); return x * sigmoidf_(2.f * u); }

namespace pg8 {
constexpr int BM = 256, BK = 64, HALF = 128, HTB = HALF * BK * 2, STAGE_BYTES = 8 * HTB, NXCD = 8, WGM = 8;
__host__ __device__ __forceinline__ int lds_byte(int r, int c) { const int st = (r >> 4) * 2 + (c >> 5), rr = r & 15, cc = c & 31, ob = rr * 64 + cc * 2; return st * 1024 + (ob ^ (((ob >> 9) & 1) << 5)); }
__host__ __device__ __forceinline__ void stage_rc(int b, int& R, int& C) { const int st = b / 1024, sb = b % 1024, swz = sb ^ (((sb >> 9) & 1) << 5); R = (st >> 1) * 16 + swz / 64; C = (st & 1) * 32 + (swz % 64) / 2; }
__host__ __device__ __forceinline__ int perm32(int rho) { const int n = rho >> 4, i = rho & 15; return 8 * (i >> 2) + 4 * n + (i & 3); }

struct Unit { const char* A; const char* B; int pm, pn, e, nvalid, r0, buf; };

__device__ __forceinline__ int xcd_remap(int L, int nwg) { const int q = nwg / NXCD, r = nwg % NXCD, xcd = L % NXCD, off = L / NXCD; return (xcd < r ? xcd * (q + 1) : r * (q + 1) + (xcd - r) * q) + off; }

struct DenseOrder {
    const char* A; const char* Bt; int K, nM, nN, nwg, G, c; const int* list; const float* gwl; static constexpr int a_compact = 0;
    __device__ __forceinline__ void init(const void* A_, const void* Bt_, int M_, int N_, int K_, int G_, int c_) { A = (const char*)A_; Bt = (const char*)Bt_; K = K_; nM = M_ / BM; nN = N_ / BM; nwg = nM * nN; G = G_; c = c_; list = nullptr; gwl = nullptr; }
    __device__ __forceinline__ bool next(int i, Unit& u) const {
        const long L = (long)i * G + c; if (L >= nwg) return false;
        const int wgid = xcd_remap((int)L, nwg);
        const int nig = WGM * nN, gid = wgid / nig, fm = gid * WGM, gsz = (nM - fm) < WGM ? (nM - fm) : WGM;
        u.pm = fm + ((wgid % nig) % gsz); u.pn = (wgid % nig) / gsz; u.e = 0; u.nvalid = 256; u.r0 = 0;
        u.A = A + (size_t)u.pm * 256 * K * 2; u.B = Bt + (size_t)u.pn * 256 * K * 2; return true;
    }
};
struct MoeOrder {
    const char* A; const char* Bt; const LAS int* tab;
    int K, nN, ntiles, nwg, G, c; size_t b_estride; int a_compact; const int* list; const float* gwl;
    __device__ __forceinline__ bool next(int i, Unit& u) const {
        const long L = (long)i * G + c; if (L >= nwg) return false;
        const int wgid = xcd_remap((int)L, nwg);
        const int nig = WGM * nN, gid = wgid / nig, fm = gid * WGM, gsz = (ntiles - fm) < WGM ? (ntiles - fm) : WGM;
        const int tl = fm + ((wgid % nig) % gsz); u.pm = tl; u.pn = (wgid % nig) / gsz;
        const int e = __builtin_amdgcn_readfirstlane(tab[72 + tl]); u.e = e; const int r0 = (tl - __builtin_amdgcn_readfirstlane(tab[32 + e])) * 256; const int rem = __builtin_amdgcn_readfirstlane(tab[e]) - r0; u.nvalid = rem < 256 ? rem : 256; u.r0 = r0;
        u.A = (a_compact == 2) ? A : a_compact ? A + (size_t)tl * 256 * K * 2 : A + ((size_t)e * CAP + r0) * K * 2;
        u.B = Bt + (size_t)e * b_estride + (size_t)u.pn * 256 * K * 2; return true;
    }
};

__device__ __forceinline__ unsigned cvt_pk_bf16(float lo, float hi) { unsigned r; asm volatile("v_cvt_pk_bf16_f32 %0, %1, %2" : "=v"(r) : "v"(lo), "v"(hi)); return r; }

struct EpiBf16 {
    static constexpr bool BIASTAB = false; static constexpr bool ROWINFO = false; static constexpr bool PERM = true;
    bf16* O; int ldc; const float* cs; int rot_tiles;
    __device__ __forceinline__ void operator()(const f32x4 (&acc)[2][2][4][2], const Unit& u, int wr, int wc, int fr, int fq) const {
        const int row0 = u.pm * BM + wr * 64 + fr, col0 = u.pn * BM + wc * 32 + 8 * fq;
        const bool rot = u.pn < rot_tiles; const float sc = (col0 >= 1024) ? 0.08838834764831845f : 1.f;
#pragma unroll
        for (int ai = 0; ai < 2; ++ai)
#pragma unroll
            for (int m = 0; m < 4; ++m) { const int row = row0 + ai * HALF + m * 16; bf16* rowp = O + (size_t)row * ldc + col0;
#pragma unroll
                for (int bj = 0; bj < 2; ++bj) { f32x4 v0 = acc[ai][bj][m][0], v1 = acc[ai][bj][m][1];
                    if (rot) { const float* cp = cs + ((size_t)(row & (T - 1)) * 64 + (((col0 + bj * HALF) & 127) >> 1)) * 2; const f32x4 c0 = *(const f32x4*)cp, c1 = *(const f32x4*)(cp + 4);
                        const f32x4 a0 = v0, a1 = v1;
                        v0[0] = (a0[0] * c0[0] - a0[1] * c0[1]) * sc; v0[1] = (a0[0] * c0[1] + a0[1] * c0[0]) * sc; v0[2] = (a0[2] * c0[2] - a0[3] * c0[3]) * sc; v0[3] = (a0[2] * c0[3] + a0[3] * c0[2]) * sc;
                        v1[0] = (a1[0] * c1[0] - a1[1] * c1[1]) * sc; v1[1] = (a1[0] * c1[1] + a1[1] * c1[0]) * sc; v1[2] = (a1[2] * c1[2] - a1[3] * c1[3]) * sc; v1[3] = (a1[2] * c1[3] + a1[3] * c1[2]) * sc; }
                    u32x4 w; w.x = cvt_pk_bf16(v0[0], v0[1]); w.y = cvt_pk_bf16(v0[2], v0[3]); w.z = cvt_pk_bf16(v1[0], v1[1]); w.w = cvt_pk_bf16(v1[2], v1[3]);
                    *(u32x4*)(rowp + bj * HALF) = w; } }
    }
};
struct EpiResid {
    static constexpr bool BIASTAB = false; static constexpr bool ROWINFO = false; static constexpr bool PERM = true;
    const float* __restrict__ hin; const bf16* __restrict__ hinb; bf16* __restrict__ Z;
    __device__ __forceinline__ void operator()(const f32x4 (&acc)[2][2][4][2], const Unit& u, int wr, int wc, int fr, int fq) const {
        const int row0 = u.pm * BM + wr * 64 + fr, col0 = u.pn * BM + wc * 32 + 8 * fq;
#pragma unroll
        for (int ai = 0; ai < 2; ++ai)
#pragma unroll
            for (int m = 0; m < 4; ++m) { const size_t off = (size_t)(row0 + ai * HALF + m * 16) * D + col0;
                f32x4 hv[2][2];
                if (hinb) {
#pragma unroll
                    for (int bj = 0; bj < 2; ++bj) { const u32x4 hw = *(const u32x4*)(hinb + off + bj * HALF);
                        hv[bj][0] = (f32x4){bflo(hw.x), bfhi(hw.x), bflo(hw.y), bfhi(hw.y)}; hv[bj][1] = (f32x4){bflo(hw.z), bfhi(hw.z), bflo(hw.w), bfhi(hw.w)}; }
                } else {
#pragma unroll
                    for (int bj = 0; bj < 2; ++bj)
#pragma unroll
                        for (int n = 0; n < 2; ++n) hv[bj][n] = *(const f32x4*)(hin + off + bj * HALF + n * 4);
                }
#pragma unroll
                for (int bj = 0; bj < 2; ++bj) { const f32x4 v0 = hv[bj][0] * ALPHA + acc[ai][bj][m][0], v1 = hv[bj][1] * ALPHA + acc[ai][bj][m][1];
                    u32x4 w; w.x = cvt_pk_bf16(v0[0], v0[1]); w.y = cvt_pk_bf16(v0[2], v0[3]); w.z = cvt_pk_bf16(v1[0], v1[1]); w.w = cvt_pk_bf16(v1[2], v1[3]);
                    *(u32x4*)(Z + off + bj * HALF) = w; } }
    }
};
struct EpiGlu {
    static constexpr bool BIASTAB = false; static constexpr bool ROWINFO = false; static constexpr bool PERM = true;
    const bf16* Y; const float* bias; bf16* O;
    __device__ __forceinline__ void operator()(const f32x4 (&acc)[2][2][4][2], const Unit& u, int wr, int wc, int fr, int fq) const {
        const int row0 = u.pm * BM + wr * 64 + fr, col0 = u.pn * BM + wc * 32 + 8 * fq;
#pragma unroll
        for (int ai = 0; ai < 2; ++ai)
#pragma unroll
            for (int m = 0; m < 4; ++m) { const size_t off = (size_t)(row0 + ai * HALF + m * 16) * D + col0;
#pragma unroll
                for (int bj = 0; bj < 2; ++bj) {
                    const f32x4 b0 = *(const f32x4*)(bias + col0 + bj * HALF), b1 = *(const f32x4*)(bias + col0 + bj * HALF + 4);
                    const u32x4 yw = *(const u32x4*)(Y + off + bj * HALF);
                    const f32x4 v0 = acc[ai][bj][m][0] + b0, v1 = acc[ai][bj][m][1] + b1;
                    float o[8];
                    o[0] = bflo(yw.x) * sigmoidf_(v0[0]); o[1] = bfhi(yw.x) * sigmoidf_(v0[1]); o[2] = bflo(yw.y) * sigmoidf_(v0[2]); o[3] = bfhi(yw.y) * sigmoidf_(v0[3]);
                    o[4] = bflo(yw.z) * sigmoidf_(v1[0]); o[5] = bfhi(yw.z) * sigmoidf_(v1[1]); o[6] = bflo(yw.w) * sigmoidf_(v1[2]); o[7] = bfhi(yw.w) * sigmoidf_(v1[3]);
                    u32x4 w; w.x = cvt_pk_bf16(o[0], o[1]); w.y = cvt_pk_bf16(o[2], o[3]); w.z = cvt_pk_bf16(o[4], o[5]); w.w = cvt_pk_bf16(o[6], o[7]);
                    *(u32x4*)(O + off + bj * HALF) = w; } }
    }
};
struct EpiSwiglu {
    static constexpr bool BIASTAB = true; static constexpr bool ROWINFO = false; static constexpr bool PERM = true;
    bf16* ACT; const float* bgu; const LAS float* btab;
    __device__ __forceinline__ float bias_at(const Unit& u, int j) const { return bgu[(size_t)u.e * 2 * DFF + (j < HALF ? 0 : DFF) + u.pn * HALF + (j & (HALF - 1))]; }
    __device__ __forceinline__ void operator()(const f32x4 (&acc)[2][2][4][2], const Unit& u, int wr, int wc, int fr, int fq) const {
        const int row0 = u.pm * BM + wr * 64 + fr, j0 = u.pn * HALF + wc * 32 + 8 * fq;
        const LAS float* bt = btab + u.buf * 256 + wc * 32 + 8 * fq;
        const f32x4 g0 = *(const LAS f32x4*)(bt), g1 = *(const LAS f32x4*)(bt + 4), u0 = *(const LAS f32x4*)(bt + HALF), u1 = *(const LAS f32x4*)(bt + HALF + 4);
#pragma unroll
        for (int ai = 0; ai < 2; ++ai)
#pragma unroll
            for (int m = 0; m < 4; ++m) {
                float o[8];
#pragma unroll
                for (int n = 0; n < 2; ++n)
#pragma unroll
                    for (int i = 0; i < 4; ++i) {
                        float g = acc[ai][0][m][n][i] + (n ? g1[i] : g0[i]), up = acc[ai][1][m][n][i] + (n ? u1[i] : u0[i]);
                        g = fminf(g, 7.0f); up = fminf(fmaxf(up, -7.0f), 7.0f);
                        o[n * 4 + i] = (up + 1.0f) * g * sigmoidf_(1.702f * g); }
                u32x4 w; w.x = cvt_pk_bf16(o[0], o[1]); w.y = cvt_pk_bf16(o[2], o[3]); w.z = cvt_pk_bf16(o[4], o[5]); w.w = cvt_pk_bf16(o[6], o[7]);
                *(u32x4*)(ACT + (size_t)(row0 + ai * HALF + m * 16) * DFF + j0) = w; }
    }
};
struct EpiMoeDown {
    static constexpr bool BIASTAB = true; static constexpr bool ROWINFO = true; static constexpr bool PERM = true;
    bf16* YS; const float* bd; const LAS int* rinfo; const LAS float* btab;
    __device__ __forceinline__ float bias_at(const Unit& u, int j) const { return bd[(size_t)u.e * D + u.pn * BM + j]; }
    __device__ __forceinline__ void operator()(const f32x4 (&acc)[2][2][4][2], const Unit& u, int wr, int wc, int fr, int fq) const {
        const int col0 = u.pn * BM + wc * 32 + 8 * fq;
        const LAS float* bt = btab + u.buf * 256 + wc * 32 + 8 * fq;
        f32x4 bv[2][2];
#pragma unroll
        for (int bj = 0; bj < 2; ++bj)
#pragma unroll
            for (int n = 0; n < 2; ++n) bv[bj][n] = *(const LAS f32x4*)(bt + bj * HALF + 4 * n);
        const LAS int* ri = rinfo + u.buf * 512;
#pragma unroll
        for (int ai = 0; ai < 2; ++ai)
#pragma unroll
            for (int m = 0; m < 4; ++m) { const int r = ai * HALF + wr * 64 + m * 16 + fr; const int slot = ri[r];
                if (slot >= 0) { const float gg = __builtin_bit_cast(float, ri[256 + r]); bf16* op = YS + (size_t)slot * D + col0;
#pragma unroll
                    for (int bj = 0; bj < 2; ++bj) { const f32x4 v0 = (acc[ai][bj][m][0] + bv[bj][0]) * gg, v1 = (acc[ai][bj][m][1] + bv[bj][1]) * gg;
                        u32x4 w; w.x = cvt_pk_bf16(v0[0], v0[1]); w.y = cvt_pk_bf16(v0[2], v0[3]); w.z = cvt_pk_bf16(v1[0], v1[1]); w.w = cvt_pk_bf16(v1[2], v1[3]);
                        *(u32x4*)(op + bj * HALF) = w; } } }
    }
};

template <class Epi, class Sched, bool ALIGN_EPI, bool SP2, bool GATHER = false>
__device__ __forceinline__ void gemm_phase(LAS unsigned char* lds, const int wid, const int K, const Sched& S, const Epi& E, LAS int* rowtab = nullptr) {
    const int lane = lane_id(), tid = wid * 64 + lane, wr = wid >> 2, wc = wid & 3, fr = lane & 15, fq = lane >> 4;
    const int nt = K / BK;
    unsigned voffA[2], voffB[2]; int Rr[2]; unsigned Cc2[2];
#pragma unroll
    for (int i = 0; i < 2; ++i) { int R, C; stage_rc(tid * 16 + i * 8192, R, C); const int Rb = Epi::PERM ? ((R & ~31) + perm32(R & 31)) : R;
        voffA[i] = (unsigned)(R * K + C) * 2u; voffB[i] = (unsigned)(Rb * K + C) * 2u; Rr[i] = R; Cc2[i] = (unsigned)C * 2u; }
    unsigned vA[2][2] = {{0u, 0u}, {0u, 0u}}, vN[2][2] = {{0u, 0u}, {0u, 0u}};
    const size_t kstep = (size_t)(BK * 2);
    const size_t hstep = (size_t)HALF * K * 2;
    const unsigned ldsw = (unsigned)wid * 1024u;
    const int aoff = lds_byte(wr * 64 + fr, fq * 8), boff = lds_byte(wc * 32 + fr, fq * 8);
#define PG8_SA(b, h) (((b) * 2 + (h)) * HTB)
#define PG8_SB(b, h) ((4 + (b) * 2 + (h)) * HTB)
#define PG8_STAGE(bufoff, gbase, voff) do { _Pragma("unroll") for (int _i = 0; _i < 2; ++_i) \
        __builtin_amdgcn_global_load_lds((const unsigned*)((const char*)(gbase) + (voff)[_i]), (LAS unsigned*)(lds + (bufoff) + ldsw + _i * 8192), 16, 0, 0); } while (0)
#define PG8_STAGE_A(bufoff, kbase, h, VO) do { if constexpr (GATHER) { PG8_STAGE(bufoff, kbase, (VO)[h]); } else { PG8_STAGE(bufoff, (kbase) + (h) * hstep, voffA); } } while (0)
#define PG8_FILL(buf, U) do { if (tid < 256) { const bool ok_ = tid < (U).nvalid; const int ent_ = (ok_ && (S.a_compact == 2 || Epi::ROWINFO)) ? S.list[(size_t)(U).e * CAP + (U).r0 + tid] : 0; \
        rowtab[(buf) * 256 + tid] = (S.a_compact == 2) ? (ent_ >> 2) * (K * 2) : tid * (K * 2); \
        if constexpr (Epi::ROWINFO) { rowtab[768 + (buf) * 512 + tid] = ok_ ? ent_ : -1; rowtab[768 + (buf) * 512 + 256 + tid] = ok_ ? __builtin_bit_cast(int, S.gwl[(size_t)(U).e * CAP + (U).r0 + tid]) : 0; } } \
        if constexpr (Epi::BIASTAB) { if (tid >= 256) rowtab[2304 + (buf) * 256 + (tid - 256)] = __builtin_bit_cast(int, E.bias_at((U), tid - 256)); } } while (0)
#define PG8_LOADVO(VO, buf) do { _Pragma("unroll") for (int h_ = 0; h_ < 2; ++h_) _Pragma("unroll") for (int i_ = 0; i_ < 2; ++i_) (VO)[h_][i_] = (unsigned)rowtab[(buf) * 256 + h_ * 128 + Rr[i_]] + Cc2[i_]; } while (0)
#define PG8_LDA(dst, b, h) do { _Pragma("unroll") for (int m = 0; m < 4; ++m) _Pragma("unroll") for (int k = 0; k < 2; ++k) dst[m][k] = *(const LAS bf16x8*)(lds + PG8_SA(b, h) + aoff + m * 2048 + k * 1024); } while (0)
#define PG8_LDB(dst, b, h) do { _Pragma("unroll") for (int n = 0; n < 2; ++n) _Pragma("unroll") for (int k = 0; k < 2; ++k) dst[n][k] = *(const LAS bf16x8*)(lds + PG8_SB(b, h) + boff + n * 2048 + k * 1024); } while (0)
#define PG8_MMA(ai, bj, At, Bt) do { __builtin_amdgcn_s_setprio(1); _Pragma("unroll") for (int m = 0; m < 4; ++m) _Pragma("unroll") for (int n = 0; n < 2; ++n) _Pragma("unroll") for (int k = 0; k < 2; ++k) \
        acc[ai][bj][m][n] = __builtin_amdgcn_mfma_f32_16x16x32_bf16(Bt[n][k], At[m][k], acc[ai][bj][m][n], 0, 0, 0); __builtin_amdgcn_s_setprio(0); } while (0)
#define PG8_WAIT_V(n) asm volatile("s_waitcnt vmcnt(" #n ")" ::: "memory")
#define PG8_WAIT_L(n) asm volatile("s_waitcnt lgkmcnt(" #n ")" ::: "memory")
#define PG8_BAR __builtin_amdgcn_s_barrier()
#define PG8_SCHED __builtin_amdgcn_sched_barrier(0)
#define VO_a1 vA
#define VO_cA vA
#define VO_a2 vS
#define VO_a3 vS
    Unit cur, nxt; int ui = 0;
    if (!S.next(0, cur)) return;
    f32x4 acc[2][2][4][2];
#pragma unroll
    for (int a = 0; a < 2; ++a)
#pragma unroll
        for (int b = 0; b < 2; ++b)
#pragma unroll
            for (int m = 0; m < 4; ++m)
#pragma unroll
                for (int n = 0; n < 2; ++n) acc[a][b][m][n] = (f32x4){0.f, 0.f, 0.f, 0.f};
    bf16x8 At[4][2], B0[2][2], B1[2][2];
    const char* cA = cur.A; const char* cB = cur.B;
    cur.buf = 0;
    if constexpr (GATHER) { PG8_FILL(0, cur); asm volatile("s_waitcnt lgkmcnt(0)" ::: "memory"); PG8_BAR; asm volatile("" ::: "memory"); PG8_LOADVO(vA, 0); }
    if constexpr (SP2) {
        PG8_STAGE(PG8_SB(0, 0), cB, voffB); PG8_STAGE(PG8_SB(0, 1), cB + hstep, voffB); PG8_STAGE_A(PG8_SA(0, 0), cA, 0, VO_cA); PG8_STAGE_A(PG8_SA(0, 1), cA, 1, VO_cA);
        if (wr == 1) PG8_BAR;
        PG8_WAIT_V(2); PG8_BAR;
        PG8_STAGE(PG8_SB(1, 0), cB + kstep, voffB); PG8_STAGE_A(PG8_SA(1, 0), cA + kstep, 0, VO_cA); PG8_STAGE(PG8_SB(1, 1), cB + hstep + kstep, voffB);
        PG8_WAIT_V(6); PG8_BAR;
    } else {
        PG8_STAGE(PG8_SB(0, 0), cB, voffB); PG8_STAGE_A(PG8_SA(0, 0), cA, 0, VO_cA); PG8_STAGE(PG8_SB(0, 1), cB + hstep, voffB); PG8_STAGE_A(PG8_SA(0, 1), cA, 1, VO_cA);
        if (wr == 1) PG8_BAR;
        PG8_WAIT_V(4); PG8_BAR;
        PG8_STAGE(PG8_SB(1, 0), cB + kstep, voffB); PG8_STAGE_A(PG8_SA(1, 0), cA + kstep, 0, VO_cA); PG8_STAGE(PG8_SB(1, 1), cB + hstep + kstep, voffB);
        PG8_WAIT_V(6); PG8_BAR;
    }
    for (;;) {
        const bool has_next = S.next(ui + 1, nxt);
        const char* nA = has_next ? nxt.A : cA; const char* nB = has_next ? nxt.B : cB;
        nxt.buf = (ui + 1) % 3;
        if constexpr (GATHER) { if (has_next) PG8_FILL((ui + 1) % 3, nxt); }
        for (int t = 0; t < nt; t += 2) {
            const bool last = (t == nt - 2);
            const char* a1 = cA + (size_t)(t + 1) * kstep;
            const char* a2 = last ? nA : cA + (size_t)(t + 2) * kstep; const char* b2 = last ? nB : cB + (size_t)(t + 2) * kstep;
            const char* a3 = a2 + kstep; const char* b3 = b2 + kstep;
            unsigned vS[2][2];
            if constexpr (GATHER) { if (last && has_next) PG8_LOADVO(vN, (ui + 1) % 3);
#pragma unroll
                for (int h_ = 0; h_ < 2; ++h_)
#pragma unroll
                    for (int i_ = 0; i_ < 2; ++i_) vS[h_][i_] = (last && has_next) ? vN[h_][i_] : vA[h_][i_]; }
            else { vS[0][0] = 0u; vS[0][1] = 0u; vS[1][0] = 0u; vS[1][1] = 0u; }
            if constexpr (SP2) {
            PG8_LDB(B0, 0, 0); PG8_LDB(B1, 0, 1); PG8_SCHED; PG8_LDA(At, 0, 0); PG8_STAGE_A(PG8_SA(1, 1), a1, 1, VO_a1);
            PG8_WAIT_V(8); PG8_WAIT_L(0); PG8_BAR; PG8_MMA(0, 0, At, B0); PG8_MMA(0, 1, At, B1); PG8_BAR; PG8_SCHED;
            PG8_LDA(At, 0, 1); PG8_STAGE(PG8_SB(0, 0), b2, voffB); PG8_STAGE(PG8_SB(0, 1), b2 + hstep, voffB); PG8_STAGE_A(PG8_SA(0, 0), a2, 0, VO_a2);
            PG8_WAIT_V(8); PG8_WAIT_L(0); PG8_BAR; PG8_MMA(1, 0, At, B0); PG8_MMA(1, 1, At, B1); PG8_BAR; PG8_SCHED;
            PG8_LDB(B0, 1, 0); PG8_LDB(B1, 1, 1); PG8_SCHED; PG8_LDA(At, 1, 0); PG8_STAGE_A(PG8_SA(0, 1), a2, 1, VO_a2);
            PG8_WAIT_V(8); PG8_WAIT_L(0); PG8_BAR; PG8_MMA(0, 0, At, B0); PG8_MMA(0, 1, At, B1); PG8_BAR; PG8_SCHED;
            PG8_LDA(At, 1, 1); PG8_STAGE(PG8_SB(1, 0), b3, voffB); PG8_STAGE(PG8_SB(1, 1), b3 + hstep, voffB); PG8_STAGE_A(PG8_SA(1, 0), a3, 0, VO_a3);
            PG8_WAIT_V(8); PG8_WAIT_L(0); PG8_BAR; PG8_MMA(1, 0, At, B0); PG8_MMA(1, 1, At, B1); PG8_BAR; PG8_SCHED;
            } else {
            PG8_LDB(B0, 0, 0); PG8_SCHED; PG8_LDA(At, 0, 0); PG8_STAGE_A(PG8_SA(1, 1), a1, 1, VO_a1);
            PG8_WAIT_L(8); PG8_BAR; PG8_WAIT_L(0); PG8_MMA(0, 0, At, B0); PG8_BAR; PG8_SCHED;
            PG8_LDB(B1, 0, 1); PG8_STAGE(PG8_SB(0, 0), b2, voffB);
            PG8_BAR; PG8_WAIT_L(0); PG8_MMA(0, 1, At, B1); PG8_BAR;
            PG8_LDA(At, 0, 1); PG8_STAGE_A(PG8_SA(0, 0), a2, 0, VO_a2);
            PG8_BAR; PG8_WAIT_L(0); PG8_MMA(1, 0, At, B0); PG8_BAR; PG8_SCHED;
            PG8_STAGE(PG8_SB(0, 1), b2 + hstep, voffB);
            PG8_WAIT_V(6); PG8_BAR; PG8_MMA(1, 1, At, B1); PG8_BAR;
            PG8_LDB(B0, 1, 0); PG8_SCHED; PG8_LDA(At, 1, 0); PG8_STAGE_A(PG8_SA(0, 1), a2, 1, VO_a2);
            PG8_WAIT_L(8); PG8_BAR; PG8_WAIT_L(0); PG8_MMA(0, 0, At, B0); PG8_BAR; PG8_SCHED;
            PG8_LDB(B1, 1, 1); PG8_STAGE(PG8_SB(1, 0), b3, voffB);
            PG8_BAR; PG8_WAIT_L(0); PG8_MMA(0, 1, At, B1); PG8_BAR;
            PG8_LDA(At, 1, 1); PG8_STAGE_A(PG8_SA(1, 0), a3, 0, VO_a3);
            PG8_BAR; PG8_WAIT_L(0); PG8_MMA(1, 0, At, B0); PG8_BAR; PG8_SCHED;
            PG8_STAGE(PG8_SB(1, 1), b3 + hstep, voffB);
            PG8_WAIT_V(6); PG8_BAR; PG8_MMA(1, 1, At, B1); PG8_BAR;
            }
        }
        if constexpr (ALIGN_EPI) { if (wr == 0) PG8_BAR; }
        E(acc, cur, wr, wc, fr, fq);
        if (!has_next) break;
#pragma unroll
        for (int a = 0; a < 2; ++a)
#pragma unroll
            for (int b = 0; b < 2; ++b)
#pragma unroll
                for (int m = 0; m < 4; ++m)
#pragma unroll
                    for (int n = 0; n < 2; ++n) acc[a][b][m][n] = (f32x4){0.f, 0.f, 0.f, 0.f};
        cur = nxt; cA = nA; cB = nB; ++ui;
        if constexpr (GATHER) { vA[0][0] = vN[0][0]; vA[0][1] = vN[0][1]; vA[1][0] = vN[1][0]; vA[1][1] = vN[1][1]; }
        if constexpr (ALIGN_EPI) { if (wr == 1) PG8_BAR; }
    }
    PG8_WAIT_V(0);
    if constexpr (!ALIGN_EPI) { if (wr == 0) PG8_BAR; }
    PG8_BAR;
#undef PG8_SA
#undef PG8_SB
#undef PG8_STAGE
#undef PG8_STAGE_A
#undef PG8_FILL
#undef PG8_LOADVO
#undef VO_a1
#undef VO_cA
#undef VO_a2
#undef VO_a3
#undef PG8_LDA
#undef PG8_LDB
#undef PG8_MMA
#undef PG8_WAIT_V
#undef PG8_WAIT_L
#undef PG8_BAR
#undef PG8_SCHED
}
}

#define XB_TMO      128
#define XB_XCNT(j)  (256  + 64 * (j))
#define XB_XSUB(j)  (1280 + 64 * (j))
#define XB_XGEN(j)  (2304 + 64 * (j))
#define XB_TOP      3328
#define XB_TOPGEN   3392
#define XCD_BAR_WORDS 3456
#define XB_SPIN_CAP (1u << 18)
__device__ __forceinline__ unsigned xb_ld(unsigned* p)              { return __hip_atomic_load(p, __ATOMIC_RELAXED, __HIP_MEMORY_SCOPE_AGENT); }
__device__ __forceinline__ unsigned xb_add(unsigned* p, unsigned v) { return __hip_atomic_fetch_add(p, v, __ATOMIC_RELAXED, __HIP_MEMORY_SCOPE_AGENT); }
__device__ __forceinline__ unsigned xb_xcc_id() { return (unsigned)__builtin_amdgcn_s_getreg((3 << 11) | 20) & 0xFu; }
#define XB_SPIN(cond, bar) do { unsigned _sp = 0; while (cond) { __builtin_amdgcn_s_sleep(1); \
    if ((++_sp & 255u) == 0u) { if (xb_ld(&(bar)[XB_TMO])) break; if (_sp > XB_SPIN_CAP) { atomicAdd(&(bar)[XB_TMO], 1u); break; } } } } while (0)
struct XcdBarrier { unsigned* bar; unsigned x; volatile LAS unsigned* st; };
__device__ __forceinline__ XcdBarrier xcd_barrier_post(unsigned* bar, volatile LAS unsigned* st, bool leader) {
    XcdBarrier b; b.bar = bar; b.x = xb_xcc_id(); b.st = st;
    if (leader) (void)xb_add(&bar[XB_XCNT(b.x)], 1u);
    return b;
}
__device__ __forceinline__ void xcd_barrier_complete(unsigned* bar, unsigned x, unsigned& nloc, unsigned& nx) {
    const unsigned G = gridDim.x * gridDim.y * gridDim.z;
    unsigned sum, cnt, mine, sp = 0u;
    for (;;) {
        sum = 0u; cnt = 0u; mine = 0u;
#pragma unroll
        for (unsigned j = 0; j < 16; ++j) { const unsigned c = xb_ld(&bar[XB_XCNT(j)]); sum += c; cnt += (c > 0u) ? 1u : 0u; mine = (j == x) ? c : mine; }
        if (sum == G) break;
        __builtin_amdgcn_s_sleep(1);
        if ((++sp & 255u) == 0u) { if (xb_ld(&bar[XB_TMO])) break; if (sp > XB_SPIN_CAP) { atomicAdd(&bar[XB_TMO], 1u); break; } }
    }
    nloc = mine > 0u ? mine : 1u; nx = cnt > 0u ? cnt : 1u;
}
__device__ __forceinline__ void xcd_barrier(const XcdBarrier& b, int wave) {
    asm volatile("s_waitcnt vmcnt(0)" ::: "memory");
    __syncthreads();
    if (wave == 0 && lane_id() == 0) {
        unsigned* bar = b.bar;
        __builtin_amdgcn_s_waitcnt(0);
        unsigned nloc = b.st[0], nx = b.st[1];
        if (nloc == 0u) { xcd_barrier_complete(bar, b.x, nloc, nx); b.st[0] = nloc; b.st[1] = nx; }
        const unsigned old = xb_add(&bar[XB_XSUB(b.x)], 1u);
        const unsigned gen = old / nloc;
        if (old + 1u == (gen + 1u) * nloc) {
            __builtin_amdgcn_fence(__ATOMIC_RELEASE, "agent");
            asm volatile("s_waitcnt vmcnt(0)" ::: "memory");
            const unsigned og = xb_add(&bar[XB_TOP], 1u);
            const unsigned tg = og / nx;
            if (og + 1u == (tg + 1u) * nx) xb_add(&bar[XB_TOPGEN], 1u);
            else XB_SPIN(xb_ld(&bar[XB_TOPGEN]) == tg, bar);
            __builtin_amdgcn_fence(__ATOMIC_ACQUIRE, "agent");
            xb_add(&bar[XB_XGEN(b.x)], 1u);
            asm volatile("s_waitcnt vmcnt(0)" ::: "memory");
        } else {
            XB_SPIN(xb_ld(&bar[XB_XGEN(b.x)]) == gen, bar);
            __builtin_amdgcn_fence(__ATOMIC_ACQUIRE, "agent");
            asm volatile("s_waitcnt vmcnt(0)" ::: "memory");
        }
    }
    __syncthreads();
}

struct Args { const float* in[33]; float* out; unsigned char* ws; int ph_lo, ph_hi; };
struct Frame {
    LAS unsigned char* lds;
    int wave, vcu, G, gw, NGW;
};

__device__ __forceinline__ void transpose_item(const float* W, int ldw, int col_off, int K, bf16* WT, int mode, int kb, int nb, LAS unsigned char* scr, int lane) {
    const int k0 = 64 * kb, n0 = 64 * nb;
    const float* src = W + (size_t)k0 * ldw + col_off + n0;
    f32x4 v[16];
#pragma unroll
    for (int i = 0; i < 16; ++i) v[i] = __builtin_nontemporal_load((const f32x4*)(src + (size_t)((lane >> 4) + 4 * i) * ldw + 4 * (lane & 15)));
#pragma unroll
    for (int i = 0; i < 16; ++i) { LAS unsigned* p = (LAS unsigned*)(scr + ((lane >> 4) + 4 * i) * 132 + 8 * (lane & 15)); p[0] = pk2(v[i][0], v[i][1]); p[1] = pk2(v[i][2], v[i][3]); }
    asm volatile("s_waitcnt lgkmcnt(0)" ::: "memory");
    const int c = lane >> 3, nl = lane & 7;
#pragma unroll
    for (int r = 0; r < 8; ++r) { const int n = nl + 8 * r; const LAS unsigned short* s = (const LAS unsigned short*)(scr + (8 * c) * 132 + 2 * n);
        u32x4 o; o.x = (unsigned)s[0] | ((unsigned)s[66] << 16); o.y = (unsigned)s[132] | ((unsigned)s[198] << 16); o.z = (unsigned)s[264] | ((unsigned)s[330] << 16); o.w = (unsigned)s[396] | ((unsigned)s[462] << 16);
        const int ng = n0 + n; int drow = ng; if (mode == 1) { drow = ng < 1024 ? 256 * (ng >> 7) + (ng & 127) : 256 * ((ng - 1024) >> 7) + 128 + (ng & 127); }
        if (mode == 2 && ng < 2048) { const int i_ = ng & 127; drow = (ng & ~127) + (i_ < 64 ? 2 * i_ : 2 * (i_ - 64) + 1); }
        __builtin_nontemporal_store(o, (u32x4*)(WT + (size_t)drow * K + k0 + 8 * c)); }
    asm volatile("s_waitcnt lgkmcnt(0)" ::: "memory");
}

__device__ __forceinline__ void load_cols16(int tid, const float* W, int ldw, int col_off, LAS float* Wt) {
    f32x4 wv[8];
#pragma unroll
    for (int i = 0; i < 8; ++i) { const int q = tid + i * NTHREADS, k = q >> 2, e0 = (q & 3) * 4; wv[i] = *(const f32x4*)(W + (size_t)k * ldw + col_off + e0); }
#pragma unroll
    for (int i = 0; i < 8; ++i) { const int q = tid + i * NTHREADS, k = q >> 2, e0 = (q & 3) * 4;
        Wt[(e0 + 0) * 1028 + k] = wv[i][0]; Wt[(e0 + 1) * 1028 + k] = wv[i][1]; Wt[(e0 + 2) * 1028 + k] = wv[i][2]; Wt[(e0 + 3) * 1028 + k] = wv[i][3]; }
}
__device__ __forceinline__ float row_dot16(const f32x4 (&v)[4], const LAS float* Wt, int lane) {
    float p[16];
#pragma unroll
    for (int e = 0; e < 16; ++e) { float s = 0.f;
#pragma unroll
        for (int j = 0; j < 4; ++j) { const f32x4 w = *(const LAS f32x4*)(Wt + e * 1028 + 4 * (lane + 64 * j)); s += v[j][0] * w[0] + v[j][1] * w[1] + v[j][2] * w[2] + v[j][3] * w[3]; }
        p[e] = s; }
    float a8[8], a4[4], a2[2], r1;
#pragma unroll
    for (int e = 0; e < 8; ++e) { const auto r = __builtin_amdgcn_permlane32_swap(__builtin_bit_cast(unsigned, p[e]), __builtin_bit_cast(unsigned, p[e + 8]), false, false); a8[e] = __builtin_bit_cast(float, (unsigned)r[0]) + __builtin_bit_cast(float, (unsigned)r[1]); }
#pragma unroll
    for (int e = 0; e < 4; ++e) { const auto r = __builtin_amdgcn_permlane16_swap(__builtin_bit_cast(unsigned, a8[e]), __builtin_bit_cast(unsigned, a8[e + 4]), false, false); a4[e] = __builtin_bit_cast(float, (unsigned)r[0]) + __builtin_bit_cast(float, (unsigned)r[1]); }
    { const bool hi = (lane & 8) != 0;
#pragma unroll
      for (int e = 0; e < 2; ++e) { const float mine = hi ? a4[e + 2] : a4[e], theirs = hi ? a4[e] : a4[e + 2]; a2[e] = mine + dpp_f<0x128>(theirs); } }
    { const bool hi = (lane & 4) != 0; const float mine = hi ? a2[1] : a2[0], theirs = hi ? a2[0] : a2[1]; r1 = mine + dpp_f<0x141>(theirs); }
    r1 += dpp_f<0x4E>(r1); r1 += dpp_f<0xB1>(r1);
    return r1;
}
__device__ __forceinline__ void store_row_bf16(bf16* orow, const f32x4 (&v)[4], int lane) {
    unsigned long long* o8 = (unsigned long long*)orow + lane;
#pragma unroll
    for (int j = 0; j < 4; ++j) o8[64 * j] = (unsigned long long)pk2(v[j][0], v[j][1]) | ((unsigned long long)pk2(v[j][2], v[j][3]) << 32);
}
__device__ __forceinline__ void store_row_f32(float* orow, const f32x4 (&v)[4], int lane) {
    f32x4* o = (f32x4*)orow + lane;
#pragma unroll
    for (int j = 0; j < 4; ++j) o[64 * j] = v[j];
}
__device__ __forceinline__ void load_row_f32(const float* row, f32x4 (&v)[4], int lane) {
    const f32x4* p = (const f32x4*)row + lane;
#pragma unroll
    for (int j = 0; j < 4; ++j) v[j] = p[64 * j];
}
__device__ __forceinline__ void ln_row(f32x4 (&v)[4], const f32x4 (&gv)[4], const f32x4 (&bv)[4]) {
    float s = 0.f;
#pragma unroll
    for (int j = 0; j < 4; ++j) s += (v[j][0] + v[j][1]) + (v[j][2] + v[j][3]);
    const float mean = wave_sum(s) * (1.f / D); float s2 = 0.f;
#pragma unroll
    for (int j = 0; j < 4; ++j) { v[j] = v[j] - mean; s2 += (v[j][0] * v[j][0] + v[j][1] * v[j][1]) + (v[j][2] * v[j][2] + v[j][3] * v[j][3]); }
    const float rstd = __builtin_amdgcn_rsqf(wave_sum(s2) * (1.f / D) + LN_EPS);
#pragma unroll
    for (int j = 0; j < 4; ++j) v[j] = v[j] * rstd * gv[j] + bv[j];
}

__device__ __forceinline__ const float* inp_ptr(LAS unsigned char* lds, int i) {
    const LAS unsigned* p = (const LAS unsigned*)(lds + MISC_OFF + 256) + 2 * i;
    const unsigned lo = __builtin_amdgcn_readfirstlane(p[0]), hi = __builtin_amdgcn_readfirstlane(p[1]);
    return (const float*)(const GAS float*)(((unsigned long long)hi << 32) | lo);
}

__device__ __forceinline__ void stamp_fn(LAS unsigned char* lds, int wave, int k) {
    if (blockIdx.x == 0 && wave == 0 && lane_id() == 0) { volatile LAS unsigned long long* st = (volatile LAS unsigned long long*)(lds + MISC_OFF + 1024);
        const unsigned long long now = __builtin_amdgcn_s_memrealtime(); if (k >= PROBE_T && k <= PROBE_T2) st[1] = st[1] + (now - st[0]); st[0] = now; }
}
typedef short s16x4 __attribute__((ext_vector_type(4)));
typedef short v4i16_t __attribute__((ext_vector_type(4)));
constexpr int CL = 128, NCH = T / CL;
template <int MODE> struct MX;
template <> struct MX<0> { static constexpr int NH = 8, DK = 64,  DV = 128, LDP = 3072, KOFF = 512,  VOFF = 1024, GOFF = 2048; };
template <> struct MX<1> { static constexpr int NH = 8, DK = 128, DV = 256, LDP = 6144, KOFF = 1024, VOFF = 2048, GOFF = 4096; };
template <> struct MX<2> { static constexpr int NH = 4, DK = 128, DV = 256, LDP = 3072, KOFF = 512,  VOFF = 1024, GOFF = 2048; };
__device__ __forceinline__ s16x4 ds_tr(const LAS unsigned char* p) { return __builtin_bit_cast(s16x4, __builtin_amdgcn_ds_read_tr16_b64_v4i16((LAS v4i16_t*)p)); }
__device__ __forceinline__ bf16x8 tr_frag(const LAS unsigned char* base, int pitch, int k0, int n0, int lane) {
    const int g = lane >> 4, q = (lane & 15) >> 2, p = lane & 3;
    const LAS unsigned char* a = base + (k0 + 4 * g + q) * pitch + (n0 + 4 * p) * 2;
    const s16x4 r1 = ds_tr(a), r2 = ds_tr(a + 16 * pitch);
    bf16x8 f; f[0] = r1[0]; f[1] = r1[1]; f[2] = r1[2]; f[3] = r1[3]; f[4] = r2[0]; f[5] = r2[1]; f[6] = r2[2]; f[7] = r2[3]; return f;
}
__device__ __forceinline__ u32x4 scale_bf16x8(u32x4 v, float sc) {
    u32x4 o; o.x = pk2(bflo(v.x) * sc, bfhi(v.x) * sc); o.y = pk2(bflo(v.y) * sc, bfhi(v.y) * sc); o.z = pk2(bflo(v.z) * sc, bfhi(v.z) * sc); o.w = pk2(bflo(v.w) * sc, bfhi(v.w) * sc); return o;
}
__device__ __forceinline__ float ret_lg2gamma(int h) { return log2f(1.f - exp2f(-5.f - (float)h)); }

template <int MODE>
__device__ __forceinline__ void mix_phaseA(const Frame& F, unsigned char* ws, const int tid, const int lane) {
    typedef MX<MODE> C; constexpr int DK = C::DK, DV = C::DV, NH = C::NH, LDP = C::LDP, KP = DK * 2 + 32, VP = DV * 2 + 32, ETW = DV / 128, NDT = DK / 16;
    LAS unsigned char* ldsK = F.lds; LAS unsigned char* ldsV = F.lds + 128 * KP; LAS float* rsc = (LAS float*)(F.lds + 128 * KP + 128 * VP);
    const bf16* PB = (const bf16*)(ws + WS_PB); const bf16* KPP = (const bf16*)(ws + WS_KPP); bf16* UT = (bf16*)(ws + WS_UT);
    const float* GSC = (const float*)(ws + WS_SC); float* NLOC = (float*)(ws + WS_SC + 2 * MiB);
    const int w = F.wave, g = lane >> 4;
    for (int u = blockIdx.x; u < 2 * NH * NCH; u += F.G) {
        const int c = u % NCH, bh = u / NCH, h = bh % NH, b = bh / NH; const size_t row0 = (size_t)b * T + (size_t)c * CL;
        u32x4 kr[DK / 32], vr[DV / 32];
#pragma unroll
        for (int i = 0; i < DK / 32; ++i) { const int p = tid + i * NTHREADS, r = p / (DK / 8), cp = p % (DK / 8);
            kr[i] = (MODE == 2) ? *(const u32x4*)(KPP + (row0 + r) * 512 + h * 128 + cp * 8) : *(const u32x4*)(PB + (row0 + r) * LDP + C::KOFF + h * DK + cp * 8); }
#pragma unroll
        for (int i = 0; i < DV / 32; ++i) { const int p = tid + i * NTHREADS, r = p / (DV / 8), cp = p % (DV / 8);
            vr[i] = *(const u32x4*)(PB + (row0 + r) * LDP + C::VOFF + h * DV + cp * 8); }
        float gmax = 0.f; if (MODE == 0) gmax = GSC[(size_t)(2 * 16 + bh) * T + c * CL + 127];
        const float lgh = (MODE == 1) ? ret_lg2gamma(h) : 0.f;
        __syncthreads();
#pragma unroll
        for (int i = 0; i < DK / 32; ++i) { const int p = tid + i * NTHREADS, r = p / (DK / 8), cp = p % (DK / 8);
            u32x4 v = kr[i];
            if (MODE == 0) v = scale_bf16x8(v, __expf(GSC[(size_t)(1 * 16 + bh) * T + c * CL + r] - gmax));
            if (MODE == 1) v = scale_bf16x8(v, exp2f((float)(127 - r) * lgh));
            *(LAS u32x4*)(ldsK + r * KP + cp * 16) = v; }
#pragma unroll
        for (int i = 0; i < DV / 32; ++i) { const int p = tid + i * NTHREADS, r = p / (DV / 8), cp = p % (DV / 8); *(LAS u32x4*)(ldsV + r * VP + cp * 16) = vr[i]; }
        __syncthreads();
        f32x4 acc[ETW][NDT];
#pragma unroll
        for (int i = 0; i < ETW; ++i)
#pragma unroll
            for (int j = 0; j < NDT; ++j) acc[i][j] = (f32x4){0.f, 0.f, 0.f, 0.f};
#pragma unroll
        for (int ks = 0; ks < 4; ++ks) {
            bf16x8 af[ETW], bfv[NDT];
#pragma unroll
            for (int i = 0; i < ETW; ++i) af[i] = tr_frag(ldsV, VP, 32 * ks, (w * ETW + i) * 16, lane);
#pragma unroll
            for (int j = 0; j < NDT; ++j) bfv[j] = tr_frag(ldsK, KP, 32 * ks, j * 16, lane);
#pragma unroll
            for (int i = 0; i < ETW; ++i)
#pragma unroll
                for (int j = 0; j < NDT; ++j) acc[i][j] = __builtin_amdgcn_mfma_f32_16x16x32_bf16(bfv[j], af[i], acc[i][j], 0, 0, 0);
        }
        bf16* ut = UT + (size_t)u * DV * DK;
#pragma unroll
        for (int i = 0; i < ETW; ++i)
#pragma unroll
            for (int j = 0; j < NDT; ++j)
                { uint2 o; o.x = pk2(acc[i][j][0], acc[i][j][1]); o.y = pk2(acc[i][j][2], acc[i][j][3]); *(uint2*)(ut + (size_t)((w * ETW + i) * 16 + (lane & 15)) * DK + j * 16 + 4 * g) = o; }
        if (MODE == 0) {
            float sacc = 0.f;
#pragma unroll
            for (int r = 0; r < 16; ++r) sacc += bf2f(*(const LAS unsigned short*)(ldsK + (16 * w + r) * KP + lane * 2));
            rsc[w * 64 + lane] = sacc;
            __syncthreads();
            if (tid < 64) { float t = 0.f;
#pragma unroll
                for (int q = 0; q < NWAVES; ++q) t += rsc[q * 64 + tid];
                NLOC[(size_t)u * 64 + tid] = t; } }
    }
    __syncthreads();
}

template <int MODE>
__device__ __forceinline__ void mix_phaseB(const Frame& F, unsigned char* ws, const int tid) {
    typedef MX<MODE> C; constexpr int DK = C::DK, DV = C::DV, NH = C::NH, NEL = DV * DK, NBH = 2 * NH;
    const bf16* UT = (const bf16*)(ws + WS_UT); bf16* ST = (bf16*)(ws + WS_ST);
    const float* GSC = (const float*)(ws + WS_SC); const float* NLOC = (const float*)(ws + WS_SC + 2 * MiB); float* NPREV = (float*)(ws + WS_SC + 2 * MiB + 256 * 1024);
    float* MPREV = (float*)(ws + WS_SC + 2 * MiB + 512 * 1024); const float* DEC = (const float*)(ws + WS_SC + 3 * MiB);
    const int gtid = blockIdx.x * NTHREADS + tid, nthr = F.G * NTHREADS;
    for (int el8 = gtid; el8 < NBH * NEL / 8; el8 += nthr) {
        const int el = el8 * 8, bh = el / NEL, idx = el - bh * NEL, h = bh % NH, b = bh / NH;
        float S[8]; float m = -1e30f;
#pragma unroll
        for (int q = 0; q < 8; ++q) S[q] = 0.f;
        const float rdec = (MODE == 1) ? exp2f(128.f * ret_lg2gamma(h)) : 1.f;
#pragma unroll 1
        for (int c0 = 0; c0 < NCH; c0 += 8) {
            u32x4 uv[8];
#pragma unroll
            for (int i = 0; i < 8; ++i) uv[i] = *(const u32x4*)(UT + (size_t)(bh * NCH + c0 + i) * NEL + idx);
#pragma unroll
            for (int i = 0; i < 8; ++i) { const int c = c0 + i; const size_t u = (size_t)bh * NCH + c;
                u32x4 o; o.x = pk2(S[0], S[1]); o.y = pk2(S[2], S[3]); o.z = pk2(S[4], S[5]); o.w = pk2(S[6], S[7]);
                *(u32x4*)(ST + u * NEL + idx) = o;
                const float u0 = bflo(uv[i].x), u1 = bfhi(uv[i].x), u2 = bflo(uv[i].y), u3 = bfhi(uv[i].y), u4 = bflo(uv[i].z), u5 = bfhi(uv[i].z), u6 = bflo(uv[i].w), u7 = bfhi(uv[i].w);
                if (MODE == 0) { const float atot = GSC[(size_t)(0 * 16 + bh) * T + c * CL + 127], mloc = atot + GSC[(size_t)(2 * 16 + bh) * T + c * CL + 127];
                    const float mnew = fmaxf(atot + m, mloc), so = __expf(atot + m - mnew), sl = __expf(mloc - mnew);
                    if (idx == 0) MPREV[u] = m;
                    S[0] = so * S[0] + sl * u0; S[1] = so * S[1] + sl * u1; S[2] = so * S[2] + sl * u2; S[3] = so * S[3] + sl * u3;
                    S[4] = so * S[4] + sl * u4; S[5] = so * S[5] + sl * u5; S[6] = so * S[6] + sl * u6; S[7] = so * S[7] + sl * u7; m = mnew; }
                else if (MODE == 1) { S[0] = rdec * S[0] + u0; S[1] = rdec * S[1] + u1; S[2] = rdec * S[2] + u2; S[3] = rdec * S[3] + u3; S[4] = rdec * S[4] + u4; S[5] = rdec * S[5] + u5; S[6] = rdec * S[6] + u6; S[7] = rdec * S[7] + u7; }
                else { const float* dp = DEC + (size_t)(b * NCH + c) * 512 + h * 128 + (idx & 127); const f32x4 d0 = *(const f32x4*)dp, d1 = *(const f32x4*)(dp + 4);
                    S[0] = d0[0] * S[0] + u0; S[1] = d0[1] * S[1] + u1; S[2] = d0[2] * S[2] + u2; S[3] = d0[3] * S[3] + u3; S[4] = d1[0] * S[4] + u4; S[5] = d1[1] * S[5] + u5; S[6] = d1[2] * S[6] + u6; S[7] = d1[3] * S[7] + u7; } }
        }
    }
    if (MODE == 0) {
        for (int el = gtid; el < NBH * 64; el += nthr) { const int bh = el >> 6, d = el & 63; float S = 0.f, m = -1e30f;
#pragma unroll 1
            for (int c0 = 0; c0 < NCH; c0 += 8) { float at[8], gm[8], nl[8];
#pragma unroll
                for (int i = 0; i < 8; ++i) { const int c = c0 + i; at[i] = GSC[(size_t)(0 * 16 + bh) * T + c * CL + 127]; gm[i] = GSC[(size_t)(2 * 16 + bh) * T + c * CL + 127]; nl[i] = NLOC[((size_t)bh * NCH + c) * 64 + d]; }
#pragma unroll
                for (int i = 0; i < 8; ++i) { const size_t u = (size_t)bh * NCH + c0 + i; const float atot = at[i], mloc = atot + gm[i];
                    const float mnew = fmaxf(atot + m, mloc), so = __expf(atot + m - mnew), sl = __expf(mloc - mnew);
                    NPREV[u * 64 + d] = S; S = so * S + sl * nl[i]; m = mnew; } } }
    }
}

template <int MODE>
__device__ __forceinline__ void mix_phaseC(const Frame& F, unsigned char* ws, const int tid, const int lane, const float* ng) {
    typedef MX<MODE> C; constexpr int DK = C::DK, DV = C::DV, NH = C::NH, LDP = C::LDP, VP = DV * 2 + 32, KP = DK * 2 + 16, SP = DK * 2 + 16, NET = DV / 16, NKS = DK / 32, DVT = NH * DV;
    constexpr int NSP = DV * DK / 8 / NTHREADS;
    LAS unsigned char* ldsV = F.lds; LAS unsigned char* ldsK = F.lds + 128 * VP; LAS unsigned char* ldsS = F.lds;
    LAS float* tabs = (LAS float*)(F.lds + 128 * VP + 128 * KP);
    static_assert(DV * SP <= 128 * VP + 128 * KP, "S^T image fits the stage-1 region");
    const bf16* PB = (const bf16*)(ws + WS_PB); const bf16* ST = (const bf16*)(ws + WS_ST);
    const float* GSC = (const float*)(ws + WS_SC); const float* NPREV = (const float*)(ws + WS_SC + 2 * MiB + 256 * 1024); const float* MPREV = (const float*)(ws + WS_SC + 2 * MiB + 512 * 1024);
    const int w = F.wave, g = lane >> 4, li = lane & 15;
    constexpr int NU = 2 * NH * NCH;
    u32x4 kr[DK / 32], vr[DV / 32], sreg[NSP];
#define PC_LOAD_KV(U_) do { const int c_ = (U_) % NCH, bh_ = (U_) / NCH, h_ = bh_ % NH, b_ = bh_ / NH; const char* pb_ = (const char*)(PB + ((size_t)b_ * T + (size_t)c_ * CL) * LDP); \
        const char* vb_ = pb_ + (C::VOFF + h_ * DV) * 2; const char* kb_ = pb_ + (C::KOFF + h_ * DK) * 2; int t_ = tid; asm volatile("" : "+v"(t_));     \
        _Pragma("unroll") for (int i = 0; i < DV / 32; ++i) { const int p = t_ + i * NTHREADS, r = p / (DV / 8), cp = p % (DV / 8); vr[i] = *(const u32x4*)(vb_ + (unsigned)(r * LDP + cp * 8) * 2u); } \
        _Pragma("unroll") for (int i = 0; i < DK / 32; ++i) { const int p = t_ + i * NTHREADS, r = p / (DK / 8), cp = p % (DK / 8); kr[i] = *(const u32x4*)(kb_ + (unsigned)(r * LDP + cp * 8) * 2u); } } while (0)
#define PC_LOAD_S(U_) do { const bf16* st_ = ST + (size_t)(U_) * DV * DK; _Pragma("unroll") for (int i = 0; i < NSP; ++i) sreg[i] = *(const u32x4*)(st_ + (size_t)(tid + i * NTHREADS) * 8); } while (0)
    if ((int)blockIdx.x < NU) { PC_LOAD_KV((int)blockIdx.x); }
    for (int u = blockIdx.x; u < NU; u += F.G) {
        const int c = u % NCH, bh = u / NCH, h = bh % NH, b = bh / NH; const size_t row0 = (size_t)b * T + (size_t)c * CL;
        const float lg = (MODE == 1) ? ret_lg2gamma(h) : 0.f;
        PC_LOAD_S(u);
        __syncthreads();
#pragma unroll
        for (int i = 0; i < DV / 32; ++i) { const int p = tid + i * NTHREADS, r = p / (DV / 8), cp = p % (DV / 8); *(LAS u32x4*)(ldsV + r * VP + cp * 16) = vr[i]; }
#pragma unroll
        for (int i = 0; i < DK / 32; ++i) { const int p = tid + i * NTHREADS, r = p / (DK / 8), cp = p % (DK / 8); *(LAS u32x4*)(ldsK + r * KP + cp * 16) = kr[i]; }
        if (u + F.G < NU) PC_LOAD_KV(u + F.G);
        if (MODE == 0 && tid < 128) { const float mp = MPREV[u]; const size_t gi = (size_t)bh * T + c * CL + tid;
            const float a = GSC[(size_t)(0 * 16) * T + gi], gg = GSC[(size_t)(1 * 16) * T + gi], cm = GSC[(size_t)(2 * 16) * T + gi];
            const float Mt = fmaxf(mp, cm);
            tabs[tid] = gg; tabs[128 + tid] = Mt; tabs[256 + tid] = __expf(mp - Mt) * 0.125f; tabs[384 + tid] = __expf(-(a + Mt)); }
        __syncthreads();
        const int tq = 16 * w + li;
        const bf16* qrow = PB + (row0 + tq) * LDP + h * DK;
        bf16x8 qf[NKS];
#pragma unroll
        for (int ks = 0; ks < NKS; ++ks) qf[ks] = *(const bf16x8*)(qrow + 32 * ks + 8 * g);
        f32x4 O[NET];
#pragma unroll
        for (int et = 0; et < NET; ++et) O[et] = (f32x4){0.f, 0.f, 0.f, 0.f};
        float den = 0.f;
        const float Mq = (MODE == 0) ? tabs[128 + tq] : 0.f;
        const float qs = (MODE == 0) ? tabs[256 + tq] : (MODE == 1) ? exp2f((float)(tq + 1) * lg) : 1.f;
        const float fin = (MODE == 0) ? tabs[384 + tq] : 1.f;
        for (int jp = 0; jp <= (w >> 1); ++jp) {
            f32x4 p0 = (f32x4){0.f, 0.f, 0.f, 0.f}, p1 = (f32x4){0.f, 0.f, 0.f, 0.f};
            const LAS unsigned char* k0p = ldsK + (32 * jp + li) * KP + 16 * g;
#pragma unroll
            for (int ks = 0; ks < NKS; ++ks) p0 = __builtin_amdgcn_mfma_f32_16x16x32_bf16(*(const LAS bf16x8*)(k0p + 64 * ks), qf[ks], p0, 0, 0, 0);
            if (2 * jp + 1 <= w) {
#pragma unroll
                for (int ks = 0; ks < NKS; ++ks) p1 = __builtin_amdgcn_mfma_f32_16x16x32_bf16(*(const LAS bf16x8*)(k0p + 16 * KP + 64 * ks), qf[ks], p1, 0, 0, 0);
            }
#pragma unroll
            for (int r = 0; r < 4; ++r) {
                const int s0 = 32 * jp + 4 * g + r, s1 = s0 + 16;
                float f0, f1;
                if (MODE == 0) { f0 = __expf(tabs[s0] - Mq) * 0.125f; f1 = __expf(tabs[s1] - Mq) * 0.125f; }
                else if (MODE == 1) { f0 = exp2f((float)(tq - s0) * lg); f1 = exp2f((float)(tq - s1) * lg); }
                else { f0 = 1.f; f1 = 1.f; }
                p0[r] = (s0 <= tq) ? p0[r] * f0 : 0.f; p1[r] = (s1 <= tq) ? p1[r] * f1 : 0.f;
                den += p0[r] + p1[r];
            }
            bf16x8 af; { const unsigned a0 = pk2(p0[0], p0[1]), a1 = pk2(p0[2], p0[3]), a2 = pk2(p1[0], p1[1]), a3 = pk2(p1[2], p1[3]); u32x4 t4; t4.x = a0; t4.y = a1; t4.z = a2; t4.w = a3; af = __builtin_bit_cast(bf16x8, t4); }
#pragma unroll
            for (int et = 0; et < NET; ++et) O[et] = __builtin_amdgcn_mfma_f32_16x16x32_bf16(af, tr_frag(ldsV, VP, 32 * jp, 16 * et, lane), O[et], 0, 0, 0);
        }
        __syncthreads();
#pragma unroll
        for (int i = 0; i < NSP; ++i) { const int p = tid + i * NTHREADS, e = p / (DK / 8), cp = p % (DK / 8); *(LAS u32x4*)(ldsS + e * SP + cp * 16) = sreg[i]; }
        __syncthreads();
        float dint = 0.f;
#pragma unroll
        for (int ks = 0; ks < NKS; ++ks) {
            bf16x8 aq = qf[ks];
            if (MODE != 2) aq = __builtin_bit_cast(bf16x8, scale_bf16x8(__builtin_bit_cast(u32x4, qf[ks]), qs));
            if (MODE == 0) { const float* np = NPREV + (size_t)u * 64 + 32 * ks + 8 * g; const u32x4 qa = __builtin_bit_cast(u32x4, aq);
                dint += bflo(qa.x) * np[0] + bfhi(qa.x) * np[1] + bflo(qa.y) * np[2] + bfhi(qa.y) * np[3] + bflo(qa.z) * np[4] + bfhi(qa.z) * np[5] + bflo(qa.w) * np[6] + bfhi(qa.w) * np[7]; }
#pragma unroll
            for (int et = 0; et < NET; ++et) O[et] = __builtin_amdgcn_mfma_f32_16x16x32_bf16(aq, *(const LAS bf16x8*)(ldsS + (16 * et + li) * SP + 64 * ks + 16 * g), O[et], 0, 0, 0);
        }
        float rd[4] = {1.f, 1.f, 1.f, 1.f};
        if (MODE == 0) {
            float dt = den + dint; dt += __shfl_xor(dt, 16); dt += __shfl_xor(dt, 32);
            LAS float* wsc = tabs + 512 + 16 * w;
            if (g == 0) wsc[li] = __builtin_amdgcn_rcpf(fmaxf(fabsf(dt), fin));
            asm volatile("s_waitcnt lgkmcnt(0)" ::: "memory");
#pragma unroll
            for (int r = 0; r < 4; ++r) rd[r] = wsc[4 * g + r];
        }
        float mean[4], rstd[4];
#pragma unroll
        for (int r = 0; r < 4; ++r) { float sacc = 0.f;
#pragma unroll
            for (int et = 0; et < NET; ++et) { O[et][r] *= rd[r]; sacc += O[et][r]; }
            sacc = row16_sum(sacc);
            mean[r] = sacc * (1.f / DV); float q = 0.f;
#pragma unroll
            for (int et = 0; et < NET; ++et) { const float dlt = O[et][r] - mean[r]; q += dlt * dlt; }
            q = row16_sum(q);
            rstd[r] = __builtin_amdgcn_rsqf(q * (1.f / DV) + LN_EPS); }
        bf16* YBp = (bf16*)(ws + WS_YB);
        constexpr int RPF = DV * 2 + 16, TB = (MODE == 0) ? (128 * VP + 128 * KP + 2560) : DV * SP;
        static_assert(TB + NWAVES * 16 * RPF <= PH_BYTES && TB % 16 == 0, "epilogue tiles fit");
        LAS unsigned char* tw = F.lds + TB + w * (16 * RPF);
        const float* ngp = ng + h * DV + li;
        const int rr = lane >> 3, pq = lane & 7;
        const bf16* gpr = PB + (row0 + 16 * w + rr) * LDP + C::GOFF + h * DV + pq * 8; bf16* ypr = YBp + (row0 + 16 * w + rr) * DVT + h * DV + pq * 8;
        asm volatile("" : "+v"(gpr), "+v"(ypr));
#define GATEF(x_) ((MODE == 0) ? sigmoidf_(x_) : (x_) * sigmoidf_(x_))
#pragma unroll
        for (int hf = 0; hf < 2; ++hf) {
#pragma unroll
            for (int e2 = 0; e2 < NET / 2; ++e2) { const int et = hf * (NET / 2) + e2; const float gn = ngp[16 * et];
#pragma unroll
                for (int r = 0; r < 4; ++r) *(LAS float*)(tw + (4 * g + r) * RPF + (16 * e2 + li) * 4) = (O[et][r] - mean[r]) * rstd[r] * gn; }
            asm volatile("s_waitcnt lgkmcnt(0)" ::: "memory");
#pragma unroll
            for (int it = 0; it < DV / 64; ++it) { const int rb = 8 * (it & 1), cb = 64 * (it >> 1);
                const u32x4 gv = *(const u32x4*)(gpr + (size_t)rb * LDP + hf * (DV / 2) + cb);
                const LAS float* tp = (const LAS float*)(tw + (rb + rr) * RPF + (cb + pq * 8) * 4);
                const f32x4 n0 = *(const LAS f32x4*)tp, n1 = *(const LAS f32x4*)(tp + 4);
                const float g0 = bflo(gv.x), g1 = bfhi(gv.x), g2 = bflo(gv.y), g3 = bfhi(gv.y), g4 = bflo(gv.z), g5 = bfhi(gv.z), g6 = bflo(gv.w), g7 = bfhi(gv.w);
                u32x4 o; o.x = pk2(GATEF(g0) * n0[0], GATEF(g1) * n0[1]); o.y = pk2(GATEF(g2) * n0[2], GATEF(g3) * n0[3]);
                o.z = pk2(GATEF(g4) * n1[0], GATEF(g5) * n1[1]); o.w = pk2(GATEF(g6) * n1[2], GATEF(g7) * n1[3]);
                *(u32x4*)(ypr + (size_t)rb * DVT + hf * (DV / 2) + cb) = o; }
            asm volatile("s_waitcnt lgkmcnt(0)" ::: "memory");
        }
#undef GATEF
    }
    __syncthreads();
#undef PC_LOAD_KV
#undef PC_LOAD_S
}

constexpr int SLN = 32, NCI = T / SLN, NI = 2 * NCI, NRT = NI / 16, SKK = SLN * 16;
__device__ __forceinline__ void s5_pow(const f32x4 cf, float n, float& pr, float& pi) { const float e = __expf(n * cf[0]); const float a = n * cf[1]; pr = e * __cosf(a); pi = e * __sinf(a); }

__device__ __forceinline__ void s5_tables(const Frame& F, unsigned char* ws, const int tid, const float* lam_re, const float* lam_im, const float* b_re, const float* b_im, const float* c_re, const float* c_im, const float* log_dt) {
    bf16* KT = (bf16*)(ws + WS_S5KT); bf16* VT = (bf16*)(ws + WS_S5VT); bf16* WT = (bf16*)(ws + WS_S5WT); float* L64 = (float*)(ws + WS_S5L64);
    LAS f32x4* CF = (LAS f32x4*)F.lds;
    for (int i = tid; i < 64 * 64; i += NTHREADS) { const int g = i >> 6; const float lr = lam_re[i], li = lam_im[i], dt = expf(log_dt[g]);
        const float er = expf(lr * dt); float sn, cs; sincosf(li * dt, &sn, &cs);
        const float nr = er * cs - 1.f, ni = er * sn, den = lr * lr + li * li;
        CF[i] = (f32x4){lr * dt, li * dt, (nr * lr + ni * li) / den, (ni * lr - nr * li) / den}; }
    __syncthreads();
    const int gt = blockIdx.x * NTHREADS + tid, nthr = F.G * NTHREADS;
    LAS float* BR = (LAS float*)(F.lds + 65536); LAS float* BI = BR + 1024; LAS float* CR = BI + 1024; LAS float* CI = CR + 1024;
    for (int i0 = blockIdx.x * NTHREADS; i0 < 64 * SLN * 16 * 4; i0 += nthr) {
        const int g = i0 / (64 * SLN);
        __syncthreads();
        for (int q = tid; q < 1024; q += NTHREADS) { BR[q] = b_re[(size_t)g * 1024 + q]; BI[q] = b_im[(size_t)g * 1024 + q]; CR[q] = c_re[(size_t)g * 1024 + q]; CI[q] = c_im[(size_t)g * 1024 + q]; }
        __syncthreads();
        const int i4 = i0 + tid, pq = i4 & 3, idx = i4 >> 2, h = idx & 15, tau = (idx >> 4) % SLN;
        float acc[16];
#pragma unroll
        for (int q = 0; q < 16; ++q) acc[q] = 0.f;
#pragma unroll 4
        for (int p = pq * 16; p < pq * 16 + 16; ++p) { const f32x4 cf = CF[g * 64 + p]; float pr, pi; s5_pow(cf, (float)tau, pr, pi);
            const float cr = CR[h * 64 + p], ci = CI[h * 64 + p];
            const float xr = cr * pr - ci * pi, xi = cr * pi + ci * pr;
            const float yr = xr * cf[2] - xi * cf[3], yi = xr * cf[3] + xi * cf[2];
            const LAS f32x4* br4 = (const LAS f32x4*)(BR + p * 16); const LAS f32x4* bi4 = (const LAS f32x4*)(BI + p * 16);
#pragma unroll
            for (int q = 0; q < 4; ++q) { const f32x4 b_r = br4[q], b_i = bi4[q];
#pragma unroll
                for (int z = 0; z < 4; ++z) acc[4 * q + z] += yr * b_r[z] - yi * b_i[z]; } }
#pragma unroll
        for (int q = 0; q < 16; ++q) { acc[q] += dpp_f<0xB1>(acc[q]); acc[q] += dpp_f<0x4E>(acc[q]); }
        if (pq == 0) { u32x4 o0, o1; o0.x = pk2(acc[0], acc[1]); o0.y = pk2(acc[2], acc[3]); o0.z = pk2(acc[4], acc[5]); o0.w = pk2(acc[6], acc[7]);
            o1.x = pk2(acc[8], acc[9]); o1.y = pk2(acc[10], acc[11]); o1.z = pk2(acc[12], acc[13]); o1.w = pk2(acc[14], acc[15]);
            *(u32x4*)(KT + (size_t)idx * 16) = o0; *(u32x4*)(KT + (size_t)idx * 16 + 8) = o1; } }
    for (int idx = gt; idx < 64 * 64 * SLN; idx += nthr) {
        const int j = idx % SLN, p = (idx / SLN) & 63, g = idx / (SLN * 64);
        const f32x4 cf = CF[g * 64 + p]; float pr, pi;
        s5_pow(cf, (float)(SLN - 1 - j), pr, pi);
        const float yr = pr * cf[2] - pi * cf[3], yi = pr * cf[3] + pi * cf[2];
        const float* br = b_re + (size_t)(g * 64 + p) * 16; const float* bi = b_im + (size_t)(g * 64 + p) * 16;
        float vr[16], vi[16];
#pragma unroll
        for (int q = 0; q < 16; ++q) { vr[q] = yr * br[q] - yi * bi[q]; vi[q] = yr * bi[q] + yi * br[q]; }
        bf16* v0 = VT + ((size_t)(g * 128 + 2 * p) * SKK + j * 16);
        u32x4 o; o.x = pk2(vr[0], vr[1]); o.y = pk2(vr[2], vr[3]); o.z = pk2(vr[4], vr[5]); o.w = pk2(vr[6], vr[7]); *(u32x4*)v0 = o;
        o.x = pk2(vr[8], vr[9]); o.y = pk2(vr[10], vr[11]); o.z = pk2(vr[12], vr[13]); o.w = pk2(vr[14], vr[15]); *(u32x4*)(v0 + 8) = o;
        o.x = pk2(vi[0], vi[1]); o.y = pk2(vi[2], vi[3]); o.z = pk2(vi[4], vi[5]); o.w = pk2(vi[6], vi[7]); *(u32x4*)(v0 + SKK) = o;
        o.x = pk2(vi[8], vi[9]); o.y = pk2(vi[10], vi[11]); o.z = pk2(vi[12], vi[13]); o.w = pk2(vi[14], vi[15]); *(u32x4*)(v0 + SKK + 8) = o;
        if (j == 0) { s5_pow(cf, (float)SLN, pr, pi); L64[(g * 64 + p) * 2] = pr; L64[(g * 64 + p) * 2 + 1] = pi; }
    }
    for (int idx = gt; idx < 64 * 64 * SLN; idx += nthr) {
        const int p = idx & 63, l = (idx >> 6) % SLN, g = idx / (SLN * 64);
        const f32x4 cf = CF[g * 64 + p]; float pr, pi; s5_pow(cf, (float)(l + 1), pr, pi);
#pragma unroll
        for (int h = 0; h < 16; ++h) { const float cr = c_re[(g * 16 + h) * 64 + p], ci = c_im[(g * 16 + h) * 64 + p];
            *(unsigned*)(WT + ((size_t)((g * SLN + l) * 16 + h) * 128 + 2 * p)) = pk2(cr * pr - ci * pi, -(cr * pi + ci * pr)); }
    }
    __syncthreads();
}
__device__ __forceinline__ void s5_phaseA(const Frame& F, unsigned char* ws, const int lane) {
    const bf16* PB = (const bf16*)(ws + WS_PB); const bf16* VT = (const bf16*)(ws + WS_S5VT); float* SL = (float*)(ws + WS_S5SL);
    const int gq = lane >> 4, li = lane & 15;
    for (int wu = F.gw; wu < 64 * NRT * 2; wu += F.NGW) {
        const int half = wu & 1, rt = (wu >> 1) % NRT, g = wu / (2 * NRT), b = rt / (NRT / 2), c0 = (rt % (NRT / 2)) * 16;
        f32x4 acc[4];
#pragma unroll
        for (int ct = 0; ct < 4; ++ct) acc[ct] = (f32x4){0.f, 0.f, 0.f, 0.f};
        const bf16* ap = PB + ((size_t)b * T + (size_t)(c0 + li) * SLN + (gq >> 1)) * 1024 + g * 16 + 8 * (gq & 1);
        const bf16* bp = VT + (size_t)(g * 128 + half * 64 + li) * SKK + 8 * gq;
#pragma unroll 4
        for (int ks = 0; ks < SLN / 2; ++ks) {
            const bf16x8 af = *(const bf16x8*)(ap + (size_t)(2 * ks) * 1024);
#pragma unroll
            for (int ct = 0; ct < 4; ++ct) acc[ct] = __builtin_amdgcn_mfma_f32_16x16x32_bf16(af, *(const bf16x8*)(bp + (size_t)(16 * ct) * SKK + 32 * ks), acc[ct], 0, 0, 0);
        }
#pragma unroll
        for (int ct = 0; ct < 4; ++ct)
#pragma unroll
            for (int r = 0; r < 4; ++r) SL[(size_t)(g * NI + rt * 16 + 4 * gq + r) * 128 + half * 64 + ct * 16 + li] = acc[ct][r];
    }
}
__device__ __forceinline__ void s5_phaseB(const Frame& F, unsigned char* ws, const int tid) {
    static_assert(NCI == 256, "16 groups of 16 chunks");
    const float* SL = (const float*)(ws + WS_S5SL); bf16* SP = (bf16*)(ws + WS_S5SP); const float* L64 = (const float*)(ws + WS_S5L64);
    for (int gt = blockIdx.x * NTHREADS + tid; gt < 2 * 64 * 64 * 16; gt += F.G * NTHREADS) {
        const int grp = gt & 15, p = (gt >> 4) & 63, g = (gt >> 10) & 63, b = gt >> 16;
        const float ar = L64[(g * 64 + p) * 2], ai = L64[(g * 64 + p) * 2 + 1];
        const size_t base = (size_t)(g * NI + b * NCI + grp * 16) * 128 + 2 * p;
        f32x2 x[16];
#pragma unroll
        for (int i = 0; i < 16; ++i) x[i] = *(const f32x2*)(SL + base + (size_t)i * 128);
        float lr[16], li[16], sr = 0.f, si = 0.f;
#pragma unroll
        for (int i = 0; i < 16; ++i) { lr[i] = sr; li[i] = si; const float nr = ar * sr - ai * si + x[i][0], ni = ar * si + ai * sr + x[i][1]; sr = nr; si = ni; }
        float mr = ar, mi = ai;
#pragma unroll
        for (int k = 0; k < 4; ++k) { const float t = mr * mr - mi * mi; mi = 2.f * mr * mi; mr = t; }
#define S5_STEP(CTRL) do { const float tr = __builtin_bit_cast(float, __builtin_amdgcn_update_dpp(0, __builtin_bit_cast(int, sr), CTRL, 0xf, 0xf, true)), ti = __builtin_bit_cast(float, __builtin_amdgcn_update_dpp(0, __builtin_bit_cast(int, si), CTRL, 0xf, 0xf, true)); \
            sr += mr * tr - mi * ti; si += mr * ti + mi * tr; const float t2 = mr * mr - mi * mi; mi = 2.f * mr * mi; mr = t2; } while (0)
        S5_STEP(0x111); S5_STEP(0x112); S5_STEP(0x114); S5_STEP(0x118);
#undef S5_STEP
        const float pr = __builtin_bit_cast(float, __builtin_amdgcn_update_dpp(0, __builtin_bit_cast(int, sr), 0x111, 0xf, 0xf, true)), pi = __builtin_bit_cast(float, __builtin_amdgcn_update_dpp(0, __builtin_bit_cast(int, si), 0x111, 0xf, 0xf, true));
        float qr = 1.f, qi = 0.f;
#pragma unroll
        for (int i = 0; i < 16; ++i) { const float orr = qr * pr - qi * pi + lr[i], oi = qr * pi + qi * pr + li[i];
            *(unsigned*)(SP + base + (size_t)i * 128) = pk2(orr, oi);
            const float t = qr * ar - qi * ai; qi = qr * ai + qi * ar; qr = t; }
    }
}
__device__ __forceinline__ void s5_phaseC(const Frame& F, unsigned char* ws, const int lane, const float* dskip) {
    const bf16* PB = (const bf16*)(ws + WS_PB); const bf16* KT = (const bf16*)(ws + WS_S5KT); const bf16* WT = (const bf16*)(ws + WS_S5WT); const bf16* SP = (const bf16*)(ws + WS_S5SP);
    bf16* YB = (bf16*)(ws + WS_YB);
    const int gq = lane >> 4, li = lane & 15;
#pragma unroll 1
    for (int wu = F.gw; wu < 64 * NRT * 2; wu += F.NGW) {
        const int par = wu & 1, rt = (wu >> 1) % NRT, g = wu / (2 * NRT), b = rt / (NRT / 2), c0 = (rt % (NRT / 2)) * 16;
        bf16x8 af[SLN / 2], sf[4];
        const bf16* ap = PB + ((size_t)b * T + (size_t)(c0 + li) * SLN + (gq >> 1)) * 1024 + g * 16 + 8 * (gq & 1);
#pragma unroll
        for (int ks = 0; ks < SLN / 2; ++ks) af[ks] = *(const bf16x8*)(ap + (size_t)(2 * ks) * 1024);
#pragma unroll
        for (int ks = 0; ks < 4; ++ks) sf[ks] = *(const bf16x8*)(SP + (size_t)(g * NI + rt * 16 + li) * 128 + 32 * ks + 8 * gq);
        const float dl = dskip[g * 16 + li];
        const bf16* ktp = KT + (size_t)g * SLN * 256 + li * 16 + 8 * (gq & 1);
#pragma unroll
        for (int l2 = 0; l2 < SLN / 2; ++l2) {
            int l = 2 * l2 + par; asm volatile("" : "+v"(l));
            f32x4 acc = (f32x4){0.f, 0.f, 0.f, 0.f};
#pragma unroll
            for (int ks = 0; ks <= l2; ++ks) { const int tau = l - 2 * ks - (gq >> 1);
                bf16x8 bfv = *(const bf16x8*)(ktp + (size_t)(tau < 0 ? 0 : tau) * 256);
                if (ks == l2 && tau < 0) bfv = (bf16x8){0, 0, 0, 0, 0, 0, 0, 0};
                acc = __builtin_amdgcn_mfma_f32_16x16x32_bf16(af[ks], bfv, acc, 0, 0, 0); }
            const bf16* wp = WT + (size_t)((g * SLN + l) * 16 + li) * 128 + 8 * gq;
#pragma unroll
            for (int ks = 0; ks < 4; ++ks) acc = __builtin_amdgcn_mfma_f32_16x16x32_bf16(sf[ks], *(const bf16x8*)(wp + 32 * ks), acc, 0, 0, 0);
#pragma unroll
            for (int r = 0; r < 4; ++r) { const size_t row = (size_t)b * T + (size_t)(c0 + 4 * gq + r) * SLN + l; const size_t o = row * 1024 + g * 16 + li;
                const float y = acc[r] + dl * bf2f(PB[o]); YB[o] = (bf16)f2bf(gelu_tanh(y)); }
            asm volatile("" ::: "memory");
        }
    }
}

#define IN(k) (lo <= (k) && (k) < hi)
#define SEAM(k) do { if ((k) + 1 < hi) { xcd_barrier(bar, F.wave); if (PROBE_CLS == 10) xcd_barrier(bar, F.wave); if (PROBE_T >= 0) stamp_fn(F.lds, F.wave, (k)); } } while (0)
#define INP(i) inp_ptr(F.lds, (i))
#define x_in INP(0)
#define ln_g INP(1)
#define ln_b INP(2)
#define WS_PTRS \
    float* HF = (float*)(ws + WS_HF); bf16* XB = (bf16*)(ws + WS_XB); bf16* ZF = (bf16*)(ws + WS_ZF); bf16* PB = (bf16*)(ws + WS_PB); \
    float* GB = (float*)(ws + WS_GB); float* LA = (float*)(ws + WS_LA); float* ORAW = (float*)(ws + WS_ORAW); bf16* YB = (bf16*)(ws + WS_YB); \
    bf16* ACT = (bf16*)(ws + WS_ACT); bf16* YS = (bf16*)(ws + WS_YS); bf16* XG = (bf16*)(ws + WS_XG); \
    int* LIST = (int*)(ws + WS_LIST); float* GW = (float*)(ws + WS_ORAW); \
    float* S5LB = (float*)(ws + WS_S5TAB); float* S5BB = (float*)(ws + WS_S5TAB + 32768); \
    (void)HF; (void)XB; (void)ZF; (void)PB; (void)GB; (void)LA; (void)ORAW; (void)YB; (void)ACT; (void)YS; (void)XG; (void)LIST; (void)GW; (void)S5LB; (void)S5BB;

template <int layer>
__device__ __forceinline__ void layer_body(const Frame& F, unsigned char* ws, unsigned* ctl, LAS int* TAB, const XcdBarrier& bar, const int lo, const int hi, float* d_out) {
    WS_PTRS
        const int pb = 1 + layer * 16;
        const float* hin = (layer == 0) ? x_in : HF;
        if (PHE(1) && IN(pb + 0)) {
            const bf16* Wt = (const bf16*)(ws + (layer == 0 ? WS_WT_ML_IN : layer == 1 ? WS_WT_RET_IN : layer == 2 ? WS_WT_GLA_IN : WS_WT_S5_IN));
            const int N = (layer == 0 || layer == 2) ? 3072 : (layer == 1 ? 6144 : 1024);
            pg8::DenseOrder S; S.init(XB, Wt, M, N, D, F.G, (int)blockIdx.x);
            pg8::EpiBf16 E{PB, N, (const float*)(ws + WS_CS), (layer == 1) ? 8 : 0};
            for (int rep_ = 0; rep_ < REPS(2); ++rep_)
            pg8::gemm_phase<pg8::EpiBf16, pg8::DenseOrder, true, true>(F.lds, F.wave, D, S, E);
            if (layer == 0 && CH_ML) {
                const int lane = lane_id(); float* GSC = (float*)(ws + WS_SC);
                for (int wu = F.gw; wu < 16 * NCH; wu += F.NGW) { const int bh = wu / NCH, c = wu % NCH, b = bh >> 3, h = bh & 7;
                    const int t0 = c * CL + 2 * lane; const size_t row = (size_t)b * T + t0;
                    const float lf0 = log_sigmoidf_(GB[row * 16 + 8 + h]), lf1 = log_sigmoidf_(GB[(row + 1) * 16 + 8 + h]);
                    const float sp = lf0 + lf1; float inc = sp;
#pragma unroll
                    for (int d = 1; d < 64; d <<= 1) { const float tv_ = __shfl_up(inc, d); if (lane >= d) inc += tv_; }
                    const float a0 = inc - sp + lf0, a1 = inc;
                    const float g0 = GB[row * 16 + h] - a0, g1 = GB[(row + 1) * 16 + h] - a1;
                    float mx = fmaxf(g0, g1);
#pragma unroll
                    for (int d = 1; d < 64; d <<= 1) { const float tv_ = __shfl_up(mx, d); if (lane >= d) mx = fmaxf(mx, tv_); }
                    float ex = __shfl_up(mx, 1); if (lane == 0) ex = -3.0e38f;
                    const size_t o0 = (size_t)bh * T + t0;
                    *(f32x2*)(GSC + (size_t)(0 * 16) * T + o0) = (f32x2){a0, a1};
                    *(f32x2*)(GSC + (size_t)(1 * 16) * T + o0) = (f32x2){g0, g1};
                    *(f32x2*)(GSC + (size_t)(2 * 16) * T + o0) = (f32x2){fmaxf(ex, g0), mx}; }
            }
            SEAM(pb + 0);
        }
        if (layer == 0) {
            if (CH_ML) {
                if (IN(pb + 2)) { const int lane = lane_id(), tid = F.wave * 64 + lane; for (int rep_ = 0; rep_ < REPS(6); ++rep_) mix_phaseA<0>(F, ws, tid, lane); SEAM(pb + 2); }
                if (IN(pb + 3)) { const int lane = lane_id(), tid = F.wave * 64 + lane; for (int rep_ = 0; rep_ < REPS(7); ++rep_) mix_phaseB<0>(F, ws, tid); SEAM(pb + 3); }
                if (IN(pb + 4)) { const int lane = lane_id(), tid = F.wave * 64 + lane; for (int rep_ = 0; rep_ < REPS(8); ++rep_) mix_phaseC<0>(F, ws, tid, lane, INP(5)); SEAM(pb + 4); }
            }
        } else if (layer == 1) {
            if (CH_RET) {
                if (IN(pb + 2)) { const int lane = lane_id(), tid = F.wave * 64 + lane; for (int rep_ = 0; rep_ < REPS(6); ++rep_) mix_phaseA<1>(F, ws, tid, lane); SEAM(pb + 2); }
                if (IN(pb + 3)) { const int lane = lane_id(), tid = F.wave * 64 + lane; for (int rep_ = 0; rep_ < REPS(7); ++rep_) mix_phaseB<1>(F, ws, tid); SEAM(pb + 3); }
                if (IN(pb + 4)) { const int lane = lane_id(), tid = F.wave * 64 + lane; for (int rep_ = 0; rep_ < REPS(8); ++rep_) mix_phaseC<1>(F, ws, tid, lane, INP(8)); SEAM(pb + 4); }
            }
        } else if (layer == 2) {
            if (CH_GLA) {
                if (IN(pb + 1)) {
                    const int lane = lane_id();
                    bf16* KPP = (bf16*)(ws + WS_KPP); float* DEC = (float*)(ws + WS_SC + 3 * MiB); LAS float* tot = (LAS float*)F.lds;
                    for (int u = blockIdx.x; u < 2 * NCH * 8; u += F.G) { const int cg = u & 7, bc = u >> 3, b = bc / NCH, c = bc % NCH, ch = cg * 64 + lane;
                        const size_t r0 = (size_t)b * T + (size_t)c * CL + 16 * F.wave;
                        float cs[16]; unsigned short qv[16], kv[16];
#pragma unroll
                        for (int i = 0; i < 16; ++i) { cs[i] = LA[(r0 + i) * 512 + ch]; qv[i] = PB[(r0 + i) * 3072 + ch]; kv[i] = PB[(r0 + i) * 3072 + 512 + ch]; }
#pragma unroll
                        for (int i = 1; i < 16; ++i) cs[i] += cs[i - 1];
                        __syncthreads();
                        tot[F.wave * 64 + lane] = cs[15];
                        __syncthreads();
                        float pre = 0.f, bend = 0.f;
#pragma unroll
                        for (int w2 = 0; w2 < NWAVES; ++w2) { const float tw = tot[w2 * 64 + lane]; bend += tw; if (w2 < F.wave) pre += tw; }
#pragma unroll
                        for (int i = 0; i < 16; ++i) { const float bcum = pre + cs[i]; const float q_ = bf2f(qv[i]), k_ = bf2f(kv[i]) * 0.08838834764831845f;
                            PB[(r0 + i) * 3072 + ch] = (bf16)f2bf(q_ * __expf(bcum)); PB[(r0 + i) * 3072 + 512 + ch] = (bf16)f2bf(k_ * __expf(-bcum)); KPP[(r0 + i) * 512 + ch] = (bf16)f2bf(k_ * __expf(bend - bcum)); }
                        if (F.wave == 0) DEC[(size_t)bc * 512 + ch] = __expf(bend); }
                    __syncthreads();
                    SEAM(pb + 1);
                }
                if (IN(pb + 2)) { const int lane = lane_id(), tid = F.wave * 64 + lane; for (int rep_ = 0; rep_ < REPS(6); ++rep_) mix_phaseA<2>(F, ws, tid, lane); SEAM(pb + 2); }
                if (IN(pb + 3)) { const int lane = lane_id(), tid = F.wave * 64 + lane; for (int rep_ = 0; rep_ < REPS(7); ++rep_) mix_phaseB<2>(F, ws, tid); SEAM(pb + 3); }
                if (IN(pb + 4)) { const int lane = lane_id(), tid = F.wave * 64 + lane; for (int rep_ = 0; rep_ < REPS(8); ++rep_) mix_phaseC<2>(F, ws, tid, lane, INP(13)); SEAM(pb + 4); }
            }
        } else {
            if (CH_S5) {
                if (IN(pb + 2)) { const int lane = lane_id(); for (int rep_ = 0; rep_ < REPS(6); ++rep_) s5_phaseA(F, ws, lane); SEAM(pb + 2); }
                if (IN(pb + 3)) { const int lane = lane_id(), tid = F.wave * 64 + lane; for (int rep_ = 0; rep_ < REPS(7); ++rep_) s5_phaseB(F, ws, tid); SEAM(pb + 3); }
                if (IN(pb + 4)) { const int lane = lane_id(); for (int rep_ = 0; rep_ < REPS(8); ++rep_) s5_phaseC(F, ws, lane, INP(22)); SEAM(pb + 4); }
            }
        }
        if (PHE(4) && layer == 3 && IN(pb + 6)) {
            pg8::DenseOrder S; S.init(YB, ws + WS_WT_S5_GLU, M, D, D, F.G, (int)blockIdx.x);
            pg8::EpiGlu E{YB, INP(25), (bf16*)ORAW};
            for (int rep_ = 0; rep_ < REPS(3); ++rep_)
            pg8::gemm_phase<pg8::EpiGlu, pg8::DenseOrder, true, true>(F.lds, F.wave, D, S, E);
            SEAM(pb + 6);
        }
        if (PHE(5) && IN(pb + 7)) {
            const bf16* Wt = (const bf16*)(ws + (layer == 0 ? WS_WT_ML_OUT : layer == 1 ? WS_WT_RET_OUT : layer == 2 ? WS_WT_GLA_OUT : WS_WT_S5_OUT));
            const int Kd = (layer == 1) ? 2048 : 1024;
            const bf16* Ain = (layer == 3) ? (const bf16*)ORAW : YB;
            pg8::DenseOrder S; S.init(Ain, Wt, M, D, Kd, F.G, (int)blockIdx.x);
            pg8::EpiResid E{hin, (layer == 0) ? (const bf16*)nullptr : (const bf16*)XB, ZF};
            for (int rep_ = 0; rep_ < REPS(3); ++rep_)
            pg8::gemm_phase<pg8::EpiResid, pg8::DenseOrder, true, true>(F.lds, F.wave, Kd, S, E);
            SEAM(pb + 7);
        }
        unsigned* cnt = ctl + CW_CNT + layer * 32 * 64;
        if (IN(pb + 8) && !defined_SKIP_LN1) { const int lane = lane_id(), tid = F.wave * 64 + lane; (void)tid;
            LAS float* Wt = (LAS float*)(F.lds);
            { const f32x4* wr4 = (const f32x4*)(INP(27) + (size_t)layer * D * NEXP);
              f32x4 wv[16];
#pragma unroll
              for (int i = 0; i < 16; ++i) wv[i] = wr4[tid + i * NTHREADS];
#pragma unroll
              for (int i = 0; i < 16; ++i) { const int q = tid + i * NTHREADS, k = q >> 3, e0 = (q & 7) * 4;
                  Wt[(e0 + 0) * 1028 + k] = wv[i][0]; Wt[(e0 + 1) * 1028 + k] = wv[i][1]; Wt[(e0 + 2) * 1028 + k] = wv[i][2]; Wt[(e0 + 3) * 1028 + k] = wv[i][3]; } }
            __syncthreads();
            const float* br_ = INP(28) + layer * NEXP;
            const float* lng_ = ln_g + (size_t)(layer * 2 + 0) * D; const float* lnb_ = ln_b + (size_t)(layer * 2 + 0) * D;
          {
            unsigned* cntp = cnt;
            int aE = 0, aRow = -1; float aG = 0.f;
            LAS unsigned* lcnt = (LAS unsigned*)(F.lds + 131584); LAS int* lbase = (LAS int*)(lcnt + 32);
            if (tid < 32) lcnt[tid] = 0u;
            const int ntrip = (M + F.NGW - 1) / F.NGW;
            u32x2 vnext[2][4];
#pragma unroll
            for (int q = 0; q < 2; ++q) { const int r_ = F.gw + q * F.NGW; if (r_ < M) { const u32x2* zp = (const u32x2*)(ZF + (size_t)r_ * D) + lane;
#pragma unroll
                for (int j = 0; j < 4; ++j) vnext[q][j] = zp[64 * j]; } }
            for (int it_ = 0; it_ < ntrip; it_ += 2) { const int row0_ = F.gw + it_ * F.NGW;
                asm volatile("" ::: "memory");
                const bool ok[2] = {row0_ < M, it_ + 1 < ntrip && row0_ + F.NGW < M};
                f32x4 v[2][4];
#pragma unroll
                for (int q = 0; q < 2; ++q)
#pragma unroll
                    for (int j = 0; j < 4; ++j) v[q][j] = (f32x4){bflo(vnext[q][j].x), bfhi(vnext[q][j].x), bflo(vnext[q][j].y), bfhi(vnext[q][j].y)};
#pragma unroll
                for (int q = 0; q < 2; ++q) { const int r_ = row0_ + (2 + q) * F.NGW; if (it_ + 2 + q < ntrip && r_ < M) { const u32x2* zp = (const u32x2*)(ZF + (size_t)r_ * D) + lane;
#pragma unroll
                    for (int j = 0; j < 4; ++j) vnext[q][j] = zp[64 * j]; } }
                { f32x4 gv[4], bv[4]; load_row_f32(lng_, gv, lane); load_row_f32(lnb_, bv, lane); ln_row(v[0], gv, bv); ln_row(v[1], gv, bv); }
                float pz[2][32];
#pragma unroll
                for (int e = 0; e < 32; ++e) { float s0 = 0.f, s1 = 0.f;
#pragma unroll
                    for (int j = 0; j < 4; ++j) { const f32x4 w = *(const LAS f32x4*)(Wt + e * 1028 + 4 * (lane + 64 * j));
                        s0 += v[0][j][0] * w[0] + v[0][j][1] * w[1] + v[0][j][2] * w[2] + v[0][j][3] * w[3]; s1 += v[1][j][0] * w[0] + v[1][j][1] * w[1] + v[1][j][2] * w[2] + v[1][j][3] * w[3]; }
                    pz[0][e] = s0; pz[1][e] = s1; }
                float lgv[2];
#pragma unroll
                for (int q = 0; q < 2; ++q) {
                    float a16[16], a8[8], a4[4], a2[2];
#pragma unroll
                    for (int e = 0; e < 16; ++e) { const auto r = __builtin_amdgcn_permlane32_swap(__builtin_bit_cast(unsigned, pz[q][e]), __builtin_bit_cast(unsigned, pz[q][e + 16]), false, false);
                        a16[e] = __builtin_bit_cast(float, (unsigned)r[0]) + __builtin_bit_cast(float, (unsigned)r[1]); }
#pragma unroll
                    for (int e = 0; e < 8; ++e) { const auto r = __builtin_amdgcn_permlane16_swap(__builtin_bit_cast(unsigned, a16[e]), __builtin_bit_cast(unsigned, a16[e + 8]), false, false);
                        a8[e] = __builtin_bit_cast(float, (unsigned)r[0]) + __builtin_bit_cast(float, (unsigned)r[1]); }
                    { const bool hi = (lane & 8) != 0;
#pragma unroll
                      for (int e = 0; e < 4; ++e) { const float mine = hi ? a8[e + 4] : a8[e], theirs = hi ? a8[e] : a8[e + 4]; a4[e] = mine + dpp_f<0x128>(theirs); } }
                    { const bool hi = (lane & 4) != 0;
#pragma unroll
                      for (int e = 0; e < 2; ++e) { const float mine = hi ? a4[e + 2] : a4[e], theirs = hi ? a4[e] : a4[e + 2]; a2[e] = mine + dpp_f<0x141>(theirs); } }
                    { const bool hi = (lane & 2) != 0; const float mine = hi ? a2[1] : a2[0], theirs = hi ? a2[0] : a2[1]; lgv[q] = mine + dpp_f<0x4E>(theirs); }
                    lgv[q] += dpp_f<0xB1>(lgv[q]);
                    lgv[q] += br_[lane >> 1];
                }
                int te[2][4]; float tv[2][4];
#pragma unroll
                for (int k = 0; k < 4; ++k)
#pragma unroll
                    for (int q = 0; q < 2; ++q) { const float best = wave_max(lgv[q]);
                        const unsigned long long mk = __ballot(lgv[q] == best); const int src = __builtin_amdgcn_readfirstlane((int)__ffsll((long long)mk) - 1);
                        te[q][k] = src >> 1; tv[q][k] = best; if ((lane >> 1) == te[q][k]) lgv[q] = -3.0e38f; }
#pragma unroll
                for (int q = 0; q < 2; ++q) if (ok[q]) { const int row = row0_ + q * F.NGW;
                    const float e0 = 1.f, e1 = __expf(tv[q][1] - tv[q][0]), e2 = __expf(tv[q][2] - tv[q][0]), e3 = __expf(tv[q][3] - tv[q][0]), rs = __builtin_amdgcn_rcpf(e0 + e1 + e2 + e3);
                    const int ri = (it_ + q) & 15;
                    if ((lane >> 2) == ri) { const int k = lane & 3; aE = k == 0 ? te[q][0] : k == 1 ? te[q][1] : k == 2 ? te[q][2] : te[q][3]; aG = (k == 0 ? e0 : k == 1 ? e1 : k == 2 ? e2 : e3) * rs; aRow = row; }
                    store_row_bf16(XB + (size_t)row * D, v[q], lane); }
                if (((it_ + 1) & 15) == 15 || it_ + 2 >= ntrip) {
                    __syncthreads();
                    int lp = 0; if (aRow >= 0) lp = (int)__hip_atomic_fetch_add(lcnt + aE, 1u, __ATOMIC_RELAXED, __HIP_MEMORY_SCOPE_WORKGROUP);
                    __syncthreads();
                    if (tid < 32) { const unsigned n = lcnt[tid]; lbase[tid] = n ? (int)__hip_atomic_fetch_add(cntp + tid * 64, n, __ATOMIC_RELAXED, __HIP_MEMORY_SCOPE_AGENT) : 0; }
                    __syncthreads();
                    if (aRow >= 0) { const int pos = lbase[aE] + lp; LIST[(size_t)aE * CAP + pos] = aRow * 4 + (lane & 3); GW[(size_t)aE * CAP + pos] = aG; }
                    aRow = -1;
                    __syncthreads();
                    if (tid < 32) lcnt[tid] = 0u;
                }
            }
          }
            __syncthreads();
            SEAM(pb + 8);
        }
        if ((PHE(7) || PHE(8)) && (IN(pb + 9) || IN(pb + 10))) { const int lane = lane_id(), tid = F.wave * 64 + lane; (void)tid;
            __syncthreads();
            if (tid < 32) TAB[tid] = (int)__hip_atomic_load(cnt + tid * 64, __ATOMIC_RELAXED, __HIP_MEMORY_SCOPE_AGENT);
            __syncthreads();
            if (tid < 64) {
                const int nt_ = (lane < 32) ? ((TAB[lane] + 255) >> 8) : 0; int inc = nt_;
#pragma unroll
                for (int d = 1; d < 32; d <<= 1) { const int t_ = __shfl_up(inc, d); if (lane >= d) inc += t_; }
                if (lane < 32) TAB[32 + lane] = inc - nt_;
                if (lane == 31) TAB[64] = inc; }
            __syncthreads();
            if (tid < MAXTILES) { int e = 0;
#pragma unroll
                for (int k = 1; k < 32; ++k) e += (TAB[32 + k] <= tid) ? 1 : 0;
                if (tid < TAB[64]) TAB[72 + tid] = e; }
            __syncthreads();
        }
        if (PHE(7) && IN(pb + 9)) {
            pg8::MoeOrder S; S.A = (const char*)XB; S.list = LIST; S.gwl = GW; S.Bt = (const char*)(ws + WS_WT_GU + (size_t)layer * 32 * 2048 * 1024 * 2); S.tab = TAB; S.K = D; S.nN = 8; S.ntiles = __builtin_amdgcn_readfirstlane(TAB[64]); S.nwg = S.ntiles * 8; S.G = F.G; S.c = (int)blockIdx.x;
            S.b_estride = (size_t)2048 * 1024 * 2; S.a_compact = 2;
            pg8::EpiSwiglu E{ACT, INP(30) + (size_t)layer * 32 * 2048, (const LAS float*)(TAB + 2816)};
            for (int rep_ = 0; rep_ < REPS(4); ++rep_)
            pg8::gemm_phase<pg8::EpiSwiglu, pg8::MoeOrder, MOE_ALIGN, true, true>(F.lds, F.wave, D, S, E, TAB + 512);
            SEAM(pb + 9);
        }
        if (PHE(8) && IN(pb + 10)) {
            pg8::MoeOrder S; S.A = (const char*)ACT; S.list = LIST; S.gwl = GW; S.Bt = (const char*)(ws + WS_WT_DN + (size_t)layer * 32 * 1024 * 1024 * 2); S.tab = TAB; S.K = DFF; S.nN = 4; S.ntiles = __builtin_amdgcn_readfirstlane(TAB[64]); S.nwg = S.ntiles * 4; S.G = F.G; S.c = (int)blockIdx.x;
            S.b_estride = (size_t)1024 * 1024 * 2; S.a_compact = 1;
            pg8::EpiMoeDown E{YS, INP(32) + (size_t)layer * 32 * 1024, TAB + 1280, (const LAS float*)(TAB + 2816)};
            for (int rep_ = 0; rep_ < REPS(5); ++rep_)
            pg8::gemm_phase<pg8::EpiMoeDown, pg8::MoeOrder, MOE_ALIGN, true, true>(F.lds, F.wave, DFF, S, E, TAB + 512);
            SEAM(pb + 10);
        }
        if (PHE(9) && IN(pb + 11)) { const int lane = lane_id(), tid = F.wave * 64 + lane; (void)tid;
            LAS float* Wt = (LAS float*)(F.lds);
            if (layer == 1) { load_cols16(tid, INP(10), 3088, 3072, Wt); __syncthreads(); }
            const float* lng_ = ln_g + (size_t)(layer * 2 + 1) * D; const float* lnb_ = ln_b + (size_t)(layer * 2 + 1) * D;
          for (int rep_ = 0; rep_ < REPS(12); ++rep_) {
            float* outp = (PROBE_CLS == 12 && rep_ == 0) ? ORAW : (layer == 3) ? d_out : HF; bf16* XBo = (PROBE_CLS == 12 && rep_ == 0) ? YB : XB;
            f32x4 hn[4]; u32x2 yn[4][4];
#define CMB_LOAD(r_) do { { const u32x2* hp_ = (const u32x2*)(XB + (size_t)(r_) * D) + lane; _Pragma("unroll") for (int j = 0; j < 4; ++j) { const u32x2 hw_ = hp_[64 * j]; hn[j] = (f32x4){bflo(hw_.x), bfhi(hw_.x), bflo(hw_.y), bfhi(hw_.y)}; } } _Pragma("unroll") for (int k = 0; k < 4; ++k) { const u32x2* yp = (const u32x2*)(YS + ((size_t)(r_) * 4 + k) * D) + lane; _Pragma("unroll") for (int j = 0; j < 4; ++j) yn[k][j] = yp[64 * j]; } } while (0)
            if (F.gw < M) CMB_LOAD(F.gw);
            for (int row = F.gw; row < M; row += F.NGW) {
                asm volatile("" ::: "memory");
                f32x4 v[4];
#pragma unroll
                for (int j = 0; j < 4; ++j) v[j] = hn[j] * ALPHA;
#pragma unroll
                for (int k = 0; k < 4; ++k)
#pragma unroll
                    for (int j = 0; j < 4; ++j) { const u32x2 yw = yn[k][j]; v[j][0] += bflo(yw.x); v[j][1] += bfhi(yw.x); v[j][2] += bflo(yw.y); v[j][3] += bfhi(yw.y); }
                if (row + F.NGW < M) CMB_LOAD(row + F.NGW);
                { f32x4 gv[4], bv[4]; load_row_f32(lng_, gv, lane); load_row_f32(lnb_, bv, lane); ln_row(v, gv, bv); }
                if (layer == 3) store_row_f32(outp + (size_t)row * D, v, lane);
                if (layer < 3) store_row_bf16(XBo + (size_t)row * D, v, lane);
                if (layer == 1) {
                    const float zsum = row_dot16(v, Wt, lane);
                    if ((lane & 3) == 0) GB[(size_t)row * 16 + (lane >> 2)] = zsum;
                }
            }
            if (layer == 1) {
                __syncthreads();
                const float* wgp = INP(11); const float bgc = INP(12)[tid];
                float wg[16];
#pragma unroll
                for (int r = 0; r < 16; ++r) wg[r] = wgp[r * 512 + tid];
                for (int row = F.vcu * NWAVES; row < M; row += F.NGW) {
                    f32x4 zv[NWAVES][4];
#pragma unroll
                    for (int w = 0; w < NWAVES; ++w)
#pragma unroll
                        for (int q = 0; q < 4; ++q) zv[w][q] = *(const f32x4*)(GB + (size_t)(row + w) * 16 + 4 * q);
#pragma unroll
                    for (int w = 0; w < NWAVES; ++w) { float sacc = bgc;
#pragma unroll
                        for (int q = 0; q < 4; ++q) sacc += zv[w][q][0] * wg[4 * q] + zv[w][q][1] * wg[4 * q + 1] + zv[w][q][2] * wg[4 * q + 2] + zv[w][q][3] * wg[4 * q + 3];
                        LA[(size_t)(row + w) * 512 + tid] = log_sigmoidf_(sacc) * (1.f / 16.f); }
                }
            }
          }
            __syncthreads();
#undef CMB_LOAD
            if (layer < 3) SEAM(pb + 11);
        }
}
__global__ void __launch_bounds__(NTHREADS, 2) mega_fwd(Args args) {
    extern __shared__ __attribute__((aligned(16))) unsigned char lds_raw[];
    Frame F;
    F.lds = (LAS unsigned char*)lds_raw;
    F.wave = __builtin_amdgcn_readfirstlane((int)threadIdx.x >> 6);
    F.G = gridDim.x; { const int bx = blockIdx.x; F.vcu = (F.G % 8 == 0) ? (bx % 8) * (F.G / 8) + bx / 8 : bx; }
    F.gw = F.vcu * NWAVES + F.wave; F.NGW = F.G * NWAVES;
    unsigned char* ws = args.ws;
    unsigned* ctl = (unsigned*)(ws + WS_CTL);
    volatile LAS unsigned* MISC = (volatile LAS unsigned*)(F.lds + MISC_OFF);
    LAS int* TAB = (LAS int*)(F.lds + TAB_OFF);
    { const int tid0 = threadIdx.x;
      if (tid0 < 64) MISC[tid0] = 0u;
      if (tid0 < 33) ((LAS unsigned long long*)(F.lds + MISC_OFF + 256))[tid0] = (unsigned long long)args.in[tid0]; }
    __syncthreads();
    XcdBarrier bar = xcd_barrier_post(ctl + CW_BAR, MISC + 8, F.wave == 0 && lane_id() == 0);
    if (PROBE_T >= 0 && blockIdx.x == 0 && F.wave == 0 && lane_id() == 0) { volatile LAS unsigned long long* st = (volatile LAS unsigned long long*)(F.lds + MISC_OFF + 1024); st[0] = __builtin_amdgcn_s_memrealtime(); st[1] = 0ull; }
    const int lo = args.ph_lo, hi = args.ph_hi;
    WS_PTRS
    if (IN(0) && !defined_SKIP_P0) { const int lane = lane_id(), tid = F.wave * 64 + lane; (void)tid;
      {
        LAS unsigned char* scr = F.lds + F.wave * 8704;
        {
            constexpr int I_GU = 128 * 16 * 32, I_DN = 128 * 16 * 16, I_ML = 16 * 48, I_SQ = 16 * 16, I_RI = 16 * 96, I_RO = 32 * 16;
            constexpr int B0 = I_GU, B1 = B0 + I_DN, B2 = B1 + I_ML, B3 = B2 + I_SQ, B4 = B3 + I_RI, B5 = B4 + I_RO, B6 = B5 + I_ML, B7 = B6 + I_SQ, B8 = B7 + I_SQ, B9 = B8 + I_SQ, B10 = B9 + I_SQ;
#define P0_ITEM(IT_) do { const int it = (IT_); \
                    const float* src; bf16* dst; int ldw, Kd, nnb, mode = 0, r; \
                    if (it < B0)      { r = it;      const int q = r / (16 * 32); r -= q * (16 * 32); src = INP(29) + (size_t)q * 1024 * 2048; dst = (bf16*)(ws + WS_WT_GU) + (size_t)q * 2048 * 1024; ldw = 2048; Kd = 1024; nnb = 32; mode = 1; } \
                    else if (it < B1) { r = it - B0; const int q = r / (16 * 16); r -= q * (16 * 16); src = INP(31) + (size_t)q * 1024 * 1024; dst = (bf16*)(ws + WS_WT_DN) + (size_t)q * 1024 * 1024; ldw = 1024; Kd = 1024; nnb = 16; } \
                    else if (it < B2) { r = it - B1; src = INP(3);  dst = (bf16*)(ws + WS_WT_ML_IN);  ldw = 3088; Kd = 1024; nnb = 48; } \
                    else if (it < B3) { r = it - B2; src = INP(6);  dst = (bf16*)(ws + WS_WT_ML_OUT); ldw = 1024; Kd = 1024; nnb = 16; } \
                    else if (it < B4) { r = it - B3; src = INP(7);  dst = (bf16*)(ws + WS_WT_RET_IN); ldw = 6144; Kd = 1024; nnb = 96; mode = 2; } \
                    else if (it < B5) { r = it - B4; src = INP(9);  dst = (bf16*)(ws + WS_WT_RET_OUT); ldw = 1024; Kd = 2048; nnb = 16; } \
                    else if (it < B6) { r = it - B5; src = INP(10); dst = (bf16*)(ws + WS_WT_GLA_IN); ldw = 3088; Kd = 1024; nnb = 48; } \
                    else if (it < B7) { r = it - B6; src = INP(14); dst = (bf16*)(ws + WS_WT_GLA_OUT); ldw = 1024; Kd = 1024; nnb = 16; } \
                    else if (it < B8) { r = it - B7; src = INP(15); dst = (bf16*)(ws + WS_WT_S5_IN);  ldw = 1024; Kd = 1024; nnb = 16; } \
                    else if (it < B9) { r = it - B8; src = INP(24); dst = (bf16*)(ws + WS_WT_S5_GLU); ldw = 1024; Kd = 1024; nnb = 16; } \
                    else              { r = it - B9; src = INP(26); dst = (bf16*)(ws + WS_WT_S5_OUT); ldw = 1024; Kd = 1024; nnb = 16; } \
                const int kb = r / nnb, nb = r - kb * nnb; \
                transpose_item(src, ldw, 0, Kd, dst, mode, kb, nb, scr, lane); } while (0)
            const int NSTAT = (B10 / F.NGW) * 4 / 5, DYN0 = NSTAT * F.NGW, DLEN = B10 - DYN0, GLEN = (DLEN + 7) / 8;
#pragma unroll 1
            for (int n_ = 0; n_ < NSTAT; ++n_) P0_ITEM(F.gw + n_ * F.NGW);
#pragma unroll 1
            for (int tr = 0; tr < 8; ++tr) { const int grp = ((int)blockIdx.x + tr) & 7; unsigned* q = ctl + 2304 + 64 * grp; const int glo = DYN0 + grp * GLEN, glen = (DLEN - grp * GLEN) < GLEN ? (DLEN - grp * GLEN) : GLEN;
                int cur = 0; if (lane == 0) cur = (int)__hip_atomic_fetch_add(q, 4u, __ATOMIC_RELAXED, __HIP_MEMORY_SCOPE_AGENT); cur = __builtin_amdgcn_readfirstlane(cur);
#pragma unroll 1
                while (cur < glen) { int nx = 0; if (lane == 0) nx = (int)__hip_atomic_fetch_add(q, 4u, __ATOMIC_RELAXED, __HIP_MEMORY_SCOPE_AGENT);
#pragma unroll 1
                    for (int k = 0; k < 4; ++k) if (cur + k < glen) P0_ITEM(glo + cur + k);
                    cur = __builtin_amdgcn_readfirstlane(nx); } }
#undef P0_ITEM
        }
        __syncthreads();
        if (CH_S5) s5_tables(F, ws, tid, INP(16), INP(17), INP(18), INP(19), INP(20), INP(21), INP(23));
        { float* CS = (float*)(ws + WS_CS);
          for (int it = blockIdx.x * NTHREADS + tid; it < T * 64; it += F.G * NTHREADS) { const int t = it >> 6, i = it & 63;
              const float inv = exp2f(-(float)(2 * i) * (13.287712379549449f / 128.f)); float sn, cs; sincosf((float)t * inv, &sn, &cs); CS[2 * it] = cs; CS[2 * it + 1] = sn; } }
        LAS float* Wt = (LAS float*)(F.lds);
        load_cols16(tid, INP(3), 3088, 3072, Wt);
        __syncthreads();
        {
            const float* bg = INP(4);
            f32x4 vn[4]; if (F.gw < M) load_row_f32(x_in + (size_t)F.gw * D, vn, lane);
            for (int row = F.gw; row < M; row += F.NGW) {
                asm volatile("" ::: "memory");
                f32x4 v[4];
#pragma unroll
                for (int j = 0; j < 4; ++j) v[j] = vn[j];
                if (row + F.NGW < M) load_row_f32(x_in + (size_t)(row + F.NGW) * D, vn, lane);
                store_row_bf16(XB + (size_t)row * D, v, lane);
                const float gsum = row_dot16(v, Wt, lane);
                if ((lane & 3) == 0) GB[(size_t)row * 16 + (lane >> 2)] = gsum + bg[lane >> 2];
            }
        }
        __syncthreads();
      }
        SEAM(0);
    }

    layer_body<0>(F, ws, ctl, TAB, bar, lo, hi, args.out);
    layer_body<1>(F, ws, ctl, TAB, bar, lo, hi, args.out);
    layer_body<2>(F, ws, ctl, TAB, bar, lo, hi, args.out);
    layer_body<3>(F, ws, ctl, TAB, bar, lo, hi, args.out);
    if (PROBE_T >= 0 && blockIdx.x == 0 && F.wave == 0 && lane_id() == 0) { volatile LAS unsigned long long* st = (volatile LAS unsigned long long*)(F.lds + MISC_OFF + 1024); args.out[0] = (float)st[1] * (0.01f / 16.f); }
#undef IN
#undef SEAM
#undef INP
#undef x_in
#undef ln_g
#undef ln_b
}

extern "C" void kernel_launch(void* const* d_in, const int* in_sizes, int n_in, void* d_out, int out_size, void* d_ws, size_t ws_size, hipStream_t stream) {
    static int grid = 0;
    if (grid == 0) {
        if (n_in != 33 || out_size != M * D || ws_size < WS_END) { fprintf(stderr, "kernel_launch: unexpected problem (n_in %d, out %d, ws %zu < %zu)\n", n_in, out_size, ws_size, (size_t)WS_END); grid = -1; return; }
        int dev = 0, cus = 0, per_cu = 0;
        if (hipGetDevice(&dev) != hipSuccess || hipDeviceGetAttribute(&cus, hipDeviceAttributeMultiprocessorCount, dev) != hipSuccess) { grid = -1; return; }
        if (hipFuncSetAttribute((const void*)mega_fwd, hipFuncAttributeMaxDynamicSharedMemorySize, LDS_BYTES) != hipSuccess) { fprintf(stderr, "kernel_launch: hipFuncSetAttribute failed\n"); grid = -1; return; }
        if (hipOccupancyMaxActiveBlocksPerMultiprocessor(&per_cu, (const void*)mega_fwd, NTHREADS, LDS_BYTES) != hipSuccess || per_cu < 1) { fprintf(stderr, "kernel_launch: occupancy query says %d\n", per_cu); }
        (void)hipGetLastError();
        grid = cus;
    }
    if (grid < 0) return;
    hipMemsetAsync((char*)d_ws + WS_CTL, 0, CTL_ZERO_BYTES, stream);
    Args a{};
    for (int i = 0; i < 33; ++i) a.in[i] = (const float*)d_in[i];
    a.out = (float*)d_out; a.ws = (unsigned char*)d_ws;
#if N_LAUNCH_MODE == 1
    a.ph_lo = 0; a.ph_hi = 1000;
    hipLaunchKernelGGL(mega_fwd, dim3(grid), dim3(NTHREADS), LDS_BYTES, stream, a);
#else
    for (int ph = 0; ph < 65; ++ph) { a.ph_lo = ph; a.ph_hi = ph + 1; hipLaunchKernelGGL(mega_fwd, dim3(grid), dim3(NTHREADS), LDS_BYTES, stream, a); }
#endif
}
```

```cpp
#include <hip/hip_runtime.h>
#include <cstdio>
#include <cstdint>

#ifndef NAIVE_MIX
#define NAIVE_MIX 1
#endif
#ifndef CH_ML
#define CH_ML 1
#endif
#ifndef CH_RET
#define CH_RET 1
#endif
#ifndef CH_GLA
#define CH_GLA 1
#endif
#ifndef CH_S5
#define CH_S5 1
#endif
#ifndef PROBE_CLS
#define PROBE_CLS 0
#endif
#define REPS(c) ((PROBE_CLS == (c) || PROBE_CLS == 100 + layer * 10 + (c)) ? 2 : 1)
#ifndef PROBE_T
#define PROBE_T -1
#endif
#ifndef PROBE_T2
#define PROBE_T2 PROBE_T
#endif
#ifndef MOE_ALIGN
#define MOE_ALIGN true
#endif
#ifndef N_LAUNCH_MODE
#define N_LAUNCH_MODE 1
#endif


#ifdef SKIP_ML
constexpr bool defined_SKIP_ML = true;
#else
constexpr bool defined_SKIP_ML = false;
#endif
#ifdef SKIP_RET
constexpr bool defined_SKIP_RET = true;
#else
constexpr bool defined_SKIP_RET = false;
#endif
#ifdef SKIP_GLA
constexpr bool defined_SKIP_GLA = true;
#else
constexpr bool defined_SKIP_GLA = false;
#endif
#ifdef SKIP_S5
constexpr bool defined_SKIP_S5 = true;
#else
constexpr bool defined_SKIP_S5 = false;
#endif
#ifdef SKIP_LN1
constexpr bool defined_SKIP_LN1 = true;
#else
constexpr bool defined_SKIP_LN1 = false;
#endif
#ifdef SKIP_P0
constexpr bool defined_SKIP_P0 = true;
#else
constexpr bool defined_SKIP_P0 = false;
#endif
#ifndef PHMASK
#define PHMASK 0xffff
#endif
#define PHE(b) (((PHMASK) >> (b)) & 1)
#define GAS __attribute__((address_space(1)))
#define LAS __attribute__((address_space(3)))
typedef unsigned short bf16;
typedef short bf16x8 __attribute__((ext_vector_type(8)));
typedef float f32x4 __attribute__((ext_vector_type(4)));
typedef float f32x2 __attribute__((ext_vector_type(2)));
typedef unsigned u32x4 __attribute__((ext_vector_type(4)));
typedef unsigned u32x2 __attribute__((ext_vector_type(2)));

constexpr int BATCH = 2, T = 8192, D = 1024, M = BATCH * T;
constexpr int NEXP = 32, TOPK = 4, DFF = 1024, CAP = M;
constexpr int NWAVES = 8, NTHREADS = 512;
constexpr float LN_EPS = 1e-5f;
constexpr float ALPHA = 1.681792830507429f;
constexpr int MAXTILES = (M * TOPK) / 256 + NEXP;

constexpr size_t MiB = 1u << 20;
constexpr size_t WS_CTL = 0, CTL_ZERO_BYTES = 1 * MiB;
constexpr size_t WS_WT_ML_IN = 1 * MiB;
constexpr size_t WS_WT_ML_OUT = WS_WT_ML_IN + 6 * MiB;
constexpr size_t WS_WT_RET_IN = WS_WT_ML_OUT + 2 * MiB;
constexpr size_t WS_WT_RET_OUT = WS_WT_RET_IN + 12 * MiB;
constexpr size_t WS_WT_GLA_IN = WS_WT_RET_OUT + 4 * MiB;
constexpr size_t WS_WT_GLA_OUT = WS_WT_GLA_IN + 6 * MiB;
constexpr size_t WS_WT_S5_IN = WS_WT_GLA_OUT + 2 * MiB;
constexpr size_t WS_WT_S5_GLU = WS_WT_S5_IN + 2 * MiB;
constexpr size_t WS_WT_S5_OUT = WS_WT_S5_GLU + 2 * MiB;
constexpr size_t WS_S5TAB = WS_WT_S5_OUT + 2 * MiB;
constexpr size_t WS_GB = WS_S5TAB + 1 * MiB;
constexpr size_t WS_LIST = WS_GB + 1 * MiB;
constexpr size_t WS_GW = WS_LIST + 2 * MiB;
constexpr size_t WS_WT_GU = WS_GW + 1 * MiB;
constexpr size_t WS_WT_DN = WS_WT_GU + 512 * MiB;
constexpr size_t WS_HF = WS_WT_DN + 256 * MiB;
constexpr size_t WS_XB = WS_HF + 64 * MiB;
constexpr size_t WS_ZF = WS_XB + 32 * MiB;
constexpr size_t WS_PB = WS_ZF + 64 * MiB;
constexpr size_t WS_LA = WS_PB + 192 * MiB;
constexpr size_t WS_ORAW = WS_LA + 32 * MiB;
constexpr size_t WS_YB = WS_ORAW + 128 * MiB;
constexpr size_t WS_ACT = WS_YB + 64 * MiB;
constexpr size_t WS_YS = WS_ACT + 144 * MiB;
constexpr size_t WS_XG = WS_YS + 256 * MiB;
constexpr size_t WS_UT = WS_XG + 1024 * MiB;
constexpr size_t WS_ST = WS_UT + 128 * MiB;
constexpr size_t WS_KPP = WS_ST + 64 * MiB;
constexpr size_t WS_SC = WS_KPP + 16 * MiB;
constexpr size_t WS_S5KT = WS_SC + 4 * MiB;
constexpr size_t WS_S5VT = WS_S5KT + 2 * MiB;
constexpr size_t WS_S5WT = WS_S5VT + 16 * MiB;
constexpr size_t WS_S5L64 = WS_S5WT + 16 * MiB;
constexpr size_t WS_S5SL = WS_S5L64 + 1 * MiB;
constexpr size_t WS_S5SP = WS_S5SL + 16 * MiB;
constexpr size_t WS_CS = WS_S5SP + 8 * MiB;
constexpr size_t WS_END = WS_CS + 4 * MiB;
constexpr int CW_BAR = 4096;
constexpr int CW_CNT = 16384;

constexpr int PH_BYTES = 139264;
constexpr int TAB_OFF = PH_BYTES;
constexpr int MISC_OFF = TAB_OFF + 16384;
constexpr int LDS_BYTES = 159744;

typedef __bf16 bf16x2_t __attribute__((ext_vector_type(2)));
__device__ __forceinline__ unsigned pk2(float lo, float hi) { const f32x2 v = {lo, hi}; const bf16x2_t b = __builtin_convertvector(v, bf16x2_t); return __builtin_bit_cast(unsigned, b); }
__device__ __forceinline__ unsigned f2bf(float f) { return pk2(f, 0.f) & 0xffffu; }
__device__ __forceinline__ float bf2f(unsigned short b) { return __builtin_bit_cast(float, ((unsigned)b) << 16); }
__device__ __forceinline__ float bflo(unsigned w) { return __builtin_bit_cast(float, w << 16); }
__device__ __forceinline__ float bfhi(unsigned w) { return __builtin_bit_cast(float, w & 0xffff0000u); }
__device__ __forceinline__ int lane_id() { int l; asm volatile("v_mbcnt_lo_u32_b32 %0, -1, 0\n\tv_mbcnt_hi_u32_b32 %0, -1, %0" : "=v"(l)); return l; }
template <int CTRL> __device__ __forceinline__ float dpp_f(float v) { return __builtin_bit_cast(float, __builtin_amdgcn_update_dpp(0, __builtin_bit_cast(int, v), CTRL, 0xf, 0xf, false)); }
__device__ __forceinline__ float rl_f(float v, int l) { return __builtin_bit_cast(float, __builtin_amdgcn_readlane(__builtin_bit_cast(int, v), l)); }
__device__ __forceinline__ float wave_sum(float v) {
    v += dpp_f<0xB1>(v);
    v += dpp_f<0x4E>(v);
    v += dpp_f<0x141>(v);
    v += dpp_f<0x140>(v);
    return (rl_f(v, 0) + rl_f(v, 16)) + (rl_f(v, 32) + rl_f(v, 48));
}
__device__ __forceinline__ float row16_sum(float v) { v += dpp_f<0xB1>(v); v += dpp_f<0x4E>(v); v += dpp_f<0x141>(v); v += dpp_f<0x140>(v); return v; }
__device__ __forceinline__ float wave_max(float v) {
    v = fmaxf(v, dpp_f<0xB1>(v)); v = fmaxf(v, dpp_f<0x4E>(v)); v = fmaxf(v, dpp_f<0x141>(v)); v = fmaxf(v, dpp_f<0x140>(v));
    return fmaxf(fmaxf(rl_f(v, 0), rl_f(v, 16)), fmaxf(rl_f(v, 32), rl_f(v, 48)));
}
__device__ __forceinline__ float sigmoidf_(float x) { return __builtin_amdgcn_rcpf(1.f + __expf(-x)); }
__device__ __forceinline__ float log_sigmoidf_(float x) { return fminf(x, 0.f) - __logf(1.f + __expf(-fabsf(x))); }
__device__ __forceinline__ float gelu_tanh(float x) { const float u = 0.7978845608028654f * (x + 0.044715f * x * x * x); return x * sigmoidf_(2.f * u); }

namespace pg8 {
constexpr int BM = 256, BK = 64, HALF = 128, HTB = HALF * BK * 2, STAGE_BYTES = 8 * HTB, NXCD = 8, WGM = 8;
__host__ __device__ __forceinline__ int lds_byte(int r, int c) { const int st = (r >> 4) * 2 + (c >> 5), rr = r & 15, cc = c & 31, ob = rr * 64 + cc * 2; return st * 1024 + (ob ^ (((ob >> 9) & 1) << 5)); }
__host__ __device__ __forceinline__ void stage_rc(int b, int& R, int& C) { const int st = b / 1024, sb = b % 1024, swz = sb ^ (((sb >> 9) & 1) << 5); R = (st >> 1) * 16 + swz / 64; C = (st & 1) * 32 + (swz % 64) / 2; }
__host__ __device__ __forceinline__ int perm32(int rho) { const int n = rho >> 4, i = rho & 15; return 8 * (i >> 2) + 4 * n + (i & 3); }

struct Unit { const char* A; const char* B; int pm, pn, e, nvalid, r0, buf; };

__device__ __forceinline__ int xcd_remap(int L, int nwg) { const int q = nwg / NXCD, r = nwg % NXCD, xcd = L % NXCD, off = L / NXCD; return (xcd < r ? xcd * (q + 1) : r * (q + 1) + (xcd - r) * q) + off; }

struct DenseOrder {
    const char* A; const char* Bt; int K, nM, nN, nwg, G, c; const int* list; const float* gwl; static constexpr int a_compact = 0;
    __device__ __forceinline__ void init(const void* A_, const void* Bt_, int M_, int N_, int K_, int G_, int c_) { A = (const char*)A_; Bt = (const char*)Bt_; K = K_; nM = M_ / BM; nN = N_ / BM; nwg = nM * nN; G = G_; c = c_; list = nullptr; gwl = nullptr; }
    __device__ __forceinline__ bool next(int i, Unit& u) const {
        const long L = (long)i * G + c; if (L >= nwg) return false;
        const int wgid = xcd_remap((int)L, nwg);
        const int nig = WGM * nN, gid = wgid / nig, fm = gid * WGM, gsz = (nM - fm) < WGM ? (nM - fm) : WGM;
        u.pm = fm + ((wgid % nig) % gsz); u.pn = (wgid % nig) / gsz; u.e = 0; u.nvalid = 256; u.r0 = 0;
        u.A = A + (size_t)u.pm * 256 * K * 2; u.B = Bt + (size_t)u.pn * 256 * K * 2; return true;
    }
};
struct MoeOrder {
    const char* A; const char* Bt; const LAS int* tab;
    int K, nN, ntiles, nwg, G, c; size_t b_estride; int a_compact; const int* list; const float* gwl;
    __device__ __forceinline__ bool next(int i, Unit& u) const {
        const long L = (long)i * G + c; if (L >= nwg) return false;
        const int wgid = xcd_remap((int)L, nwg);
        const int nig = WGM * nN, gid = wgid / nig, fm = gid * WGM, gsz = (ntiles - fm) < WGM ? (ntiles - fm) : WGM;
        const int tl = fm + ((wgid % nig) % gsz); u.pm = tl; u.pn = (wgid % nig) / gsz;
        const int e = __builtin_amdgcn_readfirstlane(tab[72 + tl]); u.e = e; const int r0 = (tl - __builtin_amdgcn_readfirstlane(tab[32 + e])) * 256; const int rem = __builtin_amdgcn_readfirstlane(tab[e]) - r0; u.nvalid = rem < 256 ? rem : 256; u.r0 = r0;
        u.A = (a_compact == 2) ? A : a_compact ? A + (size_t)tl * 256 * K * 2 : A + ((size_t)e * CAP + r0) * K * 2;
        u.B = Bt + (size_t)e * b_estride + (size_t)u.pn * 256 * K * 2; return true;
    }
};

__device__ __forceinline__ unsigned cvt_pk_bf16(float lo, float hi) { unsigned r; asm volatile("v_cvt_pk_bf16_f32 %0, %1, %2" : "=v"(r) : "v"(lo), "v"(hi)); return r; }

struct EpiBf16 {
    static constexpr bool BIASTAB = false; static constexpr bool ROWINFO = false; static constexpr bool PERM = true;
    bf16* O; int ldc; const float* cs; int rot_tiles;
    __device__ __forceinline__ void operator()(const f32x4 (&acc)[2][2][4][2], const Unit& u, int wr, int wc, int fr, int fq) const {
        const int row0 = u.pm * BM + wr * 64 + fr, col0 = u.pn * BM + wc * 32 + 8 * fq;
        const bool rot = u.pn < rot_tiles; const float sc = (col0 >= 1024) ? 0.08838834764831845f : 1.f;
#pragma unroll
        for (int ai = 0; ai < 2; ++ai)
#pragma unroll
            for (int m = 0; m < 4; ++m) { const int row = row0 + ai * HALF + m * 16; bf16* rowp = O + (size_t)row * ldc + col0;
#pragma unroll
                for (int bj = 0; bj < 2; ++bj) { f32x4 v0 = acc[ai][bj][m][0], v1 = acc[ai][bj][m][1];
                    if (rot) { const float* cp = cs + ((size_t)(row & (T - 1)) * 64 + (((col0 + bj * HALF) & 127) >> 1)) * 2; const f32x4 c0 = *(const f32x4*)cp, c1 = *(const f32x4*)(cp + 4);
                        const f32x4 a0 = v0, a1 = v1;
                        v0[0] = (a0[0] * c0[0] - a0[1] * c0[1]) * sc; v0[1] = (a0[0] * c0[1] + a0[1] * c0[0]) * sc; v0[2] = (a0[2] * c0[2] - a0[3] * c0[3]) * sc; v0[3] = (a0[2] * c0[3] + a0[3] * c0[2]) * sc;
                        v1[0] = (a1[0] * c1[0] - a1[1] * c1[1]) * sc; v1[1] = (a1[0] * c1[1] + a1[1] * c1[0]) * sc; v1[2] = (a1[2] * c1[2] - a1[3] * c1[3]) * sc; v1[3] = (a1[2] * c1[3] + a1[3] * c1[2]) * sc; }
                    u32x4 w; w.x = cvt_pk_bf16(v0[0], v0[1]); w.y = cvt_pk_bf16(v0[2], v0[3]); w.z = cvt_pk_bf16(v1[0], v1[1]); w.w = cvt_pk_bf16(v1[2], v1[3]);
                    *(u32x4*)(rowp + bj * HALF) = w; } }
    }
};
struct EpiResid {
    static constexpr bool BIASTAB = false; static constexpr bool ROWINFO = false; static constexpr bool PERM = true;
    const float* __restrict__ hin; const bf16* __restrict__ hinb; bf16* __restrict__ Z;
    __device__ __forceinline__ void operator()(const f32x4 (&acc)[2][2][4][2], const Unit& u, int wr, int wc, int fr, int fq) const {
        const int row0 = u.pm * BM + wr * 64 + fr, col0 = u.pn * BM + wc * 32 + 8 * fq;
#pragma unroll
        for (int ai = 0; ai < 2; ++ai)
#pragma unroll
            for (int m = 0; m < 4; ++m) { const size_t off = (size_t)(row0 + ai * HALF + m * 16) * D + col0;
                f32x4 hv[2][2];
                if (hinb) {
#pragma unroll
                    for (int bj = 0; bj < 2; ++bj) { const u32x4 hw = *(const u32x4*)(hinb + off + bj * HALF);
                        hv[bj][0] = (f32x4){bflo(hw.x), bfhi(hw.x), bflo(hw.y), bfhi(hw.y)}; hv[bj][1] = (f32x4){bflo(hw.z), bfhi(hw.z), bflo(hw.w), bfhi(hw.w)}; }
                } else {
#pragma unroll
                    for (int bj = 0; bj < 2; ++bj)
#pragma unroll
                        for (int n = 0; n < 2; ++n) hv[bj][n] = *(const f32x4*)(hin + off + bj * HALF + n * 4);
                }
#pragma unroll
                for (int bj = 0; bj < 2; ++bj) { const f32x4 v0 = hv[bj][0] * ALPHA + acc[ai][bj][m][0], v1 = hv[bj][1] * ALPHA + acc[ai][bj][m][1];
                    u32x4 w; w.x = cvt_pk_bf16(v0[0], v0[1]); w.y = cvt_pk_bf16(v0[2], v0[3]); w.z = cvt_pk_bf16(v1[0], v1[1]); w.w = cvt_pk_bf16(v1[2], v1[3]);
                    *(u32x4*)(Z + off + bj * HALF) = w; } }
    }
};
struct EpiGlu {
    static constexpr bool BIASTAB = false; static constexpr bool ROWINFO = false; static constexpr bool PERM = true;
    const bf16* Y; const float* bias; bf16* O;
    __device__ __forceinline__ void operator()(const f32x4 (&acc)[2][2][4][2], const Unit& u, int wr, int wc, int fr, int fq) const {
        const int row0 = u.pm * BM + wr * 64 + fr, col0 = u.pn * BM + wc * 32 + 8 * fq;
#pragma unroll
        for (int ai = 0; ai < 2; ++ai)
#pragma unroll
            for (int m = 0; m < 4; ++m) { const size_t off = (size_t)(row0 + ai * HALF + m * 16) * D + col0;
#pragma unroll
                for (int bj = 0; bj < 2; ++bj) {
                    const f32x4 b0 = *(const f32x4*)(bias + col0 + bj * HALF), b1 = *(const f32x4*)(bias + col0 + bj * HALF + 4);
                    const u32x4 yw = *(const u32x4*)(Y + off + bj * HALF);
                    const f32x4 v0 = acc[ai][bj][m][0] + b0, v1 = acc[ai][bj][m][1] + b1;
                    float o[8];
                    o[0] = bflo(yw.x) * sigmoidf_(v0[0]); o[1] = bfhi(yw.x) * sigmoidf_(v0[1]); o[2] = bflo(yw.y) * sigmoidf_(v0[2]); o[3] = bfhi(yw.y) * sigmoidf_(v0[3]);
                    o[4] = bflo(yw.z) * sigmoidf_(v1[0]); o[5] = bfhi(yw.z) * sigmoidf_(v1[1]); o[6] = bflo(yw.w) * sigmoidf_(v1[2]); o[7] = bfhi(yw.w) * sigmoidf_(v1[3]);
                    u32x4 w; w.x = cvt_pk_bf16(o[0], o[1]); w.y = cvt_pk_bf16(o[2], o[3]); w.z = cvt_pk_bf16(o[4], o[5]); w.w = cvt_pk_bf16(o[6], o[7]);
                    *(u32x4*)(O + off + bj * HALF) = w; } }
    }
};
struct EpiSwiglu {
    static constexpr bool BIASTAB = true; static constexpr bool ROWINFO = false; static constexpr bool PERM = true;
    bf16* ACT; const float* bgu; const LAS float* btab;
    __device__ __forceinline__ float bias_at(const Unit& u, int j) const { return bgu[(size_t)u.e * 2 * DFF + (j < HALF ? 0 : DFF) + u.pn * HALF + (j & (HALF - 1))]; }
    __device__ __forceinline__ void operator()(const f32x4 (&acc)[2][2][4][2], const Unit& u, int wr, int wc, int fr, int fq) const {
        const int row0 = u.pm * BM + wr * 64 + fr, j0 = u.pn * HALF + wc * 32 + 8 * fq;
        const LAS float* bt = btab + u.buf * 256 + wc * 32 + 8 * fq;
        const f32x4 g0 = *(const LAS f32x4*)(bt), g1 = *(const LAS f32x4*)(bt + 4), u0 = *(const LAS f32x4*)(bt + HALF), u1 = *(const LAS f32x4*)(bt + HALF + 4);
#pragma unroll
        for (int ai = 0; ai < 2; ++ai)
#pragma unroll
            for (int m = 0; m < 4; ++m) {
                float o[8];
#pragma unroll
                for (int n = 0; n < 2; ++n)
#pragma unroll
                    for (int i = 0; i < 4; ++i) {
                        float g = acc[ai][0][m][n][i] + (n ? g1[i] : g0[i]), up = acc[ai][1][m][n][i] + (n ? u1[i] : u0[i]);
                        g = fminf(g, 7.0f); up = fminf(fmaxf(up, -7.0f), 7.0f);
                        o[n * 4 + i] = (up + 1.0f) * g * sigmoidf_(1.702f * g); }
                u32x4 w; w.x = cvt_pk_bf16(o[0], o[1]); w.y = cvt_pk_bf16(o[2], o[3]); w.z = cvt_pk_bf16(o[4], o[5]); w.w = cvt_pk_bf16(o[6], o[7]);
                *(u32x4*)(ACT + (size_t)(row0 + ai * HALF + m * 16) * DFF + j0) = w; }
    }
};
struct EpiMoeDown {
    static constexpr bool BIASTAB = true; static constexpr bool ROWINFO = true; static constexpr bool PERM = true;
    bf16* YS; const float* bd; const LAS int* rinfo; const LAS float* btab;
    __device__ __forceinline__ float bias_at(const Unit& u, int j) const { return bd[(size_t)u.e * D + u.pn * BM + j]; }
    __device__ __forceinline__ void operator()(const f32x4 (&acc)[2][2][4][2], const Unit& u, int wr, int wc, int fr, int fq) const {
        const int col0 = u.pn * BM + wc * 32 + 8 * fq;
        const LAS float* bt = btab + u.buf * 256 + wc * 32 + 8 * fq;
        f32x4 bv[2][2];
#pragma unroll
        for (int bj = 0; bj < 2; ++bj)
#pragma unroll
            for (int n = 0; n < 2; ++n) bv[bj][n] = *(const LAS f32x4*)(bt + bj * HALF + 4 * n);
        const LAS int* ri = rinfo + u.buf * 512;
#pragma unroll
        for (int ai = 0; ai < 2; ++ai)
#pragma unroll
            for (int m = 0; m < 4; ++m) { const int r = ai * HALF + wr * 64 + m * 16 + fr; const int slot = ri[r];
                if (slot >= 0) { const float gg = __builtin_bit_cast(float, ri[256 + r]); bf16* op = YS + (size_t)slot * D + col0;
#pragma unroll
                    for (int bj = 0; bj < 2; ++bj) { const f32x4 v0 = (acc[ai][bj][m][0] + bv[bj][0]) * gg, v1 = (acc[ai][bj][m][1] + bv[bj][1]) * gg;
                        u32x4 w; w.x = cvt_pk_bf16(v0[0], v0[1]); w.y = cvt_pk_bf16(v0[2], v0[3]); w.z = cvt_pk_bf16(v1[0], v1[1]); w.w = cvt_pk_bf16(v1[2], v1[3]);
                        *(u32x4*)(op + bj * HALF) = w; } } }
    }
};

template <class Epi, class Sched, bool ALIGN_EPI, bool SP2, bool GATHER = false>
__device__ __forceinline__ void gemm_phase(LAS unsigned char* lds, const int wid, const int K, const Sched& S, const Epi& E, LAS int* rowtab = nullptr) {
    const int lane = lane_id(), tid = wid * 64 + lane, wr = wid >> 2, wc = wid & 3, fr = lane & 15, fq = lane >> 4;
    const int nt = K / BK;
    unsigned voffA[2], voffB[2]; int Rr[2]; unsigned Cc2[2];
#pragma unroll
    for (int i = 0; i < 2; ++i) { int R, C; stage_rc(tid * 16 + i * 8192, R, C); const int Rb = Epi::PERM ? ((R & ~31) + perm32(R & 31)) : R;
        voffA[i] = (unsigned)(R * K + C) * 2u; voffB[i] = (unsigned)(Rb * K + C) * 2u; Rr[i] = R; Cc2[i] = (unsigned)C * 2u; }
    unsigned vA[2][2] = {{0u, 0u}, {0u, 0u}}, vN[2][2] = {{0u, 0u}, {0u, 0u}};
    const size_t kstep = (size_t)(BK * 2);
    const size_t hstep = (size_t)HALF * K * 2;
    const unsigned ldsw = (unsigned)wid * 1024u;
    const int aoff = lds_byte(wr * 64 + fr, fq * 8), boff = lds_byte(wc * 32 + fr, fq * 8);
#define PG8_SA(b, h) (((b) * 2 + (h)) * HTB)
#define PG8_SB(b, h) ((4 + (b) * 2 + (h)) * HTB)
#define PG8_STAGE(bufoff, gbase, voff) do { _Pragma("unroll") for (int _i = 0; _i < 2; ++_i) \
        __builtin_amdgcn_global_load_lds((const unsigned*)((const char*)(gbase) + (voff)[_i]), (LAS unsigned*)(lds + (bufoff) + ldsw + _i * 8192), 16, 0, 0); } while (0)
#define PG8_STAGE_A(bufoff, kbase, h, VO) do { if constexpr (GATHER) { PG8_STAGE(bufoff, kbase, (VO)[h]); } else { PG8_STAGE(bufoff, (kbase) + (h) * hstep, voffA); } } while (0)
#define PG8_FILL(buf, U) do { if (tid < 256) { const bool ok_ = tid < (U).nvalid; const int ent_ = (ok_ && (S.a_compact == 2 || Epi::ROWINFO)) ? S.list[(size_t)(U).e * CAP + (U).r0 + tid] : 0; \
        rowtab[(buf) * 256 + tid] = (S.a_compact == 2) ? (ent_ >> 2) * (K * 2) : tid * (K * 2); \
        if constexpr (Epi::ROWINFO) { rowtab[768 + (buf) * 512 + tid] = ok_ ? ent_ : -1; rowtab[768 + (buf) * 512 + 256 + tid] = ok_ ? __builtin_bit_cast(int, S.gwl[(size_t)(U).e * CAP + (U).r0 + tid]) : 0; } } \
        if constexpr (Epi::BIASTAB) { if (tid >= 256) rowtab[2304 + (buf) * 256 + (tid - 256)] = __builtin_bit_cast(int, E.bias_at((U), tid - 256)); } } while (0)
#define PG8_LOADVO(VO, buf) do { _Pragma("unroll") for (int h_ = 0; h_ < 2; ++h_) _Pragma("unroll") for (int i_ = 0; i_ < 2; ++i_) (VO)[h_][i_] = (unsigned)rowtab[(buf) * 256 + h_ * 128 + Rr[i_]] + Cc2[i_]; } while (0)
#define PG8_LDA(dst, b, h) do { _Pragma("unroll") for (int m = 0; m < 4; ++m) _Pragma("unroll") for (int k = 0; k < 2; ++k) dst[m][k] = *(const LAS bf16x8*)(lds + PG8_SA(b, h) + aoff + m * 2048 + k * 1024); } while (0)
#define PG8_LDB(dst, b, h) do { _Pragma("unroll") for (int n = 0; n < 2; ++n) _Pragma("unroll") for (int k = 0; k < 2; ++k) dst[n][k] = *(const LAS bf16x8*)(lds + PG8_SB(b, h) + boff + n * 2048 + k * 1024); } while (0)
#define PG8_MMA(ai, bj, At, Bt) do { __builtin_amdgcn_s_setprio(1); _Pragma("unroll") for (int m = 0; m < 4; ++m) _Pragma("unroll") for (int n = 0; n < 2; ++n) _Pragma("unroll") for (int k = 0; k < 2; ++k) \
        acc[ai][bj][m][n] = __builtin_amdgcn_mfma_f32_16x16x32_bf16(Bt[n][k], At[m][k], acc[ai][bj][m][n], 0, 0, 0); __builtin_amdgcn_s_setprio(0); } while (0)
#define PG8_WAIT_V(n) asm volatile("s_waitcnt vmcnt(" #n ")" ::: "memory")
#define PG8_WAIT_L(n) asm volatile("s_waitcnt lgkmcnt(" #n ")" ::: "memory")
#define PG8_BAR __builtin_amdgcn_s_barrier()
#define PG8_SCHED __builtin_amdgcn_sched_barrier(0)
#define VO_a1 vA
#define VO_cA vA
#define VO_a2 vS
#define VO_a3 vS
    Unit cur, nxt; int ui = 0;
    if (!S.next(0, cur)) return;
    f32x4 acc[2][2][4][2];
#pragma unroll
    for (int a = 0; a < 2; ++a)
#pragma unroll
        for (int b = 0; b < 2; ++b)
#pragma unroll
            for (int m = 0; m < 4; ++m)
#pragma unroll
                for (int n = 0; n < 2; ++n) acc[a][b][m][n] = (f32x4){0.f, 0.f, 0.f, 0.f};
    bf16x8 At[4][2], B0[2][2], B1[2][2];
    const char* cA = cur.A; const char* cB = cur.B;
    cur.buf = 0;
    if constexpr (GATHER) { PG8_FILL(0, cur); asm volatile("s_waitcnt lgkmcnt(0)" ::: "memory"); PG8_BAR; asm volatile("" ::: "memory"); PG8_LOADVO(vA, 0); }
    if constexpr (SP2) {
        PG8_STAGE(PG8_SB(0, 0), cB, voffB); PG8_STAGE(PG8_SB(0, 1), cB + hstep, voffB); PG8_STAGE_A(PG8_SA(0, 0), cA, 0, VO_cA); PG8_STAGE_A(PG8_SA(0, 1), cA, 1, VO_cA);
        if (wr == 1) PG8_BAR;
        PG8_WAIT_V(2); PG8_BAR;
        PG8_STAGE(PG8_SB(1, 0), cB + kstep, voffB); PG8_STAGE_A(PG8_SA(1, 0), cA + kstep, 0, VO_cA); PG8_STAGE(PG8_SB(1, 1), cB + hstep + kstep, voffB);
        PG8_WAIT_V(6); PG8_BAR;
    } else {
        PG8_STAGE(PG8_SB(0, 0), cB, voffB); PG8_STAGE_A(PG8_SA(0, 0), cA, 0, VO_cA); PG8_STAGE(PG8_SB(0, 1), cB + hstep, voffB); PG8_STAGE_A(PG8_SA(0, 1), cA, 1, VO_cA);
        if (wr == 1) PG8_BAR;
        PG8_WAIT_V(4); PG8_BAR;
        PG8_STAGE(PG8_SB(1, 0), cB + kstep, voffB); PG8_STAGE_A(PG8_SA(1, 0), cA + kstep, 0, VO_cA); PG8_STAGE(PG8_SB(1, 1), cB + hstep + kstep, voffB);
        PG8_WAIT_V(6); PG8_BAR;
    }
    for (;;) {
        const bool has_next = S.next(ui + 1, nxt);
        const char* nA = has_next ? nxt.A : cA; const char* nB = has_next ? nxt.B : cB;
        nxt.buf = (ui + 1) % 3;
        if constexpr (GATHER) { if (has_next) PG8_FILL((ui + 1) % 3, nxt); }
        for (int t = 0; t < nt; t += 2) {
            const bool last = (t == nt - 2);
            const char* a1 = cA + (size_t)(t + 1) * kstep;
            const char* a2 = last ? nA : cA + (size_t)(t + 2) * kstep; const char* b2 = last ? nB : cB + (size_t)(t + 2) * kstep;
            const char* a3 = a2 + kstep; const char* b3 = b2 + kstep;
            unsigned vS[2][2];
            if constexpr (GATHER) { if (last && has_next) PG8_LOADVO(vN, (ui + 1) % 3);
#pragma unroll
                for (int h_ = 0; h_ < 2; ++h_)
#pragma unroll
                    for (int i_ = 0; i_ < 2; ++i_) vS[h_][i_] = (last && has_next) ? vN[h_][i_] : vA[h_][i_]; }
            else { vS[0][0] = 0u; vS[0][1] = 0u; vS[1][0] = 0u; vS[1][1] = 0u; }
            if constexpr (SP2) {
            PG8_LDB(B0, 0, 0); PG8_LDB(B1, 0, 1); PG8_SCHED; PG8_LDA(At, 0, 0); PG8_STAGE_A(PG8_SA(1, 1), a1, 1, VO_a1);
            PG8_WAIT_V(8); PG8_WAIT_L(0); PG8_BAR; PG8_MMA(0, 0, At, B0); PG8_MMA(0, 1, At, B1); PG8_BAR; PG8_SCHED;
            PG8_LDA(At, 0, 1); PG8_STAGE(PG8_SB(0, 0), b2, voffB); PG8_STAGE(PG8_SB(0, 1), b2 + hstep, voffB); PG8_STAGE_A(PG8_SA(0, 0), a2, 0, VO_a2);
            PG8_WAIT_V(8); PG8_WAIT_L(0); PG8_BAR; PG8_MMA(1, 0, At, B0); PG8_MMA(1, 1, At, B1); PG8_BAR; PG8_SCHED;
            PG8_LDB(B0, 1, 0); PG8_LDB(B1, 1, 1); PG8_SCHED; PG8_LDA(At, 1, 0); PG8_STAGE_A(PG8_SA(0, 1), a2, 1, VO_a2);
            PG8_WAIT_V(8); PG8_WAIT_L(0); PG8_BAR; PG8_MMA(0, 0, At, B0); PG8_MMA(0, 1, At, B1); PG8_BAR; PG8_SCHED;
            PG8_LDA(At, 1, 1); PG8_STAGE(PG8_SB(1, 0), b3, voffB); PG8_STAGE(PG8_SB(1, 1), b3 + hstep, voffB); PG8_STAGE_A(PG8_SA(1, 0), a3, 0, VO_a3);
            PG8_WAIT_V(8); PG8_WAIT_L(0); PG8_BAR; PG8_MMA(1, 0, At, B0); PG8_MMA(1, 1, At, B1); PG8_BAR; PG8_SCHED;
            } else {
            PG8_LDB(B0, 0, 0); PG8_SCHED; PG8_LDA(At, 0, 0); PG8_STAGE_A(PG8_SA(1, 1), a1, 1, VO_a1);
            PG8_WAIT_L(8); PG8_BAR; PG8_WAIT_L(0); PG8_MMA(0, 0, At, B0); PG8_BAR; PG8_SCHED;
            PG8_LDB(B1, 0, 1); PG8_STAGE(PG8_SB(0, 0), b2, voffB);
            PG8_BAR; PG8_WAIT_L(0); PG8_MMA(0, 1, At, B1); PG8_BAR;
            PG8_LDA(At, 0, 1); PG8_STAGE_A(PG8_SA(0, 0), a2, 0, VO_a2);
            PG8_BAR; PG8_WAIT_L(0); PG8_MMA(1, 0, At, B0); PG8_BAR; PG8_SCHED;
            PG8_STAGE(PG8_SB(0, 1), b2 + hstep, voffB);
            PG8_WAIT_V(6); PG8_BAR; PG8_MMA(1, 1, At, B1); PG8_BAR;
            PG8_LDB(B0, 1, 0); PG8_SCHED; PG8_LDA(At, 1, 0); PG8_STAGE_A(PG8_SA(0, 1), a2, 1, VO_a2);
            PG8_WAIT_L(8); PG8_BAR; PG8_WAIT_L(0); PG8_MMA(0, 0, At, B0); PG8_BAR; PG8_SCHED;
            PG8_LDB(B1, 1, 1); PG8_STAGE(PG8_SB(1, 0), b3, voffB);
            PG8_BAR; PG8_WAIT_L(0); PG8_MMA(0, 1, At, B1); PG8_BAR;
            PG8_LDA(At, 1, 1); PG8_STAGE_A(PG8_SA(1, 0), a3, 0, VO_a3);
            PG8_BAR; PG8_WAIT_L(0); PG8_MMA(1, 0, At, B0); PG8_BAR; PG8_SCHED;
            PG8_STAGE(PG8_SB(1, 1), b3 + hstep, voffB);
            PG8_WAIT_V(6); PG8_BAR; PG8_MMA(1, 1, At, B1); PG8_BAR;
            }
        }
        if constexpr (ALIGN_EPI) { if (wr == 0) PG8_BAR; }
        E(acc, cur, wr, wc, fr, fq);
        if (!has_next) break;
#pragma unroll
        for (int a = 0; a < 2; ++a)
#pragma unroll
            for (int b = 0; b < 2; ++b)
#pragma unroll
                for (int m = 0; m < 4; ++m)
#pragma unroll
                    for (int n = 0; n < 2; ++n) acc[a][b][m][n] = (f32x4){0.f, 0.f, 0.f, 0.f};
        cur = nxt; cA = nA; cB = nB; ++ui;
        if constexpr (GATHER) { vA[0][0] = vN[0][0]; vA[0][1] = vN[0][1]; vA[1][0] = vN[1][0]; vA[1][1] = vN[1][1]; }
        if constexpr (ALIGN_EPI) { if (wr == 1) PG8_BAR; }
    }
    PG8_WAIT_V(0);
    if constexpr (!ALIGN_EPI) { if (wr == 0) PG8_BAR; }
    PG8_BAR;
#undef PG8_SA
#undef PG8_SB
#undef PG8_STAGE
#undef PG8_STAGE_A
#undef PG8_FILL
#undef PG8_LOADVO
#undef VO_a1
#undef VO_cA
#undef VO_a2
#undef VO_a3
#undef PG8_LDA
#undef PG8_LDB
#undef PG8_MMA
#undef PG8_WAIT_V
#undef PG8_WAIT_L
#undef PG8_BAR
#undef PG8_SCHED
}
}

#define XB_TMO      128
#define XB_XCNT(j)  (256  + 64 * (j))
#define XB_XSUB(j)  (1280 + 64 * (j))
#define XB_XGEN(j)  (2304 + 64 * (j))
#define XB_TOP      3328
#define XB_TOPGEN   3392
#define XCD_BAR_WORDS 3456
#define XB_SPIN_CAP (1u << 18)
__device__ __forceinline__ unsigned xb_ld(unsigned* p)              { return __hip_atomic_load(p, __ATOMIC_RELAXED, __HIP_MEMORY_SCOPE_AGENT); }
__device__ __forceinline__ unsigned xb_add(unsigned* p, unsigned v) { return __hip_atomic_fetch_add(p, v, __ATOMIC_RELAXED, __HIP_MEMORY_SCOPE_AGENT); }
__device__ __forceinline__ unsigned xb_xcc_id() { return (unsigned)__builtin_amdgcn_s_getreg((3 << 11) | 20) & 0xFu; }
#define XB_SPIN(cond, bar) do { unsigned _sp = 0; while (cond) { __builtin_amdgcn_s_sleep(1); \
    if ((++_sp & 255u) == 0u) { if (xb_ld(&(bar)[XB_TMO])) break; if (_sp > XB_SPIN_CAP) { atomicAdd(&(bar)[XB_TMO], 1u); break; } } } } while (0)
struct XcdBarrier { unsigned* bar; unsigned x; volatile LAS unsigned* st; };
__device__ __forceinline__ XcdBarrier xcd_barrier_post(unsigned* bar, volatile LAS unsigned* st, bool leader) {
    XcdBarrier b; b.bar = bar; b.x = xb_xcc_id(); b.st = st;
    if (leader) (void)xb_add(&bar[XB_XCNT(b.x)], 1u);
    return b;
}
__device__ __forceinline__ void xcd_barrier_complete(unsigned* bar, unsigned x, unsigned& nloc, unsigned& nx) {
    const unsigned G = gridDim.x * gridDim.y * gridDim.z;
    unsigned sum, cnt, mine, sp = 0u;
    for (;;) {
        sum = 0u; cnt = 0u; mine = 0u;
#pragma unroll
        for (unsigned j = 0; j < 16; ++j) { const unsigned c = xb_ld(&bar[XB_XCNT(j)]); sum += c; cnt += (c > 0u) ? 1u : 0u; mine = (j == x) ? c : mine; }
        if (sum == G) break;
        __builtin_amdgcn_s_sleep(1);
        if ((++sp & 255u) == 0u) { if (xb_ld(&bar[XB_TMO])) break; if (sp > XB_SPIN_CAP) { atomicAdd(&bar[XB_TMO], 1u); break; } }
    }
    nloc = mine > 0u ? mine : 1u; nx = cnt > 0u ? cnt : 1u;
}
__device__ __forceinline__ void xcd_barrier(const XcdBarrier& b, int wave) {
    asm volatile("s_waitcnt vmcnt(0)" ::: "memory");
    __syncthreads();
    if (wave == 0 && lane_id() == 0) {
        unsigned* bar = b.bar;
        __builtin_amdgcn_s_waitcnt(0);
        unsigned nloc = b.st[0], nx = b.st[1];
        if (nloc == 0u) { xcd_barrier_complete(bar, b.x, nloc, nx); b.st[0] = nloc; b.st[1] = nx; }
        const unsigned old = xb_add(&bar[XB_XSUB(b.x)], 1u);
        const unsigned gen = old / nloc;
        if (old + 1u == (gen + 1u) * nloc) {
            __builtin_amdgcn_fence(__ATOMIC_RELEASE, "agent");
            asm volatile("s_waitcnt vmcnt(0)" ::: "memory");
            const unsigned og = xb_add(&bar[XB_TOP], 1u);
            const unsigned tg = og / nx;
            if (og + 1u == (tg + 1u) * nx) xb_add(&bar[XB_TOPGEN], 1u);
            else XB_SPIN(xb_ld(&bar[XB_TOPGEN]) == tg, bar);
            __builtin_amdgcn_fence(__ATOMIC_ACQUIRE, "agent");
            xb_add(&bar[XB_XGEN(b.x)], 1u);
            asm volatile("s_waitcnt vmcnt(0)" ::: "memory");
        } else {
            XB_SPIN(xb_ld(&bar[XB_XGEN(b.x)]) == gen, bar);
            __builtin_amdgcn_fence(__ATOMIC_ACQUIRE, "agent");
            asm volatile("s_waitcnt vmcnt(0)" ::: "memory");
        }
    }
    __syncthreads();
}

struct Args { const float* in[33]; float* out; unsigned char* ws; int ph_lo, ph_hi; };
struct Frame {
    LAS unsigned char* lds;
    int wave, vcu, G, gw, NGW;
};

__device__ __forceinline__ void transpose_item(const float* W, int ldw, int col_off, int K, bf16* WT, int mode, int kb, int nb, LAS unsigned char* scr, int lane) {
    const int k0 = 64 * kb, n0 = 64 * nb;
    const float* src = W + (size_t)k0 * ldw + col_off + n0;
    f32x4 v[16];
#pragma unroll
    for (int i = 0; i < 16; ++i) v[i] = __builtin_nontemporal_load((const f32x4*)(src + (size_t)((lane >> 4) + 4 * i) * ldw + 4 * (lane & 15)));
#pragma unroll
    for (int i = 0; i < 16; ++i) { LAS unsigned* p = (LAS unsigned*)(scr + ((lane >> 4) + 4 * i) * 132 + 8 * (lane & 15)); p[0] = pk2(v[i][0], v[i][1]); p[1] = pk2(v[i][2], v[i][3]); }
    asm volatile("s_waitcnt lgkmcnt(0)" ::: "memory");
    const int c = lane >> 3, nl = lane & 7;
#pragma unroll
    for (int r = 0; r < 8; ++r) { const int n = nl + 8 * r; const LAS unsigned short* s = (const LAS unsigned short*)(scr + (8 * c) * 132 + 2 * n);
        u32x4 o; o.x = (unsigned)s[0] | ((unsigned)s[66] << 16); o.y = (unsigned)s[132] | ((unsigned)s[198] << 16); o.z = (unsigned)s[264] | ((unsigned)s[330] << 16); o.w = (unsigned)s[396] | ((unsigned)s[462] << 16);
        const int ng = n0 + n; int drow = ng; if (mode == 1) { drow = ng < 1024 ? 256 * (ng >> 7) + (ng & 127) : 256 * ((ng - 1024) >> 7) + 128 + (ng & 127); }
        if (mode == 2 && ng < 2048) { const int i_ = ng & 127; drow = (ng & ~127) + (i_ < 64 ? 2 * i_ : 2 * (i_ - 64) + 1); }
        __builtin_nontemporal_store(o, (u32x4*)(WT + (size_t)drow * K + k0 + 8 * c)); }
    asm volatile("s_waitcnt lgkmcnt(0)" ::: "memory");
}

__device__ __forceinline__ void load_cols16(int tid, const float* W, int ldw, int col_off, LAS float* Wt) {
    f32x4 wv[8];
#pragma unroll
    for (int i = 0; i < 8; ++i) { const int q = tid + i * NTHREADS, k = q >> 2, e0 = (q & 3) * 4; wv[i] = *(const f32x4*)(W + (size_t)k * ldw + col_off + e0); }
#pragma unroll
    for (int i = 0; i < 8; ++i) { const int q = tid + i * NTHREADS, k = q >> 2, e0 = (q & 3) * 4;
        Wt[(e0 + 0) * 1028 + k] = wv[i][0]; Wt[(e0 + 1) * 1028 + k] = wv[i][1]; Wt[(e0 + 2) * 1028 + k] = wv[i][2]; Wt[(e0 + 3) * 1028 + k] = wv[i][3]; }
}
__device__ __forceinline__ float row_dot16(const f32x4 (&v)[4], const LAS float* Wt, int lane) {
    float p[16];
#pragma unroll
    for (int e = 0; e < 16; ++e) { float s = 0.f;
#pragma unroll
        for (int j = 0; j < 4; ++j) { const f32x4 w = *(const LAS f32x4*)(Wt + e * 1028 + 4 * (lane + 64 * j)); s += v[j][0] * w[0] + v[j][1] * w[1] + v[j][2] * w[2] + v[j][3] * w[3]; }
        p[e] = s; }
    float a8[8], a4[4], a2[2], r1;
#pragma unroll
    for (int e = 0; e < 8; ++e) { const auto r = __builtin_amdgcn_permlane32_swap(__builtin_bit_cast(unsigned, p[e]), __builtin_bit_cast(unsigned, p[e + 8]), false, false); a8[e] = __builtin_bit_cast(float, (unsigned)r[0]) + __builtin_bit_cast(float, (unsigned)r[1]); }
#pragma unroll
    for (int e = 0; e < 4; ++e) { const auto r = __builtin_amdgcn_permlane16_swap(__builtin_bit_cast(unsigned, a8[e]), __builtin_bit_cast(unsigned, a8[e + 4]), false, false); a4[e] = __builtin_bit_cast(float, (unsigned)r[0]) + __builtin_bit_cast(float, (unsigned)r[1]); }
    { const bool hi = (lane & 8) != 0;
#pragma unroll
      for (int e = 0; e < 2; ++e) { const float mine = hi ? a4[e + 2] : a4[e], theirs = hi ? a4[e] : a4[e + 2]; a2[e] = mine + dpp_f<0x128>(theirs); } }
    { const bool hi = (lane & 4) != 0; const float mine = hi ? a2[1] : a2[0], theirs = hi ? a2[0] : a2[1]; r1 = mine + dpp_f<0x141>(theirs); }
    r1 += dpp_f<0x4E>(r1); r1 += dpp_f<0xB1>(r1);
    return r1;
}
__device__ __forceinline__ void store_row_bf16(bf16* orow, const f32x4 (&v)[4], int lane) {
    unsigned long long* o8 = (unsigned long long*)orow + lane;
#pragma unroll
    for (int j = 0; j < 4; ++j) o8[64 * j] = (unsigned long long)pk2(v[j][0], v[j][1]) | ((unsigned long long)pk2(v[j][2], v[j][3]) << 32);
}
__device__ __forceinline__ void store_row_f32(float* orow, const f32x4 (&v)[4], int lane) {
    f32x4* o = (f32x4*)orow + lane;
#pragma unroll
    for (int j = 0; j < 4; ++j) o[64 * j] = v[j];
}
__device__ __forceinline__ void load_row_f32(const float* row, f32x4 (&v)[4], int lane) {
    const f32x4* p = (const f32x4*)row + lane;
#pragma unroll
    for (int j = 0; j < 4; ++j) v[j] = p[64 * j];
}
__device__ __forceinline__ void ln_row(f32x4 (&v)[4], const f32x4 (&gv)[4], const f32x4 (&bv)[4]) {
    float s = 0.f;
#pragma unroll
    for (int j = 0; j < 4; ++j) s += (v[j][0] + v[j][1]) + (v[j][2] + v[j][3]);
    const float mean = wave_sum(s) * (1.f / D); float s2 = 0.f;
#pragma unroll
    for (int j = 0; j < 4; ++j) { v[j] = v[j] - mean; s2 += (v[j][0] * v[j][0] + v[j][1] * v[j][1]) + (v[j][2] * v[j][2] + v[j][3] * v[j][3]); }
    const float rstd = __builtin_amdgcn_rsqf(wave_sum(s2) * (1.f / D) + LN_EPS);
#pragma unroll
    for (int j = 0; j < 4; ++j) v[j] = v[j] * rstd * gv[j] + bv[j];
}

__device__ __forceinline__ const float* inp_ptr(LAS unsigned char* lds, int i) {
    const LAS unsigned* p = (const LAS unsigned*)(lds + MISC_OFF + 256) + 2 * i;
    const unsigned lo = __builtin_amdgcn_readfirstlane(p[0]), hi = __builtin_amdgcn_readfirstlane(p[1]);
    return (const float*)(const GAS float*)(((unsigned long long)hi << 32) | lo);
}

__device__ __forceinline__ void stamp_fn(LAS unsigned char* lds, int wave, int k) {
    if (blockIdx.x == 0 && wave == 0 && lane_id() == 0) { volatile LAS unsigned long long* st = (volatile LAS unsigned long long*)(lds + MISC_OFF + 1024);
        const unsigned long long now = __builtin_amdgcn_s_memrealtime(); if (k >= PROBE_T && k <= PROBE_T2) st[1] = st[1] + (now - st[0]); st[0] = now; }
}
typedef short s16x4 __attribute__((ext_vector_type(4)));
typedef short v4i16_t __attribute__((ext_vector_type(4)));
constexpr int CL = 128, NCH = T / CL;
template <int MODE> struct MX;
template <> struct MX<0> { static constexpr int NH = 8, DK = 64,  DV = 128, LDP = 3072, KOFF = 512,  VOFF = 1024, GOFF = 2048; };
template <> struct MX<1> { static constexpr int NH = 8, DK = 128, DV = 256, LDP = 6144, KOFF = 1024, VOFF = 2048, GOFF = 4096; };
template <> struct MX<2> { static constexpr int NH = 4, DK = 128, DV = 256, LDP = 3072, KOFF = 512,  VOFF = 1024, GOFF = 2048; };
__device__ __forceinline__ s16x4 ds_tr(const LAS unsigned char* p) { return __builtin_bit_cast(s16x4, __builtin_amdgcn_ds_read_tr16_b64_v4i16((LAS v4i16_t*)p)); }
__device__ __forceinline__ bf16x8 tr_frag(const LAS unsigned char* base, int pitch, int k0, int n0, int lane) {
    const int g = lane >> 4, q = (lane & 15) >> 2, p = lane & 3;
    const LAS unsigned char* a = base + (k0 + 4 * g + q) * pitch + (n0 + 4 * p) * 2;
    const s16x4 r1 = ds_tr(a), r2 = ds_tr(a + 16 * pitch);
    bf16x8 f; f[0] = r1[0]; f[1] = r1[1]; f[2] = r1[2]; f[3] = r1[3]; f[4] = r2[0]; f[5] = r2[1]; f[6] = r2[2]; f[7] = r2[3]; return f;
}
__device__ __forceinline__ u32x4 scale_bf16x8(u32x4 v, float sc) {
    u32x4 o; o.x = pk2(bflo(v.x) * sc, bfhi(v.x) * sc); o.y = pk2(bflo(v.y) * sc, bfhi(v.y) * sc); o.z = pk2(bflo(v.z) * sc, bfhi(v.z) * sc); o.w = pk2(bflo(v.w) * sc, bfhi(v.w) * sc); return o;
}
__device__ __forceinline__ float ret_lg2gamma(int h) { return log2f(1.f - exp2f(-5.f - (float)h)); }

template <int MODE>
__device__ __forceinline__ void mix_phaseA(const Frame& F, unsigned char* ws, const int tid, const int lane) {
    typedef MX<MODE> C; constexpr int DK = C::DK, DV = C::DV, NH = C::NH, LDP = C::LDP, KP = DK * 2 + 32, VP = DV * 2 + 32, ETW = DV / 128, NDT = DK / 16;
    LAS unsigned char* ldsK = F.lds; LAS unsigned char* ldsV = F.lds + 128 * KP; LAS float* rsc = (LAS float*)(F.lds + 128 * KP + 128 * VP);
    const bf16* PB = (const bf16*)(ws + WS_PB); const bf16* KPP = (const bf16*)(ws + WS_KPP); bf16* UT = (bf16*)(ws + WS_UT);
    const float* GSC = (const float*)(ws + WS_SC); float* NLOC = (float*)(ws + WS_SC + 2 * MiB);
    const int w = F.wave, g = lane >> 4;
    for (int u = blockIdx.x; u < 2 * NH * NCH; u += F.G) {
        const int c = u % NCH, bh = u / NCH, h = bh % NH, b = bh / NH; const size_t row0 = (size_t)b * T + (size_t)c * CL;
        u32x4 kr[DK / 32], vr[DV / 32];
#pragma unroll
        for (int i = 0; i < DK / 32; ++i) { const int p = tid + i * NTHREADS, r = p / (DK / 8), cp = p % (DK / 8);
            kr[i] = (MODE == 2) ? *(const u32x4*)(KPP + (row0 + r) * 512 + h * 128 + cp * 8) : *(const u32x4*)(PB + (row0 + r) * LDP + C::KOFF + h * DK + cp * 8); }
#pragma unroll
        for (int i = 0; i < DV / 32; ++i) { const int p = tid + i * NTHREADS, r = p / (DV / 8), cp = p % (DV / 8);
            vr[i] = *(const u32x4*)(PB + (row0 + r) * LDP + C::VOFF + h * DV + cp * 8); }
        float gmax = 0.f; if (MODE == 0) gmax = GSC[(size_t)(2 * 16 + bh) * T + c * CL + 127];
        const float lgh = (MODE == 1) ? ret_lg2gamma(h) : 0.f;
        __syncthreads();
#pragma unroll
        for (int i = 0; i < DK / 32; ++i) { const int p = tid + i * NTHREADS, r = p / (DK / 8), cp = p % (DK / 8);
            u32x4 v = kr[i];
            if (MODE == 0) v = scale_bf16x8(v, __expf(GSC[(size_t)(1 * 16 + bh) * T + c * CL + r] - gmax));
            if (MODE == 1) v = scale_bf16x8(v, exp2f((float)(127 - r) * lgh));
            *(LAS u32x4*)(ldsK + r * KP + cp * 16) = v; }
#pragma unroll
        for (int i = 0; i < DV / 32; ++i) { const int p = tid + i * NTHREADS, r = p / (DV / 8), cp = p % (DV / 8); *(LAS u32x4*)(ldsV + r * VP + cp * 16) = vr[i]; }
        __syncthreads();
        f32x4 acc[ETW][NDT];
#pragma unroll
        for (int i = 0; i < ETW; ++i)
#pragma unroll
            for (int j = 0; j < NDT; ++j) acc[i][j] = (f32x4){0.f, 0.f, 0.f, 0.f};
#pragma unroll
        for (int ks = 0; ks < 4; ++ks) {
            bf16x8 af[ETW], bfv[NDT];
#pragma unroll
            for (int i = 0; i < ETW; ++i) af[i] = tr_frag(ldsV, VP, 32 * ks, (w * ETW + i) * 16, lane);
#pragma unroll
            for (int j = 0; j < NDT; ++j) bfv[j] = tr_frag(ldsK, KP, 32 * ks, j * 16, lane);
#pragma unroll
            for (int i = 0; i < ETW; ++i)
#pragma unroll
                for (int j = 0; j < NDT; ++j) acc[i][j] = __builtin_amdgcn_mfma_f32_16x16x32_bf16(bfv[j], af[i], acc[i][j], 0, 0, 0);
        }
        bf16* ut = UT + (size_t)u * DV * DK;
#pragma unroll
        for (int i = 0; i < ETW; ++i)
#pragma unroll
            for (int j = 0; j < NDT; ++j)
                { uint2 o; o.x = pk2(acc[i][j][0], acc[i][j][1]); o.y = pk2(acc[i][j][2], acc[i][j][3]); *(uint2*)(ut + (size_t)((w * ETW + i) * 16 + (lane & 15)) * DK + j * 16 + 4 * g) = o; }
        if (MODE == 0) {
            float sacc = 0.f;
#pragma unroll
            for (int r = 0; r < 16; ++r) sacc += bf2f(*(const LAS unsigned short*)(ldsK + (16 * w + r) * KP + lane * 2));
            rsc[w * 64 + lane] = sacc;
            __syncthreads();
            if (tid < 64) { float t = 0.f;
#pragma unroll
                for (int q = 0; q < NWAVES; ++q) t += rsc[q * 64 + tid];
                NLOC[(size_t)u * 64 + tid] = t; } }
    }
    __syncthreads();
}

template <int MODE>
__device__ __forceinline__ void mix_phaseB(const Frame& F, unsigned char* ws, const int tid) {
    typedef MX<MODE> C; constexpr int DK = C::DK, DV = C::DV, NH = C::NH, NEL = DV * DK, NBH = 2 * NH;
    const bf16* UT = (const bf16*)(ws + WS_UT); bf16* ST = (bf16*)(ws + WS_ST);
    const float* GSC = (const float*)(ws + WS_SC); const float* NLOC = (const float*)(ws + WS_SC + 2 * MiB); float* NPREV = (float*)(ws + WS_SC + 2 * MiB + 256 * 1024);
    float* MPREV = (float*)(ws + WS_SC + 2 * MiB + 512 * 1024); const float* DEC = (const float*)(ws + WS_SC + 3 * MiB);
    const int gtid = blockIdx.x * NTHREADS + tid, nthr = F.G * NTHREADS;
    for (int el8 = gtid; el8 < NBH * NEL / 8; el8 += nthr) {
        const int el = el8 * 8, bh = el / NEL, idx = el - bh * NEL, h = bh % NH, b = bh / NH;
        float S[8]; float m = -1e30f;
#pragma unroll
        for (int q = 0; q < 8; ++q) S[q] = 0.f;
        const float rdec = (MODE == 1) ? exp2f(128.f * ret_lg2gamma(h)) : 1.f;
#pragma unroll 1
        for (int c0 = 0; c0 < NCH; c0 += 8) {
            u32x4 uv[8];
#pragma unroll
            for (int i = 0; i < 8; ++i) uv[i] = *(const u32x4*)(UT + (size_t)(bh * NCH + c0 + i) * NEL + idx);
#pragma unroll
            for (int i = 0; i < 8; ++i) { const int c = c0 + i; const size_t u = (size_t)bh * NCH + c;
                u32x4 o; o.x = pk2(S[0], S[1]); o.y = pk2(S[2], S[3]); o.z = pk2(S[4], S[5]); o.w = pk2(S[6], S[7]);
                *(u32x4*)(ST + u * NEL + idx) = o;
                const float u0 = bflo(uv[i].x), u1 = bfhi(uv[i].x), u2 = bflo(uv[i].y), u3 = bfhi(uv[i].y), u4 = bflo(uv[i].z), u5 = bfhi(uv[i].z), u6 = bflo(uv[i].w), u7 = bfhi(uv[i].w);
                if (MODE == 0) { const float atot = GSC[(size_t)(0 * 16 + bh) * T + c * CL + 127], mloc = atot + GSC[(size_t)(2 * 16 + bh) * T + c * CL + 127];
                    const float mnew = fmaxf(atot + m, mloc), so = __expf(atot + m - mnew), sl = __expf(mloc - mnew);
                    if (idx == 0) MPREV[u] = m;
                    S[0] = so * S[0] + sl * u0; S[1] = so * S[1] + sl * u1; S[2] = so * S[2] + sl * u2; S[3] = so * S[3] + sl * u3;
                    S[4] = so * S[4] + sl * u4; S[5] = so * S[5] + sl * u5; S[6] = so * S[6] + sl * u6; S[7] = so * S[7] + sl * u7; m = mnew; }
                else if (MODE == 1) { S[0] = rdec * S[0] + u0; S[1] = rdec * S[1] + u1; S[2] = rdec * S[2] + u2; S[3] = rdec * S[3] + u3; S[4] = rdec * S[4] + u4; S[5] = rdec * S[5] + u5; S[6] = rdec * S[6] + u6; S[7] = rdec * S[7] + u7; }
                else { const float* dp = DEC + (size_t)(b * NCH + c) * 512 + h * 128 + (idx & 127); const f32x4 d0 = *(const f32x4*)dp, d1 = *(const f32x4*)(dp + 4);
                    S[0] = d0[0] * S[0] + u0; S[1] = d0[1] * S[1] + u1; S[2] = d0[2] * S[2] + u2; S[3] = d0[3] * S[3] + u3; S[4] = d1[0] * S[4] + u4; S[5] = d1[1] * S[5] + u5; S[6] = d1[2] * S[6] + u6; S[7] = d1[3] * S[7] + u7; } }
        }
    }
    if (MODE == 0) {
        for (int el = gtid; el < NBH * 64; el += nthr) { const int bh = el >> 6, d = el & 63; float S = 0.f, m = -1e30f;
#pragma unroll 1
            for (int c0 = 0; c0 < NCH; c0 += 8) { float at[8], gm[8], nl[8];
#pragma unroll
                for (int i = 0; i < 8; ++i) { const int c = c0 + i; at[i] = GSC[(size_t)(0 * 16 + bh) * T + c * CL + 127]; gm[i] = GSC[(size_t)(2 * 16 + bh) * T + c * CL + 127]; nl[i] = NLOC[((size_t)bh * NCH + c) * 64 + d]; }
#pragma unroll
                for (int i = 0; i < 8; ++i) { const size_t u = (size_t)bh * NCH + c0 + i; const float atot = at[i], mloc = atot + gm[i];
                    const float mnew = fmaxf(atot + m, mloc), so = __expf(atot + m - mnew), sl = __expf(mloc - mnew);
                    NPREV[u * 64 + d] = S; S = so * S + sl * nl[i]; m = mnew; } } }
    }
}

template <int MODE>
__device__ __forceinline__ void mix_phaseC(const Frame& F, unsigned char* ws, const int tid, const int lane, const float* ng) {
    typedef MX<MODE> C; constexpr int DK = C::DK, DV = C::DV, NH = C::NH, LDP = C::LDP, VP = DV * 2 + 32, KP = DK * 2 + 16, SP = DK * 2 + 16, NET = DV / 16, NKS = DK / 32, DVT = NH * DV;
    constexpr int NSP = DV * DK / 8 / NTHREADS;
    LAS unsigned char* ldsV = F.lds; LAS unsigned char* ldsK = F.lds + 128 * VP; LAS unsigned char* ldsS = F.lds;
    LAS float* tabs = (LAS float*)(F.lds + 128 * VP + 128 * KP);
    static_assert(DV * SP <= 128 * VP + 128 * KP, "S^T image fits the stage-1 region");
    const bf16* PB = (const bf16*)(ws + WS_PB); const bf16* ST = (const bf16*)(ws + WS_ST);
    const float* GSC = (const float*)(ws + WS_SC); const float* NPREV = (const float*)(ws + WS_SC + 2 * MiB + 256 * 1024); const float* MPREV = (const float*)(ws + WS_SC + 2 * MiB + 512 * 1024);
    const int w = F.wave, g = lane >> 4, li = lane & 15;
    constexpr int NU = 2 * NH * NCH;
    u32x4 kr[DK / 32], vr[DV / 32], sreg[NSP];
#define PC_LOAD_KV(U_) do { const int c_ = (U_) % NCH, bh_ = (U_) / NCH, h_ = bh_ % NH, b_ = bh_ / NH; const char* pb_ = (const char*)(PB + ((size_t)b_ * T + (size_t)c_ * CL) * LDP); \
        const char* vb_ = pb_ + (C::VOFF + h_ * DV) * 2; const char* kb_ = pb_ + (C::KOFF + h_ * DK) * 2; int t_ = tid; asm volatile("" : "+v"(t_));     \
        _Pragma("unroll") for (int i = 0; i < DV / 32; ++i) { const int p = t_ + i * NTHREADS, r = p / (DV / 8), cp = p % (DV / 8); vr[i] = *(const u32x4*)(vb_ + (unsigned)(r * LDP + cp * 8) * 2u); } \
        _Pragma("unroll") for (int i = 0; i < DK / 32; ++i) { const int p = t_ + i * NTHREADS, r = p / (DK / 8), cp = p % (DK / 8); kr[i] = *(const u32x4*)(kb_ + (unsigned)(r * LDP + cp * 8) * 2u); } } while (0)
#define PC_LOAD_S(U_) do { const bf16* st_ = ST + (size_t)(U_) * DV * DK; _Pragma("unroll") for (int i = 0; i < NSP; ++i) sreg[i] = *(const u32x4*)(st_ + (size_t)(tid + i * NTHREADS) * 8); } while (0)
    if ((int)blockIdx.x < NU) { PC_LOAD_KV((int)blockIdx.x); }
    for (int u = blockIdx.x; u < NU; u += F.G) {
        const int c = u % NCH, bh = u / NCH, h = bh % NH, b = bh / NH; const size_t row0 = (size_t)b * T + (size_t)c * CL;
        const float lg = (MODE == 1) ? ret_lg2gamma(h) : 0.f;
        PC_LOAD_S(u);
        __syncthreads();
#pragma unroll
        for (int i = 0; i < DV / 32; ++i) { const int p = tid + i * NTHREADS, r = p / (DV / 8), cp = p % (DV / 8); *(LAS u32x4*)(ldsV + r * VP + cp * 16) = vr[i]; }
#pragma unroll
        for (int i = 0; i < DK / 32; ++i) { const int p = tid + i * NTHREADS, r = p / (DK / 8), cp = p % (DK / 8); *(LAS u32x4*)(ldsK + r * KP + cp * 16) = kr[i]; }
        if (u + F.G < NU) PC_LOAD_KV(u + F.G);
        if (MODE == 0 && tid < 128) { const float mp = MPREV[u]; const size_t gi = (size_t)bh * T + c * CL + tid;
            const float a = GSC[(size_t)(0 * 16) * T + gi], gg = GSC[(size_t)(1 * 16) * T + gi], cm = GSC[(size_t)(2 * 16) * T + gi];
            const float Mt = fmaxf(mp, cm);
            tabs[tid] = gg; tabs[128 + tid] = Mt; tabs[256 + tid] = __expf(mp - Mt) * 0.125f; tabs[384 + tid] = __expf(-(a + Mt)); }
        __syncthreads();
        const int tq = 16 * w + li;
        const bf16* qrow = PB + (row0 + tq) * LDP + h * DK;
        bf16x8 qf[NKS];
#pragma unroll
        for (int ks = 0; ks < NKS; ++ks) qf[ks] = *(const bf16x8*)(qrow + 32 * ks + 8 * g);
        f32x4 O[NET];
#pragma unroll
        for (int et = 0; et < NET; ++et) O[et] = (f32x4){0.f, 0.f, 0.f, 0.f};
        float den = 0.f;
        const float Mq = (MODE == 0) ? tabs[128 + tq] : 0.f;
        const float qs = (MODE == 0) ? tabs[256 + tq] : (MODE == 1) ? exp2f((float)(tq + 1) * lg) : 1.f;
        const float fin = (MODE == 0) ? tabs[384 + tq] : 1.f;
        for (int jp = 0; jp <= (w >> 1); ++jp) {
            f32x4 p0 = (f32x4){0.f, 0.f, 0.f, 0.f}, p1 = (f32x4){0.f, 0.f, 0.f, 0.f};
            const LAS unsigned char* k0p = ldsK + (32 * jp + li) * KP + 16 * g;
#pragma unroll
            for (int ks = 0; ks < NKS; ++ks) p0 = __builtin_amdgcn_mfma_f32_16x16x32_bf16(*(const LAS bf16x8*)(k0p + 64 * ks), qf[ks], p0, 0, 0, 0);
            if (2 * jp + 1 <= w) {
#pragma unroll
                for (int ks = 0; ks < NKS; ++ks) p1 = __builtin_amdgcn_mfma_f32_16x16x32_bf16(*(const LAS bf16x8*)(k0p + 16 * KP + 64 * ks), qf[ks], p1, 0, 0, 0);
            }
#pragma unroll
            for (int r = 0; r < 4; ++r) {
                const int s0 = 32 * jp + 4 * g + r, s1 = s0 + 16;
                float f0, f1;
                if (MODE == 0) { f0 = __expf(tabs[s0] - Mq) * 0.125f; f1 = __expf(tabs[s1] - Mq) * 0.125f; }
                else if (MODE == 1) { f0 = exp2f((float)(tq - s0) * lg); f1 = exp2f((float)(tq - s1) * lg); }
                else { f0 = 1.f; f1 = 1.f; }
                p0[r] = (s0 <= tq) ? p0[r] * f0 : 0.f; p1[r] = (s1 <= tq) ? p1[r] * f1 : 0.f;
                den += p0[r] + p1[r];
            }
            bf16x8 af; { const unsigned a0 = pk2(p0[0], p0[1]), a1 = pk2(p0[2], p0[3]), a2 = pk2(p1[0], p1[1]), a3 = pk2(p1[2], p1[3]); u32x4 t4; t4.x = a0; t4.y = a1; t4.z = a2; t4.w = a3; af = __builtin_bit_cast(bf16x8, t4); }
#pragma unroll
            for (int et = 0; et < NET; ++et) O[et] = __builtin_amdgcn_mfma_f32_16x16x32_bf16(af, tr_frag(ldsV, VP, 32 * jp, 16 * et, lane), O[et], 0, 0, 0);
        }
        __syncthreads();
#pragma unroll
        for (int i = 0; i < NSP; ++i) { const int p = tid + i * NTHREADS, e = p / (DK / 8), cp = p % (DK / 8); *(LAS u32x4*)(ldsS + e * SP + cp * 16) = sreg[i]; }
        __syncthreads();
        float dint = 0.f;
#pragma unroll
        for (int ks = 0; ks < NKS; ++ks) {
            bf16x8 aq = qf[ks];
            if (MODE != 2) aq = __builtin_bit_cast(bf16x8, scale_bf16x8(__builtin_bit_cast(u32x4, qf[ks]), qs));
            if (MODE == 0) { const float* np = NPREV + (size_t)u * 64 + 32 * ks + 8 * g; const u32x4 qa = __builtin_bit_cast(u32x4, aq);
                dint += bflo(qa.x) * np[0] + bfhi(qa.x) * np[1] + bflo(qa.y) * np[2] + bfhi(qa.y) * np[3] + bflo(qa.z) * np[4] + bfhi(qa.z) * np[5] + bflo(qa.w) * np[6] + bfhi(qa.w) * np[7]; }
#pragma unroll
            for (int et = 0; et < NET; ++et) O[et] = __builtin_amdgcn_mfma_f32_16x16x32_bf16(aq, *(const LAS bf16x8*)(ldsS + (16 * et + li) * SP + 64 * ks + 16 * g), O[et], 0, 0, 0);
        }
        float rd[4] = {1.f, 1.f, 1.f, 1.f};
        if (MODE == 0) {
            float dt = den + dint; dt += __shfl_xor(dt, 16); dt += __shfl_xor(dt, 32);
            LAS float* wsc = tabs + 512 + 16 * w;
            if (g == 0) wsc[li] = __builtin_amdgcn_rcpf(fmaxf(fabsf(dt), fin));
            asm volatile("s_waitcnt lgkmcnt(0)" ::: "memory");
#pragma unroll
            for (int r = 0; r < 4; ++r) rd[r] = wsc[4 * g + r];
        }
        float mean[4], rstd[4];
#pragma unroll
        for (int r = 0; r < 4; ++r) { float sacc = 0.f;
#pragma unroll
            for (int et = 0; et < NET; ++et) { O[et][r] *= rd[r]; sacc += O[et][r]; }
            sacc = row16_sum(sacc);
            mean[r] = sacc * (1.f / DV); float q = 0.f;
#pragma unroll
            for (int et = 0; et < NET; ++et) { const float dlt = O[et][r] - mean[r]; q += dlt * dlt; }
            q = row16_sum(q);
            rstd[r] = __builtin_amdgcn_rsqf(q * (1.f / DV) + LN_EPS); }
        bf16* YBp = (bf16*)(ws + WS_YB);
        constexpr int RPF = DV * 2 + 16, TB = (MODE == 0) ? (128 * VP + 128 * KP + 2560) : DV * SP;
        static_assert(TB + NWAVES * 16 * RPF <= PH_BYTES && TB % 16 == 0, "epilogue tiles fit");
        LAS unsigned char* tw = F.lds + TB + w * (16 * RPF);
        const float* ngp = ng + h * DV + li;
        const int rr = lane >> 3, pq = lane & 7;
        const bf16* gpr = PB + (row0 + 16 * w + rr) * LDP + C::GOFF + h * DV + pq * 8; bf16* ypr = YBp + (row0 + 16 * w + rr) * DVT + h * DV + pq * 8;
        asm volatile("" : "+v"(gpr), "+v"(ypr));
#define GATEF(x_) ((MODE == 0) ? sigmoidf_(x_) : (x_) * sigmoidf_(x_))
#pragma unroll
        for (int hf = 0; hf < 2; ++hf) {
#pragma unroll
            for (int e2 = 0; e2 < NET / 2; ++e2) { const int et = hf * (NET / 2) + e2; const float gn = ngp[16 * et];
#pragma unroll
                for (int r = 0; r < 4; ++r) *(LAS float*)(tw + (4 * g + r) * RPF + (16 * e2 + li) * 4) = (O[et][r] - mean[r]) * rstd[r] * gn; }
            asm volatile("s_waitcnt lgkmcnt(0)" ::: "memory");
#pragma unroll
            for (int it = 0; it < DV / 64; ++it) { const int rb = 8 * (it & 1), cb = 64 * (it >> 1);
                const u32x4 gv = *(const u32x4*)(gpr + (size_t)rb * LDP + hf * (DV / 2) + cb);
                const LAS float* tp = (const LAS float*)(tw + (rb + rr) * RPF + (cb + pq * 8) * 4);
                const f32x4 n0 = *(const LAS f32x4*)tp, n1 = *(const LAS f32x4*)(tp + 4);
                const float g0 = bflo(gv.x), g1 = bfhi(gv.x), g2 = bflo(gv.y), g3 = bfhi(gv.y), g4 = bflo(gv.z), g5 = bfhi(gv.z), g6 = bflo(gv.w), g7 = bfhi(gv.w);
                u32x4 o; o.x = pk2(GATEF(g0) * n0[0], GATEF(g1) * n0[1]); o.y = pk2(GATEF(g2) * n0[2], GATEF(g3) * n0[3]);
                o.z = pk2(GATEF(g4) * n1[0], GATEF(g5) * n1[1]); o.w = pk2(GATEF(g6) * n1[2], GATEF(g7) * n1[3]);
                *(u32x4*)(ypr + (size_t)rb * DVT + hf * (DV / 2) + cb) = o; }
            asm volatile("s_waitcnt lgkmcnt(0)" ::: "memory");
        }
#undef GATEF
    }
    __syncthreads();
#undef PC_LOAD_KV
#undef PC_LOAD_S
}

constexpr int SLN = 32, NCI = T / SLN, NI = 2 * NCI, NRT = NI / 16, SKK = SLN * 16;
__device__ __forceinline__ void s5_pow(const f32x4 cf, float n, float& pr, float& pi) { const float e = __expf(n * cf[0]); const float a = n * cf[1]; pr = e * __cosf(a); pi = e * __sinf(a); }

__device__ __forceinline__ void s5_tables(const Frame& F, unsigned char* ws, const int tid, const float* lam_re, const float* lam_im, const float* b_re, const float* b_im, const float* c_re, const float* c_im, const float* log_dt) {
    bf16* KT = (bf16*)(ws + WS_S5KT); bf16* VT = (bf16*)(ws + WS_S5VT); bf16* WT = (bf16*)(ws + WS_S5WT); float* L64 = (float*)(ws + WS_S5L64);
    LAS f32x4* CF = (LAS f32x4*)F.lds;
    for (int i = tid; i < 64 * 64; i += NTHREADS) { const int g = i >> 6; const float lr = lam_re[i], li = lam_im[i], dt = expf(log_dt[g]);
        const float er = expf(lr * dt); float sn, cs; sincosf(li * dt, &sn, &cs);
        const float nr = er * cs - 1.f, ni = er * sn, den = lr * lr + li * li;
        CF[i] = (f32x4){lr * dt, li * dt, (nr * lr + ni * li) / den, (ni * lr - nr * li) / den}; }
    __syncthreads();
    const int gt = blockIdx.x * NTHREADS + tid, nthr = F.G * NTHREADS;
    LAS float* BR = (LAS float*)(F.lds + 65536); LAS float* BI = BR + 1024; LAS float* CR = BI + 1024; LAS float* CI = CR + 1024;
    for (int i0 = blockIdx.x * NTHREADS; i0 < 64 * SLN * 16 * 4; i0 += nthr) {
        const int g = i0 / (64 * SLN);
        __syncthreads();
        for (int q = tid; q < 1024; q += NTHREADS) { BR[q] = b_re[(size_t)g * 1024 + q]; BI[q] = b_im[(size_t)g * 1024 + q]; CR[q] = c_re[(size_t)g * 1024 + q]; CI[q] = c_im[(size_t)g * 1024 + q]; }
        __syncthreads();
        const int i4 = i0 + tid, pq = i4 & 3, idx = i4 >> 2, h = idx & 15, tau = (idx >> 4) % SLN;
        float acc[16];
#pragma unroll
        for (int q = 0; q < 16; ++q) acc[q] = 0.f;
#pragma unroll 4
        for (int p = pq * 16; p < pq * 16 + 16; ++p) { const f32x4 cf = CF[g * 64 + p]; float pr, pi; s5_pow(cf, (float)tau, pr, pi);
            const float cr = CR[h * 64 + p], ci = CI[h * 64 + p];
            const float xr = cr * pr - ci * pi, xi = cr * pi + ci * pr;
            const float yr = xr * cf[2] - xi * cf[3], yi = xr * cf[3] + xi * cf[2];
            const LAS f32x4* br4 = (const LAS f32x4*)(BR + p * 16); const LAS f32x4* bi4 = (const LAS f32x4*)(BI + p * 16);
#pragma unroll
            for (int q = 0; q < 4; ++q) { const f32x4 b_r = br4[q], b_i = bi4[q];
#pragma unroll
                for (int z = 0; z < 4; ++z) acc[4 * q + z] += yr * b_r[z] - yi * b_i[z]; } }
#pragma unroll
        for (int q = 0; q < 16; ++q) { acc[q] += dpp_f<0xB1>(acc[q]); acc[q] += dpp_f<0x4E>(acc[q]); }
        if (pq == 0) { u32x4 o0, o1; o0.x = pk2(acc[0], acc[1]); o0.y = pk2(acc[2], acc[3]); o0.z = pk2(acc[4], acc[5]); o0.w = pk2(acc[6], acc[7]);
            o1.x = pk2(acc[8], acc[9]); o1.y = pk2(acc[10], acc[11]); o1.z = pk2(acc[12], acc[13]); o1.w = pk2(acc[14], acc[15]);
            *(u32x4*)(KT + (size_t)idx * 16) = o0; *(u32x4*)(KT + (size_t)idx * 16 + 8) = o1; } }
    for (int idx = gt; idx < 64 * 64 * SLN; idx += nthr) {
        const int j = idx % SLN, p = (idx / SLN) & 63, g = idx / (SLN * 64);
        const f32x4 cf = CF[g * 64 + p]; float pr, pi;
        s5_pow(cf, (float)(SLN - 1 - j), pr, pi);
        const float yr = pr * cf[2] - pi * cf[3], yi = pr * cf[3] + pi * cf[2];
        const float* br = b_re + (size_t)(g * 64 + p) * 16; const float* bi = b_im + (size_t)(g * 64 + p) * 16;
        float vr[16], vi[16];
#pragma unroll
        for (int q = 0; q < 16; ++q) { vr[q] = yr * br[q] - yi * bi[q]; vi[q] = yr * bi[q] + yi * br[q]; }
        bf16* v0 = VT + ((size_t)(g * 128 + 2 * p) * SKK + j * 16);
        u32x4 o; o.x = pk2(vr[0], vr[1]); o.y = pk2(vr[2], vr[3]); o.z = pk2(vr[4], vr[5]); o.w = pk2(vr[6], vr[7]); *(u32x4*)v0 = o;
        o.x = pk2(vr[8], vr[9]); o.y = pk2(vr[10], vr[11]); o.z = pk2(vr[12], vr[13]); o.w = pk2(vr[14], vr[15]); *(u32x4*)(v0 + 8) = o;
        o.x = pk2(vi[0], vi[1]); o.y = pk2(vi[2], vi[3]); o.z = pk2(vi[4], vi[5]); o.w = pk2(vi[6], vi[7]); *(u32x4*)(v0 + SKK) = o;
        o.x = pk2(vi[8], vi[9]); o.y = pk2(vi[10], vi[11]); o.z = pk2(vi[12], vi[13]); o.w = pk2(vi[14], vi[15]); *(u32x4*)(v0 + SKK + 8) = o;
        if (j == 0) { s5_pow(cf, (float)SLN, pr, pi); L64[(g * 64 + p) * 2] = pr; L64[(g * 64 + p) * 2 + 1] = pi; }
    }
    for (int idx = gt; idx < 64 * 64 * SLN; idx += nthr) {
        const int p = idx & 63, l = (idx >> 6) % SLN, g = idx / (SLN * 64);
        const f32x4 cf = CF[g * 64 + p]; float pr, pi; s5_pow(cf, (float)(l + 1), pr, pi);
#pragma unroll
        for (int h = 0; h < 16; ++h) { const float cr = c_re[(g * 16 + h) * 64 + p], ci = c_im[(g * 16 + h) * 64 + p];
            *(unsigned*)(WT + ((size_t)((g * SLN + l) * 16 + h) * 128 + 2 * p)) = pk2(cr * pr - ci * pi, -(cr * pi + ci * pr)); }
    }
    __syncthreads();
}
__device__ __forceinline__ void s5_phaseA(const Frame& F, unsigned char* ws, const int lane) {
    const bf16* PB = (const bf16*)(ws + WS_PB); const bf16* VT = (const bf16*)(ws + WS_S5VT); float* SL = (float*)(ws + WS_S5SL);
    const int gq = lane >> 4, li = lane & 15;
    for (int wu = F.gw; wu < 64 * NRT * 2; wu += F.NGW) {
        const int half = wu & 1, rt = (wu >> 1) % NRT, g = wu / (2 * NRT), b = rt / (NRT / 2), c0 = (rt % (NRT / 2)) * 16;
        f32x4 acc[4];
#pragma unroll
        for (int ct = 0; ct < 4; ++ct) acc[ct] = (f32x4){0.f, 0.f, 0.f, 0.f};
        const bf16* ap = PB + ((size_t)b * T + (size_t)(c0 + li) * SLN + (gq >> 1)) * 1024 + g * 16 + 8 * (gq & 1);
        const bf16* bp = VT + (size_t)(g * 128 + half * 64 + li) * SKK + 8 * gq;
#pragma unroll 4
        for (int ks = 0; ks < SLN / 2; ++ks) {
            const bf16x8 af = *(const bf16x8*)(ap + (size_t)(2 * ks) * 1024);
#pragma unroll
            for (int ct = 0; ct < 4; ++ct) acc[ct] = __builtin_amdgcn_mfma_f32_16x16x32_bf16(af, *(const bf16x8*)(bp + (size_t)(16 * ct) * SKK + 32 * ks), acc[ct], 0, 0, 0);
        }
#pragma unroll
        for (int ct = 0; ct < 4; ++ct)
#pragma unroll
            for (int r = 0; r < 4; ++r) SL[(size_t)(g * NI + rt * 16 + 4 * gq + r) * 128 + half * 64 + ct * 16 + li] = acc[ct][r];
    }
}
__device__ __forceinline__ void s5_phaseB(const Frame& F, unsigned char* ws, const int tid) {
    static_assert(NCI == 256, "16 groups of 16 chunks");
    const float* SL = (const float*)(ws + WS_S5SL); bf16* SP = (bf16*)(ws + WS_S5SP); const float* L64 = (const float*)(ws + WS_S5L64);
    for (int gt = blockIdx.x * NTHREADS + tid; gt < 2 * 64 * 64 * 16; gt += F.G * NTHREADS) {
        const int grp = gt & 15, p = (gt >> 4) & 63, g = (gt >> 10) & 63, b = gt >> 16;
        const float ar = L64[(g * 64 + p) * 2], ai = L64[(g * 64 + p) * 2 + 1];
        const size_t base = (size_t)(g * NI + b * NCI + grp * 16) * 128 + 2 * p;
        f32x2 x[16];
#pragma unroll
        for (int i = 0; i < 16; ++i) x[i] = *(const f32x2*)(SL + base + (size_t)i * 128);
        float lr[16], li[16], sr = 0.f, si = 0.f;
#pragma unroll
        for (int i = 0; i < 16; ++i) { lr[i] = sr; li[i] = si; const float nr = ar * sr - ai * si + x[i][0], ni = ar * si + ai * sr + x[i][1]; sr = nr; si = ni; }
        float mr = ar, mi = ai;
#pragma unroll
        for (int k = 0; k < 4; ++k) { const float t = mr * mr - mi * mi; mi = 2.f * mr * mi; mr = t; }
#define S5_STEP(CTRL) do { const float tr = __builtin_bit_cast(float, __builtin_amdgcn_update_dpp(0, __builtin_bit_cast(int, sr), CTRL, 0xf, 0xf, true)), ti = __builtin_bit_cast(float, __builtin_amdgcn_update_dpp(0, __builtin_bit_cast(int, si), CTRL, 0xf, 0xf, true)); \
            sr += mr * tr - mi * ti; si += mr * ti + mi * tr; const float t2 = mr * mr - mi * mi; mi = 2.f * mr * mi; mr = t2; } while (0)
        S5_STEP(0x111); S5_STEP(0x112); S5_STEP(0x114); S5_STEP(0x118);
#undef S5_STEP
        const float pr = __builtin_bit_cast(float, __builtin_amdgcn_update_dpp(0, __builtin_bit_cast(int, sr), 0x111, 0xf, 0xf, true)), pi = __builtin_bit_cast(float, __builtin_amdgcn_update_dpp(0, __builtin_bit_cast(int, si), 0x111, 0xf, 0xf, true));
        float qr = 1.f, qi = 0.f;
#pragma unroll
        for (int i = 0; i < 16; ++i) { const float orr = qr * pr - qi * pi + lr[i], oi = qr * pi + qi * pr + li[i];
            *(unsigned*)(SP + base + (size_t)i * 128) = pk2(orr, oi);
            const float t = qr * ar - qi * ai; qi = qr * ai + qi * ar; qr = t; }
    }
}
__device__ __forceinline__ void s5_phaseC(const Frame& F, unsigned char* ws, const int lane, const float* dskip) {
    const bf16* PB = (const bf16*)(ws + WS_PB); const bf16* KT = (const bf16*)(ws + WS_S5KT); const bf16* WT = (const bf16*)(ws + WS_S5WT); const bf16* SP = (const bf16*)(ws + WS_S5SP);
    bf16* YB = (bf16*)(ws + WS_YB);
    const int gq = lane >> 4, li = lane & 15;
#pragma unroll 1
    for (int wu = F.gw; wu < 64 * NRT * 2; wu += F.NGW) {
        const int par = wu & 1, rt = (wu >> 1) % NRT, g = wu / (2 * NRT), b = rt / (NRT / 2), c0 = (rt % (NRT / 2)) * 16;
        bf16x8 af[SLN / 2], sf[4];
        const bf16* ap = PB + ((size_t)b * T + (size_t)(c0 + li) * SLN + (gq >> 1)) * 1024 + g * 16 + 8 * (gq & 1);
#pragma unroll
        for (int ks = 0; ks < SLN / 2; ++ks) af[ks] = *(const bf16x8*)(ap + (size_t)(2 * ks) * 1024);
#pragma unroll
        for (int ks = 0; ks < 4; ++ks) sf[ks] = *(const bf16x8*)(SP + (size_t)(g * NI + rt * 16 + li) * 128 + 32 * ks + 8 * gq);
        const f32x4 dl = *(const f32x4*)(dskip + g * 16 + 4 * gq);
        const bf16* ktp = KT + (size_t)g * SLN * 256 + li * 16 + 8 * (gq & 1);
#pragma unroll
        for (int l2 = 0; l2 < SLN / 2; ++l2) {
            int l = 2 * l2 + par; asm volatile("" : "+v"(l));
            f32x4 acc = (f32x4){0.f, 0.f, 0.f, 0.f};
#pragma unroll
            for (int ks = 0; ks <= l2; ++ks) { const int tau = l - 2 * ks - (gq >> 1);
                bf16x8 bfv = *(const bf16x8*)(ktp + (size_t)(tau < 0 ? 0 : tau) * 256);
                if (ks == l2 && tau < 0) bfv = (bf16x8){0, 0, 0, 0, 0, 0, 0, 0};
                acc = __builtin_amdgcn_mfma_f32_16x16x32_bf16(bfv, af[ks], acc, 0, 0, 0); }
            const bf16* wp = WT + (size_t)((g * SLN + l) * 16 + li) * 128 + 8 * gq;
#pragma unroll
            for (int ks = 0; ks < 4; ++ks) acc = __builtin_amdgcn_mfma_f32_16x16x32_bf16(*(const bf16x8*)(wp + 32 * ks), sf[ks], acc, 0, 0, 0);
            { const size_t row = (size_t)b * T + (size_t)(c0 + li) * SLN + l; const size_t o = row * 1024 + g * 16 + 4 * gq;
                const uint2 uv = *(const uint2*)(PB + o);
                uint2 ov; ov.x = pk2(gelu_tanh(acc[0] + dl[0] * bflo(uv.x)), gelu_tanh(acc[1] + dl[1] * bfhi(uv.x))); ov.y = pk2(gelu_tanh(acc[2] + dl[2] * bflo(uv.y)), gelu_tanh(acc[3] + dl[3] * bfhi(uv.y)));
                *(uint2*)(YB + o) = ov; }
            asm volatile("" ::: "memory");
        }
    }
}

#define IN(k) (lo <= (k) && (k) < hi)
#define SEAM(k) do { if ((k) + 1 < hi) { xcd_barrier(bar, F.wave); if (PROBE_CLS == 10) xcd_barrier(bar, F.wave); if (PROBE_T >= 0) stamp_fn(F.lds, F.wave, (k)); } } while (0)
#define INP(i) inp_ptr(F.lds, (i))
#define x_in INP(0)
#define ln_g INP(1)
#define ln_b INP(2)
#define WS_PTRS \
    float* HF = (float*)(ws + WS_HF); bf16* XB = (bf16*)(ws + WS_XB); bf16* ZF = (bf16*)(ws + WS_ZF); bf16* PB = (bf16*)(ws + WS_PB); \
    float* GB = (float*)(ws + WS_GB); float* LA = (float*)(ws + WS_LA); float* ORAW = (float*)(ws + WS_ORAW); bf16* YB = (bf16*)(ws + WS_YB); \
    bf16* ACT = (bf16*)(ws + WS_ACT); bf16* YS = (bf16*)(ws + WS_YS); bf16* XG = (bf16*)(ws + WS_XG); \
    int* LIST = (int*)(ws + WS_LIST); float* GW = (float*)(ws + WS_ORAW); \
    float* S5LB = (float*)(ws + WS_S5TAB); float* S5BB = (float*)(ws + WS_S5TAB + 32768); \
    (void)HF; (void)XB; (void)ZF; (void)PB; (void)GB; (void)LA; (void)ORAW; (void)YB; (void)ACT; (void)YS; (void)XG; (void)LIST; (void)GW; (void)S5LB; (void)S5BB;

template <int layer>
__device__ __forceinline__ void layer_body(const Frame& F, unsigned char* ws, unsigned* ctl, LAS int* TAB, const XcdBarrier& bar, const int lo, const int hi, float* d_out) {
    WS_PTRS
        const int pb = 1 + layer * 16;
        const float* hin = (layer == 0) ? x_in : HF;
        if (PHE(1) && IN(pb + 0)) {
            const bf16* Wt = (const bf16*)(ws + (layer == 0 ? WS_WT_ML_IN : layer == 1 ? WS_WT_RET_IN : layer == 2 ? WS_WT_GLA_IN : WS_WT_S5_IN));
            const int N = (layer == 0 || layer == 2) ? 3072 : (layer == 1 ? 6144 : 1024);
            pg8::DenseOrder S; S.init(XB, Wt, M, N, D, F.G, (int)blockIdx.x);
            pg8::EpiBf16 E{PB, N, (const float*)(ws + WS_CS), (layer == 1) ? 8 : 0};
            for (int rep_ = 0; rep_ < REPS(2); ++rep_)
            pg8::gemm_phase<pg8::EpiBf16, pg8::DenseOrder, true, true>(F.lds, F.wave, D, S, E);
            if (layer == 0 && CH_ML) {
                const int lane = lane_id(); float* GSC = (float*)(ws + WS_SC);
                for (int wu = F.gw; wu < 16 * NCH; wu += F.NGW) { const int bh = wu / NCH, c = wu % NCH, b = bh >> 3, h = bh & 7;
                    const int t0 = c * CL + 2 * lane; const size_t row = (size_t)b * T + t0;
                    const float lf0 = log_sigmoidf_(GB[row * 16 + 8 + h]), lf1 = log_sigmoidf_(GB[(row + 1) * 16 + 8 + h]);
                    const float sp = lf0 + lf1; float inc = sp;
#pragma unroll
                    for (int d = 1; d < 64; d <<= 1) { const float tv_ = __shfl_up(inc, d); if (lane >= d) inc += tv_; }
                    const float a0 = inc - sp + lf0, a1 = inc;
                    const float g0 = GB[row * 16 + h] - a0, g1 = GB[(row + 1) * 16 + h] - a1;
                    float mx = fmaxf(g0, g1);
#pragma unroll
                    for (int d = 1; d < 64; d <<= 1) { const float tv_ = __shfl_up(mx, d); if (lane >= d) mx = fmaxf(mx, tv_); }
                    float ex = __shfl_up(mx, 1); if (lane == 0) ex = -3.0e38f;
                    const size_t o0 = (size_t)bh * T + t0;
                    *(f32x2*)(GSC + (size_t)(0 * 16) * T + o0) = (f32x2){a0, a1};
                    *(f32x2*)(GSC + (size_t)(1 * 16) * T + o0) = (f32x2){g0, g1};
                    *(f32x2*)(GSC + (size_t)(2 * 16) * T + o0) = (f32x2){fmaxf(ex, g0), mx}; }
            }
            SEAM(pb + 0);
        }
        if (layer == 0) {
            if (CH_ML) {
                if (IN(pb + 2)) { const int lane = lane_id(), tid = F.wave * 64 + lane; for (int rep_ = 0; rep_ < REPS(6); ++rep_) mix_phaseA<0>(F, ws, tid, lane); SEAM(pb + 2); }
                if (IN(pb + 3)) { const int lane = lane_id(), tid = F.wave * 64 + lane; for (int rep_ = 0; rep_ < REPS(7); ++rep_) mix_phaseB<0>(F, ws, tid); SEAM(pb + 3); }
                if (IN(pb + 4)) { const int lane = lane_id(), tid = F.wave * 64 + lane; for (int rep_ = 0; rep_ < REPS(8); ++rep_) mix_phaseC<0>(F, ws, tid, lane, INP(5)); SEAM(pb + 4); }
            }
        } else if (layer == 1) {
            if (CH_RET) {
                if (IN(pb + 2)) { const int lane = lane_id(), tid = F.wave * 64 + lane; for (int rep_ = 0; rep_ < REPS(6); ++rep_) mix_phaseA<1>(F, ws, tid, lane); SEAM(pb + 2); }
                if (IN(pb + 3)) { const int lane = lane_id(), tid = F.wave * 64 + lane; for (int rep_ = 0; rep_ < REPS(7); ++rep_) mix_phaseB<1>(F, ws, tid); SEAM(pb + 3); }
                if (IN(pb + 4)) { const int lane = lane_id(), tid = F.wave * 64 + lane; for (int rep_ = 0; rep_ < REPS(8); ++rep_) mix_phaseC<1>(F, ws, tid, lane, INP(8)); SEAM(pb + 4); }
            }
        } else if (layer == 2) {
            if (CH_GLA) {
                if (IN(pb + 1)) {
                    const int lane = lane_id();
                    bf16* KPP = (bf16*)(ws + WS_KPP); float* DEC = (float*)(ws + WS_SC + 3 * MiB); LAS float* tot = (LAS float*)F.lds;
                    for (int u = blockIdx.x; u < 2 * NCH * 8; u += F.G) { const int cg = u & 7, bc = u >> 3, b = bc / NCH, c = bc % NCH, ch = cg * 64 + lane;
                        const size_t r0 = (size_t)b * T + (size_t)c * CL + 16 * F.wave;
                        float cs[16]; unsigned short qv[16], kv[16];
#pragma unroll
                        for (int i = 0; i < 16; ++i) { cs[i] = LA[(r0 + i) * 512 + ch]; qv[i] = PB[(r0 + i) * 3072 + ch]; kv[i] = PB[(r0 + i) * 3072 + 512 + ch]; }
#pragma unroll
                        for (int i = 1; i < 16; ++i) cs[i] += cs[i - 1];
                        __syncthreads();
                        tot[F.wave * 64 + lane] = cs[15];
                        __syncthreads();
                        float pre = 0.f, bend = 0.f;
#pragma unroll
                        for (int w2 = 0; w2 < NWAVES; ++w2) { const float tw = tot[w2 * 64 + lane]; bend += tw; if (w2 < F.wave) pre += tw; }
#pragma unroll
                        for (int i = 0; i < 16; ++i) { const float bcum = pre + cs[i]; const float q_ = bf2f(qv[i]), k_ = bf2f(kv[i]) * 0.08838834764831845f;
                            PB[(r0 + i) * 3072 + ch] = (bf16)f2bf(q_ * __expf(bcum)); PB[(r0 + i) * 3072 + 512 + ch] = (bf16)f2bf(k_ * __expf(-bcum)); KPP[(r0 + i) * 512 + ch] = (bf16)f2bf(k_ * __expf(bend - bcum)); }
                        if (F.wave == 0) DEC[(size_t)bc * 512 + ch] = __expf(bend); }
                    __syncthreads();
                    SEAM(pb + 1);
                }
                if (IN(pb + 2)) { const int lane = lane_id(), tid = F.wave * 64 + lane; for (int rep_ = 0; rep_ < REPS(6); ++rep_) mix_phaseA<2>(F, ws, tid, lane); SEAM(pb + 2); }
                if (IN(pb + 3)) { const int lane = lane_id(), tid = F.wave * 64 + lane; for (int rep_ = 0; rep_ < REPS(7); ++rep_) mix_phaseB<2>(F, ws, tid); SEAM(pb + 3); }
                if (IN(pb + 4)) { const int lane = lane_id(), tid = F.wave * 64 + lane; for (int rep_ = 0; rep_ < REPS(8); ++rep_) mix_phaseC<2>(F, ws, tid, lane, INP(13)); SEAM(pb + 4); }
            }
        } else {
            if (CH_S5) {
                if (IN(pb + 2)) { const int lane = lane_id(); for (int rep_ = 0; rep_ < REPS(6); ++rep_) s5_phaseA(F, ws, lane); SEAM(pb + 2); }
                if (IN(pb + 3)) { const int lane = lane_id(), tid = F.wave * 64 + lane; for (int rep_ = 0; rep_ < REPS(7); ++rep_) s5_phaseB(F, ws, tid); SEAM(pb + 3); }
                if (IN(pb + 4)) { const int lane = lane_id(); for (int rep_ = 0; rep_ < REPS(8); ++rep_) s5_phaseC(F, ws, lane, INP(22)); SEAM(pb + 4); }
            }
        }
        if (PHE(4) && layer == 3 && IN(pb + 6)) {
            pg8::DenseOrder S; S.init(YB, ws + WS_WT_S5_GLU, M, D, D, F.G, (int)blockIdx.x);
            pg8::EpiGlu E{YB, INP(25), (bf16*)ORAW};
            for (int rep_ = 0; rep_ < REPS(3); ++rep_)
            pg8::gemm_phase<pg8::EpiGlu, pg8::DenseOrder, true, true>(F.lds, F.wave, D, S, E);
            SEAM(pb + 6);
        }
        if (PHE(5) && IN(pb + 7)) {
            const bf16* Wt = (const bf16*)(ws + (layer == 0 ? WS_WT_ML_OUT : layer == 1 ? WS_WT_RET_OUT : layer == 2 ? WS_WT_GLA_OUT : WS_WT_S5_OUT));
            const int Kd = (layer == 1) ? 2048 : 1024;
            const bf16* Ain = (layer == 3) ? (const bf16*)ORAW : YB;
            pg8::DenseOrder S; S.init(Ain, Wt, M, D, Kd, F.G, (int)blockIdx.x);
            pg8::EpiResid E{hin, (layer == 0) ? (const bf16*)nullptr : (const bf16*)XB, ZF};
            for (int rep_ = 0; rep_ < REPS(3); ++rep_)
            pg8::gemm_phase<pg8::EpiResid, pg8::DenseOrder, true, true>(F.lds, F.wave, Kd, S, E);
            SEAM(pb + 7);
        }
        unsigned* cnt = ctl + CW_CNT + layer * 32 * 64;
        if (IN(pb + 8) && !defined_SKIP_LN1) { const int lane = lane_id(), tid = F.wave * 64 + lane; (void)tid;
            LAS float* Wt = (LAS float*)(F.lds);
            { const f32x4* wr4 = (const f32x4*)(INP(27) + (size_t)layer * D * NEXP);
              f32x4 wv[16];
#pragma unroll
              for (int i = 0; i < 16; ++i) wv[i] = wr4[tid + i * NTHREADS];
#pragma unroll
              for (int i = 0; i < 16; ++i) { const int q = tid + i * NTHREADS, k = q >> 3, e0 = (q & 7) * 4;
                  Wt[(e0 + 0) * 1028 + k] = wv[i][0]; Wt[(e0 + 1) * 1028 + k] = wv[i][1]; Wt[(e0 + 2) * 1028 + k] = wv[i][2]; Wt[(e0 + 3) * 1028 + k] = wv[i][3]; } }
            __syncthreads();
            const float* br_ = INP(28) + layer * NEXP;
            const float* lng_ = ln_g + (size_t)(layer * 2 + 0) * D; const float* lnb_ = ln_b + (size_t)(layer * 2 + 0) * D;
          {
            unsigned* cntp = cnt;
            int aE = 0, aRow = -1; float aG = 0.f;
            LAS unsigned* lcnt = (LAS unsigned*)(F.lds + 131584); LAS int* lbase = (LAS int*)(lcnt + 32);
            if (tid < 32) lcnt[tid] = 0u;
            const int ntrip = (M + F.NGW - 1) / F.NGW;
            u32x2 vnext[2][4];
#pragma unroll
            for (int q = 0; q < 2; ++q) { const int r_ = F.gw + q * F.NGW; if (r_ < M) { const u32x2* zp = (const u32x2*)(ZF + (size_t)r_ * D) + lane;
#pragma unroll
                for (int j = 0; j < 4; ++j) vnext[q][j] = zp[64 * j]; } }
            for (int it_ = 0; it_ < ntrip; it_ += 2) { const int row0_ = F.gw + it_ * F.NGW;
                asm volatile("" ::: "memory");
                const bool ok[2] = {row0_ < M, it_ + 1 < ntrip && row0_ + F.NGW < M};
                f32x4 v[2][4];
#pragma unroll
                for (int q = 0; q < 2; ++q)
#pragma unroll
                    for (int j = 0; j < 4; ++j) v[q][j] = (f32x4){bflo(vnext[q][j].x), bfhi(vnext[q][j].x), bflo(vnext[q][j].y), bfhi(vnext[q][j].y)};
#pragma unroll
                for (int q = 0; q < 2; ++q) { const int r_ = row0_ + (2 + q) * F.NGW; if (it_ + 2 + q < ntrip && r_ < M) { const u32x2* zp = (const u32x2*)(ZF + (size_t)r_ * D) + lane;
#pragma unroll
                    for (int j = 0; j < 4; ++j) vnext[q][j] = zp[64 * j]; } }
                { f32x4 gv[4], bv[4]; load_row_f32(lng_, gv, lane); load_row_f32(lnb_, bv, lane); ln_row(v[0], gv, bv); ln_row(v[1], gv, bv); }
                float pz[2][32];
#pragma unroll
                for (int e = 0; e < 32; ++e) { float s0 = 0.f, s1 = 0.f;
#pragma unroll
                    for (int j = 0; j < 4; ++j) { const f32x4 w = *(const LAS f32x4*)(Wt + e * 1028 + 4 * (lane + 64 * j));
                        s0 += v[0][j][0] * w[0] + v[0][j][1] * w[1] + v[0][j][2] * w[2] + v[0][j][3] * w[3]; s1 += v[1][j][0] * w[0] + v[1][j][1] * w[1] + v[1][j][2] * w[2] + v[1][j][3] * w[3]; }
                    pz[0][e] = s0; pz[1][e] = s1; }
                float lgv[2];
#pragma unroll
                for (int q = 0; q < 2; ++q) {
                    float a16[16], a8[8], a4[4], a2[2];
#pragma unroll
                    for (int e = 0; e < 16; ++e) { const auto r = __builtin_amdgcn_permlane32_swap(__builtin_bit_cast(unsigned, pz[q][e]), __builtin_bit_cast(unsigned, pz[q][e + 16]), false, false);
                        a16[e] = __builtin_bit_cast(float, (unsigned)r[0]) + __builtin_bit_cast(float, (unsigned)r[1]); }
#pragma unroll
                    for (int e = 0; e < 8; ++e) { const auto r = __builtin_amdgcn_permlane16_swap(__builtin_bit_cast(unsigned, a16[e]), __builtin_bit_cast(unsigned, a16[e + 8]), false, false);
                        a8[e] = __builtin_bit_cast(float, (unsigned)r[0]) + __builtin_bit_cast(float, (unsigned)r[1]); }
                    { const bool hi = (lane & 8) != 0;
#pragma unroll
                      for (int e = 0; e < 4; ++e) { const float mine = hi ? a8[e + 4] : a8[e], theirs = hi ? a8[e] : a8[e + 4]; a4[e] = mine + dpp_f<0x128>(theirs); } }
                    { const bool hi = (lane & 4) != 0;
#pragma unroll
                      for (int e = 0; e < 2; ++e) { const float mine = hi ? a4[e + 2] : a4[e], theirs = hi ? a4[e] : a4[e + 2]; a2[e] = mine + dpp_f<0x141>(theirs); } }
                    { const bool hi = (lane & 2) != 0; const float mine = hi ? a2[1] : a2[0], theirs = hi ? a2[0] : a2[1]; lgv[q] = mine + dpp_f<0x4E>(theirs); }
                    lgv[q] += dpp_f<0xB1>(lgv[q]);
                    lgv[q] += br_[lane >> 1];
                }
                int te[2][4]; float tv[2][4];
#pragma unroll
                for (int k = 0; k < 4; ++k)
#pragma unroll
                    for (int q = 0; q < 2; ++q) { const float best = wave_max(lgv[q]);
                        const unsigned long long mk = __ballot(lgv[q] == best); const int src = __builtin_amdgcn_readfirstlane((int)__ffsll((long long)mk) - 1);
                        te[q][k] = src >> 1; tv[q][k] = best; if ((lane >> 1) == te[q][k]) lgv[q] = -3.0e38f; }
#pragma unroll
                for (int q = 0; q < 2; ++q) if (ok[q]) { const int row = row0_ + q * F.NGW;
                    const float e0 = 1.f, e1 = __expf(tv[q][1] - tv[q][0]), e2 = __expf(tv[q][2] - tv[q][0]), e3 = __expf(tv[q][3] - tv[q][0]), rs = __builtin_amdgcn_rcpf(e0 + e1 + e2 + e3);
                    const int ri = (it_ + q) & 15;
                    if ((lane >> 2) == ri) { const int k = lane & 3; aE = k == 0 ? te[q][0] : k == 1 ? te[q][1] : k == 2 ? te[q][2] : te[q][3]; aG = (k == 0 ? e0 : k == 1 ? e1 : k == 2 ? e2 : e3) * rs; aRow = row; }
                    store_row_bf16(XB + (size_t)row * D, v[q], lane); }
                if (((it_ + 1) & 15) == 15 || it_ + 2 >= ntrip) {
                    __syncthreads();
                    int lp = 0; if (aRow >= 0) lp = (int)__hip_atomic_fetch_add(lcnt + aE, 1u, __ATOMIC_RELAXED, __HIP_MEMORY_SCOPE_WORKGROUP);
                    __syncthreads();
                    if (tid < 32) { const unsigned n = lcnt[tid]; lbase[tid] = n ? (int)__hip_atomic_fetch_add(cntp + tid * 64, n, __ATOMIC_RELAXED, __HIP_MEMORY_SCOPE_AGENT) : 0; }
                    __syncthreads();
                    if (aRow >= 0) { const int pos = lbase[aE] + lp; LIST[(size_t)aE * CAP + pos] = aRow * 4 + (lane & 3); GW[(size_t)aE * CAP + pos] = aG; }
                    aRow = -1;
                    __syncthreads();
                    if (tid < 32) lcnt[tid] = 0u;
                }
            }
          }
            __syncthreads();
            SEAM(pb + 8);
        }
        if ((PHE(7) || PHE(8)) && (IN(pb + 9) || IN(pb + 10))) { const int lane = lane_id(), tid = F.wave * 64 + lane; (void)tid;
            __syncthreads();
            if (tid < 32) TAB[tid] = (int)__hip_atomic_load(cnt + tid * 64, __ATOMIC_RELAXED, __HIP_MEMORY_SCOPE_AGENT);
            __syncthreads();
            if (tid < 64) {
                const int nt_ = (lane < 32) ? ((TAB[lane] + 255) >> 8) : 0; int inc = nt_;
#pragma unroll
                for (int d = 1; d < 32; d <<= 1) { const int t_ = __shfl_up(inc, d); if (lane >= d) inc += t_; }
                if (lane < 32) TAB[32 + lane] = inc - nt_;
                if (lane == 31) TAB[64] = inc; }
            __syncthreads();
            if (tid < MAXTILES) { int e = 0;
#pragma unroll
                for (int k = 1; k < 32; ++k) e += (TAB[32 + k] <= tid) ? 1 : 0;
                if (tid < TAB[64]) TAB[72 + tid] = e; }
            __syncthreads();
        }
        if (PHE(7) && IN(pb + 9)) {
            pg8::MoeOrder S; S.A = (const char*)XB; S.list = LIST; S.gwl = GW; S.Bt = (const char*)(ws + WS_WT_GU + (size_t)layer * 32 * 2048 * 1024 * 2); S.tab = TAB; S.K = D; S.nN = 8; S.ntiles = __builtin_amdgcn_readfirstlane(TAB[64]); S.nwg = S.ntiles * 8; S.G = F.G; S.c = (int)blockIdx.x;
            S.b_estride = (size_t)2048 * 1024 * 2; S.a_compact = 2;
            pg8::EpiSwiglu E{ACT, INP(30) + (size_t)layer * 32 * 2048, (const LAS float*)(TAB + 2816)};
            for (int rep_ = 0; rep_ < REPS(4); ++rep_)
            pg8::gemm_phase<pg8::EpiSwiglu, pg8::MoeOrder, MOE_ALIGN, true, true>(F.lds, F.wave, D, S, E, TAB + 512);
            SEAM(pb + 9);
        }
        if (PHE(8) && IN(pb + 10)) {
            pg8::MoeOrder S; S.A = (const char*)ACT; S.list = LIST; S.gwl = GW; S.Bt = (const char*)(ws + WS_WT_DN + (size_t)layer * 32 * 1024 * 1024 * 2); S.tab = TAB; S.K = DFF; S.nN = 4; S.ntiles = __builtin_amdgcn_readfirstlane(TAB[64]); S.nwg = S.ntiles * 4; S.G = F.G; S.c = (int)blockIdx.x;
            S.b_estride = (size_t)1024 * 1024 * 2; S.a_compact = 1;
            pg8::EpiMoeDown E{YS, INP(32) + (size_t)layer * 32 * 1024, TAB + 1280, (const LAS float*)(TAB + 2816)};
            for (int rep_ = 0; rep_ < REPS(5); ++rep_)
            pg8::gemm_phase<pg8::EpiMoeDown, pg8::MoeOrder, MOE_ALIGN, true, true>(F.lds, F.wave, DFF, S, E, TAB + 512);
            SEAM(pb + 10);
        }
        if (PHE(9) && IN(pb + 11)) { const int lane = lane_id(), tid = F.wave * 64 + lane; (void)tid;
            LAS float* Wt = (LAS float*)(F.lds);
            if (layer == 1) { load_cols16(tid, INP(10), 3088, 3072, Wt); __syncthreads(); }
            const float* lng_ = ln_g + (size_t)(layer * 2 + 1) * D; const float* lnb_ = ln_b + (size_t)(layer * 2 + 1) * D;
          for (int rep_ = 0; rep_ < REPS(12); ++rep_) {
            float* outp = (PROBE_CLS == 12 && rep_ == 0) ? ORAW : (layer == 3) ? d_out : HF; bf16* XBo = (PROBE_CLS == 12 && rep_ == 0) ? YB : XB;
            f32x4 hn[4]; u32x2 yn[4][4];
#define CMB_LOAD(r_) do { { const u32x2* hp_ = (const u32x2*)(XB + (size_t)(r_) * D) + lane; _Pragma("unroll") for (int j = 0; j < 4; ++j) { const u32x2 hw_ = hp_[64 * j]; hn[j] = (f32x4){bflo(hw_.x), bfhi(hw_.x), bflo(hw_.y), bfhi(hw_.y)}; } } _Pragma("unroll") for (int k = 0; k < 4; ++k) { const u32x2* yp = (const u32x2*)(YS + ((size_t)(r_) * 4 + k) * D) + lane; _Pragma("unroll") for (int j = 0; j < 4; ++j) yn[k][j] = yp[64 * j]; } } while (0)
            if (F.gw < M) CMB_LOAD(F.gw);
            for (int row = F.gw; row < M; row += F.NGW) {
                asm volatile("" ::: "memory");
                f32x4 v[4];
#pragma unroll
                for (int j = 0; j < 4; ++j) v[j] = hn[j] * ALPHA;
#pragma unroll
                for (int k = 0; k < 4; ++k)
#pragma unroll
                    for (int j = 0; j < 4; ++j) { const u32x2 yw = yn[k][j]; v[j][0] += bflo(yw.x); v[j][1] += bfhi(yw.x); v[j][2] += bflo(yw.y); v[j][3] += bfhi(yw.y); }
                if (row + F.NGW < M) CMB_LOAD(row + F.NGW);
                { f32x4 gv[4], bv[4]; load_row_f32(lng_, gv, lane); load_row_f32(lnb_, bv, lane); ln_row(v, gv, bv); }
                if (layer == 3) store_row_f32(outp + (size_t)row * D, v, lane);
                if (layer < 3) store_row_bf16(XBo + (size_t)row * D, v, lane);
                if (layer == 1) {
                    const float zsum = row_dot16(v, Wt, lane);
                    if ((lane & 3) == 0) GB[(size_t)row * 16 + (lane >> 2)] = zsum;
                }
            }
            if (layer == 1) {
                __syncthreads();
                const float* wgp = INP(11); const float bgc = INP(12)[tid];
                float wg[16];
#pragma unroll
                for (int r = 0; r < 16; ++r) wg[r] = wgp[r * 512 + tid];
                for (int row = F.vcu * NWAVES; row < M; row += F.NGW) {
                    f32x4 zv[NWAVES][4];
#pragma unroll
                    for (int w = 0; w < NWAVES; ++w)
#pragma unroll
                        for (int q = 0; q < 4; ++q) zv[w][q] = *(const f32x4*)(GB + (size_t)(row + w) * 16 + 4 * q);
#pragma unroll
                    for (int w = 0; w < NWAVES; ++w) { float sacc = bgc;
#pragma unroll
                        for (int q = 0; q < 4; ++q) sacc += zv[w][q][0] * wg[4 * q] + zv[w][q][1] * wg[4 * q + 1] + zv[w][q][2] * wg[4 * q + 2] + zv[w][q][3] * wg[4 * q + 3];
                        LA[(size_t)(row + w) * 512 + tid] = log_sigmoidf_(sacc) * (1.f / 16.f); }
                }
            }
          }
            __syncthreads();
#undef CMB_LOAD
            if (layer < 3) SEAM(pb + 11);
        }
}
__global__ void __launch_bounds__(NTHREADS, 2) mega_fwd(Args args) {
    extern __shared__ __attribute__((aligned(16))) unsigned char lds_raw[];
    Frame F;
    F.lds = (LAS unsigned char*)lds_raw;
    F.wave = __builtin_amdgcn_readfirstlane((int)threadIdx.x >> 6);
    F.G = gridDim.x; { const int bx = blockIdx.x; F.vcu = (F.G % 8 == 0) ? (bx % 8) * (F.G / 8) + bx / 8 : bx; }
    F.gw = F.vcu * NWAVES + F.wave; F.NGW = F.G * NWAVES;
    unsigned char* ws = args.ws;
    unsigned* ctl = (unsigned*)(ws + WS_CTL);
    volatile LAS unsigned* MISC = (volatile LAS unsigned*)(F.lds + MISC_OFF);
    LAS int* TAB = (LAS int*)(F.lds + TAB_OFF);
    { const int tid0 = threadIdx.x;
      if (tid0 < 64) MISC[tid0] = 0u;
      if (tid0 < 33) ((LAS unsigned long long*)(F.lds + MISC_OFF + 256))[tid0] = (unsigned long long)args.in[tid0]; }
    __syncthreads();
    XcdBarrier bar = xcd_barrier_post(ctl + CW_BAR, MISC + 8, F.wave == 0 && lane_id() == 0);
    if (PROBE_T >= 0 && blockIdx.x == 0 && F.wave == 0 && lane_id() == 0) { volatile LAS unsigned long long* st = (volatile LAS unsigned long long*)(F.lds + MISC_OFF + 1024); st[0] = __builtin_amdgcn_s_memrealtime(); st[1] = 0ull; }
    const int lo = args.ph_lo, hi = args.ph_hi;
    WS_PTRS
    if (IN(0) && !defined_SKIP_P0) { const int lane = lane_id(), tid = F.wave * 64 + lane; (void)tid;
      {
        LAS unsigned char* scr = F.lds + F.wave * 8704;
        {
            constexpr int I_GU = 128 * 16 * 32, I_DN = 128 * 16 * 16, I_ML = 16 * 48, I_SQ = 16 * 16, I_RI = 16 * 96, I_RO = 32 * 16;
            constexpr int B0 = I_GU, B1 = B0 + I_DN, B2 = B1 + I_ML, B3 = B2 + I_SQ, B4 = B3 + I_RI, B5 = B4 + I_RO, B6 = B5 + I_ML, B7 = B6 + I_SQ, B8 = B7 + I_SQ, B9 = B8 + I_SQ, B10 = B9 + I_SQ;
#define P0_ITEM(IT_) do { const int it = (IT_); \
                    const float* src; bf16* dst; int ldw, Kd, nnb, mode = 0, r; \
                    if (it < B0)      { r = it;      const int q = r / (16 * 32); r -= q * (16 * 32); src = INP(29) + (size_t)q * 1024 * 2048; dst = (bf16*)(ws + WS_WT_GU) + (size_t)q * 2048 * 1024; ldw = 2048; Kd = 1024; nnb = 32; mode = 1; } \
                    else if (it < B1) { r = it - B0; const int q = r / (16 * 16); r -= q * (16 * 16); src = INP(31) + (size_t)q * 1024 * 1024; dst = (bf16*)(ws + WS_WT_DN) + (size_t)q * 1024 * 1024; ldw = 1024; Kd = 1024; nnb = 16; } \
                    else if (it < B2) { r = it - B1; src = INP(3);  dst = (bf16*)(ws + WS_WT_ML_IN);  ldw = 3088; Kd = 1024; nnb = 48; } \
                    else if (it < B3) { r = it - B2; src = INP(6);  dst = (bf16*)(ws + WS_WT_ML_OUT); ldw = 1024; Kd = 1024; nnb = 16; } \
                    else if (it < B4) { r = it - B3; src = INP(7);  dst = (bf16*)(ws + WS_WT_RET_IN); ldw = 6144; Kd = 1024; nnb = 96; mode = 2; } \
                    else if (it < B5) { r = it - B4; src = INP(9);  dst = (bf16*)(ws + WS_WT_RET_OUT); ldw = 1024; Kd = 2048; nnb = 16; } \
                    else if (it < B6) { r = it - B5; src = INP(10); dst = (bf16*)(ws + WS_WT_GLA_IN); ldw = 3088; Kd = 1024; nnb = 48; } \
                    else if (it < B7) { r = it - B6; src = INP(14); dst = (bf16*)(ws + WS_WT_GLA_OUT); ldw = 1024; Kd = 1024; nnb = 16; } \
                    else if (it < B8) { r = it - B7; src = INP(15); dst = (bf16*)(ws + WS_WT_S5_IN);  ldw = 1024; Kd = 1024; nnb = 16; } \
                    else if (it < B9) { r = it - B8; src = INP(24); dst = (bf16*)(ws + WS_WT_S5_GLU); ldw = 1024; Kd = 1024; nnb = 16; } \
                    else              { r = it - B9; src = INP(26); dst = (bf16*)(ws + WS_WT_S5_OUT); ldw = 1024; Kd = 1024; nnb = 16; } \
                const int kb = r / nnb, nb = r - kb * nnb; \
                transpose_item(src, ldw, 0, Kd, dst, mode, kb, nb, scr, lane); } while (0)
            const int NSTAT = (B10 / F.NGW) * 4 / 5, DYN0 = NSTAT * F.NGW, DLEN = B10 - DYN0, GLEN = (DLEN + 7) / 8;
#pragma unroll 1
            for (int n_ = 0; n_ < NSTAT; ++n_) P0_ITEM(F.gw + n_ * F.NGW);
#pragma unroll 1
            for (int tr = 0; tr < 8; ++tr) { const int grp = ((int)blockIdx.x + tr) & 7; unsigned* q = ctl + 2304 + 64 * grp; const int glo = DYN0 + grp * GLEN, glen = (DLEN - grp * GLEN) < GLEN ? (DLEN - grp * GLEN) : GLEN;
                int cur = 0; if (lane == 0) cur = (int)__hip_atomic_fetch_add(q, 4u, __ATOMIC_RELAXED, __HIP_MEMORY_SCOPE_AGENT); cur = __builtin_amdgcn_readfirstlane(cur);
#pragma unroll 1
                while (cur < glen) { int nx = 0; if (lane == 0) nx = (int)__hip_atomic_fetch_add(q, 4u, __ATOMIC_RELAXED, __HIP_MEMORY_SCOPE_AGENT);
#pragma unroll 1
                    for (int k = 0; k < 4; ++k) if (cur + k < glen) P0_ITEM(glo + cur + k);
                    cur = __builtin_amdgcn_readfirstlane(nx); } }
#undef P0_ITEM
        }
        __syncthreads();
        if (CH_S5) s5_tables(F, ws, tid, INP(16), INP(17), INP(18), INP(19), INP(20), INP(21), INP(23));
        { float* CS = (float*)(ws + WS_CS);
          for (int it = blockIdx.x * NTHREADS + tid; it < T * 64; it += F.G * NTHREADS) { const int t = it >> 6, i = it & 63;
              const float inv = exp2f(-(float)(2 * i) * (13.287712379549449f / 128.f)); float sn, cs; sincosf((float)t * inv, &sn, &cs); CS[2 * it] = cs; CS[2 * it + 1] = sn; } }
        LAS float* Wt = (LAS float*)(F.lds);
        load_cols16(tid, INP(3), 3088, 3072, Wt);
        __syncthreads();
        {
            const float* bg = INP(4);
            f32x4 vn[4]; if (F.gw < M) load_row_f32(x_in + (size_t)F.gw * D, vn, lane);
            for (int row = F.gw; row < M; row += F.NGW) {
                asm volatile("" ::: "memory");
                f32x4 v[4];
#pragma unroll
                for (int j = 0; j < 4; ++j) v[j] = vn[j];
                if (row + F.NGW < M) load_row_f32(x_in + (size_t)(row + F.NGW) * D, vn, lane);
                store_row_bf16(XB + (size_t)row * D, v, lane);
                const float gsum = row_dot16(v, Wt, lane);
                if ((lane & 3) == 0) GB[(size_t)row * 16 + (lane >> 2)] = gsum + bg[lane >> 2];
            }
        }
        __syncthreads();
      }
        SEAM(0);
    }

    layer_body<0>(F, ws, ctl, TAB, bar, lo, hi, args.out);
    layer_body<1>(F, ws, ctl, TAB, bar, lo, hi, args.out);
    layer_body<2>(F, ws, ctl, TAB, bar, lo, hi, args.out);
    layer_body<3>(F, ws, ctl, TAB, bar, lo, hi, args.out);
    if (PROBE_T >= 0 && blockIdx.x == 0 && F.wave == 0 && lane_id() == 0) { volatile LAS unsigned long long* st = (volatile LAS unsigned long long*)(F.lds + MISC_OFF + 1024); args.out[0] = (float)st[1] * (0.01f / 16.f); }
#undef IN
#undef SEAM
#undef INP
#undef x_in
#undef ln_g
#undef ln_b
}

extern "C" void kernel_launch(void* const* d_in, const int* in_sizes, int n_in, void* d_out, int out_size, void* d_ws, size_t ws_size, hipStream_t stream) {
    static int grid = 0;
    if (grid == 0) {
        if (n_in != 33 || out_size != M * D || ws_size < WS_END) { fprintf(stderr, "kernel_launch: unexpected problem (n_in %d, out %d, ws %zu < %zu)\n", n_in, out_size, ws_size, (size_t)WS_END); grid = -1; return; }
        int dev = 0, cus = 0, per_cu = 0;
        if (hipGetDevice(&dev) != hipSuccess || hipDeviceGetAttribute(&cus, hipDeviceAttributeMultiprocessorCount, dev) != hipSuccess) { grid = -1; return; }
        if (hipFuncSetAttribute((const void*)mega_fwd, hipFuncAttributeMaxDynamicSharedMemorySize, LDS_BYTES) != hipSuccess) { fprintf(stderr, "kernel_launch: hipFuncSetAttribute failed\n"); grid = -1; return; }
        if (hipOccupancyMaxActiveBlocksPerMultiprocessor(&per_cu, (const void*)mega_fwd, NTHREADS, LDS_BYTES) != hipSuccess || per_cu < 1) { fprintf(stderr, "kernel_launch: occupancy query says %d\n", per_cu); }
        (void)hipGetLastError();
        grid = cus;
    }
    if (grid < 0) return;
    hipMemsetAsync((char*)d_ws + WS_CTL, 0, CTL_ZERO_BYTES, stream);
    Args a{};
    for (int i = 0; i < 33; ++i) a.in[i] = (const float*)d_in[i];
    a.out = (float*)d_out; a.ws = (unsigned char*)d_ws;
#if N_LAUNCH_MODE == 1
    a.ph_lo = 0; a.ph_hi = 1000;
    hipLaunchKernelGGL(mega_fwd, dim3(grid), dim3(NTHREADS), LDS_BYTES, stream, a);
#else
    for (int ph = 0; ph < 65; ++ph) { a.ph_lo = ph; a.ph_hi = ph + 1; hipLaunchKernelGGL(mega_fwd, dim3(grid), dim3(NTHREADS), LDS_BYTES, stream, a); }
#endif
}
```

```cpp
#include <hip/hip_runtime.h>
#include <cstdio>
#include <cstdint>

#ifndef NAIVE_MIX
#define NAIVE_MIX 1
#endif
#ifndef CH_ML
#define CH_ML 1
#endif
#ifndef CH_RET
#define CH_RET 1
#endif
#ifndef CH_GLA
#define CH_GLA 1
#endif
#ifndef CH_S5
#define CH_S5 1
#endif
#ifndef PROBE_CLS
#define PROBE_CLS 0
#endif
#define REPS(c) ((PROBE_CLS == (c) || PROBE_CLS == 100 + layer * 10 + (c)) ? 2 : 1)
#ifndef PROBE_T
#define PROBE_T -1
#endif
#ifndef PROBE_T2
#define PROBE_T2 PROBE_T
#endif
#ifndef MOE_ALIGN
#define MOE_ALIGN true
#endif
#ifndef N_LAUNCH_MODE
#define N_LAUNCH_MODE 1
#endif


#ifdef SKIP_ML
constexpr bool defined_SKIP_ML = true;
#else
constexpr bool defined_SKIP_ML = false;
#endif
#ifdef SKIP_RET
constexpr bool defined_SKIP_RET = true;
#else
constexpr bool defined_SKIP_RET = false;
#endif
#ifdef SKIP_GLA
constexpr bool defined_SKIP_GLA = true;
#else
constexpr bool defined_SKIP_GLA = false;
#endif
#ifdef SKIP_S5
constexpr bool defined_SKIP_S5 = true;
#else
constexpr bool defined_SKIP_S5 = false;
#endif
#ifdef SKIP_LN1
constexpr bool defined_SKIP_LN1 = true;
#else
constexpr bool defined_SKIP_LN1 = false;
#endif
#ifdef SKIP_P0
constexpr bool defined_SKIP_P0 = true;
#else
constexpr bool defined_SKIP_P0 = false;
#endif
#ifndef PHMASK
#define PHMASK 0xffff
#endif
#define PHE(b) (((PHMASK) >> (b)) & 1)
#define GAS __attribute__((address_space(1)))
#define LAS __attribute__((address_space(3)))
typedef unsigned short bf16;
typedef short bf16x8 __attribute__((ext_vector_type(8)));
typedef float f32x4 __attribute__((ext_vector_type(4)));
typedef float f32x2 __attribute__((ext_vector_type(2)));
typedef unsigned u32x4 __attribute__((ext_vector_type(4)));
typedef unsigned u32x2 __attribute__((ext_vector_type(2)));

constexpr int BATCH = 2, T = 8192, D = 1024, M = BATCH * T;
constexpr int NEXP = 32, TOPK = 4, DFF = 1024, CAP = M;
constexpr int NWAVES = 8, NTHREADS = 512;
constexpr float LN_EPS = 1e-5f;
constexpr float ALPHA = 1.681792830507429f;
constexpr int MAXTILES = (M * TOPK) / 256 + NEXP;

constexpr size_t MiB = 1u << 20;
constexpr size_t WS_CTL = 0, CTL_ZERO_BYTES = 1 * MiB;
constexpr size_t WS_WT_ML_IN = 1 * MiB;
constexpr size_t WS_WT_ML_OUT = WS_WT_ML_IN + 6 * MiB;
constexpr size_t WS_WT_RET_IN = WS_WT_ML_OUT + 2 * MiB;
constexpr size_t WS_WT_RET_OUT = WS_WT_RET_IN + 12 * MiB;
constexpr size_t WS_WT_GLA_IN = WS_WT_RET_OUT + 4 * MiB;
constexpr size_t WS_WT_GLA_OUT = WS_WT_GLA_IN + 6 * MiB;
constexpr size_t WS_WT_S5_IN = WS_WT_GLA_OUT + 2 * MiB;
constexpr size_t WS_WT_S5_GLU = WS_WT_S5_IN + 2 * MiB;
constexpr size_t WS_WT_S5_OUT = WS_WT_S5_GLU + 2 * MiB;
constexpr size_t WS_S5TAB = WS_WT_S5_OUT + 2 * MiB;
constexpr size_t WS_GB = WS_S5TAB + 1 * MiB;
constexpr size_t WS_LIST = WS_GB + 1 * MiB;
constexpr size_t WS_GW = WS_LIST + 2 * MiB;
constexpr size_t WS_WT_GU = WS_GW + 1 * MiB;
constexpr size_t WS_WT_DN = WS_WT_GU + 512 * MiB;
constexpr size_t WS_HF = WS_WT_DN + 256 * MiB;
constexpr size_t WS_XB = WS_HF + 64 * MiB;
constexpr size_t WS_ZF = WS_XB + 32 * MiB;
constexpr size_t WS_PB = WS_ZF + 64 * MiB;
constexpr size_t WS_LA = WS_PB + 192 * MiB;
constexpr size_t WS_ORAW = WS_LA + 32 * MiB;
constexpr size_t WS_YB = WS_ORAW + 128 * MiB;
constexpr size_t WS_ACT = WS_YB + 64 * MiB;
constexpr size_t WS_YS = WS_ACT + 144 * MiB;
constexpr size_t WS_XG = WS_YS + 256 * MiB;
constexpr size_t WS_UT = WS_XG + 1024 * MiB;
constexpr size_t WS_ST = WS_UT + 128 * MiB;
constexpr size_t WS_KPP = WS_ST + 64 * MiB;
constexpr size_t WS_SC = WS_KPP + 16 * MiB;
constexpr size_t WS_S5KT = WS_SC + 4 * MiB;
constexpr size_t WS_S5VT = WS_S5KT + 2 * MiB;
constexpr size_t WS_S5WT = WS_S5VT + 16 * MiB;
constexpr size_t WS_S5L64 = WS_S5WT + 16 * MiB;
constexpr size_t WS_S5SL = WS_S5L64 + 1 * MiB;
constexpr size_t WS_S5SP = WS_S5SL + 16 * MiB;
constexpr size_t WS_CS = WS_S5SP + 8 * MiB;
constexpr size_t WS_END = WS_CS + 4 * MiB;
constexpr int CW_BAR = 4096;
constexpr int CW_CNT = 16384;

constexpr int PH_BYTES = 139264;
constexpr int TAB_OFF = PH_BYTES;
constexpr int MISC_OFF = TAB_OFF + 16384;
constexpr int LDS_BYTES = 159744;

typedef __bf16 bf16x2_t __attribute__((ext_vector_type(2)));
__device__ __forceinline__ unsigned pk2(float lo, float hi) { const f32x2 v = {lo, hi}; const bf16x2_t b = __builtin_convertvector(v, bf16x2_t); return __builtin_bit_cast(unsigned, b); }
__device__ __forceinline__ unsigned f2bf(float f) { return pk2(f, 0.f) & 0xffffu; }
__device__ __forceinline__ float bf2f(unsigned short b) { return __builtin_bit_cast(float, ((unsigned)b) << 16); }
__device__ __forceinline__ float bflo(unsigned w) { return __builtin_bit_cast(float, w << 16); }
__device__ __forceinline__ float bfhi(unsigned w) { return __builtin_bit_cast(float, w & 0xffff0000u); }
__device__ __forceinline__ int lane_id() { int l; asm volatile("v_mbcnt_lo_u32_b32 %0, -1, 0\n\tv_mbcnt_hi_u32_b32 %0, -1, %0" : "=v"(l)); return l; }
template <int CTRL> __device__ __forceinline__ float dpp_f(float v) { return __builtin_bit_cast(float, __builtin_amdgcn_update_dpp(0, __builtin_bit_cast(int, v), CTRL, 0xf, 0xf, false)); }
__device__ __forceinline__ float rl_f(float v, int l) { return __builtin_bit_cast(float, __builtin_amdgcn_readlane(__builtin_bit_cast(int, v), l)); }
__device__ __forceinline__ float wave_sum(float v) {
    v += dpp_f<0xB1>(v);
    v += dpp_f<0x4E>(v);
    v += dpp_f<0x141>(v);
    v += dpp_f<0x140>(v);
    return (rl_f(v, 0) + rl_f(v, 16)) + (rl_f(v, 32) + rl_f(v, 48));
}
__device__ __forceinline__ float row16_sum(float v) { v += dpp_f<0xB1>(v); v += dpp_f<0x4E>(v); v += dpp_f<0x141>(v); v += dpp_f<0x140>(v); return v; }
__device__ __forceinline__ float wave_max(float v) {
    v = fmaxf(v, dpp_f<0xB1>(v)); v = fmaxf(v, dpp_f<0x4E>(v)); v = fmaxf(v, dpp_f<0x141>(v)); v = fmaxf(v, dpp_f<0x140>(v));
    return fmaxf(fmaxf(rl_f(v, 0), rl_f(v, 16)), fmaxf(rl_f(v, 32), rl_f(v, 48)));
}
__device__ __forceinline__ float sigmoidf_(float x) { return __builtin_amdgcn_rcpf(1.f + __expf(-x)); }
__device__ __forceinline__ float log_sigmoidf_(float x) { return fminf(x, 0.f) - __logf(1.f + __expf(-fabsf(x))); }
__device__ __forceinline__ float gelu_tanh(float x) { const float u = 0.7978845608028654f * (x + 0.044715f * x * x * x); return x * sigmoidf_(2.f * u); }

namespace pg8 {
constexpr int BM = 256, BK = 64, HALF = 128, HTB = HALF * BK * 2, STAGE_BYTES = 8 * HTB, NXCD = 8, WGM = 8;
__host__ __device__ __forceinline__ int lds_byte(int r, int c) { const int st = (r >> 4) * 2 + (c >> 5), rr = r & 15, cc = c & 31, ob = rr * 64 + cc * 2; return st * 1024 + (ob ^ (((ob >> 9) & 1) << 5)); }
__host__ __device__ __forceinline__ void stage_rc(int b, int& R, int& C) { const int st = b / 1024, sb = b % 1024, swz = sb ^ (((sb >> 9) & 1) << 5); R = (st >> 1) * 16 + swz / 64; C = (st & 1) * 32 + (swz % 64) / 2; }
__host__ __device__ __forceinline__ int perm32(int rho) { const int n = rho >> 4, i = rho & 15; return 8 * (i >> 2) + 4 * n + (i & 3); }

struct Unit { const char* A; const char* B; int pm, pn, e, nvalid, r0, buf; };

__device__ __forceinline__ int xcd_remap(int L, int nwg) { const int q = nwg / NXCD, r = nwg % NXCD, xcd = L % NXCD, off = L / NXCD; return (xcd < r ? xcd * (q + 1) : r * (q + 1) + (xcd - r) * q) + off; }

struct DenseOrder {
    const char* A; const char* Bt; int K, nM, nN, nwg, G, c; const int* list; const float* gwl; static constexpr int a_compact = 0;
    __device__ __forceinline__ void init(const void* A_, const void* Bt_, int M_, int N_, int K_, int G_, int c_) { A = (const char*)A_; Bt = (const char*)Bt_; K = K_; nM = M_ / BM; nN = N_ / BM; nwg = nM * nN; G = G_; c = c_; list = nullptr; gwl = nullptr; }
    __device__ __forceinline__ bool next(int i, Unit& u) const {
        const long L = (long)i * G + c; if (L >= nwg) return false;
        const int wgid = xcd_remap((int)L, nwg);
        const int nig = WGM * nN, gid = wgid / nig, fm = gid * WGM, gsz = (nM - fm) < WGM ? (nM - fm) : WGM;
        u.pm = fm + ((wgid % nig) % gsz); u.pn = (wgid % nig) / gsz; u.e = 0; u.nvalid = 256; u.r0 = 0;
        u.A = A + (size_t)u.pm * 256 * K * 2; u.B = Bt + (size_t)u.pn * 256 * K * 2; return true;
    }
};
struct MoeOrder {
    const char* A; const char* Bt; const LAS int* tab;
    int K, nN, ntiles, nwg, G, c; size_t b_estride; int a_compact; const int* list; const float* gwl;
    __device__ __forceinline__ bool next(int i, Unit& u) const {
        const long L = (long)i * G + c; if (L >= nwg) return false;
        const int wgid = xcd_remap((int)L, nwg);
        const int nig = WGM * nN, gid = wgid / nig, fm = gid * WGM, gsz = (ntiles - fm) < WGM ? (ntiles - fm) : WGM;
        const int tl = fm + ((wgid % nig) % gsz); u.pm = tl; u.pn = (wgid % nig) / gsz;
        const int e = __builtin_amdgcn_readfirstlane(tab[72 + tl]); u.e = e; const int r0 = (tl - __builtin_amdgcn_readfirstlane(tab[32 + e])) * 256; const int rem = __builtin_amdgcn_readfirstlane(tab[e]) - r0; u.nvalid = rem < 256 ? rem : 256; u.r0 = r0;
        u.A = (a_compact == 2) ? A : a_compact ? A + (size_t)tl * 256 * K * 2 : A + ((size_t)e * CAP + r0) * K * 2;
        u.B = Bt + (size_t)e * b_estride + (size_t)u.pn * 256 * K * 2; return true;
    }
};

__device__ __forceinline__ unsigned cvt_pk_bf16(float lo, float hi) { unsigned r; asm volatile("v_cvt_pk_bf16_f32 %0, %1, %2" : "=v"(r) : "v"(lo), "v"(hi)); return r; }

struct EpiBf16 {
    static constexpr bool BIASTAB = false; static constexpr bool ROWINFO = false; static constexpr bool PERM = true;
    bf16* O; int ldc; const float* cs; int rot_tiles;
    __device__ __forceinline__ void operator()(const f32x4 (&acc)[2][2][4][2], const Unit& u, int wr, int wc, int fr, int fq) const {
        const int row0 = u.pm * BM + wr * 64 + fr, col0 = u.pn * BM + wc * 32 + 8 * fq;
        const bool rot = u.pn < rot_tiles; const float sc = (col0 >= 1024) ? 0.08838834764831845f : 1.f;
#pragma unroll
        for (int ai = 0; ai < 2; ++ai)
#pragma unroll
            for (int m = 0; m < 4; ++m) { const int row = row0 + ai * HALF + m * 16; bf16* rowp = O + (size_t)row * ldc + col0;
#pragma unroll
                for (int bj = 0; bj < 2; ++bj) { f32x4 v0 = acc[ai][bj][m][0], v1 = acc[ai][bj][m][1];
                    if (rot) { const float* cp = cs + ((size_t)(row & (T - 1)) * 64 + (((col0 + bj * HALF) & 127) >> 1)) * 2; const f32x4 c0 = *(const f32x4*)cp, c1 = *(const f32x4*)(cp + 4);
                        const f32x4 a0 = v0, a1 = v1;
                        v0[0] = (a0[0] * c0[0] - a0[1] * c0[1]) * sc; v0[1] = (a0[0] * c0[1] + a0[1] * c0[0]) * sc; v0[2] = (a0[2] * c0[2] - a0[3] * c0[3]) * sc; v0[3] = (a0[2] * c0[3] + a0[3] * c0[2]) * sc;
                        v1[0] = (a1[0] * c1[0] - a1[1] * c1[1]) * sc; v1[1] = (a1[0] * c1[1] + a1[1] * c1[0]) * sc; v1[2] = (a1[2] * c1[2] - a1[3] * c1[3]) * sc; v1[3] = (a1[2] * c1[3] + a1[3] * c1[2]) * sc; }
                    u32x4 w; w.x = cvt_pk_bf16(v0[0], v0[1]); w.y = cvt_pk_bf16(v0[2], v0[3]); w.z = cvt_pk_bf16(v1[0], v1[1]); w.w = cvt_pk_bf16(v1[2], v1[3]);
                    *(u32x4*)(rowp + bj * HALF) = w; } }
    }
};
struct EpiResid {
    static constexpr bool BIASTAB = false; static constexpr bool ROWINFO = false; static constexpr bool PERM = true;
    const float* __restrict__ hin; const bf16* __restrict__ hinb; bf16* __restrict__ Z;
    __device__ __forceinline__ void operator()(const f32x4 (&acc)[2][2][4][2], const Unit& u, int wr, int wc, int fr, int fq) const {
        const int row0 = u.pm * BM + wr * 64 + fr, col0 = u.pn * BM + wc * 32 + 8 * fq;
#pragma unroll
        for (int ai = 0; ai < 2; ++ai)
#pragma unroll
            for (int m = 0; m < 4; ++m) { const size_t off = (size_t)(row0 + ai * HALF + m * 16) * D + col0;
                f32x4 hv[2][2];
                if (hinb) {
#pragma unroll
                    for (int bj = 0; bj < 2; ++bj) { const u32x4 hw = *(const u32x4*)(hinb + off + bj * HALF);
                        hv[bj][0] = (f32x4){bflo(hw.x), bfhi(hw.x), bflo(hw.y), bfhi(hw.y)}; hv[bj][1] = (f32x4){bflo(hw.z), bfhi(hw.z), bflo(hw.w), bfhi(hw.w)}; }
                } else {
#pragma unroll
                    for (int bj = 0; bj < 2; ++bj)
#pragma unroll
                        for (int n = 0; n < 2; ++n) hv[bj][n] = *(const f32x4*)(hin + off + bj * HALF + n * 4);
                }
#pragma unroll
                for (int bj = 0; bj < 2; ++bj) { const f32x4 v0 = hv[bj][0] * ALPHA + acc[ai][bj][m][0], v1 = hv[bj][1] * ALPHA + acc[ai][bj][m][1];
                    u32x4 w; w.x = cvt_pk_bf16(v0[0], v0[1]); w.y = cvt_pk_bf16(v0[2], v0[3]); w.z = cvt_pk_bf16(v1[0], v1[1]); w.w = cvt_pk_bf16(v1[2], v1[3]);
                    *(u32x4*)(Z + off + bj * HALF) = w; } }
    }
};
struct EpiGlu {
    static constexpr bool BIASTAB = false; static constexpr bool ROWINFO = false; static constexpr bool PERM = true;
    const bf16* Y; const float* bias; bf16* O;
    __device__ __forceinline__ void operator()(const f32x4 (&acc)[2][2][4][2], const Unit& u, int wr, int wc, int fr, int fq) const {
        const int row0 = u.pm * BM + wr * 64 + fr, col0 = u.pn * BM + wc * 32 + 8 * fq;
#pragma unroll
        for (int ai = 0; ai < 2; ++ai)
#pragma unroll
            for (int m = 0; m < 4; ++m) { const size_t off = (size_t)(row0 + ai * HALF + m * 16) * D + col0;
#pragma unroll
                for (int bj = 0; bj < 2; ++bj) {
                    const f32x4 b0 = *(const f32x4*)(bias + col0 + bj * HALF), b1 = *(const f32x4*)(bias + col0 + bj * HALF + 4);
                    const u32x4 yw = *(const u32x4*)(Y + off + bj * HALF);
                    const f32x4 v0 = acc[ai][bj][m][0] + b0, v1 = acc[ai][bj][m][1] + b1;
                    float o[8];
                    o[0] = bflo(yw.x) * sigmoidf_(v0[0]); o[1] = bfhi(yw.x) * sigmoidf_(v0[1]); o[2] = bflo(yw.y) * sigmoidf_(v0[2]); o[3] = bfhi(yw.y) * sigmoidf_(v0[3]);
                    o[4] = bflo(yw.z) * sigmoidf_(v1[0]); o[5] = bfhi(yw.z) * sigmoidf_(v1[1]); o[6] = bflo(yw.w) * sigmoidf_(v1[2]); o[7] = bfhi(yw.w) * sigmoidf_(v1[3]);
                    u32x4 w; w.x = cvt_pk_bf16(o[0], o[1]); w.y = cvt_pk_bf16(o[2], o[3]); w.z = cvt_pk_bf16(o[4], o[5]); w.w = cvt_pk_bf16(o[6], o[7]);
                    *(u32x4*)(O + off + bj * HALF) = w; } }
    }
};
struct EpiSwiglu {
    static constexpr bool BIASTAB = true; static constexpr bool ROWINFO = false; static constexpr bool PERM = true;
    bf16* ACT; const float* bgu; const LAS float* btab;
    __device__ __forceinline__ float bias_at(const Unit& u, int j) const { return bgu[(size_t)u.e * 2 * DFF + (j < HALF ? 0 : DFF) + u.pn * HALF + (j & (HALF - 1))]; }
    __device__ __forceinline__ void operator()(const f32x4 (&acc)[2][2][4][2], const Unit& u, int wr, int wc, int fr, int fq) const {
        const int row0 = u.pm * BM + wr * 64 + fr, j0 = u.pn * HALF + wc * 32 + 8 * fq;
        const LAS float* bt = btab + u.buf * 256 + wc * 32 + 8 * fq;
        const f32x4 g0 = *(const LAS f32x4*)(bt), g1 = *(const LAS f32x4*)(bt + 4), u0 = *(const LAS f32x4*)(bt + HALF), u1 = *(const LAS f32x4*)(bt + HALF + 4);
#pragma unroll
        for (int ai = 0; ai < 2; ++ai)
#pragma unroll
            for (int m = 0; m < 4; ++m) {
                float o[8];
#pragma unroll
                for (int n = 0; n < 2; ++n)
#pragma unroll
                    for (int i = 0; i < 4; ++i) {
                        float g = acc[ai][0][m][n][i] + (n ? g1[i] : g0[i]), up = acc[ai][1][m][n][i] + (n ? u1[i] : u0[i]);
                        g = fminf(g, 7.0f); up = fminf(fmaxf(up, -7.0f), 7.0f);
                        o[n * 4 + i] = (up + 1.0f) * g * sigmoidf_(1.702f * g); }
                u32x4 w; w.x = cvt_pk_bf16(o[0], o[1]); w.y = cvt_pk_bf16(o[2], o[3]); w.z = cvt_pk_bf16(o[4], o[5]); w.w = cvt_pk_bf16(o[6], o[7]);
                *(u32x4*)(ACT + (size_t)(row0 + ai * HALF + m * 16) * DFF + j0) = w; }
    }
};
struct EpiMoeDown {
    static constexpr bool BIASTAB = true; static constexpr bool ROWINFO = true; static constexpr bool PERM = true;
    bf16* YS; const float* bd; const LAS int* rinfo; const LAS float* btab;
    __device__ __forceinline__ float bias_at(const Unit& u, int j) const { return bd[(size_t)u.e * D + u.pn * BM + j]; }
    __device__ __forceinline__ void operator()(const f32x4 (&acc)[2][2][4][2], const Unit& u, int wr, int wc, int fr, int fq) const {
        const int col0 = u.pn * BM + wc * 32 + 8 * fq;
        const LAS float* bt = btab + u.buf * 256 + wc * 32 + 8 * fq;
        f32x4 bv[2][2];
#pragma unroll
        for (int bj = 0; bj < 2; ++bj)
#pragma unroll
            for (int n = 0; n < 2; ++n) bv[bj][n] = *(const LAS f32x4*)(bt + bj * HALF + 4 * n);
        const LAS int* ri = rinfo + u.buf * 512;
#pragma unroll
        for (int ai = 0; ai < 2; ++ai)
#pragma unroll
            for (int m = 0; m < 4; ++m) { const int r = ai * HALF + wr * 64 + m * 16 + fr; const int slot = ri[r];
                if (slot >= 0) { const float gg = __builtin_bit_cast(float, ri[256 + r]); bf16* op = YS + (size_t)slot * D + col0;
#pragma unroll
                    for (int bj = 0; bj < 2; ++bj) { const f32x4 v0 = (acc[ai][bj][m][0] + bv[bj][0]) * gg, v1 = (acc[ai][bj][m][1] + bv[bj][1]) * gg;
                        u32x4 w; w.x = cvt_pk_bf16(v0[0], v0[1]); w.y = cvt_pk_bf16(v0[2], v0[3]); w.z = cvt_pk_bf16(v1[0], v1[1]); w.w = cvt_pk_bf16(v1[2], v1[3]);
                        *(u32x4*)(op + bj * HALF) = w; } } }
    }
};

template <class Epi, class Sched, bool ALIGN_EPI, bool SP2, bool GATHER = false>
__device__ __forceinline__ void gemm_phase(LAS unsigned char* lds, const int wid, const int K, const Sched& S, const Epi& E, LAS int* rowtab = nullptr) {
    const int lane = lane_id(), tid = wid * 64 + lane, wr = wid >> 2, wc = wid & 3, fr = lane & 15, fq = lane >> 4;
    const int nt = K / BK;
    unsigned voffA[2], voffB[2]; int Rr[2]; unsigned Cc2[2];
#pragma unroll
    for (int i = 0; i < 2; ++i) { int R, C; stage_rc(tid * 16 + i * 8192, R, C); const int Rb = Epi::PERM ? ((R & ~31) + perm32(R & 31)) : R;
        voffA[i] = (unsigned)(R * K + C) * 2u; voffB[i] = (unsigned)(Rb * K + C) * 2u; Rr[i] = R; Cc2[i] = (unsigned)C * 2u; }
    unsigned vA[2][2] = {{0u, 0u}, {0u, 0u}}, vN[2][2] = {{0u, 0u}, {0u, 0u}};
    const size_t kstep = (size_t)(BK * 2);
    const size_t hstep = (size_t)HALF * K * 2;
    const unsigned ldsw = (unsigned)wid * 1024u;
    const int aoff = lds_byte(wr * 64 + fr, fq * 8), boff = lds_byte(wc * 32 + fr, fq * 8);
#define PG8_SA(b, h) (((b) * 2 + (h)) * HTB)
#define PG8_SB(b, h) ((4 + (b) * 2 + (h)) * HTB)
#define PG8_STAGE(bufoff, gbase, voff) do { _Pragma("unroll") for (int _i = 0; _i < 2; ++_i) \
        __builtin_amdgcn_global_load_lds((const unsigned*)((const char*)(gbase) + (voff)[_i]), (LAS unsigned*)(lds + (bufoff) + ldsw + _i * 8192), 16, 0, 0); } while (0)
#define PG8_STAGE_A(bufoff, kbase, h, VO) do { if constexpr (GATHER) { PG8_STAGE(bufoff, kbase, (VO)[h]); } else { PG8_STAGE(bufoff, (kbase) + (h) * hstep, voffA); } } while (0)
#define PG8_FILL(buf, U) do { if (tid < 256) { const bool ok_ = tid < (U).nvalid; const int ent_ = (ok_ && (S.a_compact == 2 || Epi::ROWINFO)) ? S.list[(size_t)(U).e * CAP + (U).r0 + tid] : 0; \
        rowtab[(buf) * 256 + tid] = (S.a_compact == 2) ? (ent_ >> 2) * (K * 2) : tid * (K * 2); \
        if constexpr (Epi::ROWINFO) { rowtab[768 + (buf) * 512 + tid] = ok_ ? ent_ : -1; rowtab[768 + (buf) * 512 + 256 + tid] = ok_ ? __builtin_bit_cast(int, S.gwl[(size_t)(U).e * CAP + (U).r0 + tid]) : 0; } } \
        if constexpr (Epi::BIASTAB) { if (tid >= 256) rowtab[2304 + (buf) * 256 + (tid - 256)] = __builtin_bit_cast(int, E.bias_at((U), tid - 256)); } } while (0)
#define PG8_LOADVO(VO, buf) do { _Pragma("unroll") for (int h_ = 0; h_ < 2; ++h_) _Pragma("unroll") for (int i_ = 0; i_ < 2; ++i_) (VO)[h_][i_] = (unsigned)rowtab[(buf) * 256 + h_ * 128 + Rr[i_]] + Cc2[i_]; } while (0)
#define PG8_LDA(dst, b, h) do { _Pragma("unroll") for (int m = 0; m < 4; ++m) _Pragma("unroll") for (int k = 0; k < 2; ++k) dst[m][k] = *(const LAS bf16x8*)(lds + PG8_SA(b, h) + aoff + m * 2048 + k * 1024); } while (0)
#define PG8_LDB(dst, b, h) do { _Pragma("unroll") for (int n = 0; n < 2; ++n) _Pragma("unroll") for (int k = 0; k < 2; ++k) dst[n][k] = *(const LAS bf16x8*)(lds + PG8_SB(b, h) + boff + n * 2048 + k * 1024); } while (0)
#define PG8_MMA(ai, bj, At, Bt) do { __builtin_amdgcn_s_setprio(1); _Pragma("unroll") for (int m = 0; m < 4; ++m) _Pragma("unroll") for (int n = 0; n < 2; ++n) _Pragma("unroll") for (int k = 0; k < 2; ++k) \
        acc[ai][bj][m][n] = __builtin_amdgcn_mfma_f32_16x16x32_bf16(Bt[n][k], At[m][k], acc[ai][bj][m][n], 0, 0, 0); __builtin_amdgcn_s_setprio(0); } while (0)
#define PG8_WAIT_V(n) asm volatile("s_waitcnt vmcnt(" #n ")" ::: "memory")
#define PG8_WAIT_L(n) asm volatile("s_waitcnt lgkmcnt(" #n ")" ::: "memory")
#define PG8_BAR __builtin_amdgcn_s_barrier()
#define PG8_SCHED __builtin_amdgcn_sched_barrier(0)
#define VO_a1 vA
#define VO_cA vA
#define VO_a2 vS
#define VO_a3 vS
    Unit cur, nxt; int ui = 0;
    if (!S.next(0, cur)) return;
    f32x4 acc[2][2][4][2];
#pragma unroll
    for (int a = 0; a < 2; ++a)
#pragma unroll
        for (int b = 0; b < 2; ++b)
#pragma unroll
            for (int m = 0; m < 4; ++m)
#pragma unroll
                for (int n = 0; n < 2; ++n) acc[a][b][m][n] = (f32x4){0.f, 0.f, 0.f, 0.f};
    bf16x8 At[4][2], B0[2][2], B1[2][2];
    const char* cA = cur.A; const char* cB = cur.B;
    cur.buf = 0;
    if constexpr (GATHER) { PG8_FILL(0, cur); asm volatile("s_waitcnt lgkmcnt(0)" ::: "memory"); PG8_BAR; asm volatile("" ::: "memory"); PG8_LOADVO(vA, 0); }
    if constexpr (SP2) {
        PG8_STAGE(PG8_SB(0, 0), cB, voffB); PG8_STAGE(PG8_SB(0, 1), cB + hstep, voffB); PG8_STAGE_A(PG8_SA(0, 0), cA, 0, VO_cA); PG8_STAGE_A(PG8_SA(0, 1), cA, 1, VO_cA);
        if (wr == 1) PG8_BAR;
        PG8_WAIT_V(2); PG8_BAR;
        PG8_STAGE(PG8_SB(1, 0), cB + kstep, voffB); PG8_STAGE_A(PG8_SA(1, 0), cA + kstep, 0, VO_cA); PG8_STAGE(PG8_SB(1, 1), cB + hstep + kstep, voffB);
        PG8_WAIT_V(6); PG8_BAR;
    } else {
        PG8_STAGE(PG8_SB(0, 0), cB, voffB); PG8_STAGE_A(PG8_SA(0, 0), cA, 0, VO_cA); PG8_STAGE(PG8_SB(0, 1), cB + hstep, voffB); PG8_STAGE_A(PG8_SA(0, 1), cA, 1, VO_cA);
        if (wr == 1) PG8_BAR;
        PG8_WAIT_V(4); PG8_BAR;
        PG8_STAGE(PG8_SB(1, 0), cB + kstep, voffB); PG8_STAGE_A(PG8_SA(1, 0), cA + kstep, 0, VO_cA); PG8_STAGE(PG8_SB(1, 1), cB + hstep + kstep, voffB);
        PG8_WAIT_V(6); PG8_BAR;
    }
    for (;;) {
        const bool has_next = S.next(ui + 1, nxt);
        const char* nA = has_next ? nxt.A : cA; const char* nB = has_next ? nxt.B : cB;
        nxt.buf = (ui + 1) % 3;
        if constexpr (GATHER) { if (has_next) PG8_FILL((ui + 1) % 3, nxt); }
        for (int t = 0; t < nt; t += 2) {
            const bool last = (t == nt - 2);
            const char* a1 = cA + (size_t)(t + 1) * kstep;
            const char* a2 = last ? nA : cA + (size_t)(t + 2) * kstep; const char* b2 = last ? nB : cB + (size_t)(t + 2) * kstep;
            const char* a3 = a2 + kstep; const char* b3 = b2 + kstep;
            unsigned vS[2][2];
            if constexpr (GATHER) { if (last && has_next) PG8_LOADVO(vN, (ui + 1) % 3);
#pragma unroll
                for (int h_ = 0; h_ < 2; ++h_)
#pragma unroll
                    for (int i_ = 0; i_ < 2; ++i_) vS[h_][i_] = (last && has_next) ? vN[h_][i_] : vA[h_][i_]; }
            else { vS[0][0] = 0u; vS[0][1] = 0u; vS[1][0] = 0u; vS[1][1] = 0u; }
            if constexpr (SP2) {
            PG8_LDB(B0, 0, 0); PG8_LDB(B1, 0, 1); PG8_SCHED; PG8_LDA(At, 0, 0); PG8_STAGE_A(PG8_SA(1, 1), a1, 1, VO_a1);
            PG8_WAIT_V(8); PG8_WAIT_L(0); PG8_BAR; PG8_MMA(0, 0, At, B0); PG8_MMA(0, 1, At, B1); PG8_BAR; PG8_SCHED;
            PG8_LDA(At, 0, 1); PG8_STAGE(PG8_SB(0, 0), b2, voffB); PG8_STAGE(PG8_SB(0, 1), b2 + hstep, voffB); PG8_STAGE_A(PG8_SA(0, 0), a2, 0, VO_a2);
            PG8_WAIT_V(8); PG8_WAIT_L(0); PG8_BAR; PG8_MMA(1, 0, At, B0); PG8_MMA(1, 1, At, B1); PG8_BAR; PG8_SCHED;
            PG8_LDB(B0, 1, 0); PG8_LDB(B1, 1, 1); PG8_SCHED; PG8_LDA(At, 1, 0); PG8_STAGE_A(PG8_SA(0, 1), a2, 1, VO_a2);
            PG8_WAIT_V(8); PG8_WAIT_L(0); PG8_BAR; PG8_MMA(0, 0, At, B0); PG8_MMA(0, 1, At, B1); PG8_BAR; PG8_SCHED;
            PG8_LDA(At, 1, 1); PG8_STAGE(PG8_SB(1, 0), b3, voffB); PG8_STAGE(PG8_SB(1, 1), b3 + hstep, voffB); PG8_STAGE_A(PG8_SA(1, 0), a3, 0, VO_a3);
            PG8_WAIT_V(8); PG8_WAIT_L(0); PG8_BAR; PG8_MMA(1, 0, At, B0); PG8_MMA(1, 1, At, B1); PG8_BAR; PG8_SCHED;
            } else {
            PG8_LDB(B0, 0, 0); PG8_SCHED; PG8_LDA(At, 0, 0); PG8_STAGE_A(PG8_SA(1, 1), a1, 1, VO_a1);
            PG8_WAIT_L(8); PG8_BAR; PG8_WAIT_L(0); PG8_MMA(0, 0, At, B0); PG8_BAR; PG8_SCHED;
            PG8_LDB(B1, 0, 1); PG8_STAGE(PG8_SB(0, 0), b2, voffB);
            PG8_BAR; PG8_WAIT_L(0); PG8_MMA(0, 1, At, B1); PG8_BAR;
            PG8_LDA(At, 0, 1); PG8_STAGE_A(PG8_SA(0, 0), a2, 0, VO_a2);
            PG8_BAR; PG8_WAIT_L(0); PG8_MMA(1, 0, At, B0); PG8_BAR; PG8_SCHED;
            PG8_STAGE(PG8_SB(0, 1), b2 + hstep, voffB);
            PG8_WAIT_V(6); PG8_BAR; PG8_MMA(1, 1, At, B1); PG8_BAR;
            PG8_LDB(B0, 1, 0); PG8_SCHED; PG8_LDA(At, 1, 0); PG8_STAGE_A(PG8_SA(0, 1), a2, 1, VO_a2);
            PG8_WAIT_L(8); PG8_BAR; PG8_WAIT_L(0); PG8_MMA(0, 0, At, B0); PG8_BAR; PG8_SCHED;
            PG8_LDB(B1, 1, 1); PG8_STAGE(PG8_SB(1, 0), b3, voffB);
            PG8_BAR; PG8_WAIT_L(0); PG8_MMA(0, 1, At, B1); PG8_BAR;
            PG8_LDA(At, 1, 1); PG8_STAGE_A(PG8_SA(1, 0), a3, 0, VO_a3);
            PG8_BAR; PG8_WAIT_L(0); PG8_MMA(1, 0, At, B0); PG8_BAR; PG8_SCHED;
            PG8_STAGE(PG8_SB(1, 1), b3 + hstep, voffB);
            PG8_WAIT_V(6); PG8_BAR; PG8_MMA(1, 1, At, B1); PG8_BAR;
            }
        }
        if constexpr (ALIGN_EPI) { if (wr == 0) PG8_BAR; }
        E(acc, cur, wr, wc, fr, fq);
        if (!has_next) break;
#pragma unroll
        for (int a = 0; a < 2; ++a)
#pragma unroll
            for (int b = 0; b < 2; ++b)
#pragma unroll
                for (int m = 0; m < 4; ++m)
#pragma unroll
                    for (int n = 0; n < 2; ++n) acc[a][b][m][n] = (f32x4){0.f, 0.f, 0.f, 0.f};
        cur = nxt; cA = nA; cB = nB; ++ui;
        if constexpr (GATHER) { vA[0][0] = vN[0][0]; vA[0][1] = vN[0][1]; vA[1][0] = vN[1][0]; vA[1][1] = vN[1][1]; }
        if constexpr (ALIGN_EPI) { if (wr == 1) PG8_BAR; }
    }
    PG8_WAIT_V(0);
    if constexpr (!ALIGN_EPI) { if (wr == 0) PG8_BAR; }
    PG8_BAR;
#undef PG8_SA
#undef PG8_SB
#undef PG8_STAGE
#undef PG8_STAGE_A
#undef PG8_FILL
#undef PG8_LOADVO
#undef VO_a1
#undef VO_cA
#undef VO_a2
#undef VO_a3
#undef PG8_LDA
#undef PG8_LDB
#undef PG8_MMA
#undef PG8_WAIT_V
#undef PG8_WAIT_L
#undef PG8_BAR
#undef PG8_SCHED
}
}

#define XB_TMO      128
#define XB_XCNT(j)  (256  + 64 * (j))
#define XB_XSUB(j)  (1280 + 64 * (j))
#define XB_XGEN(j)  (2304 + 64 * (j))
#define XB_TOP      3328
#define XB_TOPGEN   3392
#define XCD_BAR_WORDS 3456
#define XB_SPIN_CAP (1u << 18)
__device__ __forceinline__ unsigned xb_ld(unsigned* p)              { return __hip_atomic_load(p, __ATOMIC_RELAXED, __HIP_MEMORY_SCOPE_AGENT); }
__device__ __forceinline__ unsigned xb_add(unsigned* p, unsigned v) { return __hip_atomic_fetch_add(p, v, __ATOMIC_RELAXED, __HIP_MEMORY_SCOPE_AGENT); }
__device__ __forceinline__ unsigned xb_xcc_id() { return (unsigned)__builtin_amdgcn_s_getreg((3 << 11) | 20) & 0xFu; }
#define XB_SPIN(cond, bar) do { unsigned _sp = 0; while (cond) { __builtin_amdgcn_s_sleep(1); \
    if ((++_sp & 255u) == 0u) { if (xb_ld(&(bar)[XB_TMO])) break; if (_sp > XB_SPIN_CAP) { atomicAdd(&(bar)[XB_TMO], 1u); break; } } } } while (0)
struct XcdBarrier { unsigned* bar; unsigned x; volatile LAS unsigned* st; };
__device__ __forceinline__ XcdBarrier xcd_barrier_post(unsigned* bar, volatile LAS unsigned* st, bool leader) {
    XcdBarrier b; b.bar = bar; b.x = xb_xcc_id(); b.st = st;
    if (leader) (void)xb_add(&bar[XB_XCNT(b.x)], 1u);
    return b;
}
__device__ __forceinline__ void xcd_barrier_complete(unsigned* bar, unsigned x, unsigned& nloc, unsigned& nx) {
    const unsigned G = gridDim.x * gridDim.y * gridDim.z;
    unsigned sum, cnt, mine, sp = 0u;
    for (;;) {
        sum = 0u; cnt = 0u; mine = 0u;
#pragma unroll
        for (unsigned j = 0; j < 16; ++j) { const unsigned c = xb_ld(&bar[XB_XCNT(j)]); sum += c; cnt += (c > 0u) ? 1u : 0u; mine = (j == x) ? c : mine; }
        if (sum == G) break;
        __builtin_amdgcn_s_sleep(1);
        if ((++sp & 255u) == 0u) { if (xb_ld(&bar[XB_TMO])) break; if (sp > XB_SPIN_CAP) { atomicAdd(&bar[XB_TMO], 1u); break; } }
    }
    nloc = mine > 0u ? mine : 1u; nx = cnt > 0u ? cnt : 1u;
}
__device__ __forceinline__ void xcd_barrier(const XcdBarrier& b, int wave) {
    asm volatile("s_waitcnt vmcnt(0)" ::: "memory");
    __syncthreads();
    if (wave == 0 && lane_id() == 0) {
        unsigned* bar = b.bar;
        __builtin_amdgcn_s_waitcnt(0);
        unsigned nloc = b.st[0], nx = b.st[1];
        if (nloc == 0u) { xcd_barrier_complete(bar, b.x, nloc, nx); b.st[0] = nloc; b.st[1] = nx; }
        const unsigned old = xb_add(&bar[XB_XSUB(b.x)], 1u);
        const unsigned gen = old / nloc;
        if (old + 1u == (gen + 1u) * nloc) {
            __builtin_amdgcn_fence(__ATOMIC_RELEASE, "agent");
            asm volatile("s_waitcnt vmcnt(0)" ::: "memory");
            const unsigned og = xb_add(&bar[XB_TOP], 1u);
            const unsigned tg = og / nx;
            if (og + 1u == (tg + 1u) * nx) xb_add(&bar[XB_TOPGEN], 1u);
            else XB_SPIN(xb_ld(&bar[XB_TOPGEN]) == tg, bar);
            __builtin_amdgcn_fence(__ATOMIC_ACQUIRE, "agent");
            xb_add(&bar[XB_XGEN(b.x)], 1u);
            asm volatile("s_waitcnt vmcnt(0)" ::: "memory");
        } else {
            XB_SPIN(xb_ld(&bar[XB_XGEN(b.x)]) == gen, bar);
            __builtin_amdgcn_fence(__ATOMIC_ACQUIRE, "agent");
            asm volatile("s_waitcnt vmcnt(0)" ::: "memory");
        }
    }
    __syncthreads();
}

struct Args { const float* in[33]; float* out; unsigned char* ws; int ph_lo, ph_hi; };
struct Frame {
    LAS unsigned char* lds;
    int wave, vcu, G, gw, NGW;
};

__device__ __forceinline__ void transpose_item(const float* W, int ldw, int col_off, int K, bf16* WT, int mode, int kb, int nb, LAS unsigned char* scr, int lane) {
    const int k0 = 64 * kb, n0 = 64 * nb;
    const float* src = W + (size_t)k0 * ldw + col_off + n0;
    f32x4 v[16];
#pragma unroll
    for (int i = 0; i < 16; ++i) v[i] = __builtin_nontemporal_load((const f32x4*)(src + (size_t)((lane >> 4) + 4 * i) * ldw + 4 * (lane & 15)));
#pragma unroll
    for (int i = 0; i < 16; ++i) { LAS unsigned* p = (LAS unsigned*)(scr + ((lane >> 4) + 4 * i) * 132 + 8 * (lane & 15)); p[0] = pk2(v[i][0], v[i][1]); p[1] = pk2(v[i][2], v[i][3]); }
    asm volatile("s_waitcnt lgkmcnt(0)" ::: "memory");
    const int c = lane >> 3, nl = lane & 7;
#pragma unroll
    for (int r = 0; r < 8; ++r) { const int n = nl + 8 * r; const LAS unsigned short* s = (const LAS unsigned short*)(scr + (8 * c) * 132 + 2 * n);
        u32x4 o; o.x = (unsigned)s[0] | ((unsigned)s[66] << 16); o.y = (unsigned)s[132] | ((unsigned)s[198] << 16); o.z = (unsigned)s[264] | ((unsigned)s[330] << 16); o.w = (unsigned)s[396] | ((unsigned)s[462] << 16);
        const int ng = n0 + n; int drow = ng; if (mode == 1) { drow = ng < 1024 ? 256 * (ng >> 7) + (ng & 127) : 256 * ((ng - 1024) >> 7) + 128 + (ng & 127); }
        if (mode == 2 && ng < 2048) { const int i_ = ng & 127; drow = (ng & ~127) + (i_ < 64 ? 2 * i_ : 2 * (i_ - 64) + 1); }
        __builtin_nontemporal_store(o, (u32x4*)(WT + (size_t)drow * K + k0 + 8 * c)); }
    asm volatile("s_waitcnt lgkmcnt(0)" ::: "memory");
}

__device__ __forceinline__ void load_cols16(int tid, const float* W, int ldw, int col_off, LAS float* Wt) {
    f32x4 wv[8];
#pragma unroll
    for (int i = 0; i < 8; ++i) { const int q = tid + i * NTHREADS, k = q >> 2, e0 = (q & 3) * 4; wv[i] = *(const f32x4*)(W + (size_t)k * ldw + col_off + e0); }
#pragma unroll
    for (int i = 0; i < 8; ++i) { const int q = tid + i * NTHREADS, k = q >> 2, e0 = (q & 3) * 4;
        Wt[(e0 + 0) * 1028 + k] = wv[i][0]; Wt[(e0 + 1) * 1028 + k] = wv[i][1]; Wt[(e0 + 2) * 1028 + k] = wv[i][2]; Wt[(e0 + 3) * 1028 + k] = wv[i][3]; }
}
__device__ __forceinline__ float row_dot16(const f32x4 (&v)[4], const LAS float* Wt, int lane) {
    float p[16];
#pragma unroll
    for (int e = 0; e < 16; ++e) { float s = 0.f;
#pragma unroll
        for (int j = 0; j < 4; ++j) { const f32x4 w = *(const LAS f32x4*)(Wt + e * 1028 + 4 * (lane + 64 * j)); s += v[j][0] * w[0] + v[j][1] * w[1] + v[j][2] * w[2] + v[j][3] * w[3]; }
        p[e] = s; }
    float a8[8], a4[4], a2[2], r1;
#pragma unroll
    for (int e = 0; e < 8; ++e) { const auto r = __builtin_amdgcn_permlane32_swap(__builtin_bit_cast(unsigned, p[e]), __builtin_bit_cast(unsigned, p[e + 8]), false, false); a8[e] = __builtin_bit_cast(float, (unsigned)r[0]) + __builtin_bit_cast(float, (unsigned)r[1]); }
#pragma unroll
    for (int e = 0; e < 4; ++e) { const auto r = __builtin_amdgcn_permlane16_swap(__builtin_bit_cast(unsigned, a8[e]), __builtin_bit_cast(unsigned, a8[e + 4]), false, false); a4[e] = __builtin_bit_cast(float, (unsigned)r[0]) + __builtin_bit_cast(float, (unsigned)r[1]); }
    { const bool hi = (lane & 8) != 0;
#pragma unroll
      for (int e = 0; e < 2; ++e) { const float mine = hi ? a4[e + 2] : a4[e], theirs = hi ? a4[e] : a4[e + 2]; a2[e] = mine + dpp_f<0x128>(theirs); } }
    { const bool hi = (lane & 4) != 0; const float mine = hi ? a2[1] : a2[0], theirs = hi ? a2[0] : a2[1]; r1 = mine + dpp_f<0x141>(theirs); }
    r1 += dpp_f<0x4E>(r1); r1 += dpp_f<0xB1>(r1);
    return r1;
}
__device__ __forceinline__ void store_row_bf16(bf16* orow, const f32x4 (&v)[4], int lane) {
    unsigned long long* o8 = (unsigned long long*)orow + lane;
#pragma unroll
    for (int j = 0; j < 4; ++j) o8[64 * j] = (unsigned long long)pk2(v[j][0], v[j][1]) | ((unsigned long long)pk2(v[j][2], v[j][3]) << 32);
}
__device__ __forceinline__ void store_row_f32(float* orow, const f32x4 (&v)[4], int lane) {
    f32x4* o = (f32x4*)orow + lane;
#pragma unroll
    for (int j = 0; j < 4; ++j) o[64 * j] = v[j];
}
__device__ __forceinline__ void load_row_f32(const float* row, f32x4 (&v)[4], int lane) {
    const f32x4* p = (const f32x4*)row + lane;
#pragma unroll
    for (int j = 0; j < 4; ++j) v[j] = p[64 * j];
}
__device__ __forceinline__ void ln_row(f32x4 (&v)[4], const f32x4 (&gv)[4], const f32x4 (&bv)[4]) {
    float s = 0.f;
#pragma unroll
    for (int j = 0; j < 4; ++j) s += (v[j][0] + v[j][1]) + (v[j][2] + v[j][3]);
    const float mean = wave_sum(s) * (1.f / D); float s2 = 0.f;
#pragma unroll
    for (int j = 0; j < 4; ++j) { v[j] = v[j] - mean; s2 += (v[j][0] * v[j][0] + v[j][1] * v[j][1]) + (v[j][2] * v[j][2] + v[j][3] * v[j][3]); }
    const float rstd = __builtin_amdgcn_rsqf(wave_sum(s2) * (1.f / D) + LN_EPS);
#pragma unroll
    for (int j = 0; j < 4; ++j) v[j] = v[j] * rstd * gv[j] + bv[j];
}

__device__ __forceinline__ const float* inp_ptr(LAS unsigned char* lds, int i) {
    const LAS unsigned* p = (const LAS unsigned*)(lds + MISC_OFF + 256) + 2 * i;
    const unsigned lo = __builtin_amdgcn_readfirstlane(p[0]), hi = __builtin_amdgcn_readfirstlane(p[1]);
    return (const float*)(const GAS float*)(((unsigned long long)hi << 32) | lo);
}

__device__ __forceinline__ void stamp_fn(LAS unsigned char* lds, int wave, int k) {
    if (blockIdx.x == 0 && wave == 0 && lane_id() == 0) { volatile LAS unsigned long long* st = (volatile LAS unsigned long long*)(lds + MISC_OFF + 1024);
        const unsigned long long now = __builtin_amdgcn_s_memrealtime(); if (k >= PROBE_T && k <= PROBE_T2) st[1] = st[1] + (now - st[0]); st[0] = now; }
}
typedef short s16x4 __attribute__((ext_vector_type(4)));
typedef short v4i16_t __attribute__((ext_vector_type(4)));
constexpr int CL = 128, NCH = T / CL;
template <int MODE> struct MX;
template <> struct MX<0> { static constexpr int NH = 8, DK = 64,  DV = 128, LDP = 3072, KOFF = 512,  VOFF = 1024, GOFF = 2048; };
template <> struct MX<1> { static constexpr int NH = 8, DK = 128, DV = 256, LDP = 6144, KOFF = 1024, VOFF = 2048, GOFF = 4096; };
template <> struct MX<2> { static constexpr int NH = 4, DK = 128, DV = 256, LDP = 3072, KOFF = 512,  VOFF = 1024, GOFF = 2048; };
__device__ __forceinline__ s16x4 ds_tr(const LAS unsigned char* p) { return __builtin_bit_cast(s16x4, __builtin_amdgcn_ds_read_tr16_b64_v4i16((LAS v4i16_t*)p)); }
__device__ __forceinline__ bf16x8 tr_frag(const LAS unsigned char* base, int pitch, int k0, int n0, int lane) {
    const int g = lane >> 4, q = (lane & 15) >> 2, p = lane & 3;
    const LAS unsigned char* a = base + (k0 + 4 * g + q) * pitch + (n0 + 4 * p) * 2;
    const s16x4 r1 = ds_tr(a), r2 = ds_tr(a + 16 * pitch);
    bf16x8 f; f[0] = r1[0]; f[1] = r1[1]; f[2] = r1[2]; f[3] = r1[3]; f[4] = r2[0]; f[5] = r2[1]; f[6] = r2[2]; f[7] = r2[3]; return f;
}
__device__ __forceinline__ u32x4 scale_bf16x8(u32x4 v, float sc) {
    u32x4 o; o.x = pk2(bflo(v.x) * sc, bfhi(v.x) * sc); o.y = pk2(bflo(v.y) * sc, bfhi(v.y) * sc); o.z = pk2(bflo(v.z) * sc, bfhi(v.z) * sc); o.w = pk2(bflo(v.w) * sc, bfhi(v.w) * sc); return o;
}
__device__ __forceinline__ float ret_lg2gamma(int h) { return log2f(1.f - exp2f(-5.f - (float)h)); }

template <int MODE>
__device__ __forceinline__ void mix_phaseA(const Frame& F, unsigned char* ws, const int tid, const int lane) {
    typedef MX<MODE> C; constexpr int DK = C::DK, DV = C::DV, NH = C::NH, LDP = C::LDP, KP = DK * 2 + 32, VP = DV * 2 + 32, ETW = DV / 128, NDT = DK / 16;
    LAS unsigned char* ldsK = F.lds; LAS unsigned char* ldsV = F.lds + 128 * KP; LAS float* rsc = (LAS float*)(F.lds + 128 * KP + 128 * VP);
    const bf16* PB = (const bf16*)(ws + WS_PB); const bf16* KPP = (const bf16*)(ws + WS_KPP); bf16* UT = (bf16*)(ws + WS_UT);
    const float* GSC = (const float*)(ws + WS_SC); float* NLOC = (float*)(ws + WS_SC + 2 * MiB);
    const float* LAp = (const float*)(ws + WS_LA); float* DECp = (float*)(ws + WS_SC + 3 * MiB);
    const int w = F.wave, g = lane >> 4;
    for (int u = blockIdx.x; u < 2 * NH * NCH; u += F.G) {
        const int c = u % NCH, bh = u / NCH, h = bh % NH, b = bh / NH; const size_t row0 = (size_t)b * T + (size_t)c * CL;
        u32x4 kr[DK / 32], vr[DV / 32];
        f32x2 cs[16]; unsigned qv[16], kv[16];
        const size_t gr0 = row0 + 16 * w; const int gch = h * 128 + 2 * lane;
        if (MODE == 2) {
#pragma unroll
            for (int i = 0; i < 16; ++i) { cs[i] = *(const f32x2*)(LAp + (gr0 + i) * 512 + gch); qv[i] = *(const unsigned*)(PB + (gr0 + i) * 3072 + gch); kv[i] = *(const unsigned*)(PB + (gr0 + i) * 3072 + 512 + gch); }
        } else {
#pragma unroll
            for (int i = 0; i < DK / 32; ++i) { const int p = tid + i * NTHREADS, r = p / (DK / 8), cp = p % (DK / 8);
                kr[i] = *(const u32x4*)(PB + (row0 + r) * LDP + C::KOFF + h * DK + cp * 8); }
        }
#pragma unroll
        for (int i = 0; i < DV / 32; ++i) { const int p = tid + i * NTHREADS, r = p / (DV / 8), cp = p % (DV / 8);
            vr[i] = *(const u32x4*)(PB + (row0 + r) * LDP + C::VOFF + h * DV + cp * 8); }
        float gmax = 0.f; if (MODE == 0) gmax = GSC[(size_t)(2 * 16 + bh) * T + c * CL + 127];
        const float lgh = (MODE == 1) ? ret_lg2gamma(h) : 0.f;
        __syncthreads();
        if (MODE == 2) {
            LAS float* tot = rsc;
#pragma unroll
            for (int i = 1; i < 16; ++i) cs[i] += cs[i - 1];
            *(LAS f32x2*)(tot + w * 128 + 2 * lane) = cs[15];
            __syncthreads();
            f32x2 pre = (f32x2){0.f, 0.f}, bend = (f32x2){0.f, 0.f};
#pragma unroll
            for (int w2 = 0; w2 < NWAVES; ++w2) { const f32x2 tw = *(const LAS f32x2*)(tot + w2 * 128 + 2 * lane); bend += tw; if (w2 < w) pre += tw; }
            bf16* PBw = (bf16*)(ws + WS_PB);
#pragma unroll
            for (int i = 0; i < 16; ++i) { const float b0 = pre[0] + cs[i][0], b1 = pre[1] + cs[i][1];
                const float q0 = bflo(qv[i]), q1 = bfhi(qv[i]), k0 = bflo(kv[i]) * 0.08838834764831845f, k1 = bfhi(kv[i]) * 0.08838834764831845f;
                *(unsigned*)(PBw + (gr0 + i) * 3072 + gch) = pk2(q0 * __expf(b0), q1 * __expf(b1));
                *(unsigned*)(PBw + (gr0 + i) * 3072 + 512 + gch) = pk2(k0 * __expf(-b0), k1 * __expf(-b1));
                *(LAS unsigned*)(ldsK + (16 * w + i) * KP + lane * 4) = pk2(k0 * __expf(bend[0] - b0), k1 * __expf(bend[1] - b1)); }
            if (w == 0) *(f32x2*)(DECp + (size_t)(b * NCH + c) * 512 + gch) = (f32x2){__expf(bend[0]), __expf(bend[1])};
        } else {
#pragma unroll
            for (int i = 0; i < DK / 32; ++i) { const int p = tid + i * NTHREADS, r = p / (DK / 8), cp = p % (DK / 8);
                u32x4 v = kr[i];
                if (MODE == 0) v = scale_bf16x8(v, __expf(GSC[(size_t)(1 * 16 + bh) * T + c * CL + r] - gmax));
                if (MODE == 1) v = scale_bf16x8(v, exp2f((float)(127 - r) * lgh));
                *(LAS u32x4*)(ldsK + r * KP + cp * 16) = v; }
        }
#pragma unroll
        for (int i = 0; i < DV / 32; ++i) { const int p = tid + i * NTHREADS, r = p / (DV / 8), cp = p % (DV / 8); *(LAS u32x4*)(ldsV + r * VP + cp * 16) = vr[i]; }
        __syncthreads();
        f32x4 acc[ETW][NDT];
#pragma unroll
        for (int i = 0; i < ETW; ++i)
#pragma unroll
            for (int j = 0; j < NDT; ++j) acc[i][j] = (f32x4){0.f, 0.f, 0.f, 0.f};
#pragma unroll
        for (int ks = 0; ks < 4; ++ks) {
            bf16x8 af[ETW], bfv[NDT];
#pragma unroll
            for (int i = 0; i < ETW; ++i) af[i] = tr_frag(ldsV, VP, 32 * ks, (w * ETW + i) * 16, lane);
#pragma unroll
            for (int j = 0; j < NDT; ++j) bfv[j] = tr_frag(ldsK, KP, 32 * ks, j * 16, lane);
#pragma unroll
            for (int i = 0; i < ETW; ++i)
#pragma unroll
                for (int j = 0; j < NDT; ++j) acc[i][j] = __builtin_amdgcn_mfma_f32_16x16x32_bf16(bfv[j], af[i], acc[i][j], 0, 0, 0);
        }
        bf16* ut = UT + (size_t)u * DV * DK;
#pragma unroll
        for (int i = 0; i < ETW; ++i)
#pragma unroll
            for (int j = 0; j < NDT; ++j)
                { uint2 o; o.x = pk2(acc[i][j][0], acc[i][j][1]); o.y = pk2(acc[i][j][2], acc[i][j][3]); *(uint2*)(ut + (size_t)((w * ETW + i) * 16 + (lane & 15)) * DK + j * 16 + 4 * g) = o; }
        if (MODE == 0) {
            float sacc = 0.f;
#pragma unroll
            for (int r = 0; r < 16; ++r) sacc += bf2f(*(const LAS unsigned short*)(ldsK + (16 * w + r) * KP + lane * 2));
            rsc[w * 64 + lane] = sacc;
            __syncthreads();
            if (tid < 64) { float t = 0.f;
#pragma unroll
                for (int q = 0; q < NWAVES; ++q) t += rsc[q * 64 + tid];
                NLOC[(size_t)u * 64 + tid] = t; } }
    }
    __syncthreads();
}

template <int MODE>
__device__ __forceinline__ void mix_phaseB(const Frame& F, unsigned char* ws, const int tid) {
    typedef MX<MODE> C; constexpr int DK = C::DK, DV = C::DV, NH = C::NH, NEL = DV * DK, NBH = 2 * NH;
    const bf16* UT = (const bf16*)(ws + WS_UT); bf16* ST = (bf16*)(ws + WS_ST);
    const float* GSC = (const float*)(ws + WS_SC); const float* NLOC = (const float*)(ws + WS_SC + 2 * MiB); float* NPREV = (float*)(ws + WS_SC + 2 * MiB + 256 * 1024);
    float* MPREV = (float*)(ws + WS_SC + 2 * MiB + 512 * 1024); const float* DEC = (const float*)(ws + WS_SC + 3 * MiB);
    const int gtid = blockIdx.x * NTHREADS + tid, nthr = F.G * NTHREADS;
    for (int el8 = gtid; el8 < NBH * NEL / 8; el8 += nthr) {
        const int el = el8 * 8, bh = el / NEL, idx = el - bh * NEL, h = bh % NH, b = bh / NH;
        float S[8]; float m = -1e30f;
#pragma unroll
        for (int q = 0; q < 8; ++q) S[q] = 0.f;
        const float rdec = (MODE == 1) ? exp2f(128.f * ret_lg2gamma(h)) : 1.f;
#pragma unroll 1
        for (int c0 = 0; c0 < NCH; c0 += 8) {
            u32x4 uv[8];
#pragma unroll
            for (int i = 0; i < 8; ++i) uv[i] = *(const u32x4*)(UT + (size_t)(bh * NCH + c0 + i) * NEL + idx);
#pragma unroll
            for (int i = 0; i < 8; ++i) { const int c = c0 + i; const size_t u = (size_t)bh * NCH + c;
                u32x4 o; o.x = pk2(S[0], S[1]); o.y = pk2(S[2], S[3]); o.z = pk2(S[4], S[5]); o.w = pk2(S[6], S[7]);
                *(u32x4*)(ST + u * NEL + idx) = o;
                const float u0 = bflo(uv[i].x), u1 = bfhi(uv[i].x), u2 = bflo(uv[i].y), u3 = bfhi(uv[i].y), u4 = bflo(uv[i].z), u5 = bfhi(uv[i].z), u6 = bflo(uv[i].w), u7 = bfhi(uv[i].w);
                if (MODE == 0) { const float atot = GSC[(size_t)(0 * 16 + bh) * T + c * CL + 127], mloc = atot + GSC[(size_t)(2 * 16 + bh) * T + c * CL + 127];
                    const float mnew = fmaxf(atot + m, mloc), so = __expf(atot + m - mnew), sl = __expf(mloc - mnew);
                    if (idx == 0) MPREV[u] = m;
                    S[0] = so * S[0] + sl * u0; S[1] = so * S[1] + sl * u1; S[2] = so * S[2] + sl * u2; S[3] = so * S[3] + sl * u3;
                    S[4] = so * S[4] + sl * u4; S[5] = so * S[5] + sl * u5; S[6] = so * S[6] + sl * u6; S[7] = so * S[7] + sl * u7; m = mnew; }
                else if (MODE == 1) { S[0] = rdec * S[0] + u0; S[1] = rdec * S[1] + u1; S[2] = rdec * S[2] + u2; S[3] = rdec * S[3] + u3; S[4] = rdec * S[4] + u4; S[5] = rdec * S[5] + u5; S[6] = rdec * S[6] + u6; S[7] = rdec * S[7] + u7; }
                else { const float* dp = DEC + (size_t)(b * NCH + c) * 512 + h * 128 + (idx & 127); const f32x4 d0 = *(const f32x4*)dp, d1 = *(const f32x4*)(dp + 4);
                    S[0] = d0[0] * S[0] + u0; S[1] = d0[1] * S[1] + u1; S[2] = d0[2] * S[2] + u2; S[3] = d0[3] * S[3] + u3; S[4] = d1[0] * S[4] + u4; S[5] = d1[1] * S[5] + u5; S[6] = d1[2] * S[6] + u6; S[7] = d1[3] * S[7] + u7; } }
        }
    }
    if (MODE == 0) {
        for (int el = gtid; el < NBH * 64; el += nthr) { const int bh = el >> 6, d = el & 63; float S = 0.f, m = -1e30f;
#pragma unroll 1
            for (int c0 = 0; c0 < NCH; c0 += 8) { float at[8], gm[8], nl[8];
#pragma unroll
                for (int i = 0; i < 8; ++i) { const int c = c0 + i; at[i] = GSC[(size_t)(0 * 16 + bh) * T + c * CL + 127]; gm[i] = GSC[(size_t)(2 * 16 + bh) * T + c * CL + 127]; nl[i] = NLOC[((size_t)bh * NCH + c) * 64 + d]; }
#pragma unroll
                for (int i = 0; i < 8; ++i) { const size_t u = (size_t)bh * NCH + c0 + i; const float atot = at[i], mloc = atot + gm[i];
                    const float mnew = fmaxf(atot + m, mloc), so = __expf(atot + m - mnew), sl = __expf(mloc - mnew);
                    NPREV[u * 64 + d] = S; S = so * S + sl * nl[i]; m = mnew; } } }
    }
}

template <int MODE>
__device__ __forceinline__ void mix_phaseC(const Frame& F, unsigned char* ws, const int tid, const int lane, const float* ng) {
    typedef MX<MODE> C; constexpr int DK = C::DK, DV = C::DV, NH = C::NH, LDP = C::LDP, VP = DV * 2 + 32, KP = DK * 2 + 16, SP = DK * 2 + 16, NET = DV / 16, NKS = DK / 32, DVT = NH * DV;
    constexpr int NSP = DV * DK / 8 / NTHREADS;
    LAS unsigned char* ldsV = F.lds; LAS unsigned char* ldsK = F.lds + 128 * VP; LAS unsigned char* ldsS = F.lds;
    LAS float* tabs = (LAS float*)(F.lds + 128 * VP + 128 * KP);
    static_assert(DV * SP <= 128 * VP + 128 * KP, "S^T image fits the stage-1 region");
    const bf16* PB = (const bf16*)(ws + WS_PB); const bf16* ST = (const bf16*)(ws + WS_ST);
    const float* GSC = (const float*)(ws + WS_SC); const float* NPREV = (const float*)(ws + WS_SC + 2 * MiB + 256 * 1024); const float* MPREV = (const float*)(ws + WS_SC + 2 * MiB + 512 * 1024);
    const int w = F.wave, g = lane >> 4, li = lane & 15;
    constexpr int NU = 2 * NH * NCH;
    u32x4 kr[DK / 32], vr[DV / 32], sreg[NSP];
#define PC_LOAD_KV(U_) do { const int c_ = (U_) % NCH, bh_ = (U_) / NCH, h_ = bh_ % NH, b_ = bh_ / NH; const char* pb_ = (const char*)(PB + ((size_t)b_ * T + (size_t)c_ * CL) * LDP); \
        const char* vb_ = pb_ + (C::VOFF + h_ * DV) * 2; const char* kb_ = pb_ + (C::KOFF + h_ * DK) * 2; int t_ = tid; asm volatile("" : "+v"(t_));     \
        _Pragma("unroll") for (int i = 0; i < DV / 32; ++i) { const int p = t_ + i * NTHREADS, r = p / (DV / 8), cp = p % (DV / 8); vr[i] = *(const u32x4*)(vb_ + (unsigned)(r * LDP + cp * 8) * 2u); } \
        _Pragma("unroll") for (int i = 0; i < DK / 32; ++i) { const int p = t_ + i * NTHREADS, r = p / (DK / 8), cp = p % (DK / 8); kr[i] = *(const u32x4*)(kb_ + (unsigned)(r * LDP + cp * 8) * 2u); } } while (0)
#define PC_LOAD_S(U_) do { const bf16* st_ = ST + (size_t)(U_) * DV * DK; _Pragma("unroll") for (int i = 0; i < NSP; ++i) sreg[i] = *(const u32x4*)(st_ + (size_t)(tid + i * NTHREADS) * 8); } while (0)
    if ((int)blockIdx.x < NU) { PC_LOAD_KV((int)blockIdx.x); }
    for (int u = blockIdx.x; u < NU; u += F.G) {
        const int c = u % NCH, bh = u / NCH, h = bh % NH, b = bh / NH; const size_t row0 = (size_t)b * T + (size_t)c * CL;
        const float lg = (MODE == 1) ? ret_lg2gamma(h) : 0.f;
        PC_LOAD_S(u);
        __syncthreads();
#pragma unroll
        for (int i = 0; i < DV / 32; ++i) { const int p = tid + i * NTHREADS, r = p / (DV / 8), cp = p % (DV / 8); *(LAS u32x4*)(ldsV + r * VP + cp * 16) = vr[i]; }
#pragma unroll
        for (int i = 0; i < DK / 32; ++i) { const int p = tid + i * NTHREADS, r = p / (DK / 8), cp = p % (DK / 8); *(LAS u32x4*)(ldsK + r * KP + cp * 16) = kr[i]; }
        if (u + F.G < NU) PC_LOAD_KV(u + F.G);
        if (MODE == 0 && tid < 128) { const float mp = MPREV[u]; const size_t gi = (size_t)bh * T + c * CL + tid;
            const float a = GSC[(size_t)(0 * 16) * T + gi], gg = GSC[(size_t)(1 * 16) * T + gi], cm = GSC[(size_t)(2 * 16) * T + gi];
            const float Mt = fmaxf(mp, cm);
            tabs[tid] = gg; tabs[128 + tid] = Mt; tabs[256 + tid] = __expf(mp - Mt) * 0.125f; tabs[384 + tid] = __expf(-(a + Mt)); }
        __syncthreads();
        const int tq = 16 * w + li;
        const bf16* qrow = PB + (row0 + tq) * LDP + h * DK;
        bf16x8 qf[NKS];
#pragma unroll
        for (int ks = 0; ks < NKS; ++ks) qf[ks] = *(const bf16x8*)(qrow + 32 * ks + 8 * g);
        f32x4 O[NET];
#pragma unroll
        for (int et = 0; et < NET; ++et) O[et] = (f32x4){0.f, 0.f, 0.f, 0.f};
        float den = 0.f;
        const float Mq = (MODE == 0) ? tabs[128 + tq] : 0.f;
        const float qs = (MODE == 0) ? tabs[256 + tq] : (MODE == 1) ? exp2f((float)(tq + 1) * lg) : 1.f;
        const float fin = (MODE == 0) ? tabs[384 + tq] : 1.f;
        for (int jp = 0; jp <= (w >> 1); ++jp) {
            f32x4 p0 = (f32x4){0.f, 0.f, 0.f, 0.f}, p1 = (f32x4){0.f, 0.f, 0.f, 0.f};
            const LAS unsigned char* k0p = ldsK + (32 * jp + li) * KP + 16 * g;
#pragma unroll
            for (int ks = 0; ks < NKS; ++ks) p0 = __builtin_amdgcn_mfma_f32_16x16x32_bf16(*(const LAS bf16x8*)(k0p + 64 * ks), qf[ks], p0, 0, 0, 0);
            if (2 * jp + 1 <= w) {
#pragma unroll
                for (int ks = 0; ks < NKS; ++ks) p1 = __builtin_amdgcn_mfma_f32_16x16x32_bf16(*(const LAS bf16x8*)(k0p + 16 * KP + 64 * ks), qf[ks], p1, 0, 0, 0);
            }
#pragma unroll
            for (int r = 0; r < 4; ++r) {
                const int s0 = 32 * jp + 4 * g + r, s1 = s0 + 16;
                float f0, f1;
                if (MODE == 0) { f0 = __expf(tabs[s0] - Mq) * 0.125f; f1 = __expf(tabs[s1] - Mq) * 0.125f; }
                else if (MODE == 1) { f0 = exp2f((float)(tq - s0) * lg); f1 = exp2f((float)(tq - s1) * lg); }
                else { f0 = 1.f; f1 = 1.f; }
                p0[r] = (s0 <= tq) ? p0[r] * f0 : 0.f; p1[r] = (s1 <= tq) ? p1[r] * f1 : 0.f;
                den += p0[r] + p1[r];
            }
            bf16x8 af; { const unsigned a0 = pk2(p0[0], p0[1]), a1 = pk2(p0[2], p0[3]), a2 = pk2(p1[0], p1[1]), a3 = pk2(p1[2], p1[3]); u32x4 t4; t4.x = a0; t4.y = a1; t4.z = a2; t4.w = a3; af = __builtin_bit_cast(bf16x8, t4); }
#pragma unroll
            for (int et = 0; et < NET; ++et) O[et] = __builtin_amdgcn_mfma_f32_16x16x32_bf16(af, tr_frag(ldsV, VP, 32 * jp, 16 * et, lane), O[et], 0, 0, 0);
        }
        __syncthreads();
#pragma unroll
        for (int i = 0; i < NSP; ++i) { const int p = tid + i * NTHREADS, e = p / (DK / 8), cp = p % (DK / 8); *(LAS u32x4*)(ldsS + e * SP + cp * 16) = sreg[i]; }
        __syncthreads();
        float dint = 0.f;
#pragma unroll
        for (int ks = 0; ks < NKS; ++ks) {
            bf16x8 aq = qf[ks];
            if (MODE != 2) aq = __builtin_bit_cast(bf16x8, scale_bf16x8(__builtin_bit_cast(u32x4, qf[ks]), qs));
            if (MODE == 0) { const float* np = NPREV + (size_t)u * 64 + 32 * ks + 8 * g; const u32x4 qa = __builtin_bit_cast(u32x4, aq);
                dint += bflo(qa.x) * np[0] + bfhi(qa.x) * np[1] + bflo(qa.y) * np[2] + bfhi(qa.y) * np[3] + bflo(qa.z) * np[4] + bfhi(qa.z) * np[5] + bflo(qa.w) * np[6] + bfhi(qa.w) * np[7]; }
#pragma unroll
            for (int et = 0; et < NET; ++et) O[et] = __builtin_amdgcn_mfma_f32_16x16x32_bf16(aq, *(const LAS bf16x8*)(ldsS + (16 * et + li) * SP + 64 * ks + 16 * g), O[et], 0, 0, 0);
        }
        float rd[4] = {1.f, 1.f, 1.f, 1.f};
        if (MODE == 0) {
            float dt = den + dint; dt += __shfl_xor(dt, 16); dt += __shfl_xor(dt, 32);
            LAS float* wsc = tabs + 512 + 16 * w;
            if (g == 0) wsc[li] = __builtin_amdgcn_rcpf(fmaxf(fabsf(dt), fin));
            asm volatile("s_waitcnt lgkmcnt(0)" ::: "memory");
#pragma unroll
            for (int r = 0; r < 4; ++r) rd[r] = wsc[4 * g + r];
        }
        float mean[4], rstd[4];
#pragma unroll
        for (int r = 0; r < 4; ++r) { float sacc = 0.f;
#pragma unroll
            for (int et = 0; et < NET; ++et) { O[et][r] *= rd[r]; sacc += O[et][r]; }
            sacc = row16_sum(sacc);
            mean[r] = sacc * (1.f / DV); float q = 0.f;
#pragma unroll
            for (int et = 0; et < NET; ++et) { const float dlt = O[et][r] - mean[r]; q += dlt * dlt; }
            q = row16_sum(q);
            rstd[r] = __builtin_amdgcn_rsqf(q * (1.f / DV) + LN_EPS); }
        bf16* YBp = (bf16*)(ws + WS_YB);
        constexpr int RPF = DV * 2 + 16, TB = (MODE == 0) ? (128 * VP + 128 * KP + 2560) : DV * SP;
        static_assert(TB + NWAVES * 16 * RPF <= PH_BYTES && TB % 16 == 0, "epilogue tiles fit");
        LAS unsigned char* tw = F.lds + TB + w * (16 * RPF);
        const float* ngp = ng + h * DV + li;
        const int rr = lane >> 3, pq = lane & 7;
        const bf16* gpr = PB + (row0 + 16 * w + rr) * LDP + C::GOFF + h * DV + pq * 8; bf16* ypr = YBp + (row0 + 16 * w + rr) * DVT + h * DV + pq * 8;
        asm volatile("" : "+v"(gpr), "+v"(ypr));
#define GATEF(x_) ((MODE == 0) ? sigmoidf_(x_) : (x_) * sigmoidf_(x_))
#pragma unroll
        for (int hf = 0; hf < 2; ++hf) {
#pragma unroll
            for (int e2 = 0; e2 < NET / 2; ++e2) { const int et = hf * (NET / 2) + e2; const float gn = ngp[16 * et];
#pragma unroll
                for (int r = 0; r < 4; ++r) *(LAS float*)(tw + (4 * g + r) * RPF + (16 * e2 + li) * 4) = (O[et][r] - mean[r]) * rstd[r] * gn; }
            asm volatile("s_waitcnt lgkmcnt(0)" ::: "memory");
#pragma unroll
            for (int it = 0; it < DV / 64; ++it) { const int rb = 8 * (it & 1), cb = 64 * (it >> 1);
                const u32x4 gv = *(const u32x4*)(gpr + (size_t)rb * LDP + hf * (DV / 2) + cb);
                const LAS float* tp = (const LAS float*)(tw + (rb + rr) * RPF + (cb + pq * 8) * 4);
                const f32x4 n0 = *(const LAS f32x4*)tp, n1 = *(const LAS f32x4*)(tp + 4);
                const float g0 = bflo(gv.x), g1 = bfhi(gv.x), g2 = bflo(gv.y), g3 = bfhi(gv.y), g4 = bflo(gv.z), g5 = bfhi(gv.z), g6 = bflo(gv.w), g7 = bfhi(gv.w);
                u32x4 o; o.x = pk2(GATEF(g0) * n0[0], GATEF(g1) * n0[1]); o.y = pk2(GATEF(g2) * n0[2], GATEF(g3) * n0[3]);
                o.z = pk2(GATEF(g4) * n1[0], GATEF(g5) * n1[1]); o.w = pk2(GATEF(g6) * n1[2], GATEF(g7) * n1[3]);
                *(u32x4*)(ypr + (size_t)rb * DVT + hf * (DV / 2) + cb) = o; }
            asm volatile("s_waitcnt lgkmcnt(0)" ::: "memory");
        }
#undef GATEF
    }
    __syncthreads();
#undef PC_LOAD_KV
#undef PC_LOAD_S
}

constexpr int SLN = 32, NCI = T / SLN, NI = 2 * NCI, NRT = NI / 16, SKK = SLN * 16;
__device__ __forceinline__ void s5_pow(const f32x4 cf, float n, float& pr, float& pi) { const float e = __expf(n * cf[0]); const float a = n * cf[1]; pr = e * __cosf(a); pi = e * __sinf(a); }

__device__ __forceinline__ void s5_tables(const Frame& F, unsigned char* ws, const int tid, const float* lam_re, const float* lam_im, const float* b_re, const float* b_im, const float* c_re, const float* c_im, const float* log_dt) {
    bf16* KT = (bf16*)(ws + WS_S5KT); bf16* VT = (bf16*)(ws + WS_S5VT); bf16* WT = (bf16*)(ws + WS_S5WT); float* L64 = (float*)(ws + WS_S5L64);
    LAS f32x4* CF = (LAS f32x4*)F.lds;
    for (int i = tid; i < 64 * 64; i += NTHREADS) { const int g = i >> 6; const float lr = lam_re[i], li = lam_im[i], dt = expf(log_dt[g]);
        const float er = expf(lr * dt); float sn, cs; sincosf(li * dt, &sn, &cs);
        const float nr = er * cs - 1.f, ni = er * sn, den = lr * lr + li * li;
        CF[i] = (f32x4){lr * dt, li * dt, (nr * lr + ni * li) / den, (ni * lr - nr * li) / den}; }
    __syncthreads();
    const int gt = blockIdx.x * NTHREADS + tid, nthr = F.G * NTHREADS;
    LAS float* BR = (LAS float*)(F.lds + 65536); LAS float* BI = BR + 1024; LAS float* CR = BI + 1024; LAS float* CI = CR + 1024;
    for (int i0 = blockIdx.x * NTHREADS; i0 < 64 * SLN * 16 * 4; i0 += nthr) {
        const int g = i0 / (64 * SLN);
        __syncthreads();
        for (int q = tid; q < 1024; q += NTHREADS) { BR[q] = b_re[(size_t)g * 1024 + q]; BI[q] = b_im[(size_t)g * 1024 + q]; CR[q] = c_re[(size_t)g * 1024 + q]; CI[q] = c_im[(size_t)g * 1024 + q]; }
        __syncthreads();
        const int i4 = i0 + tid, pq = i4 & 3, idx = i4 >> 2, h = idx & 15, tau = (idx >> 4) % SLN;
        float acc[16];
#pragma unroll
        for (int q = 0; q < 16; ++q) acc[q] = 0.f;
#pragma unroll 4
        for (int p = pq * 16; p < pq * 16 + 16; ++p) { const f32x4 cf = CF[g * 64 + p]; float pr, pi; s5_pow(cf, (float)tau, pr, pi);
            const float cr = CR[h * 64 + p], ci = CI[h * 64 + p];
            const float xr = cr * pr - ci * pi, xi = cr * pi + ci * pr;
            const float yr = xr * cf[2] - xi * cf[3], yi = xr * cf[3] + xi * cf[2];
            const LAS f32x4* br4 = (const LAS f32x4*)(BR + p * 16); const LAS f32x4* bi4 = (const LAS f32x4*)(BI + p * 16);
#pragma unroll
            for (int q = 0; q < 4; ++q) { const f32x4 b_r = br4[q], b_i = bi4[q];
#pragma unroll
                for (int z = 0; z < 4; ++z) acc[4 * q + z] += yr * b_r[z] - yi * b_i[z]; } }
#pragma unroll
        for (int q = 0; q < 16; ++q) { acc[q] += dpp_f<0xB1>(acc[q]); acc[q] += dpp_f<0x4E>(acc[q]); }
        if (pq == 0) { u32x4 o0, o1; o0.x = pk2(acc[0], acc[1]); o0.y = pk2(acc[2], acc[3]); o0.z = pk2(acc[4], acc[5]); o0.w = pk2(acc[6], acc[7]);
            o1.x = pk2(acc[8], acc[9]); o1.y = pk2(acc[10], acc[11]); o1.z = pk2(acc[12], acc[13]); o1.w = pk2(acc[14], acc[15]);
            *(u32x4*)(KT + (size_t)idx * 16) = o0; *(u32x4*)(KT + (size_t)idx * 16 + 8) = o1; } }
    for (int idx = gt; idx < 64 * 64 * SLN; idx += nthr) {
        const int j = idx % SLN, p = (idx / SLN) & 63, g = idx / (SLN * 64);
        const f32x4 cf = CF[g * 64 + p]; float pr, pi;
        s5_pow(cf, (float)(SLN - 1 - j), pr, pi);
        const float yr = pr * cf[2] - pi * cf[3], yi = pr * cf[3] + pi * cf[2];
        const float* br = b_re + (size_t)(g * 64 + p) * 16; const float* bi = b_im + (size_t)(g * 64 + p) * 16;
        float vr[16], vi[16];
#pragma unroll
        for (int q = 0; q < 16; ++q) { vr[q] = yr * br[q] - yi * bi[q]; vi[q] = yr * bi[q] + yi * br[q]; }
        bf16* v0 = VT + ((size_t)(g * 128 + 2 * p) * SKK + j * 16);
        u32x4 o; o.x = pk2(vr[0], vr[1]); o.y = pk2(vr[2], vr[3]); o.z = pk2(vr[4], vr[5]); o.w = pk2(vr[6], vr[7]); *(u32x4*)v0 = o;
        o.x = pk2(vr[8], vr[9]); o.y = pk2(vr[10], vr[11]); o.z = pk2(vr[12], vr[13]); o.w = pk2(vr[14], vr[15]); *(u32x4*)(v0 + 8) = o;
        o.x = pk2(vi[0], vi[1]); o.y = pk2(vi[2], vi[3]); o.z = pk2(vi[4], vi[5]); o.w = pk2(vi[6], vi[7]); *(u32x4*)(v0 + SKK) = o;
        o.x = pk2(vi[8], vi[9]); o.y = pk2(vi[10], vi[11]); o.z = pk2(vi[12], vi[13]); o.w = pk2(vi[14], vi[15]); *(u32x4*)(v0 + SKK + 8) = o;
        if (j == 0) { s5_pow(cf, (float)SLN, pr, pi); L64[(g * 64 + p) * 2] = pr; L64[(g * 64 + p) * 2 + 1] = pi; }
    }
    for (int idx = gt; idx < 64 * 64 * SLN; idx += nthr) {
        const int p = idx & 63, l = (idx >> 6) % SLN, g = idx / (SLN * 64);
        const f32x4 cf = CF[g * 64 + p]; float pr, pi; s5_pow(cf, (float)(l + 1), pr, pi);
#pragma unroll
        for (int h = 0; h < 16; ++h) { const float cr = c_re[(g * 16 + h) * 64 + p], ci = c_im[(g * 16 + h) * 64 + p];
            *(unsigned*)(WT + ((size_t)((g * SLN + l) * 16 + h) * 128 + 2 * p)) = pk2(cr * pr - ci * pi, -(cr * pi + ci * pr)); }
    }
    __syncthreads();
}
__device__ __forceinline__ void s5_phaseA(const Frame& F, unsigned char* ws, const int lane) {
    const bf16* PB = (const bf16*)(ws + WS_PB); const bf16* VT = (const bf16*)(ws + WS_S5VT); float* SL = (float*)(ws + WS_S5SL);
    const int gq = lane >> 4, li = lane & 15;
    for (int wu = F.gw; wu < 64 * NRT * 2; wu += F.NGW) {
        const int half = wu & 1, rt = (wu >> 1) % NRT, g = wu / (2 * NRT), b = rt / (NRT / 2), c0 = (rt % (NRT / 2)) * 16;
        f32x4 acc[4];
#pragma unroll
        for (int ct = 0; ct < 4; ++ct) acc[ct] = (f32x4){0.f, 0.f, 0.f, 0.f};
        const bf16* ap = PB + ((size_t)b * T + (size_t)(c0 + li) * SLN + (gq >> 1)) * 1024 + g * 16 + 8 * (gq & 1);
        const bf16* bp = VT + (size_t)(g * 128 + half * 64 + li) * SKK + 8 * gq;
#pragma unroll 4
        for (int ks = 0; ks < SLN / 2; ++ks) {
            const bf16x8 af = *(const bf16x8*)(ap + (size_t)(2 * ks) * 1024);
#pragma unroll
            for (int ct = 0; ct < 4; ++ct) acc[ct] = __builtin_amdgcn_mfma_f32_16x16x32_bf16(af, *(const bf16x8*)(bp + (size_t)(16 * ct) * SKK + 32 * ks), acc[ct], 0, 0, 0);
        }
#pragma unroll
        for (int ct = 0; ct < 4; ++ct)
#pragma unroll
            for (int r = 0; r < 4; ++r) SL[(size_t)(g * NI + rt * 16 + 4 * gq + r) * 128 + half * 64 + ct * 16 + li] = acc[ct][r];
    }
}
__device__ __forceinline__ void s5_phaseB(const Frame& F, unsigned char* ws, const int tid) {
    static_assert(NCI == 256, "16 groups of 16 chunks");
    const float* SL = (const float*)(ws + WS_S5SL); bf16* SP = (bf16*)(ws + WS_S5SP); const float* L64 = (const float*)(ws + WS_S5L64);
    for (int gt = blockIdx.x * NTHREADS + tid; gt < 2 * 64 * 64 * 16; gt += F.G * NTHREADS) {
        const int grp = gt & 15, p = (gt >> 4) & 63, g = (gt >> 10) & 63, b = gt >> 16;
        const float ar = L64[(g * 64 + p) * 2], ai = L64[(g * 64 + p) * 2 + 1];
        const size_t base = (size_t)(g * NI + b * NCI + grp * 16) * 128 + 2 * p;
        f32x2 x[16];
#pragma unroll
        for (int i = 0; i < 16; ++i) x[i] = *(const f32x2*)(SL + base + (size_t)i * 128);
        float lr[16], li[16], sr = 0.f, si = 0.f;
#pragma unroll
        for (int i = 0; i < 16; ++i) { lr[i] = sr; li[i] = si; const float nr = ar * sr - ai * si + x[i][0], ni = ar * si + ai * sr + x[i][1]; sr = nr; si = ni; }
        float mr = ar, mi = ai;
#pragma unroll
        for (int k = 0; k < 4; ++k) { const float t = mr * mr - mi * mi; mi = 2.f * mr * mi; mr = t; }
#define S5_STEP(CTRL) do { const float tr = __builtin_bit_cast(float, __builtin_amdgcn_update_dpp(0, __builtin_bit_cast(int, sr), CTRL, 0xf, 0xf, true)), ti = __builtin_bit_cast(float, __builtin_amdgcn_update_dpp(0, __builtin_bit_cast(int, si), CTRL, 0xf, 0xf, true)); \
            sr += mr * tr - mi * ti; si += mr * ti + mi * tr; const float t2 = mr * mr - mi * mi; mi = 2.f * mr * mi; mr = t2; } while (0)
        S5_STEP(0x111); S5_STEP(0x112); S5_STEP(0x114); S5_STEP(0x118);
#undef S5_STEP
        const float pr = __builtin_bit_cast(float, __builtin_amdgcn_update_dpp(0, __builtin_bit_cast(int, sr), 0x111, 0xf, 0xf, true)), pi = __builtin_bit_cast(float, __builtin_amdgcn_update_dpp(0, __builtin_bit_cast(int, si), 0x111, 0xf, 0xf, true));
        float qr = 1.f, qi = 0.f;
#pragma unroll
        for (int i = 0; i < 16; ++i) { const float orr = qr * pr - qi * pi + lr[i], oi = qr * pi + qi * pr + li[i];
            *(unsigned*)(SP + base + (size_t)i * 128) = pk2(orr, oi);
            const float t = qr * ar - qi * ai; qi = qr * ai + qi * ar; qr = t; }
    }
}
__device__ __forceinline__ void s5_phaseC(const Frame& F, unsigned char* ws, const int lane, const float* dskip) {
    const bf16* PB = (const bf16*)(ws + WS_PB); const bf16* KT = (const bf16*)(ws + WS_S5KT); const bf16* WT = (const bf16*)(ws + WS_S5WT); const bf16* SP = (const bf16*)(ws + WS_S5SP);
    bf16* YB = (bf16*)(ws + WS_YB);
    const int gq = lane >> 4, li = lane & 15;
#pragma unroll 1
    for (int wu = F.gw; wu < 64 * NRT * 2; wu += F.NGW) {
        const int par = wu & 1, rt = (wu >> 1) % NRT, g = wu / (2 * NRT), b = rt / (NRT / 2), c0 = (rt % (NRT / 2)) * 16;
        bf16x8 af[SLN / 2], sf[4];
        const bf16* ap = PB + ((size_t)b * T + (size_t)(c0 + li) * SLN + (gq >> 1)) * 1024 + g * 16 + 8 * (gq & 1);
#pragma unroll
        for (int ks = 0; ks < SLN / 2; ++ks) af[ks] = *(const bf16x8*)(ap + (size_t)(2 * ks) * 1024);
#pragma unroll
        for (int ks = 0; ks < 4; ++ks) sf[ks] = *(const bf16x8*)(SP + (size_t)(g * NI + rt * 16 + li) * 128 + 32 * ks + 8 * gq);
        const f32x4 dl = *(const f32x4*)(dskip + g * 16 + 4 * gq);
        const bf16* ktp = KT + (size_t)g * SLN * 256 + li * 16 + 8 * (gq & 1);
#pragma unroll
        for (int l2 = 0; l2 < SLN / 2; ++l2) {
            int l = 2 * l2 + par; asm volatile("" : "+v"(l));
            f32x4 acc = (f32x4){0.f, 0.f, 0.f, 0.f};
#pragma unroll
            for (int ks = 0; ks <= l2; ++ks) { const int tau = l - 2 * ks - (gq >> 1);
                bf16x8 bfv = *(const bf16x8*)(ktp + (size_t)(tau < 0 ? 0 : tau) * 256);
                if (ks == l2 && tau < 0) bfv = (bf16x8){0, 0, 0, 0, 0, 0, 0, 0};
                acc = __builtin_amdgcn_mfma_f32_16x16x32_bf16(bfv, af[ks], acc, 0, 0, 0); }
            const bf16* wp = WT + (size_t)((g * SLN + l) * 16 + li) * 128 + 8 * gq;
#pragma unroll
            for (int ks = 0; ks < 4; ++ks) acc = __builtin_amdgcn_mfma_f32_16x16x32_bf16(*(const bf16x8*)(wp + 32 * ks), sf[ks], acc, 0, 0, 0);
            { const size_t row = (size_t)b * T + (size_t)(c0 + li) * SLN + l; const size_t o = row * 1024 + g * 16 + 4 * gq;
                const uint2 uv = *(const uint2*)(PB + o);
                uint2 ov; ov.x = pk2(gelu_tanh(acc[0] + dl[0] * bflo(uv.x)), gelu_tanh(acc[1] + dl[1] * bfhi(uv.x))); ov.y = pk2(gelu_tanh(acc[2] + dl[2] * bflo(uv.y)), gelu_tanh(acc[3] + dl[3] * bfhi(uv.y)));
                *(uint2*)(YB + o) = ov; }
            asm volatile("" ::: "memory");
        }
    }
}

#define IN(k) (lo <= (k) && (k) < hi)
#define SEAM(k) do { if ((k) + 1 < hi) { xcd_barrier(bar, F.wave); if (PROBE_CLS == 10) xcd_barrier(bar, F.wave); if (PROBE_T >= 0) stamp_fn(F.lds, F.wave, (k)); } } while (0)
#define INP(i) inp_ptr(F.lds, (i))
#define x_in INP(0)
#define ln_g INP(1)
#define ln_b INP(2)
#define WS_PTRS \
    float* HF = (float*)(ws + WS_HF); bf16* XB = (bf16*)(ws + WS_XB); bf16* ZF = (bf16*)(ws + WS_ZF); bf16* PB = (bf16*)(ws + WS_PB); \
    float* GB = (float*)(ws + WS_GB); float* LA = (float*)(ws + WS_LA); float* ORAW = (float*)(ws + WS_ORAW); bf16* YB = (bf16*)(ws + WS_YB); \
    bf16* ACT = (bf16*)(ws + WS_ACT); bf16* YS = (bf16*)(ws + WS_YS); bf16* XG = (bf16*)(ws + WS_XG); \
    int* LIST = (int*)(ws + WS_LIST); float* GW = (float*)(ws + WS_ORAW); \
    float* S5LB = (float*)(ws + WS_S5TAB); float* S5BB = (float*)(ws + WS_S5TAB + 32768); \
    (void)HF; (void)XB; (void)ZF; (void)PB; (void)GB; (void)LA; (void)ORAW; (void)YB; (void)ACT; (void)YS; (void)XG; (void)LIST; (void)GW; (void)S5LB; (void)S5BB;

template <int layer>
__device__ __forceinline__ void layer_body(const Frame& F, unsigned char* ws, unsigned* ctl, LAS int* TAB, const XcdBarrier& bar, const int lo, const int hi, float* d_out) {
    WS_PTRS
        const int pb = 1 + layer * 16;
        const float* hin = (layer == 0) ? x_in : HF;
        if (PHE(1) && IN(pb + 0)) {
            const bf16* Wt = (const bf16*)(ws + (layer == 0 ? WS_WT_ML_IN : layer == 1 ? WS_WT_RET_IN : layer == 2 ? WS_WT_GLA_IN : WS_WT_S5_IN));
            const int N = (layer == 0 || layer == 2) ? 3072 : (layer == 1 ? 6144 : 1024);
            pg8::DenseOrder S; S.init(XB, Wt, M, N, D, F.G, (int)blockIdx.x);
            pg8::EpiBf16 E{PB, N, (const float*)(ws + WS_CS), (layer == 1) ? 8 : 0};
            for (int rep_ = 0; rep_ < REPS(2); ++rep_)
            pg8::gemm_phase<pg8::EpiBf16, pg8::DenseOrder, true, true>(F.lds, F.wave, D, S, E);
            if (layer == 0 && CH_ML) {
                const int lane = lane_id(); float* GSC = (float*)(ws + WS_SC);
                for (int wu = F.gw; wu < 16 * NCH; wu += F.NGW) { const int bh = wu / NCH, c = wu % NCH, b = bh >> 3, h = bh & 7;
                    const int t0 = c * CL + 2 * lane; const size_t row = (size_t)b * T + t0;
                    const float lf0 = log_sigmoidf_(GB[row * 16 + 8 + h]), lf1 = log_sigmoidf_(GB[(row + 1) * 16 + 8 + h]);
                    const float sp = lf0 + lf1; float inc = sp;
#pragma unroll
                    for (int d = 1; d < 64; d <<= 1) { const float tv_ = __shfl_up(inc, d); if (lane >= d) inc += tv_; }
                    const float a0 = inc - sp + lf0, a1 = inc;
                    const float g0 = GB[row * 16 + h] - a0, g1 = GB[(row + 1) * 16 + h] - a1;
                    float mx = fmaxf(g0, g1);
#pragma unroll
                    for (int d = 1; d < 64; d <<= 1) { const float tv_ = __shfl_up(mx, d); if (lane >= d) mx = fmaxf(mx, tv_); }
                    float ex = __shfl_up(mx, 1); if (lane == 0) ex = -3.0e38f;
                    const size_t o0 = (size_t)bh * T + t0;
                    *(f32x2*)(GSC + (size_t)(0 * 16) * T + o0) = (f32x2){a0, a1};
                    *(f32x2*)(GSC + (size_t)(1 * 16) * T + o0) = (f32x2){g0, g1};
                    *(f32x2*)(GSC + (size_t)(2 * 16) * T + o0) = (f32x2){fmaxf(ex, g0), mx}; }
            }
            SEAM(pb + 0);
        }
        if (layer == 0) {
            if (CH_ML) {
                if (IN(pb + 2)) { const int lane = lane_id(), tid = F.wave * 64 + lane; for (int rep_ = 0; rep_ < REPS(6); ++rep_) mix_phaseA<0>(F, ws, tid, lane); SEAM(pb + 2); }
                if (IN(pb + 3)) { const int lane = lane_id(), tid = F.wave * 64 + lane; for (int rep_ = 0; rep_ < REPS(7); ++rep_) mix_phaseB<0>(F, ws, tid); SEAM(pb + 3); }
                if (IN(pb + 4)) { const int lane = lane_id(), tid = F.wave * 64 + lane; for (int rep_ = 0; rep_ < REPS(8); ++rep_) mix_phaseC<0>(F, ws, tid, lane, INP(5)); SEAM(pb + 4); }
            }
        } else if (layer == 1) {
            if (CH_RET) {
                if (IN(pb + 2)) { const int lane = lane_id(), tid = F.wave * 64 + lane; for (int rep_ = 0; rep_ < REPS(6); ++rep_) mix_phaseA<1>(F, ws, tid, lane); SEAM(pb + 2); }
                if (IN(pb + 3)) { const int lane = lane_id(), tid = F.wave * 64 + lane; for (int rep_ = 0; rep_ < REPS(7); ++rep_) mix_phaseB<1>(F, ws, tid); SEAM(pb + 3); }
                if (IN(pb + 4)) { const int lane = lane_id(), tid = F.wave * 64 + lane; for (int rep_ = 0; rep_ < REPS(8); ++rep_) mix_phaseC<1>(F, ws, tid, lane, INP(8)); SEAM(pb + 4); }
            }
        } else if (layer == 2) {
            if (CH_GLA) {
                if (IN(pb + 2)) { const int lane = lane_id(), tid = F.wave * 64 + lane; for (int rep_ = 0; rep_ < REPS(6); ++rep_) mix_phaseA<2>(F, ws, tid, lane); SEAM(pb + 2); }
                if (IN(pb + 3)) { const int lane = lane_id(), tid = F.wave * 64 + lane; for (int rep_ = 0; rep_ < REPS(7); ++rep_) mix_phaseB<2>(F, ws, tid); SEAM(pb + 3); }
                if (IN(pb + 4)) { const int lane = lane_id(), tid = F.wave * 64 + lane; for (int rep_ = 0; rep_ < REPS(8); ++rep_) mix_phaseC<2>(F, ws, tid, lane, INP(13)); SEAM(pb + 4); }
            }
        } else {
            if (CH_S5) {
                if (IN(pb + 2)) { const int lane = lane_id(); for (int rep_ = 0; rep_ < REPS(6); ++rep_) s5_phaseA(F, ws, lane); SEAM(pb + 2); }
                if (IN(pb + 3)) { const int lane = lane_id(), tid = F.wave * 64 + lane; for (int rep_ = 0; rep_ < REPS(7); ++rep_) s5_phaseB(F, ws, tid); SEAM(pb + 3); }
                if (IN(pb + 4)) { const int lane = lane_id(); for (int rep_ = 0; rep_ < REPS(8); ++rep_) s5_phaseC(F, ws, lane, INP(22)); SEAM(pb + 4); }
            }
        }
        if (PHE(4) && layer == 3 && IN(pb + 6)) {
            pg8::DenseOrder S; S.init(YB, ws + WS_WT_S5_GLU, M, D, D, F.G, (int)blockIdx.x);
            pg8::EpiGlu E{YB, INP(25), (bf16*)ORAW};
            for (int rep_ = 0; rep_ < REPS(3); ++rep_)
            pg8::gemm_phase<pg8::EpiGlu, pg8::DenseOrder, true, true>(F.lds, F.wave, D, S, E);
            SEAM(pb + 6);
        }
        if (PHE(5) && IN(pb + 7)) {
            const bf16* Wt = (const bf16*)(ws + (layer == 0 ? WS_WT_ML_OUT : layer == 1 ? WS_WT_RET_OUT : layer == 2 ? WS_WT_GLA_OUT : WS_WT_S5_OUT));
            const int Kd = (layer == 1) ? 2048 : 1024;
            const bf16* Ain = (layer == 3) ? (const bf16*)ORAW : YB;
            pg8::DenseOrder S; S.init(Ain, Wt, M, D, Kd, F.G, (int)blockIdx.x);
            pg8::EpiResid E{hin, (layer == 0) ? (const bf16*)nullptr : (const bf16*)XB, ZF};
            for (int rep_ = 0; rep_ < REPS(3); ++rep_)
            pg8::gemm_phase<pg8::EpiResid, pg8::DenseOrder, true, true>(F.lds, F.wave, Kd, S, E);
            SEAM(pb + 7);
        }
        unsigned* cnt = ctl + CW_CNT + layer * 32 * 64;
        if (IN(pb + 8) && !defined_SKIP_LN1) { const int lane = lane_id(), tid = F.wave * 64 + lane; (void)tid;
            LAS float* Wt = (LAS float*)(F.lds);
            { const f32x4* wr4 = (const f32x4*)(INP(27) + (size_t)layer * D * NEXP);
              f32x4 wv[16];
#pragma unroll
              for (int i = 0; i < 16; ++i) wv[i] = wr4[tid + i * NTHREADS];
#pragma unroll
              for (int i = 0; i < 16; ++i) { const int q = tid + i * NTHREADS, k = q >> 3, e0 = (q & 7) * 4;
                  Wt[(e0 + 0) * 1028 + k] = wv[i][0]; Wt[(e0 + 1) * 1028 + k] = wv[i][1]; Wt[(e0 + 2) * 1028 + k] = wv[i][2]; Wt[(e0 + 3) * 1028 + k] = wv[i][3]; } }
            __syncthreads();
            const float* br_ = INP(28) + layer * NEXP;
            const float* lng_ = ln_g + (size_t)(layer * 2 + 0) * D; const float* lnb_ = ln_b + (size_t)(layer * 2 + 0) * D;
          {
            unsigned* cntp = cnt;
            int aE = 0, aRow = -1; float aG = 0.f;
            LAS unsigned* lcnt = (LAS unsigned*)(F.lds + 131584); LAS int* lbase = (LAS int*)(lcnt + 32);
            if (tid < 32) lcnt[tid] = 0u;
            const int ntrip = (M + F.NGW - 1) / F.NGW;
            u32x2 vnext[2][4];
#pragma unroll
            for (int q = 0; q < 2; ++q) { const int r_ = F.gw + q * F.NGW; if (r_ < M) { const u32x2* zp = (const u32x2*)(ZF + (size_t)r_ * D) + lane;
#pragma unroll
                for (int j = 0; j < 4; ++j) vnext[q][j] = zp[64 * j]; } }
            for (int it_ = 0; it_ < ntrip; it_ += 2) { const int row0_ = F.gw + it_ * F.NGW;
                asm volatile("" ::: "memory");
                const bool ok[2] = {row0_ < M, it_ + 1 < ntrip && row0_ + F.NGW < M};
                f32x4 v[2][4];
#pragma unroll
                for (int q = 0; q < 2; ++q)
#pragma unroll
                    for (int j = 0; j < 4; ++j) v[q][j] = (f32x4){bflo(vnext[q][j].x), bfhi(vnext[q][j].x), bflo(vnext[q][j].y), bfhi(vnext[q][j].y)};
#pragma unroll
                for (int q = 0; q < 2; ++q) { const int r_ = row0_ + (2 + q) * F.NGW; if (it_ + 2 + q < ntrip && r_ < M) { const u32x2* zp = (const u32x2*)(ZF + (size_t)r_ * D) + lane;
#pragma unroll
                    for (int j = 0; j < 4; ++j) vnext[q][j] = zp[64 * j]; } }
                { f32x4 gv[4], bv[4]; load_row_f32(lng_, gv, lane); load_row_f32(lnb_, bv, lane); ln_row(v[0], gv, bv); ln_row(v[1], gv, bv); }
                float pz[2][32];
#pragma unroll
                for (int e = 0; e < 32; ++e) { float s0 = 0.f, s1 = 0.f;
#pragma unroll
                    for (int j = 0; j < 4; ++j) { const f32x4 w = *(const LAS f32x4*)(Wt + e * 1028 + 4 * (lane + 64 * j));
                        s0 += v[0][j][0] * w[0] + v[0][j][1] * w[1] + v[0][j][2] * w[2] + v[0][j][3] * w[3]; s1 += v[1][j][0] * w[0] + v[1][j][1] * w[1] + v[1][j][2] * w[2] + v[1][j][3] * w[3]; }
                    pz[0][e] = s0; pz[1][e] = s1; }
                float lgv[2];
#pragma unroll
                for (int q = 0; q < 2; ++q) {
                    float a16[16], a8[8], a4[4], a2[2];
#pragma unroll
                    for (int e = 0; e < 16; ++e) { const auto r = __builtin_amdgcn_permlane32_swap(__builtin_bit_cast(unsigned, pz[q][e]), __builtin_bit_cast(unsigned, pz[q][e + 16]), false, false);
                        a16[e] = __builtin_bit_cast(float, (unsigned)r[0]) + __builtin_bit_cast(float, (unsigned)r[1]); }
#pragma unroll
                    for (int e = 0; e < 8; ++e) { const auto r = __builtin_amdgcn_permlane16_swap(__builtin_bit_cast(unsigned, a16[e]), __builtin_bit_cast(unsigned, a16[e + 8]), false, false);
                        a8[e] = __builtin_bit_cast(float, (unsigned)r[0]) + __builtin_bit_cast(float, (unsigned)r[1]); }
                    { const bool hi = (lane & 8) != 0;
#pragma unroll
                      for (int e = 0; e < 4; ++e) { const float mine = hi ? a8[e + 4] : a8[e], theirs = hi ? a8[e] : a8[e + 4]; a4[e] = mine + dpp_f<0x128>(theirs); } }
                    { const bool hi = (lane & 4) != 0;
#pragma unroll
                      for (int e = 0; e < 2; ++e) { const float mine = hi ? a4[e + 2] : a4[e], theirs = hi ? a4[e] : a4[e + 2]; a2[e] = mine + dpp_f<0x141>(theirs); } }
                    { const bool hi = (lane & 2) != 0; const float mine = hi ? a2[1] : a2[0], theirs = hi ? a2[0] : a2[1]; lgv[q] = mine + dpp_f<0x4E>(theirs); }
                    lgv[q] += dpp_f<0xB1>(lgv[q]);
                    lgv[q] += br_[lane >> 1];
                }
                int te[2][4]; float tv[2][4];
#pragma unroll
                for (int k = 0; k < 4; ++k)
#pragma unroll
                    for (int q = 0; q < 2; ++q) { const float best = wave_max(lgv[q]);
                        const unsigned long long mk = __ballot(lgv[q] == best); const int src = __builtin_amdgcn_readfirstlane((int)__ffsll((long long)mk) - 1);
                        te[q][k] = src >> 1; tv[q][k] = best; if ((lane >> 1) == te[q][k]) lgv[q] = -3.0e38f; }
#pragma unroll
                for (int q = 0; q < 2; ++q) if (ok[q]) { const int row = row0_ + q * F.NGW;
                    const float e0 = 1.f, e1 = __expf(tv[q][1] - tv[q][0]), e2 = __expf(tv[q][2] - tv[q][0]), e3 = __expf(tv[q][3] - tv[q][0]), rs = __builtin_amdgcn_rcpf(e0 + e1 + e2 + e3);
                    const int ri = (it_ + q) & 15;
                    if ((lane >> 2) == ri) { const int k = lane & 3; aE = k == 0 ? te[q][0] : k == 1 ? te[q][1] : k == 2 ? te[q][2] : te[q][3]; aG = (k == 0 ? e0 : k == 1 ? e1 : k == 2 ? e2 : e3) * rs; aRow = row; }
                    store_row_bf16(XB + (size_t)row * D, v[q], lane); }
                if (((it_ + 1) & 15) == 15 || it_ + 2 >= ntrip) {
                    __syncthreads();
                    int lp = 0; if (aRow >= 0) lp = (int)__hip_atomic_fetch_add(lcnt + aE, 1u, __ATOMIC_RELAXED, __HIP_MEMORY_SCOPE_WORKGROUP);
                    __syncthreads();
                    if (tid < 32) { const unsigned n = lcnt[tid]; lbase[tid] = n ? (int)__hip_atomic_fetch_add(cntp + tid * 64, n, __ATOMIC_RELAXED, __HIP_MEMORY_SCOPE_AGENT) : 0; }
                    __syncthreads();
                    if (aRow >= 0) { const int pos = lbase[aE] + lp; LIST[(size_t)aE * CAP + pos] = aRow * 4 + (lane & 3); GW[(size_t)aE * CAP + pos] = aG; }
                    aRow = -1;
                    __syncthreads();
                    if (tid < 32) lcnt[tid] = 0u;
                }
            }
          }
            __syncthreads();
            SEAM(pb + 8);
        }
        if ((PHE(7) || PHE(8)) && (IN(pb + 9) || IN(pb + 10))) { const int lane = lane_id(), tid = F.wave * 64 + lane; (void)tid;
            __syncthreads();
            if (tid < 32) TAB[tid] = (int)__hip_atomic_load(cnt + tid * 64, __ATOMIC_RELAXED, __HIP_MEMORY_SCOPE_AGENT);
            __syncthreads();
            if (tid < 64) {
                const int nt_ = (lane < 32) ? ((TAB[lane] + 255) >> 8) : 0; int inc = nt_;
#pragma unroll
                for (int d = 1; d < 32; d <<= 1) { const int t_ = __shfl_up(inc, d); if (lane >= d) inc += t_; }
                if (lane < 32) TAB[32 + lane] = inc - nt_;
                if (lane == 31) TAB[64] = inc; }
            __syncthreads();
            if (tid < MAXTILES) { int e = 0;
#pragma unroll
                for (int k = 1; k < 32; ++k) e += (TAB[32 + k] <= tid) ? 1 : 0;
                if (tid < TAB[64]) TAB[72 + tid] = e; }
            __syncthreads();
        }
        if (PHE(7) && IN(pb + 9)) {
            pg8::MoeOrder S; S.A = (const char*)XB; S.list = LIST; S.gwl = GW; S.Bt = (const char*)(ws + WS_WT_GU + (size_t)layer * 32 * 2048 * 1024 * 2); S.tab = TAB; S.K = D; S.nN = 8; S.ntiles = __builtin_amdgcn_readfirstlane(TAB[64]); S.nwg = S.ntiles * 8; S.G = F.G; S.c = (int)blockIdx.x;
            S.b_estride = (size_t)2048 * 1024 * 2; S.a_compact = 2;
            pg8::EpiSwiglu E{ACT, INP(30) + (size_t)layer * 32 * 2048, (const LAS float*)(TAB + 2816)};
            for (int rep_ = 0; rep_ < REPS(4); ++rep_)
            pg8::gemm_phase<pg8::EpiSwiglu, pg8::MoeOrder, MOE_ALIGN, true, true>(F.lds, F.wave, D, S, E, TAB + 512);
            SEAM(pb + 9);
        }
        if (PHE(8) && IN(pb + 10)) {
            pg8::MoeOrder S; S.A = (const char*)ACT; S.list = LIST; S.gwl = GW; S.Bt = (const char*)(ws + WS_WT_DN + (size_t)layer * 32 * 1024 * 1024 * 2); S.tab = TAB; S.K = DFF; S.nN = 4; S.ntiles = __builtin_amdgcn_readfirstlane(TAB[64]); S.nwg = S.ntiles * 4; S.G = F.G; S.c = (int)blockIdx.x;
            S.b_estride = (size_t)1024 * 1024 * 2; S.a_compact = 1;
            pg8::EpiMoeDown E{YS, INP(32) + (size_t)layer * 32 * 1024, TAB + 1280, (const LAS float*)(TAB + 2816)};
            for (int rep_ = 0; rep_ < REPS(5); ++rep_)
            pg8::gemm_phase<pg8::EpiMoeDown, pg8::MoeOrder, MOE_ALIGN, true, true>(F.lds, F.wave, DFF, S, E, TAB + 512);
            SEAM(pb + 10);
        }
        if (PHE(9) && IN(pb + 11)) { const int lane = lane_id(), tid = F.wave * 64 + lane; (void)tid;
            LAS float* Wt = (LAS float*)(F.lds);
            if (layer == 1) { load_cols16(tid, INP(10), 3088, 3072, Wt); __syncthreads(); }
            const float* lng_ = ln_g + (size_t)(layer * 2 + 1) * D; const float* lnb_ = ln_b + (size_t)(layer * 2 + 1) * D;
          for (int rep_ = 0; rep_ < REPS(12); ++rep_) {
            float* outp = (PROBE_CLS == 12 && rep_ == 0) ? ORAW : (layer == 3) ? d_out : HF; bf16* XBo = (PROBE_CLS == 12 && rep_ == 0) ? YB : XB;
            f32x4 hn[4]; u32x2 yn[4][4];
#define CMB_LOAD(r_) do { { const u32x2* hp_ = (const u32x2*)(XB + (size_t)(r_) * D) + lane; _Pragma("unroll") for (int j = 0; j < 4; ++j) { const u32x2 hw_ = hp_[64 * j]; hn[j] = (f32x4){bflo(hw_.x), bfhi(hw_.x), bflo(hw_.y), bfhi(hw_.y)}; } } _Pragma("unroll") for (int k = 0; k < 4; ++k) { const u32x2* yp = (const u32x2*)(YS + ((size_t)(r_) * 4 + k) * D) + lane; _Pragma("unroll") for (int j = 0; j < 4; ++j) yn[k][j] = yp[64 * j]; } } while (0)
            if (F.gw < M) CMB_LOAD(F.gw);
            for (int row = F.gw; row < M; row += F.NGW) {
                asm volatile("" ::: "memory");
                f32x4 v[4];
#pragma unroll
                for (int j = 0; j < 4; ++j) v[j] = hn[j] * ALPHA;
#pragma unroll
                for (int k = 0; k < 4; ++k)
#pragma unroll
                    for (int j = 0; j < 4; ++j) { const u32x2 yw = yn[k][j]; v[j][0] += bflo(yw.x); v[j][1] += bfhi(yw.x); v[j][2] += bflo(yw.y); v[j][3] += bfhi(yw.y); }
                if (row + F.NGW < M) CMB_LOAD(row + F.NGW);
                { f32x4 gv[4], bv[4]; load_row_f32(lng_, gv, lane); load_row_f32(lnb_, bv, lane); ln_row(v, gv, bv); }
                if (layer == 3) store_row_f32(outp + (size_t)row * D, v, lane);
                if (layer < 3) store_row_bf16(XBo + (size_t)row * D, v, lane);
                if (layer == 1) {
                    const float zsum = row_dot16(v, Wt, lane);
                    if ((lane & 3) == 0) GB[(size_t)row * 16 + (lane >> 2)] = zsum;
                }
            }
            if (layer == 1) {
                __syncthreads();
                const float* wgp = INP(11); const float bgc = INP(12)[tid];
                float wg[16];
#pragma unroll
                for (int r = 0; r < 16; ++r) wg[r] = wgp[r * 512 + tid];
                for (int row = F.vcu * NWAVES; row < M; row += F.NGW) {
                    f32x4 zv[NWAVES][4];
#pragma unroll
                    for (int w = 0; w < NWAVES; ++w)
#pragma unroll
                        for (int q = 0; q < 4; ++q) zv[w][q] = *(const f32x4*)(GB + (size_t)(row + w) * 16 + 4 * q);
#pragma unroll
                    for (int w = 0; w < NWAVES; ++w) { float sacc = bgc;
#pragma unroll
                        for (int q = 0; q < 4; ++q) sacc += zv[w][q][0] * wg[4 * q] + zv[w][q][1] * wg[4 * q + 1] + zv[w][q][2] * wg[4 * q + 2] + zv[w][q][3] * wg[4 * q + 3];
                        LA[(size_t)(row + w) * 512 + tid] = log_sigmoidf_(sacc) * (1.f / 16.f); }
                }
            }
          }
            __syncthreads();
#undef CMB_LOAD
            if (layer < 3) SEAM(pb + 11);
        }
}
__global__ void __launch_bounds__(NTHREADS, 2) mega_fwd(Args args) {
    extern __shared__ __attribute__((aligned(16))) unsigned char lds_raw[];
    Frame F;
    F.lds = (LAS unsigned char*)lds_raw;
    F.wave = __builtin_amdgcn_readfirstlane((int)threadIdx.x >> 6);
    F.G = gridDim.x; { const int bx = blockIdx.x; F.vcu = (F.G % 8 == 0) ? (bx % 8) * (F.G / 8) + bx / 8 : bx; }
    F.gw = F.vcu * NWAVES + F.wave; F.NGW = F.G * NWAVES;
    unsigned char* ws = args.ws;
    unsigned* ctl = (unsigned*)(ws + WS_CTL);
    volatile LAS unsigned* MISC = (volatile LAS unsigned*)(F.lds + MISC_OFF);
    LAS int* TAB = (LAS int*)(F.lds + TAB_OFF);
    { const int tid0 = threadIdx.x;
      if (tid0 < 64) MISC[tid0] = 0u;
      if (tid0 < 33) ((LAS unsigned long long*)(F.lds + MISC_OFF + 256))[tid0] = (unsigned long long)args.in[tid0]; }
    __syncthreads();
    XcdBarrier bar = xcd_barrier_post(ctl + CW_BAR, MISC + 8, F.wave == 0 && lane_id() == 0);
    if (PROBE_T >= 0 && blockIdx.x == 0 && F.wave == 0 && lane_id() == 0) { volatile LAS unsigned long long* st = (volatile LAS unsigned long long*)(F.lds + MISC_OFF + 1024); st[0] = __builtin_amdgcn_s_memrealtime(); st[1] = 0ull; }
    const int lo = args.ph_lo, hi = args.ph_hi;
    WS_PTRS
    if (IN(0) && !defined_SKIP_P0) { const int lane = lane_id(), tid = F.wave * 64 + lane; (void)tid;
      {
        LAS unsigned char* scr = F.lds + F.wave * 8704;
        {
            constexpr int I_GU = 128 * 16 * 32, I_DN = 128 * 16 * 16, I_ML = 16 * 48, I_SQ = 16 * 16, I_RI = 16 * 96, I_RO = 32 * 16;
            constexpr int B0 = I_GU, B1 = B0 + I_DN, B2 = B1 + I_ML, B3 = B2 + I_SQ, B4 = B3 + I_RI, B5 = B4 + I_RO, B6 = B5 + I_ML, B7 = B6 + I_SQ, B8 = B7 + I_SQ, B9 = B8 + I_SQ, B10 = B9 + I_SQ;
#define P0_ITEM(IT_) do { const int it = (IT_); \
                    const float* src; bf16* dst; int ldw, Kd, nnb, mode = 0, r; \
                    if (it < B0)      { r = it;      const int q = r / (16 * 32); r -= q * (16 * 32); src = INP(29) + (size_t)q * 1024 * 2048; dst = (bf16*)(ws + WS_WT_GU) + (size_t)q * 2048 * 1024; ldw = 2048; Kd = 1024; nnb = 32; mode = 1; } \
                    else if (it < B1) { r = it - B0; const int q = r / (16 * 16); r -= q * (16 * 16); src = INP(31) + (size_t)q * 1024 * 1024; dst = (bf16*)(ws + WS_WT_DN) + (size_t)q * 1024 * 1024; ldw = 1024; Kd = 1024; nnb = 16; } \
                    else if (it < B2) { r = it - B1; src = INP(3);  dst = (bf16*)(ws + WS_WT_ML_IN);  ldw = 3088; Kd = 1024; nnb = 48; } \
                    else if (it < B3) { r = it - B2; src = INP(6);  dst = (bf16*)(ws + WS_WT_ML_OUT); ldw = 1024; Kd = 1024; nnb = 16; } \
                    else if (it < B4) { r = it - B3; src = INP(7);  dst = (bf16*)(ws + WS_WT_RET_IN); ldw = 6144; Kd = 1024; nnb = 96; mode = 2; } \
                    else if (it < B5) { r = it - B4; src = INP(9);  dst = (bf16*)(ws + WS_WT_RET_OUT); ldw = 1024; Kd = 2048; nnb = 16; } \
                    else if (it < B6) { r = it - B5; src = INP(10); dst = (bf16*)(ws + WS_WT_GLA_IN); ldw = 3088; Kd = 1024; nnb = 48; } \
                    else if (it < B7) { r = it - B6; src = INP(14); dst = (bf16*)(ws + WS_WT_GLA_OUT); ldw = 1024; Kd = 1024; nnb = 16; } \
                    else if (it < B8) { r = it - B7; src = INP(15); dst = (bf16*)(ws + WS_WT_S5_IN);  ldw = 1024; Kd = 1024; nnb = 16; } \
                    else if (it < B9) { r = it - B8; src = INP(24); dst = (bf16*)(ws + WS_WT_S5_GLU); ldw = 1024; Kd = 1024; nnb = 16; } \
                    else              { r = it - B9; src = INP(26); dst = (bf16*)(ws + WS_WT_S5_OUT); ldw = 1024; Kd = 1024; nnb = 16; } \
                const int kb = r / nnb, nb = r - kb * nnb; \
                transpose_item(src, ldw, 0, Kd, dst, mode, kb, nb, scr, lane); } while (0)
            const int NSTAT = (B10 / F.NGW) * 4 / 5, DYN0 = NSTAT * F.NGW, DLEN = B10 - DYN0, GLEN = (DLEN + 7) / 8;
#pragma unroll 1
            for (int n_ = 0; n_ < NSTAT; ++n_) P0_ITEM(F.gw + n_ * F.NGW);
#pragma unroll 1
            for (int tr = 0; tr < 8; ++tr) { const int grp = ((int)blockIdx.x + tr) & 7; unsigned* q = ctl + 2304 + 64 * grp; const int glo = DYN0 + grp * GLEN, glen = (DLEN - grp * GLEN) < GLEN ? (DLEN - grp * GLEN) : GLEN;
                int cur = 0; if (lane == 0) cur = (int)__hip_atomic_fetch_add(q, 4u, __ATOMIC_RELAXED, __HIP_MEMORY_SCOPE_AGENT); cur = __builtin_amdgcn_readfirstlane(cur);
#pragma unroll 1
                while (cur < glen) { int nx = 0; if (lane == 0) nx = (int)__hip_atomic_fetch_add(q, 4u, __ATOMIC_RELAXED, __HIP_MEMORY_SCOPE_AGENT);
#pragma unroll 1
                    for (int k = 0; k < 4; ++k) if (cur + k < glen) P0_ITEM(glo + cur + k);
                    cur = __builtin_amdgcn_readfirstlane(nx); } }
#undef P0_ITEM
        }
        __syncthreads();
        if (CH_S5) s5_tables(F, ws, tid, INP(16), INP(17), INP(18), INP(19), INP(20), INP(21), INP(23));
        { float* CS = (float*)(ws + WS_CS);
          for (int it = blockIdx.x * NTHREADS + tid; it < T * 64; it += F.G * NTHREADS) { const int t = it >> 6, i = it & 63;
              const float inv = exp2f(-(float)(2 * i) * (13.287712379549449f / 128.f)); float sn, cs; sincosf((float)t * inv, &sn, &cs); CS[2 * it] = cs; CS[2 * it + 1] = sn; } }
        LAS float* Wt = (LAS float*)(F.lds);
        load_cols16(tid, INP(3), 3088, 3072, Wt);
        __syncthreads();
        {
            const float* bg = INP(4);
            f32x4 vn[4]; if (F.gw < M) load_row_f32(x_in + (size_t)F.gw * D, vn, lane);
            for (int row = F.gw; row < M; row += F.NGW) {
                asm volatile("" ::: "memory");
                f32x4 v[4];
#pragma unroll
                for (int j = 0; j < 4; ++j) v[j] = vn[j];
                if (row + F.NGW < M) load_row_f32(x_in + (size_t)(row + F.NGW) * D, vn, lane);
                store_row_bf16(XB + (size_t)row * D, v, lane);
                const float gsum = row_dot16(v, Wt, lane);
                if ((lane & 3) == 0) GB[(size_t)row * 16 + (lane >> 2)] = gsum + bg[lane >> 2];
            }
        }
        __syncthreads();
      }
        SEAM(0);
    }

    layer_body<0>(F, ws, ctl, TAB, bar, lo, hi, args.out);
    layer_body<1>(F, ws, ctl, TAB, bar, lo, hi, args.out);
    layer_body<2>(F, ws, ctl, TAB, bar, lo, hi, args.out);
    layer_body<3>(F, ws, ctl, TAB, bar, lo, hi, args.out);
    if (PROBE_T >= 0 && blockIdx.x == 0 && F.wave == 0 && lane_id() == 0) { volatile LAS unsigned long long* st = (volatile LAS unsigned long long*)(F.lds + MISC_OFF + 1024); args.out[0] = (float)st[1] * (0.01f / 16.f); }
#undef IN
#undef SEAM
#undef INP
#undef x_in
#undef ln_g
#undef ln_b
}

extern "C" void kernel_launch(void* const* d_in, const int* in_sizes, int n_in, void* d_out, int out_size, void* d_ws, size_t ws_size, hipStream_t stream) {
    static int grid = 0;
    if (grid == 0) {
        if (n_in != 33 || out_size != M * D || ws_size < WS_END) { fprintf(stderr, "kernel_launch: unexpected problem (n_in %d, out %d, ws %zu < %zu)\n", n_in, out_size, ws_size, (size_t)WS_END); grid = -1; return; }
        int dev = 0, cus = 0, per_cu = 0;
        if (hipGetDevice(&dev) != hipSuccess || hipDeviceGetAttribute(&cus, hipDeviceAttributeMultiprocessorCount, dev) != hipSuccess) { grid = -1; return; }
        if (hipFuncSetAttribute((const void*)mega_fwd, hipFuncAttributeMaxDynamicSharedMemorySize, LDS_BYTES) != hipSuccess) { fprintf(stderr, "kernel_launch: hipFuncSetAttribute failed\n"); grid = -1; return; }
        if (hipOccupancyMaxActiveBlocksPerMultiprocessor(&per_cu, (const void*)mega_fwd, NTHREADS, LDS_BYTES) != hipSuccess || per_cu < 1) { fprintf(stderr, "kernel_launch: occupancy query says %d\n", per_cu); }
        (void)hipGetLastError();
        grid = cus;
    }
    if (grid < 0) return;
    hipMemsetAsync((char*)d_ws + WS_CTL, 0, CTL_ZERO_BYTES, stream);
    Args a{};
    for (int i = 0; i < 33; ++i) a.in[i] = (const float*)d_in[i];
    a.out = (float*)d_out; a.ws = (unsigned char*)d_ws;
#if N_LAUNCH_MODE == 1
    a.ph_lo = 0; a.ph_hi = 1000;
    hipLaunchKernelGGL(mega_fwd, dim3(grid), dim3(NTHREADS), LDS_BYTES, stream, a);
#else
    for (int ph = 0; ph < 65; ++ph) { a.ph_lo = ph; a.ph_hi = ph + 1; hipLaunchKernelGGL(mega_fwd, dim3(grid), dim3(NTHREADS), LDS_BYTES, stream, a); }
#endif
}
```

```cpp
#include <hip/hip_runtime.h>
#include <cstdio>
#include <cstdint>

#ifndef NAIVE_MIX
#define NAIVE_MIX 1
#endif
#ifndef CH_ML
#define CH_ML 1
#endif
#ifndef CH_RET
#define CH_RET 1
#endif
#ifndef CH_GLA
#define CH_GLA 1
#endif
#ifndef CH_S5
#define CH_S5 1
#endif
#ifndef PROBE_CLS
#define PROBE_CLS 0
#endif
#define REPS(c) ((PROBE_CLS == (c) || PROBE_CLS == 100 + layer * 10 + (c)) ? 2 : 1)
#ifndef PROBE_T
#define PROBE_T -1
#endif
#ifndef PROBE_T2
#define PROBE_T2 PROBE_T
#endif
#ifndef MOE_ALIGN
#define MOE_ALIGN true
#endif
#ifndef N_LAUNCH_MODE
#define N_LAUNCH_MODE 1
#endif


#ifdef SKIP_ML
constexpr bool defined_SKIP_ML = true;
#else
constexpr bool defined_SKIP_ML = false;
#endif
#ifdef SKIP_RET
constexpr bool defined_SKIP_RET = true;
#else
constexpr bool defined_SKIP_RET = false;
#endif
#ifdef SKIP_GLA
constexpr bool defined_SKIP_GLA = true;
#else
constexpr bool defined_SKIP_GLA = false;
#endif
#ifdef SKIP_S5
constexpr bool defined_SKIP_S5 = true;
#else
constexpr bool defined_SKIP_S5 = false;
#endif
#ifdef SKIP_LN1
constexpr bool defined_SKIP_LN1 = true;
#else
constexpr bool defined_SKIP_LN1 = false;
#endif
#ifdef SKIP_P0
constexpr bool defined_SKIP_P0 = true;
#else
constexpr bool defined_SKIP_P0 = false;
#endif
#ifndef PHMASK
#define PHMASK 0xffff
#endif
#define PHE(b) (((PHMASK) >> (b)) & 1)
#define GAS __attribute__((address_space(1)))
#define LAS __attribute__((address_space(3)))
typedef unsigned short bf16;
typedef short bf16x8 __attribute__((ext_vector_type(8)));
typedef float f32x4 __attribute__((ext_vector_type(4)));
typedef float f32x2 __attribute__((ext_vector_type(2)));
typedef unsigned u32x4 __attribute__((ext_vector_type(4)));
typedef unsigned u32x2 __attribute__((ext_vector_type(2)));

constexpr int BATCH = 2, T = 8192, D = 1024, M = BATCH * T;
constexpr int NEXP = 32, TOPK = 4, DFF = 1024, CAP = M;
constexpr int NWAVES = 8, NTHREADS = 512;
constexpr float LN_EPS = 1e-5f;
constexpr float ALPHA = 1.681792830507429f;
constexpr int MAXTILES = (M * TOPK) / 256 + NEXP;

constexpr size_t MiB = 1u << 20;
constexpr size_t WS_CTL = 0, CTL_ZERO_BYTES = 1 * MiB;
constexpr size_t WS_WT_ML_IN = 1 * MiB;
constexpr size_t WS_WT_ML_OUT = WS_WT_ML_IN + 6 * MiB;
constexpr size_t WS_WT_RET_IN = WS_WT_ML_OUT + 2 * MiB;
constexpr size_t WS_WT_RET_OUT = WS_WT_RET_IN + 12 * MiB;
constexpr size_t WS_WT_GLA_IN = WS_WT_RET_OUT + 4 * MiB;
constexpr size_t WS_WT_GLA_OUT = WS_WT_GLA_IN + 6 * MiB;
constexpr size_t WS_WT_S5_IN = WS_WT_GLA_OUT + 2 * MiB;
constexpr size_t WS_WT_S5_GLU = WS_WT_S5_IN + 2 * MiB;
constexpr size_t WS_WT_S5_OUT = WS_WT_S5_GLU + 2 * MiB;
constexpr size_t WS_S5TAB = WS_WT_S5_OUT + 2 * MiB;
constexpr size_t WS_GB = WS_S5TAB + 1 * MiB;
constexpr size_t WS_LIST = WS_GB + 1 * MiB;
constexpr size_t WS_GW = WS_LIST + 2 * MiB;
constexpr size_t WS_WT_GU = WS_GW + 1 * MiB;
constexpr size_t WS_WT_DN = WS_WT_GU + 512 * MiB;
constexpr size_t WS_HF = WS_WT_DN + 256 * MiB;
constexpr size_t WS_XB = WS_HF + 64 * MiB;
constexpr size_t WS_ZF = WS_XB + 32 * MiB;
constexpr size_t WS_PB = WS_ZF + 64 * MiB;
constexpr size_t WS_LA = WS_PB + 192 * MiB;
constexpr size_t WS_ORAW = WS_LA + 32 * MiB;
constexpr size_t WS_YB = WS_ORAW + 128 * MiB;
constexpr size_t WS_ACT = WS_YB + 64 * MiB;
constexpr size_t WS_YS = WS_ACT + 144 * MiB;
constexpr size_t WS_XG = WS_YS + 256 * MiB;
constexpr size_t WS_UT = WS_XG + 1024 * MiB;
constexpr size_t WS_ST = WS_UT + 128 * MiB;
constexpr size_t WS_KPP = WS_ST + 64 * MiB;
constexpr size_t WS_SC = WS_KPP + 16 * MiB;
constexpr size_t WS_S5KT = WS_SC + 4 * MiB;
constexpr size_t WS_S5VT = WS_S5KT + 2 * MiB;
constexpr size_t WS_S5WT = WS_S5VT + 16 * MiB;
constexpr size_t WS_S5L64 = WS_S5WT + 16 * MiB;
constexpr size_t WS_S5SL = WS_S5L64 + 1 * MiB;
constexpr size_t WS_S5SP = WS_S5SL + 16 * MiB;
constexpr size_t WS_CS = WS_S5SP + 8 * MiB;
constexpr size_t WS_END = WS_CS + 4 * MiB;
constexpr int CW_BAR = 4096;
constexpr int CW_CNT = 16384;

constexpr int PH_BYTES = 139264;
constexpr int TAB_OFF = PH_BYTES;
constexpr int MISC_OFF = TAB_OFF + 16384;
constexpr int LDS_BYTES = 159744;

typedef __bf16 bf16x2_t __attribute__((ext_vector_type(2)));
__device__ __forceinline__ unsigned pk2(float lo, float hi) { const f32x2 v = {lo, hi}; const bf16x2_t b = __builtin_convertvector(v, bf16x2_t); return __builtin_bit_cast(unsigned, b); }
__device__ __forceinline__ unsigned f2bf(float f) { return pk2(f, 0.f) & 0xffffu; }
__device__ __forceinline__ float bf2f(unsigned short b) { return __builtin_bit_cast(float, ((unsigned)b) << 16); }
__device__ __forceinline__ float bflo(unsigned w) { return __builtin_bit_cast(float, w << 16); }
__device__ __forceinline__ float bfhi(unsigned w) { return __builtin_bit_cast(float, w & 0xffff0000u); }
__device__ __forceinline__ int lane_id() { int l; asm volatile("v_mbcnt_lo_u32_b32 %0, -1, 0\n\tv_mbcnt_hi_u32_b32 %0, -1, %0" : "=v"(l)); return l; }
template <int CTRL> __device__ __forceinline__ float dpp_f(float v) { return __builtin_bit_cast(float, __builtin_amdgcn_update_dpp(0, __builtin_bit_cast(int, v), CTRL, 0xf, 0xf, false)); }
__device__ __forceinline__ float rl_f(float v, int l) { return __builtin_bit_cast(float, __builtin_amdgcn_readlane(__builtin_bit_cast(int, v), l)); }
__device__ __forceinline__ float wave_sum(float v) {
    v += dpp_f<0xB1>(v);
    v += dpp_f<0x4E>(v);
    v += dpp_f<0x141>(v);
    v += dpp_f<0x140>(v);
    return (rl_f(v, 0) + rl_f(v, 16)) + (rl_f(v, 32) + rl_f(v, 48));
}
__device__ __forceinline__ float row16_sum(float v) { v += dpp_f<0xB1>(v); v += dpp_f<0x4E>(v); v += dpp_f<0x141>(v); v += dpp_f<0x140>(v); return v; }
__device__ __forceinline__ float wave_max(float v) {
    v = fmaxf(v, dpp_f<0xB1>(v)); v = fmaxf(v, dpp_f<0x4E>(v)); v = fmaxf(v, dpp_f<0x141>(v)); v = fmaxf(v, dpp_f<0x140>(v));
    return fmaxf(fmaxf(rl_f(v, 0), rl_f(v, 16)), fmaxf(rl_f(v, 32), rl_f(v, 48)));
}
__device__ __forceinline__ float sigmoidf_(float x) { return __builtin_amdgcn_rcpf(1.f + __expf(-x)); }
__device__ __forceinline__ float log_sigmoidf_(float x) { return fminf(x, 0.f) - __logf(1.f + __expf(-fabsf(x))); }
__device__ __forceinline__ float gelu_tanh(float x) { const float u = 0.7978845608028654f * (x + 0.044715f * x * x * x); return x * sigmoidf_(2.f * u); }

namespace pg8 {
constexpr int BM = 256, BK = 64, HALF = 128, HTB = HALF * BK * 2, STAGE_BYTES = 8 * HTB, NXCD = 8, WGM = 8;
__host__ __device__ __forceinline__ int lds_byte(int r, int c) { const int st = (r >> 4) * 2 + (c >> 5), rr = r & 15, cc = c & 31, ob = rr * 64 + cc * 2; return st * 1024 + (ob ^ (((ob >> 9) & 1) << 5)); }
__host__ __device__ __forceinline__ void stage_rc(int b, int& R, int& C) { const int st = b / 1024, sb = b % 1024, swz = sb ^ (((sb >> 9) & 1) << 5); R = (st >> 1) * 16 + swz / 64; C = (st & 1) * 32 + (swz % 64) / 2; }
__host__ __device__ __forceinline__ int perm32(int rho) { const int n = rho >> 4, i = rho & 15; return 8 * (i >> 2) + 4 * n + (i & 3); }

struct Unit { const char* A; const char* B; int pm, pn, e, nvalid, r0, buf; };

__device__ __forceinline__ int xcd_remap(int L, int nwg) { const int q = nwg / NXCD, r = nwg % NXCD, xcd = L % NXCD, off = L / NXCD; return (xcd < r ? xcd * (q + 1) : r * (q + 1) + (xcd - r) * q) + off; }

struct DenseOrder {
    const char* A; const char* Bt; int K, nM, nN, nwg, G, c; const int* list; const float* gwl; static constexpr int a_compact = 0;
    __device__ __forceinline__ void init(const void* A_, const void* Bt_, int M_, int N_, int K_, int G_, int c_) { A = (const char*)A_; Bt = (const char*)Bt_; K = K_; nM = M_ / BM; nN = N_ / BM; nwg = nM * nN; G = G_; c = c_; list = nullptr; gwl = nullptr; }
    __device__ __forceinline__ bool next(int i, Unit& u) const {
        const long L = (long)i * G + c; if (L >= nwg) return false;
        const int wgid = xcd_remap((int)L, nwg);
        const int nig = WGM * nN, gid = wgid / nig, fm = gid * WGM, gsz = (nM - fm) < WGM ? (nM - fm) : WGM;
        u.pm = fm + ((wgid % nig) % gsz); u.pn = (wgid % nig) / gsz; u.e = 0; u.nvalid = 256; u.r0 = 0;
        u.A = A + (size_t)u.pm * 256 * K * 2; u.B = Bt + (size_t)u.pn * 256 * K * 2; return true;
    }
};
struct MoeOrder {
    const char* A; const char* Bt; const LAS int* tab;
    int K, nN, ntiles, nwg, G, c; size_t b_estride; int a_compact; const int* list; const float* gwl;
    __device__ __forceinline__ bool next(int i, Unit& u) const {
        const long L = (long)i * G + c; if (L >= nwg) return false;
        const int wgid = xcd_remap((int)L, nwg);
        const int nig = WGM * nN, gid = wgid / nig, fm = gid * WGM, gsz = (ntiles - fm) < WGM ? (ntiles - fm) : WGM;
        const int tl = fm + ((wgid % nig) % gsz); u.pm = tl; u.pn = (wgid % nig) / gsz;
        const int e = __builtin_amdgcn_readfirstlane(tab[72 + tl]); u.e = e; const int r0 = (tl - __builtin_amdgcn_readfirstlane(tab[32 + e])) * 256; const int rem = __builtin_amdgcn_readfirstlane(tab[e]) - r0; u.nvalid = rem < 256 ? rem : 256; u.r0 = r0;
        u.A = (a_compact == 2) ? A : a_compact ? A + (size_t)tl * 256 * K * 2 : A + ((size_t)e * CAP + r0) * K * 2;
        u.B = Bt + (size_t)e * b_estride + (size_t)u.pn * 256 * K * 2; return true;
    }
};

__device__ __forceinline__ unsigned cvt_pk_bf16(float lo, float hi) { unsigned r; asm volatile("v_cvt_pk_bf16_f32 %0, %1, %2" : "=v"(r) : "v"(lo), "v"(hi)); return r; }

struct EpiBf16 {
    static constexpr bool BIASTAB = false; static constexpr bool ROWINFO = false; static constexpr bool PERM = true;
    bf16* O; int ldc; const float* cs; int rot_tiles;
    __device__ __forceinline__ void operator()(const f32x4 (&acc)[2][2][4][2], const Unit& u, int wr, int wc, int fr, int fq) const {
        const int row0 = u.pm * BM + wr * 64 + fr, col0 = u.pn * BM + wc * 32 + 8 * fq;
        const bool rot = u.pn < rot_tiles; const float sc = (col0 >= 1024) ? 0.08838834764831845f : 1.f;
#pragma unroll
        for (int ai = 0; ai < 2; ++ai)
#pragma unroll
            for (int m = 0; m < 4; ++m) { const int row = row0 + ai * HALF + m * 16; bf16* rowp = O + (size_t)row * ldc + col0;
#pragma unroll
                for (int bj = 0; bj < 2; ++bj) { f32x4 v0 = acc[ai][bj][m][0], v1 = acc[ai][bj][m][1];
                    if (rot) { const float* cp = cs + ((size_t)(row & (T - 1)) * 64 + (((col0 + bj * HALF) & 127) >> 1)) * 2; const f32x4 c0 = *(const f32x4*)cp, c1 = *(const f32x4*)(cp + 4);
                        const f32x4 a0 = v0, a1 = v1;
                        v0[0] = (a0[0] * c0[0] - a0[1] * c0[1]) * sc; v0[1] = (a0[0] * c0[1] + a0[1] * c0[0]) * sc; v0[2] = (a0[2] * c0[2] - a0[3] * c0[3]) * sc; v0[3] = (a0[2] * c0[3] + a0[3] * c0[2]) * sc;
                        v1[0] = (a1[0] * c1[0] - a1[1] * c1[1]) * sc; v1[1] = (a1[0] * c1[1] + a1[1] * c1[0]) * sc; v1[2] = (a1[2] * c1[2] - a1[3] * c1[3]) * sc; v1[3] = (a1[2] * c1[3] + a1[3] * c1[2]) * sc; }
                    u32x4 w; w.x = cvt_pk_bf16(v0[0], v0[1]); w.y = cvt_pk_bf16(v0[2], v0[3]); w.z = cvt_pk_bf16(v1[0], v1[1]); w.w = cvt_pk_bf16(v1[2], v1[3]);
                    *(u32x4*)(rowp + bj * HALF) = w; } }
    }
};
struct EpiResid {
    static constexpr bool BIASTAB = false; static constexpr bool ROWINFO = false; static constexpr bool PERM = true;
    const float* __restrict__ hin; const bf16* __restrict__ hinb; bf16* __restrict__ Z;
    __device__ __forceinline__ void operator()(const f32x4 (&acc)[2][2][4][2], const Unit& u, int wr, int wc, int fr, int fq) const {
        const int row0 = u.pm * BM + wr * 64 + fr, col0 = u.pn * BM + wc * 32 + 8 * fq;
#pragma unroll
        for (int ai = 0; ai < 2; ++ai)
#pragma unroll
            for (int m = 0; m < 4; ++m) { const size_t off = (size_t)(row0 + ai * HALF + m * 16) * D + col0;
                f32x4 hv[2][2];
                if (hinb) {
#pragma unroll
                    for (int bj = 0; bj < 2; ++bj) { const u32x4 hw = *(const u32x4*)(hinb + off + bj * HALF);
                        hv[bj][0] = (f32x4){bflo(hw.x), bfhi(hw.x), bflo(hw.y), bfhi(hw.y)}; hv[bj][1] = (f32x4){bflo(hw.z), bfhi(hw.z), bflo(hw.w), bfhi(hw.w)}; }
                } else {
#pragma unroll
                    for (int bj = 0; bj < 2; ++bj)
#pragma unroll
                        for (int n = 0; n < 2; ++n) hv[bj][n] = *(const f32x4*)(hin + off + bj * HALF + n * 4);
                }
#pragma unroll
                for (int bj = 0; bj < 2; ++bj) { const f32x4 v0 = hv[bj][0] * ALPHA + acc[ai][bj][m][0], v1 = hv[bj][1] * ALPHA + acc[ai][bj][m][1];
                    u32x4 w; w.x = cvt_pk_bf16(v0[0], v0[1]); w.y = cvt_pk_bf16(v0[2], v0[3]); w.z = cvt_pk_bf16(v1[0], v1[1]); w.w = cvt_pk_bf16(v1[2], v1[3]);
                    *(u32x4*)(Z + off + bj * HALF) = w; } }
    }
};
struct EpiGlu {
    static constexpr bool BIASTAB = false; static constexpr bool ROWINFO = false; static constexpr bool PERM = true;
    const bf16* Y; const float* bias; bf16* O;
    __device__ __forceinline__ void operator()(const f32x4 (&acc)[2][2][4][2], const Unit& u, int wr, int wc, int fr, int fq) const {
        const int row0 = u.pm * BM + wr * 64 + fr, col0 = u.pn * BM + wc * 32 + 8 * fq;
#pragma unroll
        for (int ai = 0; ai < 2; ++ai)
#pragma unroll
            for (int m = 0; m < 4; ++m) { const size_t off = (size_t)(row0 + ai * HALF + m * 16) * D + col0;
#pragma unroll
                for (int bj = 0; bj < 2; ++bj) {
                    const f32x4 b0 = *(const f32x4*)(bias + col0 + bj * HALF), b1 = *(const f32x4*)(bias + col0 + bj * HALF + 4);
                    const u32x4 yw = *(const u32x4*)(Y + off + bj * HALF);
                    const f32x4 v0 = acc[ai][bj][m][0] + b0, v1 = acc[ai][bj][m][1] + b1;
                    float o[8];
                    o[0] = bflo(yw.x) * sigmoidf_(v0[0]); o[1] = bfhi(yw.x) * sigmoidf_(v0[1]); o[2] = bflo(yw.y) * sigmoidf_(v0[2]); o[3] = bfhi(yw.y) * sigmoidf_(v0[3]);
                    o[4] = bflo(yw.z) * sigmoidf_(v1[0]); o[5] = bfhi(yw.z) * sigmoidf_(v1[1]); o[6] = bflo(yw.w) * sigmoidf_(v1[2]); o[7] = bfhi(yw.w) * sigmoidf_(v1[3]);
                    u32x4 w; w.x = cvt_pk_bf16(o[0], o[1]); w.y = cvt_pk_bf16(o[2], o[3]); w.z = cvt_pk_bf16(o[4], o[5]); w.w = cvt_pk_bf16(o[6], o[7]);
                    *(u32x4*)(O + off + bj * HALF) = w; } }
    }
};
struct EpiSwiglu {
    static constexpr bool BIASTAB = true; static constexpr bool ROWINFO = false; static constexpr bool PERM = true;
    bf16* ACT; const float* bgu; const LAS float* btab;
    __device__ __forceinline__ float bias_at(const Unit& u, int j) const { return bgu[(size_t)u.e * 2 * DFF + (j < HALF ? 0 : DFF) + u.pn * HALF + (j & (HALF - 1))]; }
    __device__ __forceinline__ void operator()(const f32x4 (&acc)[2][2][4][2], const Unit& u, int wr, int wc, int fr, int fq) const {
        const int row0 = u.pm * BM + wr * 64 + fr, j0 = u.pn * HALF + wc * 32 + 8 * fq;
        const LAS float* bt = btab + u.buf * 256 + wc * 32 + 8 * fq;
        const f32x4 g0 = *(const LAS f32x4*)(bt), g1 = *(const LAS f32x4*)(bt + 4), u0 = *(const LAS f32x4*)(bt + HALF), u1 = *(const LAS f32x4*)(bt + HALF + 4);
#pragma unroll
        for (int ai = 0; ai < 2; ++ai)
#pragma unroll
            for (int m = 0; m < 4; ++m) {
                float o[8];
#pragma unroll
                for (int n = 0; n < 2; ++n)
#pragma unroll
                    for (int i = 0; i < 4; ++i) {
                        float g = acc[ai][0][m][n][i] + (n ? g1[i] : g0[i]), up = acc[ai][1][m][n][i] + (n ? u1[i] : u0[i]);
                        g = fminf(g, 7.0f); up = fminf(fmaxf(up, -7.0f), 7.0f);
                        o[n * 4 + i] = (up + 1.0f) * g * sigmoidf_(1.702f * g); }
                u32x4 w; w.x = cvt_pk_bf16(o[0], o[1]); w.y = cvt_pk_bf16(o[2], o[3]); w.z = cvt_pk_bf16(o[4], o[5]); w.w = cvt_pk_bf16(o[6], o[7]);
                *(u32x4*)(ACT + (size_t)(row0 + ai * HALF + m * 16) * DFF + j0) = w; }
    }
};
struct EpiMoeDown {
    static constexpr bool BIASTAB = true; static constexpr bool ROWINFO = true; static constexpr bool PERM = true;
    bf16* YS; const float* bd; const LAS int* rinfo; const LAS float* btab;
    __device__ __forceinline__ float bias_at(const Unit& u, int j) const { return bd[(size_t)u.e * D + u.pn * BM + j]; }
    __device__ __forceinline__ void operator()(const f32x4 (&acc)[2][2][4][2], const Unit& u, int wr, int wc, int fr, int fq) const {
        const int col0 = u.pn * BM + wc * 32 + 8 * fq;
        const LAS float* bt = btab + u.buf * 256 + wc * 32 + 8 * fq;
        f32x4 bv[2][2];
#pragma unroll
        for (int bj = 0; bj < 2; ++bj)
#pragma unroll
            for (int n = 0; n < 2; ++n) bv[bj][n] = *(const LAS f32x4*)(bt + bj * HALF + 4 * n);
        const LAS int* ri = rinfo + u.buf * 512;
#pragma unroll
        for (int ai = 0; ai < 2; ++ai)
#pragma unroll
            for (int m = 0; m < 4; ++m) { const int r = ai * HALF + wr * 64 + m * 16 + fr; const int slot = ri[r];
                if (slot >= 0) { const float gg = __builtin_bit_cast(float, ri[256 + r]); bf16* op = YS + (size_t)slot * D + col0;
#pragma unroll
                    for (int bj = 0; bj < 2; ++bj) { const f32x4 v0 = (acc[ai][bj][m][0] + bv[bj][0]) * gg, v1 = (acc[ai][bj][m][1] + bv[bj][1]) * gg;
                        u32x4 w; w.x = cvt_pk_bf16(v0[0], v0[1]); w.y = cvt_pk_bf16(v0[2], v0[3]); w.z = cvt_pk_bf16(v1[0], v1[1]); w.w = cvt_pk_bf16(v1[2], v1[3]);
                        *(u32x4*)(op + bj * HALF) = w; } } }
    }
};

template <class Epi, class Sched, bool ALIGN_EPI, bool SP2, bool GATHER = false>
__device__ __forceinline__ void gemm_phase(LAS unsigned char* lds, const int wid, const int K, const Sched& S, const Epi& E, LAS int* rowtab = nullptr) {
    const int lane = lane_id(), tid = wid * 64 + lane, wr = wid >> 2, wc = wid & 3, fr = lane & 15, fq = lane >> 4;
    const int nt = K / BK;
    unsigned voffA[2], voffB[2]; int Rr[2]; unsigned Cc2[2];
#pragma unroll
    for (int i = 0; i < 2; ++i) { int R, C; stage_rc(tid * 16 + i * 8192, R, C); const int Rb = Epi::PERM ? ((R & ~31) + perm32(R & 31)) : R;
        voffA[i] = (unsigned)(R * K + C) * 2u; voffB[i] = (unsigned)(Rb * K + C) * 2u; Rr[i] = R; Cc2[i] = (unsigned)C * 2u; }
    unsigned vA[2][2] = {{0u, 0u}, {0u, 0u}}, vN[2][2] = {{0u, 0u}, {0u, 0u}};
    const size_t kstep = (size_t)(BK * 2);
    const size_t hstep = (size_t)HALF * K * 2;
    const unsigned ldsw = (unsigned)wid * 1024u;
    const int aoff = lds_byte(wr * 64 + fr, fq * 8), boff = lds_byte(wc * 32 + fr, fq * 8);
#define PG8_SA(b, h) (((b) * 2 + (h)) * HTB)
#define PG8_SB(b, h) ((4 + (b) * 2 + (h)) * HTB)
#define PG8_STAGE(bufoff, gbase, voff) do { _Pragma("unroll") for (int _i = 0; _i < 2; ++_i) \
        __builtin_amdgcn_global_load_lds((const unsigned*)((const char*)(gbase) + (voff)[_i]), (LAS unsigned*)(lds + (bufoff) + ldsw + _i * 8192), 16, 0, 0); } while (0)
#define PG8_STAGE_A(bufoff, kbase, h, VO) do { if constexpr (GATHER) { PG8_STAGE(bufoff, kbase, (VO)[h]); } else { PG8_STAGE(bufoff, (kbase) + (h) * hstep, voffA); } } while (0)
#define PG8_FILL(buf, U) do { if (tid < 256) { const bool ok_ = tid < (U).nvalid; const int ent_ = (ok_ && (S.a_compact == 2 || Epi::ROWINFO)) ? S.list[(size_t)(U).e * CAP + (U).r0 + tid] : 0; \
        rowtab[(buf) * 256 + tid] = (S.a_compact == 2) ? (ent_ >> 2) * (K * 2) : tid * (K * 2); \
        if constexpr (Epi::ROWINFO) { rowtab[768 + (buf) * 512 + tid] = ok_ ? ent_ : -1; rowtab[768 + (buf) * 512 + 256 + tid] = ok_ ? __builtin_bit_cast(int, S.gwl[(size_t)(U).e * CAP + (U).r0 + tid]) : 0; } } \
        if constexpr (Epi::BIASTAB) { if (tid >= 256) rowtab[2304 + (buf) * 256 + (tid - 256)] = __builtin_bit_cast(int, E.bias_at((U), tid - 256)); } } while (0)
#define PG8_LOADVO(VO, buf) do { _Pragma("unroll") for (int h_ = 0; h_ < 2; ++h_) _Pragma("unroll") for (int i_ = 0; i_ < 2; ++i_) (VO)[h_][i_] = (unsigned)rowtab[(buf) * 256 + h_ * 128 + Rr[i_]] + Cc2[i_]; } while (0)
#define PG8_LDA(dst, b, h) do { _Pragma("unroll") for (int m = 0; m < 4; ++m) _Pragma("unroll") for (int k = 0; k < 2; ++k) dst[m][k] = *(const LAS bf16x8*)(lds + PG8_SA(b, h) + aoff + m * 2048 + k * 1024); } while (0)
#define PG8_LDB(dst, b, h) do { _Pragma("unroll") for (int n = 0; n < 2; ++n) _Pragma("unroll") for (int k = 0; k < 2; ++k) dst[n][k] = *(const LAS bf16x8*)(lds + PG8_SB(b, h) + boff + n * 2048 + k * 1024); } while (0)
#define PG8_MMA(ai, bj, At, Bt) do { __builtin_amdgcn_s_setprio(1); _Pragma("unroll") for (int m = 0; m < 4; ++m) _Pragma("unroll") for (int n = 0; n < 2; ++n) _Pragma("unroll") for (int k = 0; k < 2; ++k) \
        acc[ai][bj][m][n] = __builtin_amdgcn_mfma_f32_16x16x32_bf16(Bt[n][k], At[m][k], acc[ai][bj][m][n], 0, 0, 0); __builtin_amdgcn_s_setprio(0); } while (0)
#define PG8_WAIT_V(n) asm volatile("s_waitcnt vmcnt(" #n ")" ::: "memory")
#define PG8_WAIT_L(n) asm volatile("s_waitcnt lgkmcnt(" #n ")" ::: "memory")
#define PG8_BAR __builtin_amdgcn_s_barrier()
#define PG8_SCHED __builtin_amdgcn_sched_barrier(0)
#define VO_a1 vA
#define VO_cA vA
#define VO_a2 vS
#define VO_a3 vS
    Unit cur, nxt; int ui = 0;
    if (!S.next(0, cur)) return;
    f32x4 acc[2][2][4][2];
#pragma unroll
    for (int a = 0; a < 2; ++a)
#pragma unroll
        for (int b = 0; b < 2; ++b)
#pragma unroll
            for (int m = 0; m < 4; ++m)
#pragma unroll
                for (int n = 0; n < 2; ++n) acc[a][b][m][n] = (f32x4){0.f, 0.f, 0.f, 0.f};
    bf16x8 At[4][2], B0[2][2], B1[2][2];
    const char* cA = cur.A; const char* cB = cur.B;
    cur.buf = 0;
    if constexpr (GATHER) { PG8_FILL(0, cur); asm volatile("s_waitcnt lgkmcnt(0)" ::: "memory"); PG8_BAR; asm volatile("" ::: "memory"); PG8_LOADVO(vA, 0); }
    if constexpr (SP2) {
        PG8_STAGE(PG8_SB(0, 0), cB, voffB); PG8_STAGE(PG8_SB(0, 1), cB + hstep, voffB); PG8_STAGE_A(PG8_SA(0, 0), cA, 0, VO_cA); PG8_STAGE_A(PG8_SA(0, 1), cA, 1, VO_cA);
        if (wr == 1) PG8_BAR;
        PG8_WAIT_V(2); PG8_BAR;
        PG8_STAGE(PG8_SB(1, 0), cB + kstep, voffB); PG8_STAGE_A(PG8_SA(1, 0), cA + kstep, 0, VO_cA); PG8_STAGE(PG8_SB(1, 1), cB + hstep + kstep, voffB);
        PG8_WAIT_V(6); PG8_BAR;
    } else {
        PG8_STAGE(PG8_SB(0, 0), cB, voffB); PG8_STAGE_A(PG8_SA(0, 0), cA, 0, VO_cA); PG8_STAGE(PG8_SB(0, 1), cB + hstep, voffB); PG8_STAGE_A(PG8_SA(0, 1), cA, 1, VO_cA);
        if (wr == 1) PG8_BAR;
        PG8_WAIT_V(4); PG8_BAR;
        PG8_STAGE(PG8_SB(1, 0), cB + kstep, voffB); PG8_STAGE_A(PG8_SA(1, 0), cA + kstep, 0, VO_cA); PG8_STAGE(PG8_SB(1, 1), cB + hstep + kstep, voffB);
        PG8_WAIT_V(6); PG8_BAR;
    }
    for (;;) {
        const bool has_next = S.next(ui + 1, nxt);
        const char* nA = has_next ? nxt.A : cA; const char* nB = has_next ? nxt.B : cB;
        nxt.buf = (ui + 1) % 3;
        if constexpr (GATHER) { if (has_next) PG8_FILL((ui + 1) % 3, nxt); }
        for (int t = 0; t < nt; t += 2) {
            const bool last = (t == nt - 2);
            const char* a1 = cA + (size_t)(t + 1) * kstep;
            const char* a2 = last ? nA : cA + (size_t)(t + 2) * kstep; const char* b2 = last ? nB : cB + (size_t)(t + 2) * kstep;
            const char* a3 = a2 + kstep; const char* b3 = b2 + kstep;
            unsigned vS[2][2];
            if constexpr (GATHER) { if (last && has_next) PG8_LOADVO(vN, (ui + 1) % 3);
#pragma unroll
                for (int h_ = 0; h_ < 2; ++h_)
#pragma unroll
                    for (int i_ = 0; i_ < 2; ++i_) vS[h_][i_] = (last && has_next) ? vN[h_][i_] : vA[h_][i_]; }
            else { vS[0][0] = 0u; vS[0][1] = 0u; vS[1][0] = 0u; vS[1][1] = 0u; }
            if constexpr (SP2) {
            PG8_LDB(B0, 0, 0); PG8_LDB(B1, 0, 1); PG8_SCHED; PG8_LDA(At, 0, 0); PG8_STAGE_A(PG8_SA(1, 1), a1, 1, VO_a1);
            PG8_WAIT_V(8); PG8_WAIT_L(0); PG8_BAR; PG8_MMA(0, 0, At, B0); PG8_MMA(0, 1, At, B1); PG8_BAR; PG8_SCHED;
            PG8_LDA(At, 0, 1); PG8_STAGE(PG8_SB(0, 0), b2, voffB); PG8_STAGE(PG8_SB(0, 1), b2 + hstep, voffB); PG8_STAGE_A(PG8_SA(0, 0), a2, 0, VO_a2);
            PG8_WAIT_V(8); PG8_WAIT_L(0); PG8_BAR; PG8_MMA(1, 0, At, B0); PG8_MMA(1, 1, At, B1); PG8_BAR; PG8_SCHED;
            PG8_LDB(B0, 1, 0); PG8_LDB(B1, 1, 1); PG8_SCHED; PG8_LDA(At, 1, 0); PG8_STAGE_A(PG8_SA(0, 1), a2, 1, VO_a2);
            PG8_WAIT_V(8); PG8_WAIT_L(0); PG8_BAR; PG8_MMA(0, 0, At, B0); PG8_MMA(0, 1, At, B1); PG8_BAR; PG8_SCHED;
            PG8_LDA(At, 1, 1); PG8_STAGE(PG8_SB(1, 0), b3, voffB); PG8_STAGE(PG8_SB(1, 1), b3 + hstep, voffB); PG8_STAGE_A(PG8_SA(1, 0), a3, 0, VO_a3);
            PG8_WAIT_V(8); PG8_WAIT_L(0); PG8_BAR; PG8_MMA(1, 0, At, B0); PG8_MMA(1, 1, At, B1); PG8_BAR; PG8_SCHED;
            } else {
            PG8_LDB(B0, 0, 0); PG8_SCHED; PG8_LDA(At, 0, 0); PG8_STAGE_A(PG8_SA(1, 1), a1, 1, VO_a1);
            PG8_WAIT_L(8); PG8_BAR; PG8_WAIT_L(0); PG8_MMA(0, 0, At, B0); PG8_BAR; PG8_SCHED;
            PG8_LDB(B1, 0, 1); PG8_STAGE(PG8_SB(0, 0), b2, voffB);
            PG8_BAR; PG8_WAIT_L(0); PG8_MMA(0, 1, At, B1); PG8_BAR;
            PG8_LDA(At, 0, 1); PG8_STAGE_A(PG8_SA(0, 0), a2, 0, VO_a2);
            PG8_BAR; PG8_WAIT_L(0); PG8_MMA(1, 0, At, B0); PG8_BAR; PG8_SCHED;
            PG8_STAGE(PG8_SB(0, 1), b2 + hstep, voffB);
            PG8_WAIT_V(6); PG8_BAR; PG8_MMA(1, 1, At, B1); PG8_BAR;
            PG8_LDB(B0, 1, 0); PG8_SCHED; PG8_LDA(At, 1, 0); PG8_STAGE_A(PG8_SA(0, 1), a2, 1, VO_a2);
            PG8_WAIT_L(8); PG8_BAR; PG8_WAIT_L(0); PG8_MMA(0, 0, At, B0); PG8_BAR; PG8_SCHED;
            PG8_LDB(B1, 1, 1); PG8_STAGE(PG8_SB(1, 0), b3, voffB);
            PG8_BAR; PG8_WAIT_L(0); PG8_MMA(0, 1, At, B1); PG8_BAR;
            PG8_LDA(At, 1, 1); PG8_STAGE_A(PG8_SA(1, 0), a3, 0, VO_a3);
            PG8_BAR; PG8_WAIT_L(0); PG8_MMA(1, 0, At, B0); PG8_BAR; PG8_SCHED;
            PG8_STAGE(PG8_SB(1, 1), b3 + hstep, voffB);
            PG8_WAIT_V(6); PG8_BAR; PG8_MMA(1, 1, At, B1); PG8_BAR;
            }
        }
        if constexpr (ALIGN_EPI) { if (wr == 0) PG8_BAR; }
        E(acc, cur, wr, wc, fr, fq);
        if (!has_next) break;
#pragma unroll
        for (int a = 0; a < 2; ++a)
#pragma unroll
            for (int b = 0; b < 2; ++b)
#pragma unroll
                for (int m = 0; m < 4; ++m)
#pragma unroll
                    for (int n = 0; n < 2; ++n) acc[a][b][m][n] = (f32x4){0.f, 0.f, 0.f, 0.f};
        cur = nxt; cA = nA; cB = nB; ++ui;
        if constexpr (GATHER) { vA[0][0] = vN[0][0]; vA[0][1] = vN[0][1]; vA[1][0] = vN[1][0]; vA[1][1] = vN[1][1]; }
        if constexpr (ALIGN_EPI) { if (wr == 1) PG8_BAR; }
    }
    PG8_WAIT_V(0);
    if constexpr (!ALIGN_EPI) { if (wr == 0) PG8_BAR; }
    PG8_BAR;
#undef PG8_SA
#undef PG8_SB
#undef PG8_STAGE
#undef PG8_STAGE_A
#undef PG8_FILL
#undef PG8_LOADVO
#undef VO_a1
#undef VO_cA
#undef VO_a2
#undef VO_a3
#undef PG8_LDA
#undef PG8_LDB
#undef PG8_MMA
#undef PG8_WAIT_V
#undef PG8_WAIT_L
#undef PG8_BAR
#undef PG8_SCHED
}
}

#define XB_TMO      128
#define XB_XCNT(j)  (256  + 64 * (j))
#define XB_XSUB(j)  (1280 + 64 * (j))
#define XB_XGEN(j)  (2304 + 64 * (j))
#define XB_TOP      3328
#define XB_TOPGEN   3392
#define XCD_BAR_WORDS 3456
#define XB_SPIN_CAP (1u << 18)
__device__ __forceinline__ unsigned xb_ld(unsigned* p)              { return __hip_atomic_load(p, __ATOMIC_RELAXED, __HIP_MEMORY_SCOPE_AGENT); }
__device__ __forceinline__ unsigned xb_add(unsigned* p, unsigned v) { return __hip_atomic_fetch_add(p, v, __ATOMIC_RELAXED, __HIP_MEMORY_SCOPE_AGENT); }
__device__ __forceinline__ unsigned xb_xcc_id() { return (unsigned)__builtin_amdgcn_s_getreg((3 << 11) | 20) & 0xFu; }
#define XB_SPIN(cond, bar) do { unsigned _sp = 0; while (cond) { __builtin_amdgcn_s_sleep(1); \
    if ((++_sp & 255u) == 0u) { if (xb_ld(&(bar)[XB_TMO])) break; if (_sp > XB_SPIN_CAP) { atomicAdd(&(bar)[XB_TMO], 1u); break; } } } } while (0)
struct XcdBarrier { unsigned* bar; unsigned x; volatile LAS unsigned* st; };
__device__ __forceinline__ XcdBarrier xcd_barrier_post(unsigned* bar, volatile LAS unsigned* st, bool leader) {
    XcdBarrier b; b.bar = bar; b.x = xb_xcc_id(); b.st = st;
    if (leader) (void)xb_add(&bar[XB_XCNT(b.x)], 1u);
    return b;
}
__device__ __forceinline__ void xcd_barrier_complete(unsigned* bar, unsigned x, unsigned& nloc, unsigned& nx) {
    const unsigned G = gridDim.x * gridDim.y * gridDim.z;
    unsigned sum, cnt, mine, sp = 0u;
    for (;;) {
        sum = 0u; cnt = 0u; mine = 0u;
#pragma unroll
        for (unsigned j = 0; j < 16; ++j) { const unsigned c = xb_ld(&bar[XB_XCNT(j)]); sum += c; cnt += (c > 0u) ? 1u : 0u; mine = (j == x) ? c : mine; }
        if (sum == G) break;
        __builtin_amdgcn_s_sleep(1);
        if ((++sp & 255u) == 0u) { if (xb_ld(&bar[XB_TMO])) break; if (sp > XB_SPIN_CAP) { atomicAdd(&bar[XB_TMO], 1u); break; } }
    }
    nloc = mine > 0u ? mine : 1u; nx = cnt > 0u ? cnt : 1u;
}
__device__ __forceinline__ void xcd_barrier(const XcdBarrier& b, int wave) {
    asm volatile("s_waitcnt vmcnt(0)" ::: "memory");
    __syncthreads();
    if (wave == 0 && lane_id() == 0) {
        unsigned* bar = b.bar;
        __builtin_amdgcn_s_waitcnt(0);
        unsigned nloc = b.st[0], nx = b.st[1];
        if (nloc == 0u) { xcd_barrier_complete(bar, b.x, nloc, nx); b.st[0] = nloc; b.st[1] = nx; }
        const unsigned old = xb_add(&bar[XB_XSUB(b.x)], 1u);
        const unsigned gen = old / nloc;
        if (old + 1u == (gen + 1u) * nloc) {
            __builtin_amdgcn_fence(__ATOMIC_RELEASE, "agent");
            asm volatile("s_waitcnt vmcnt(0)" ::: "memory");
            const unsigned og = xb_add(&bar[XB_TOP], 1u);
            const unsigned tg = og / nx;
            if (og + 1u == (tg + 1u) * nx) xb_add(&bar[XB_TOPGEN], 1u);
            else XB_SPIN(xb_ld(&bar[XB_TOPGEN]) == tg, bar);
            __builtin_amdgcn_fence(__ATOMIC_ACQUIRE, "agent");
            xb_add(&bar[XB_XGEN(b.x)], 1u);
            asm volatile("s_waitcnt vmcnt(0)" ::: "memory");
        } else {
            XB_SPIN(xb_ld(&bar[XB_XGEN(b.x)]) == gen, bar);
            __builtin_amdgcn_fence(__ATOMIC_ACQUIRE, "agent");
            asm volatile("s_waitcnt vmcnt(0)" ::: "memory");
        }
    }
    __syncthreads();
}

struct Args { const float* in[33]; float* out; unsigned char* ws; int ph_lo, ph_hi; };
struct Frame {
    LAS unsigned char* lds;
    int wave, vcu, G, gw, NGW;
};

__device__ __forceinline__ void transpose_item(const float* W, int ldw, int col_off, int K, bf16* WT, int mode, int kb, int nb, LAS unsigned char* scr, int lane) {
    const int k0 = 64 * kb, n0 = 64 * nb;
    const float* src = W + (size_t)k0 * ldw + col_off + n0;
    f32x4 v[16];
#pragma unroll
    for (int i = 0; i < 16; ++i) v[i] = __builtin_nontemporal_load((const f32x4*)(src + (size_t)((lane >> 4) + 4 * i) * ldw + 4 * (lane & 15)));
#pragma unroll
    for (int i = 0; i < 16; ++i) { LAS unsigned* p = (LAS unsigned*)(scr + ((lane >> 4) + 4 * i) * 132 + 8 * (lane & 15)); p[0] = pk2(v[i][0], v[i][1]); p[1] = pk2(v[i][2], v[i][3]); }
    asm volatile("s_waitcnt lgkmcnt(0)" ::: "memory");
    const int c = lane >> 3, nl = lane & 7;
#pragma unroll
    for (int r = 0; r < 8; ++r) { const int n = nl + 8 * r; const LAS unsigned short* s = (const LAS unsigned short*)(scr + (8 * c) * 132 + 2 * n);
        u32x4 o; o.x = (unsigned)s[0] | ((unsigned)s[66] << 16); o.y = (unsigned)s[132] | ((unsigned)s[198] << 16); o.z = (unsigned)s[264] | ((unsigned)s[330] << 16); o.w = (unsigned)s[396] | ((unsigned)s[462] << 16);
        const int ng = n0 + n; int drow = ng; if (mode == 1) { drow = ng < 1024 ? 256 * (ng >> 7) + (ng & 127) : 256 * ((ng - 1024) >> 7) + 128 + (ng & 127); }
        if (mode == 2 && ng < 2048) { const int i_ = ng & 127; drow = (ng & ~127) + (i_ < 64 ? 2 * i_ : 2 * (i_ - 64) + 1); }
        __builtin_nontemporal_store(o, (u32x4*)(WT + (size_t)drow * K + k0 + 8 * c)); }
    asm volatile("s_waitcnt lgkmcnt(0)" ::: "memory");
}

__device__ __forceinline__ void load_cols16(int tid, const float* W, int ldw, int col_off, LAS float* Wt) {
    f32x4 wv[8];
#pragma unroll
    for (int i = 0; i < 8; ++i) { const int q = tid + i * NTHREADS, k = q >> 2, e0 = (q & 3) * 4; wv[i] = *(const f32x4*)(W + (size_t)k * ldw + col_off + e0); }
#pragma unroll
    for (int i = 0; i < 8; ++i) { const int q = tid + i * NTHREADS, k = q >> 2, e0 = (q & 3) * 4;
        Wt[(e0 + 0) * 1028 + k] = wv[i][0]; Wt[(e0 + 1) * 1028 + k] = wv[i][1]; Wt[(e0 + 2) * 1028 + k] = wv[i][2]; Wt[(e0 + 3) * 1028 + k] = wv[i][3]; }
}
__device__ __forceinline__ float row_dot16(const f32x4 (&v)[4], const LAS float* Wt, int lane) {
    float p[16];
#pragma unroll
    for (int e = 0; e < 16; ++e) { float s = 0.f;
#pragma unroll
        for (int j = 0; j < 4; ++j) { const f32x4 w = *(const LAS f32x4*)(Wt + e * 1028 + 4 * (lane + 64 * j)); s += v[j][0] * w[0] + v[j][1] * w[1] + v[j][2] * w[2] + v[j][3] * w[3]; }
        p[e] = s; }
    float a8[8], a4[4], a2[2], r1;
#pragma unroll
    for (int e = 0; e < 8; ++e) { const auto r = __builtin_amdgcn_permlane32_swap(__builtin_bit_cast(unsigned, p[e]), __builtin_bit_cast(unsigned, p[e + 8]), false, false); a8[e] = __builtin_bit_cast(float, (unsigned)r[0]) + __builtin_bit_cast(float, (unsigned)r[1]); }
#pragma unroll
    for (int e = 0; e < 4; ++e) { const auto r = __builtin_amdgcn_permlane16_swap(__builtin_bit_cast(unsigned, a8[e]), __builtin_bit_cast(unsigned, a8[e + 4]), false, false); a4[e] = __builtin_bit_cast(float, (unsigned)r[0]) + __builtin_bit_cast(float, (unsigned)r[1]); }
    { const bool hi = (lane & 8) != 0;
#pragma unroll
      for (int e = 0; e < 2; ++e) { const float mine = hi ? a4[e + 2] : a4[e], theirs = hi ? a4[e] : a4[e + 2]; a2[e] = mine + dpp_f<0x128>(theirs); } }
    { const bool hi = (lane & 4) != 0; const float mine = hi ? a2[1] : a2[0], theirs = hi ? a2[0] : a2[1]; r1 = mine + dpp_f<0x141>(theirs); }
    r1 += dpp_f<0x4E>(r1); r1 += dpp_f<0xB1>(r1);
    return r1;
}
__device__ __forceinline__ void store_row_bf16(bf16* orow, const f32x4 (&v)[4], int lane) {
    unsigned long long* o8 = (unsigned long long*)orow + lane;
#pragma unroll
    for (int j = 0; j < 4; ++j) o8[64 * j] = (unsigned long long)pk2(v[j][0], v[j][1]) | ((unsigned long long)pk2(v[j][2], v[j][3]) << 32);
}
__device__ __forceinline__ void store_row_f32(float* orow, const f32x4 (&v)[4], int lane) {
    f32x4* o = (f32x4*)orow + lane;
#pragma unroll
    for (int j = 0; j < 4; ++j) o[64 * j] = v[j];
}
__device__ __forceinline__ void load_row_f32(const float* row, f32x4 (&v)[4], int lane) {
    const f32x4* p = (const f32x4*)row + lane;
#pragma unroll
    for (int j = 0; j < 4; ++j) v[j] = p[64 * j];
}
__device__ __forceinline__ void ln_row(f32x4 (&v)[4], const f32x4 (&gv)[4], const f32x4 (&bv)[4]) {
    float s = 0.f;
#pragma unroll
    for (int j = 0; j < 4; ++j) s += (v[j][0] + v[j][1]) + (v[j][2] + v[j][3]);
    const float mean = wave_sum(s) * (1.f / D); float s2 = 0.f;
#pragma unroll
    for (int j = 0; j < 4; ++j) { v[j] = v[j] - mean; s2 += (v[j][0] * v[j][0] + v[j][1] * v[j][1]) + (v[j][2] * v[j][2] + v[j][3] * v[j][3]); }
    const float rstd = __builtin_amdgcn_rsqf(wave_sum(s2) * (1.f / D) + LN_EPS);
#pragma unroll
    for (int j = 0; j < 4; ++j) v[j] = v[j] * rstd * gv[j] + bv[j];
}

__device__ __forceinline__ const float* inp_ptr(LAS unsigned char* lds, int i) {
    const LAS unsigned* p = (const LAS unsigned*)(lds + MISC_OFF + 256) + 2 * i;
    const unsigned lo = __builtin_amdgcn_readfirstlane(p[0]), hi = __builtin_amdgcn_readfirstlane(p[1]);
    return (const float*)(const GAS float*)(((unsigned long long)hi << 32) | lo);
}

__device__ __forceinline__ void stamp_fn(LAS unsigned char* lds, int wave, int k) {
    if (blockIdx.x == 0 && wave == 0 && lane_id() == 0) { volatile LAS unsigned long long* st = (volatile LAS unsigned long long*)(lds + MISC_OFF + 1024);
        const unsigned long long now = __builtin_amdgcn_s_memrealtime(); if (k >= PROBE_T && k <= PROBE_T2) st[1] = st[1] + (now - st[0]); st[0] = now; }
}
typedef short s16x4 __attribute__((ext_vector_type(4)));
typedef short v4i16_t __attribute__((ext_vector_type(4)));
constexpr int CL = 128, NCH = T / CL;
template <int MODE> struct MX;
template <> struct MX<0> { static constexpr int NH = 8, DK = 64,  DV = 128, LDP = 3072, KOFF = 512,  VOFF = 1024, GOFF = 2048; };
template <> struct MX<1> { static constexpr int NH = 8, DK = 128, DV = 256, LDP = 6144, KOFF = 1024, VOFF = 2048, GOFF = 4096; };
template <> struct MX<2> { static constexpr int NH = 4, DK = 128, DV = 256, LDP = 3072, KOFF = 512,  VOFF = 1024, GOFF = 2048; };
__device__ __forceinline__ s16x4 ds_tr(const LAS unsigned char* p) { return __builtin_bit_cast(s16x4, __builtin_amdgcn_ds_read_tr16_b64_v4i16((LAS v4i16_t*)p)); }
__device__ __forceinline__ bf16x8 tr_frag(const LAS unsigned char* base, int pitch, int k0, int n0, int lane) {
    const int g = lane >> 4, q = (lane & 15) >> 2, p = lane & 3;
    const LAS unsigned char* a = base + (k0 + 4 * g + q) * pitch + (n0 + 4 * p) * 2;
    const s16x4 r1 = ds_tr(a), r2 = ds_tr(a + 16 * pitch);
    bf16x8 f; f[0] = r1[0]; f[1] = r1[1]; f[2] = r1[2]; f[3] = r1[3]; f[4] = r2[0]; f[5] = r2[1]; f[6] = r2[2]; f[7] = r2[3]; return f;
}
__device__ __forceinline__ u32x4 scale_bf16x8(u32x4 v, float sc) {
    u32x4 o; o.x = pk2(bflo(v.x) * sc, bfhi(v.x) * sc); o.y = pk2(bflo(v.y) * sc, bfhi(v.y) * sc); o.z = pk2(bflo(v.z) * sc, bfhi(v.z) * sc); o.w = pk2(bflo(v.w) * sc, bfhi(v.w) * sc); return o;
}
__device__ __forceinline__ float ret_lg2gamma(int h) { return log2f(1.f - exp2f(-5.f - (float)h)); }

template <int MODE>
__device__ __forceinline__ void mix_phaseA(const Frame& F, unsigned char* ws, const int tid, const int lane) {
    typedef MX<MODE> C; constexpr int DK = C::DK, DV = C::DV, NH = C::NH, LDP = C::LDP, KP = DK * 2 + 32, VP = DV * 2 + 32, ETW = DV / 128, NDT = DK / 16;
    LAS unsigned char* ldsK = F.lds; LAS unsigned char* ldsV = F.lds + 128 * KP; LAS float* rsc = (LAS float*)(F.lds + 128 * KP + 128 * VP);
    const bf16* PB = (const bf16*)(ws + WS_PB); const bf16* KPP = (const bf16*)(ws + WS_KPP); bf16* UT = (bf16*)(ws + WS_UT);
    const float* GSC = (const float*)(ws + WS_SC); float* NLOC = (float*)(ws + WS_SC + 2 * MiB);
    const float* LAp = (const float*)(ws + WS_LA); float* DECp = (float*)(ws + WS_SC + 3 * MiB);
    const int w = F.wave, g = lane >> 4;
    for (int u = blockIdx.x; u < 2 * NH * NCH; u += F.G) {
        const int c = u % NCH, bh = u / NCH, h = bh % NH, b = bh / NH; const size_t row0 = (size_t)b * T + (size_t)c * CL;
        u32x4 kr[DK / 32], vr[DV / 32];
        f32x2 cs[16]; unsigned qv[16], kv[16];
        const size_t gr0 = row0 + 16 * w; const int gch = h * 128 + 2 * lane;
        if (MODE == 2) {
#pragma unroll
            for (int i = 0; i < 16; ++i) { cs[i] = *(const f32x2*)(LAp + (gr0 + i) * 512 + gch); qv[i] = *(const unsigned*)(PB + (gr0 + i) * 3072 + gch); kv[i] = *(const unsigned*)(PB + (gr0 + i) * 3072 + 512 + gch); }
        } else {
#pragma unroll
            for (int i = 0; i < DK / 32; ++i) { const int p = tid + i * NTHREADS, r = p / (DK / 8), cp = p % (DK / 8);
                kr[i] = *(const u32x4*)(PB + (row0 + r) * LDP + C::KOFF + h * DK + cp * 8); }
        }
#pragma unroll
        for (int i = 0; i < DV / 32; ++i) { const int p = tid + i * NTHREADS, r = p / (DV / 8), cp = p % (DV / 8);
            vr[i] = *(const u32x4*)(PB + (row0 + r) * LDP + C::VOFF + h * DV + cp * 8); }
        float gmax = 0.f; if (MODE == 0) gmax = GSC[(size_t)(2 * 16 + bh) * T + c * CL + 127];
        const float lgh = (MODE == 1) ? ret_lg2gamma(h) : 0.f;
        __syncthreads();
        if (MODE == 2) {
            LAS float* tot = rsc;
#pragma unroll
            for (int i = 1; i < 16; ++i) cs[i] += cs[i - 1];
            *(LAS f32x2*)(tot + w * 128 + 2 * lane) = cs[15];
            __syncthreads();
            f32x2 pre = (f32x2){0.f, 0.f}, bend = (f32x2){0.f, 0.f};
#pragma unroll
            for (int w2 = 0; w2 < NWAVES; ++w2) { const f32x2 tw = *(const LAS f32x2*)(tot + w2 * 128 + 2 * lane); bend += tw; if (w2 < w) pre += tw; }
            bf16* PBw = (bf16*)(ws + WS_PB);
#pragma unroll
            for (int i = 0; i < 16; ++i) { const float b0 = pre[0] + cs[i][0], b1 = pre[1] + cs[i][1];
                const float q0 = bflo(qv[i]), q1 = bfhi(qv[i]), k0 = bflo(kv[i]) * 0.08838834764831845f, k1 = bfhi(kv[i]) * 0.08838834764831845f;
                *(unsigned*)(PBw + (gr0 + i) * 3072 + gch) = pk2(q0 * __expf(b0), q1 * __expf(b1));
                *(unsigned*)(PBw + (gr0 + i) * 3072 + 512 + gch) = pk2(k0 * __expf(-b0), k1 * __expf(-b1));
                *(LAS unsigned*)(ldsK + (16 * w + i) * KP + lane * 4) = pk2(k0 * __expf(bend[0] - b0), k1 * __expf(bend[1] - b1)); }
            if (w == 0) *(f32x2*)(DECp + (size_t)(b * NCH + c) * 512 + gch) = (f32x2){__expf(bend[0]), __expf(bend[1])};
        } else {
#pragma unroll
            for (int i = 0; i < DK / 32; ++i) { const int p = tid + i * NTHREADS, r = p / (DK / 8), cp = p % (DK / 8);
                u32x4 v = kr[i];
                if (MODE == 0) v = scale_bf16x8(v, __expf(GSC[(size_t)(1 * 16 + bh) * T + c * CL + r] - gmax));
                if (MODE == 1) v = scale_bf16x8(v, exp2f((float)(127 - r) * lgh));
                *(LAS u32x4*)(ldsK + r * KP + cp * 16) = v; }
        }
#pragma unroll
        for (int i = 0; i < DV / 32; ++i) { const int p = tid + i * NTHREADS, r = p / (DV / 8), cp = p % (DV / 8); *(LAS u32x4*)(ldsV + r * VP + cp * 16) = vr[i]; }
        __syncthreads();
        f32x4 acc[ETW][NDT];
#pragma unroll
        for (int i = 0; i < ETW; ++i)
#pragma unroll
            for (int j = 0; j < NDT; ++j) acc[i][j] = (f32x4){0.f, 0.f, 0.f, 0.f};
#pragma unroll
        for (int ks = 0; ks < 4; ++ks) {
            bf16x8 af[ETW], bfv[NDT];
#pragma unroll
            for (int i = 0; i < ETW; ++i) af[i] = tr_frag(ldsV, VP, 32 * ks, (w * ETW + i) * 16, lane);
#pragma unroll
            for (int j = 0; j < NDT; ++j) bfv[j] = tr_frag(ldsK, KP, 32 * ks, j * 16, lane);
#pragma unroll
            for (int i = 0; i < ETW; ++i)
#pragma unroll
                for (int j = 0; j < NDT; ++j) acc[i][j] = __builtin_amdgcn_mfma_f32_16x16x32_bf16(bfv[j], af[i], acc[i][j], 0, 0, 0);
        }
        bf16* ut = UT + (size_t)u * DV * DK;
#pragma unroll
        for (int i = 0; i < ETW; ++i)
#pragma unroll
            for (int j = 0; j < NDT; ++j)
                { uint2 o; o.x = pk2(acc[i][j][0], acc[i][j][1]); o.y = pk2(acc[i][j][2], acc[i][j][3]); *(uint2*)(ut + (size_t)((w * ETW + i) * 16 + (lane & 15)) * DK + j * 16 + 4 * g) = o; }
        if (MODE == 0) {
            float sacc = 0.f;
#pragma unroll
            for (int r = 0; r < 16; ++r) sacc += bf2f(*(const LAS unsigned short*)(ldsK + (16 * w + r) * KP + lane * 2));
            rsc[w * 64 + lane] = sacc;
            __syncthreads();
            if (tid < 64) { float t = 0.f;
#pragma unroll
                for (int q = 0; q < NWAVES; ++q) t += rsc[q * 64 + tid];
                NLOC[(size_t)u * 64 + tid] = t; } }
    }
    __syncthreads();
}

template <int MODE>
__device__ __forceinline__ void mix_phaseB(const Frame& F, unsigned char* ws, const int tid) {
    typedef MX<MODE> C; constexpr int DK = C::DK, DV = C::DV, NH = C::NH, NEL = DV * DK, NBH = 2 * NH;
    const bf16* UT = (const bf16*)(ws + WS_UT); bf16* ST = (bf16*)(ws + WS_ST);
    const float* GSC = (const float*)(ws + WS_SC); const float* NLOC = (const float*)(ws + WS_SC + 2 * MiB); float* NPREV = (float*)(ws + WS_SC + 2 * MiB + 256 * 1024);
    float* MPREV = (float*)(ws + WS_SC + 2 * MiB + 512 * 1024); const float* DEC = (const float*)(ws + WS_SC + 3 * MiB);
    const int gtid = blockIdx.x * NTHREADS + tid, nthr = F.G * NTHREADS;
    for (int el8 = gtid; el8 < NBH * NEL / 8; el8 += nthr) {
        const int el = el8 * 8, bh = el / NEL, idx = el - bh * NEL, h = bh % NH, b = bh / NH;
        float S[8]; float m = -1e30f;
#pragma unroll
        for (int q = 0; q < 8; ++q) S[q] = 0.f;
        const float rdec = (MODE == 1) ? exp2f(128.f * ret_lg2gamma(h)) : 1.f;
#pragma unroll 1
        for (int c0 = 0; c0 < NCH; c0 += 8) {
            u32x4 uv[8];
#pragma unroll
            for (int i = 0; i < 8; ++i) uv[i] = *(const u32x4*)(UT + (size_t)(bh * NCH + c0 + i) * NEL + idx);
#pragma unroll
            for (int i = 0; i < 8; ++i) { const int c = c0 + i; const size_t u = (size_t)bh * NCH + c;
                u32x4 o; o.x = pk2(S[0], S[1]); o.y = pk2(S[2], S[3]); o.z = pk2(S[4], S[5]); o.w = pk2(S[6], S[7]);
                *(u32x4*)(ST + u * NEL + idx) = o;
                const float u0 = bflo(uv[i].x), u1 = bfhi(uv[i].x), u2 = bflo(uv[i].y), u3 = bfhi(uv[i].y), u4 = bflo(uv[i].z), u5 = bfhi(uv[i].z), u6 = bflo(uv[i].w), u7 = bfhi(uv[i].w);
                if (MODE == 0) { const float atot = GSC[(size_t)(0 * 16 + bh) * T + c * CL + 127], mloc = atot + GSC[(size_t)(2 * 16 + bh) * T + c * CL + 127];
                    const float mnew = fmaxf(atot + m, mloc), so = __expf(atot + m - mnew), sl = __expf(mloc - mnew);
                    if (idx == 0) MPREV[u] = m;
                    S[0] = so * S[0] + sl * u0; S[1] = so * S[1] + sl * u1; S[2] = so * S[2] + sl * u2; S[3] = so * S[3] + sl * u3;
                    S[4] = so * S[4] + sl * u4; S[5] = so * S[5] + sl * u5; S[6] = so * S[6] + sl * u6; S[7] = so * S[7] + sl * u7; m = mnew; }
                else if (MODE == 1) { S[0] = rdec * S[0] + u0; S[1] = rdec * S[1] + u1; S[2] = rdec * S[2] + u2; S[3] = rdec * S[3] + u3; S[4] = rdec * S[4] + u4; S[5] = rdec * S[5] + u5; S[6] = rdec * S[6] + u6; S[7] = rdec * S[7] + u7; }
                else { const float* dp = DEC + (size_t)(b * NCH + c) * 512 + h * 128 + (idx & 127); const f32x4 d0 = *(const f32x4*)dp, d1 = *(const f32x4*)(dp + 4);
                    S[0] = d0[0] * S[0] + u0; S[1] = d0[1] * S[1] + u1; S[2] = d0[2] * S[2] + u2; S[3] = d0[3] * S[3] + u3; S[4] = d1[0] * S[4] + u4; S[5] = d1[1] * S[5] + u5; S[6] = d1[2] * S[6] + u6; S[7] = d1[3] * S[7] + u7; } }
        }
    }
    if (MODE == 0) {
        for (int el = gtid; el < NBH * 64; el += nthr) { const int bh = el >> 6, d = el & 63; float S = 0.f, m = -1e30f;
#pragma unroll 1
            for (int c0 = 0; c0 < NCH; c0 += 8) { float at[8], gm[8], nl[8];
#pragma unroll
                for (int i = 0; i < 8; ++i) { const int c = c0 + i; at[i] = GSC[(size_t)(0 * 16 + bh) * T + c * CL + 127]; gm[i] = GSC[(size_t)(2 * 16 + bh) * T + c * CL + 127]; nl[i] = NLOC[((size_t)bh * NCH + c) * 64 + d]; }
#pragma unroll
                for (int i = 0; i < 8; ++i) { const size_t u = (size_t)bh * NCH + c0 + i; const float atot = at[i], mloc = atot + gm[i];
                    const float mnew = fmaxf(atot + m, mloc), so = __expf(atot + m - mnew), sl = __expf(mloc - mnew);
                    NPREV[u * 64 + d] = S; S = so * S + sl * nl[i]; m = mnew; } } }
    }
}

template <int MODE>
__device__ __forceinline__ void mix_phaseC(const Frame& F, unsigned char* ws, const int tid, const int lane, const float* ng) {
    typedef MX<MODE> C; constexpr int DK = C::DK, DV = C::DV, NH = C::NH, LDP = C::LDP, VP = DV * 2 + 32, KP = DK * 2 + 16, SP = DK * 2 + 16, NET = DV / 16, NKS = DK / 32, DVT = NH * DV;
    constexpr int NSP = DV * DK / 8 / NTHREADS;
    LAS unsigned char* ldsV = F.lds; LAS unsigned char* ldsK = F.lds + 128 * VP; LAS unsigned char* ldsS = F.lds;
    LAS float* tabs = (LAS float*)(F.lds + 128 * VP + 128 * KP);
    static_assert(DV * SP <= 128 * VP + 128 * KP, "S^T image fits the stage-1 region");
    const bf16* PB = (const bf16*)(ws + WS_PB); const bf16* ST = (const bf16*)(ws + WS_ST);
    const float* GSC = (const float*)(ws + WS_SC); const float* NPREV = (const float*)(ws + WS_SC + 2 * MiB + 256 * 1024); const float* MPREV = (const float*)(ws + WS_SC + 2 * MiB + 512 * 1024);
    const int w = F.wave, g = lane >> 4, li = lane & 15;
    constexpr int NU = 2 * NH * NCH;
    u32x4 kr[DK / 32], vr[DV / 32], sreg[NSP];
#define PC_LOAD_KV(U_) do { const int c_ = (U_) % NCH, bh_ = (U_) / NCH, h_ = bh_ % NH, b_ = bh_ / NH; const char* pb_ = (const char*)(PB + ((size_t)b_ * T + (size_t)c_ * CL) * LDP); \
        const char* vb_ = pb_ + (C::VOFF + h_ * DV) * 2; const char* kb_ = pb_ + (C::KOFF + h_ * DK) * 2; int t_ = tid; asm volatile("" : "+v"(t_));     \
        _Pragma("unroll") for (int i = 0; i < DV / 32; ++i) { const int p = t_ + i * NTHREADS, r = p / (DV / 8), cp = p % (DV / 8); vr[i] = *(const u32x4*)(vb_ + (unsigned)(r * LDP + cp * 8) * 2u); } \
        _Pragma("unroll") for (int i = 0; i < DK / 32; ++i) { const int p = t_ + i * NTHREADS, r = p / (DK / 8), cp = p % (DK / 8); kr[i] = *(const u32x4*)(kb_ + (unsigned)(r * LDP + cp * 8) * 2u); } } while (0)
#define PC_LOAD_S(U_) do { const bf16* st_ = ST + (size_t)(U_) * DV * DK; _Pragma("unroll") for (int i = 0; i < NSP; ++i) sreg[i] = *(const u32x4*)(st_ + (size_t)(tid + i * NTHREADS) * 8); } while (0)
    if ((int)blockIdx.x < NU) { PC_LOAD_KV((int)blockIdx.x); }
    for (int u = blockIdx.x; u < NU; u += F.G) {
        const int c = u % NCH, bh = u / NCH, h = bh % NH, b = bh / NH; const size_t row0 = (size_t)b * T + (size_t)c * CL;
        const float lg = (MODE == 1) ? ret_lg2gamma(h) : 0.f;
        const int tq = 16 * w + li;
        const bf16* qrow = PB + (row0 + tq) * LDP + h * DK;
        bf16x8 qf[NKS];
#pragma unroll
        for (int ks = 0; ks < NKS; ++ks) qf[ks] = *(const bf16x8*)(qrow + 32 * ks + 8 * g);
        PC_LOAD_S(u);
        __syncthreads();
#pragma unroll
        for (int i = 0; i < DV / 32; ++i) { const int p = tid + i * NTHREADS, r = p / (DV / 8), cp = p % (DV / 8); *(LAS u32x4*)(ldsV + r * VP + cp * 16) = vr[i]; }
#pragma unroll
        for (int i = 0; i < DK / 32; ++i) { const int p = tid + i * NTHREADS, r = p / (DK / 8), cp = p % (DK / 8); *(LAS u32x4*)(ldsK + r * KP + cp * 16) = kr[i]; }
        if (u + F.G < NU) PC_LOAD_KV(u + F.G);
        if (MODE == 0 && tid < 128) { const float mp = MPREV[u]; const size_t gi = (size_t)bh * T + c * CL + tid;
            const float a = GSC[(size_t)(0 * 16) * T + gi], gg = GSC[(size_t)(1 * 16) * T + gi], cm = GSC[(size_t)(2 * 16) * T + gi];
            const float Mt = fmaxf(mp, cm);
            tabs[tid] = gg; tabs[128 + tid] = Mt; tabs[256 + tid] = __expf(mp - Mt) * 0.125f; tabs[384 + tid] = __expf(-(a + Mt)); }
        __syncthreads();
        f32x4 O[NET];
#pragma unroll
        for (int et = 0; et < NET; ++et) O[et] = (f32x4){0.f, 0.f, 0.f, 0.f};
        float den = 0.f;
        const float Mq = (MODE == 0) ? tabs[128 + tq] : 0.f;
        const float qs = (MODE == 0) ? tabs[256 + tq] : (MODE == 1) ? exp2f((float)(tq + 1) * lg) : 1.f;
        const float fin = (MODE == 0) ? tabs[384 + tq] : 1.f;
        for (int jp = 0; jp <= (w >> 1); ++jp) {
            f32x4 p0 = (f32x4){0.f, 0.f, 0.f, 0.f}, p1 = (f32x4){0.f, 0.f, 0.f, 0.f};
            const LAS unsigned char* k0p = ldsK + (32 * jp + li) * KP + 16 * g;
#pragma unroll
            for (int ks = 0; ks < NKS; ++ks) p0 = __builtin_amdgcn_mfma_f32_16x16x32_bf16(*(const LAS bf16x8*)(k0p + 64 * ks), qf[ks], p0, 0, 0, 0);
            if (2 * jp + 1 <= w) {
#pragma unroll
                for (int ks = 0; ks < NKS; ++ks) p1 = __builtin_amdgcn_mfma_f32_16x16x32_bf16(*(const LAS bf16x8*)(k0p + 16 * KP + 64 * ks), qf[ks], p1, 0, 0, 0);
            }
#pragma unroll
            for (int r = 0; r < 4; ++r) {
                const int s0 = 32 * jp + 4 * g + r, s1 = s0 + 16;
                float f0, f1;
                if (MODE == 0) { f0 = __expf(tabs[s0] - Mq) * 0.125f; f1 = __expf(tabs[s1] - Mq) * 0.125f; }
                else if (MODE == 1) { f0 = exp2f((float)(tq - s0) * lg); f1 = exp2f((float)(tq - s1) * lg); }
                else { f0 = 1.f; f1 = 1.f; }
                p0[r] = (s0 <= tq) ? p0[r] * f0 : 0.f; p1[r] = (s1 <= tq) ? p1[r] * f1 : 0.f;
                den += p0[r] + p1[r];
            }
            bf16x8 af; { const unsigned a0 = pk2(p0[0], p0[1]), a1 = pk2(p0[2], p0[3]), a2 = pk2(p1[0], p1[1]), a3 = pk2(p1[2], p1[3]); u32x4 t4; t4.x = a0; t4.y = a1; t4.z = a2; t4.w = a3; af = __builtin_bit_cast(bf16x8, t4); }
#pragma unroll
            for (int et = 0; et < NET; ++et) O[et] = __builtin_amdgcn_mfma_f32_16x16x32_bf16(af, tr_frag(ldsV, VP, 32 * jp, 16 * et, lane), O[et], 0, 0, 0);
        }
        __syncthreads();
#pragma unroll
        for (int i = 0; i < NSP; ++i) { const int p = tid + i * NTHREADS, e = p / (DK / 8), cp = p % (DK / 8); *(LAS u32x4*)(ldsS + e * SP + cp * 16) = sreg[i]; }
        __syncthreads();
        bf16* YBp = (bf16*)(ws + WS_YB);
        const int rr = lane >> 3, pq = lane & 7;
        const bf16* gpr = PB + (row0 + 16 * w + rr) * LDP + C::GOFF + h * DV + pq * 8; bf16* ypr = YBp + (row0 + 16 * w + rr) * DVT + h * DV + pq * 8;
        asm volatile("" : "+v"(gpr), "+v"(ypr));
        u32x4 gvv[2][DV / 64];
#pragma unroll
        for (int hf = 0; hf < 2; ++hf)
#pragma unroll
            for (int it = 0; it < DV / 64; ++it) gvv[hf][it] = *(const u32x4*)(gpr + (size_t)(8 * (it & 1)) * LDP + hf * (DV / 2) + 64 * (it >> 1));
        float dint = 0.f;
#pragma unroll
        for (int ks = 0; ks < NKS; ++ks) {
            bf16x8 aq = qf[ks];
            if (MODE != 2) aq = __builtin_bit_cast(bf16x8, scale_bf16x8(__builtin_bit_cast(u32x4, qf[ks]), qs));
            if (MODE == 0) { const float* np = NPREV + (size_t)u * 64 + 32 * ks + 8 * g; const u32x4 qa = __builtin_bit_cast(u32x4, aq);
                dint += bflo(qa.x) * np[0] + bfhi(qa.x) * np[1] + bflo(qa.y) * np[2] + bfhi(qa.y) * np[3] + bflo(qa.z) * np[4] + bfhi(qa.z) * np[5] + bflo(qa.w) * np[6] + bfhi(qa.w) * np[7]; }
#pragma unroll
            for (int et = 0; et < NET; ++et) O[et] = __builtin_amdgcn_mfma_f32_16x16x32_bf16(aq, *(const LAS bf16x8*)(ldsS + (16 * et + li) * SP + 64 * ks + 16 * g), O[et], 0, 0, 0);
        }
        float rd[4] = {1.f, 1.f, 1.f, 1.f};
        if (MODE == 0) {
            float dt = den + dint; dt += __shfl_xor(dt, 16); dt += __shfl_xor(dt, 32);
            LAS float* wsc = tabs + 512 + 16 * w;
            if (g == 0) wsc[li] = __builtin_amdgcn_rcpf(fmaxf(fabsf(dt), fin));
            asm volatile("s_waitcnt lgkmcnt(0)" ::: "memory");
#pragma unroll
            for (int r = 0; r < 4; ++r) rd[r] = wsc[4 * g + r];
        }
        float mean[4], rstd[4];
#pragma unroll
        for (int r = 0; r < 4; ++r) { float sacc = 0.f;
#pragma unroll
            for (int et = 0; et < NET; ++et) { O[et][r] *= rd[r]; sacc += O[et][r]; }
            sacc = row16_sum(sacc);
            mean[r] = sacc * (1.f / DV); float q = 0.f;
#pragma unroll
            for (int et = 0; et < NET; ++et) { const float dlt = O[et][r] - mean[r]; q += dlt * dlt; }
            q = row16_sum(q);
            rstd[r] = __builtin_amdgcn_rsqf(q * (1.f / DV) + LN_EPS); }
        constexpr int RPF = DV * 2 + 16, TB = (MODE == 0) ? (128 * VP + 128 * KP + 2560) : DV * SP;
        static_assert(TB + NWAVES * 16 * RPF <= PH_BYTES && TB % 16 == 0, "epilogue tiles fit");
        LAS unsigned char* tw = F.lds + TB + w * (16 * RPF);
        const float* ngp = ng + h * DV + li;
#define GATEF(x_) ((MODE == 0) ? sigmoidf_(x_) : (x_) * sigmoidf_(x_))
#pragma unroll
        for (int hf = 0; hf < 2; ++hf) {
#pragma unroll
            for (int e2 = 0; e2 < NET / 2; ++e2) { const int et = hf * (NET / 2) + e2; const float gn = ngp[16 * et];
#pragma unroll
                for (int r = 0; r < 4; ++r) *(LAS float*)(tw + (4 * g + r) * RPF + (16 * e2 + li) * 4) = (O[et][r] - mean[r]) * rstd[r] * gn; }
            asm volatile("s_waitcnt lgkmcnt(0)" ::: "memory");
#pragma unroll
            for (int it = 0; it < DV / 64; ++it) { const int rb = 8 * (it & 1), cb = 64 * (it >> 1);
                const u32x4 gv = gvv[hf][it];
                const LAS float* tp = (const LAS float*)(tw + (rb + rr) * RPF + (cb + pq * 8) * 4);
                const f32x4 n0 = *(const LAS f32x4*)tp, n1 = *(const LAS f32x4*)(tp + 4);
                const float g0 = bflo(gv.x), g1 = bfhi(gv.x), g2 = bflo(gv.y), g3 = bfhi(gv.y), g4 = bflo(gv.z), g5 = bfhi(gv.z), g6 = bflo(gv.w), g7 = bfhi(gv.w);
                u32x4 o; o.x = pk2(GATEF(g0) * n0[0], GATEF(g1) * n0[1]); o.y = pk2(GATEF(g2) * n0[2], GATEF(g3) * n0[3]);
                o.z = pk2(GATEF(g4) * n1[0], GATEF(g5) * n1[1]); o.w = pk2(GATEF(g6) * n1[2], GATEF(g7) * n1[3]);
                *(u32x4*)(ypr + (size_t)rb * DVT + hf * (DV / 2) + cb) = o; }
            asm volatile("s_waitcnt lgkmcnt(0)" ::: "memory");
        }
#undef GATEF
    }
    __syncthreads();
#undef PC_LOAD_KV
#undef PC_LOAD_S
}

constexpr int SLN = 32, NCI = T / SLN, NI = 2 * NCI, NRT = NI / 16, SKK = SLN * 16;
__device__ __forceinline__ void s5_pow(const f32x4 cf, float n, float& pr, float& pi) { const float e = __expf(n * cf[0]); const float a = n * cf[1]; pr = e * __cosf(a); pi = e * __sinf(a); }

__device__ __forceinline__ void s5_tables(const Frame& F, unsigned char* ws, const int tid, const float* lam_re, const float* lam_im, const float* b_re, const float* b_im, const float* c_re, const float* c_im, const float* log_dt) {
    bf16* KT = (bf16*)(ws + WS_S5KT); bf16* VT = (bf16*)(ws + WS_S5VT); bf16* WT = (bf16*)(ws + WS_S5WT); float* L64 = (float*)(ws + WS_S5L64);
    LAS f32x4* CF = (LAS f32x4*)F.lds;
    for (int i = tid; i < 64 * 64; i += NTHREADS) { const int g = i >> 6; const float lr = lam_re[i], li = lam_im[i], dt = expf(log_dt[g]);
        const float er = expf(lr * dt); float sn, cs; sincosf(li * dt, &sn, &cs);
        const float nr = er * cs - 1.f, ni = er * sn, den = lr * lr + li * li;
        CF[i] = (f32x4){lr * dt, li * dt, (nr * lr + ni * li) / den, (ni * lr - nr * li) / den}; }
    __syncthreads();
    const int gt = blockIdx.x * NTHREADS + tid, nthr = F.G * NTHREADS;
    LAS float* BR = (LAS float*)(F.lds + 65536); LAS float* BI = BR + 1024; LAS float* CR = BI + 1024; LAS float* CI = CR + 1024;
    for (int i0 = blockIdx.x * NTHREADS; i0 < 64 * SLN * 16 * 4; i0 += nthr) {
        const int g = i0 / (64 * SLN);
        __syncthreads();
        for (int q = tid; q < 1024; q += NTHREADS) { BR[q] = b_re[(size_t)g * 1024 + q]; BI[q] = b_im[(size_t)g * 1024 + q]; CR[q] = c_re[(size_t)g * 1024 + q]; CI[q] = c_im[(size_t)g * 1024 + q]; }
        __syncthreads();
        const int i4 = i0 + tid, pq = i4 & 3, idx = i4 >> 2, h = idx & 15, tau = (idx >> 4) % SLN;
        float acc[16];
#pragma unroll
        for (int q = 0; q < 16; ++q) acc[q] = 0.f;
#pragma unroll 4
        for (int p = pq * 16; p < pq * 16 + 16; ++p) { const f32x4 cf = CF[g * 64 + p]; float pr, pi; s5_pow(cf, (float)tau, pr, pi);
            const float cr = CR[h * 64 + p], ci = CI[h * 64 + p];
            const float xr = cr * pr - ci * pi, xi = cr * pi + ci * pr;
            const float yr = xr * cf[2] - xi * cf[3], yi = xr * cf[3] + xi * cf[2];
            const LAS f32x4* br4 = (const LAS f32x4*)(BR + p * 16); const LAS f32x4* bi4 = (const LAS f32x4*)(BI + p * 16);
#pragma unroll
            for (int q = 0; q < 4; ++q) { const f32x4 b_r = br4[q], b_i = bi4[q];
#pragma unroll
                for (int z = 0; z < 4; ++z) acc[4 * q + z] += yr * b_r[z] - yi * b_i[z]; } }
#pragma unroll
        for (int q = 0; q < 16; ++q) { acc[q] += dpp_f<0xB1>(acc[q]); acc[q] += dpp_f<0x4E>(acc[q]); }
        if (pq == 0) { u32x4 o0, o1; o0.x = pk2(acc[0], acc[1]); o0.y = pk2(acc[2], acc[3]); o0.z = pk2(acc[4], acc[5]); o0.w = pk2(acc[6], acc[7]);
            o1.x = pk2(acc[8], acc[9]); o1.y = pk2(acc[10], acc[11]); o1.z = pk2(acc[12], acc[13]); o1.w = pk2(acc[14], acc[15]);
            *(u32x4*)(KT + (size_t)idx * 16) = o0; *(u32x4*)(KT + (size_t)idx * 16 + 8) = o1; } }
    for (int idx = gt; idx < 64 * 64 * SLN; idx += nthr) {
        const int j = idx % SLN, p = (idx / SLN) & 63, g = idx / (SLN * 64);
        const f32x4 cf = CF[g * 64 + p]; float pr, pi;
        s5_pow(cf, (float)(SLN - 1 - j), pr, pi);
        const float yr = pr * cf[2] - pi * cf[3], yi = pr * cf[3] + pi * cf[2];
        const float* br = b_re + (size_t)(g * 64 + p) * 16; const float* bi = b_im + (size_t)(g * 64 + p) * 16;
        float vr[16], vi[16];
#pragma unroll
        for (int q = 0; q < 16; ++q) { vr[q] = yr * br[q] - yi * bi[q]; vi[q] = yr * bi[q] + yi * br[q]; }
        bf16* v0 = VT + ((size_t)(g * 128 + 2 * p) * SKK + j * 16);
        u32x4 o; o.x = pk2(vr[0], vr[1]); o.y = pk2(vr[2], vr[3]); o.z = pk2(vr[4], vr[5]); o.w = pk2(vr[6], vr[7]); *(u32x4*)v0 = o;
        o.x = pk2(vr[8], vr[9]); o.y = pk2(vr[10], vr[11]); o.z = pk2(vr[12], vr[13]); o.w = pk2(vr[14], vr[15]); *(u32x4*)(v0 + 8) = o;
        o.x = pk2(vi[0], vi[1]); o.y = pk2(vi[2], vi[3]); o.z = pk2(vi[4], vi[5]); o.w = pk2(vi[6], vi[7]); *(u32x4*)(v0 + SKK) = o;
        o.x = pk2(vi[8], vi[9]); o.y = pk2(vi[10], vi[11]); o.z = pk2(vi[12], vi[13]); o.w = pk2(vi[14], vi[15]); *(u32x4*)(v0 + SKK + 8) = o;
        if (j == 0) { s5_pow(cf, (float)SLN, pr, pi); L64[(g * 64 + p) * 2] = pr; L64[(g * 64 + p) * 2 + 1] = pi; }
    }
    for (int idx = gt; idx < 64 * 64 * SLN; idx += nthr) {
        const int p = idx & 63, l = (idx >> 6) % SLN, g = idx / (SLN * 64);
        const f32x4 cf = CF[g * 64 + p]; float pr, pi; s5_pow(cf, (float)(l + 1), pr, pi);
#pragma unroll
        for (int h = 0; h < 16; ++h) { const float cr = c_re[(g * 16 + h) * 64 + p], ci = c_im[(g * 16 + h) * 64 + p];
            *(unsigned*)(WT + ((size_t)((g * SLN + l) * 16 + h) * 128 + 2 * p)) = pk2(cr * pr - ci * pi, -(cr * pi + ci * pr)); }
    }
    __syncthreads();
}
__device__ __forceinline__ void s5_phaseA(const Frame& F, unsigned char* ws, const int lane) {
    const bf16* PB = (const bf16*)(ws + WS_PB); const bf16* VT = (const bf16*)(ws + WS_S5VT); float* SL = (float*)(ws + WS_S5SL);
    const int gq = lane >> 4, li = lane & 15;
    for (int wu = F.gw; wu < 64 * NRT * 2; wu += F.NGW) {
        const int half = wu & 1, rt = (wu >> 1) % NRT, g = wu / (2 * NRT), b = rt / (NRT / 2), c0 = (rt % (NRT / 2)) * 16;
        f32x4 acc[4];
#pragma unroll
        for (int ct = 0; ct < 4; ++ct) acc[ct] = (f32x4){0.f, 0.f, 0.f, 0.f};
        const bf16* ap = PB + ((size_t)b * T + (size_t)(c0 + li) * SLN + (gq >> 1)) * 1024 + g * 16 + 8 * (gq & 1);
        const bf16* bp = VT + (size_t)(g * 128 + half * 64 + li) * SKK + 8 * gq;
#pragma unroll 4
        for (int ks = 0; ks < SLN / 2; ++ks) {
            const bf16x8 af = *(const bf16x8*)(ap + (size_t)(2 * ks) * 1024);
#pragma unroll
            for (int ct = 0; ct < 4; ++ct) acc[ct] = __builtin_amdgcn_mfma_f32_16x16x32_bf16(af, *(const bf16x8*)(bp + (size_t)(16 * ct) * SKK + 32 * ks), acc[ct], 0, 0, 0);
        }
#pragma unroll
        for (int ct = 0; ct < 4; ++ct)
#pragma unroll
            for (int r = 0; r < 4; ++r) SL[(size_t)(g * NI + rt * 16 + 4 * gq + r) * 128 + half * 64 + ct * 16 + li] = acc[ct][r];
    }
}
__device__ __forceinline__ void s5_phaseB(const Frame& F, unsigned char* ws, const int tid) {
    static_assert(NCI == 256, "16 groups of 16 chunks");
    const float* SL = (const float*)(ws + WS_S5SL); bf16* SP = (bf16*)(ws + WS_S5SP); const float* L64 = (const float*)(ws + WS_S5L64);
    for (int gt = blockIdx.x * NTHREADS + tid; gt < 2 * 64 * 64 * 16; gt += F.G * NTHREADS) {
        const int grp = gt & 15, p = (gt >> 4) & 63, g = (gt >> 10) & 63, b = gt >> 16;
        const float ar = L64[(g * 64 + p) * 2], ai = L64[(g * 64 + p) * 2 + 1];
        const size_t base = (size_t)(g * NI + b * NCI + grp * 16) * 128 + 2 * p;
        f32x2 x[16];
#pragma unroll
        for (int i = 0; i < 16; ++i) x[i] = *(const f32x2*)(SL + base + (size_t)i * 128);
        float lr[16], li[16], sr = 0.f, si = 0.f;
#pragma unroll
        for (int i = 0; i < 16; ++i) { lr[i] = sr; li[i] = si; const float nr = ar * sr - ai * si + x[i][0], ni = ar * si + ai * sr + x[i][1]; sr = nr; si = ni; }
        float mr = ar, mi = ai;
#pragma unroll
        for (int k = 0; k < 4; ++k) { const float t = mr * mr - mi * mi; mi = 2.f * mr * mi; mr = t; }
#define S5_STEP(CTRL) do { const float tr = __builtin_bit_cast(float, __builtin_amdgcn_update_dpp(0, __builtin_bit_cast(int, sr), CTRL, 0xf, 0xf, true)), ti = __builtin_bit_cast(float, __builtin_amdgcn_update_dpp(0, __builtin_bit_cast(int, si), CTRL, 0xf, 0xf, true)); \
            sr += mr * tr - mi * ti; si += mr * ti + mi * tr; const float t2 = mr * mr - mi * mi; mi = 2.f * mr * mi; mr = t2; } while (0)
        S5_STEP(0x111); S5_STEP(0x112); S5_STEP(0x114); S5_STEP(0x118);
#undef S5_STEP
        const float pr = __builtin_bit_cast(float, __builtin_amdgcn_update_dpp(0, __builtin_bit_cast(int, sr), 0x111, 0xf, 0xf, true)), pi = __builtin_bit_cast(float, __builtin_amdgcn_update_dpp(0, __builtin_bit_cast(int, si), 0x111, 0xf, 0xf, true));
        float qr = 1.f, qi = 0.f;
#pragma unroll
        for (int i = 0; i < 16; ++i) { const float orr = qr * pr - qi * pi + lr[i], oi = qr * pi + qi * pr + li[i];
            *(unsigned*)(SP + base + (size_t)i * 128) = pk2(orr, oi);
            const float t = qr * ar - qi * ai; qi = qr * ai + qi * ar; qr = t; }
    }
}
__device__ __forceinline__ void s5_phaseC(const Frame& F, unsigned char* ws, const int lane, const float* dskip) {
    const bf16* PB = (const bf16*)(ws + WS_PB); const bf16* KT = (const bf16*)(ws + WS_S5KT); const bf16* WT = (const bf16*)(ws + WS_S5WT); const bf16* SP = (const bf16*)(ws + WS_S5SP);
    bf16* YB = (bf16*)(ws + WS_YB);
    const int gq = lane >> 4, li = lane & 15;
#pragma unroll 1
    for (int wu = F.gw; wu < 64 * NRT * 2; wu += F.NGW) {
        const int par = wu & 1, rt = (wu >> 1) % NRT, g = wu / (2 * NRT), b = rt / (NRT / 2), c0 = (rt % (NRT / 2)) * 16;
        bf16x8 af[SLN / 2], sf[4];
        const bf16* ap = PB + ((size_t)b * T + (size_t)(c0 + li) * SLN + (gq >> 1)) * 1024 + g * 16 + 8 * (gq & 1);
#pragma unroll
        for (int ks = 0; ks < SLN / 2; ++ks) af[ks] = *(const bf16x8*)(ap + (size_t)(2 * ks) * 1024);
#pragma unroll
        for (int ks = 0; ks < 4; ++ks) sf[ks] = *(const bf16x8*)(SP + (size_t)(g * NI + rt * 16 + li) * 128 + 32 * ks + 8 * gq);
        const f32x4 dl = *(const f32x4*)(dskip + g * 16 + 4 * gq);
        const bf16* ktp = KT + (size_t)g * SLN * 256 + li * 16 + 8 * (gq & 1);
#pragma unroll
        for (int l2 = 0; l2 < SLN / 2; ++l2) {
            int l = 2 * l2 + par; asm volatile("" : "+v"(l));
            f32x4 acc = (f32x4){0.f, 0.f, 0.f, 0.f};
#pragma unroll
            for (int ks = 0; ks <= l2; ++ks) { const int tau = l - 2 * ks - (gq >> 1);
                bf16x8 bfv = *(const bf16x8*)(ktp + (size_t)(tau < 0 ? 0 : tau) * 256);
                if (ks == l2 && tau < 0) bfv = (bf16x8){0, 0, 0, 0, 0, 0, 0, 0};
                acc = __builtin_amdgcn_mfma_f32_16x16x32_bf16(bfv, af[ks], acc, 0, 0, 0); }
            const bf16* wp = WT + (size_t)((g * SLN + l) * 16 + li) * 128 + 8 * gq;
#pragma unroll
            for (int ks = 0; ks < 4; ++ks) acc = __builtin_amdgcn_mfma_f32_16x16x32_bf16(*(const bf16x8*)(wp + 32 * ks), sf[ks], acc, 0, 0, 0);
            { const size_t row = (size_t)b * T + (size_t)(c0 + li) * SLN + l; const size_t o = row * 1024 + g * 16 + 4 * gq;
                const uint2 uv = *(const uint2*)(PB + o);
                uint2 ov; ov.x = pk2(gelu_tanh(acc[0] + dl[0] * bflo(uv.x)), gelu_tanh(acc[1] + dl[1] * bfhi(uv.x))); ov.y = pk2(gelu_tanh(acc[2] + dl[2] * bflo(uv.y)), gelu_tanh(acc[3] + dl[3] * bfhi(uv.y)));
                *(uint2*)(YB + o) = ov; }
            asm volatile("" ::: "memory");
        }
    }
}

#define IN(k) (lo <= (k) && (k) < hi)
#define SEAM(k) do { if ((k) + 1 < hi) { xcd_barrier(bar, F.wave); if (PROBE_CLS == 10) xcd_barrier(bar, F.wave); if (PROBE_T >= 0) stamp_fn(F.lds, F.wave, (k)); } } while (0)
#define INP(i) inp_ptr(F.lds, (i))
#define x_in INP(0)
#define ln_g INP(1)
#define ln_b INP(2)
#define WS_PTRS \
    float* HF = (float*)(ws + WS_HF); bf16* XB = (bf16*)(ws + WS_XB); bf16* ZF = (bf16*)(ws + WS_ZF); bf16* PB = (bf16*)(ws + WS_PB); \
    float* GB = (float*)(ws + WS_GB); float* LA = (float*)(ws + WS_LA); float* ORAW = (float*)(ws + WS_ORAW); bf16* YB = (bf16*)(ws + WS_YB); \
    bf16* ACT = (bf16*)(ws + WS_ACT); bf16* YS = (bf16*)(ws + WS_YS); bf16* XG = (bf16*)(ws + WS_XG); \
    int* LIST = (int*)(ws + WS_LIST); float* GW = (float*)(ws + WS_ORAW); \
    float* S5LB = (float*)(ws + WS_S5TAB); float* S5BB = (float*)(ws + WS_S5TAB + 32768); \
    (void)HF; (void)XB; (void)ZF; (void)PB; (void)GB; (void)LA; (void)ORAW; (void)YB; (void)ACT; (void)YS; (void)XG; (void)LIST; (void)GW; (void)S5LB; (void)S5BB;

template <int layer>
__device__ __forceinline__ void layer_body(const Frame& F, unsigned char* ws, unsigned* ctl, LAS int* TAB, const XcdBarrier& bar, const int lo, const int hi, float* d_out) {
    WS_PTRS
        const int pb = 1 + layer * 16;
        const float* hin = (layer == 0) ? x_in : HF;
        if (PHE(1) && IN(pb + 0)) {
            const bf16* Wt = (const bf16*)(ws + (layer == 0 ? WS_WT_ML_IN : layer == 1 ? WS_WT_RET_IN : layer == 2 ? WS_WT_GLA_IN : WS_WT_S5_IN));
            const int N = (layer == 0 || layer == 2) ? 3072 : (layer == 1 ? 6144 : 1024);
            pg8::DenseOrder S; S.init(XB, Wt, M, N, D, F.G, (int)blockIdx.x);
            pg8::EpiBf16 E{PB, N, (const float*)(ws + WS_CS), (layer == 1) ? 8 : 0};
            for (int rep_ = 0; rep_ < REPS(2); ++rep_)
            pg8::gemm_phase<pg8::EpiBf16, pg8::DenseOrder, true, true>(F.lds, F.wave, D, S, E);
            if (layer == 0 && CH_ML) {
                const int lane = lane_id(); float* GSC = (float*)(ws + WS_SC);
                for (int wu = F.gw; wu < 16 * NCH; wu += F.NGW) { const int bh = wu / NCH, c = wu % NCH, b = bh >> 3, h = bh & 7;
                    const int t0 = c * CL + 2 * lane; const size_t row = (size_t)b * T + t0;
                    const float lf0 = log_sigmoidf_(GB[row * 16 + 8 + h]), lf1 = log_sigmoidf_(GB[(row + 1) * 16 + 8 + h]);
                    const float sp = lf0 + lf1; float inc = sp;
#pragma unroll
                    for (int d = 1; d < 64; d <<= 1) { const float tv_ = __shfl_up(inc, d); if (lane >= d) inc += tv_; }
                    const float a0 = inc - sp + lf0, a1 = inc;
                    const float g0 = GB[row * 16 + h] - a0, g1 = GB[(row + 1) * 16 + h] - a1;
                    float mx = fmaxf(g0, g1);
#pragma unroll
                    for (int d = 1; d < 64; d <<= 1) { const float tv_ = __shfl_up(mx, d); if (lane >= d) mx = fmaxf(mx, tv_); }
                    float ex = __shfl_up(mx, 1); if (lane == 0) ex = -3.0e38f;
                    const size_t o0 = (size_t)bh * T + t0;
                    *(f32x2*)(GSC + (size_t)(0 * 16) * T + o0) = (f32x2){a0, a1};
                    *(f32x2*)(GSC + (size_t)(1 * 16) * T + o0) = (f32x2){g0, g1};
                    *(f32x2*)(GSC + (size_t)(2 * 16) * T + o0) = (f32x2){fmaxf(ex, g0), mx}; }
            }
            SEAM(pb + 0);
        }
        if (layer == 0) {
            if (CH_ML) {
                if (IN(pb + 2)) { const int lane = lane_id(), tid = F.wave * 64 + lane; for (int rep_ = 0; rep_ < REPS(6); ++rep_) mix_phaseA<0>(F, ws, tid, lane); SEAM(pb + 2); }
                if (IN(pb + 3)) { const int lane = lane_id(), tid = F.wave * 64 + lane; for (int rep_ = 0; rep_ < REPS(7); ++rep_) mix_phaseB<0>(F, ws, tid); SEAM(pb + 3); }
                if (IN(pb + 4)) { const int lane = lane_id(), tid = F.wave * 64 + lane; for (int rep_ = 0; rep_ < REPS(8); ++rep_) mix_phaseC<0>(F, ws, tid, lane, INP(5)); SEAM(pb + 4); }
            }
        } else if (layer == 1) {
            if (CH_RET) {
                if (IN(pb + 2)) { const int lane = lane_id(), tid = F.wave * 64 + lane; for (int rep_ = 0; rep_ < REPS(6); ++rep_) mix_phaseA<1>(F, ws, tid, lane); SEAM(pb + 2); }
                if (IN(pb + 3)) { const int lane = lane_id(), tid = F.wave * 64 + lane; for (int rep_ = 0; rep_ < REPS(7); ++rep_) mix_phaseB<1>(F, ws, tid); SEAM(pb + 3); }
                if (IN(pb + 4)) { const int lane = lane_id(), tid = F.wave * 64 + lane; for (int rep_ = 0; rep_ < REPS(8); ++rep_) mix_phaseC<1>(F, ws, tid, lane, INP(8)); SEAM(pb + 4); }
            }
        } else if (layer == 2) {
            if (CH_GLA) {
                if (IN(pb + 2)) { const int lane = lane_id(), tid = F.wave * 64 + lane; for (int rep_ = 0; rep_ < REPS(6); ++rep_) mix_phaseA<2>(F, ws, tid, lane); SEAM(pb + 2); }
                if (IN(pb + 3)) { const int lane = lane_id(), tid = F.wave * 64 + lane; for (int rep_ = 0; rep_ < REPS(7); ++rep_) mix_phaseB<2>(F, ws, tid); SEAM(pb + 3); }
                if (IN(pb + 4)) { const int lane = lane_id(), tid = F.wave * 64 + lane; for (int rep_ = 0; rep_ < REPS(8); ++rep_) mix_phaseC<2>(F, ws, tid, lane, INP(13)); SEAM(pb + 4); }
            }
        } else {
            if (CH_S5) {
                if (IN(pb + 2)) { const int lane = lane_id(); for (int rep_ = 0; rep_ < REPS(6); ++rep_) s5_phaseA(F, ws, lane); SEAM(pb + 2); }
                if (IN(pb + 3)) { const int lane = lane_id(), tid = F.wave * 64 + lane; for (int rep_ = 0; rep_ < REPS(7); ++rep_) s5_phaseB(F, ws, tid); SEAM(pb + 3); }
                if (IN(pb + 4)) { const int lane = lane_id(); for (int rep_ = 0; rep_ < REPS(8); ++rep_) s5_phaseC(F, ws, lane, INP(22)); SEAM(pb + 4); }
            }
        }
        if (PHE(4) && layer == 3 && IN(pb + 6)) {
            pg8::DenseOrder S; S.init(YB, ws + WS_WT_S5_GLU, M, D, D, F.G, (int)blockIdx.x);
            pg8::EpiGlu E{YB, INP(25), (bf16*)ORAW};
            for (int rep_ = 0; rep_ < REPS(3); ++rep_)
            pg8::gemm_phase<pg8::EpiGlu, pg8::DenseOrder, true, true>(F.lds, F.wave, D, S, E);
            SEAM(pb + 6);
        }
        if (PHE(5) && IN(pb + 7)) {
            const bf16* Wt = (const bf16*)(ws + (layer == 0 ? WS_WT_ML_OUT : layer == 1 ? WS_WT_RET_OUT : layer == 2 ? WS_WT_GLA_OUT : WS_WT_S5_OUT));
            const int Kd = (layer == 1) ? 2048 : 1024;
            const bf16* Ain = (layer == 3) ? (const bf16*)ORAW : YB;
            pg8::DenseOrder S; S.init(Ain, Wt, M, D, Kd, F.G, (int)blockIdx.x);
            pg8::EpiResid E{hin, (layer == 0) ? (const bf16*)nullptr : (const bf16*)XB, ZF};
            for (int rep_ = 0; rep_ < REPS(3); ++rep_)
            pg8::gemm_phase<pg8::EpiResid, pg8::DenseOrder, true, true>(F.lds, F.wave, Kd, S, E);
            SEAM(pb + 7);
        }
        unsigned* cnt = ctl + CW_CNT + layer * 32 * 64;
        if (IN(pb + 8) && !defined_SKIP_LN1) { const int lane = lane_id(), tid = F.wave * 64 + lane; (void)tid;
            LAS float* Wt = (LAS float*)(F.lds);
            { const f32x4* wr4 = (const f32x4*)(INP(27) + (size_t)layer * D * NEXP);
              f32x4 wv[16];
#pragma unroll
              for (int i = 0; i < 16; ++i) wv[i] = wr4[tid + i * NTHREADS];
#pragma unroll
              for (int i = 0; i < 16; ++i) { const int q = tid + i * NTHREADS, k = q >> 3, e0 = (q & 7) * 4;
                  Wt[(e0 + 0) * 1028 + k] = wv[i][0]; Wt[(e0 + 1) * 1028 + k] = wv[i][1]; Wt[(e0 + 2) * 1028 + k] = wv[i][2]; Wt[(e0 + 3) * 1028 + k] = wv[i][3]; } }
            __syncthreads();
            const float* br_ = INP(28) + layer * NEXP;
            const float* lng_ = ln_g + (size_t)(layer * 2 + 0) * D; const float* lnb_ = ln_b + (size_t)(layer * 2 + 0) * D;
          {
            unsigned* cntp = cnt;
            int aE = 0, aRow = -1; float aG = 0.f;
            LAS unsigned* lcnt = (LAS unsigned*)(F.lds + 131584); LAS int* lbase = (LAS int*)(lcnt + 32);
            if (tid < 32) lcnt[tid] = 0u;
            const int ntrip = (M + F.NGW - 1) / F.NGW;
            u32x2 vnext[2][4];
#pragma unroll
            for (int q = 0; q < 2; ++q) { const int r_ = F.gw + q * F.NGW; if (r_ < M) { const u32x2* zp = (const u32x2*)(ZF + (size_t)r_ * D) + lane;
#pragma unroll
                for (int j = 0; j < 4; ++j) vnext[q][j] = zp[64 * j]; } }
            for (int it_ = 0; it_ < ntrip; it_ += 2) { const int row0_ = F.gw + it_ * F.NGW;
                asm volatile("" ::: "memory");
                const bool ok[2] = {row0_ < M, it_ + 1 < ntrip && row0_ + F.NGW < M};
                f32x4 v[2][4];
#pragma unroll
                for (int q = 0; q < 2; ++q)
#pragma unroll
                    for (int j = 0; j < 4; ++j) v[q][j] = (f32x4){bflo(vnext[q][j].x), bfhi(vnext[q][j].x), bflo(vnext[q][j].y), bfhi(vnext[q][j].y)};
#pragma unroll
                for (int q = 0; q < 2; ++q) { const int r_ = row0_ + (2 + q) * F.NGW; if (it_ + 2 + q < ntrip && r_ < M) { const u32x2* zp = (const u32x2*)(ZF + (size_t)r_ * D) + lane;
#pragma unroll
                    for (int j = 0; j < 4; ++j) vnext[q][j] = zp[64 * j]; } }
                { f32x4 gv[4], bv[4]; load_row_f32(lng_, gv, lane); load_row_f32(lnb_, bv, lane); ln_row(v[0], gv, bv); ln_row(v[1], gv, bv); }
                float pz[2][32];
#pragma unroll
                for (int e = 0; e < 32; ++e) { float s0 = 0.f, s1 = 0.f;
#pragma unroll
                    for (int j = 0; j < 4; ++j) { const f32x4 w = *(const LAS f32x4*)(Wt + e * 1028 + 4 * (lane + 64 * j));
                        s0 += v[0][j][0] * w[0] + v[0][j][1] * w[1] + v[0][j][2] * w[2] + v[0][j][3] * w[3]; s1 += v[1][j][0] * w[0] + v[1][j][1] * w[1] + v[1][j][2] * w[2] + v[1][j][3] * w[3]; }
                    pz[0][e] = s0; pz[1][e] = s1; }
                float lgv[2];
#pragma unroll
                for (int q = 0; q < 2; ++q) {
                    float a16[16], a8[8], a4[4], a2[2];
#pragma unroll
                    for (int e = 0; e < 16; ++e) { const auto r = __builtin_amdgcn_permlane32_swap(__builtin_bit_cast(unsigned, pz[q][e]), __builtin_bit_cast(unsigned, pz[q][e + 16]), false, false);
                        a16[e] = __builtin_bit_cast(float, (unsigned)r[0]) + __builtin_bit_cast(float, (unsigned)r[1]); }
#pragma unroll
                    for (int e = 0; e < 8; ++e) { const auto r = __builtin_amdgcn_permlane16_swap(__builtin_bit_cast(unsigned, a16[e]), __builtin_bit_cast(unsigned, a16[e + 8]), false, false);
                        a8[e] = __builtin_bit_cast(float, (unsigned)r[0]) + __builtin_bit_cast(float, (unsigned)r[1]); }
                    { const bool hi = (lane & 8) != 0;
#pragma unroll
                      for (int e = 0; e < 4; ++e) { const float mine = hi ? a8[e + 4] : a8[e], theirs = hi ? a8[e] : a8[e + 4]; a4[e] = mine + dpp_f<0x128>(theirs); } }
                    { const bool hi = (lane & 4) != 0;
#pragma unroll
                      for (int e = 0; e < 2; ++e) { const float mine = hi ? a4[e + 2] : a4[e], theirs = hi ? a4[e] : a4[e + 2]; a2[e] = mine + dpp_f<0x141>(theirs); } }
                    { const bool hi = (lane & 2) != 0; const float mine = hi ? a2[1] : a2[0], theirs = hi ? a2[0] : a2[1]; lgv[q] = mine + dpp_f<0x4E>(theirs); }
                    lgv[q] += dpp_f<0xB1>(lgv[q]);
                    lgv[q] += br_[lane >> 1];
                }
                int te[2][4]; float tv[2][4];
#pragma unroll
                for (int k = 0; k < 4; ++k)
#pragma unroll
                    for (int q = 0; q < 2; ++q) { const float best = wave_max(lgv[q]);
                        const unsigned long long mk = __ballot(lgv[q] == best); const int src = __builtin_amdgcn_readfirstlane((int)__ffsll((long long)mk) - 1);
                        te[q][k] = src >> 1; tv[q][k] = best; if ((lane >> 1) == te[q][k]) lgv[q] = -3.0e38f; }
#pragma unroll
                for (int q = 0; q < 2; ++q) if (ok[q]) { const int row = row0_ + q * F.NGW;
                    const float e0 = 1.f, e1 = __expf(tv[q][1] - tv[q][0]), e2 = __expf(tv[q][2] - tv[q][0]), e3 = __expf(tv[q][3] - tv[q][0]), rs = __builtin_amdgcn_rcpf(e0 + e1 + e2 + e3);
                    const int ri = (it_ + q) & 15;
                    if ((lane >> 2) == ri) { const int k = lane & 3; aE = k == 0 ? te[q][0] : k == 1 ? te[q][1] : k == 2 ? te[q][2] : te[q][3]; aG = (k == 0 ? e0 : k == 1 ? e1 : k == 2 ? e2 : e3) * rs; aRow = row; }
                    store_row_bf16(XB + (size_t)row * D, v[q], lane); }
                if (((it_ + 1) & 15) == 15 || it_ + 2 >= ntrip) {
                    __syncthreads();
                    int lp = 0; if (aRow >= 0) lp = (int)__hip_atomic_fetch_add(lcnt + aE, 1u, __ATOMIC_RELAXED, __HIP_MEMORY_SCOPE_WORKGROUP);
                    __syncthreads();
                    if (tid < 32) { const unsigned n = lcnt[tid]; lbase[tid] = n ? (int)__hip_atomic_fetch_add(cntp + tid * 64, n, __ATOMIC_RELAXED, __HIP_MEMORY_SCOPE_AGENT) : 0; }
                    __syncthreads();
                    if (aRow >= 0) { const int pos = lbase[aE] + lp; LIST[(size_t)aE * CAP + pos] = aRow * 4 + (lane & 3); GW[(size_t)aE * CAP + pos] = aG; }
                    aRow = -1;
                    __syncthreads();
                    if (tid < 32) lcnt[tid] = 0u;
                }
            }
          }
            __syncthreads();
            SEAM(pb + 8);
        }
        if ((PHE(7) || PHE(8)) && (IN(pb + 9) || IN(pb + 10))) { const int lane = lane_id(), tid = F.wave * 64 + lane; (void)tid;
            __syncthreads();
            if (tid < 32) TAB[tid] = (int)__hip_atomic_load(cnt + tid * 64, __ATOMIC_RELAXED, __HIP_MEMORY_SCOPE_AGENT);
            __syncthreads();
            if (tid < 64) {
                const int nt_ = (lane < 32) ? ((TAB[lane] + 255) >> 8) : 0; int inc = nt_;
#pragma unroll
                for (int d = 1; d < 32; d <<= 1) { const int t_ = __shfl_up(inc, d); if (lane >= d) inc += t_; }
                if (lane < 32) TAB[32 + lane] = inc - nt_;
                if (lane == 31) TAB[64] = inc; }
            __syncthreads();
            if (tid < MAXTILES) { int e = 0;
#pragma unroll
                for (int k = 1; k < 32; ++k) e += (TAB[32 + k] <= tid) ? 1 : 0;
                if (tid < TAB[64]) TAB[72 + tid] = e; }
            __syncthreads();
        }
        if (PHE(7) && IN(pb + 9)) {
            pg8::MoeOrder S; S.A = (const char*)XB; S.list = LIST; S.gwl = GW; S.Bt = (const char*)(ws + WS_WT_GU + (size_t)layer * 32 * 2048 * 1024 * 2); S.tab = TAB; S.K = D; S.nN = 8; S.ntiles = __builtin_amdgcn_readfirstlane(TAB[64]); S.nwg = S.ntiles * 8; S.G = F.G; S.c = (int)blockIdx.x;
            S.b_estride = (size_t)2048 * 1024 * 2; S.a_compact = 2;
            pg8::EpiSwiglu E{ACT, INP(30) + (size_t)layer * 32 * 2048, (const LAS float*)(TAB + 2816)};
            for (int rep_ = 0; rep_ < REPS(4); ++rep_)
            pg8::gemm_phase<pg8::EpiSwiglu, pg8::MoeOrder, MOE_ALIGN, true, true>(F.lds, F.wave, D, S, E, TAB + 512);
            SEAM(pb + 9);
        }
        if (PHE(8) && IN(pb + 10)) {
            pg8::MoeOrder S; S.A = (const char*)ACT; S.list = LIST; S.gwl = GW; S.Bt = (const char*)(ws + WS_WT_DN + (size_t)layer * 32 * 1024 * 1024 * 2); S.tab = TAB; S.K = DFF; S.nN = 4; S.ntiles = __builtin_amdgcn_readfirstlane(TAB[64]); S.nwg = S.ntiles * 4; S.G = F.G; S.c = (int)blockIdx.x;
            S.b_estride = (size_t)1024 * 1024 * 2; S.a_compact = 1;
            pg8::EpiMoeDown E{YS, INP(32) + (size_t)layer * 32 * 1024, TAB + 1280, (const LAS float*)(TAB + 2816)};
            for (int rep_ = 0; rep_ < REPS(5); ++rep_)
            pg8::gemm_phase<pg8::EpiMoeDown, pg8::MoeOrder, MOE_ALIGN, true, true>(F.lds, F.wave, DFF, S, E, TAB + 512);
            SEAM(pb + 10);
        }
        if (PHE(9) && IN(pb + 11)) { const int lane = lane_id(), tid = F.wave * 64 + lane; (void)tid;
            LAS float* Wt = (LAS float*)(F.lds);
            if (layer == 1) { load_cols16(tid, INP(10), 3088, 3072, Wt); __syncthreads(); }
            const float* lng_ = ln_g + (size_t)(layer * 2 + 1) * D; const float* lnb_ = ln_b + (size_t)(layer * 2 + 1) * D;
          for (int rep_ = 0; rep_ < REPS(12); ++rep_) {
            float* outp = (PROBE_CLS == 12 && rep_ == 0) ? ORAW : (layer == 3) ? d_out : HF; bf16* XBo = (PROBE_CLS == 12 && rep_ == 0) ? YB : XB;
            f32x4 hn[4]; u32x2 yn[4][4];
#define CMB_LOAD(r_) do { { const u32x2* hp_ = (const u32x2*)(XB + (size_t)(r_) * D) + lane; _Pragma("unroll") for (int j = 0; j < 4; ++j) { const u32x2 hw_ = hp_[64 * j]; hn[j] = (f32x4){bflo(hw_.x), bfhi(hw_.x), bflo(hw_.y), bfhi(hw_.y)}; } } _Pragma("unroll") for (int k = 0; k < 4; ++k) { const u32x2* yp = (const u32x2*)(YS + ((size_t)(r_) * 4 + k) * D) + lane; _Pragma("unroll") for (int j = 0; j < 4; ++j) yn[k][j] = yp[64 * j]; } } while (0)
            if (F.gw < M) CMB_LOAD(F.gw);
            for (int row = F.gw; row < M; row += F.NGW) {
                asm volatile("" ::: "memory");
                f32x4 v[4];
#pragma unroll
                for (int j = 0; j < 4; ++j) v[j] = hn[j] * ALPHA;
#pragma unroll
                for (int k = 0; k < 4; ++k)
#pragma unroll
                    for (int j = 0; j < 4; ++j) { const u32x2 yw = yn[k][j]; v[j][0] += bflo(yw.x); v[j][1] += bfhi(yw.x); v[j][2] += bflo(yw.y); v[j][3] += bfhi(yw.y); }
                if (row + F.NGW < M) CMB_LOAD(row + F.NGW);
                { f32x4 gv[4], bv[4]; load_row_f32(lng_, gv, lane); load_row_f32(lnb_, bv, lane); ln_row(v, gv, bv); }
                if (layer == 3) store_row_f32(outp + (size_t)row * D, v, lane);
                if (layer < 3) store_row_bf16(XBo + (size_t)row * D, v, lane);
                if (layer == 1) {
                    const float zsum = row_dot16(v, Wt, lane);
                    if ((lane & 3) == 0) GB[(size_t)row * 16 + (lane >> 2)] = zsum;
                }
            }
            if (layer == 1) {
                __syncthreads();
                const float* wgp = INP(11); const float bgc = INP(12)[tid];
                float wg[16];
#pragma unroll
                for (int r = 0; r < 16; ++r) wg[r] = wgp[r * 512 + tid];
                for (int row = F.vcu * NWAVES; row < M; row += F.NGW) {
                    f32x4 zv[NWAVES][4];
#pragma unroll
                    for (int w = 0; w < NWAVES; ++w)
#pragma unroll
                        for (int q = 0; q < 4; ++q) zv[w][q] = *(const f32x4*)(GB + (size_t)(row + w) * 16 + 4 * q);
#pragma unroll
                    for (int w = 0; w < NWAVES; ++w) { float sacc = bgc;
#pragma unroll
                        for (int q = 0; q < 4; ++q) sacc += zv[w][q][0] * wg[4 * q] + zv[w][q][1] * wg[4 * q + 1] + zv[w][q][2] * wg[4 * q + 2] + zv[w][q][3] * wg[4 * q + 3];
                        LA[(size_t)(row + w) * 512 + tid] = log_sigmoidf_(sacc) * (1.f / 16.f); }
                }
            }
          }
            __syncthreads();
#undef CMB_LOAD
            if (layer < 3) SEAM(pb + 11);
        }
}
__global__ void __launch_bounds__(NTHREADS, 2) mega_fwd(Args args) {
    extern __shared__ __attribute__((aligned(16))) unsigned char lds_raw[];
    Frame F;
    F.lds = (LAS unsigned char*)lds_raw;
    F.wave = __builtin_amdgcn_readfirstlane((int)threadIdx.x >> 6);
    F.G = gridDim.x; { const int bx = blockIdx.x; F.vcu = (F.G % 8 == 0) ? (bx % 8) * (F.G / 8) + bx / 8 : bx; }
    F.gw = F.vcu * NWAVES + F.wave; F.NGW = F.G * NWAVES;
    unsigned char* ws = args.ws;
    unsigned* ctl = (unsigned*)(ws + WS_CTL);
    volatile LAS unsigned* MISC = (volatile LAS unsigned*)(F.lds + MISC_OFF);
    LAS int* TAB = (LAS int*)(F.lds + TAB_OFF);
    { const int tid0 = threadIdx.x;
      if (tid0 < 64) MISC[tid0] = 0u;
      if (tid0 < 33) ((LAS unsigned long long*)(F.lds + MISC_OFF + 256))[tid0] = (unsigned long long)args.in[tid0]; }
    __syncthreads();
    XcdBarrier bar = xcd_barrier_post(ctl + CW_BAR, MISC + 8, F.wave == 0 && lane_id() == 0);
    if (PROBE_T >= 0 && blockIdx.x == 0 && F.wave == 0 && lane_id() == 0) { volatile LAS unsigned long long* st = (volatile LAS unsigned long long*)(F.lds + MISC_OFF + 1024); st[0] = __builtin_amdgcn_s_memrealtime(); st[1] = 0ull; }
    const int lo = args.ph_lo, hi = args.ph_hi;
    WS_PTRS
    if (IN(0) && !defined_SKIP_P0) { const int lane = lane_id(), tid = F.wave * 64 + lane; (void)tid;
      {
        LAS unsigned char* scr = F.lds + F.wave * 8704;
        {
            constexpr int I_GU = 128 * 16 * 32, I_DN = 128 * 16 * 16, I_ML = 16 * 48, I_SQ = 16 * 16, I_RI = 16 * 96, I_RO = 32 * 16;
            constexpr int B0 = I_GU, B1 = B0 + I_DN, B2 = B1 + I_ML, B3 = B2 + I_SQ, B4 = B3 + I_RI, B5 = B4 + I_RO, B6 = B5 + I_ML, B7 = B6 + I_SQ, B8 = B7 + I_SQ, B9 = B8 + I_SQ, B10 = B9 + I_SQ;
#define P0_ITEM(IT_) do { const int it = (IT_); \
                    const float* src; bf16* dst; int ldw, Kd, nnb, mode = 0, r; \
                    if (it < B0)      { r = it;      const int q = r / (16 * 32); r -= q * (16 * 32); src = INP(29) + (size_t)q * 1024 * 2048; dst = (bf16*)(ws + WS_WT_GU) + (size_t)q * 2048 * 1024; ldw = 2048; Kd = 1024; nnb = 32; mode = 1; } \
                    else if (it < B1) { r = it - B0; const int q = r / (16 * 16); r -= q * (16 * 16); src = INP(31) + (size_t)q * 1024 * 1024; dst = (bf16*)(ws + WS_WT_DN) + (size_t)q * 1024 * 1024; ldw = 1024; Kd = 1024; nnb = 16; } \
                    else if (it < B2) { r = it - B1; src = INP(3);  dst = (bf16*)(ws + WS_WT_ML_IN);  ldw = 3088; Kd = 1024; nnb = 48; } \
                    else if (it < B3) { r = it - B2; src = INP(6);  dst = (bf16*)(ws + WS_WT_ML_OUT); ldw = 1024; Kd = 1024; nnb = 16; } \
                    else if (it < B4) { r = it - B3; src = INP(7);  dst = (bf16*)(ws + WS_WT_RET_IN); ldw = 6144; Kd = 1024; nnb = 96; mode = 2; } \
                    else if (it < B5) { r = it - B4; src = INP(9);  dst = (bf16*)(ws + WS_WT_RET_OUT); ldw = 1024; Kd = 2048; nnb = 16; } \
                    else if (it < B6) { r = it - B5; src = INP(10); dst = (bf16*)(ws + WS_WT_GLA_IN); ldw = 3088; Kd = 1024; nnb = 48; } \
                    else if (it < B7) { r = it - B6; src = INP(14); dst = (bf16*)(ws + WS_WT_GLA_OUT); ldw = 1024; Kd = 1024; nnb = 16; } \
                    else if (it < B8) { r = it - B7; src = INP(15); dst = (bf16*)(ws + WS_WT_S5_IN);  ldw = 1024; Kd = 1024; nnb = 16; } \
                    else if (it < B9) { r = it - B8; src = INP(24); dst = (bf16*)(ws + WS_WT_S5_GLU); ldw = 1024; Kd = 1024; nnb = 16; } \
                    else              { r = it - B9; src = INP(26); dst = (bf16*)(ws + WS_WT_S5_OUT); ldw = 1024; Kd = 1024; nnb = 16; } \
                const int kb = r / nnb, nb = r - kb * nnb; \
                transpose_item(src, ldw, 0, Kd, dst, mode, kb, nb, scr, lane); } while (0)
            const int NSTAT = (B10 / F.NGW) * 4 / 5, DYN0 = NSTAT * F.NGW, DLEN = B10 - DYN0, GLEN = (DLEN + 7) / 8;
#pragma unroll 1
            for (int n_ = 0; n_ < NSTAT; ++n_) P0_ITEM(F.gw + n_ * F.NGW);
#pragma unroll 1
            for (int tr = 0; tr < 8; ++tr) { const int grp = ((int)blockIdx.x + tr) & 7; unsigned* q = ctl + 2304 + 64 * grp; const int glo = DYN0 + grp * GLEN, glen = (DLEN - grp * GLEN) < GLEN ? (DLEN - grp * GLEN) : GLEN;
                int cur = 0; if (lane == 0) cur = (int)__hip_atomic_fetch_add(q, 4u, __ATOMIC_RELAXED, __HIP_MEMORY_SCOPE_AGENT); cur = __builtin_amdgcn_readfirstlane(cur);
#pragma unroll 1
                while (cur < glen) { int nx = 0; if (lane == 0) nx = (int)__hip_atomic_fetch_add(q, 4u, __ATOMIC_RELAXED, __HIP_MEMORY_SCOPE_AGENT);
#pragma unroll 1
                    for (int k = 0; k < 4; ++k) if (cur + k < glen) P0_ITEM(glo + cur + k);
                    cur = __builtin_amdgcn_readfirstlane(nx); } }
#undef P0_ITEM
        }
        __syncthreads();
        if (CH_S5) s5_tables(F, ws, tid, INP(16), INP(17), INP(18), INP(19), INP(20), INP(21), INP(23));
        { float* CS = (float*)(ws + WS_CS);
          for (int it = blockIdx.x * NTHREADS + tid; it < T * 64; it += F.G * NTHREADS) { const int t = it >> 6, i = it & 63;
              const float inv = exp2f(-(float)(2 * i) * (13.287712379549449f / 128.f)); float sn, cs; sincosf((float)t * inv, &sn, &cs); CS[2 * it] = cs; CS[2 * it + 1] = sn; } }
        LAS float* Wt = (LAS float*)(F.lds);
        load_cols16(tid, INP(3), 3088, 3072, Wt);
        __syncthreads();
        {
            const float* bg = INP(4);
            f32x4 vn[4]; if (F.gw < M) load_row_f32(x_in + (size_t)F.gw * D, vn, lane);
            for (int row = F.gw; row < M; row += F.NGW) {
                asm volatile("" ::: "memory");
                f32x4 v[4];
#pragma unroll
                for (int j = 0; j < 4; ++j) v[j] = vn[j];
                if (row + F.NGW < M) load_row_f32(x_in + (size_t)(row + F.NGW) * D, vn, lane);
                store_row_bf16(XB + (size_t)row * D, v, lane);
                const float gsum = row_dot16(v, Wt, lane);
                if ((lane & 3) == 0) GB[(size_t)row * 16 + (lane >> 2)] = gsum + bg[lane >> 2];
            }
        }
        __syncthreads();
      }
        SEAM(0);
    }

    layer_body<0>(F, ws, ctl, TAB, bar, lo, hi, args.out);
    layer_body<1>(F, ws, ctl, TAB, bar, lo, hi, args.out);
    layer_body<2>(F, ws, ctl, TAB, bar, lo, hi, args.out);
    layer_body<3>(F, ws, ctl, TAB, bar, lo, hi, args.out);
    if (PROBE_T >= 0 && blockIdx.x == 0 && F.wave == 0 && lane_id() == 0) { volatile LAS unsigned long long* st = (volatile LAS unsigned long long*)(F.lds + MISC_OFF + 1024); args.out[0] = (float)st[1] * (0.01f / 16.f); }
#undef IN
#undef SEAM
#undef INP
#undef x_in
#undef ln_g
#undef ln_b
}

extern "C" void kernel_launch(void* const* d_in, const int* in_sizes, int n_in, void* d_out, int out_size, void* d_ws, size_t ws_size, hipStream_t stream) {
    static int grid = 0;
    if (grid == 0) {
        if (n_in != 33 || out_size != M * D || ws_size < WS_END) { fprintf(stderr, "kernel_launch: unexpected problem (n_in %d, out %d, ws %zu < %zu)\n", n_in, out_size, ws_size, (size_t)WS_END); grid = -1; return; }
        int dev = 0, cus = 0, per_cu = 0;
        if (hipGetDevice(&dev) != hipSuccess || hipDeviceGetAttribute(&cus, hipDeviceAttributeMultiprocessorCount, dev) != hipSuccess) { grid = -1; return; }
        if (hipFuncSetAttribute((const void*)mega_fwd, hipFuncAttributeMaxDynamicSharedMemorySize, LDS_BYTES) != hipSuccess) { fprintf(stderr, "kernel_launch: hipFuncSetAttribute failed\n"); grid = -1; return; }
        if (hipOccupancyMaxActiveBlocksPerMultiprocessor(&per_cu, (const void*)mega_fwd, NTHREADS, LDS_BYTES) != hipSuccess || per_cu < 1) { fprintf(stderr, "kernel_launch: occupancy query says %d\n", per_cu); }
        (void)hipGetLastError();
        grid = cus;
    }
    if (grid < 0) return;
    hipMemsetAsync((char*)d_ws + WS_CTL, 0, CTL_ZERO_BYTES, stream);
    Args a{};
    for (int i = 0; i < 33; ++i) a.in[i] = (const float*)d_in[i];
    a.out = (float*)d_out; a.ws = (unsigned char*)d_ws;
#if N_LAUNCH_MODE == 1
    a.ph_lo = 0; a.ph_hi = 1000;
    hipLaunchKernelGGL(mega_fwd, dim3(grid), dim3(NTHREADS), LDS_BYTES, stream, a);
#else
    for (int ph = 0; ph < 65; ++ph) { a.ph_lo = ph; a.ph_hi = ph + 1; hipLaunchKernelGGL(mega_fwd, dim3(grid), dim3(NTHREADS), LDS_BYTES, stream, a); }
#endif
}
```

```cpp
#include <hip/hip_runtime.h>
#include <cstdio>
#include <cstdint>

#ifndef NAIVE_MIX
#define NAIVE_MIX 1
#endif
#ifndef CH_ML
#define CH_ML 1
#endif
#ifndef CH_RET
#define CH_RET 1
#endif
#ifndef CH_GLA
#define CH_GLA 1
#endif
#ifndef CH_S5
#define CH_S5 1
#endif
#ifndef PROBE_CLS
#define PROBE_CLS 0
#endif
#define REPS(c) ((PROBE_CLS == (c) || PROBE_CLS == 100 + layer * 10 + (c)) ? 2 : 1)
#ifndef PROBE_T
#define PROBE_T -1
#endif
#ifndef PROBE_T2
#define PROBE_T2 PROBE_T
#endif
#ifndef MOE_ALIGN
#define MOE_ALIGN true
#endif
#ifndef N_LAUNCH_MODE
#define N_LAUNCH_MODE 1
#endif


#ifdef SKIP_ML
constexpr bool defined_SKIP_ML = true;
#else
constexpr bool defined_SKIP_ML = false;
#endif
#ifdef SKIP_RET
constexpr bool defined_SKIP_RET = true;
#else
constexpr bool defined_SKIP_RET = false;
#endif
#ifdef SKIP_GLA
constexpr bool defined_SKIP_GLA = true;
#else
constexpr bool defined_SKIP_GLA = false;
#endif
#ifdef SKIP_S5
constexpr bool defined_SKIP_S5 = true;
#else
constexpr bool defined_SKIP_S5 = false;
#endif
#ifdef SKIP_LN1
constexpr bool defined_SKIP_LN1 = true;
#else
constexpr bool defined_SKIP_LN1 = false;
#endif
#ifdef SKIP_P0
constexpr bool defined_SKIP_P0 = true;
#else
constexpr bool defined_SKIP_P0 = false;
#endif
#ifndef PHMASK
#define PHMASK 0xffff
#endif
#define PHE(b) (((PHMASK) >> (b)) & 1)
#define GAS __attribute__((address_space(1)))
#define LAS __attribute__((address_space(3)))
typedef unsigned short bf16;
typedef short bf16x8 __attribute__((ext_vector_type(8)));
typedef float f32x4 __attribute__((ext_vector_type(4)));
typedef float f32x2 __attribute__((ext_vector_type(2)));
typedef unsigned u32x4 __attribute__((ext_vector_type(4)));
typedef unsigned u32x2 __attribute__((ext_vector_type(2)));

constexpr int BATCH = 2, T = 8192, D = 1024, M = BATCH * T;
constexpr int NEXP = 32, TOPK = 4, DFF = 1024, CAP = M;
constexpr int NWAVES = 8, NTHREADS = 512;
constexpr float LN_EPS = 1e-5f;
constexpr float ALPHA = 1.681792830507429f;
constexpr int MAXTILES = (M * TOPK) / 256 + NEXP;

constexpr size_t MiB = 1u << 20;
constexpr size_t WS_CTL = 0, CTL_ZERO_BYTES = 1 * MiB;
constexpr size_t WS_WT_ML_IN = 1 * MiB;
constexpr size_t WS_WT_ML_OUT = WS_WT_ML_IN + 6 * MiB;
constexpr size_t WS_WT_RET_IN = WS_WT_ML_OUT + 2 * MiB;
constexpr size_t WS_WT_RET_OUT = WS_WT_RET_IN + 12 * MiB;
constexpr size_t WS_WT_GLA_IN = WS_WT_RET_OUT + 4 * MiB;
constexpr size_t WS_WT_GLA_OUT = WS_WT_GLA_IN + 6 * MiB;
constexpr size_t WS_WT_S5_IN = WS_WT_GLA_OUT + 2 * MiB;
constexpr size_t WS_WT_S5_GLU = WS_WT_S5_IN + 2 * MiB;
constexpr size_t WS_WT_S5_OUT = WS_WT_S5_GLU + 2 * MiB;
constexpr size_t WS_S5TAB = WS_WT_S5_OUT + 2 * MiB;
constexpr size_t WS_GB = WS_S5TAB + 1 * MiB;
constexpr size_t WS_LIST = WS_GB + 1 * MiB;
constexpr size_t WS_GW = WS_LIST + 2 * MiB;
constexpr size_t WS_WT_GU = WS_GW + 1 * MiB;
constexpr size_t WS_WT_DN = WS_WT_GU + 512 * MiB;
constexpr size_t WS_HF = WS_WT_DN + 256 * MiB;
constexpr size_t WS_XB = WS_HF + 64 * MiB;
constexpr size_t WS_ZF = WS_XB + 32 * MiB;
constexpr size_t WS_PB = WS_ZF + 64 * MiB;
constexpr size_t WS_LA = WS_PB + 192 * MiB;
constexpr size_t WS_ORAW = WS_LA + 32 * MiB;
constexpr size_t WS_YB = WS_ORAW + 128 * MiB;
constexpr size_t WS_ACT = WS_YB + 64 * MiB;
constexpr size_t WS_YS = WS_ACT + 144 * MiB;
constexpr size_t WS_XG = WS_YS + 256 * MiB;
constexpr size_t WS_UT = WS_XG + 1024 * MiB;
constexpr size_t WS_ST = WS_UT + 128 * MiB;
constexpr size_t WS_KPP = WS_ST + 64 * MiB;
constexpr size_t WS_SC = WS_KPP + 16 * MiB;
constexpr size_t WS_S5KT = WS_SC + 4 * MiB;
constexpr size_t WS_S5VT = WS_S5KT + 2 * MiB;
constexpr size_t WS_S5WT = WS_S5VT + 16 * MiB;
constexpr size_t WS_S5L64 = WS_S5WT + 16 * MiB;
constexpr size_t WS_S5SL = WS_S5L64 + 1 * MiB;
constexpr size_t WS_S5SP = WS_S5SL + 16 * MiB;
constexpr size_t WS_CS = WS_S5SP + 8 * MiB;
constexpr size_t WS_END = WS_CS + 4 * MiB;
constexpr int CW_BAR = 4096;
constexpr int CW_CNT = 16384;

constexpr int PH_BYTES = 139264;
constexpr int TAB_OFF = PH_BYTES;
constexpr int MISC_OFF = TAB_OFF + 16384;
constexpr int LDS_BYTES = 159744;

typedef __bf16 bf16x2_t __attribute__((ext_vector_type(2)));
__device__ __forceinline__ unsigned pk2(float lo, float hi) { const f32x2 v = {lo, hi}; const bf16x2_t b = __builtin_convertvector(v, bf16x2_t); return __builtin_bit_cast(unsigned, b); }
__device__ __forceinline__ unsigned f2bf(float f) { return pk2(f, 0.f) & 0xffffu; }
__device__ __forceinline__ float bf2f(unsigned short b) { return __builtin_bit_cast(float, ((unsigned)b) << 16); }
__device__ __forceinline__ float bflo(unsigned w) { return __builtin_bit_cast(float, w << 16); }
__device__ __forceinline__ float bfhi(unsigned w) { return __builtin_bit_cast(float, w & 0xffff0000u); }
__device__ __forceinline__ int lane_id() { int l; asm volatile("v_mbcnt_lo_u32_b32 %0, -1, 0\n\tv_mbcnt_hi_u32_b32 %0, -1, %0" : "=v"(l)); return l; }
template <int CTRL> __device__ __forceinline__ float dpp_f(float v) { return __builtin_bit_cast(float, __builtin_amdgcn_update_dpp(0, __builtin_bit_cast(int, v), CTRL, 0xf, 0xf, false)); }
__device__ __forceinline__ float rl_f(float v, int l) { return __builtin_bit_cast(float, __builtin_amdgcn_readlane(__builtin_bit_cast(int, v), l)); }
__device__ __forceinline__ float wave_sum(float v) {
    v += dpp_f<0xB1>(v);
    v += dpp_f<0x4E>(v);
    v += dpp_f<0x141>(v);
    v += dpp_f<0x140>(v);
    return (rl_f(v, 0) + rl_f(v, 16)) + (rl_f(v, 32) + rl_f(v, 48));
}
__device__ __forceinline__ float row16_sum(float v) { v += dpp_f<0xB1>(v); v += dpp_f<0x4E>(v); v += dpp_f<0x141>(v); v += dpp_f<0x140>(v); return v; }
__device__ __forceinline__ float wave_max(float v) {
    v = fmaxf(v, dpp_f<0xB1>(v)); v = fmaxf(v, dpp_f<0x4E>(v)); v = fmaxf(v, dpp_f<0x141>(v)); v = fmaxf(v, dpp_f<0x140>(v));
    return fmaxf(fmaxf(rl_f(v, 0), rl_f(v, 16)), fmaxf(rl_f(v, 32), rl_f(v, 48)));
}
__device__ __forceinline__ float sigmoidf_(float x) { return __builtin_amdgcn_rcpf(1.f + __expf(-x)); }
__device__ __forceinline__ float log_sigmoidf_(float x) { return fminf(x, 0.f) - __logf(1.f + __expf(-fabsf(x))); }
__device__ __forceinline__ float gelu_tanh(float x) { const float u = 0.7978845608028654f * (x + 0.044715f * x * x * x); return x * sigmoidf_(2.f * u); }

namespace pg8 {
constexpr int BM = 256, BK = 64, HALF = 128, HTB = HALF * BK * 2, STAGE_BYTES = 8 * HTB, NXCD = 8, WGM = 8;
__host__ __device__ __forceinline__ int lds_byte(int r, int c) { const int st = (r >> 4) * 2 + (c >> 5), rr = r & 15, cc = c & 31, ob = rr * 64 + cc * 2; return st * 1024 + (ob ^ (((ob >> 9) & 1) << 5)); }
__host__ __device__ __forceinline__ void stage_rc(int b, int& R, int& C) { const int st = b / 1024, sb = b % 1024, swz = sb ^ (((sb >> 9) & 1) << 5); R = (st >> 1) * 16 + swz / 64; C = (st & 1) * 32 + (swz % 64) / 2; }
__host__ __device__ __forceinline__ int perm32(int rho) { const int n = rho >> 4, i = rho & 15; return 8 * (i >> 2) + 4 * n + (i & 3); }

struct Unit { const char* A; const char* B; int pm, pn, e, nvalid, r0, buf; };

__device__ __forceinline__ int xcd_remap(int L, int nwg) { const int q = nwg / NXCD, r = nwg % NXCD, xcd = L % NXCD, off = L / NXCD; return (xcd < r ? xcd * (q + 1) : r * (q + 1) + (xcd - r) * q) + off; }

struct DenseOrder {
    const char* A; const char* Bt; int K, nM, nN, nwg, G, c; const int* list; const float* gwl; static constexpr int a_compact = 0;
    __device__ __forceinline__ void init(const void* A_, const void* Bt_, int M_, int N_, int K_, int G_, int c_) { A = (const char*)A_; Bt = (const char*)Bt_; K = K_; nM = M_ / BM; nN = N_ / BM; nwg = nM * nN; G = G_; c = c_; list = nullptr; gwl = nullptr; }
    __device__ __forceinline__ bool next(int i, Unit& u) const {
        const long L = (long)i * G + c; if (L >= nwg) return false;
        const int wgid = xcd_remap((int)L, nwg);
        const int nig = WGM * nN, gid = wgid / nig, fm = gid * WGM, gsz = (nM - fm) < WGM ? (nM - fm) : WGM;
        u.pm = fm + ((wgid % nig) % gsz); u.pn = (wgid % nig) / gsz; u.e = 0; u.nvalid = 256; u.r0 = 0;
        u.A = A + (size_t)u.pm * 256 * K * 2; u.B = Bt + (size_t)u.pn * 256 * K * 2; return true;
    }
};
struct MoeOrder {
    const char* A; const char* Bt; const LAS int* tab;
    int K, nN, ntiles, nwg, G, c; size_t b_estride; int a_compact; const int* list; const float* gwl;
    __device__ __forceinline__ bool next(int i, Unit& u) const {
        const long L = (long)i * G + c; if (L >= nwg) return false;
        const int wgid = xcd_remap((int)L, nwg);
        const int nig = WGM * nN, gid = wgid / nig, fm = gid * WGM, gsz = (ntiles - fm) < WGM ? (ntiles - fm) : WGM;
        const int tl = fm + ((wgid % nig) % gsz); u.pm = tl; u.pn = (wgid % nig) / gsz;
        const int e = __builtin_amdgcn_readfirstlane(tab[72 + tl]); u.e = e; const int r0 = (tl - __builtin_amdgcn_readfirstlane(tab[32 + e])) * 256; const int rem = __builtin_amdgcn_readfirstlane(tab[e]) - r0; u.nvalid = rem < 256 ? rem : 256; u.r0 = r0;
        u.A = (a_compact == 2) ? A : a_compact ? A + (size_t)tl * 256 * K * 2 : A + ((size_t)e * CAP + r0) * K * 2;
        u.B = Bt + (size_t)e * b_estride + (size_t)u.pn * 256 * K * 2; return true;
    }
};

__device__ __forceinline__ unsigned cvt_pk_bf16(float lo, float hi) { unsigned r; asm volatile("v_cvt_pk_bf16_f32 %0, %1, %2" : "=v"(r) : "v"(lo), "v"(hi)); return r; }

struct EpiBf16 {
    static constexpr bool BIASTAB = false; static constexpr bool ROWINFO = false; static constexpr bool PERM = true;
    bf16* O; int ldc; const float* cs; int rot_tiles;
    __device__ __forceinline__ void operator()(const f32x4 (&acc)[2][2][4][2], const Unit& u, int wr, int wc, int fr, int fq) const {
        const int row0 = u.pm * BM + wr * 64 + fr, col0 = u.pn * BM + wc * 32 + 8 * fq;
        const bool rot = u.pn < rot_tiles; const float sc = (col0 >= 1024) ? 0.08838834764831845f : 1.f;
#pragma unroll
        for (int ai = 0; ai < 2; ++ai)
#pragma unroll
            for (int m = 0; m < 4; ++m) { const int row = row0 + ai * HALF + m * 16; bf16* rowp = O + (size_t)row * ldc + col0;
#pragma unroll
                for (int bj = 0; bj < 2; ++bj) { f32x4 v0 = acc[ai][bj][m][0], v1 = acc[ai][bj][m][1];
                    if (rot) { const float* cp = cs + ((size_t)(row & (T - 1)) * 64 + (((col0 + bj * HALF) & 127) >> 1)) * 2; const f32x4 c0 = *(const f32x4*)cp, c1 = *(const f32x4*)(cp + 4);
                        const f32x4 a0 = v0, a1 = v1;
                        v0[0] = (a0[0] * c0[0] - a0[1] * c0[1]) * sc; v0[1] = (a0[0] * c0[1] + a0[1] * c0[0]) * sc; v0[2] = (a0[2] * c0[2] - a0[3] * c0[3]) * sc; v0[3] = (a0[2] * c0[3] + a0[3] * c0[2]) * sc;
                        v1[0] = (a1[0] * c1[0] - a1[1] * c1[1]) * sc; v1[1] = (a1[0] * c1[1] + a1[1] * c1[0]) * sc; v1[2] = (a1[2] * c1[2] - a1[3] * c1[3]) * sc; v1[3] = (a1[2] * c1[3] + a1[3] * c1[2]) * sc; }
                    u32x4 w; w.x = cvt_pk_bf16(v0[0], v0[1]); w.y = cvt_pk_bf16(v0[2], v0[3]); w.z = cvt_pk_bf16(v1[0], v1[1]); w.w = cvt_pk_bf16(v1[2], v1[3]);
                    *(u32x4*)(rowp + bj * HALF) = w; } }
    }
};
struct EpiResid {
    static constexpr bool BIASTAB = false; static constexpr bool ROWINFO = false; static constexpr bool PERM = true;
    const float* __restrict__ hin; const bf16* __restrict__ hinb; bf16* __restrict__ Z;
    __device__ __forceinline__ void operator()(const f32x4 (&acc)[2][2][4][2], const Unit& u, int wr, int wc, int fr, int fq) const {
        const int row0 = u.pm * BM + wr * 64 + fr, col0 = u.pn * BM + wc * 32 + 8 * fq;
#pragma unroll
        for (int ai = 0; ai < 2; ++ai)
#pragma unroll
            for (int m = 0; m < 4; ++m) { const size_t off = (size_t)(row0 + ai * HALF + m * 16) * D + col0;
                f32x4 hv[2][2];
                if (hinb) {
#pragma unroll
                    for (int bj = 0; bj < 2; ++bj) { const u32x4 hw = *(const u32x4*)(hinb + off + bj * HALF);
                        hv[bj][0] = (f32x4){bflo(hw.x), bfhi(hw.x), bflo(hw.y), bfhi(hw.y)}; hv[bj][1] = (f32x4){bflo(hw.z), bfhi(hw.z), bflo(hw.w), bfhi(hw.w)}; }
                } else {
#pragma unroll
                    for (int bj = 0; bj < 2; ++bj)
#pragma unroll
                        for (int n = 0; n < 2; ++n) hv[bj][n] = *(const f32x4*)(hin + off + bj * HALF + n * 4);
                }
#pragma unroll
                for (int bj = 0; bj < 2; ++bj) { const f32x4 v0 = hv[bj][0] * ALPHA + acc[ai][bj][m][0], v1 = hv[bj][1] * ALPHA + acc[ai][bj][m][1];
                    u32x4 w; w.x = cvt_pk_bf16(v0[0], v0[1]); w.y = cvt_pk_bf16(v0[2], v0[3]); w.z = cvt_pk_bf16(v1[0], v1[1]); w.w = cvt_pk_bf16(v1[2], v1[3]);
                    *(u32x4*)(Z + off + bj * HALF) = w; } }
    }
};
struct EpiGlu {
    static constexpr bool BIASTAB = false; static constexpr bool ROWINFO = false; static constexpr bool PERM = true;
    const bf16* Y; const float* bias; bf16* O;
    __device__ __forceinline__ void operator()(const f32x4 (&acc)[2][2][4][2], const Unit& u, int wr, int wc, int fr, int fq) const {
        const int row0 = u.pm * BM + wr * 64 + fr, col0 = u.pn * BM + wc * 32 + 8 * fq;
#pragma unroll
        for (int ai = 0; ai < 2; ++ai)
#pragma unroll
            for (int m = 0; m < 4; ++m) { const size_t off = (size_t)(row0 + ai * HALF + m * 16) * D + col0;
#pragma unroll
                for (int bj = 0; bj < 2; ++bj) {
                    const f32x4 b0 = *(const f32x4*)(bias + col0 + bj * HALF), b1 = *(const f32x4*)(bias + col0 + bj * HALF + 4);
                    const u32x4 yw = *(const u32x4*)(Y + off + bj * HALF);
                    const f32x4 v0 = acc[ai][bj][m][0] + b0, v1 = acc[ai][bj][m][1] + b1;
                    float o[8];
                    o[0] = bflo(yw.x) * sigmoidf_(v0[0]); o[1] = bfhi(yw.x) * sigmoidf_(v0[1]); o[2] = bflo(yw.y) * sigmoidf_(v0[2]); o[3] = bfhi(yw.y) * sigmoidf_(v0[3]);
                    o[4] = bflo(yw.z) * sigmoidf_(v1[0]); o[5] = bfhi(yw.z) * sigmoidf_(v1[1]); o[6] = bflo(yw.w) * sigmoidf_(v1[2]); o[7] = bfhi(yw.w) * sigmoidf_(v1[3]);
                    u32x4 w; w.x = cvt_pk_bf16(o[0], o[1]); w.y = cvt_pk_bf16(o[2], o[3]); w.z = cvt_pk_bf16(o[4], o[5]); w.w = cvt_pk_bf16(o[6], o[7]);
                    *(u32x4*)(O + off + bj * HALF) = w; } }
    }
};
struct EpiSwiglu {
    static constexpr bool BIASTAB = true; static constexpr bool ROWINFO = false; static constexpr bool PERM = true;
    bf16* ACT; const float* bgu; const LAS float* btab;
    __device__ __forceinline__ float bias_at(const Unit& u, int j) const { return bgu[(size_t)u.e * 2 * DFF + (j < HALF ? 0 : DFF) + u.pn * HALF + (j & (HALF - 1))]; }
    __device__ __forceinline__ void operator()(const f32x4 (&acc)[2][2][4][2], const Unit& u, int wr, int wc, int fr, int fq) const {
        const int row0 = u.pm * BM + wr * 64 + fr, j0 = u.pn * HALF + wc * 32 + 8 * fq;
        const LAS float* bt = btab + u.buf * 256 + wc * 32 + 8 * fq;
        const f32x4 g0 = *(const LAS f32x4*)(bt), g1 = *(const LAS f32x4*)(bt + 4), u0 = *(const LAS f32x4*)(bt + HALF), u1 = *(const LAS f32x4*)(bt + HALF + 4);
#pragma unroll
        for (int ai = 0; ai < 2; ++ai)
#pragma unroll
            for (int m = 0; m < 4; ++m) {
                float o[8];
#pragma unroll
                for (int n = 0; n < 2; ++n)
#pragma unroll
                    for (int i = 0; i < 4; ++i) {
                        float g = acc[ai][0][m][n][i] + (n ? g1[i] : g0[i]), up = acc[ai][1][m][n][i] + (n ? u1[i] : u0[i]);
                        g = fminf(g, 7.0f); up = fminf(fmaxf(up, -7.0f), 7.0f);
                        o[n * 4 + i] = (up + 1.0f) * g * sigmoidf_(1.702f * g); }
                u32x4 w; w.x = cvt_pk_bf16(o[0], o[1]); w.y = cvt_pk_bf16(o[2], o[3]); w.z = cvt_pk_bf16(o[4], o[5]); w.w = cvt_pk_bf16(o[6], o[7]);
                *(u32x4*)(ACT + (size_t)(row0 + ai * HALF + m * 16) * DFF + j0) = w; }
    }
};
struct EpiMoeDown {
    static constexpr bool BIASTAB = true; static constexpr bool ROWINFO = true; static constexpr bool PERM = true;
    bf16* YS; const float* bd; const LAS int* rinfo; const LAS float* btab;
    __device__ __forceinline__ float bias_at(const Unit& u, int j) const { return bd[(size_t)u.e * D + u.pn * BM + j]; }
    __device__ __forceinline__ void operator()(const f32x4 (&acc)[2][2][4][2], const Unit& u, int wr, int wc, int fr, int fq) const {
        const int col0 = u.pn * BM + wc * 32 + 8 * fq;
        const LAS float* bt = btab + u.buf * 256 + wc * 32 + 8 * fq;
        f32x4 bv[2][2];
#pragma unroll
        for (int bj = 0; bj < 2; ++bj)
#pragma unroll
            for (int n = 0; n < 2; ++n) bv[bj][n] = *(const LAS f32x4*)(bt + bj * HALF + 4 * n);
        const LAS int* ri = rinfo + u.buf * 512;
#pragma unroll
        for (int ai = 0; ai < 2; ++ai)
#pragma unroll
            for (int m = 0; m < 4; ++m) { const int r = ai * HALF + wr * 64 + m * 16 + fr; const int slot = ri[r];
                if (slot >= 0) { const float gg = __builtin_bit_cast(float, ri[256 + r]); bf16* op = YS + (size_t)slot * D + col0;
#pragma unroll
                    for (int bj = 0; bj < 2; ++bj) { const f32x4 v0 = (acc[ai][bj][m][0] + bv[bj][0]) * gg, v1 = (acc[ai][bj][m][1] + bv[bj][1]) * gg;
                        u32x4 w; w.x = cvt_pk_bf16(v0[0], v0[1]); w.y = cvt_pk_bf16(v0[2], v0[3]); w.z = cvt_pk_bf16(v1[0], v1[1]); w.w = cvt_pk_bf16(v1[2], v1[3]);
                        *(u32x4*)(op + bj * HALF) = w; } } }
    }
};

template <class Epi, class Sched, bool ALIGN_EPI, bool SP2, bool GATHER = false>
__device__ __forceinline__ void gemm_phase(LAS unsigned char* lds, const int wid, const int K, const Sched& S, const Epi& E, LAS int* rowtab = nullptr) {
    const int lane = lane_id(), tid = wid * 64 + lane, wr = wid >> 2, wc = wid & 3, fr = lane & 15, fq = lane >> 4;
    const int nt = K / BK;
    unsigned voffA[2], voffB[2]; int Rr[2]; unsigned Cc2[2];
#pragma unroll
    for (int i = 0; i < 2; ++i) { int R, C; stage_rc(tid * 16 + i * 8192, R, C); const int Rb = Epi::PERM ? ((R & ~31) + perm32(R & 31)) : R;
        voffA[i] = (unsigned)(R * K + C) * 2u; voffB[i] = (unsigned)(Rb * K + C) * 2u; Rr[i] = R; Cc2[i] = (unsigned)C * 2u; }
    unsigned vA[2][2] = {{0u, 0u}, {0u, 0u}}, vN[2][2] = {{0u, 0u}, {0u, 0u}};
    const size_t kstep = (size_t)(BK * 2);
    const size_t hstep = (size_t)HALF * K * 2;
    const unsigned ldsw = (unsigned)wid * 1024u;
    const int aoff = lds_byte(wr * 64 + fr, fq * 8), boff = lds_byte(wc * 32 + fr, fq * 8);
#define PG8_SA(b, h) (((b) * 2 + (h)) * HTB)
#define PG8_SB(b, h) ((4 + (b) * 2 + (h)) * HTB)
#define PG8_STAGE(bufoff, gbase, voff) do { _Pragma("unroll") for (int _i = 0; _i < 2; ++_i) \
        __builtin_amdgcn_global_load_lds((const unsigned*)((const char*)(gbase) + (voff)[_i]), (LAS unsigned*)(lds + (bufoff) + ldsw + _i * 8192), 16, 0, 0); } while (0)
#define PG8_STAGE_A(bufoff, kbase, h, VO) do { if constexpr (GATHER) { PG8_STAGE(bufoff, kbase, (VO)[h]); } else { PG8_STAGE(bufoff, (kbase) + (h) * hstep, voffA); } } while (0)
#define PG8_FILL(buf, U) do { if (tid < 256) { const bool ok_ = tid < (U).nvalid; const int ent_ = (ok_ && (S.a_compact == 2 || Epi::ROWINFO)) ? S.list[(size_t)(U).e * CAP + (U).r0 + tid] : 0; \
        rowtab[(buf) * 256 + tid] = (S.a_compact == 2) ? (ent_ >> 2) * (K * 2) : tid * (K * 2); \
        if constexpr (Epi::ROWINFO) { rowtab[768 + (buf) * 512 + tid] = ok_ ? ent_ : -1; rowtab[768 + (buf) * 512 + 256 + tid] = ok_ ? __builtin_bit_cast(int, S.gwl[(size_t)(U).e * CAP + (U).r0 + tid]) : 0; } } \
        if constexpr (Epi::BIASTAB) { if (tid >= 256) rowtab[2304 + (buf) * 256 + (tid - 256)] = __builtin_bit_cast(int, E.bias_at((U), tid - 256)); } } while (0)
#define PG8_LOADVO(VO, buf) do { _Pragma("unroll") for (int h_ = 0; h_ < 2; ++h_) _Pragma("unroll") for (int i_ = 0; i_ < 2; ++i_) (VO)[h_][i_] = (unsigned)rowtab[(buf) * 256 + h_ * 128 + Rr[i_]] + Cc2[i_]; } while (0)
#define PG8_LDA(dst, b, h) do { _Pragma("unroll") for (int m = 0; m < 4; ++m) _Pragma("unroll") for (int k = 0; k < 2; ++k) dst[m][k] = *(const LAS bf16x8*)(lds + PG8_SA(b, h) + aoff + m * 2048 + k * 1024); } while (0)
#define PG8_LDB(dst, b, h) do { _Pragma("unroll") for (int n = 0; n < 2; ++n) _Pragma("unroll") for (int k = 0; k < 2; ++k) dst[n][k] = *(const LAS bf16x8*)(lds + PG8_SB(b, h) + boff + n * 2048 + k * 1024); } while (0)
#define PG8_MMA(ai, bj, At, Bt) do { __builtin_amdgcn_s_setprio(1); _Pragma("unroll") for (int m = 0; m < 4; ++m) _Pragma("unroll") for (int n = 0; n < 2; ++n) _Pragma("unroll") for (int k = 0; k < 2; ++k) \
        acc[ai][bj][m][n] = __builtin_amdgcn_mfma_f32_16x16x32_bf16(Bt[n][k], At[m][k], acc[ai][bj][m][n], 0, 0, 0); __builtin_amdgcn_s_setprio(0); } while (0)
#define PG8_WAIT_V(n) asm volatile("s_waitcnt vmcnt(" #n ")" ::: "memory")
#define PG8_WAIT_L(n) asm volatile("s_waitcnt lgkmcnt(" #n ")" ::: "memory")
#define PG8_BAR __builtin_amdgcn_s_barrier()
#define PG8_SCHED __builtin_amdgcn_sched_barrier(0)
#define VO_a1 vA
#define VO_cA vA
#define VO_a2 vS
#define VO_a3 vS
    Unit cur, nxt; int ui = 0;
    if (!S.next(0, cur)) return;
    f32x4 acc[2][2][4][2];
#pragma unroll
    for (int a = 0; a < 2; ++a)
#pragma unroll
        for (int b = 0; b < 2; ++b)
#pragma unroll
            for (int m = 0; m < 4; ++m)
#pragma unroll
                for (int n = 0; n < 2; ++n) acc[a][b][m][n] = (f32x4){0.f, 0.f, 0.f, 0.f};
    bf16x8 At[4][2], B0[2][2], B1[2][2];
    const char* cA = cur.A; const char* cB = cur.B;
    cur.buf = 0;
    if constexpr (GATHER) { PG8_FILL(0, cur); asm volatile("s_waitcnt lgkmcnt(0)" ::: "memory"); PG8_BAR; asm volatile("" ::: "memory"); PG8_LOADVO(vA, 0); }
    if constexpr (SP2) {
        PG8_STAGE(PG8_SB(0, 0), cB, voffB); PG8_STAGE(PG8_SB(0, 1), cB + hstep, voffB); PG8_STAGE_A(PG8_SA(0, 0), cA, 0, VO_cA); PG8_STAGE_A(PG8_SA(0, 1), cA, 1, VO_cA);
        if (wr == 1) PG8_BAR;
        PG8_WAIT_V(2); PG8_BAR;
        PG8_STAGE(PG8_SB(1, 0), cB + kstep, voffB); PG8_STAGE_A(PG8_SA(1, 0), cA + kstep, 0, VO_cA); PG8_STAGE(PG8_SB(1, 1), cB + hstep + kstep, voffB);
        PG8_WAIT_V(6); PG8_BAR;
    } else {
        PG8_STAGE(PG8_SB(0, 0), cB, voffB); PG8_STAGE_A(PG8_SA(0, 0), cA, 0, VO_cA); PG8_STAGE(PG8_SB(0, 1), cB + hstep, voffB); PG8_STAGE_A(PG8_SA(0, 1), cA, 1, VO_cA);
        if (wr == 1) PG8_BAR;
        PG8_WAIT_V(4); PG8_BAR;
        PG8_STAGE(PG8_SB(1, 0), cB + kstep, voffB); PG8_STAGE_A(PG8_SA(1, 0), cA + kstep, 0, VO_cA); PG8_STAGE(PG8_SB(1, 1), cB + hstep + kstep, voffB);
        PG8_WAIT_V(6); PG8_BAR;
    }
    for (;;) {
        const bool has_next = S.next(ui + 1, nxt);
        const char* nA = has_next ? nxt.A : cA; const char* nB = has_next ? nxt.B : cB;
        nxt.buf = (ui + 1) % 3;
        if constexpr (GATHER) { if (has_next) PG8_FILL((ui + 1) % 3, nxt); }
        for (int t = 0; t < nt; t += 2) {
            const bool last = (t == nt - 2);
            const char* a1 = cA + (size_t)(t + 1) * kstep;
            const char* a2 = last ? nA : cA + (size_t)(t + 2) * kstep; const char* b2 = last ? nB : cB + (size_t)(t + 2) * kstep;
            const char* a3 = a2 + kstep; const char* b3 = b2 + kstep;
            unsigned vS[2][2];
            if constexpr (GATHER) { if (last && has_next) PG8_LOADVO(vN, (ui + 1) % 3);
#pragma unroll
                for (int h_ = 0; h_ < 2; ++h_)
#pragma unroll
                    for (int i_ = 0; i_ < 2; ++i_) vS[h_][i_] = (last && has_next) ? vN[h_][i_] : vA[h_][i_]; }
            else { vS[0][0] = 0u; vS[0][1] = 0u; vS[1][0] = 0u; vS[1][1] = 0u; }
            if constexpr (SP2) {
            PG8_LDB(B0, 0, 0); PG8_LDB(B1, 0, 1); PG8_SCHED; PG8_LDA(At, 0, 0); PG8_STAGE_A(PG8_SA(1, 1), a1, 1, VO_a1);
            PG8_WAIT_V(8); PG8_WAIT_L(0); PG8_BAR; PG8_MMA(0, 0, At, B0); PG8_MMA(0, 1, At, B1); PG8_BAR; PG8_SCHED;
            PG8_LDA(At, 0, 1); PG8_STAGE(PG8_SB(0, 0), b2, voffB); PG8_STAGE(PG8_SB(0, 1), b2 + hstep, voffB); PG8_STAGE_A(PG8_SA(0, 0), a2, 0, VO_a2);
            PG8_WAIT_V(8); PG8_WAIT_L(0); PG8_BAR; PG8_MMA(1, 0, At, B0); PG8_MMA(1, 1, At, B1); PG8_BAR; PG8_SCHED;
            PG8_LDB(B0, 1, 0); PG8_LDB(B1, 1, 1); PG8_SCHED; PG8_LDA(At, 1, 0); PG8_STAGE_A(PG8_SA(0, 1), a2, 1, VO_a2);
            PG8_WAIT_V(8); PG8_WAIT_L(0); PG8_BAR; PG8_MMA(0, 0, At, B0); PG8_MMA(0, 1, At, B1); PG8_BAR; PG8_SCHED;
            PG8_LDA(At, 1, 1); PG8_STAGE(PG8_SB(1, 0), b3, voffB); PG8_STAGE(PG8_SB(1, 1), b3 + hstep, voffB); PG8_STAGE_A(PG8_SA(1, 0), a3, 0, VO_a3);
            PG8_WAIT_V(8); PG8_WAIT_L(0); PG8_BAR; PG8_MMA(1, 0, At, B0); PG8_MMA(1, 1, At, B1); PG8_BAR; PG8_SCHED;
            } else {
            PG8_LDB(B0, 0, 0); PG8_SCHED; PG8_LDA(At, 0, 0); PG8_STAGE_A(PG8_SA(1, 1), a1, 1, VO_a1);
            PG8_WAIT_L(8); PG8_BAR; PG8_WAIT_L(0); PG8_MMA(0, 0, At, B0); PG8_BAR; PG8_SCHED;
            PG8_LDB(B1, 0, 1); PG8_STAGE(PG8_SB(0, 0), b2, voffB);
            PG8_BAR; PG8_WAIT_L(0); PG8_MMA(0, 1, At, B1); PG8_BAR;
            PG8_LDA(At, 0, 1); PG8_STAGE_A(PG8_SA(0, 0), a2, 0, VO_a2);
            PG8_BAR; PG8_WAIT_L(0); PG8_MMA(1, 0, At, B0); PG8_BAR; PG8_SCHED;
            PG8_STAGE(PG8_SB(0, 1), b2 + hstep, voffB);
            PG8_WAIT_V(6); PG8_BAR; PG8_MMA(1, 1, At, B1); PG8_BAR;
            PG8_LDB(B0, 1, 0); PG8_SCHED; PG8_LDA(At, 1, 0); PG8_STAGE_A(PG8_SA(0, 1), a2, 1, VO_a2);
            PG8_WAIT_L(8); PG8_BAR; PG8_WAIT_L(0); PG8_MMA(0, 0, At, B0); PG8_BAR; PG8_SCHED;
            PG8_LDB(B1, 1, 1); PG8_STAGE(PG8_SB(1, 0), b3, voffB);
            PG8_BAR; PG8_WAIT_L(0); PG8_MMA(0, 1, At, B1); PG8_BAR;
            PG8_LDA(At, 1, 1); PG8_STAGE_A(PG8_SA(1, 0), a3, 0, VO_a3);
            PG8_BAR; PG8_WAIT_L(0); PG8_MMA(1, 0, At, B0); PG8_BAR; PG8_SCHED;
            PG8_STAGE(PG8_SB(1, 1), b3 + hstep, voffB);
            PG8_WAIT_V(6); PG8_BAR; PG8_MMA(1, 1, At, B1); PG8_BAR;
            }
        }
        if constexpr (ALIGN_EPI) { if (wr == 0) PG8_BAR; }
        E(acc, cur, wr, wc, fr, fq);
        if (!has_next) break;
#pragma unroll
        for (int a = 0; a < 2; ++a)
#pragma unroll
            for (int b = 0; b < 2; ++b)
#pragma unroll
                for (int m = 0; m < 4; ++m)
#pragma unroll
                    for (int n = 0; n < 2; ++n) acc[a][b][m][n] = (f32x4){0.f, 0.f, 0.f, 0.f};
        cur = nxt; cA = nA; cB = nB; ++ui;
        if constexpr (GATHER) { vA[0][0] = vN[0][0]; vA[0][1] = vN[0][1]; vA[1][0] = vN[1][0]; vA[1][1] = vN[1][1]; }
        if constexpr (ALIGN_EPI) { if (wr == 1) PG8_BAR; }
    }
    PG8_WAIT_V(0);
    if constexpr (!ALIGN_EPI) { if (wr == 0) PG8_BAR; }
    PG8_BAR;
#undef PG8_SA
#undef PG8_SB
#undef PG8_STAGE
#undef PG8_STAGE_A
#undef PG8_FILL
#undef PG8_LOADVO
#undef VO_a1
#undef VO_cA
#undef VO_a2
#undef VO_a3
#undef PG8_LDA
#undef PG8_LDB
#undef PG8_MMA
#undef PG8_WAIT_V
#undef PG8_WAIT_L
#undef PG8_BAR
#undef PG8_SCHED
}
}

#define XB_TMO      128
#define XB_XCNT(j)  (256  + 64 * (j))
#define XB_XSUB(j)  (1280 + 64 * (j))
#define XB_XGEN(j)  (2304 + 64 * (j))
#define XB_TOP      3328
#define XB_TOPGEN   3392
#define XCD_BAR_WORDS 3456
#define XB_SPIN_CAP (1u << 18)
__device__ __forceinline__ unsigned xb_ld(unsigned* p)              { return __hip_atomic_load(p, __ATOMIC_RELAXED, __HIP_MEMORY_SCOPE_AGENT); }
__device__ __forceinline__ unsigned xb_add(unsigned* p, unsigned v) { return __hip_atomic_fetch_add(p, v, __ATOMIC_RELAXED, __HIP_MEMORY_SCOPE_AGENT); }
__device__ __forceinline__ unsigned xb_xcc_id() { return (unsigned)__builtin_amdgcn_s_getreg((3 << 11) | 20) & 0xFu; }
#define XB_SPIN(cond, bar) do { unsigned _sp = 0; while (cond) { __builtin_amdgcn_s_sleep(1); \
    if ((++_sp & 255u) == 0u) { if (xb_ld(&(bar)[XB_TMO])) break; if (_sp > XB_SPIN_CAP) { atomicAdd(&(bar)[XB_TMO], 1u); break; } } } } while (0)
struct XcdBarrier { unsigned* bar; unsigned x; volatile LAS unsigned* st; };
__device__ __forceinline__ XcdBarrier xcd_barrier_post(unsigned* bar, volatile LAS unsigned* st, bool leader) {
    XcdBarrier b; b.bar = bar; b.x = xb_xcc_id(); b.st = st;
    if (leader) (void)xb_add(&bar[XB_XCNT(b.x)], 1u);
    return b;
}
__device__ __forceinline__ void xcd_barrier_complete(unsigned* bar, unsigned x, unsigned& nloc, unsigned& nx) {
    const unsigned G = gridDim.x * gridDim.y * gridDim.z;
    unsigned sum, cnt, mine, sp = 0u;
    for (;;) {
        sum = 0u; cnt = 0u; mine = 0u;
#pragma unroll
        for (unsigned j = 0; j < 16; ++j) { const unsigned c = xb_ld(&bar[XB_XCNT(j)]); sum += c; cnt += (c > 0u) ? 1u : 0u; mine = (j == x) ? c : mine; }
        if (sum == G) break;
        __builtin_amdgcn_s_sleep(1);
        if ((++sp & 255u) == 0u) { if (xb_ld(&bar[XB_TMO])) break; if (sp > XB_SPIN_CAP) { atomicAdd(&bar[XB_TMO], 1u); break; } }
    }
    nloc = mine > 0u ? mine : 1u; nx = cnt > 0u ? cnt : 1u;
}
__device__ __forceinline__ void xcd_barrier(const XcdBarrier& b, int wave) {
    asm volatile("s_waitcnt vmcnt(0)" ::: "memory");
    __syncthreads();
    if (wave == 0 && lane_id() == 0) {
        unsigned* bar = b.bar;
        __builtin_amdgcn_s_waitcnt(0);
        unsigned nloc = b.st[0], nx = b.st[1];
        if (nloc == 0u) { xcd_barrier_complete(bar, b.x, nloc, nx); b.st[0] = nloc; b.st[1] = nx; }
        const unsigned old = xb_add(&bar[XB_XSUB(b.x)], 1u);
        const unsigned gen = old / nloc;
        if (old + 1u == (gen + 1u) * nloc) {
            __builtin_amdgcn_fence(__ATOMIC_RELEASE, "agent");
            asm volatile("s_waitcnt vmcnt(0)" ::: "memory");
            const unsigned og = xb_add(&bar[XB_TOP], 1u);
            const unsigned tg = og / nx;
            if (og + 1u == (tg + 1u) * nx) xb_add(&bar[XB_TOPGEN], 1u);
            else XB_SPIN(xb_ld(&bar[XB_TOPGEN]) == tg, bar);
            __builtin_amdgcn_fence(__ATOMIC_ACQUIRE, "agent");
            xb_add(&bar[XB_XGEN(b.x)], 1u);
            asm volatile("s_waitcnt vmcnt(0)" ::: "memory");
        } else {
            XB_SPIN(xb_ld(&bar[XB_XGEN(b.x)]) == gen, bar);
            __builtin_amdgcn_fence(__ATOMIC_ACQUIRE, "agent");
            asm volatile("s_waitcnt vmcnt(0)" ::: "memory");
        }
    }
    __syncthreads();
}

struct Args { const float* in[33]; float* out; unsigned char* ws; int ph_lo, ph_hi; };
struct Frame {
    LAS unsigned char* lds;
    int wave, vcu, G, gw, NGW;
};

__device__ __forceinline__ void transpose_item(const float* W, int ldw, int col_off, int K, bf16* WT, int mode, int kb, int nb, LAS unsigned char* scr, int lane) {
    const int k0 = 64 * kb, n0 = 64 * nb;
    const float* src = W + (size_t)k0 * ldw + col_off + n0;
    f32x4 v[16];
#pragma unroll
    for (int i = 0; i < 16; ++i) v[i] = __builtin_nontemporal_load((const f32x4*)(src + (size_t)((lane >> 4) + 4 * i) * ldw + 4 * (lane & 15)));
#pragma unroll
    for (int i = 0; i < 16; ++i) { LAS unsigned* p = (LAS unsigned*)(scr + ((lane >> 4) + 4 * i) * 132 + 8 * (lane & 15)); p[0] = pk2(v[i][0], v[i][1]); p[1] = pk2(v[i][2], v[i][3]); }
    asm volatile("s_waitcnt lgkmcnt(0)" ::: "memory");
    const int c = lane >> 3, nl = lane & 7;
#pragma unroll
    for (int r = 0; r < 8; ++r) { const int n = nl + 8 * r; const LAS unsigned short* s = (const LAS unsigned short*)(scr + (8 * c) * 132 + 2 * n);
        u32x4 o; o.x = (unsigned)s[0] | ((unsigned)s[66] << 16); o.y = (unsigned)s[132] | ((unsigned)s[198] << 16); o.z = (unsigned)s[264] | ((unsigned)s[330] << 16); o.w = (unsigned)s[396] | ((unsigned)s[462] << 16);
        const int ng = n0 + n; int drow = ng; if (mode == 1) { drow = ng < 1024 ? 256 * (ng >> 7) + (ng & 127) : 256 * ((ng - 1024) >> 7) + 128 + (ng & 127); }
        if (mode == 2 && ng < 2048) { const int i_ = ng & 127; drow = (ng & ~127) + (i_ < 64 ? 2 * i_ : 2 * (i_ - 64) + 1); }
        __builtin_nontemporal_store(o, (u32x4*)(WT + (size_t)drow * K + k0 + 8 * c)); }
    asm volatile("s_waitcnt lgkmcnt(0)" ::: "memory");
}

__device__ __forceinline__ void load_cols16(int tid, const float* W, int ldw, int col_off, LAS float* Wt) {
    f32x4 wv[8];
#pragma unroll
    for (int i = 0; i < 8; ++i) { const int q = tid + i * NTHREADS, k = q >> 2, e0 = (q & 3) * 4; wv[i] = *(const f32x4*)(W + (size_t)k * ldw + col_off + e0); }
#pragma unroll
    for (int i = 0; i < 8; ++i) { const int q = tid + i * NTHREADS, k = q >> 2, e0 = (q & 3) * 4;
        Wt[(e0 + 0) * 1028 + k] = wv[i][0]; Wt[(e0 + 1) * 1028 + k] = wv[i][1]; Wt[(e0 + 2) * 1028 + k] = wv[i][2]; Wt[(e0 + 3) * 1028 + k] = wv[i][3]; }
}
__device__ __forceinline__ float row_dot16(const f32x4 (&v)[4], const LAS float* Wt, int lane) {
    float p[16];
#pragma unroll
    for (int e = 0; e < 16; ++e) { float s = 0.f;
#pragma unroll
        for (int j = 0; j < 4; ++j) { const f32x4 w = *(const LAS f32x4*)(Wt + e * 1028 + 4 * (lane + 64 * j)); s += v[j][0] * w[0] + v[j][1] * w[1] + v[j][2] * w[2] + v[j][3] * w[3]; }
        p[e] = s; }
    float a8[8], a4[4], a2[2], r1;
#pragma unroll
    for (int e = 0; e < 8; ++e) { const auto r = __builtin_amdgcn_permlane32_swap(__builtin_bit_cast(unsigned, p[e]), __builtin_bit_cast(unsigned, p[e + 8]), false, false); a8[e] = __builtin_bit_cast(float, (unsigned)r[0]) + __builtin_bit_cast(float, (unsigned)r[1]); }
#pragma unroll
    for (int e = 0; e < 4; ++e) { const auto r = __builtin_amdgcn_permlane16_swap(__builtin_bit_cast(unsigned, a8[e]), __builtin_bit_cast(unsigned, a8[e + 4]), false, false); a4[e] = __builtin_bit_cast(float, (unsigned)r[0]) + __builtin_bit_cast(float, (unsigned)r[1]); }
    { const bool hi = (lane & 8) != 0;
#pragma unroll
      for (int e = 0; e < 2; ++e) { const float mine = hi ? a4[e + 2] : a4[e], theirs = hi ? a4[e] : a4[e + 2]; a2[e] = mine + dpp_f<0x128>(theirs); } }
    { const bool hi = (lane & 4) != 0; const float mine = hi ? a2[1] : a2[0], theirs = hi ? a2[0] : a2[1]; r1 = mine + dpp_f<0x141>(theirs); }
    r1 += dpp_f<0x4E>(r1); r1 += dpp_f<0xB1>(r1);
    return r1;
}
__device__ __forceinline__ void store_row_bf16(bf16* orow, const f32x4 (&v)[4], int lane) {
    unsigned long long* o8 = (unsigned long long*)orow + lane;
#pragma unroll
    for (int j = 0; j < 4; ++j) o8[64 * j] = (unsigned long long)pk2(v[j][0], v[j][1]) | ((unsigned long long)pk2(v[j][2], v[j][3]) << 32);
}
__device__ __forceinline__ void store_row_f32(float* orow, const f32x4 (&v)[4], int lane) {
    f32x4* o = (f32x4*)orow + lane;
#pragma unroll
    for (int j = 0; j < 4; ++j) o[64 * j] = v[j];
}
__device__ __forceinline__ void load_row_f32(const float* row, f32x4 (&v)[4], int lane) {
    const f32x4* p = (const f32x4*)row + lane;
#pragma unroll
    for (int j = 0; j < 4; ++j) v[j] = p[64 * j];
}
__device__ __forceinline__ void ln_row(f32x4 (&v)[4], const f32x4 (&gv)[4], const f32x4 (&bv)[4]) {
    float s = 0.f;
#pragma unroll
    for (int j = 0; j < 4; ++j) s += (v[j][0] + v[j][1]) + (v[j][2] + v[j][3]);
    const float mean = wave_sum(s) * (1.f / D); float s2 = 0.f;
#pragma unroll
    for (int j = 0; j < 4; ++j) { v[j] = v[j] - mean; s2 += (v[j][0] * v[j][0] + v[j][1] * v[j][1]) + (v[j][2] * v[j][2] + v[j][3] * v[j][3]); }
    const float rstd = __builtin_amdgcn_rsqf(wave_sum(s2) * (1.f / D) + LN_EPS);
#pragma unroll
    for (int j = 0; j < 4; ++j) v[j] = v[j] * rstd * gv[j] + bv[j];
}

__device__ __forceinline__ const float* inp_ptr(LAS unsigned char* lds, int i) {
    const LAS unsigned* p = (const LAS unsigned*)(lds + MISC_OFF + 256) + 2 * i;
    const unsigned lo = __builtin_amdgcn_readfirstlane(p[0]), hi = __builtin_amdgcn_readfirstlane(p[1]);
    return (const float*)(const GAS float*)(((unsigned long long)hi << 32) | lo);
}

__device__ __forceinline__ void stamp_fn(LAS unsigned char* lds, int wave, int k) {
    if (blockIdx.x == 0 && wave == 0 && lane_id() == 0) { volatile LAS unsigned long long* st = (volatile LAS unsigned long long*)(lds + MISC_OFF + 1024);
        const unsigned long long now = __builtin_amdgcn_s_memrealtime(); if (k >= PROBE_T && k <= PROBE_T2) st[1] = st[1] + (now - st[0]); st[0] = now; }
}
typedef short s16x4 __attribute__((ext_vector_type(4)));
typedef short v4i16_t __attribute__((ext_vector_type(4)));
constexpr int CL = 128, NCH = T / CL;
template <int MODE> struct MX;
template <> struct MX<0> { static constexpr int NH = 8, DK = 64,  DV = 128, LDP = 3072, KOFF = 512,  VOFF = 1024, GOFF = 2048; };
template <> struct MX<1> { static constexpr int NH = 8, DK = 128, DV = 256, LDP = 6144, KOFF = 1024, VOFF = 2048, GOFF = 4096; };
template <> struct MX<2> { static constexpr int NH = 4, DK = 128, DV = 256, LDP = 3072, KOFF = 512,  VOFF = 1024, GOFF = 2048; };
__device__ __forceinline__ s16x4 ds_tr(const LAS unsigned char* p) { return __builtin_bit_cast(s16x4, __builtin_amdgcn_ds_read_tr16_b64_v4i16((LAS v4i16_t*)p)); }
__device__ __forceinline__ bf16x8 tr_frag(const LAS unsigned char* base, int pitch, int k0, int n0, int lane) {
    const int g = lane >> 4, q = (lane & 15) >> 2, p = lane & 3;
    const LAS unsigned char* a = base + (k0 + 4 * g + q) * pitch + (n0 + 4 * p) * 2;
    const s16x4 r1 = ds_tr(a), r2 = ds_tr(a + 16 * pitch);
    bf16x8 f; f[0] = r1[0]; f[1] = r1[1]; f[2] = r1[2]; f[3] = r1[3]; f[4] = r2[0]; f[5] = r2[1]; f[6] = r2[2]; f[7] = r2[3]; return f;
}
__device__ __forceinline__ u32x4 scale_bf16x8(u32x4 v, float sc) {
    u32x4 o; o.x = pk2(bflo(v.x) * sc, bfhi(v.x) * sc); o.y = pk2(bflo(v.y) * sc, bfhi(v.y) * sc); o.z = pk2(bflo(v.z) * sc, bfhi(v.z) * sc); o.w = pk2(bflo(v.w) * sc, bfhi(v.w) * sc); return o;
}
__device__ __forceinline__ float ret_lg2gamma(int h) { return log2f(1.f - exp2f(-5.f - (float)h)); }

template <int MODE>
__device__ __forceinline__ void mix_phaseA(const Frame& F, unsigned char* ws, const int tid, const int lane) {
    typedef MX<MODE> C; constexpr int DK = C::DK, DV = C::DV, NH = C::NH, LDP = C::LDP, KP = DK * 2 + 32, VP = DV * 2 + 32, ETW = DV / 128, NDT = DK / 16;
    LAS unsigned char* ldsK = F.lds; LAS unsigned char* ldsV = F.lds + 128 * KP; LAS float* rsc = (LAS float*)(F.lds + 128 * KP + 128 * VP);
    const bf16* PB = (const bf16*)(ws + WS_PB); const bf16* KPP = (const bf16*)(ws + WS_KPP); bf16* UT = (bf16*)(ws + WS_UT);
    const float* GSC = (const float*)(ws + WS_SC); float* NLOC = (float*)(ws + WS_SC + 2 * MiB);
    const float* LAp = (const float*)(ws + WS_LA); float* DECp = (float*)(ws + WS_SC + 3 * MiB);
    const int w = F.wave, g = lane >> 4;
    for (int u = blockIdx.x; u < 2 * NH * NCH; u += F.G) {
        const int c = u % NCH, bh = u / NCH, h = bh % NH, b = bh / NH; const size_t row0 = (size_t)b * T + (size_t)c * CL;
        u32x4 kr[DK / 32], vr[DV / 32];
        f32x2 cs[16]; unsigned qv[16], kv[16];
        const size_t gr0 = row0 + 16 * w; const int gch = h * 128 + 2 * lane;
        if (MODE == 2) {
#pragma unroll
            for (int i = 0; i < 16; ++i) { cs[i] = *(const f32x2*)(LAp + (gr0 + i) * 512 + gch); qv[i] = *(const unsigned*)(PB + (gr0 + i) * 3072 + gch); kv[i] = *(const unsigned*)(PB + (gr0 + i) * 3072 + 512 + gch); }
        } else {
#pragma unroll
            for (int i = 0; i < DK / 32; ++i) { const int p = tid + i * NTHREADS, r = p / (DK / 8), cp = p % (DK / 8);
                kr[i] = *(const u32x4*)(PB + (row0 + r) * LDP + C::KOFF + h * DK + cp * 8); }
        }
#pragma unroll
        for (int i = 0; i < DV / 32; ++i) { const int p = tid + i * NTHREADS, r = p / (DV / 8), cp = p % (DV / 8);
            vr[i] = *(const u32x4*)(PB + (row0 + r) * LDP + C::VOFF + h * DV + cp * 8); }
        float gmax = 0.f; if (MODE == 0) gmax = GSC[(size_t)(2 * 16 + bh) * T + c * CL + 127];
        const float lgh = (MODE == 1) ? ret_lg2gamma(h) : 0.f;
        __syncthreads();
        if (MODE == 2) {
            LAS float* tot = rsc;
#pragma unroll
            for (int i = 1; i < 16; ++i) cs[i] += cs[i - 1];
            *(LAS f32x2*)(tot + w * 128 + 2 * lane) = cs[15];
            __syncthreads();
            f32x2 pre = (f32x2){0.f, 0.f}, bend = (f32x2){0.f, 0.f};
#pragma unroll
            for (int w2 = 0; w2 < NWAVES; ++w2) { const f32x2 tw = *(const LAS f32x2*)(tot + w2 * 128 + 2 * lane); bend += tw; if (w2 < w) pre += tw; }
            bf16* PBw = (bf16*)(ws + WS_PB);
#pragma unroll
            for (int i = 0; i < 16; ++i) { const float b0 = pre[0] + cs[i][0], b1 = pre[1] + cs[i][1];
                const float q0 = bflo(qv[i]), q1 = bfhi(qv[i]), k0 = bflo(kv[i]) * 0.08838834764831845f, k1 = bfhi(kv[i]) * 0.08838834764831845f;
                *(unsigned*)(PBw + (gr0 + i) * 3072 + gch) = pk2(q0 * __expf(b0), q1 * __expf(b1));
                *(unsigned*)(PBw + (gr0 + i) * 3072 + 512 + gch) = pk2(k0 * __expf(-b0), k1 * __expf(-b1));
                *(LAS unsigned*)(ldsK + (16 * w + i) * KP + lane * 4) = pk2(k0 * __expf(bend[0] - b0), k1 * __expf(bend[1] - b1)); }
            if (w == 0) *(f32x2*)(DECp + (size_t)(b * NCH + c) * 512 + gch) = (f32x2){__expf(bend[0]), __expf(bend[1])};
        } else {
#pragma unroll
            for (int i = 0; i < DK / 32; ++i) { const int p = tid + i * NTHREADS, r = p / (DK / 8), cp = p % (DK / 8);
                u32x4 v = kr[i];
                if (MODE == 0) v = scale_bf16x8(v, __expf(GSC[(size_t)(1 * 16 + bh) * T + c * CL + r] - gmax));
                if (MODE == 1) v = scale_bf16x8(v, exp2f((float)(127 - r) * lgh));
                *(LAS u32x4*)(ldsK + r * KP + cp * 16) = v; }
        }
#pragma unroll
        for (int i = 0; i < DV / 32; ++i) { const int p = tid + i * NTHREADS, r = p / (DV / 8), cp = p % (DV / 8); *(LAS u32x4*)(ldsV + r * VP + cp * 16) = vr[i]; }
        __syncthreads();
        f32x4 acc[ETW][NDT];
#pragma unroll
        for (int i = 0; i < ETW; ++i)
#pragma unroll
            for (int j = 0; j < NDT; ++j) acc[i][j] = (f32x4){0.f, 0.f, 0.f, 0.f};
#pragma unroll
        for (int ks = 0; ks < 4; ++ks) {
            bf16x8 af[ETW], bfv[NDT];
#pragma unroll
            for (int i = 0; i < ETW; ++i) af[i] = tr_frag(ldsV, VP, 32 * ks, (w * ETW + i) * 16, lane);
#pragma unroll
            for (int j = 0; j < NDT; ++j) bfv[j] = tr_frag(ldsK, KP, 32 * ks, j * 16, lane);
#pragma unroll
            for (int i = 0; i < ETW; ++i)
#pragma unroll
                for (int j = 0; j < NDT; ++j) acc[i][j] = __builtin_amdgcn_mfma_f32_16x16x32_bf16(bfv[j], af[i], acc[i][j], 0, 0, 0);
        }
        bf16* ut = UT + (size_t)u * DV * DK;
#pragma unroll
        for (int i = 0; i < ETW; ++i)
#pragma unroll
            for (int j = 0; j < NDT; ++j)
                { uint2 o; o.x = pk2(acc[i][j][0], acc[i][j][1]); o.y = pk2(acc[i][j][2], acc[i][j][3]); *(uint2*)(ut + (size_t)((w * ETW + i) * 16 + (lane & 15)) * DK + j * 16 + 4 * g) = o; }
        if (MODE == 0) {
            float sacc = 0.f;
#pragma unroll
            for (int r = 0; r < 16; ++r) sacc += bf2f(*(const LAS unsigned short*)(ldsK + (16 * w + r) * KP + lane * 2));
            rsc[w * 64 + lane] = sacc;
            __syncthreads();
            if (tid < 64) { float t = 0.f;
#pragma unroll
                for (int q = 0; q < NWAVES; ++q) t += rsc[q * 64 + tid];
                NLOC[(size_t)u * 64 + tid] = t; } }
    }
    __syncthreads();
}

template <int MODE>
__device__ __forceinline__ void mix_phaseB(const Frame& F, unsigned char* ws, const int tid) {
    typedef MX<MODE> C; constexpr int DK = C::DK, DV = C::DV, NH = C::NH, NEL = DV * DK, NBH = 2 * NH;
    const bf16* UT = (const bf16*)(ws + WS_UT); bf16* ST = (bf16*)(ws + WS_ST);
    const float* GSC = (const float*)(ws + WS_SC); const float* NLOC = (const float*)(ws + WS_SC + 2 * MiB); float* NPREV = (float*)(ws + WS_SC + 2 * MiB + 256 * 1024);
    float* MPREV = (float*)(ws + WS_SC + 2 * MiB + 512 * 1024); const float* DEC = (const float*)(ws + WS_SC + 3 * MiB);
    const int gtid = blockIdx.x * NTHREADS + tid, nthr = F.G * NTHREADS;
    for (int el8 = gtid; el8 < NBH * NEL / 8; el8 += nthr) {
        const int el = el8 * 8, bh = el / NEL, idx = el - bh * NEL, h = bh % NH, b = bh / NH;
        float S[8]; float m = -1e30f;
#pragma unroll
        for (int q = 0; q < 8; ++q) S[q] = 0.f;
        const float rdec = (MODE == 1) ? exp2f(128.f * ret_lg2gamma(h)) : 1.f;
#pragma unroll 1
        for (int c0 = 0; c0 < NCH; c0 += 16) {
            u32x4 uv[16]; float at_[16], gm_[16];
#pragma unroll
            for (int i = 0; i < 16; ++i) { uv[i] = *(const u32x4*)(UT + (size_t)(bh * NCH + c0 + i) * NEL + idx);
                if (MODE == 0) { at_[i] = GSC[(size_t)(0 * 16 + bh) * T + (c0 + i) * CL + 127]; gm_[i] = GSC[(size_t)(2 * 16 + bh) * T + (c0 + i) * CL + 127]; } }
#pragma unroll
            for (int i = 0; i < 16; ++i) { const int c = c0 + i; const size_t u = (size_t)bh * NCH + c;
                u32x4 o; o.x = pk2(S[0], S[1]); o.y = pk2(S[2], S[3]); o.z = pk2(S[4], S[5]); o.w = pk2(S[6], S[7]);
                *(u32x4*)(ST + u * NEL + idx) = o;
                const float u0 = bflo(uv[i].x), u1 = bfhi(uv[i].x), u2 = bflo(uv[i].y), u3 = bfhi(uv[i].y), u4 = bflo(uv[i].z), u5 = bfhi(uv[i].z), u6 = bflo(uv[i].w), u7 = bfhi(uv[i].w);
                if (MODE == 0) { const float atot = at_[i], mloc = atot + gm_[i];
                    const float mnew = fmaxf(atot + m, mloc), so = __expf(atot + m - mnew), sl = __expf(mloc - mnew);
                    if (idx == 0) MPREV[u] = m;
                    S[0] = so * S[0] + sl * u0; S[1] = so * S[1] + sl * u1; S[2] = so * S[2] + sl * u2; S[3] = so * S[3] + sl * u3;
                    S[4] = so * S[4] + sl * u4; S[5] = so * S[5] + sl * u5; S[6] = so * S[6] + sl * u6; S[7] = so * S[7] + sl * u7; m = mnew; }
                else if (MODE == 1) { S[0] = rdec * S[0] + u0; S[1] = rdec * S[1] + u1; S[2] = rdec * S[2] + u2; S[3] = rdec * S[3] + u3; S[4] = rdec * S[4] + u4; S[5] = rdec * S[5] + u5; S[6] = rdec * S[6] + u6; S[7] = rdec * S[7] + u7; }
                else { const float* dp = DEC + (size_t)(b * NCH + c) * 512 + h * 128 + (idx & 127); const f32x4 d0 = *(const f32x4*)dp, d1 = *(const f32x4*)(dp + 4);
                    S[0] = d0[0] * S[0] + u0; S[1] = d0[1] * S[1] + u1; S[2] = d0[2] * S[2] + u2; S[3] = d0[3] * S[3] + u3; S[4] = d1[0] * S[4] + u4; S[5] = d1[1] * S[5] + u5; S[6] = d1[2] * S[6] + u6; S[7] = d1[3] * S[7] + u7; } }
        }
    }
    if (MODE == 0) {
        for (int el = gtid; el < NBH * 64; el += nthr) { const int bh = el >> 6, d = el & 63; float S = 0.f, m = -1e30f;
#pragma unroll 1
            for (int c0 = 0; c0 < NCH; c0 += 8) { float at[8], gm[8], nl[8];
#pragma unroll
                for (int i = 0; i < 8; ++i) { const int c = c0 + i; at[i] = GSC[(size_t)(0 * 16 + bh) * T + c * CL + 127]; gm[i] = GSC[(size_t)(2 * 16 + bh) * T + c * CL + 127]; nl[i] = NLOC[((size_t)bh * NCH + c) * 64 + d]; }
#pragma unroll
                for (int i = 0; i < 8; ++i) { const size_t u = (size_t)bh * NCH + c0 + i; const float atot = at[i], mloc = atot + gm[i];
                    const float mnew = fmaxf(atot + m, mloc), so = __expf(atot + m - mnew), sl = __expf(mloc - mnew);
                    NPREV[u * 64 + d] = S; S = so * S + sl * nl[i]; m = mnew; } } }
    }
}

template <int MODE>
__device__ __forceinline__ void mix_phaseC(const Frame& F, unsigned char* ws, const int tid, const int lane, const float* ng) {
    typedef MX<MODE> C; constexpr int DK = C::DK, DV = C::DV, NH = C::NH, LDP = C::LDP, VP = DV * 2 + 32, KP = DK * 2 + 16, SP = DK * 2 + 16, NET = DV / 16, NKS = DK / 32, DVT = NH * DV;
    constexpr int NSP = DV * DK / 8 / NTHREADS;
    LAS unsigned char* ldsV = F.lds; LAS unsigned char* ldsK = F.lds + 128 * VP; LAS unsigned char* ldsS = F.lds;
    LAS float* tabs = (LAS float*)(F.lds + 128 * VP + 128 * KP);
    static_assert(DV * SP <= 128 * VP + 128 * KP, "S^T image fits the stage-1 region");
    const bf16* PB = (const bf16*)(ws + WS_PB); const bf16* ST = (const bf16*)(ws + WS_ST);
    const float* GSC = (const float*)(ws + WS_SC); const float* NPREV = (const float*)(ws + WS_SC + 2 * MiB + 256 * 1024); const float* MPREV = (const float*)(ws + WS_SC + 2 * MiB + 512 * 1024);
    const int w = F.wave, g = lane >> 4, li = lane & 15;
    constexpr int NU = 2 * NH * NCH;
    u32x4 kr[DK / 32], vr[DV / 32], sreg[NSP];
#define PC_LOAD_KV(U_) do { const int c_ = (U_) % NCH, bh_ = (U_) / NCH, h_ = bh_ % NH, b_ = bh_ / NH; const char* pb_ = (const char*)(PB + ((size_t)b_ * T + (size_t)c_ * CL) * LDP); \
        const char* vb_ = pb_ + (C::VOFF + h_ * DV) * 2; const char* kb_ = pb_ + (C::KOFF + h_ * DK) * 2; int t_ = tid; asm volatile("" : "+v"(t_));     \
        _Pragma("unroll") for (int i = 0; i < DV / 32; ++i) { const int p = t_ + i * NTHREADS, r = p / (DV / 8), cp = p % (DV / 8); vr[i] = *(const u32x4*)(vb_ + (unsigned)(r * LDP + cp * 8) * 2u); } \
        _Pragma("unroll") for (int i = 0; i < DK / 32; ++i) { const int p = t_ + i * NTHREADS, r = p / (DK / 8), cp = p % (DK / 8); kr[i] = *(const u32x4*)(kb_ + (unsigned)(r * LDP + cp * 8) * 2u); } } while (0)
#define PC_LOAD_S(U_) do { const bf16* st_ = ST + (size_t)(U_) * DV * DK; _Pragma("unroll") for (int i = 0; i < NSP; ++i) sreg[i] = *(const u32x4*)(st_ + (size_t)(tid + i * NTHREADS) * 8); } while (0)
    if ((int)blockIdx.x < NU) { PC_LOAD_KV((int)blockIdx.x); }
    for (int u = blockIdx.x; u < NU; u += F.G) {
        const int c = u % NCH, bh = u / NCH, h = bh % NH, b = bh / NH; const size_t row0 = (size_t)b * T + (size_t)c * CL;
        const float lg = (MODE == 1) ? ret_lg2gamma(h) : 0.f;
        const int tq = 16 * w + li;
        const bf16* qrow = PB + (row0 + tq) * LDP + h * DK;
        bf16x8 qf[NKS];
#pragma unroll
        for (int ks = 0; ks < NKS; ++ks) qf[ks] = *(const bf16x8*)(qrow + 32 * ks + 8 * g);
        PC_LOAD_S(u);
        __syncthreads();
#pragma unroll
        for (int i = 0; i < DV / 32; ++i) { const int p = tid + i * NTHREADS, r = p / (DV / 8), cp = p % (DV / 8); *(LAS u32x4*)(ldsV + r * VP + cp * 16) = vr[i]; }
#pragma unroll
        for (int i = 0; i < DK / 32; ++i) { const int p = tid + i * NTHREADS, r = p / (DK / 8), cp = p % (DK / 8); *(LAS u32x4*)(ldsK + r * KP + cp * 16) = kr[i]; }
        if (u + F.G < NU) PC_LOAD_KV(u + F.G);
        if (MODE == 0 && tid < 128) { const float mp = MPREV[u]; const size_t gi = (size_t)bh * T + c * CL + tid;
            const float a = GSC[(size_t)(0 * 16) * T + gi], gg = GSC[(size_t)(1 * 16) * T + gi], cm = GSC[(size_t)(2 * 16) * T + gi];
            const float Mt = fmaxf(mp, cm);
            tabs[tid] = gg; tabs[128 + tid] = Mt; tabs[256 + tid] = __expf(mp - Mt) * 0.125f; tabs[384 + tid] = __expf(-(a + Mt)); }
        __syncthreads();
        f32x4 O[NET];
#pragma unroll
        for (int et = 0; et < NET; ++et) O[et] = (f32x4){0.f, 0.f, 0.f, 0.f};
        float den = 0.f;
        const float Mq = (MODE == 0) ? tabs[128 + tq] : 0.f;
        const float qs = (MODE == 0) ? tabs[256 + tq] : (MODE == 1) ? exp2f((float)(tq + 1) * lg) : 1.f;
        const float fin = (MODE == 0) ? tabs[384 + tq] : 1.f;
        for (int jp = 0; jp <= (w >> 1); ++jp) {
            f32x4 p0 = (f32x4){0.f, 0.f, 0.f, 0.f}, p1 = (f32x4){0.f, 0.f, 0.f, 0.f};
            const LAS unsigned char* k0p = ldsK + (32 * jp + li) * KP + 16 * g;
#pragma unroll
            for (int ks = 0; ks < NKS; ++ks) p0 = __builtin_amdgcn_mfma_f32_16x16x32_bf16(*(const LAS bf16x8*)(k0p + 64 * ks), qf[ks], p0, 0, 0, 0);
            if (2 * jp + 1 <= w) {
#pragma unroll
                for (int ks = 0; ks < NKS; ++ks) p1 = __builtin_amdgcn_mfma_f32_16x16x32_bf16(*(const LAS bf16x8*)(k0p + 16 * KP + 64 * ks), qf[ks], p1, 0, 0, 0);
            }
#pragma unroll
            for (int r = 0; r < 4; ++r) {
                const int s0 = 32 * jp + 4 * g + r, s1 = s0 + 16;
                float f0, f1;
                if (MODE == 0) { f0 = __expf(tabs[s0] - Mq) * 0.125f; f1 = __expf(tabs[s1] - Mq) * 0.125f; }
                else if (MODE == 1) { f0 = exp2f((float)(tq - s0) * lg); f1 = exp2f((float)(tq - s1) * lg); }
                else { f0 = 1.f; f1 = 1.f; }
                p0[r] = (s0 <= tq) ? p0[r] * f0 : 0.f; p1[r] = (s1 <= tq) ? p1[r] * f1 : 0.f;
                den += p0[r] + p1[r];
            }
            bf16x8 af; { const unsigned a0 = pk2(p0[0], p0[1]), a1 = pk2(p0[2], p0[3]), a2 = pk2(p1[0], p1[1]), a3 = pk2(p1[2], p1[3]); u32x4 t4; t4.x = a0; t4.y = a1; t4.z = a2; t4.w = a3; af = __builtin_bit_cast(bf16x8, t4); }
#pragma unroll
            for (int et = 0; et < NET; ++et) O[et] = __builtin_amdgcn_mfma_f32_16x16x32_bf16(af, tr_frag(ldsV, VP, 32 * jp, 16 * et, lane), O[et], 0, 0, 0);
        }
        __syncthreads();
#pragma unroll
        for (int i = 0; i < NSP; ++i) { const int p = tid + i * NTHREADS, e = p / (DK / 8), cp = p % (DK / 8); *(LAS u32x4*)(ldsS + e * SP + cp * 16) = sreg[i]; }
        __syncthreads();
        bf16* YBp = (bf16*)(ws + WS_YB);
        const int rr = lane >> 3, pq = lane & 7;
        const bf16* gpr = PB + (row0 + 16 * w + rr) * LDP + C::GOFF + h * DV + pq * 8; bf16* ypr = YBp + (row0 + 16 * w + rr) * DVT + h * DV + pq * 8;
        asm volatile("" : "+v"(gpr), "+v"(ypr));
        u32x4 gvv[2][DV / 64];
#pragma unroll
        for (int hf = 0; hf < 2; ++hf)
#pragma unroll
            for (int it = 0; it < DV / 64; ++it) gvv[hf][it] = *(const u32x4*)(gpr + (size_t)(8 * (it & 1)) * LDP + hf * (DV / 2) + 64 * (it >> 1));
        float dint = 0.f;
#pragma unroll
        for (int ks = 0; ks < NKS; ++ks) {
            bf16x8 aq = qf[ks];
            if (MODE != 2) aq = __builtin_bit_cast(bf16x8, scale_bf16x8(__builtin_bit_cast(u32x4, qf[ks]), qs));
            if (MODE == 0) { const float* np = NPREV + (size_t)u * 64 + 32 * ks + 8 * g; const u32x4 qa = __builtin_bit_cast(u32x4, aq);
                dint += bflo(qa.x) * np[0] + bfhi(qa.x) * np[1] + bflo(qa.y) * np[2] + bfhi(qa.y) * np[3] + bflo(qa.z) * np[4] + bfhi(qa.z) * np[5] + bflo(qa.w) * np[6] + bfhi(qa.w) * np[7]; }
#pragma unroll
            for (int et = 0; et < NET; ++et) O[et] = __builtin_amdgcn_mfma_f32_16x16x32_bf16(aq, *(const LAS bf16x8*)(ldsS + (16 * et + li) * SP + 64 * ks + 16 * g), O[et], 0, 0, 0);
        }
        float rd[4] = {1.f, 1.f, 1.f, 1.f};
        if (MODE == 0) {
            float dt = den + dint; dt += __shfl_xor(dt, 16); dt += __shfl_xor(dt, 32);
            LAS float* wsc = tabs + 512 + 16 * w;
            if (g == 0) wsc[li] = __builtin_amdgcn_rcpf(fmaxf(fabsf(dt), fin));
            asm volatile("s_waitcnt lgkmcnt(0)" ::: "memory");
#pragma unroll
            for (int r = 0; r < 4; ++r) rd[r] = wsc[4 * g + r];
        }
        float mean[4], rstd[4];
#pragma unroll
        for (int r = 0; r < 4; ++r) { float sacc = 0.f;
#pragma unroll
            for (int et = 0; et < NET; ++et) { O[et][r] *= rd[r]; sacc += O[et][r]; }
            sacc = row16_sum(sacc);
            mean[r] = sacc * (1.f / DV); float q = 0.f;
#pragma unroll
            for (int et = 0; et < NET; ++et) { const float dlt = O[et][r] - mean[r]; q += dlt * dlt; }
            q = row16_sum(q);
            rstd[r] = __builtin_amdgcn_rsqf(q * (1.f / DV) + LN_EPS); }
        constexpr int RPF = DV * 2 + 16, TB = (MODE == 0) ? (128 * VP + 128 * KP + 2560) : DV * SP;
        static_assert(TB + NWAVES * 16 * RPF <= PH_BYTES && TB % 16 == 0, "epilogue tiles fit");
        LAS unsigned char* tw = F.lds + TB + w * (16 * RPF);
        const float* ngp = ng + h * DV + li;
#define GATEF(x_) ((MODE == 0) ? sigmoidf_(x_) : (x_) * sigmoidf_(x_))
#pragma unroll
        for (int hf = 0; hf < 2; ++hf) {
#pragma unroll
            for (int e2 = 0; e2 < NET / 2; ++e2) { const int et = hf * (NET / 2) + e2; const float gn = ngp[16 * et];
#pragma unroll
                for (int r = 0; r < 4; ++r) *(LAS float*)(tw + (4 * g + r) * RPF + (16 * e2 + li) * 4) = (O[et][r] - mean[r]) * rstd[r] * gn; }
            asm volatile("s_waitcnt lgkmcnt(0)" ::: "memory");
#pragma unroll
            for (int it = 0; it < DV / 64; ++it) { const int rb = 8 * (it & 1), cb = 64 * (it >> 1);
                const u32x4 gv = gvv[hf][it];
                const LAS float* tp = (const LAS float*)(tw + (rb + rr) * RPF + (cb + pq * 8) * 4);
                const f32x4 n0 = *(const LAS f32x4*)tp, n1 = *(const LAS f32x4*)(tp + 4);
                const float g0 = bflo(gv.x), g1 = bfhi(gv.x), g2 = bflo(gv.y), g3 = bfhi(gv.y), g4 = bflo(gv.z), g5 = bfhi(gv.z), g6 = bflo(gv.w), g7 = bfhi(gv.w);
                u32x4 o; o.x = pk2(GATEF(g0) * n0[0], GATEF(g1) * n0[1]); o.y = pk2(GATEF(g2) * n0[2], GATEF(g3) * n0[3]);
                o.z = pk2(GATEF(g4) * n1[0], GATEF(g5) * n1[1]); o.w = pk2(GATEF(g6) * n1[2], GATEF(g7) * n1[3]);
                *(u32x4*)(ypr + (size_t)rb * DVT + hf * (DV / 2) + cb) = o; }
            asm volatile("s_waitcnt lgkmcnt(0)" ::: "memory");
        }
#undef GATEF
    }
    __syncthreads();
#undef PC_LOAD_KV
#undef PC_LOAD_S
}

constexpr int SLN = 32, NCI = T / SLN, NI = 2 * NCI, NRT = NI / 16, SKK = SLN * 16;
__device__ __forceinline__ void s5_pow(const f32x4 cf, float n, float& pr, float& pi) { const float e = __expf(n * cf[0]); const float a = n * cf[1]; pr = e * __cosf(a); pi = e * __sinf(a); }

__device__ __forceinline__ void s5_tables(const Frame& F, unsigned char* ws, const int tid, const float* lam_re, const float* lam_im, const float* b_re, const float* b_im, const float* c_re, const float* c_im, const float* log_dt) {
    bf16* KT = (bf16*)(ws + WS_S5KT); bf16* VT = (bf16*)(ws + WS_S5VT); bf16* WT = (bf16*)(ws + WS_S5WT); float* L64 = (float*)(ws + WS_S5L64);
    LAS f32x4* CF = (LAS f32x4*)F.lds;
    for (int i = tid; i < 64 * 64; i += NTHREADS) { const int g = i >> 6; const float lr = lam_re[i], li = lam_im[i], dt = expf(log_dt[g]);
        const float er = expf(lr * dt); float sn, cs; sincosf(li * dt, &sn, &cs);
        const float nr = er * cs - 1.f, ni = er * sn, den = lr * lr + li * li;
        CF[i] = (f32x4){lr * dt, li * dt, (nr * lr + ni * li) / den, (ni * lr - nr * li) / den}; }
    __syncthreads();
    const int gt = blockIdx.x * NTHREADS + tid, nthr = F.G * NTHREADS;
    LAS float* BR = (LAS float*)(F.lds + 65536); LAS float* BI = BR + 1024; LAS float* CR = BI + 1024; LAS float* CI = CR + 1024;
    for (int i0 = blockIdx.x * NTHREADS; i0 < 64 * SLN * 16 * 4; i0 += nthr) {
        const int g = i0 / (64 * SLN);
        __syncthreads();
        for (int q = tid; q < 1024; q += NTHREADS) { BR[q] = b_re[(size_t)g * 1024 + q]; BI[q] = b_im[(size_t)g * 1024 + q]; CR[q] = c_re[(size_t)g * 1024 + q]; CI[q] = c_im[(size_t)g * 1024 + q]; }
        __syncthreads();
        const int i4 = i0 + tid, pq = i4 & 3, idx = i4 >> 2, h = idx & 15, tau = (idx >> 4) % SLN;
        float acc[16];
#pragma unroll
        for (int q = 0; q < 16; ++q) acc[q] = 0.f;
#pragma unroll 4
        for (int p = pq * 16; p < pq * 16 + 16; ++p) { const f32x4 cf = CF[g * 64 + p]; float pr, pi; s5_pow(cf, (float)tau, pr, pi);
            const float cr = CR[h * 64 + p], ci = CI[h * 64 + p];
            const float xr = cr * pr - ci * pi, xi = cr * pi + ci * pr;
            const float yr = xr * cf[2] - xi * cf[3], yi = xr * cf[3] + xi * cf[2];
            const LAS f32x4* br4 = (const LAS f32x4*)(BR + p * 16); const LAS f32x4* bi4 = (const LAS f32x4*)(BI + p * 16);
#pragma unroll
            for (int q = 0; q < 4; ++q) { const f32x4 b_r = br4[q], b_i = bi4[q];
#pragma unroll
                for (int z = 0; z < 4; ++z) acc[4 * q + z] += yr * b_r[z] - yi * b_i[z]; } }
#pragma unroll
        for (int q = 0; q < 16; ++q) { acc[q] += dpp_f<0xB1>(acc[q]); acc[q] += dpp_f<0x4E>(acc[q]); }
        if (pq == 0) { u32x4 o0, o1; o0.x = pk2(acc[0], acc[1]); o0.y = pk2(acc[2], acc[3]); o0.z = pk2(acc[4], acc[5]); o0.w = pk2(acc[6], acc[7]);
            o1.x = pk2(acc[8], acc[9]); o1.y = pk2(acc[10], acc[11]); o1.z = pk2(acc[12], acc[13]); o1.w = pk2(acc[14], acc[15]);
            *(u32x4*)(KT + (size_t)idx * 16) = o0; *(u32x4*)(KT + (size_t)idx * 16 + 8) = o1; } }
    for (int idx = gt; idx < 64 * 64 * SLN; idx += nthr) {
        const int j = idx % SLN, p = (idx / SLN) & 63, g = idx / (SLN * 64);
        const f32x4 cf = CF[g * 64 + p]; float pr, pi;
        s5_pow(cf, (float)(SLN - 1 - j), pr, pi);
        const float yr = pr * cf[2] - pi * cf[3], yi = pr * cf[3] + pi * cf[2];
        const float* br = b_re + (size_t)(g * 64 + p) * 16; const float* bi = b_im + (size_t)(g * 64 + p) * 16;
        float vr[16], vi[16];
#pragma unroll
        for (int q = 0; q < 16; ++q) { vr[q] = yr * br[q] - yi * bi[q]; vi[q] = yr * bi[q] + yi * br[q]; }
        bf16* v0 = VT + ((size_t)(g * 128 + 2 * p) * SKK + j * 16);
        u32x4 o; o.x = pk2(vr[0], vr[1]); o.y = pk2(vr[2], vr[3]); o.z = pk2(vr[4], vr[5]); o.w = pk2(vr[6], vr[7]); *(u32x4*)v0 = o;
        o.x = pk2(vr[8], vr[9]); o.y = pk2(vr[10], vr[11]); o.z = pk2(vr[12], vr[13]); o.w = pk2(vr[14], vr[15]); *(u32x4*)(v0 + 8) = o;
        o.x = pk2(vi[0], vi[1]); o.y = pk2(vi[2], vi[3]); o.z = pk2(vi[4], vi[5]); o.w = pk2(vi[6], vi[7]); *(u32x4*)(v0 + SKK) = o;
        o.x = pk2(vi[8], vi[9]); o.y = pk2(vi[10], vi[11]); o.z = pk2(vi[12], vi[13]); o.w = pk2(vi[14], vi[15]); *(u32x4*)(v0 + SKK + 8) = o;
        if (j == 0) { s5_pow(cf, (float)SLN, pr, pi); L64[(g * 64 + p) * 2] = pr; L64[(g * 64 + p) * 2 + 1] = pi; }
    }
    for (int idx = gt; idx < 64 * 64 * SLN; idx += nthr) {
        const int p = idx & 63, l = (idx >> 6) % SLN, g = idx / (SLN * 64);
        const f32x4 cf = CF[g * 64 + p]; float pr, pi; s5_pow(cf, (float)(l + 1), pr, pi);
#pragma unroll
        for (int h = 0; h < 16; ++h) { const float cr = c_re[(g * 16 + h) * 64 + p], ci = c_im[(g * 16 + h) * 64 + p];
            *(unsigned*)(WT + ((size_t)((g * SLN + l) * 16 + h) * 128 + 2 * p)) = pk2(cr * pr - ci * pi, -(cr * pi + ci * pr)); }
    }
    __syncthreads();
}
__device__ __forceinline__ void s5_phaseA(const Frame& F, unsigned char* ws, const int lane) {
    const bf16* PB = (const bf16*)(ws + WS_PB); const bf16* VT = (const bf16*)(ws + WS_S5VT); float* SL = (float*)(ws + WS_S5SL);
    const int gq = lane >> 4, li = lane & 15;
    for (int wu = F.gw; wu < 64 * NRT * 2; wu += F.NGW) {
        const int half = wu & 1, rt = (wu >> 1) % NRT, g = wu / (2 * NRT), b = rt / (NRT / 2), c0 = (rt % (NRT / 2)) * 16;
        f32x4 acc[4];
#pragma unroll
        for (int ct = 0; ct < 4; ++ct) acc[ct] = (f32x4){0.f, 0.f, 0.f, 0.f};
        const bf16* ap = PB + ((size_t)b * T + (size_t)(c0 + li) * SLN + (gq >> 1)) * 1024 + g * 16 + 8 * (gq & 1);
        const bf16* bp = VT + (size_t)(g * 128 + half * 64 + li) * SKK + 8 * gq;
#pragma unroll 4
        for (int ks = 0; ks < SLN / 2; ++ks) {
            const bf16x8 af = *(const bf16x8*)(ap + (size_t)(2 * ks) * 1024);
#pragma unroll
            for (int ct = 0; ct < 4; ++ct) acc[ct] = __builtin_amdgcn_mfma_f32_16x16x32_bf16(af, *(const bf16x8*)(bp + (size_t)(16 * ct) * SKK + 32 * ks), acc[ct], 0, 0, 0);
        }
#pragma unroll
        for (int ct = 0; ct < 4; ++ct)
#pragma unroll
            for (int r = 0; r < 4; ++r) SL[(size_t)(g * NI + rt * 16 + 4 * gq + r) * 128 + half * 64 + ct * 16 + li] = acc[ct][r];
    }
}
__device__ __forceinline__ void s5_phaseB(const Frame& F, unsigned char* ws, const int tid) {
    static_assert(NCI == 256, "16 groups of 16 chunks");
    const float* SL = (const float*)(ws + WS_S5SL); bf16* SP = (bf16*)(ws + WS_S5SP); const float* L64 = (const float*)(ws + WS_S5L64);
    for (int gt = blockIdx.x * NTHREADS + tid; gt < 2 * 64 * 64 * 16; gt += F.G * NTHREADS) {
        const int grp = gt & 15, p = (gt >> 4) & 63, g = (gt >> 10) & 63, b = gt >> 16;
        const float ar = L64[(g * 64 + p) * 2], ai = L64[(g * 64 + p) * 2 + 1];
        const size_t base = (size_t)(g * NI + b * NCI + grp * 16) * 128 + 2 * p;
        f32x2 x[16];
#pragma unroll
        for (int i = 0; i < 16; ++i) x[i] = *(const f32x2*)(SL + base + (size_t)i * 128);
        float lr[16], li[16], sr = 0.f, si = 0.f;
#pragma unroll
        for (int i = 0; i < 16; ++i) { lr[i] = sr; li[i] = si; const float nr = ar * sr - ai * si + x[i][0], ni = ar * si + ai * sr + x[i][1]; sr = nr; si = ni; }
        float mr = ar, mi = ai;
#pragma unroll
        for (int k = 0; k < 4; ++k) { const float t = mr * mr - mi * mi; mi = 2.f * mr * mi; mr = t; }
#define S5_STEP(CTRL) do { const float tr = __builtin_bit_cast(float, __builtin_amdgcn_update_dpp(0, __builtin_bit_cast(int, sr), CTRL, 0xf, 0xf, true)), ti = __builtin_bit_cast(float, __builtin_amdgcn_update_dpp(0, __builtin_bit_cast(int, si), CTRL, 0xf, 0xf, true)); \
            sr += mr * tr - mi * ti; si += mr * ti + mi * tr; const float t2 = mr * mr - mi * mi; mi = 2.f * mr * mi; mr = t2; } while (0)
        S5_STEP(0x111); S5_STEP(0x112); S5_STEP(0x114); S5_STEP(0x118);
#undef S5_STEP
        const float pr = __builtin_bit_cast(float, __builtin_amdgcn_update_dpp(0, __builtin_bit_cast(int, sr), 0x111, 0xf, 0xf, true)), pi = __builtin_bit_cast(float, __builtin_amdgcn_update_dpp(0, __builtin_bit_cast(int, si), 0x111, 0xf, 0xf, true));
        float qr = 1.f, qi = 0.f;
#pragma unroll
        for (int i = 0; i < 16; ++i) { const float orr = qr * pr - qi * pi + lr[i], oi = qr * pi + qi * pr + li[i];
            *(unsigned*)(SP + base + (size_t)i * 128) = pk2(orr, oi);
            const float t = qr * ar - qi * ai; qi = qr * ai + qi * ar; qr = t; }
    }
}
__device__ __forceinline__ void s5_phaseC(const Frame& F, unsigned char* ws, const int lane, const float* dskip) {
    const bf16* PB = (const bf16*)(ws + WS_PB); const bf16* KT = (const bf16*)(ws + WS_S5KT); const bf16* WT = (const bf16*)(ws + WS_S5WT); const bf16* SP = (const bf16*)(ws + WS_S5SP);
    bf16* YB = (bf16*)(ws + WS_YB);
    const int gq = lane >> 4, li = lane & 15;
#pragma unroll 1
    for (int wu = F.gw; wu < 64 * NRT * 2; wu += F.NGW) {
        const int par = wu & 1, rt = (wu >> 1) % NRT, g = wu / (2 * NRT), b = rt / (NRT / 2), c0 = (rt % (NRT / 2)) * 16;
        bf16x8 af[SLN / 2], sf[4];
        const bf16* ap = PB + ((size_t)b * T + (size_t)(c0 + li) * SLN + (gq >> 1)) * 1024 + g * 16 + 8 * (gq & 1);
#pragma unroll
        for (int ks = 0; ks < SLN / 2; ++ks) af[ks] = *(const bf16x8*)(ap + (size_t)(2 * ks) * 1024);
#pragma unroll
        for (int ks = 0; ks < 4; ++ks) sf[ks] = *(const bf16x8*)(SP + (size_t)(g * NI + rt * 16 + li) * 128 + 32 * ks + 8 * gq);
        const f32x4 dl = *(const f32x4*)(dskip + g * 16 + 4 * gq);
        const bf16* ktp = KT + (size_t)g * SLN * 256 + li * 16 + 8 * (gq & 1);
#pragma unroll
        for (int l2 = 0; l2 < SLN / 2; ++l2) {
            int l = 2 * l2 + par; asm volatile("" : "+v"(l));
            f32x4 acc = (f32x4){0.f, 0.f, 0.f, 0.f};
            const size_t o = ((size_t)b * T + (size_t)(c0 + li) * SLN + l) * 1024 + g * 16 + 4 * gq;
            const uint2 uv = *(const uint2*)(PB + o);
#pragma unroll
            for (int ks = 0; ks <= l2; ++ks) { const int tau = l - 2 * ks - (gq >> 1);
                bf16x8 bfv = *(const bf16x8*)(ktp + (size_t)(tau < 0 ? 0 : tau) * 256);
                if (ks == l2 && tau < 0) bfv = (bf16x8){0, 0, 0, 0, 0, 0, 0, 0};
                acc = __builtin_amdgcn_mfma_f32_16x16x32_bf16(bfv, af[ks], acc, 0, 0, 0); }
            const bf16* wp = WT + (size_t)((g * SLN + l) * 16 + li) * 128 + 8 * gq;
#pragma unroll
            for (int ks = 0; ks < 4; ++ks) acc = __builtin_amdgcn_mfma_f32_16x16x32_bf16(*(const bf16x8*)(wp + 32 * ks), sf[ks], acc, 0, 0, 0);
            { uint2 ov; ov.x = pk2(gelu_tanh(acc[0] + dl[0] * bflo(uv.x)), gelu_tanh(acc[1] + dl[1] * bfhi(uv.x))); ov.y = pk2(gelu_tanh(acc[2] + dl[2] * bflo(uv.y)), gelu_tanh(acc[3] + dl[3] * bfhi(uv.y)));
                *(uint2*)(YB + o) = ov; }
            asm volatile("" ::: "memory");
        }
    }
}

#define IN(k) (lo <= (k) && (k) < hi)
#define SEAM(k) do { if ((k) + 1 < hi) { xcd_barrier(bar, F.wave); if (PROBE_CLS == 10) xcd_barrier(bar, F.wave); if (PROBE_T >= 0) stamp_fn(F.lds, F.wave, (k)); } } while (0)
#define INP(i) inp_ptr(F.lds, (i))
#define x_in INP(0)
#define ln_g INP(1)
#define ln_b INP(2)
#define WS_PTRS \
    float* HF = (float*)(ws + WS_HF); bf16* XB = (bf16*)(ws + WS_XB); bf16* ZF = (bf16*)(ws + WS_ZF); bf16* PB = (bf16*)(ws + WS_PB); \
    float* GB = (float*)(ws + WS_GB); float* LA = (float*)(ws + WS_LA); float* ORAW = (float*)(ws + WS_ORAW); bf16* YB = (bf16*)(ws + WS_YB); \
    bf16* ACT = (bf16*)(ws + WS_ACT); bf16* YS = (bf16*)(ws + WS_YS); bf16* XG = (bf16*)(ws + WS_XG); \
    int* LIST = (int*)(ws + WS_LIST); float* GW = (float*)(ws + WS_ORAW); \
    float* S5LB = (float*)(ws + WS_S5TAB); float* S5BB = (float*)(ws + WS_S5TAB + 32768); \
    (void)HF; (void)XB; (void)ZF; (void)PB; (void)GB; (void)LA; (void)ORAW; (void)YB; (void)ACT; (void)YS; (void)XG; (void)LIST; (void)GW; (void)S5LB; (void)S5BB;

template <int layer>
__device__ __forceinline__ void layer_body(const Frame& F, unsigned char* ws, unsigned* ctl, LAS int* TAB, const XcdBarrier& bar, const int lo, const int hi, float* d_out) {
    WS_PTRS
        const int pb = 1 + layer * 16;
        const float* hin = (layer == 0) ? x_in : HF;
        if (PHE(1) && IN(pb + 0)) {
            const bf16* Wt = (const bf16*)(ws + (layer == 0 ? WS_WT_ML_IN : layer == 1 ? WS_WT_RET_IN : layer == 2 ? WS_WT_GLA_IN : WS_WT_S5_IN));
            const int N = (layer == 0 || layer == 2) ? 3072 : (layer == 1 ? 6144 : 1024);
            pg8::DenseOrder S; S.init(XB, Wt, M, N, D, F.G, (int)blockIdx.x);
            pg8::EpiBf16 E{PB, N, (const float*)(ws + WS_CS), (layer == 1) ? 8 : 0};
            for (int rep_ = 0; rep_ < REPS(2); ++rep_)
            pg8::gemm_phase<pg8::EpiBf16, pg8::DenseOrder, true, true>(F.lds, F.wave, D, S, E);
            if (layer == 0 && CH_ML) {
                const int lane = lane_id(); float* GSC = (float*)(ws + WS_SC);
                for (int wu = F.gw; wu < 16 * NCH; wu += F.NGW) { const int bh = wu / NCH, c = wu % NCH, b = bh >> 3, h = bh & 7;
                    const int t0 = c * CL + 2 * lane; const size_t row = (size_t)b * T + t0;
                    const float lf0 = log_sigmoidf_(GB[row * 16 + 8 + h]), lf1 = log_sigmoidf_(GB[(row + 1) * 16 + 8 + h]);
                    const float sp = lf0 + lf1; float inc = sp;
#pragma unroll
                    for (int d = 1; d < 64; d <<= 1) { const float tv_ = __shfl_up(inc, d); if (lane >= d) inc += tv_; }
                    const float a0 = inc - sp + lf0, a1 = inc;
                    const float g0 = GB[row * 16 + h] - a0, g1 = GB[(row + 1) * 16 + h] - a1;
                    float mx = fmaxf(g0, g1);
#pragma unroll
                    for (int d = 1; d < 64; d <<= 1) { const float tv_ = __shfl_up(mx, d); if (lane >= d) mx = fmaxf(mx, tv_); }
                    float ex = __shfl_up(mx, 1); if (lane == 0) ex = -3.0e38f;
                    const size_t o0 = (size_t)bh * T + t0;
                    *(f32x2*)(GSC + (size_t)(0 * 16) * T + o0) = (f32x2){a0, a1};
                    *(f32x2*)(GSC + (size_t)(1 * 16) * T + o0) = (f32x2){g0, g1};
                    *(f32x2*)(GSC + (size_t)(2 * 16) * T + o0) = (f32x2){fmaxf(ex, g0), mx}; }
            }
            SEAM(pb + 0);
        }
        if (layer == 0) {
            if (CH_ML) {
                if (IN(pb + 2)) { const int lane = lane_id(), tid = F.wave * 64 + lane; for (int rep_ = 0; rep_ < REPS(6); ++rep_) mix_phaseA<0>(F, ws, tid, lane); SEAM(pb + 2); }
                if (IN(pb + 3)) { const int lane = lane_id(), tid = F.wave * 64 + lane; for (int rep_ = 0; rep_ < REPS(7); ++rep_) mix_phaseB<0>(F, ws, tid); SEAM(pb + 3); }
                if (IN(pb + 4)) { const int lane = lane_id(), tid = F.wave * 64 + lane; for (int rep_ = 0; rep_ < REPS(8); ++rep_) mix_phaseC<0>(F, ws, tid, lane, INP(5)); SEAM(pb + 4); }
            }
        } else if (layer == 1) {
            if (CH_RET) {
                if (IN(pb + 2)) { const int lane = lane_id(), tid = F.wave * 64 + lane; for (int rep_ = 0; rep_ < REPS(6); ++rep_) mix_phaseA<1>(F, ws, tid, lane); SEAM(pb + 2); }
                if (IN(pb + 3)) { const int lane = lane_id(), tid = F.wave * 64 + lane; for (int rep_ = 0; rep_ < REPS(7); ++rep_) mix_phaseB<1>(F, ws, tid); SEAM(pb + 3); }
                if (IN(pb + 4)) { const int lane = lane_id(), tid = F.wave * 64 + lane; for (int rep_ = 0; rep_ < REPS(8); ++rep_) mix_phaseC<1>(F, ws, tid, lane, INP(8)); SEAM(pb + 4); }
            }
        } else if (layer == 2) {
            if (CH_GLA) {
                if (IN(pb + 2)) { const int lane = lane_id(), tid = F.wave * 64 + lane; for (int rep_ = 0; rep_ < REPS(6); ++rep_) mix_phaseA<2>(F, ws, tid, lane); SEAM(pb + 2); }
                if (IN(pb + 3)) { const int lane = lane_id(), tid = F.wave * 64 + lane; for (int rep_ = 0; rep_ < REPS(7); ++rep_) mix_phaseB<2>(F, ws, tid); SEAM(pb + 3); }
                if (IN(pb + 4)) { const int lane = lane_id(), tid = F.wave * 64 + lane; for (int rep_ = 0; rep_ < REPS(8); ++rep_) mix_phaseC<2>(F, ws, tid, lane, INP(13)); SEAM(pb + 4); }
            }
        } else {
            if (CH_S5) {
                if (IN(pb + 2)) { const int lane = lane_id(); for (int rep_ = 0; rep_ < REPS(6); ++rep_) s5_phaseA(F, ws, lane); SEAM(pb + 2); }
                if (IN(pb + 3)) { const int lane = lane_id(), tid = F.wave * 64 + lane; for (int rep_ = 0; rep_ < REPS(7); ++rep_) s5_phaseB(F, ws, tid); SEAM(pb + 3); }
                if (IN(pb + 4)) { const int lane = lane_id(); for (int rep_ = 0; rep_ < REPS(8); ++rep_) s5_phaseC(F, ws, lane, INP(22)); SEAM(pb + 4); }
            }
        }
        if (PHE(4) && layer == 3 && IN(pb + 6)) {
            pg8::DenseOrder S; S.init(YB, ws + WS_WT_S5_GLU, M, D, D, F.G, (int)blockIdx.x);
            pg8::EpiGlu E{YB, INP(25), (bf16*)ORAW};
            for (int rep_ = 0; rep_ < REPS(3); ++rep_)
            pg8::gemm_phase<pg8::EpiGlu, pg8::DenseOrder, true, true>(F.lds, F.wave, D, S, E);
            SEAM(pb + 6);
        }
        if (PHE(5) && IN(pb + 7)) {
            const bf16* Wt = (const bf16*)(ws + (layer == 0 ? WS_WT_ML_OUT : layer == 1 ? WS_WT_RET_OUT : layer == 2 ? WS_WT_GLA_OUT : WS_WT_S5_OUT));
            const int Kd = (layer == 1) ? 2048 : 1024;
            const bf16* Ain = (layer == 3) ? (const bf16*)ORAW : YB;
            pg8::DenseOrder S; S.init(Ain, Wt, M, D, Kd, F.G, (int)blockIdx.x);
            pg8::EpiResid E{hin, (layer == 0) ? (const bf16*)nullptr : (const bf16*)XB, ZF};
            for (int rep_ = 0; rep_ < REPS(3); ++rep_)
            pg8::gemm_phase<pg8::EpiResid, pg8::DenseOrder, true, true>(F.lds, F.wave, Kd, S, E);
            SEAM(pb + 7);
        }
        unsigned* cnt = ctl + CW_CNT + layer * 32 * 64;
        if (IN(pb + 8) && !defined_SKIP_LN1) { const int lane = lane_id(), tid = F.wave * 64 + lane; (void)tid;
            LAS float* Wt = (LAS float*)(F.lds);
            { const f32x4* wr4 = (const f32x4*)(INP(27) + (size_t)layer * D * NEXP);
              f32x4 wv[16];
#pragma unroll
              for (int i = 0; i < 16; ++i) wv[i] = wr4[tid + i * NTHREADS];
#pragma unroll
              for (int i = 0; i < 16; ++i) { const int q = tid + i * NTHREADS, k = q >> 3, e0 = (q & 7) * 4;
                  Wt[(e0 + 0) * 1028 + k] = wv[i][0]; Wt[(e0 + 1) * 1028 + k] = wv[i][1]; Wt[(e0 + 2) * 1028 + k] = wv[i][2]; Wt[(e0 + 3) * 1028 + k] = wv[i][3]; } }
            __syncthreads();
            const float* br_ = INP(28) + layer * NEXP;
            const float* lng_ = ln_g + (size_t)(layer * 2 + 0) * D; const float* lnb_ = ln_b + (size_t)(layer * 2 + 0) * D;
          {
            unsigned* cntp = cnt;
            int aE = 0, aRow = -1; float aG = 0.f;
            LAS unsigned* lcnt = (LAS unsigned*)(F.lds + 131584); LAS int* lbase = (LAS int*)(lcnt + 32);
            if (tid < 32) lcnt[tid] = 0u;
            const int ntrip = (M + F.NGW - 1) / F.NGW;
            u32x2 vnext[2][4];
#pragma unroll
            for (int q = 0; q < 2; ++q) { const int r_ = F.gw + q * F.NGW; if (r_ < M) { const u32x2* zp = (const u32x2*)(ZF + (size_t)r_ * D) + lane;
#pragma unroll
                for (int j = 0; j < 4; ++j) vnext[q][j] = zp[64 * j]; } }
            for (int it_ = 0; it_ < ntrip; it_ += 2) { const int row0_ = F.gw + it_ * F.NGW;
                asm volatile("" ::: "memory");
                const bool ok[2] = {row0_ < M, it_ + 1 < ntrip && row0_ + F.NGW < M};
                f32x4 v[2][4];
#pragma unroll
                for (int q = 0; q < 2; ++q)
#pragma unroll
                    for (int j = 0; j < 4; ++j) v[q][j] = (f32x4){bflo(vnext[q][j].x), bfhi(vnext[q][j].x), bflo(vnext[q][j].y), bfhi(vnext[q][j].y)};
#pragma unroll
                for (int q = 0; q < 2; ++q) { const int r_ = row0_ + (2 + q) * F.NGW; if (it_ + 2 + q < ntrip && r_ < M) { const u32x2* zp = (const u32x2*)(ZF + (size_t)r_ * D) + lane;
#pragma unroll
                    for (int j = 0; j < 4; ++j) vnext[q][j] = zp[64 * j]; } }
                { f32x4 gv[4], bv[4]; load_row_f32(lng_, gv, lane); load_row_f32(lnb_, bv, lane); ln_row(v[0], gv, bv); ln_row(v[1], gv, bv); }
                float pz[2][32];
#pragma unroll
                for (int e = 0; e < 32; ++e) { float s0 = 0.f, s1 = 0.f;
#pragma unroll
                    for (int j = 0; j < 4; ++j) { const f32x4 w = *(const LAS f32x4*)(Wt + e * 1028 + 4 * (lane + 64 * j));
                        s0 += v[0][j][0] * w[0] + v[0][j][1] * w[1] + v[0][j][2] * w[2] + v[0][j][3] * w[3]; s1 += v[1][j][0] * w[0] + v[1][j][1] * w[1] + v[1][j][2] * w[2] + v[1][j][3] * w[3]; }
                    pz[0][e] = s0; pz[1][e] = s1; }
                float lgv[2];
#pragma unroll
                for (int q = 0; q < 2; ++q) {
                    float a16[16], a8[8], a4[4], a2[2];
#pragma unroll
                    for (int e = 0; e < 16; ++e) { const auto r = __builtin_amdgcn_permlane32_swap(__builtin_bit_cast(unsigned, pz[q][e]), __builtin_bit_cast(unsigned, pz[q][e + 16]), false, false);
                        a16[e] = __builtin_bit_cast(float, (unsigned)r[0]) + __builtin_bit_cast(float, (unsigned)r[1]); }
#pragma unroll
                    for (int e = 0; e < 8; ++e) { const auto r = __builtin_amdgcn_permlane16_swap(__builtin_bit_cast(unsigned, a16[e]), __builtin_bit_cast(unsigned, a16[e + 8]), false, false);
                        a8[e] = __builtin_bit_cast(float, (unsigned)r[0]) + __builtin_bit_cast(float, (unsigned)r[1]); }
                    { const bool hi = (lane & 8) != 0;
#pragma unroll
                      for (int e = 0; e < 4; ++e) { const float mine = hi ? a8[e + 4] : a8[e], theirs = hi ? a8[e] : a8[e + 4]; a4[e] = mine + dpp_f<0x128>(theirs); } }
                    { const bool hi = (lane & 4) != 0;
#pragma unroll
                      for (int e = 0; e < 2; ++e) { const float mine = hi ? a4[e + 2] : a4[e], theirs = hi ? a4[e] : a4[e + 2]; a2[e] = mine + dpp_f<0x141>(theirs); } }
                    { const bool hi = (lane & 2) != 0; const float mine = hi ? a2[1] : a2[0], theirs = hi ? a2[0] : a2[1]; lgv[q] = mine + dpp_f<0x4E>(theirs); }
                    lgv[q] += dpp_f<0xB1>(lgv[q]);
                    lgv[q] += br_[lane >> 1];
                }
                int te[2][4]; float tv[2][4];
#pragma unroll
                for (int k = 0; k < 4; ++k)
#pragma unroll
                    for (int q = 0; q < 2; ++q) { const float best = wave_max(lgv[q]);
                        const unsigned long long mk = __ballot(lgv[q] == best); const int src = __builtin_amdgcn_readfirstlane((int)__ffsll((long long)mk) - 1);
                        te[q][k] = src >> 1; tv[q][k] = best; if ((lane >> 1) == te[q][k]) lgv[q] = -3.0e38f; }
#pragma unroll
                for (int q = 0; q < 2; ++q) if (ok[q]) { const int row = row0_ + q * F.NGW;
                    const float e0 = 1.f, e1 = __expf(tv[q][1] - tv[q][0]), e2 = __expf(tv[q][2] - tv[q][0]), e3 = __expf(tv[q][3] - tv[q][0]), rs = __builtin_amdgcn_rcpf(e0 + e1 + e2 + e3);
                    const int ri = (it_ + q) & 15;
                    if ((lane >> 2) == ri) { const int k = lane & 3; aE = k == 0 ? te[q][0] : k == 1 ? te[q][1] : k == 2 ? te[q][2] : te[q][3]; aG = (k == 0 ? e0 : k == 1 ? e1 : k == 2 ? e2 : e3) * rs; aRow = row; }
                    store_row_bf16(XB + (size_t)row * D, v[q], lane); }
                if (((it_ + 1) & 15) == 15 || it_ + 2 >= ntrip) {
                    __syncthreads();
                    int lp = 0; if (aRow >= 0) lp = (int)__hip_atomic_fetch_add(lcnt + aE, 1u, __ATOMIC_RELAXED, __HIP_MEMORY_SCOPE_WORKGROUP);
                    __syncthreads();
                    if (tid < 32) { const unsigned n = lcnt[tid]; lbase[tid] = n ? (int)__hip_atomic_fetch_add(cntp + tid * 64, n, __ATOMIC_RELAXED, __HIP_MEMORY_SCOPE_AGENT) : 0; }
                    __syncthreads();
                    if (aRow >= 0) { const int pos = lbase[aE] + lp; LIST[(size_t)aE * CAP + pos] = aRow * 4 + (lane & 3); GW[(size_t)aE * CAP + pos] = aG; }
                    aRow = -1;
                    __syncthreads();
                    if (tid < 32) lcnt[tid] = 0u;
                }
            }
          }
            __syncthreads();
            SEAM(pb + 8);
        }
        if ((PHE(7) || PHE(8)) && (IN(pb + 9) || IN(pb + 10))) { const int lane = lane_id(), tid = F.wave * 64 + lane; (void)tid;
            __syncthreads();
            if (tid < 32) TAB[tid] = (int)__hip_atomic_load(cnt + tid * 64, __ATOMIC_RELAXED, __HIP_MEMORY_SCOPE_AGENT);
            __syncthreads();
            if (tid < 64) {
                const int nt_ = (lane < 32) ? ((TAB[lane] + 255) >> 8) : 0; int inc = nt_;
#pragma unroll
                for (int d = 1; d < 32; d <<= 1) { const int t_ = __shfl_up(inc, d); if (lane >= d) inc += t_; }
                if (lane < 32) TAB[32 + lane] = inc - nt_;
                if (lane == 31) TAB[64] = inc; }
            __syncthreads();
            if (tid < MAXTILES) { int e = 0;
#pragma unroll
                for (int k = 1; k < 32; ++k) e += (TAB[32 + k] <= tid) ? 1 : 0;
                if (tid < TAB[64]) TAB[72 + tid] = e; }
            __syncthreads();
        }
        if (PHE(7) && IN(pb + 9)) {
            pg8::MoeOrder S; S.A = (const char*)XB; S.list = LIST; S.gwl = GW; S.Bt = (const char*)(ws + WS_WT_GU + (size_t)layer * 32 * 2048 * 1024 * 2); S.tab = TAB; S.K = D; S.nN = 8; S.ntiles = __builtin_amdgcn_readfirstlane(TAB[64]); S.nwg = S.ntiles * 8; S.G = F.G; S.c = (int)blockIdx.x;
            S.b_estride = (size_t)2048 * 1024 * 2; S.a_compact = 2;
            pg8::EpiSwiglu E{ACT, INP(30) + (size_t)layer * 32 * 2048, (const LAS float*)(TAB + 2816)};
            for (int rep_ = 0; rep_ < REPS(4); ++rep_)
            pg8::gemm_phase<pg8::EpiSwiglu, pg8::MoeOrder, MOE_ALIGN, true, true>(F.lds, F.wave, D, S, E, TAB + 512);
            SEAM(pb + 9);
        }
        if (PHE(8) && IN(pb + 10)) {
            pg8::MoeOrder S; S.A = (const char*)ACT; S.list = LIST; S.gwl = GW; S.Bt = (const char*)(ws + WS_WT_DN + (size_t)layer * 32 * 1024 * 1024 * 2); S.tab = TAB; S.K = DFF; S.nN = 4; S.ntiles = __builtin_amdgcn_readfirstlane(TAB[64]); S.nwg = S.ntiles * 4; S.G = F.G; S.c = (int)blockIdx.x;
            S.b_estride = (size_t)1024 * 1024 * 2; S.a_compact = 1;
            pg8::EpiMoeDown E{YS, INP(32) + (size_t)layer * 32 * 1024, TAB + 1280, (const LAS float*)(TAB + 2816)};
            for (int rep_ = 0; rep_ < REPS(5); ++rep_)
            pg8::gemm_phase<pg8::EpiMoeDown, pg8::MoeOrder, MOE_ALIGN, true, true>(F.lds, F.wave, DFF, S, E, TAB + 512);
            SEAM(pb + 10);
        }
        if (PHE(9) && IN(pb + 11)) { const int lane = lane_id(), tid = F.wave * 64 + lane; (void)tid;
            LAS float* Wt = (LAS float*)(F.lds);
            if (layer == 1) { load_cols16(tid, INP(10), 3088, 3072, Wt); __syncthreads(); }
            const float* lng_ = ln_g + (size_t)(layer * 2 + 1) * D; const float* lnb_ = ln_b + (size_t)(layer * 2 + 1) * D;
          for (int rep_ = 0; rep_ < REPS(12); ++rep_) {
            float* outp = (PROBE_CLS == 12 && rep_ == 0) ? ORAW : (layer == 3) ? d_out : HF; bf16* XBo = (PROBE_CLS == 12 && rep_ == 0) ? YB : XB;
            f32x4 hn[4]; u32x2 yn[4][4];
#define CMB_LOAD(r_) do { { const u32x2* hp_ = (const u32x2*)(XB + (size_t)(r_) * D) + lane; _Pragma("unroll") for (int j = 0; j < 4; ++j) { const u32x2 hw_ = hp_[64 * j]; hn[j] = (f32x4){bflo(hw_.x), bfhi(hw_.x), bflo(hw_.y), bfhi(hw_.y)}; } } _Pragma("unroll") for (int k = 0; k < 4; ++k) { const u32x2* yp = (const u32x2*)(YS + ((size_t)(r_) * 4 + k) * D) + lane; _Pragma("unroll") for (int j = 0; j < 4; ++j) yn[k][j] = yp[64 * j]; } } while (0)
            if (F.gw < M) CMB_LOAD(F.gw);
            for (int row = F.gw; row < M; row += F.NGW) {
                asm volatile("" ::: "memory");
                f32x4 v[4];
#pragma unroll
                for (int j = 0; j < 4; ++j) v[j] = hn[j] * ALPHA;
#pragma unroll
                for (int k = 0; k < 4; ++k)
#pragma unroll
                    for (int j = 0; j < 4; ++j) { const u32x2 yw = yn[k][j]; v[j][0] += bflo(yw.x); v[j][1] += bfhi(yw.x); v[j][2] += bflo(yw.y); v[j][3] += bfhi(yw.y); }
                if (row + F.NGW < M) CMB_LOAD(row + F.NGW);
                { f32x4 gv[4], bv[4]; load_row_f32(lng_, gv, lane); load_row_f32(lnb_, bv, lane); ln_row(v, gv, bv); }
                if (layer == 3) store_row_f32(outp + (size_t)row * D, v, lane);
                if (layer < 3) store_row_bf16(XBo + (size_t)row * D, v, lane);
                if (layer == 1) {
                    const float zsum = row_dot16(v, Wt, lane);
                    if ((lane & 3) == 0) GB[(size_t)row * 16 + (lane >> 2)] = zsum;
                }
            }
            if (layer == 1) {
                __syncthreads();
                const float* wgp = INP(11); const float bgc = INP(12)[tid];
                float wg[16];
#pragma unroll
                for (int r = 0; r < 16; ++r) wg[r] = wgp[r * 512 + tid];
                for (int row = F.vcu * NWAVES; row < M; row += F.NGW) {
                    f32x4 zv[NWAVES][4];
#pragma unroll
                    for (int w = 0; w < NWAVES; ++w)
#pragma unroll
                        for (int q = 0; q < 4; ++q) zv[w][q] = *(const f32x4*)(GB + (size_t)(row + w) * 16 + 4 * q);
#pragma unroll
                    for (int w = 0; w < NWAVES; ++w) { float sacc = bgc;
#pragma unroll
                        for (int q = 0; q < 4; ++q) sacc += zv[w][q][0] * wg[4 * q] + zv[w][q][1] * wg[4 * q + 1] + zv[w][q][2] * wg[4 * q + 2] + zv[w][q][3] * wg[4 * q + 3];
                        LA[(size_t)(row + w) * 512 + tid] = log_sigmoidf_(sacc) * (1.f / 16.f); }
                }
            }
          }
            __syncthreads();
#undef CMB_LOAD
            if (layer < 3) SEAM(pb + 11);
        }
}
__global__ void __launch_bounds__(NTHREADS, 2) mega_fwd(Args args) {
    extern __shared__ __attribute__((aligned(16))) unsigned char lds_raw[];
    Frame F;
    F.lds = (LAS unsigned char*)lds_raw;
    F.wave = __builtin_amdgcn_readfirstlane((int)threadIdx.x >> 6);
    F.G = gridDim.x; { const int bx = blockIdx.x; F.vcu = (F.G % 8 == 0) ? (bx % 8) * (F.G / 8) + bx / 8 : bx; }
    F.gw = F.vcu * NWAVES + F.wave; F.NGW = F.G * NWAVES;
    unsigned char* ws = args.ws;
    unsigned* ctl = (unsigned*)(ws + WS_CTL);
    volatile LAS unsigned* MISC = (volatile LAS unsigned*)(F.lds + MISC_OFF);
    LAS int* TAB = (LAS int*)(F.lds + TAB_OFF);
    { const int tid0 = threadIdx.x;
      if (tid0 < 64) MISC[tid0] = 0u;
      if (tid0 < 33) ((LAS unsigned long long*)(F.lds + MISC_OFF + 256))[tid0] = (unsigned long long)args.in[tid0]; }
    __syncthreads();
    XcdBarrier bar = xcd_barrier_post(ctl + CW_BAR, MISC + 8, F.wave == 0 && lane_id() == 0);
    if (PROBE_T >= 0 && blockIdx.x == 0 && F.wave == 0 && lane_id() == 0) { volatile LAS unsigned long long* st = (volatile LAS unsigned long long*)(F.lds + MISC_OFF + 1024); st[0] = __builtin_amdgcn_s_memrealtime(); st[1] = 0ull; }
    const int lo = args.ph_lo, hi = args.ph_hi;
    WS_PTRS
    if (IN(0) && !defined_SKIP_P0) { const int lane = lane_id(), tid = F.wave * 64 + lane; (void)tid;
      {
        LAS unsigned char* scr = F.lds + F.wave * 8704;
        {
            constexpr int I_GU = 128 * 16 * 32, I_DN = 128 * 16 * 16, I_ML = 16 * 48, I_SQ = 16 * 16, I_RI = 16 * 96, I_RO = 32 * 16;
            constexpr int B0 = I_GU, B1 = B0 + I_DN, B2 = B1 + I_ML, B3 = B2 + I_SQ, B4 = B3 + I_RI, B5 = B4 + I_RO, B6 = B5 + I_ML, B7 = B6 + I_SQ, B8 = B7 + I_SQ, B9 = B8 + I_SQ, B10 = B9 + I_SQ;
#define P0_ITEM(IT_) do { const int it = (IT_); \
                    const float* src; bf16* dst; int ldw, Kd, nnb, mode = 0, r; \
                    if (it < B0)      { r = it;      const int q = r / (16 * 32); r -= q * (16 * 32); src = INP(29) + (size_t)q * 1024 * 2048; dst = (bf16*)(ws + WS_WT_GU) + (size_t)q * 2048 * 1024; ldw = 2048; Kd = 1024; nnb = 32; mode = 1; } \
                    else if (it < B1) { r = it - B0; const int q = r / (16 * 16); r -= q * (16 * 16); src = INP(31) + (size_t)q * 1024 * 1024; dst = (bf16*)(ws + WS_WT_DN) + (size_t)q * 1024 * 1024; ldw = 1024; Kd = 1024; nnb = 16; } \
                    else if (it < B2) { r = it - B1; src = INP(3);  dst = (bf16*)(ws + WS_WT_ML_IN);  ldw = 3088; Kd = 1024; nnb = 48; } \
                    else if (it < B3) { r = it - B2; src = INP(6);  dst = (bf16*)(ws + WS_WT_ML_OUT); ldw = 1024; Kd = 1024; nnb = 16; } \
                    else if (it < B4) { r = it - B3; src = INP(7);  dst = (bf16*)(ws + WS_WT_RET_IN); ldw = 6144; Kd = 1024; nnb = 96; mode = 2; } \
                    else if (it < B5) { r = it - B4; src = INP(9);  dst = (bf16*)(ws + WS_WT_RET_OUT); ldw = 1024; Kd = 2048; nnb = 16; } \
                    else if (it < B6) { r = it - B5; src = INP(10); dst = (bf16*)(ws + WS_WT_GLA_IN); ldw = 3088; Kd = 1024; nnb = 48; } \
                    else if (it < B7) { r = it - B6; src = INP(14); dst = (bf16*)(ws + WS_WT_GLA_OUT); ldw = 1024; Kd = 1024; nnb = 16; } \
                    else if (it < B8) { r = it - B7; src = INP(15); dst = (bf16*)(ws + WS_WT_S5_IN);  ldw = 1024; Kd = 1024; nnb = 16; } \
                    else if (it < B9) { r = it - B8; src = INP(24); dst = (bf16*)(ws + WS_WT_S5_GLU); ldw = 1024; Kd = 1024; nnb = 16; } \
                    else              { r = it - B9; src = INP(26); dst = (bf16*)(ws + WS_WT_S5_OUT); ldw = 1024; Kd = 1024; nnb = 16; } \
                const int kb = r / nnb, nb = r - kb * nnb; \
                transpose_item(src, ldw, 0, Kd, dst, mode, kb, nb, scr, lane); } while (0)
            const int NSTAT = (B10 / F.NGW) * 4 / 5, DYN0 = NSTAT * F.NGW, DLEN = B10 - DYN0, GLEN = (DLEN + 7) / 8;
#pragma unroll 1
            for (int n_ = 0; n_ < NSTAT; ++n_) P0_ITEM(F.gw + n_ * F.NGW);
#pragma unroll 1
            for (int tr = 0; tr < 8; ++tr) { const int grp = ((int)blockIdx.x + tr) & 7; unsigned* q = ctl + 2304 + 64 * grp; const int glo = DYN0 + grp * GLEN, glen = (DLEN - grp * GLEN) < GLEN ? (DLEN - grp * GLEN) : GLEN;
                int cur = 0; if (lane == 0) cur = (int)__hip_atomic_fetch_add(q, 4u, __ATOMIC_RELAXED, __HIP_MEMORY_SCOPE_AGENT); cur = __builtin_amdgcn_readfirstlane(cur);
#pragma unroll 1
                while (cur < glen) { int nx = 0; if (lane == 0) nx = (int)__hip_atomic_fetch_add(q, 4u, __ATOMIC_RELAXED, __HIP_MEMORY_SCOPE_AGENT);
#pragma unroll 1
                    for (int k = 0; k < 4; ++k) if (cur + k < glen) P0_ITEM(glo + cur + k);
                    cur = __builtin_amdgcn_readfirstlane(nx); } }
#undef P0_ITEM
        }
        __syncthreads();
        if (CH_S5) s5_tables(F, ws, tid, INP(16), INP(17), INP(18), INP(19), INP(20), INP(21), INP(23));
        { float* CS = (float*)(ws + WS_CS);
          for (int it = blockIdx.x * NTHREADS + tid; it < T * 64; it += F.G * NTHREADS) { const int t = it >> 6, i = it & 63;
              const float inv = exp2f(-(float)(2 * i) * (13.287712379549449f / 128.f)); float sn, cs; sincosf((float)t * inv, &sn, &cs); CS[2 * it] = cs; CS[2 * it + 1] = sn; } }
        LAS float* Wt = (LAS float*)(F.lds);
        load_cols16(tid, INP(3), 3088, 3072, Wt);
        __syncthreads();
        {
            const float* bg = INP(4);
            f32x4 vn[4]; if (F.gw < M) load_row_f32(x_in + (size_t)F.gw * D, vn, lane);
            for (int row = F.gw; row < M; row += F.NGW) {
                asm volatile("" ::: "memory");
                f32x4 v[4];
#pragma unroll
                for (int j = 0; j < 4; ++j) v[j] = vn[j];
                if (row + F.NGW < M) load_row_f32(x_in + (size_t)(row + F.NGW) * D, vn, lane);
                store_row_bf16(XB + (size_t)row * D, v, lane);
                const float gsum = row_dot16(v, Wt, lane);
                if ((lane & 3) == 0) GB[(size_t)row * 16 + (lane >> 2)] = gsum + bg[lane >> 2];
            }
        }
        __syncthreads();
      }
        SEAM(0);
    }

    layer_body<0>(F, ws, ctl, TAB, bar, lo, hi, args.out);
    layer_body<1>(F, ws, ctl, TAB, bar, lo, hi, args.out);
    layer_body<2>(F, ws, ctl, TAB, bar, lo, hi, args.out);
    layer_body<3>(F, ws, ctl, TAB, bar, lo, hi, args.out);
    if (PROBE_T >= 0 && blockIdx.x == 0 && F.wave == 0 && lane_id() == 0) { volatile LAS unsigned long long* st = (volatile LAS unsigned long long*)(F.lds + MISC_OFF + 1024); args.out[0] = (float)st[1] * (0.01f / 16.f); }
#undef IN
#undef SEAM
#undef INP
#undef x_in
#undef ln_g
#undef ln_b
}

extern "C" void kernel_launch(void* const* d_in, const int* in_sizes, int n_in, void* d_out, int out_size, void* d_ws, size_t ws_size, hipStream_t stream) {
    static int grid = 0;
    if (grid == 0) {
        if (n_in != 33 || out_size != M * D || ws_size < WS_END) { fprintf(stderr, "kernel_launch: unexpected problem (n_in %d, out %d, ws %zu < %zu)\n", n_in, out_size, ws_size, (size_t)WS_END); grid = -1; return; }
        int dev = 0, cus = 0, per_cu = 0;
        if (hipGetDevice(&dev) != hipSuccess || hipDeviceGetAttribute(&cus, hipDeviceAttributeMultiprocessorCount, dev) != hipSuccess) { grid = -1; return; }
        if (hipFuncSetAttribute((const void*)mega_fwd, hipFuncAttributeMaxDynamicSharedMemorySize, LDS_BYTES) != hipSuccess) { fprintf(stderr, "kernel_launch: hipFuncSetAttribute failed\n"); grid = -1; return; }
        if (hipOccupancyMaxActiveBlocksPerMultiprocessor(&per_cu, (const void*)mega_fwd, NTHREADS, LDS_BYTES) != hipSuccess || per_cu < 1) { fprintf(stderr, "kernel_launch: occupancy query says %d\n", per_cu); }
        (void)hipGetLastError();
        grid = cus;
    }
    if (grid < 0) return;
    hipMemsetAsync((char*)d_ws + WS_CTL, 0, CTL_ZERO_BYTES, stream);
    Args a{};
    for (int i = 0; i < 33; ++i) a.in[i] = (const float*)d_in[i];
    a.out = (float*)d_out; a.ws = (unsigned char*)d_ws;
#if N_LAUNCH_MODE == 1
    a.ph_lo = 0; a.ph_hi = 1000;
    hipLaunchKernelGGL(mega_fwd, dim3(grid), dim3(NTHREADS), LDS_BYTES, stream, a);
#else
    for (int ph = 0; ph < 65; ++ph) { a.ph_lo = ph; a.ph_hi = ph + 1; hipLaunchKernelGGL(mega_fwd, dim3(grid), dim3(NTHREADS), LDS_BYTES, stream, a); }
#endif
}
```

```cpp
#include <hip/hip_runtime.h>
#include <cstdio>
#include <cstdint>

#ifndef NAIVE_MIX
#define NAIVE_MIX 1
#endif
#ifndef CH_ML
#define CH_ML 1
#endif
#ifndef CH_RET
#define CH_RET 1
#endif
#ifndef CH_GLA
#define CH_GLA 1
#endif
#ifndef CH_S5
#define CH_S5 1
#endif
#ifndef PROBE_CLS
#define PROBE_CLS 0
#endif
#define REPS(c) ((PROBE_CLS == (c) || PROBE_CLS == 100 + layer * 10 + (c)) ? 2 : 1)
#ifndef PROBE_T
#define PROBE_T -1
#endif
#ifndef PROBE_T2
#define PROBE_T2 PROBE_T
#endif
#ifndef MOE_ALIGN
#define MOE_ALIGN true
#endif
#ifndef N_LAUNCH_MODE
#define N_LAUNCH_MODE 1
#endif


#ifdef SKIP_ML
constexpr bool defined_SKIP_ML = true;
#else
constexpr bool defined_SKIP_ML = false;
#endif
#ifdef SKIP_RET
constexpr bool defined_SKIP_RET = true;
#else
constexpr bool defined_SKIP_RET = false;
#endif
#ifdef SKIP_GLA
constexpr bool defined_SKIP_GLA = true;
#else
constexpr bool defined_SKIP_GLA = false;
#endif
#ifdef SKIP_S5
constexpr bool defined_SKIP_S5 = true;
#else
constexpr bool defined_SKIP_S5 = false;
#endif
#ifdef SKIP_LN1
constexpr bool defined_SKIP_LN1 = true;
#else
constexpr bool defined_SKIP_LN1 = false;
#endif
#ifdef SKIP_P0
constexpr bool defined_SKIP_P0 = true;
#else
constexpr bool defined_SKIP_P0 = false;
#endif
#ifndef PHMASK
#define PHMASK 0xffff
#endif
#define PHE(b) (((PHMASK) >> (b)) & 1)
#define GAS __attribute__((address_space(1)))
#define LAS __attribute__((address_space(3)))
typedef unsigned short bf16;
typedef short bf16x8 __attribute__((ext_vector_type(8)));
typedef float f32x4 __attribute__((ext_vector_type(4)));
typedef float f32x2 __attribute__((ext_vector_type(2)));
typedef unsigned u32x4 __attribute__((ext_vector_type(4)));
typedef unsigned u32x2 __attribute__((ext_vector_type(2)));

constexpr int BATCH = 2, T = 8192, D = 1024, M = BATCH * T;
constexpr int NEXP = 32, TOPK = 4, DFF = 1024, CAP = M;
constexpr int NWAVES = 8, NTHREADS = 512;
constexpr float LN_EPS = 1e-5f;
constexpr float ALPHA = 1.681792830507429f;
constexpr int MAXTILES = (M * TOPK) / 256 + NEXP;

constexpr size_t MiB = 1u << 20;
constexpr size_t WS_CTL = 0, CTL_ZERO_BYTES = 1 * MiB;
constexpr size_t WS_WT_ML_IN = 1 * MiB;
constexpr size_t WS_WT_ML_OUT = WS_WT_ML_IN + 6 * MiB;
constexpr size_t WS_WT_RET_IN = WS_WT_ML_OUT + 2 * MiB;
constexpr size_t WS_WT_RET_OUT = WS_WT_RET_IN + 12 * MiB;
constexpr size_t WS_WT_GLA_IN = WS_WT_RET_OUT + 4 * MiB;
constexpr size_t WS_WT_GLA_OUT = WS_WT_GLA_IN + 6 * MiB;
constexpr size_t WS_WT_S5_IN = WS_WT_GLA_OUT + 2 * MiB;
constexpr size_t WS_WT_S5_GLU = WS_WT_S5_IN + 2 * MiB;
constexpr size_t WS_WT_S5_OUT = WS_WT_S5_GLU + 2 * MiB;
constexpr size_t WS_S5TAB = WS_WT_S5_OUT + 2 * MiB;
constexpr size_t WS_GB = WS_S5TAB + 1 * MiB;
constexpr size_t WS_LIST = WS_GB + 1 * MiB;
constexpr size_t WS_GW = WS_LIST + 2 * MiB;
constexpr size_t WS_WT_GU = WS_GW + 1 * MiB;
constexpr size_t WS_WT_DN = WS_WT_GU + 512 * MiB;
constexpr size_t WS_HF = WS_WT_DN + 256 * MiB;
constexpr size_t WS_XB = WS_HF + 64 * MiB;
constexpr size_t WS_ZF = WS_XB + 32 * MiB;
constexpr size_t WS_PB = WS_ZF + 64 * MiB;
constexpr size_t WS_LA = WS_PB + 192 * MiB;
constexpr size_t WS_ORAW = WS_LA + 32 * MiB;
constexpr size_t WS_YB = WS_ORAW + 128 * MiB;
constexpr size_t WS_ACT = WS_YB + 64 * MiB;
constexpr size_t WS_YS = WS_ACT + 144 * MiB;
constexpr size_t WS_XG = WS_YS + 256 * MiB;
constexpr size_t WS_UT = WS_XG + 1024 * MiB;
constexpr size_t WS_ST = WS_UT + 128 * MiB;
constexpr size_t WS_KPP = WS_ST + 64 * MiB;
constexpr size_t WS_SC = WS_KPP + 16 * MiB;
constexpr size_t WS_S5KT = WS_SC + 4 * MiB;
constexpr size_t WS_S5VT = WS_S5KT + 2 * MiB;
constexpr size_t WS_S5WT = WS_S5VT + 16 * MiB;
constexpr size_t WS_S5L64 = WS_S5WT + 16 * MiB;
constexpr size_t WS_S5SL = WS_S5L64 + 1 * MiB;
constexpr size_t WS_S5SP = WS_S5SL + 16 * MiB;
constexpr size_t WS_CS = WS_S5SP + 8 * MiB;
constexpr size_t WS_END = WS_CS + 4 * MiB;
constexpr int CW_BAR = 4096;
constexpr int CW_CNT = 16384;

constexpr int PH_BYTES = 139264;
constexpr int TAB_OFF = PH_BYTES;
constexpr int MISC_OFF = TAB_OFF + 16384;
constexpr int LDS_BYTES = 159744;

typedef __bf16 bf16x2_t __attribute__((ext_vector_type(2)));
__device__ __forceinline__ unsigned pk2(float lo, float hi) { const f32x2 v = {lo, hi}; const bf16x2_t b = __builtin_convertvector(v, bf16x2_t); return __builtin_bit_cast(unsigned, b); }
__device__ __forceinline__ unsigned f2bf(float f) { return pk2(f, 0.f) & 0xffffu; }
__device__ __forceinline__ float bf2f(unsigned short b) { return __builtin_bit_cast(float, ((unsigned)b) << 16); }
__device__ __forceinline__ float bflo(unsigned w) { return __builtin_bit_cast(float, w << 16); }
__device__ __forceinline__ float bfhi(unsigned w) { return __builtin_bit_cast(float, w & 0xffff0000u); }
__device__ __forceinline__ int lane_id() { int l; asm volatile("v_mbcnt_lo_u32_b32 %0, -1, 0\n\tv_mbcnt_hi_u32_b32 %0, -1, %0" : "=v"(l)); return l; }
template <int CTRL> __device__ __forceinline__ float dpp_f(float v) { return __builtin_bit_cast(float, __builtin_amdgcn_update_dpp(0, __builtin_bit_cast(int, v), CTRL, 0xf, 0xf, false)); }
__device__ __forceinline__ float rl_f(float v, int l) { return __builtin_bit_cast(float, __builtin_amdgcn_readlane(__builtin_bit_cast(int, v), l)); }
__device__ __forceinline__ float wave_sum(float v) {
    v += dpp_f<0xB1>(v);
    v += dpp_f<0x4E>(v);
    v += dpp_f<0x141>(v);
    v += dpp_f<0x140>(v);
    return (rl_f(v, 0) + rl_f(v, 16)) + (rl_f(v, 32) + rl_f(v, 48));
}
__device__ __forceinline__ float row16_sum(float v) { v += dpp_f<0xB1>(v); v += dpp_f<0x4E>(v); v += dpp_f<0x141>(v); v += dpp_f<0x140>(v); return v; }
__device__ __forceinline__ float wave_max(float v) {
    v = fmaxf(v, dpp_f<0xB1>(v)); v = fmaxf(v, dpp_f<0x4E>(v)); v = fmaxf(v, dpp_f<0x141>(v)); v = fmaxf(v, dpp_f<0x140>(v));
    return fmaxf(fmaxf(rl_f(v, 0), rl_f(v, 16)), fmaxf(rl_f(v, 32), rl_f(v, 48)));
}
__device__ __forceinline__ float sigmoidf_(float x) { return __builtin_amdgcn_rcpf(1.f + __expf(-x)); }
__device__ __forceinline__ float log_sigmoidf_(float x) { return fminf(x, 0.f) - __logf(1.f + __expf(-fabsf(x))); }
__device__ __forceinline__ float gelu_tanh(float x) { const float u = 0.7978845608028654f * (x + 0.044715f * x * x * x); return x * sigmoidf_(2.f * u); }

namespace pg8 {
constexpr int BM = 256, BK = 64, HALF = 128, HTB = HALF * BK * 2, STAGE_BYTES = 8 * HTB, NXCD = 8, WGM = 8;
__host__ __device__ __forceinline__ int lds_byte(int r, int c) { const int st = (r >> 4) * 2 + (c >> 5), rr = r & 15, cc = c & 31, ob = rr * 64 + cc * 2; return st * 1024 + (ob ^ (((ob >> 9) & 1) << 5)); }
__host__ __device__ __forceinline__ void stage_rc(int b, int& R, int& C) { const int st = b / 1024, sb = b % 1024, swz = sb ^ (((sb >> 9) & 1) << 5); R = (st >> 1) * 16 + swz / 64; C = (st & 1) * 32 + (swz % 64) / 2; }
__host__ __device__ __forceinline__ int perm32(int rho) { const int n = rho >> 4, i = rho & 15; return 8 * (i >> 2) + 4 * n + (i & 3); }

struct Unit { const char* A; const char* B; int pm, pn, e, nvalid, r0, buf; };

__device__ __forceinline__ int xcd_remap(int L, int nwg) { const int q = nwg / NXCD, r = nwg % NXCD, xcd = L % NXCD, off = L / NXCD; return (xcd < r ? xcd * (q + 1) : r * (q + 1) + (xcd - r) * q) + off; }

struct DenseOrder {
    const char* A; const char* Bt; int K, nM, nN, nwg, G, c; const int* list; const float* gwl; static constexpr int a_compact = 0;
    __device__ __forceinline__ void init(const void* A_, const void* Bt_, int M_, int N_, int K_, int G_, int c_) { A = (const char*)A_; Bt = (const char*)Bt_; K = K_; nM = M_ / BM; nN = N_ / BM; nwg = nM * nN; G = G_; c = c_; list = nullptr; gwl = nullptr; }
    __device__ __forceinline__ bool next(int i, Unit& u) const {
        const long L = (long)i * G + c; if (L >= nwg) return false;
        const int wgid = xcd_remap((int)L, nwg);
        const int nig = WGM * nN, gid = wgid / nig, fm = gid * WGM, gsz = (nM - fm) < WGM ? (nM - fm) : WGM;
        u.pm = fm + ((wgid % nig) % gsz); u.pn = (wgid % nig) / gsz; u.e = 0; u.nvalid = 256; u.r0 = 0;
        u.A = A + (size_t)u.pm * 256 * K * 2; u.B = Bt + (size_t)u.pn * 256 * K * 2; return true;
    }
};
struct MoeOrder {
    const char* A; const char* Bt; const LAS int* tab;
    int K, nN, ntiles, nwg, G, c; size_t b_estride; int a_compact; const int* list; const float* gwl;
    __device__ __forceinline__ bool next(int i, Unit& u) const {
        const long L = (long)i * G + c; if (L >= nwg) return false;
        const int wgid = xcd_remap((int)L, nwg);
        const int nig = WGM * nN, gid = wgid / nig, fm = gid * WGM, gsz = (ntiles - fm) < WGM ? (ntiles - fm) : WGM;
        const int tl = fm + ((wgid % nig) % gsz); u.pm = tl; u.pn = (wgid % nig) / gsz;
        const int e = __builtin_amdgcn_readfirstlane(tab[72 + tl]); u.e = e; const int r0 = (tl - __builtin_amdgcn_readfirstlane(tab[32 + e])) * 256; const int rem = __builtin_amdgcn_readfirstlane(tab[e]) - r0; u.nvalid = rem < 256 ? rem : 256; u.r0 = r0;
        u.A = (a_compact == 2) ? A : a_compact ? A + (size_t)tl * 256 * K * 2 : A + ((size_t)e * CAP + r0) * K * 2;
        u.B = Bt + (size_t)e * b_estride + (size_t)u.pn * 256 * K * 2; return true;
    }
};

__device__ __forceinline__ unsigned cvt_pk_bf16(float lo, float hi) { unsigned r; asm volatile("v_cvt_pk_bf16_f32 %0, %1, %2" : "=v"(r) : "v"(lo), "v"(hi)); return r; }

struct EpiBf16 {
    static constexpr bool BIASTAB = false; static constexpr bool ROWINFO = false; static constexpr bool PERM = true;
    bf16* O; int ldc; const float* cs; int rot_tiles;
    __device__ __forceinline__ void operator()(const f32x4 (&acc)[2][2][4][2], const Unit& u, int wr, int wc, int fr, int fq) const {
        const int row0 = u.pm * BM + wr * 64 + fr, col0 = u.pn * BM + wc * 32 + 8 * fq;
        const bool rot = u.pn < rot_tiles; const float sc = (col0 >= 1024) ? 0.08838834764831845f : 1.f;
#pragma unroll
        for (int ai = 0; ai < 2; ++ai)
#pragma unroll
            for (int m = 0; m < 4; ++m) { const int row = row0 + ai * HALF + m * 16; bf16* rowp = O + (size_t)row * ldc + col0;
#pragma unroll
                for (int bj = 0; bj < 2; ++bj) { f32x4 v0 = acc[ai][bj][m][0], v1 = acc[ai][bj][m][1];
                    if (rot) { const float* cp = cs + ((size_t)(row & (T - 1)) * 64 + (((col0 + bj * HALF) & 127) >> 1)) * 2; const f32x4 c0 = *(const f32x4*)cp, c1 = *(const f32x4*)(cp + 4);
                        const f32x4 a0 = v0, a1 = v1;
                        v0[0] = (a0[0] * c0[0] - a0[1] * c0[1]) * sc; v0[1] = (a0[0] * c0[1] + a0[1] * c0[0]) * sc; v0[2] = (a0[2] * c0[2] - a0[3] * c0[3]) * sc; v0[3] = (a0[2] * c0[3] + a0[3] * c0[2]) * sc;
                        v1[0] = (a1[0] * c1[0] - a1[1] * c1[1]) * sc; v1[1] = (a1[0] * c1[1] + a1[1] * c1[0]) * sc; v1[2] = (a1[2] * c1[2] - a1[3] * c1[3]) * sc; v1[3] = (a1[2] * c1[3] + a1[3] * c1[2]) * sc; }
                    u32x4 w; w.x = cvt_pk_bf16(v0[0], v0[1]); w.y = cvt_pk_bf16(v0[2], v0[3]); w.z = cvt_pk_bf16(v1[0], v1[1]); w.w = cvt_pk_bf16(v1[2], v1[3]);
                    *(u32x4*)(rowp + bj * HALF) = w; } }
    }
};
struct EpiResid {
    static constexpr bool BIASTAB = false; static constexpr bool ROWINFO = false; static constexpr bool PERM = true;
    const float* __restrict__ hin; const bf16* __restrict__ hinb; bf16* __restrict__ Z;
    __device__ __forceinline__ void operator()(const f32x4 (&acc)[2][2][4][2], const Unit& u, int wr, int wc, int fr, int fq) const {
        const int row0 = u.pm * BM + wr * 64 + fr, col0 = u.pn * BM + wc * 32 + 8 * fq;
#pragma unroll
        for (int ai = 0; ai < 2; ++ai)
#pragma unroll
            for (int m = 0; m < 4; ++m) { const size_t off = (size_t)(row0 + ai * HALF + m * 16) * D + col0;
                f32x4 hv[2][2];
                if (hinb) {
#pragma unroll
                    for (int bj = 0; bj < 2; ++bj) { const u32x4 hw = *(const u32x4*)(hinb + off + bj * HALF);
                        hv[bj][0] = (f32x4){bflo(hw.x), bfhi(hw.x), bflo(hw.y), bfhi(hw.y)}; hv[bj][1] = (f32x4){bflo(hw.z), bfhi(hw.z), bflo(hw.w), bfhi(hw.w)}; }
                } else {
#pragma unroll
                    for (int bj = 0; bj < 2; ++bj)
#pragma unroll
                        for (int n = 0; n < 2; ++n) hv[bj][n] = *(const f32x4*)(hin + off + bj * HALF + n * 4);
                }
#pragma unroll
                for (int bj = 0; bj < 2; ++bj) { const f32x4 v0 = hv[bj][0] * ALPHA + acc[ai][bj][m][0], v1 = hv[bj][1] * ALPHA + acc[ai][bj][m][1];
                    u32x4 w; w.x = cvt_pk_bf16(v0[0], v0[1]); w.y = cvt_pk_bf16(v0[2], v0[3]); w.z = cvt_pk_bf16(v1[0], v1[1]); w.w = cvt_pk_bf16(v1[2], v1[3]);
                    *(u32x4*)(Z + off + bj * HALF) = w; } }
    }
};
struct EpiGlu {
    static constexpr bool BIASTAB = false; static constexpr bool ROWINFO = false; static constexpr bool PERM = true;
    const bf16* Y; const float* bias; bf16* O;
    __device__ __forceinline__ void operator()(const f32x4 (&acc)[2][2][4][2], const Unit& u, int wr, int wc, int fr, int fq) const {
        const int row0 = u.pm * BM + wr * 64 + fr, col0 = u.pn * BM + wc * 32 + 8 * fq;
#pragma unroll
        for (int ai = 0; ai < 2; ++ai)
#pragma unroll
            for (int m = 0; m < 4; ++m) { const size_t off = (size_t)(row0 + ai * HALF + m * 16) * D + col0;
#pragma unroll
                for (int bj = 0; bj < 2; ++bj) {
                    const f32x4 b0 = *(const f32x4*)(bias + col0 + bj * HALF), b1 = *(const f32x4*)(bias + col0 + bj * HALF + 4);
                    const u32x4 yw = *(const u32x4*)(Y + off + bj * HALF);
                    const f32x4 v0 = acc[ai][bj][m][0] + b0, v1 = acc[ai][bj][m][1] + b1;
                    float o[8];
                    o[0] = bflo(yw.x) * sigmoidf_(v0[0]); o[1] = bfhi(yw.x) * sigmoidf_(v0[1]); o[2] = bflo(yw.y) * sigmoidf_(v0[2]); o[3] = bfhi(yw.y) * sigmoidf_(v0[3]);
                    o[4] = bflo(yw.z) * sigmoidf_(v1[0]); o[5] = bfhi(yw.z) * sigmoidf_(v1[1]); o[6] = bflo(yw.w) * sigmoidf_(v1[2]); o[7] = bfhi(yw.w) * sigmoidf_(v1[3]);
                    u32x4 w; w.x = cvt_pk_bf16(o[0], o[1]); w.y = cvt_pk_bf16(o[2], o[3]); w.z = cvt_pk_bf16(o[4], o[5]); w.w = cvt_pk_bf16(o[6], o[7]);
                    *(u32x4*)(O + off + bj * HALF) = w; } }
    }
};
struct EpiSwiglu {
    static constexpr bool BIASTAB = true; static constexpr bool ROWINFO = false; static constexpr bool PERM = true;
    bf16* ACT; const float* bgu; const LAS float* btab;
    __device__ __forceinline__ float bias_at(const Unit& u, int j) const { return bgu[(size_t)u.e * 2 * DFF + (j < HALF ? 0 : DFF) + u.pn * HALF + (j & (HALF - 1))]; }
    __device__ __forceinline__ void operator()(const f32x4 (&acc)[2][2][4][2], const Unit& u, int wr, int wc, int fr, int fq) const {
        const int row0 = u.pm * BM + wr * 64 + fr, j0 = u.pn * HALF + wc * 32 + 8 * fq;
        const LAS float* bt = btab + u.buf * 256 + wc * 32 + 8 * fq;
        const f32x4 g0 = *(const LAS f32x4*)(bt), g1 = *(const LAS f32x4*)(bt + 4), u0 = *(const LAS f32x4*)(bt + HALF), u1 = *(const LAS f32x4*)(bt + HALF + 4);
#pragma unroll
        for (int ai = 0; ai < 2; ++ai)
#pragma unroll
            for (int m = 0; m < 4; ++m) {
                float o[8];
#pragma unroll
                for (int n = 0; n < 2; ++n)
#pragma unroll
                    for (int i = 0; i < 4; ++i) {
                        float g = acc[ai][0][m][n][i] + (n ? g1[i] : g0[i]), up = acc[ai][1][m][n][i] + (n ? u1[i] : u0[i]);
                        g = fminf(g, 7.0f); up = fminf(fmaxf(up, -7.0f), 7.0f);
                        o[n * 4 + i] = (up + 1.0f) * g * sigmoidf_(1.702f * g); }
                u32x4 w; w.x = cvt_pk_bf16(o[0], o[1]); w.y = cvt_pk_bf16(o[2], o[3]); w.z = cvt_pk_bf16(o[4], o[5]); w.w = cvt_pk_bf16(o[6], o[7]);
                *(u32x4*)(ACT + (size_t)(row0 + ai * HALF + m * 16) * DFF + j0) = w; }
    }
};
struct EpiMoeDown {
    static constexpr bool BIASTAB = true; static constexpr bool ROWINFO = true; static constexpr bool PERM = true;
    bf16* YS; const float* bd; const LAS int* rinfo; const LAS float* btab;
    __device__ __forceinline__ float bias_at(const Unit& u, int j) const { return bd[(size_t)u.e * D + u.pn * BM + j]; }
    __device__ __forceinline__ void operator()(const f32x4 (&acc)[2][2][4][2], const Unit& u, int wr, int wc, int fr, int fq) const {
        const int col0 = u.pn * BM + wc * 32 + 8 * fq;
        const LAS float* bt = btab + u.buf * 256 + wc * 32 + 8 * fq;
        f32x4 bv[2][2];
#pragma unroll
        for (int bj = 0; bj < 2; ++bj)
#pragma unroll
            for (int n = 0; n < 2; ++n) bv[bj][n] = *(const LAS f32x4*)(bt + bj * HALF + 4 * n);
        const LAS int* ri = rinfo + u.buf * 512;
#pragma unroll
        for (int ai = 0; ai < 2; ++ai)
#pragma unroll
            for (int m = 0; m < 4; ++m) { const int r = ai * HALF + wr * 64 + m * 16 + fr; const int slot = ri[r];
                if (slot >= 0) { const float gg = __builtin_bit_cast(float, ri[256 + r]); bf16* op = YS + (size_t)slot * D + col0;
#pragma unroll
                    for (int bj = 0; bj < 2; ++bj) { const f32x4 v0 = (acc[ai][bj][m][0] + bv[bj][0]) * gg, v1 = (acc[ai][bj][m][1] + bv[bj][1]) * gg;
                        u32x4 w; w.x = cvt_pk_bf16(v0[0], v0[1]); w.y = cvt_pk_bf16(v0[2], v0[3]); w.z = cvt_pk_bf16(v1[0], v1[1]); w.w = cvt_pk_bf16(v1[2], v1[3]);
                        *(u32x4*)(op + bj * HALF) = w; } } }
    }
};

template <class Epi, class Sched, bool ALIGN_EPI, bool SP2, bool GATHER = false>
__device__ __forceinline__ void gemm_phase(LAS unsigned char* lds, const int wid, const int K, const Sched& S, const Epi& E, LAS int* rowtab = nullptr) {
    const int lane = lane_id(), tid = wid * 64 + lane, wr = wid >> 2, wc = wid & 3, fr = lane & 15, fq = lane >> 4;
    const int nt = K / BK;
    unsigned voffA[2], voffB[2]; int Rr[2]; unsigned Cc2[2];
#pragma unroll
    for (int i = 0; i < 2; ++i) { int R, C; stage_rc(tid * 16 + i * 8192, R, C); const int Rb = Epi::PERM ? ((R & ~31) + perm32(R & 31)) : R;
        voffA[i] = (unsigned)(R * K + C) * 2u; voffB[i] = (unsigned)(Rb * K + C) * 2u; Rr[i] = R; Cc2[i] = (unsigned)C * 2u; }
    unsigned vA[2][2] = {{0u, 0u}, {0u, 0u}}, vN[2][2] = {{0u, 0u}, {0u, 0u}};
    const size_t kstep = (size_t)(BK * 2);
    const size_t hstep = (size_t)HALF * K * 2;
    const unsigned ldsw = (unsigned)wid * 1024u;
    const int aoff = lds_byte(wr * 64 + fr, fq * 8), boff = lds_byte(wc * 32 + fr, fq * 8);
#define PG8_SA(b, h) (((b) * 2 + (h)) * HTB)
#define PG8_SB(b, h) ((4 + (b) * 2 + (h)) * HTB)
#define PG8_STAGE(bufoff, gbase, voff) do { _Pragma("unroll") for (int _i = 0; _i < 2; ++_i) \
        __builtin_amdgcn_global_load_lds((const unsigned*)((const char*)(gbase) + (voff)[_i]), (LAS unsigned*)(lds + (bufoff) + ldsw + _i * 8192), 16, 0, 0); } while (0)
#define PG8_STAGE_A(bufoff, kbase, h, VO) do { if constexpr (GATHER) { PG8_STAGE(bufoff, kbase, (VO)[h]); } else { PG8_STAGE(bufoff, (kbase) + (h) * hstep, voffA); } } while (0)
#define PG8_FILL(buf, U) do { if (tid < 256) { const bool ok_ = tid < (U).nvalid; const int ent_ = (ok_ && (S.a_compact == 2 || Epi::ROWINFO)) ? S.list[(size_t)(U).e * CAP + (U).r0 + tid] : 0; \
        rowtab[(buf) * 256 + tid] = (S.a_compact == 2) ? (ent_ >> 2) * (K * 2) : tid * (K * 2); \
        if constexpr (Epi::ROWINFO) { rowtab[768 + (buf) * 512 + tid] = ok_ ? ent_ : -1; rowtab[768 + (buf) * 512 + 256 + tid] = ok_ ? __builtin_bit_cast(int, S.gwl[(size_t)(U).e * CAP + (U).r0 + tid]) : 0; } } \
        if constexpr (Epi::BIASTAB) { if (tid >= 256) rowtab[2304 + (buf) * 256 + (tid - 256)] = __builtin_bit_cast(int, E.bias_at((U), tid - 256)); } } while (0)
#define PG8_LOADVO(VO, buf) do { _Pragma("unroll") for (int h_ = 0; h_ < 2; ++h_) _Pragma("unroll") for (int i_ = 0; i_ < 2; ++i_) (VO)[h_][i_] = (unsigned)rowtab[(buf) * 256 + h_ * 128 + Rr[i_]] + Cc2[i_]; } while (0)
#define PG8_LDA(dst, b, h) do { _Pragma("unroll") for (int m = 0; m < 4; ++m) _Pragma("unroll") for (int k = 0; k < 2; ++k) dst[m][k] = *(const LAS bf16x8*)(lds + PG8_SA(b, h) + aoff + m * 2048 + k * 1024); } while (0)
#define PG8_LDB(dst, b, h) do { _Pragma("unroll") for (int n = 0; n < 2; ++n) _Pragma("unroll") for (int k = 0; k < 2; ++k) dst[n][k] = *(const LAS bf16x8*)(lds + PG8_SB(b, h) + boff + n * 2048 + k * 1024); } while (0)
#define PG8_MMA(ai, bj, At, Bt) do { __builtin_amdgcn_s_setprio(1); _Pragma("unroll") for (int m = 0; m < 4; ++m) _Pragma("unroll") for (int n = 0; n < 2; ++n) _Pragma("unroll") for (int k = 0; k < 2; ++k) \
        acc[ai][bj][m][n] = __builtin_amdgcn_mfma_f32_16x16x32_bf16(Bt[n][k], At[m][k], acc[ai][bj][m][n], 0, 0, 0); __builtin_amdgcn_s_setprio(0); } while (0)
#define PG8_WAIT_V(n) asm volatile("s_waitcnt vmcnt(" #n ")" ::: "memory")
#define PG8_WAIT_L(n) asm volatile("s_waitcnt lgkmcnt(" #n ")" ::: "memory")
#define PG8_BAR __builtin_amdgcn_s_barrier()
#define PG8_SCHED __builtin_amdgcn_sched_barrier(0)
#define VO_a1 vA
#define VO_cA vA
#define VO_a2 vS
#define VO_a3 vS
    Unit cur, nxt; int ui = 0;
    if (!S.next(0, cur)) return;
    f32x4 acc[2][2][4][2];
#pragma unroll
    for (int a = 0; a < 2; ++a)
#pragma unroll
        for (int b = 0; b < 2; ++b)
#pragma unroll
            for (int m = 0; m < 4; ++m)
#pragma unroll
                for (int n = 0; n < 2; ++n) acc[a][b][m][n] = (f32x4){0.f, 0.f, 0.f, 0.f};
    bf16x8 At[4][2], B0[2][2], B1[2][2];
    const char* cA = cur.A; const char* cB = cur.B;
    cur.buf = 0;
    if constexpr (GATHER) { PG8_FILL(0, cur); asm volatile("s_waitcnt lgkmcnt(0)" ::: "memory"); PG8_BAR; asm volatile("" ::: "memory"); PG8_LOADVO(vA, 0); }
    if constexpr (SP2) {
        PG8_STAGE(PG8_SB(0, 0), cB, voffB); PG8_STAGE(PG8_SB(0, 1), cB + hstep, voffB); PG8_STAGE_A(PG8_SA(0, 0), cA, 0, VO_cA); PG8_STAGE_A(PG8_SA(0, 1), cA, 1, VO_cA);
        if (wr == 1) PG8_BAR;
        PG8_WAIT_V(2); PG8_BAR;
        PG8_STAGE(PG8_SB(1, 0), cB + kstep, voffB); PG8_STAGE_A(PG8_SA(1, 0), cA + kstep, 0, VO_cA); PG8_STAGE(PG8_SB(1, 1), cB + hstep + kstep, voffB);
        PG8_WAIT_V(6); PG8_BAR;
    } else {
        PG8_STAGE(PG8_SB(0, 0), cB, voffB); PG8_STAGE_A(PG8_SA(0, 0), cA, 0, VO_cA); PG8_STAGE(PG8_SB(0, 1), cB + hstep, voffB); PG8_STAGE_A(PG8_SA(0, 1), cA, 1, VO_cA);
        if (wr == 1) PG8_BAR;
        PG8_WAIT_V(4); PG8_BAR;
        PG8_STAGE(PG8_SB(1, 0), cB + kstep, voffB); PG8_STAGE_A(PG8_SA(1, 0), cA + kstep, 0, VO_cA); PG8_STAGE(PG8_SB(1, 1), cB + hstep + kstep, voffB);
        PG8_WAIT_V(6); PG8_BAR;
    }
    for (;;) {
        const bool has_next = S.next(ui + 1, nxt);
        const char* nA = has_next ? nxt.A : cA; const char* nB = has_next ? nxt.B : cB;
        nxt.buf = (ui + 1) % 3;
        if constexpr (GATHER) { if (has_next) PG8_FILL((ui + 1) % 3, nxt); }
        for (int t = 0; t < nt; t += 2) {
            const bool last = (t == nt - 2);
            const char* a1 = cA + (size_t)(t + 1) * kstep;
            const char* a2 = last ? nA : cA + (size_t)(t + 2) * kstep; const char* b2 = last ? nB : cB + (size_t)(t + 2) * kstep;
            const char* a3 = a2 + kstep; const char* b3 = b2 + kstep;
            unsigned vS[2][2];
            if constexpr (GATHER) { if (last && has_next) PG8_LOADVO(vN, (ui + 1) % 3);
#pragma unroll
                for (int h_ = 0; h_ < 2; ++h_)
#pragma unroll
                    for (int i_ = 0; i_ < 2; ++i_) vS[h_][i_] = (last && has_next) ? vN[h_][i_] : vA[h_][i_]; }
            else { vS[0][0] = 0u; vS[0][1] = 0u; vS[1][0] = 0u; vS[1][1] = 0u; }
            if constexpr (SP2) {
            PG8_LDB(B0, 0, 0); PG8_LDB(B1, 0, 1); PG8_SCHED; PG8_LDA(At, 0, 0); PG8_STAGE_A(PG8_SA(1, 1), a1, 1, VO_a1);
            PG8_WAIT_V(8); PG8_WAIT_L(0); PG8_BAR; PG8_MMA(0, 0, At, B0); PG8_MMA(0, 1, At, B1); PG8_BAR; PG8_SCHED;
            PG8_LDA(At, 0, 1); PG8_STAGE(PG8_SB(0, 0), b2, voffB); PG8_STAGE(PG8_SB(0, 1), b2 + hstep, voffB); PG8_STAGE_A(PG8_SA(0, 0), a2, 0, VO_a2);
            PG8_WAIT_V(8); PG8_WAIT_L(0); PG8_BAR; PG8_MMA(1, 0, At, B0); PG8_MMA(1, 1, At, B1); PG8_BAR; PG8_SCHED;
            PG8_LDB(B0, 1, 0); PG8_LDB(B1, 1, 1); PG8_SCHED; PG8_LDA(At, 1, 0); PG8_STAGE_A(PG8_SA(0, 1), a2, 1, VO_a2);
            PG8_WAIT_V(8); PG8_WAIT_L(0); PG8_BAR; PG8_MMA(0, 0, At, B0); PG8_MMA(0, 1, At, B1); PG8_BAR; PG8_SCHED;
            PG8_LDA(At, 1, 1); PG8_STAGE(PG8_SB(1, 0), b3, voffB); PG8_STAGE(PG8_SB(1, 1), b3 + hstep, voffB); PG8_STAGE_A(PG8_SA(1, 0), a3, 0, VO_a3);
            PG8_WAIT_V(8); PG8_WAIT_L(0); PG8_BAR; PG8_MMA(1, 0, At, B0); PG8_MMA(1, 1, At, B1); PG8_BAR; PG8_SCHED;
            } else {
            PG8_LDB(B0, 0, 0); PG8_SCHED; PG8_LDA(At, 0, 0); PG8_STAGE_A(PG8_SA(1, 1), a1, 1, VO_a1);
            PG8_WAIT_L(8); PG8_BAR; PG8_WAIT_L(0); PG8_MMA(0, 0, At, B0); PG8_BAR; PG8_SCHED;
            PG8_LDB(B1, 0, 1); PG8_STAGE(PG8_SB(0, 0), b2, voffB);
            PG8_BAR; PG8_WAIT_L(0); PG8_MMA(0, 1, At, B1); PG8_BAR;
            PG8_LDA(At, 0, 1); PG8_STAGE_A(PG8_SA(0, 0), a2, 0, VO_a2);
            PG8_BAR; PG8_WAIT_L(0); PG8_MMA(1, 0, At, B0); PG8_BAR; PG8_SCHED;
            PG8_STAGE(PG8_SB(0, 1), b2 + hstep, voffB);
            PG8_WAIT_V(6); PG8_BAR; PG8_MMA(1, 1, At, B1); PG8_BAR;
            PG8_LDB(B0, 1, 0); PG8_SCHED; PG8_LDA(At, 1, 0); PG8_STAGE_A(PG8_SA(0, 1), a2, 1, VO_a2);
            PG8_WAIT_L(8); PG8_BAR; PG8_WAIT_L(0); PG8_MMA(0, 0, At, B0); PG8_BAR; PG8_SCHED;
            PG8_LDB(B1, 1, 1); PG8_STAGE(PG8_SB(1, 0), b3, voffB);
            PG8_BAR; PG8_WAIT_L(0); PG8_MMA(0, 1, At, B1); PG8_BAR;
            PG8_LDA(At, 1, 1); PG8_STAGE_A(PG8_SA(1, 0), a3, 0, VO_a3);
            PG8_BAR; PG8_WAIT_L(0); PG8_MMA(1, 0, At, B0); PG8_BAR; PG8_SCHED;
            PG8_STAGE(PG8_SB(1, 1), b3 + hstep, voffB);
            PG8_WAIT_V(6); PG8_BAR; PG8_MMA(1, 1, At, B1); PG8_BAR;
            }
        }
        if constexpr (ALIGN_EPI) { if (wr == 0) PG8_BAR; }
        E(acc, cur, wr, wc, fr, fq);
        if (!has_next) break;
#pragma unroll
        for (int a = 0; a < 2; ++a)
#pragma unroll
            for (int b = 0; b < 2; ++b)
#pragma unroll
                for (int m = 0; m < 4; ++m)
#pragma unroll
                    for (int n = 0; n < 2; ++n) acc[a][b][m][n] = (f32x4){0.f, 0.f, 0.f, 0.f};
        cur = nxt; cA = nA; cB = nB; ++ui;
        if constexpr (GATHER) { vA[0][0] = vN[0][0]; vA[0][1] = vN[0][1]; vA[1][0] = vN[1][0]; vA[1][1] = vN[1][1]; }
        if constexpr (ALIGN_EPI) { if (wr == 1) PG8_BAR; }
    }
    PG8_WAIT_V(0);
    if constexpr (!ALIGN_EPI) { if (wr == 0) PG8_BAR; }
    PG8_BAR;
#undef PG8_SA
#undef PG8_SB
#undef PG8_STAGE
#undef PG8_STAGE_A
#undef PG8_FILL
#undef PG8_LOADVO
#undef VO_a1
#undef VO_cA
#undef VO_a2
#undef VO_a3
#undef PG8_LDA
#undef PG8_LDB
#undef PG8_MMA
#undef PG8_WAIT_V
#undef PG8_WAIT_L
#undef PG8_BAR
#undef PG8_SCHED
}
}

#define XB_TMO      128
#define XB_XCNT(j)  (256  + 64 * (j))
#define XB_XSUB(j)  (1280 + 64 * (j))
#define XB_XGEN(j)  (2304 + 64 * (j))
#define XB_TOP      3328
#define XB_TOPGEN   3392
#define XCD_BAR_WORDS 3456
#define XB_SPIN_CAP (1u << 18)
__device__ __forceinline__ unsigned xb_ld(unsigned* p)              { return __hip_atomic_load(p, __ATOMIC_RELAXED, __HIP_MEMORY_SCOPE_AGENT); }
__device__ __forceinline__ unsigned xb_add(unsigned* p, unsigned v) { return __hip_atomic_fetch_add(p, v, __ATOMIC_RELAXED, __HIP_MEMORY_SCOPE_AGENT); }
__device__ __forceinline__ unsigned xb_xcc_id() { return (unsigned)__builtin_amdgcn_s_getreg((3 << 11) | 20) & 0xFu; }
#define XB_SPIN(cond, bar) do { unsigned _sp = 0; while (cond) { __builtin_amdgcn_s_sleep(1); \
    if ((++_sp & 255u) == 0u) { if (xb_ld(&(bar)[XB_TMO])) break; if (_sp > XB_SPIN_CAP) { atomicAdd(&(bar)[XB_TMO], 1u); break; } } } } while (0)
struct XcdBarrier { unsigned* bar; unsigned x; volatile LAS unsigned* st; };
__device__ __forceinline__ XcdBarrier xcd_barrier_post(unsigned* bar, volatile LAS unsigned* st, bool leader) {
    XcdBarrier b; b.bar = bar; b.x = xb_xcc_id(); b.st = st;
    if (leader) (void)xb_add(&bar[XB_XCNT(b.x)], 1u);
    return b;
}
__device__ __forceinline__ void xcd_barrier_complete(unsigned* bar, unsigned x, unsigned& nloc, unsigned& nx) {
    const unsigned G = gridDim.x * gridDim.y * gridDim.z;
    unsigned sum, cnt, mine, sp = 0u;
    for (;;) {
        sum = 0u; cnt = 0u; mine = 0u;
#pragma unroll
        for (unsigned j = 0; j < 16; ++j) { const unsigned c = xb_ld(&bar[XB_XCNT(j)]); sum += c; cnt += (c > 0u) ? 1u : 0u; mine = (j == x) ? c : mine; }
        if (sum == G) break;
        __builtin_amdgcn_s_sleep(1);
        if ((++sp & 255u) == 0u) { if (xb_ld(&bar[XB_TMO])) break; if (sp > XB_SPIN_CAP) { atomicAdd(&bar[XB_TMO], 1u); break; } }
    }
    nloc = mine > 0u ? mine : 1u; nx = cnt > 0u ? cnt : 1u;
}
__device__ __forceinline__ void xcd_barrier(const XcdBarrier& b, int wave) {
    asm volatile("s_waitcnt vmcnt(0)" ::: "memory");
    __syncthreads();
    if (wave == 0 && lane_id() == 0) {
        unsigned* bar = b.bar;
        __builtin_amdgcn_s_waitcnt(0);
        unsigned nloc = b.st[0], nx = b.st[1];
        if (nloc == 0u) { xcd_barrier_complete(bar, b.x, nloc, nx); b.st[0] = nloc; b.st[1] = nx; }
        const unsigned old = xb_add(&bar[XB_XSUB(b.x)], 1u);
        const unsigned gen = old / nloc;
        if (old + 1u == (gen + 1u) * nloc) {
            __builtin_amdgcn_fence(__ATOMIC_RELEASE, "agent");
            asm volatile("s_waitcnt vmcnt(0)" ::: "memory");
            const unsigned og = xb_add(&bar[XB_TOP], 1u);
            const unsigned tg = og / nx;
            if (og + 1u == (tg + 1u) * nx) xb_add(&bar[XB_TOPGEN], 1u);
            else XB_SPIN(xb_ld(&bar[XB_TOPGEN]) == tg, bar);
            __builtin_amdgcn_fence(__ATOMIC_ACQUIRE, "agent");
            xb_add(&bar[XB_XGEN(b.x)], 1u);
            asm volatile("s_waitcnt vmcnt(0)" ::: "memory");
        } else {
            XB_SPIN(xb_ld(&bar[XB_XGEN(b.x)]) == gen, bar);
            __builtin_amdgcn_fence(__ATOMIC_ACQUIRE, "agent");
            asm volatile("s_waitcnt vmcnt(0)" ::: "memory");
        }
    }
    __syncthreads();
}

struct Args { const float* in[33]; float* out; unsigned char* ws; int ph_lo, ph_hi; };
struct Frame {
    LAS unsigned char* lds;
    int wave, vcu, G, gw, NGW;
};

__device__ __forceinline__ void transpose_item(const float* W, int ldw, int col_off, int K, bf16* WT, int mode, int kb, int nb, LAS unsigned char* scr, int lane) {
    const int k0 = 64 * kb, n0 = 64 * nb;
    const float* src = W + (size_t)k0 * ldw + col_off + n0;
    f32x4 v[16];
#pragma unroll
    for (int i = 0; i < 16; ++i) v[i] = __builtin_nontemporal_load((const f32x4*)(src + (size_t)((lane >> 4) + 4 * i) * ldw + 4 * (lane & 15)));
#pragma unroll
    for (int i = 0; i < 16; ++i) { LAS unsigned* p = (LAS unsigned*)(scr + ((lane >> 4) + 4 * i) * 132 + 8 * (lane & 15)); p[0] = pk2(v[i][0], v[i][1]); p[1] = pk2(v[i][2], v[i][3]); }
    asm volatile("s_waitcnt lgkmcnt(0)" ::: "memory");
    const int c = lane >> 3, nl = lane & 7;
#pragma unroll
    for (int r = 0; r < 8; ++r) { const int n = nl + 8 * r; const LAS unsigned short* s = (const LAS unsigned short*)(scr + (8 * c) * 132 + 2 * n);
        u32x4 o; o.x = (unsigned)s[0] | ((unsigned)s[66] << 16); o.y = (unsigned)s[132] | ((unsigned)s[198] << 16); o.z = (unsigned)s[264] | ((unsigned)s[330] << 16); o.w = (unsigned)s[396] | ((unsigned)s[462] << 16);
        const int ng = n0 + n; int drow = ng; if (mode == 1) { drow = ng < 1024 ? 256 * (ng >> 7) + (ng & 127) : 256 * ((ng - 1024) >> 7) + 128 + (ng & 127); }
        if (mode == 2 && ng < 2048) { const int i_ = ng & 127; drow = (ng & ~127) + (i_ < 64 ? 2 * i_ : 2 * (i_ - 64) + 1); }
        __builtin_nontemporal_store(o, (u32x4*)(WT + (size_t)drow * K + k0 + 8 * c)); }
    asm volatile("s_waitcnt lgkmcnt(0)" ::: "memory");
}

__device__ __forceinline__ void load_cols16(int tid, const float* W, int ldw, int col_off, LAS float* Wt) {
    f32x4 wv[8];
#pragma unroll
    for (int i = 0; i < 8; ++i) { const int q = tid + i * NTHREADS, k = q >> 2, e0 = (q & 3) * 4; wv[i] = *(const f32x4*)(W + (size_t)k * ldw + col_off + e0); }
#pragma unroll
    for (int i = 0; i < 8; ++i) { const int q = tid + i * NTHREADS, k = q >> 2, e0 = (q & 3) * 4;
        Wt[(e0 + 0) * 1028 + k] = wv[i][0]; Wt[(e0 + 1) * 1028 + k] = wv[i][1]; Wt[(e0 + 2) * 1028 + k] = wv[i][2]; Wt[(e0 + 3) * 1028 + k] = wv[i][3]; }
}
__device__ __forceinline__ float row_dot16(const f32x4 (&v)[4], const LAS float* Wt, int lane) {
    float p[16];
#pragma unroll
    for (int e = 0; e < 16; ++e) { float s = 0.f;
#pragma unroll
        for (int j = 0; j < 4; ++j) { const f32x4 w = *(const LAS f32x4*)(Wt + e * 1028 + 4 * (lane + 64 * j)); s += v[j][0] * w[0] + v[j][1] * w[1] + v[j][2] * w[2] + v[j][3] * w[3]; }
        p[e] = s; }
    float a8[8], a4[4], a2[2], r1;
#pragma unroll
    for (int e = 0; e < 8; ++e) { const auto r = __builtin_amdgcn_permlane32_swap(__builtin_bit_cast(unsigned, p[e]), __builtin_bit_cast(unsigned, p[e + 8]), false, false); a8[e] = __builtin_bit_cast(float, (unsigned)r[0]) + __builtin_bit_cast(float, (unsigned)r[1]); }
#pragma unroll
    for (int e = 0; e < 4; ++e) { const auto r = __builtin_amdgcn_permlane16_swap(__builtin_bit_cast(unsigned, a8[e]), __builtin_bit_cast(unsigned, a8[e + 4]), false, false); a4[e] = __builtin_bit_cast(float, (unsigned)r[0]) + __builtin_bit_cast(float, (unsigned)r[1]); }
    { const bool hi = (lane & 8) != 0;
#pragma unroll
      for (int e = 0; e < 2; ++e) { const float mine = hi ? a4[e + 2] : a4[e], theirs = hi ? a4[e] : a4[e + 2]; a2[e] = mine + dpp_f<0x128>(theirs); } }
    { const bool hi = (lane & 4) != 0; const float mine = hi ? a2[1] : a2[0], theirs = hi ? a2[0] : a2[1]; r1 = mine + dpp_f<0x141>(theirs); }
    r1 += dpp_f<0x4E>(r1); r1 += dpp_f<0xB1>(r1);
    return r1;
}
__device__ __forceinline__ void store_row_bf16(bf16* orow, const f32x4 (&v)[4], int lane) {
    unsigned long long* o8 = (unsigned long long*)orow + lane;
#pragma unroll
    for (int j = 0; j < 4; ++j) o8[64 * j] = (unsigned long long)pk2(v[j][0], v[j][1]) | ((unsigned long long)pk2(v[j][2], v[j][3]) << 32);
}
__device__ __forceinline__ void store_row_f32(float* orow, const f32x4 (&v)[4], int lane) {
    f32x4* o = (f32x4*)orow + lane;
#pragma unroll
    for (int j = 0; j < 4; ++j) o[64 * j] = v[j];
}
__device__ __forceinline__ void load_row_f32(const float* row, f32x4 (&v)[4], int lane) {
    const f32x4* p = (const f32x4*)row + lane;
#pragma unroll
    for (int j = 0; j < 4; ++j) v[j] = p[64 * j];
}
__device__ __forceinline__ void ln_row(f32x4 (&v)[4], const f32x4 (&gv)[4], const f32x4 (&bv)[4]) {
    float s = 0.f;
#pragma unroll
    for (int j = 0; j < 4; ++j) s += (v[j][0] + v[j][1]) + (v[j][2] + v[j][3]);
    const float mean = wave_sum(s) * (1.f / D); float s2 = 0.f;
#pragma unroll
    for (int j = 0; j < 4; ++j) { v[j] = v[j] - mean; s2 += (v[j][0] * v[j][0] + v[j][1] * v[j][1]) + (v[j][2] * v[j][2] + v[j][3] * v[j][3]); }
    const float rstd = __builtin_amdgcn_rsqf(wave_sum(s2) * (1.f / D) + LN_EPS);
#pragma unroll
    for (int j = 0; j < 4; ++j) v[j] = v[j] * rstd * gv[j] + bv[j];
}

__device__ __forceinline__ const float* inp_ptr(LAS unsigned char* lds, int i) {
    const LAS unsigned* p = (const LAS unsigned*)(lds + MISC_OFF + 256) + 2 * i;
    const unsigned lo = __builtin_amdgcn_readfirstlane(p[0]), hi = __builtin_amdgcn_readfirstlane(p[1]);
    return (const float*)(const GAS float*)(((unsigned long long)hi << 32) | lo);
}

__device__ __forceinline__ void stamp_fn(LAS unsigned char* lds, int wave, int k) {
    if (blockIdx.x == 0 && wave == 0 && lane_id() == 0) { volatile LAS unsigned long long* st = (volatile LAS unsigned long long*)(lds + MISC_OFF + 1024);
        const unsigned long long now = __builtin_amdgcn_s_memrealtime(); if (k >= PROBE_T && k <= PROBE_T2) st[1] = st[1] + (now - st[0]); st[0] = now; }
}
typedef short s16x4 __attribute__((ext_vector_type(4)));
typedef short v4i16_t __attribute__((ext_vector_type(4)));
constexpr int CL = 128, NCH = T / CL;
template <int MODE> struct MX;
template <> struct MX<0> { static constexpr int NH = 8, DK = 64,  DV = 128, LDP = 3072, KOFF = 512,  VOFF = 1024, GOFF = 2048; };
template <> struct MX<1> { static constexpr int NH = 8, DK = 128, DV = 256, LDP = 6144, KOFF = 1024, VOFF = 2048, GOFF = 4096; };
template <> struct MX<2> { static constexpr int NH = 4, DK = 128, DV = 256, LDP = 3072, KOFF = 512,  VOFF = 1024, GOFF = 2048; };
__device__ __forceinline__ s16x4 ds_tr(const LAS unsigned char* p) { return __builtin_bit_cast(s16x4, __builtin_amdgcn_ds_read_tr16_b64_v4i16((LAS v4i16_t*)p)); }
__device__ __forceinline__ bf16x8 tr_frag(const LAS unsigned char* base, int pitch, int k0, int n0, int lane) {
    const int g = lane >> 4, q = (lane & 15) >> 2, p = lane & 3;
    const LAS unsigned char* a = base + (k0 + 4 * g + q) * pitch + (n0 + 4 * p) * 2;
    const s16x4 r1 = ds_tr(a), r2 = ds_tr(a + 16 * pitch);
    bf16x8 f; f[0] = r1[0]; f[1] = r1[1]; f[2] = r1[2]; f[3] = r1[3]; f[4] = r2[0]; f[5] = r2[1]; f[6] = r2[2]; f[7] = r2[3]; return f;
}
__device__ __forceinline__ u32x4 scale_bf16x8(u32x4 v, float sc) {
    u32x4 o; o.x = pk2(bflo(v.x) * sc, bfhi(v.x) * sc); o.y = pk2(bflo(v.y) * sc, bfhi(v.y) * sc); o.z = pk2(bflo(v.z) * sc, bfhi(v.z) * sc); o.w = pk2(bflo(v.w) * sc, bfhi(v.w) * sc); return o;
}
__device__ __forceinline__ float ret_lg2gamma(int h) { return log2f(1.f - exp2f(-5.f - (float)h)); }

template <int MODE>
__device__ __forceinline__ void mix_phaseA(const Frame& F, unsigned char* ws, const int tid, const int lane) {
    typedef MX<MODE> C; constexpr int DK = C::DK, DV = C::DV, NH = C::NH, LDP = C::LDP, KP = DK * 2 + 32, VP = DV * 2 + 32, ETW = DV / 128, NDT = DK / 16;
    LAS unsigned char* ldsK = F.lds; LAS unsigned char* ldsV = F.lds + 128 * KP; LAS float* rsc = (LAS float*)(F.lds + 128 * KP + 128 * VP);
    const bf16* PB = (const bf16*)(ws + WS_PB); const bf16* KPP = (const bf16*)(ws + WS_KPP); bf16* UT = (bf16*)(ws + WS_UT);
    const float* GSC = (const float*)(ws + WS_SC); float* NLOC = (float*)(ws + WS_SC + 2 * MiB);
    const float* LAp = (const float*)(ws + WS_LA); float* DECp = (float*)(ws + WS_SC + 3 * MiB);
    const int w = F.wave, g = lane >> 4;
    constexpr int NUA = 2 * NH * NCH;
    u32x4 kr[DK / 32], vr[DV / 32]; f32x2 cs[16]; unsigned qv[16], kv[16]; float gsr[DK / 32]; float gmax = 0.f;
#define PA_LOAD(U_) do { const int c_ = (U_) % NCH, bh_ = (U_) / NCH, h_ = bh_ % NH, b_ = bh_ / NH; const size_t row0_ = (size_t)b_ * T + (size_t)c_ * CL; \
        if (MODE == 2) { const size_t gr0_ = row0_ + 16 * w; const int gch_ = h_ * 128 + 2 * lane; \
            _Pragma("unroll") for (int i = 0; i < 16; ++i) { cs[i] = *(const f32x2*)(LAp + (gr0_ + i) * 512 + gch_); qv[i] = *(const unsigned*)(PB + (gr0_ + i) * 3072 + gch_); kv[i] = *(const unsigned*)(PB + (gr0_ + i) * 3072 + 512 + gch_); } \
        } else { \
            _Pragma("unroll") for (int i = 0; i < DK / 32; ++i) { const int p = tid + i * NTHREADS, r = p / (DK / 8), cp = p % (DK / 8); \
                kr[i] = *(const u32x4*)(PB + (row0_ + r) * LDP + C::KOFF + h_ * DK + cp * 8); \
                if (MODE == 0) gsr[i] = GSC[(size_t)(1 * 16 + bh_) * T + c_ * CL + r]; } \
        } \
        _Pragma("unroll") for (int i = 0; i < DV / 32; ++i) { const int p = tid + i * NTHREADS, r = p / (DV / 8), cp = p % (DV / 8); \
            vr[i] = *(const u32x4*)(PB + (row0_ + r) * LDP + C::VOFF + h_ * DV + cp * 8); } \
        if (MODE == 0) gmax = GSC[(size_t)(2 * 16 + bh_) * T + c_ * CL + 127]; } while (0)
    if (MODE != 2 && (int)blockIdx.x < NUA) PA_LOAD((int)blockIdx.x);
    for (int u = blockIdx.x; u < NUA; u += F.G) {
        const int c = u % NCH, bh = u / NCH, h = bh % NH, b = bh / NH; const size_t row0 = (size_t)b * T + (size_t)c * CL;
        const size_t gr0 = row0 + 16 * w; const int gch = h * 128 + 2 * lane;
        const float lgh = (MODE == 1) ? ret_lg2gamma(h) : 0.f;
        if (MODE == 2) PA_LOAD(u);
        __syncthreads();
        if (MODE == 2) {
            LAS float* tot = rsc;
#pragma unroll
            for (int i = 1; i < 16; ++i) cs[i] += cs[i - 1];
            *(LAS f32x2*)(tot + w * 128 + 2 * lane) = cs[15];
            __syncthreads();
            f32x2 pre = (f32x2){0.f, 0.f}, bend = (f32x2){0.f, 0.f};
#pragma unroll
            for (int w2 = 0; w2 < NWAVES; ++w2) { const f32x2 tw = *(const LAS f32x2*)(tot + w2 * 128 + 2 * lane); bend += tw; if (w2 < w) pre += tw; }
            bf16* PBw = (bf16*)(ws + WS_PB);
#pragma unroll
            for (int i = 0; i < 16; ++i) { const float b0 = pre[0] + cs[i][0], b1 = pre[1] + cs[i][1];
                const float q0 = bflo(qv[i]), q1 = bfhi(qv[i]), k0 = bflo(kv[i]) * 0.08838834764831845f, k1 = bfhi(kv[i]) * 0.08838834764831845f;
                *(unsigned*)(PBw + (gr0 + i) * 3072 + gch) = pk2(q0 * __expf(b0), q1 * __expf(b1));
                *(unsigned*)(PBw + (gr0 + i) * 3072 + 512 + gch) = pk2(k0 * __expf(-b0), k1 * __expf(-b1));
                *(LAS unsigned*)(ldsK + (16 * w + i) * KP + lane * 4) = pk2(k0 * __expf(bend[0] - b0), k1 * __expf(bend[1] - b1)); }
            if (w == 0) *(f32x2*)(DECp + (size_t)(b * NCH + c) * 512 + gch) = (f32x2){__expf(bend[0]), __expf(bend[1])};
        } else {
#pragma unroll
            for (int i = 0; i < DK / 32; ++i) { const int p = tid + i * NTHREADS, r = p / (DK / 8), cp = p % (DK / 8);
                u32x4 v = kr[i];
                if (MODE == 0) v = scale_bf16x8(v, __expf(gsr[i] - gmax));
                if (MODE == 1) v = scale_bf16x8(v, exp2f((float)(127 - r) * lgh));
                *(LAS u32x4*)(ldsK + r * KP + cp * 16) = v; }
        }
#pragma unroll
        for (int i = 0; i < DV / 32; ++i) { const int p = tid + i * NTHREADS, r = p / (DV / 8), cp = p % (DV / 8); *(LAS u32x4*)(ldsV + r * VP + cp * 16) = vr[i]; }
        if (MODE != 2 && u + F.G < NUA) PA_LOAD(u + F.G);
        __syncthreads();
        f32x4 acc[ETW][NDT];
#pragma unroll
        for (int i = 0; i < ETW; ++i)
#pragma unroll
            for (int j = 0; j < NDT; ++j) acc[i][j] = (f32x4){0.f, 0.f, 0.f, 0.f};
#pragma unroll
        for (int ks = 0; ks < 4; ++ks) {
            bf16x8 af[ETW], bfv[NDT];
#pragma unroll
            for (int i = 0; i < ETW; ++i) af[i] = tr_frag(ldsV, VP, 32 * ks, (w * ETW + i) * 16, lane);
#pragma unroll
            for (int j = 0; j < NDT; ++j) bfv[j] = tr_frag(ldsK, KP, 32 * ks, j * 16, lane);
#pragma unroll
            for (int i = 0; i < ETW; ++i)
#pragma unroll
                for (int j = 0; j < NDT; ++j) acc[i][j] = __builtin_amdgcn_mfma_f32_16x16x32_bf16(bfv[j], af[i], acc[i][j], 0, 0, 0);
        }
        bf16* ut = UT + (size_t)u * DV * DK;
#pragma unroll
        for (int i = 0; i < ETW; ++i)
#pragma unroll
            for (int j = 0; j < NDT; ++j)
                { uint2 o; o.x = pk2(acc[i][j][0], acc[i][j][1]); o.y = pk2(acc[i][j][2], acc[i][j][3]); *(uint2*)(ut + (size_t)((w * ETW + i) * 16 + (lane & 15)) * DK + j * 16 + 4 * g) = o; }
        if (MODE == 0) {
            float sacc = 0.f;
#pragma unroll
            for (int r = 0; r < 16; ++r) sacc += bf2f(*(const LAS unsigned short*)(ldsK + (16 * w + r) * KP + lane * 2));
            rsc[w * 64 + lane] = sacc;
            __syncthreads();
            if (tid < 64) { float t = 0.f;
#pragma unroll
                for (int q = 0; q < NWAVES; ++q) t += rsc[q * 64 + tid];
                NLOC[(size_t)u * 64 + tid] = t; } }
    }
    __syncthreads();
#undef PA_LOAD
}

template <int MODE>
__device__ __forceinline__ void mix_phaseB(const Frame& F, unsigned char* ws, const int tid) {
    typedef MX<MODE> C; constexpr int DK = C::DK, DV = C::DV, NH = C::NH, NEL = DV * DK, NBH = 2 * NH;
    const bf16* UT = (const bf16*)(ws + WS_UT); bf16* ST = (bf16*)(ws + WS_ST);
    const float* GSC = (const float*)(ws + WS_SC); const float* NLOC = (const float*)(ws + WS_SC + 2 * MiB); float* NPREV = (float*)(ws + WS_SC + 2 * MiB + 256 * 1024);
    float* MPREV = (float*)(ws + WS_SC + 2 * MiB + 512 * 1024); const float* DEC = (const float*)(ws + WS_SC + 3 * MiB);
    const int gtid = blockIdx.x * NTHREADS + tid, nthr = F.G * NTHREADS;
    for (int el4 = gtid; el4 < NBH * NEL / 4; el4 += nthr) {
        const int el = el4 * 4, bh = el / NEL, idx = el - bh * NEL, h = bh % NH, b = bh / NH;
        float S[4]; float m = -1e30f;
#pragma unroll
        for (int q = 0; q < 4; ++q) S[q] = 0.f;
        const float rdec = (MODE == 1) ? exp2f(128.f * ret_lg2gamma(h)) : 1.f;
#pragma unroll 1
        for (int c0 = 0; c0 < NCH; c0 += 16) {
            uint2 uv[16]; float at_[16], gm_[16]; f32x4 dc[16];
#pragma unroll
            for (int i = 0; i < 16; ++i) { uv[i] = *(const uint2*)(UT + (size_t)(bh * NCH + c0 + i) * NEL + idx);
                if (MODE == 0) { at_[i] = GSC[(size_t)(0 * 16 + bh) * T + (c0 + i) * CL + 127]; gm_[i] = GSC[(size_t)(2 * 16 + bh) * T + (c0 + i) * CL + 127]; }
                if (MODE == 2) dc[i] = *(const f32x4*)(DEC + (size_t)(b * NCH + c0 + i) * 512 + h * 128 + (idx & 127)); }
#pragma unroll
            for (int i = 0; i < 16; ++i) { const int c = c0 + i; const size_t u = (size_t)bh * NCH + c;
                uint2 o; o.x = pk2(S[0], S[1]); o.y = pk2(S[2], S[3]);
                *(uint2*)(ST + u * NEL + idx) = o;
                const float u0 = bflo(uv[i].x), u1 = bfhi(uv[i].x), u2 = bflo(uv[i].y), u3 = bfhi(uv[i].y);
                if (MODE == 0) { const float atot = at_[i], mloc = atot + gm_[i];
                    const float mnew = fmaxf(atot + m, mloc), so = __expf(atot + m - mnew), sl = __expf(mloc - mnew);
                    if (idx == 0) MPREV[u] = m;
                    S[0] = so * S[0] + sl * u0; S[1] = so * S[1] + sl * u1; S[2] = so * S[2] + sl * u2; S[3] = so * S[3] + sl * u3; m = mnew; }
                else if (MODE == 1) { S[0] = rdec * S[0] + u0; S[1] = rdec * S[1] + u1; S[2] = rdec * S[2] + u2; S[3] = rdec * S[3] + u3; }
                else { S[0] = dc[i][0] * S[0] + u0; S[1] = dc[i][1] * S[1] + u1; S[2] = dc[i][2] * S[2] + u2; S[3] = dc[i][3] * S[3] + u3; } }
        }
    }
    if (MODE == 0) {
        for (int el = nthr - 1 - gtid; el < NBH * 64; el += nthr) { const int bh = el >> 6, d = el & 63; float S = 0.f, m = -1e30f;
#pragma unroll 1
            for (int c0 = 0; c0 < NCH; c0 += 16) { float at[16], gm[16], nl[16];
#pragma unroll
                for (int i = 0; i < 16; ++i) { const int c = c0 + i; at[i] = GSC[(size_t)(0 * 16 + bh) * T + c * CL + 127]; gm[i] = GSC[(size_t)(2 * 16 + bh) * T + c * CL + 127]; nl[i] = NLOC[((size_t)bh * NCH + c) * 64 + d]; }
#pragma unroll
                for (int i = 0; i < 16; ++i) { const size_t u = (size_t)bh * NCH + c0 + i; const float atot = at[i], mloc = atot + gm[i];
                    const float mnew = fmaxf(atot + m, mloc), so = __expf(atot + m - mnew), sl = __expf(mloc - mnew);
                    NPREV[u * 64 + d] = S; S = so * S + sl * nl[i]; m = mnew; } } }
    }
}

template <int MODE>
__device__ __forceinline__ void mix_phaseC(const Frame& F, unsigned char* ws, const int tid, const int lane, const float* ng) {
    typedef MX<MODE> C; constexpr int DK = C::DK, DV = C::DV, NH = C::NH, LDP = C::LDP, VP = DV * 2 + 32, KP = DK * 2 + 16, SP = DK * 2 + 16, NET = DV / 16, NKS = DK / 32, DVT = NH * DV;
    constexpr int NSP = DV * DK / 8 / NTHREADS;
    LAS unsigned char* ldsV = F.lds; LAS unsigned char* ldsK = F.lds + 128 * VP; LAS unsigned char* ldsS = F.lds;
    LAS float* tabs = (LAS float*)(F.lds + 128 * VP + 128 * KP);
    static_assert(DV * SP <= 128 * VP + 128 * KP, "S^T image fits the stage-1 region");
    const bf16* PB = (const bf16*)(ws + WS_PB); const bf16* ST = (const bf16*)(ws + WS_ST);
    const float* GSC = (const float*)(ws + WS_SC); const float* NPREV = (const float*)(ws + WS_SC + 2 * MiB + 256 * 1024); const float* MPREV = (const float*)(ws + WS_SC + 2 * MiB + 512 * 1024);
    const int w = F.wave, g = lane >> 4, li = lane & 15;
    constexpr int NU = 2 * NH * NCH;
    u32x4 kr[DK / 32], vr[DV / 32], sreg[NSP];
#define PC_LOAD_KV(U_) do { const int c_ = (U_) % NCH, bh_ = (U_) / NCH, h_ = bh_ % NH, b_ = bh_ / NH; const char* pb_ = (const char*)(PB + ((size_t)b_ * T + (size_t)c_ * CL) * LDP); \
        const char* vb_ = pb_ + (C::VOFF + h_ * DV) * 2; const char* kb_ = pb_ + (C::KOFF + h_ * DK) * 2; int t_ = tid; asm volatile("" : "+v"(t_));     \
        _Pragma("unroll") for (int i = 0; i < DV / 32; ++i) { const int p = t_ + i * NTHREADS, r = p / (DV / 8), cp = p % (DV / 8); vr[i] = *(const u32x4*)(vb_ + (unsigned)(r * LDP + cp * 8) * 2u); } \
        _Pragma("unroll") for (int i = 0; i < DK / 32; ++i) { const int p = t_ + i * NTHREADS, r = p / (DK / 8), cp = p % (DK / 8); kr[i] = *(const u32x4*)(kb_ + (unsigned)(r * LDP + cp * 8) * 2u); } } while (0)
#define PC_LOAD_S(U_) do { const bf16* st_ = ST + (size_t)(U_) * DV * DK; _Pragma("unroll") for (int i = 0; i < NSP; ++i) sreg[i] = *(const u32x4*)(st_ + (size_t)(tid + i * NTHREADS) * 8); } while (0)
    if ((int)blockIdx.x < NU) { PC_LOAD_KV((int)blockIdx.x); }
    for (int u = blockIdx.x; u < NU; u += F.G) {
        const int c = u % NCH, bh = u / NCH, h = bh % NH, b = bh / NH; const size_t row0 = (size_t)b * T + (size_t)c * CL;
        const float lg = (MODE == 1) ? ret_lg2gamma(h) : 0.f;
        const int tq = 16 * w + li;
        const bf16* qrow = PB + (row0 + tq) * LDP + h * DK;
        bf16x8 qf[NKS];
#pragma unroll
        for (int ks = 0; ks < NKS; ++ks) qf[ks] = *(const bf16x8*)(qrow + 32 * ks + 8 * g);
        float mp_ = 0.f, ga_ = 0.f, gg_ = 0.f, gc_ = 0.f;
        if (MODE == 0 && tid < 128) { const size_t gi = (size_t)bh * T + c * CL + tid; mp_ = MPREV[u];
            ga_ = GSC[(size_t)(0 * 16) * T + gi]; gg_ = GSC[(size_t)(1 * 16) * T + gi]; gc_ = GSC[(size_t)(2 * 16) * T + gi]; }
        PC_LOAD_S(u);
        __syncthreads();
#pragma unroll
        for (int i = 0; i < DV / 32; ++i) { const int p = tid + i * NTHREADS, r = p / (DV / 8), cp = p % (DV / 8); *(LAS u32x4*)(ldsV + r * VP + cp * 16) = vr[i]; }
#pragma unroll
        for (int i = 0; i < DK / 32; ++i) { const int p = tid + i * NTHREADS, r = p / (DK / 8), cp = p % (DK / 8); *(LAS u32x4*)(ldsK + r * KP + cp * 16) = kr[i]; }
        if (u + F.G < NU) PC_LOAD_KV(u + F.G);
        if (MODE == 0 && tid < 128) { const float mp = mp_, a = ga_, gg = gg_, cm = gc_;
            const float Mt = fmaxf(mp, cm);
            tabs[tid] = gg; tabs[128 + tid] = Mt; tabs[256 + tid] = __expf(mp - Mt) * 0.125f; tabs[384 + tid] = __expf(-(a + Mt)); }
        __syncthreads();
        f32x4 O[NET];
#pragma unroll
        for (int et = 0; et < NET; ++et) O[et] = (f32x4){0.f, 0.f, 0.f, 0.f};
        float den = 0.f;
        const float Mq = (MODE == 0) ? tabs[128 + tq] : 0.f;
        const float qs = (MODE == 0) ? tabs[256 + tq] : (MODE == 1) ? exp2f((float)(tq + 1) * lg) : 1.f;
        const float fin = (MODE == 0) ? tabs[384 + tq] : 1.f;
        for (int jp = 0; jp <= (w >> 1); ++jp) {
            f32x4 p0 = (f32x4){0.f, 0.f, 0.f, 0.f}, p1 = (f32x4){0.f, 0.f, 0.f, 0.f};
            const LAS unsigned char* k0p = ldsK + (32 * jp + li) * KP + 16 * g;
#pragma unroll
            for (int ks = 0; ks < NKS; ++ks) p0 = __builtin_amdgcn_mfma_f32_16x16x32_bf16(*(const LAS bf16x8*)(k0p + 64 * ks), qf[ks], p0, 0, 0, 0);
            if (2 * jp + 1 <= w) {
#pragma unroll
                for (int ks = 0; ks < NKS; ++ks) p1 = __builtin_amdgcn_mfma_f32_16x16x32_bf16(*(const LAS bf16x8*)(k0p + 16 * KP + 64 * ks), qf[ks], p1, 0, 0, 0);
            }
#pragma unroll
            for (int r = 0; r < 4; ++r) {
                const int s0 = 32 * jp + 4 * g + r, s1 = s0 + 16;
                float f0, f1;
                if (MODE == 0) { f0 = __expf(tabs[s0] - Mq) * 0.125f; f1 = __expf(tabs[s1] - Mq) * 0.125f; }
                else if (MODE == 1) { f0 = exp2f((float)(tq - s0) * lg); f1 = exp2f((float)(tq - s1) * lg); }
                else { f0 = 1.f; f1 = 1.f; }
                p0[r] = (s0 <= tq) ? p0[r] * f0 : 0.f; p1[r] = (s1 <= tq) ? p1[r] * f1 : 0.f;
                den += p0[r] + p1[r];
            }
            bf16x8 af; { const unsigned a0 = pk2(p0[0], p0[1]), a1 = pk2(p0[2], p0[3]), a2 = pk2(p1[0], p1[1]), a3 = pk2(p1[2], p1[3]); u32x4 t4; t4.x = a0; t4.y = a1; t4.z = a2; t4.w = a3; af = __builtin_bit_cast(bf16x8, t4); }
#pragma unroll
            for (int et = 0; et < NET; ++et) O[et] = __builtin_amdgcn_mfma_f32_16x16x32_bf16(af, tr_frag(ldsV, VP, 32 * jp, 16 * et, lane), O[et], 0, 0, 0);
        }
        __syncthreads();
#pragma unroll
        for (int i = 0; i < NSP; ++i) { const int p = tid + i * NTHREADS, e = p / (DK / 8), cp = p % (DK / 8); *(LAS u32x4*)(ldsS + e * SP + cp * 16) = sreg[i]; }
        __syncthreads();
        bf16* YBp = (bf16*)(ws + WS_YB);
        const int rr = lane >> 3, pq = lane & 7;
        const bf16* gpr = PB + (row0 + 16 * w + rr) * LDP + C::GOFF + h * DV + pq * 8; bf16* ypr = YBp + (row0 + 16 * w + rr) * DVT + h * DV + pq * 8;
        asm volatile("" : "+v"(gpr), "+v"(ypr));
        u32x4 gvv[2][DV / 64];
#pragma unroll
        for (int hf = 0; hf < 2; ++hf)
#pragma unroll
            for (int it = 0; it < DV / 64; ++it) gvv[hf][it] = *(const u32x4*)(gpr + (size_t)(8 * (it & 1)) * LDP + hf * (DV / 2) + 64 * (it >> 1));
        float dint = 0.f;
#pragma unroll
        for (int ks = 0; ks < NKS; ++ks) {
            bf16x8 aq = qf[ks];
            if (MODE != 2) aq = __builtin_bit_cast(bf16x8, scale_bf16x8(__builtin_bit_cast(u32x4, qf[ks]), qs));
            if (MODE == 0) { const float* np = NPREV + (size_t)u * 64 + 32 * ks + 8 * g; const u32x4 qa = __builtin_bit_cast(u32x4, aq);
                dint += bflo(qa.x) * np[0] + bfhi(qa.x) * np[1] + bflo(qa.y) * np[2] + bfhi(qa.y) * np[3] + bflo(qa.z) * np[4] + bfhi(qa.z) * np[5] + bflo(qa.w) * np[6] + bfhi(qa.w) * np[7]; }
#pragma unroll
            for (int et = 0; et < NET; ++et) O[et] = __builtin_amdgcn_mfma_f32_16x16x32_bf16(aq, *(const LAS bf16x8*)(ldsS + (16 * et + li) * SP + 64 * ks + 16 * g), O[et], 0, 0, 0);
        }
        const float* ngp = ng + h * DV + li; float gnv[NET];
#pragma unroll
        for (int et = 0; et < NET; ++et) gnv[et] = ngp[16 * et];
        float rd[4] = {1.f, 1.f, 1.f, 1.f};
        if (MODE == 0) {
            float dt = den + dint; dt += __shfl_xor(dt, 16); dt += __shfl_xor(dt, 32);
            LAS float* wsc = tabs + 512 + 16 * w;
            if (g == 0) wsc[li] = __builtin_amdgcn_rcpf(fmaxf(fabsf(dt), fin));
            asm volatile("s_waitcnt lgkmcnt(0)" ::: "memory");
#pragma unroll
            for (int r = 0; r < 4; ++r) rd[r] = wsc[4 * g + r];
        }
        float mean[4], rstd[4];
#pragma unroll
        for (int r = 0; r < 4; ++r) { float sacc = 0.f;
#pragma unroll
            for (int et = 0; et < NET; ++et) { O[et][r] *= rd[r]; sacc += O[et][r]; }
            sacc = row16_sum(sacc);
            mean[r] = sacc * (1.f / DV); float q = 0.f;
#pragma unroll
            for (int et = 0; et < NET; ++et) { const float dlt = O[et][r] - mean[r]; q += dlt * dlt; }
            q = row16_sum(q);
            rstd[r] = __builtin_amdgcn_rsqf(q * (1.f / DV) + LN_EPS); }
        constexpr int RPF = DV * 2 + 16, TB = (MODE == 0) ? (128 * VP + 128 * KP + 2560) : DV * SP;
        static_assert(TB + NWAVES * 16 * RPF <= PH_BYTES && TB % 16 == 0, "epilogue tiles fit");
        LAS unsigned char* tw = F.lds + TB + w * (16 * RPF);
#define GATEF(x_) ((MODE == 0) ? sigmoidf_(x_) : (x_) * sigmoidf_(x_))
#pragma unroll
        for (int hf = 0; hf < 2; ++hf) {
#pragma unroll
            for (int e2 = 0; e2 < NET / 2; ++e2) { const int et = hf * (NET / 2) + e2; const float gn = gnv[et];
#pragma unroll
                for (int r = 0; r < 4; ++r) *(LAS float*)(tw + (4 * g + r) * RPF + (16 * e2 + li) * 4) = (O[et][r] - mean[r]) * rstd[r] * gn; }
            asm volatile("s_waitcnt lgkmcnt(0)" ::: "memory");
#pragma unroll
            for (int it = 0; it < DV / 64; ++it) { const int rb = 8 * (it & 1), cb = 64 * (it >> 1);
                const u32x4 gv = gvv[hf][it];
                const LAS float* tp = (const LAS float*)(tw + (rb + rr) * RPF + (cb + pq * 8) * 4);
                const f32x4 n0 = *(const LAS f32x4*)tp, n1 = *(const LAS f32x4*)(tp + 4);
                const float g0 = bflo(gv.x), g1 = bfhi(gv.x), g2 = bflo(gv.y), g3 = bfhi(gv.y), g4 = bflo(gv.z), g5 = bfhi(gv.z), g6 = bflo(gv.w), g7 = bfhi(gv.w);
                u32x4 o; o.x = pk2(GATEF(g0) * n0[0], GATEF(g1) * n0[1]); o.y = pk2(GATEF(g2) * n0[2], GATEF(g3) * n0[3]);
                o.z = pk2(GATEF(g4) * n1[0], GATEF(g5) * n1[1]); o.w = pk2(GATEF(g6) * n1[2], GATEF(g7) * n1[3]);
                *(u32x4*)(ypr + (size_t)rb * DVT + hf * (DV / 2) + cb) = o; }
            asm volatile("s_waitcnt lgkmcnt(0)" ::: "memory");
        }
#undef GATEF
    }
    __syncthreads();
#undef PC_LOAD_KV
#undef PC_LOAD_S
}

constexpr int SLN = 32, NCI = T / SLN, NI = 2 * NCI, NRT = NI / 16, SKK = SLN * 16;
__device__ __forceinline__ void s5_pow(const f32x4 cf, float n, float& pr, float& pi) { const float e = __expf(n * cf[0]); const float a = n * cf[1]; pr = e * __cosf(a); pi = e * __sinf(a); }

__device__ __forceinline__ void s5_tables(const Frame& F, unsigned char* ws, const int tid, const float* lam_re, const float* lam_im, const float* b_re, const float* b_im, const float* c_re, const float* c_im, const float* log_dt) {
    bf16* KT = (bf16*)(ws + WS_S5KT); bf16* VT = (bf16*)(ws + WS_S5VT); bf16* WT = (bf16*)(ws + WS_S5WT); float* L64 = (float*)(ws + WS_S5L64);
    LAS f32x4* CF = (LAS f32x4*)F.lds;
    for (int i = tid; i < 64 * 64; i += NTHREADS) { const int g = i >> 6; const float lr = lam_re[i], li = lam_im[i], dt = expf(log_dt[g]);
        const float er = expf(lr * dt); float sn, cs; sincosf(li * dt, &sn, &cs);
        const float nr = er * cs - 1.f, ni = er * sn, den = lr * lr + li * li;
        CF[i] = (f32x4){lr * dt, li * dt, (nr * lr + ni * li) / den, (ni * lr - nr * li) / den}; }
    __syncthreads();
    const int gt = blockIdx.x * NTHREADS + tid, nthr = F.G * NTHREADS;
    LAS float* BR = (LAS float*)(F.lds + 65536); LAS float* BI = BR + 1024; LAS float* CR = BI + 1024; LAS float* CI = CR + 1024;
    for (int i0 = blockIdx.x * NTHREADS; i0 < 64 * SLN * 16 * 4; i0 += nthr) {
        const int g = i0 / (64 * SLN);
        __syncthreads();
        for (int q = tid; q < 1024; q += NTHREADS) { BR[q] = b_re[(size_t)g * 1024 + q]; BI[q] = b_im[(size_t)g * 1024 + q]; CR[q] = c_re[(size_t)g * 1024 + q]; CI[q] = c_im[(size_t)g * 1024 + q]; }
        __syncthreads();
        const int i4 = i0 + tid, pq = i4 & 3, idx = i4 >> 2, h = idx & 15, tau = (idx >> 4) % SLN;
        float acc[16];
#pragma unroll
        for (int q = 0; q < 16; ++q) acc[q] = 0.f;
#pragma unroll 4
        for (int p = pq * 16; p < pq * 16 + 16; ++p) { const f32x4 cf = CF[g * 64 + p]; float pr, pi; s5_pow(cf, (float)tau, pr, pi);
            const float cr = CR[h * 64 + p], ci = CI[h * 64 + p];
            const float xr = cr * pr - ci * pi, xi = cr * pi + ci * pr;
            const float yr = xr * cf[2] - xi * cf[3], yi = xr * cf[3] + xi * cf[2];
            const LAS f32x4* br4 = (const LAS f32x4*)(BR + p * 16); const LAS f32x4* bi4 = (const LAS f32x4*)(BI + p * 16);
#pragma unroll
            for (int q = 0; q < 4; ++q) { const f32x4 b_r = br4[q], b_i = bi4[q];
#pragma unroll
                for (int z = 0; z < 4; ++z) acc[4 * q + z] += yr * b_r[z] - yi * b_i[z]; } }
#pragma unroll
        for (int q = 0; q < 16; ++q) { acc[q] += dpp_f<0xB1>(acc[q]); acc[q] += dpp_f<0x4E>(acc[q]); }
        if (pq == 0) { u32x4 o0, o1; o0.x = pk2(acc[0], acc[1]); o0.y = pk2(acc[2], acc[3]); o0.z = pk2(acc[4], acc[5]); o0.w = pk2(acc[6], acc[7]);
            o1.x = pk2(acc[8], acc[9]); o1.y = pk2(acc[10], acc[11]); o1.z = pk2(acc[12], acc[13]); o1.w = pk2(acc[14], acc[15]);
            *(u32x4*)(KT + (size_t)idx * 16) = o0; *(u32x4*)(KT + (size_t)idx * 16 + 8) = o1; } }
    for (int idx = gt; idx < 64 * 64 * SLN; idx += nthr) {
        const int j = idx % SLN, p = (idx / SLN) & 63, g = idx / (SLN * 64);
        const f32x4 cf = CF[g * 64 + p]; float pr, pi;
        s5_pow(cf, (float)(SLN - 1 - j), pr, pi);
        const float yr = pr * cf[2] - pi * cf[3], yi = pr * cf[3] + pi * cf[2];
        const float* br = b_re + (size_t)(g * 64 + p) * 16; const float* bi = b_im + (size_t)(g * 64 + p) * 16;
        float vr[16], vi[16];
#pragma unroll
        for (int q = 0; q < 16; ++q) { vr[q] = yr * br[q] - yi * bi[q]; vi[q] = yr * bi[q] + yi * br[q]; }
        bf16* v0 = VT + ((size_t)(g * 128 + 2 * p) * SKK + j * 16);
        u32x4 o; o.x = pk2(vr[0], vr[1]); o.y = pk2(vr[2], vr[3]); o.z = pk2(vr[4], vr[5]); o.w = pk2(vr[6], vr[7]); *(u32x4*)v0 = o;
        o.x = pk2(vr[8], vr[9]); o.y = pk2(vr[10], vr[11]); o.z = pk2(vr[12], vr[13]); o.w = pk2(vr[14], vr[15]); *(u32x4*)(v0 + 8) = o;
        o.x = pk2(vi[0], vi[1]); o.y = pk2(vi[2], vi[3]); o.z = pk2(vi[4], vi[5]); o.w = pk2(vi[6], vi[7]); *(u32x4*)(v0 + SKK) = o;
        o.x = pk2(vi[8], vi[9]); o.y = pk2(vi[10], vi[11]); o.z = pk2(vi[12], vi[13]); o.w = pk2(vi[14], vi[15]); *(u32x4*)(v0 + SKK + 8) = o;
        if (j == 0) { s5_pow(cf, (float)SLN, pr, pi); L64[(g * 64 + p) * 2] = pr; L64[(g * 64 + p) * 2 + 1] = pi; }
    }
    for (int idx = gt; idx < 64 * 64 * SLN; idx += nthr) {
        const int p = idx & 63, l = (idx >> 6) % SLN, g = idx / (SLN * 64);
        const f32x4 cf = CF[g * 64 + p]; float pr, pi; s5_pow(cf, (float)(l + 1), pr, pi);
#pragma unroll
        for (int h = 0; h < 16; ++h) { const float cr = c_re[(g * 16 + h) * 64 + p], ci = c_im[(g * 16 + h) * 64 + p];
            *(unsigned*)(WT + ((size_t)((g * SLN + l) * 16 + h) * 128 + 2 * p)) = pk2(cr * pr - ci * pi, -(cr * pi + ci * pr)); }
    }
    __syncthreads();
}
__device__ __forceinline__ void s5_phaseA(const Frame& F, unsigned char* ws, const int lane) {
    const bf16* PB = (const bf16*)(ws + WS_PB); const bf16* VT = (const bf16*)(ws + WS_S5VT); float* SL = (float*)(ws + WS_S5SL);
    const int gq = lane >> 4, li = lane & 15;
    for (int wu = F.gw; wu < 64 * NRT * 2; wu += F.NGW) {
        const int half = wu & 1, rt = (wu >> 1) % NRT, g = wu / (2 * NRT), b = rt / (NRT / 2), c0 = (rt % (NRT / 2)) * 16;
        f32x4 acc[4];
#pragma unroll
        for (int ct = 0; ct < 4; ++ct) acc[ct] = (f32x4){0.f, 0.f, 0.f, 0.f};
        const bf16* ap = PB + ((size_t)b * T + (size_t)(c0 + li) * SLN + (gq >> 1)) * 1024 + g * 16 + 8 * (gq & 1);
        const bf16* bp = VT + (size_t)(g * 128 + half * 64 + li) * SKK + 8 * gq;
        bf16x8 af[SLN / 2];
#pragma unroll
        for (int ks = 0; ks < SLN / 2; ++ks) af[ks] = *(const bf16x8*)(ap + (size_t)(2 * ks) * 1024);
#pragma unroll
        for (int ks = 0; ks < SLN / 2; ++ks) {
#pragma unroll
            for (int ct = 0; ct < 4; ++ct) acc[ct] = __builtin_amdgcn_mfma_f32_16x16x32_bf16(af[ks], *(const bf16x8*)(bp + (size_t)(16 * ct) * SKK + 32 * ks), acc[ct], 0, 0, 0);
            if ((ks & 3) == 3) asm volatile("" ::: "memory");
        }
#pragma unroll
        for (int ct = 0; ct < 4; ++ct)
#pragma unroll
            for (int r = 0; r < 4; ++r) SL[(size_t)(g * NI + rt * 16 + 4 * gq + r) * 128 + half * 64 + ct * 16 + li] = acc[ct][r];
    }
}
__device__ __forceinline__ void s5_phaseB(const Frame& F, unsigned char* ws, const int tid) {
    static_assert(NCI == 256, "16 groups of 16 chunks");
    const float* SL = (const float*)(ws + WS_S5SL); bf16* SP = (bf16*)(ws + WS_S5SP); const float* L64 = (const float*)(ws + WS_S5L64);
    for (int gt = blockIdx.x * NTHREADS + tid; gt < 2 * 64 * 64 * 16; gt += F.G * NTHREADS) {
        const int grp = gt & 15, p = (gt >> 4) & 63, g = (gt >> 10) & 63, b = gt >> 16;
        const float ar = L64[(g * 64 + p) * 2], ai = L64[(g * 64 + p) * 2 + 1];
        const size_t base = (size_t)(g * NI + b * NCI + grp * 16) * 128 + 2 * p;
        f32x2 x[16];
#pragma unroll
        for (int i = 0; i < 16; ++i) x[i] = *(const f32x2*)(SL + base + (size_t)i * 128);
        float lr[16], li[16], sr = 0.f, si = 0.f;
#pragma unroll
        for (int i = 0; i < 16; ++i) { lr[i] = sr; li[i] = si; const float nr = ar * sr - ai * si + x[i][0], ni = ar * si + ai * sr + x[i][1]; sr = nr; si = ni; }
        float mr = ar, mi = ai;
#pragma unroll
        for (int k = 0; k < 4; ++k) { const float t = mr * mr - mi * mi; mi = 2.f * mr * mi; mr = t; }
#define S5_STEP(CTRL) do { const float tr = __builtin_bit_cast(float, __builtin_amdgcn_update_dpp(0, __builtin_bit_cast(int, sr), CTRL, 0xf, 0xf, true)), ti = __builtin_bit_cast(float, __builtin_amdgcn_update_dpp(0, __builtin_bit_cast(int, si), CTRL, 0xf, 0xf, true)); \
            sr += mr * tr - mi * ti; si += mr * ti + mi * tr; const float t2 = mr * mr - mi * mi; mi = 2.f * mr * mi; mr = t2; } while (0)
        S5_STEP(0x111); S5_STEP(0x112); S5_STEP(0x114); S5_STEP(0x118);
#undef S5_STEP
        const float pr = __builtin_bit_cast(float, __builtin_amdgcn_update_dpp(0, __builtin_bit_cast(int, sr), 0x111, 0xf, 0xf, true)), pi = __builtin_bit_cast(float, __builtin_amdgcn_update_dpp(0, __builtin_bit_cast(int, si), 0x111, 0xf, 0xf, true));
        float qr = 1.f, qi = 0.f;
#pragma unroll
        for (int i = 0; i < 16; ++i) { const float orr = qr * pr - qi * pi + lr[i], oi = qr * pi + qi * pr + li[i];
            *(unsigned*)(SP + base + (size_t)i * 128) = pk2(orr, oi);
            const float t = qr * ar - qi * ai; qi = qr * ai + qi * ar; qr = t; }
    }
}
__device__ __forceinline__ void s5_phaseC(const Frame& F, unsigned char* ws, const int lane, const float* dskip) {
    const bf16* PB = (const bf16*)(ws + WS_PB); const bf16* KT = (const bf16*)(ws + WS_S5KT); const bf16* WT = (const bf16*)(ws + WS_S5WT); const bf16* SP = (const bf16*)(ws + WS_S5SP);
    bf16* YB = (bf16*)(ws + WS_YB);
    const int gq = lane >> 4, li = lane & 15;
#pragma unroll 1
    for (int wu = F.gw; wu < 64 * NRT * 2; wu += F.NGW) {
        const int par = wu & 1, rt = (wu >> 1) % NRT, g = wu / (2 * NRT), b = rt / (NRT / 2), c0 = (rt % (NRT / 2)) * 16;
        bf16x8 af[SLN / 2], sf[4];
        const bf16* ap = PB + ((size_t)b * T + (size_t)(c0 + li) * SLN + (gq >> 1)) * 1024 + g * 16 + 8 * (gq & 1);
#pragma unroll
        for (int ks = 0; ks < SLN / 2; ++ks) af[ks] = *(const bf16x8*)(ap + (size_t)(2 * ks) * 1024);
#pragma unroll
        for (int ks = 0; ks < 4; ++ks) sf[ks] = *(const bf16x8*)(SP + (size_t)(g * NI + rt * 16 + li) * 128 + 32 * ks + 8 * gq);
        const f32x4 dl = *(const f32x4*)(dskip + g * 16 + 4 * gq);
        const bf16* ktp = KT + (size_t)g * SLN * 256 + li * 16 + 8 * (gq & 1);
#pragma unroll
        for (int l2 = 0; l2 < SLN / 2; ++l2) {
            int l = 2 * l2 + par; asm volatile("" : "+v"(l));
            f32x4 acc = (f32x4){0.f, 0.f, 0.f, 0.f};
            const size_t o = ((size_t)b * T + (size_t)(c0 + li) * SLN + l) * 1024 + g * 16 + 4 * gq;
            const uint2 uv = *(const uint2*)(PB + o);
#pragma unroll
            for (int ks = 0; ks <= l2; ++ks) { const int tau = l - 2 * ks - (gq >> 1);
                bf16x8 bfv = *(const bf16x8*)(ktp + (size_t)(tau < 0 ? 0 : tau) * 256);
                if (ks == l2 && tau < 0) bfv = (bf16x8){0, 0, 0, 0, 0, 0, 0, 0};
                acc = __builtin_amdgcn_mfma_f32_16x16x32_bf16(bfv, af[ks], acc, 0, 0, 0); }
            const bf16* wp = WT + (size_t)((g * SLN + l) * 16 + li) * 128 + 8 * gq;
#pragma unroll
            for (int ks = 0; ks < 4; ++ks) acc = __builtin_amdgcn_mfma_f32_16x16x32_bf16(*(const bf16x8*)(wp + 32 * ks), sf[ks], acc, 0, 0, 0);
            { uint2 ov; ov.x = pk2(gelu_tanh(acc[0] + dl[0] * bflo(uv.x)), gelu_tanh(acc[1] + dl[1] * bfhi(uv.x))); ov.y = pk2(gelu_tanh(acc[2] + dl[2] * bflo(uv.y)), gelu_tanh(acc[3] + dl[3] * bfhi(uv.y)));
                *(uint2*)(YB + o) = ov; }
            asm volatile("" ::: "memory");
        }
    }
}

#define IN(k) (lo <= (k) && (k) < hi)
#define SEAM(k) do { if ((k) + 1 < hi) { xcd_barrier(bar, F.wave); if (PROBE_CLS == 10) xcd_barrier(bar, F.wave); if (PROBE_T >= 0) stamp_fn(F.lds, F.wave, (k)); } } while (0)
#define INP(i) inp_ptr(F.lds, (i))
#define x_in INP(0)
#define ln_g INP(1)
#define ln_b INP(2)
#define WS_PTRS \
    float* HF = (float*)(ws + WS_HF); bf16* XB = (bf16*)(ws + WS_XB); bf16* ZF = (bf16*)(ws + WS_ZF); bf16* PB = (bf16*)(ws + WS_PB); \
    float* GB = (float*)(ws + WS_GB); float* LA = (float*)(ws + WS_LA); float* ORAW = (float*)(ws + WS_ORAW); bf16* YB = (bf16*)(ws + WS_YB); \
    bf16* ACT = (bf16*)(ws + WS_ACT); bf16* YS = (bf16*)(ws + WS_YS); bf16* XG = (bf16*)(ws + WS_XG); \
    int* LIST = (int*)(ws + WS_LIST); float* GW = (float*)(ws + WS_ORAW); \
    float* S5LB = (float*)(ws + WS_S5TAB); float* S5BB = (float*)(ws + WS_S5TAB + 32768); \
    (void)HF; (void)XB; (void)ZF; (void)PB; (void)GB; (void)LA; (void)ORAW; (void)YB; (void)ACT; (void)YS; (void)XG; (void)LIST; (void)GW; (void)S5LB; (void)S5BB;

template <int layer>
__device__ __forceinline__ void layer_body(const Frame& F, unsigned char* ws, unsigned* ctl, LAS int* TAB, const XcdBarrier& bar, const int lo, const int hi, float* d_out) {
    WS_PTRS
        const int pb = 1 + layer * 16;
        const float* hin = (layer == 0) ? x_in : HF;
        if (PHE(1) && IN(pb + 0)) {
            const bf16* Wt = (const bf16*)(ws + (layer == 0 ? WS_WT_ML_IN : layer == 1 ? WS_WT_RET_IN : layer == 2 ? WS_WT_GLA_IN : WS_WT_S5_IN));
            const int N = (layer == 0 || layer == 2) ? 3072 : (layer == 1 ? 6144 : 1024);
            pg8::DenseOrder S; S.init(XB, Wt, M, N, D, F.G, (int)blockIdx.x);
            pg8::EpiBf16 E{PB, N, (const float*)(ws + WS_CS), (layer == 1) ? 8 : 0};
            for (int rep_ = 0; rep_ < REPS(2); ++rep_)
            pg8::gemm_phase<pg8::EpiBf16, pg8::DenseOrder, true, true>(F.lds, F.wave, D, S, E);
            if (layer == 0 && CH_ML) {
                const int lane = lane_id(); float* GSC = (float*)(ws + WS_SC);
                for (int wu = F.gw; wu < 16 * NCH; wu += F.NGW) { const int bh = wu / NCH, c = wu % NCH, b = bh >> 3, h = bh & 7;
                    const int t0 = c * CL + 2 * lane; const size_t row = (size_t)b * T + t0;
                    const float lf0 = log_sigmoidf_(GB[row * 16 + 8 + h]), lf1 = log_sigmoidf_(GB[(row + 1) * 16 + 8 + h]);
                    const float sp = lf0 + lf1; float inc = sp;
#pragma unroll
                    for (int d = 1; d < 64; d <<= 1) { const float tv_ = __shfl_up(inc, d); if (lane >= d) inc += tv_; }
                    const float a0 = inc - sp + lf0, a1 = inc;
                    const float g0 = GB[row * 16 + h] - a0, g1 = GB[(row + 1) * 16 + h] - a1;
                    float mx = fmaxf(g0, g1);
#pragma unroll
                    for (int d = 1; d < 64; d <<= 1) { const float tv_ = __shfl_up(mx, d); if (lane >= d) mx = fmaxf(mx, tv_); }
                    float ex = __shfl_up(mx, 1); if (lane == 0) ex = -3.0e38f;
                    const size_t o0 = (size_t)bh * T + t0;
                    *(f32x2*)(GSC + (size_t)(0 * 16) * T + o0) = (f32x2){a0, a1};
                    *(f32x2*)(GSC + (size_t)(1 * 16) * T + o0) = (f32x2){g0, g1};
                    *(f32x2*)(GSC + (size_t)(2 * 16) * T + o0) = (f32x2){fmaxf(ex, g0), mx}; }
            }
            SEAM(pb + 0);
        }
        if (layer == 0) {
            if (CH_ML) {
                if (IN(pb + 2)) { const int lane = lane_id(), tid = F.wave * 64 + lane; for (int rep_ = 0; rep_ < REPS(6); ++rep_) mix_phaseA<0>(F, ws, tid, lane); SEAM(pb + 2); }
                if (IN(pb + 3)) { const int lane = lane_id(), tid = F.wave * 64 + lane; for (int rep_ = 0; rep_ < REPS(7); ++rep_) mix_phaseB<0>(F, ws, tid); SEAM(pb + 3); }
                if (IN(pb + 4)) { const int lane = lane_id(), tid = F.wave * 64 + lane; for (int rep_ = 0; rep_ < REPS(8); ++rep_) mix_phaseC<0>(F, ws, tid, lane, INP(5)); SEAM(pb + 4); }
            }
        } else if (layer == 1) {
            if (CH_RET) {
                if (IN(pb + 2)) { const int lane = lane_id(), tid = F.wave * 64 + lane; for (int rep_ = 0; rep_ < REPS(6); ++rep_) mix_phaseA<1>(F, ws, tid, lane); SEAM(pb + 2); }
                if (IN(pb + 3)) { const int lane = lane_id(), tid = F.wave * 64 + lane; for (int rep_ = 0; rep_ < REPS(7); ++rep_) mix_phaseB<1>(F, ws, tid); SEAM(pb + 3); }
                if (IN(pb + 4)) { const int lane = lane_id(), tid = F.wave * 64 + lane; for (int rep_ = 0; rep_ < REPS(8); ++rep_) mix_phaseC<1>(F, ws, tid, lane, INP(8)); SEAM(pb + 4); }
            }
        } else if (layer == 2) {
            if (CH_GLA) {
                if (IN(pb + 2)) { const int lane = lane_id(), tid = F.wave * 64 + lane; for (int rep_ = 0; rep_ < REPS(6); ++rep_) mix_phaseA<2>(F, ws, tid, lane); SEAM(pb + 2); }
                if (IN(pb + 3)) { const int lane = lane_id(), tid = F.wave * 64 + lane; for (int rep_ = 0; rep_ < REPS(7); ++rep_) mix_phaseB<2>(F, ws, tid); SEAM(pb + 3); }
                if (IN(pb + 4)) { const int lane = lane_id(), tid = F.wave * 64 + lane; for (int rep_ = 0; rep_ < REPS(8); ++rep_) mix_phaseC<2>(F, ws, tid, lane, INP(13)); SEAM(pb + 4); }
            }
        } else {
            if (CH_S5) {
                if (IN(pb + 2)) { const int lane = lane_id(); for (int rep_ = 0; rep_ < REPS(6); ++rep_) s5_phaseA(F, ws, lane); SEAM(pb + 2); }
                if (IN(pb + 3)) { const int lane = lane_id(), tid = F.wave * 64 + lane; for (int rep_ = 0; rep_ < REPS(7); ++rep_) s5_phaseB(F, ws, tid); SEAM(pb + 3); }
                if (IN(pb + 4)) { const int lane = lane_id(); for (int rep_ = 0; rep_ < REPS(8); ++rep_) s5_phaseC(F, ws, lane, INP(22)); SEAM(pb + 4); }
            }
        }
        if (PHE(4) && layer == 3 && IN(pb + 6)) {
            pg8::DenseOrder S; S.init(YB, ws + WS_WT_S5_GLU, M, D, D, F.G, (int)blockIdx.x);
            pg8::EpiGlu E{YB, INP(25), (bf16*)ORAW};
            for (int rep_ = 0; rep_ < REPS(3); ++rep_)
            pg8::gemm_phase<pg8::EpiGlu, pg8::DenseOrder, true, true>(F.lds, F.wave, D, S, E);
            SEAM(pb + 6);
        }
        if (PHE(5) && IN(pb + 7)) {
            const bf16* Wt = (const bf16*)(ws + (layer == 0 ? WS_WT_ML_OUT : layer == 1 ? WS_WT_RET_OUT : layer == 2 ? WS_WT_GLA_OUT : WS_WT_S5_OUT));
            const int Kd = (layer == 1) ? 2048 : 1024;
            const bf16* Ain = (layer == 3) ? (const bf16*)ORAW : YB;
            pg8::DenseOrder S; S.init(Ain, Wt, M, D, Kd, F.G, (int)blockIdx.x);
            pg8::EpiResid E{hin, (layer == 0) ? (const bf16*)nullptr : (const bf16*)XB, ZF};
            for (int rep_ = 0; rep_ < REPS(3); ++rep_)
            pg8::gemm_phase<pg8::EpiResid, pg8::DenseOrder, true, true>(F.lds, F.wave, Kd, S, E);
            SEAM(pb + 7);
        }
        unsigned* cnt = ctl + CW_CNT + layer * 32 * 64;
        if (IN(pb + 8) && !defined_SKIP_LN1) { const int lane = lane_id(), tid = F.wave * 64 + lane; (void)tid;
            LAS float* Wt = (LAS float*)(F.lds);
            { const f32x4* wr4 = (const f32x4*)(INP(27) + (size_t)layer * D * NEXP);
              f32x4 wv[16];
#pragma unroll
              for (int i = 0; i < 16; ++i) wv[i] = wr4[tid + i * NTHREADS];
#pragma unroll
              for (int i = 0; i < 16; ++i) { const int q = tid + i * NTHREADS, k = q >> 3, e0 = (q & 7) * 4;
                  Wt[(e0 + 0) * 1028 + k] = wv[i][0]; Wt[(e0 + 1) * 1028 + k] = wv[i][1]; Wt[(e0 + 2) * 1028 + k] = wv[i][2]; Wt[(e0 + 3) * 1028 + k] = wv[i][3]; } }
            __syncthreads();
            const float* br_ = INP(28) + layer * NEXP;
            const float* lng_ = ln_g + (size_t)(layer * 2 + 0) * D; const float* lnb_ = ln_b + (size_t)(layer * 2 + 0) * D;
          {
            unsigned* cntp = cnt;
            int aE = 0, aRow = -1; float aG = 0.f;
            LAS unsigned* lcnt = (LAS unsigned*)(F.lds + 131584); LAS int* lbase = (LAS int*)(lcnt + 32);
            if (tid < 32) lcnt[tid] = 0u;
            const int ntrip = (M + F.NGW - 1) / F.NGW;
            u32x2 vnext[2][4];
#pragma unroll
            for (int q = 0; q < 2; ++q) { const int r_ = F.gw + q * F.NGW; if (r_ < M) { const u32x2* zp = (const u32x2*)(ZF + (size_t)r_ * D) + lane;
#pragma unroll
                for (int j = 0; j < 4; ++j) vnext[q][j] = zp[64 * j]; } }
            for (int it_ = 0; it_ < ntrip; it_ += 2) { const int row0_ = F.gw + it_ * F.NGW;
                asm volatile("" ::: "memory");
                const bool ok[2] = {row0_ < M, it_ + 1 < ntrip && row0_ + F.NGW < M};
                f32x4 v[2][4];
#pragma unroll
                for (int q = 0; q < 2; ++q)
#pragma unroll
                    for (int j = 0; j < 4; ++j) v[q][j] = (f32x4){bflo(vnext[q][j].x), bfhi(vnext[q][j].x), bflo(vnext[q][j].y), bfhi(vnext[q][j].y)};
#pragma unroll
                for (int q = 0; q < 2; ++q) { const int r_ = row0_ + (2 + q) * F.NGW; if (it_ + 2 + q < ntrip && r_ < M) { const u32x2* zp = (const u32x2*)(ZF + (size_t)r_ * D) + lane;
#pragma unroll
                    for (int j = 0; j < 4; ++j) vnext[q][j] = zp[64 * j]; } }
                { f32x4 gv[4], bv[4]; load_row_f32(lng_, gv, lane); load_row_f32(lnb_, bv, lane); ln_row(v[0], gv, bv); ln_row(v[1], gv, bv); }
                float pz[2][32];
#pragma unroll
                for (int e = 0; e < 32; ++e) { float s0 = 0.f, s1 = 0.f;
#pragma unroll
                    for (int j = 0; j < 4; ++j) { const f32x4 w = *(const LAS f32x4*)(Wt + e * 1028 + 4 * (lane + 64 * j));
                        s0 += v[0][j][0] * w[0] + v[0][j][1] * w[1] + v[0][j][2] * w[2] + v[0][j][3] * w[3]; s1 += v[1][j][0] * w[0] + v[1][j][1] * w[1] + v[1][j][2] * w[2] + v[1][j][3] * w[3]; }
                    pz[0][e] = s0; pz[1][e] = s1; }
                float lgv[2];
#pragma unroll
                for (int q = 0; q < 2; ++q) {
                    float a16[16], a8[8], a4[4], a2[2];
#pragma unroll
                    for (int e = 0; e < 16; ++e) { const auto r = __builtin_amdgcn_permlane32_swap(__builtin_bit_cast(unsigned, pz[q][e]), __builtin_bit_cast(unsigned, pz[q][e + 16]), false, false);
                        a16[e] = __builtin_bit_cast(float, (unsigned)r[0]) + __builtin_bit_cast(float, (unsigned)r[1]); }
#pragma unroll
                    for (int e = 0; e < 8; ++e) { const auto r = __builtin_amdgcn_permlane16_swap(__builtin_bit_cast(unsigned, a16[e]), __builtin_bit_cast(unsigned, a16[e + 8]), false, false);
                        a8[e] = __builtin_bit_cast(float, (unsigned)r[0]) + __builtin_bit_cast(float, (unsigned)r[1]); }
                    { const bool hi = (lane & 8) != 0;
#pragma unroll
                      for (int e = 0; e < 4; ++e) { const float mine = hi ? a8[e + 4] : a8[e], theirs = hi ? a8[e] : a8[e + 4]; a4[e] = mine + dpp_f<0x128>(theirs); } }
                    { const bool hi = (lane & 4) != 0;
#pragma unroll
                      for (int e = 0; e < 2; ++e) { const float mine = hi ? a4[e + 2] : a4[e], theirs = hi ? a4[e] : a4[e + 2]; a2[e] = mine + dpp_f<0x141>(theirs); } }
                    { const bool hi = (lane & 2) != 0; const float mine = hi ? a2[1] : a2[0], theirs = hi ? a2[0] : a2[1]; lgv[q] = mine + dpp_f<0x4E>(theirs); }
                    lgv[q] += dpp_f<0xB1>(lgv[q]);
                    lgv[q] += br_[lane >> 1];
                }
                int te[2][4]; float tv[2][4];
#pragma unroll
                for (int k = 0; k < 4; ++k)
#pragma unroll
                    for (int q = 0; q < 2; ++q) { const float best = wave_max(lgv[q]);
                        const unsigned long long mk = __ballot(lgv[q] == best); const int src = __builtin_amdgcn_readfirstlane((int)__ffsll((long long)mk) - 1);
                        te[q][k] = src >> 1; tv[q][k] = best; if ((lane >> 1) == te[q][k]) lgv[q] = -3.0e38f; }
#pragma unroll
                for (int q = 0; q < 2; ++q) if (ok[q]) { const int row = row0_ + q * F.NGW;
                    const float e0 = 1.f, e1 = __expf(tv[q][1] - tv[q][0]), e2 = __expf(tv[q][2] - tv[q][0]), e3 = __expf(tv[q][3] - tv[q][0]), rs = __builtin_amdgcn_rcpf(e0 + e1 + e2 + e3);
                    const int ri = (it_ + q) & 15;
                    if ((lane >> 2) == ri) { const int k = lane & 3; aE = k == 0 ? te[q][0] : k == 1 ? te[q][1] : k == 2 ? te[q][2] : te[q][3]; aG = (k == 0 ? e0 : k == 1 ? e1 : k == 2 ? e2 : e3) * rs; aRow = row; }
                    store_row_bf16(XB + (size_t)row * D, v[q], lane); }
                if (((it_ + 1) & 15) == 15 || it_ + 2 >= ntrip) {
                    __syncthreads();
                    int lp = 0; if (aRow >= 0) lp = (int)__hip_atomic_fetch_add(lcnt + aE, 1u, __ATOMIC_RELAXED, __HIP_MEMORY_SCOPE_WORKGROUP);
                    __syncthreads();
                    if (tid < 32) { const unsigned n = lcnt[tid]; lbase[tid] = n ? (int)__hip_atomic_fetch_add(cntp + tid * 64, n, __ATOMIC_RELAXED, __HIP_MEMORY_SCOPE_AGENT) : 0; }
                    __syncthreads();
                    if (aRow >= 0) { const int pos = lbase[aE] + lp; LIST[(size_t)aE * CAP + pos] = aRow * 4 + (lane & 3); GW[(size_t)aE * CAP + pos] = aG; }
                    aRow = -1;
                    __syncthreads();
                    if (tid < 32) lcnt[tid] = 0u;
                }
            }
          }
            __syncthreads();
            SEAM(pb + 8);
        }
        if ((PHE(7) || PHE(8)) && (IN(pb + 9) || IN(pb + 10))) { const int lane = lane_id(), tid = F.wave * 64 + lane; (void)tid;
            __syncthreads();
            if (tid < 32) TAB[tid] = (int)__hip_atomic_load(cnt + tid * 64, __ATOMIC_RELAXED, __HIP_MEMORY_SCOPE_AGENT);
            __syncthreads();
            if (tid < 64) {
                const int nt_ = (lane < 32) ? ((TAB[lane] + 255) >> 8) : 0; int inc = nt_;
#pragma unroll
                for (int d = 1; d < 32; d <<= 1) { const int t_ = __shfl_up(inc, d); if (lane >= d) inc += t_; }
                if (lane < 32) TAB[32 + lane] = inc - nt_;
                if (lane == 31) TAB[64] = inc; }
            __syncthreads();
            if (tid < MAXTILES) { int e = 0;
#pragma unroll
                for (int k = 1; k < 32; ++k) e += (TAB[32 + k] <= tid) ? 1 : 0;
                if (tid < TAB[64]) TAB[72 + tid] = e; }
            __syncthreads();
        }
        if (PHE(7) && IN(pb + 9)) {
            pg8::MoeOrder S; S.A = (const char*)XB; S.list = LIST; S.gwl = GW; S.Bt = (const char*)(ws + WS_WT_GU + (size_t)layer * 32 * 2048 * 1024 * 2); S.tab = TAB; S.K = D; S.nN = 8; S.ntiles = __builtin_amdgcn_readfirstlane(TAB[64]); S.nwg = S.ntiles * 8; S.G = F.G; S.c = (int)blockIdx.x;
            S.b_estride = (size_t)2048 * 1024 * 2; S.a_compact = 2;
            pg8::EpiSwiglu E{ACT, INP(30) + (size_t)layer * 32 * 2048, (const LAS float*)(TAB + 2816)};
            for (int rep_ = 0; rep_ < REPS(4); ++rep_)
            pg8::gemm_phase<pg8::EpiSwiglu, pg8::MoeOrder, MOE_ALIGN, true, true>(F.lds, F.wave, D, S, E, TAB + 512);
            SEAM(pb + 9);
        }
        if (PHE(8) && IN(pb + 10)) {
            pg8::MoeOrder S; S.A = (const char*)ACT; S.list = LIST; S.gwl = GW; S.Bt = (const char*)(ws + WS_WT_DN + (size_t)layer * 32 * 1024 * 1024 * 2); S.tab = TAB; S.K = DFF; S.nN = 4; S.ntiles = __builtin_amdgcn_readfirstlane(TAB[64]); S.nwg = S.ntiles * 4; S.G = F.G; S.c = (int)blockIdx.x;
            S.b_estride = (size_t)1024 * 1024 * 2; S.a_compact = 1;
            pg8::EpiMoeDown E{YS, INP(32) + (size_t)layer * 32 * 1024, TAB + 1280, (const LAS float*)(TAB + 2816)};
            for (int rep_ = 0; rep_ < REPS(5); ++rep_)
            pg8::gemm_phase<pg8::EpiMoeDown, pg8::MoeOrder, MOE_ALIGN, true, true>(F.lds, F.wave, DFF, S, E, TAB + 512);
            SEAM(pb + 10);
        }
        if (PHE(9) && IN(pb + 11)) { const int lane = lane_id(), tid = F.wave * 64 + lane; (void)tid;
            LAS float* Wt = (LAS float*)(F.lds);
            if (layer == 1) { load_cols16(tid, INP(10), 3088, 3072, Wt); __syncthreads(); }
            const float* lng_ = ln_g + (size_t)(layer * 2 + 1) * D; const float* lnb_ = ln_b + (size_t)(layer * 2 + 1) * D;
          for (int rep_ = 0; rep_ < REPS(12); ++rep_) {
            float* outp = (PROBE_CLS == 12 && rep_ == 0) ? ORAW : (layer == 3) ? d_out : HF; bf16* XBo = (PROBE_CLS == 12 && rep_ == 0) ? YB : XB;
            f32x4 hn[4]; u32x2 yn[4][4];
#define CMB_LOAD(r_) do { { const u32x2* hp_ = (const u32x2*)(XB + (size_t)(r_) * D) + lane; _Pragma("unroll") for (int j = 0; j < 4; ++j) { const u32x2 hw_ = hp_[64 * j]; hn[j] = (f32x4){bflo(hw_.x), bfhi(hw_.x), bflo(hw_.y), bfhi(hw_.y)}; } } _Pragma("unroll") for (int k = 0; k < 4; ++k) { const u32x2* yp = (const u32x2*)(YS + ((size_t)(r_) * 4 + k) * D) + lane; _Pragma("unroll") for (int j = 0; j < 4; ++j) yn[k][j] = yp[64 * j]; } } while (0)
            if (F.gw < M) CMB_LOAD(F.gw);
            for (int row = F.gw; row < M; row += F.NGW) {
                asm volatile("" ::: "memory");
                f32x4 v[4];
#pragma unroll
                for (int j = 0; j < 4; ++j) v[j] = hn[j] * ALPHA;
#pragma unroll
                for (int k = 0; k < 4; ++k)
#pragma unroll
                    for (int j = 0; j < 4; ++j) { const u32x2 yw = yn[k][j]; v[j][0] += bflo(yw.x); v[j][1] += bfhi(yw.x); v[j][2] += bflo(yw.y); v[j][3] += bfhi(yw.y); }
                if (row + F.NGW < M) CMB_LOAD(row + F.NGW);
                { f32x4 gv[4], bv[4]; load_row_f32(lng_, gv, lane); load_row_f32(lnb_, bv, lane); ln_row(v, gv, bv); }
                if (layer == 3) store_row_f32(outp + (size_t)row * D, v, lane);
                if (layer < 3) store_row_bf16(XBo + (size_t)row * D, v, lane);
                if (layer == 1) {
                    const float zsum = row_dot16(v, Wt, lane);
                    if ((lane & 3) == 0) GB[(size_t)row * 16 + (lane >> 2)] = zsum;
                }
            }
            if (layer == 1) {
                __syncthreads();
                const float* wgp = INP(11); const float bgc = INP(12)[tid];
                float wg[16];
#pragma unroll
                for (int r = 0; r < 16; ++r) wg[r] = wgp[r * 512 + tid];
                for (int row = F.vcu * NWAVES; row < M; row += F.NGW) {
                    f32x4 zv[NWAVES][4];
#pragma unroll
                    for (int w = 0; w < NWAVES; ++w)
#pragma unroll
                        for (int q = 0; q < 4; ++q) zv[w][q] = *(const f32x4*)(GB + (size_t)(row + w) * 16 + 4 * q);
#pragma unroll
                    for (int w = 0; w < NWAVES; ++w) { float sacc = bgc;
#pragma unroll
                        for (int q = 0; q < 4; ++q) sacc += zv[w][q][0] * wg[4 * q] + zv[w][q][1] * wg[4 * q + 1] + zv[w][q][2] * wg[4 * q + 2] + zv[w][q][3] * wg[4 * q + 3];
                        LA[(size_t)(row + w) * 512 + tid] = log_sigmoidf_(sacc) * (1.f / 16.f); }
                }
            }
          }
            __syncthreads();
#undef CMB_LOAD
            if (layer < 3) SEAM(pb + 11);
        }
}
__global__ void __launch_bounds__(NTHREADS, 2) mega_fwd(Args args) {
    extern __shared__ __attribute__((aligned(16))) unsigned char lds_raw[];
    Frame F;
    F.lds = (LAS unsigned char*)lds_raw;
    F.wave = __builtin_amdgcn_readfirstlane((int)threadIdx.x >> 6);
    F.G = gridDim.x; { const int bx = blockIdx.x; F.vcu = (F.G % 8 == 0) ? (bx % 8) * (F.G / 8) + bx / 8 : bx; }
    F.gw = F.vcu * NWAVES + F.wave; F.NGW = F.G * NWAVES;
    unsigned char* ws = args.ws;
    unsigned* ctl = (unsigned*)(ws + WS_CTL);
    volatile LAS unsigned* MISC = (volatile LAS unsigned*)(F.lds + MISC_OFF);
    LAS int* TAB = (LAS int*)(F.lds + TAB_OFF);
    { const int tid0 = threadIdx.x;
      if (tid0 < 64) MISC[tid0] = 0u;
      if (tid0 < 33) ((LAS unsigned long long*)(F.lds + MISC_OFF + 256))[tid0] = (unsigned long long)args.in[tid0]; }
    __syncthreads();
    XcdBarrier bar = xcd_barrier_post(ctl + CW_BAR, MISC + 8, F.wave == 0 && lane_id() == 0);
    if (PROBE_T >= 0 && blockIdx.x == 0 && F.wave == 0 && lane_id() == 0) { volatile LAS unsigned long long* st = (volatile LAS unsigned long long*)(F.lds + MISC_OFF + 1024); st[0] = __builtin_amdgcn_s_memrealtime(); st[1] = 0ull; }
    const int lo = args.ph_lo, hi = args.ph_hi;
    WS_PTRS
    if (IN(0) && !defined_SKIP_P0) { const int lane = lane_id(), tid = F.wave * 64 + lane; (void)tid;
      {
        LAS unsigned char* scr = F.lds + F.wave * 8704;
        {
            constexpr int I_GU = 128 * 16 * 32, I_DN = 128 * 16 * 16, I_ML = 16 * 48, I_SQ = 16 * 16, I_RI = 16 * 96, I_RO = 32 * 16;
            constexpr int B0 = I_GU, B1 = B0 + I_DN, B2 = B1 + I_ML, B3 = B2 + I_SQ, B4 = B3 + I_RI, B5 = B4 + I_RO, B6 = B5 + I_ML, B7 = B6 + I_SQ, B8 = B7 + I_SQ, B9 = B8 + I_SQ, B10 = B9 + I_SQ;
#define P0_ITEM(IT_) do { const int it = (IT_); \
                    const float* src; bf16* dst; int ldw, Kd, nnb, mode = 0, r; \
                    if (it < B0)      { r = it;      const int q = r / (16 * 32); r -= q * (16 * 32); src = INP(29) + (size_t)q * 1024 * 2048; dst = (bf16*)(ws + WS_WT_GU) + (size_t)q * 2048 * 1024; ldw = 2048; Kd = 1024; nnb = 32; mode = 1; } \
                    else if (it < B1) { r = it - B0; const int q = r / (16 * 16); r -= q * (16 * 16); src = INP(31) + (size_t)q * 1024 * 1024; dst = (bf16*)(ws + WS_WT_DN) + (size_t)q * 1024 * 1024; ldw = 1024; Kd = 1024; nnb = 16; } \
                    else if (it < B2) { r = it - B1; src = INP(3);  dst = (bf16*)(ws + WS_WT_ML_IN);  ldw = 3088; Kd = 1024; nnb = 48; } \
                    else if (it < B3) { r = it - B2; src = INP(6);  dst = (bf16*)(ws + WS_WT_ML_OUT); ldw = 1024; Kd = 1024; nnb = 16; } \
                    else if (it < B4) { r = it - B3; src = INP(7);  dst = (bf16*)(ws + WS_WT_RET_IN); ldw = 6144; Kd = 1024; nnb = 96; mode = 2; } \
                    else if (it < B5) { r = it - B4; src = INP(9);  dst = (bf16*)(ws + WS_WT_RET_OUT); ldw = 1024; Kd = 2048; nnb = 16; } \
                    else if (it < B6) { r = it - B5; src = INP(10); dst = (bf16*)(ws + WS_WT_GLA_IN); ldw = 3088; Kd = 1024; nnb = 48; } \
                    else if (it < B7) { r = it - B6; src = INP(14); dst = (bf16*)(ws + WS_WT_GLA_OUT); ldw = 1024; Kd = 1024; nnb = 16; } \
                    else if (it < B8) { r = it - B7; src = INP(15); dst = (bf16*)(ws + WS_WT_S5_IN);  ldw = 1024; Kd = 1024; nnb = 16; } \
                    else if (it < B9) { r = it - B8; src = INP(24); dst = (bf16*)(ws + WS_WT_S5_GLU); ldw = 1024; Kd = 1024; nnb = 16; } \
                    else              { r = it - B9; src = INP(26); dst = (bf16*)(ws + WS_WT_S5_OUT); ldw = 1024; Kd = 1024; nnb = 16; } \
                const int kb = r / nnb, nb = r - kb * nnb; \
                transpose_item(src, ldw, 0, Kd, dst, mode, kb, nb, scr, lane); } while (0)
            const int NSTAT = (B10 / F.NGW) * 4 / 5, DYN0 = NSTAT * F.NGW, DLEN = B10 - DYN0, GLEN = (DLEN + 7) / 8;
#pragma unroll 1
            for (int n_ = 0; n_ < NSTAT; ++n_) P0_ITEM(F.gw + n_ * F.NGW);
#pragma unroll 1
            for (int tr = 0; tr < 8; ++tr) { const int grp = ((int)blockIdx.x + tr) & 7; unsigned* q = ctl + 2304 + 64 * grp; const int glo = DYN0 + grp * GLEN, glen = (DLEN - grp * GLEN) < GLEN ? (DLEN - grp * GLEN) : GLEN;
                int cur = 0; if (lane == 0) cur = (int)__hip_atomic_fetch_add(q, 4u, __ATOMIC_RELAXED, __HIP_MEMORY_SCOPE_AGENT); cur = __builtin_amdgcn_readfirstlane(cur);
#pragma unroll 1
                while (cur < glen) { int nx = 0; if (lane == 0) nx = (int)__hip_atomic_fetch_add(q, 4u, __ATOMIC_RELAXED, __HIP_MEMORY_SCOPE_AGENT);
#pragma unroll 1
                    for (int k = 0; k < 4; ++k) if (cur + k < glen) P0_ITEM(glo + cur + k);
                    cur = __builtin_amdgcn_readfirstlane(nx); } }
#undef P0_ITEM
        }
        __syncthreads();
        if (CH_S5) s5_tables(F, ws, tid, INP(16), INP(17), INP(18), INP(19), INP(20), INP(21), INP(23));
        { float* CS = (float*)(ws + WS_CS);
          for (int it = blockIdx.x * NTHREADS + tid; it < T * 64; it += F.G * NTHREADS) { const int t = it >> 6, i = it & 63;
              const float inv = exp2f(-(float)(2 * i) * (13.287712379549449f / 128.f)); float sn, cs; sincosf((float)t * inv, &sn, &cs); CS[2 * it] = cs; CS[2 * it + 1] = sn; } }
        LAS float* Wt = (LAS float*)(F.lds);
        load_cols16(tid, INP(3), 3088, 3072, Wt);
        __syncthreads();
        {
            const float* bg = INP(4);
            f32x4 vn[4]; if (F.gw < M) load_row_f32(x_in + (size_t)F.gw * D, vn, lane);
            for (int row = F.gw; row < M; row += F.NGW) {
                asm volatile("" ::: "memory");
                f32x4 v[4];
#pragma unroll
                for (int j = 0; j < 4; ++j) v[j] = vn[j];
                if (row + F.NGW < M) load_row_f32(x_in + (size_t)(row + F.NGW) * D, vn, lane);
                store_row_bf16(XB + (size_t)row * D, v, lane);
                const float gsum = row_dot16(v, Wt, lane);
                if ((lane & 3) == 0) GB[(size_t)row * 16 + (lane >> 2)] = gsum + bg[lane >> 2];
            }
        }
        __syncthreads();
      }
        SEAM(0);
    }

    layer_body<0>(F, ws, ctl, TAB, bar, lo, hi, args.out);
    layer_body<1>(F, ws, ctl, TAB, bar, lo, hi, args.out);
    layer_body<2>(F, ws, ctl, TAB, bar, lo, hi, args.out);
    layer_body<3>(F, ws, ctl, TAB, bar, lo, hi, args.out);
    if (PROBE_T >= 0 && blockIdx.x == 0 && F.wave == 0 && lane_id() == 0) { volatile LAS unsigned long long* st = (volatile LAS unsigned long long*)(F.lds + MISC_OFF + 1024); args.out[0] = (float)st[1] * (0.01f / 16.f); }
#undef IN
#undef SEAM
#undef INP
#undef x_in
#undef ln_g
#undef ln_b
}

extern "C" void kernel_launch(void* const* d_in, const int* in_sizes, int n_in, void* d_out, int out_size, void* d_ws, size_t ws_size, hipStream_t stream) {
    static int grid = 0;
    if (grid == 0) {
        if (n_in != 33 || out_size != M * D || ws_size < WS_END) { fprintf(stderr, "kernel_launch: unexpected problem (n_in %d, out %d, ws %zu < %zu)\n", n_in, out_size, ws_size, (size_t)WS_END); grid = -1; return; }
        int dev = 0, cus = 0, per_cu = 0;
        if (hipGetDevice(&dev) != hipSuccess || hipDeviceGetAttribute(&cus, hipDeviceAttributeMultiprocessorCount, dev) != hipSuccess) { grid = -1; return; }
        if (hipFuncSetAttribute((const void*)mega_fwd, hipFuncAttributeMaxDynamicSharedMemorySize, LDS_BYTES) != hipSuccess) { fprintf(stderr, "kernel_launch: hipFuncSetAttribute failed\n"); grid = -1; return; }
        if (hipOccupancyMaxActiveBlocksPerMultiprocessor(&per_cu, (const void*)mega_fwd, NTHREADS, LDS_BYTES) != hipSuccess || per_cu < 1) { fprintf(stderr, "kernel_launch: occupancy query says %d\n", per_cu); }
        (void)hipGetLastError();
        grid = cus;
    }
    if (grid < 0) return;
    hipMemsetAsync((char*)d_ws + WS_CTL, 0, CTL_ZERO_BYTES, stream);
    Args a{};
    for (int i = 0; i < 33; ++i) a.in[i] = (const float*)d_in[i];
    a.out = (float*)d_out; a.ws = (unsigned char*)d_ws;
#if N_LAUNCH_MODE == 1
    a.ph_lo = 0; a.ph_hi = 1000;
    hipLaunchKernelGGL(mega_fwd, dim3(grid), dim3(NTHREADS), LDS_BYTES, stream, a);
#else
    for (int ph = 0; ph < 65; ++ph) { a.ph_lo = ph; a.ph_hi = ph + 1; hipLaunchKernelGGL(mega_fwd, dim3(grid), dim3(NTHREADS), LDS_BYTES, stream, a); }
#endif
}
```
